# Optimizing an MI355X kernel written in HIP

```python
import math
import jax
import jax.numpy as jnp
from jax import lax
import numpy as np


D_MODEL = 2048
BATCH = 16
SEQ = 2048
DEPTH = 2

MEM_LEN = 256
Q_BLOCK = 128
ROPE_THETA = 10000.0
NORM_EPS = 1e-6

DIFF_HEADS = 12
DIFF_HEAD_DIM = 64
DIFF_WIDTH = DIFF_HEADS * 2 * DIFF_HEAD_DIM
S5_WIDTH = D_MODEL // 4
S5_GROUP = 16
S5_GROUPS = S5_WIDTH // S5_GROUP
S5_STATE = 64
AB_IN_WIDTH = 3 * DIFF_WIDTH + S5_WIDTH
AB_OUT_WIDTH = DIFF_WIDTH + S5_WIDTH
MLA_HEADS = 16
MLA_Q_RANK = 768
MLA_KV_RANK = 256
MLA_NOPE = 128
MLA_ROPE = 64
MLA_V = 128
MLA_IN_WIDTH = MLA_Q_RANK + MLA_KV_RANK + MLA_ROPE
XA_HEADS = 4
XA_HEAD_DIM = D_MODEL // XA_HEADS
PEER_HEADS = 8
PEER_N_KEYS = 128
PEER_N_EXPERTS = PEER_N_KEYS * PEER_N_KEYS
PEER_TOPK = 16
PEER_KEY_DIM = 256
PEER_HALF = PEER_KEY_DIM // 2
PEER_TOKEN_CHUNK = 128

N_EVEN = (DEPTH + 1) // 2
N_ODD = DEPTH // 2

kernel_name = 'hybrid_diffattn_s5_mla_peer'


def rmsnorm(x, g):
    xf = x.astype(jnp.float32)
    y = xf * lax.rsqrt(jnp.mean(xf * xf, axis=-1, keepdims=True) + NORM_EPS)
    return (y * g.astype(jnp.float32)).astype(x.dtype)


def rope(x, positions):
    d = x.shape[-1]
    half = d // 2
    inv_freq = ROPE_THETA ** (-jnp.arange(half, dtype=jnp.float32) * 2.0 / d)
    ang = positions.astype(jnp.float32)[..., None] * inv_freq
    ang = ang.reshape((ang.shape[0],) + (1,) * (x.ndim - 3) + (ang.shape[1], half))
    cos, sin = jnp.cos(ang), jnp.sin(ang)
    xf = x.astype(jnp.float32)
    x1, x2 = xf[..., :half], xf[..., half:]
    return jnp.concatenate([x1 * cos - x2 * sin, x2 * cos + x1 * sin], axis=-1).astype(x.dtype)


def causal_attention(q, k, v, scale):
    seq = q.shape[2]
    outs = []
    for start in range(0, seq, Q_BLOCK):
        end = start + Q_BLOCK
        s = jnp.einsum('bhqd,bhkd->bhqk', q[:, :, start:end], k[:, :, :end]).astype(jnp.float32) * scale
        mask = (start + jnp.arange(Q_BLOCK))[:, None] >= jnp.arange(end)[None, :]
        p = jax.nn.softmax(jnp.where(mask, s, -jnp.inf), axis=-1)
        outs.append(jnp.einsum('bhqk,bhkd->bhqd', p.astype(v.dtype), v[:, :, :end]))
    return jnp.concatenate(outs, axis=2)


def diff_attention(q, k, v, positions, lq1, lk1, lq2, lk2, subln, lam_init):
    b, s, _ = q.shape
    q = rope(q.reshape(b, s, DIFF_HEADS, 2, DIFF_HEAD_DIM).transpose(0, 2, 3, 1, 4), positions)
    k = rope(k.reshape(b, s, DIFF_HEADS, 2, DIFF_HEAD_DIM).transpose(0, 2, 3, 1, 4), positions)
    v = v.reshape(b, s, DIFF_HEADS, 2 * DIFF_HEAD_DIM).transpose(0, 2, 1, 3)
    lam = (jnp.exp(jnp.sum(lq1.astype(jnp.float32) * lk1.astype(jnp.float32)))
           - jnp.exp(jnp.sum(lq2.astype(jnp.float32) * lk2.astype(jnp.float32))) + lam_init)
    scale = DIFF_HEAD_DIM ** -0.5
    o1 = causal_attention(q[:, :, 0], k[:, :, 0], v, scale)
    o2 = causal_attention(q[:, :, 1], k[:, :, 1], v, scale)
    o = (o1.astype(jnp.float32) - lam * o2.astype(jnp.float32)).astype(v.dtype)
    o = rmsnorm(o, subln) * (1.0 - lam_init)
    return o.transpose(0, 2, 1, 3).reshape(b, s, DIFF_WIDTH)


def s5_mixer(u, a_re, a_im, log_step, b_re, b_im, c_re, c_im, d, w_glu, b_glu):
    bsz, s, _ = u.shape
    f32 = jnp.float32
    uf = u.astype(f32).reshape(bsz, s, S5_GROUPS, S5_GROUP)
    a_re = a_re.astype(f32)
    a_im = a_im.astype(f32)
    step = jnp.exp(log_step.astype(f32))[:, None]
    mag = jnp.exp(a_re * step)
    ab_re = mag * jnp.cos(a_im * step)
    ab_im = mag * jnp.sin(a_im * step)
    den = a_re * a_re + a_im * a_im
    num_re = ab_re - 1.0
    f_re = (num_re * a_re + ab_im * a_im) / den
    f_im = (ab_im * a_re - num_re * a_im) / den
    b_re = b_re.astype(f32)
    b_im = b_im.astype(f32)
    bb_re = f_re[..., None] * b_re - f_im[..., None] * b_im
    bb_im = f_re[..., None] * b_im + f_im[..., None] * b_re
    bu_re = jnp.einsum('bsgp,gnp->bsgn', uf, bb_re)
    bu_im = jnp.einsum('bsgp,gnp->bsgn', uf, bb_im)

    def combine(left, right):
        al_re, al_im, bl_re, bl_im = left
        ar_re, ar_im, br_re, br_im = right
        return (ar_re * al_re - ar_im * al_im,
                ar_re * al_im + ar_im * al_re,
                ar_re * bl_re - ar_im * bl_im + br_re,
                ar_re * bl_im + ar_im * bl_re + br_im)

    a_seq_re = jnp.broadcast_to(ab_re[None, None], (1, s, S5_GROUPS, S5_STATE))
    a_seq_im = jnp.broadcast_to(ab_im[None, None], (1, s, S5_GROUPS, S5_STATE))
    _, _, h_re, h_im = lax.associative_scan(combine, (a_seq_re, a_seq_im, bu_re, bu_im), axis=1)
    y = (jnp.einsum('bsgn,gpn->bsgp', h_re, c_re.astype(f32))
         - jnp.einsum('bsgn,gpn->bsgp', h_im, c_im.astype(f32))
         + d.astype(f32) * uf).reshape(bsz, s, S5_WIDTH)
    g = jax.nn.gelu(y, approximate=False)
    out = g * jax.nn.sigmoid(g @ w_glu.astype(f32) + b_glu.astype(f32))
    return out.astype(u.dtype)


def mla(h, positions, w_in, q_norm, kv_norm, w_uq, w_ukv, w_o):
    b, s, _ = h.shape
    proj = h @ w_in
    cq = proj[..., :MLA_Q_RANK]
    ckv = proj[..., MLA_Q_RANK:MLA_Q_RANK + MLA_KV_RANK]
    k_rope = proj[..., MLA_Q_RANK + MLA_KV_RANK:]
    q = (rmsnorm(cq, q_norm) @ w_uq).reshape(b, s, MLA_HEADS, MLA_NOPE + MLA_ROPE).transpose(0, 2, 1, 3)
    q = jnp.concatenate([q[..., :MLA_NOPE], rope(q[..., MLA_NOPE:], positions)], axis=-1)
    kv = (rmsnorm(ckv, kv_norm) @ w_ukv).reshape(b, s, MLA_HEADS, MLA_NOPE + MLA_V).transpose(0, 2, 1, 3)
    k_rope = rope(k_rope[:, None], positions)
    k = jnp.concatenate([kv[..., :MLA_NOPE], jnp.broadcast_to(k_rope, (b, MLA_HEADS, s, MLA_ROPE))], axis=-1)
    o = causal_attention(q, k, kv[..., MLA_NOPE:], (MLA_NOPE + MLA_ROPE) ** -0.5)
    return o.transpose(0, 2, 1, 3).reshape(b, s, MLA_HEADS * MLA_V) @ w_o


def memory_cross_attention(h, mem_n, w_q, w_kv, w_o):
    b, s, _ = h.shape
    m = mem_n.shape[1]
    q = (h @ w_q).reshape(b, s, XA_HEADS, XA_HEAD_DIM)
    kv = mem_n @ w_kv
    k = kv[..., :D_MODEL].reshape(b, m, XA_HEADS, XA_HEAD_DIM)
    v = kv[..., D_MODEL:].reshape(b, m, XA_HEADS, XA_HEAD_DIM)
    sc = jnp.einsum('bshd,bmhd->bhsm', q, k).astype(jnp.float32) * XA_HEAD_DIM ** -0.5
    p = jax.nn.softmax(sc, axis=-1)
    o = jnp.einsum('bhsm,bmhd->bshd', p.astype(v.dtype), v).reshape(b, s, D_MODEL)
    return o @ w_o


def peer_ffn(h, w_query, sub_keys, u_table, v_table):
    b, s, d = h.shape
    t = h.reshape(b * s, d)
    n_tok = t.shape[0]
    q = (t @ w_query).reshape(n_tok, PEER_HEADS, 2, PEER_HALF)
    sc = jnp.einsum('thcq,hcnq->thcn', q, sub_keys).astype(jnp.float32)
    top_s, top_i = lax.top_k(sc, PEER_TOPK)
    cand_s = top_s[:, :, 0, :, None] + top_s[:, :, 1, None, :]
    cand_i = top_i[:, :, 0, :, None] * PEER_N_KEYS + top_i[:, :, 1, None, :]
    best_s, best_pos = lax.top_k(cand_s.reshape(n_tok, PEER_HEADS, PEER_TOPK * PEER_TOPK), PEER_TOPK)
    expert_idx = jnp.take_along_axis(cand_i.reshape(n_tok, PEER_HEADS, PEER_TOPK * PEER_TOPK), best_pos, axis=-1)
    gates = jax.nn.softmax(best_s, axis=-1)
    n_chunks = n_tok // PEER_TOKEN_CHUNK

    def chunk_fn(args):
        tc, ic, gc = args
        act = jax.nn.gelu(jnp.einsum('cd,chkd->chk', tc, u_table[ic]).astype(jnp.float32), approximate=False)
        w = (gc * act).astype(tc.dtype)
        return jnp.einsum('chk,chkd->cd', w, v_table[ic])

    out = lax.map(chunk_fn, (t.reshape(n_chunks, PEER_TOKEN_CHUNK, d),
                             expert_idx.reshape(n_chunks, PEER_TOKEN_CHUNK, PEER_HEADS, PEER_TOPK),
                             gates.reshape(n_chunks, PEER_TOKEN_CHUNK, PEER_HEADS, PEER_TOPK)))
    return out.reshape(b, s, d)


def setup_inputs(seed: int = 0) -> dict:
    key = jax.random.key(seed)
    ks = iter(jax.random.split(key, 64))

    def nrm(shape, scale):
        return scale * jax.random.normal(next(ks), shape, jnp.float32)

    def gain(shape):
        return 1.0 + nrm(shape, 0.02)

    x = nrm((BATCH, SEQ, D_MODEL), 1.0)
    mem = nrm((BATCH, MEM_LEN, D_MODEL), 1.0)
    offsets = jax.random.randint(next(ks), (BATCH, 1), 0, 1024, dtype=jnp.int32)
    positions = (offsets + jnp.arange(SEQ, dtype=jnp.int32)[None, :]).astype(jnp.int32)
    NE, NO, L = N_EVEN, N_ODD, DEPTH
    G, N, P = S5_GROUPS, S5_STATE, S5_GROUP
    return {
        'x': x, 'mem': mem, 'positions': positions,
        'ab_norm': gain((NE, D_MODEL)),
        'ab_w_in': nrm((NE, D_MODEL, AB_IN_WIDTH), D_MODEL ** -0.5),
        'ab_w_out': nrm((NE, AB_OUT_WIDTH, D_MODEL), AB_OUT_WIDTH ** -0.5),
        'diff_lq1': nrm((NE, DIFF_HEAD_DIM), 0.1),
        'diff_lk1': nrm((NE, DIFF_HEAD_DIM), 0.1),
        'diff_lq2': nrm((NE, DIFF_HEAD_DIM), 0.1),
        'diff_lk2': nrm((NE, DIFF_HEAD_DIM), 0.1),
        'diff_subln': gain((NE, 2 * DIFF_HEAD_DIM)),
        's5_a_re': -0.5 + nrm((NE, G, N), 0.01),
        's5_a_im': jnp.pi * jnp.arange(N, dtype=jnp.float32) + nrm((NE, G, N), 0.01),
        's5_log_step': jax.random.uniform(next(ks), (NE, G), jnp.float32, math.log(1e-3), math.log(1e-1)),
        's5_b_re': nrm((NE, G, N, P), (2 * P) ** -0.5),
        's5_b_im': nrm((NE, G, N, P), (2 * P) ** -0.5),
        's5_c_re': nrm((NE, G, P, N), (2 * N) ** -0.5 * 4.0),
        's5_c_im': nrm((NE, G, P, N), (2 * N) ** -0.5 * 4.0),
        's5_d': nrm((NE, G, P), 1.0),
        's5_w_glu': nrm((NE, S5_WIDTH, S5_WIDTH), S5_WIDTH ** -0.5),
        's5_b_glu': nrm((NE, S5_WIDTH), 0.02),
        'mla_norm': gain((NO, D_MODEL)),
        'mla_w_in': nrm((NO, D_MODEL, MLA_IN_WIDTH), D_MODEL ** -0.5),
        'mla_q_norm': gain((NO, MLA_Q_RANK)),
        'mla_kv_norm': gain((NO, MLA_KV_RANK)),
        'mla_w_uq': nrm((NO, MLA_Q_RANK, MLA_HEADS * (MLA_NOPE + MLA_ROPE)), MLA_Q_RANK ** -0.5),
        'mla_w_ukv': nrm((NO, MLA_KV_RANK, MLA_HEADS * (MLA_NOPE + MLA_V)), MLA_KV_RANK ** -0.5),
        'mla_w_o': nrm((NO, MLA_HEADS * MLA_V, D_MODEL), (MLA_HEADS * MLA_V) ** -0.5),
        'xa_norm': gain((L, D_MODEL)),
        'xa_mem_norm': gain((L, D_MODEL)),
        'xa_w_q': nrm((L, D_MODEL, D_MODEL), D_MODEL ** -0.5),
        'xa_w_kv': nrm((L, D_MODEL, 2 * D_MODEL), D_MODEL ** -0.5),
        'xa_w_o': nrm((L, D_MODEL, D_MODEL), D_MODEL ** -0.5),
        'ffn_norm': gain((L, D_MODEL)),
        'peer_w_query': nrm((L, D_MODEL, PEER_HEADS * PEER_KEY_DIM), D_MODEL ** -0.5),
        'peer_sub_keys': nrm((L, PEER_HEADS, 2, PEER_N_KEYS, PEER_HALF), PEER_HALF ** -0.5),
        'peer_u': nrm((L, PEER_N_EXPERTS, D_MODEL), D_MODEL ** -0.5),
        'peer_v': nrm((L, PEER_N_EXPERTS, D_MODEL), PEER_HEADS ** -0.5),
        'final_norm': gain((D_MODEL,)),
    }


def reference(x, mem, positions, ab_norm, ab_w_in, ab_w_out, diff_lq1, diff_lk1, diff_lq2, diff_lk2,
              diff_subln, s5_a_re, s5_a_im, s5_log_step, s5_b_re, s5_b_im, s5_c_re, s5_c_im, s5_d,
              s5_w_glu, s5_b_glu, mla_norm, mla_w_in, mla_q_norm, mla_kv_norm, mla_w_uq, mla_w_ukv,
              mla_w_o, xa_norm, xa_mem_norm, xa_w_q, xa_w_kv, xa_w_o, ffn_norm, peer_w_query,
              peer_sub_keys, peer_u, peer_v, final_norm):
    for layer in range(DEPTH):
        i = layer // 2
        if layer % 2 == 0:
            h = rmsnorm(x, ab_norm[i])
            proj = h @ ab_w_in[i]
            q = proj[..., :DIFF_WIDTH]
            k = proj[..., DIFF_WIDTH:2 * DIFF_WIDTH]
            v = proj[..., 2 * DIFF_WIDTH:3 * DIFF_WIDTH]
            u = proj[..., 3 * DIFF_WIDTH:]
            lam_init = 0.8 - 0.6 * math.exp(-0.3 * layer)
            a_out = diff_attention(q, k, v, positions, diff_lq1[i], diff_lk1[i], diff_lq2[i],
                                   diff_lk2[i], diff_subln[i], lam_init)
            b_out = s5_mixer(u, s5_a_re[i], s5_a_im[i], s5_log_step[i], s5_b_re[i], s5_b_im[i],
                             s5_c_re[i], s5_c_im[i], s5_d[i], s5_w_glu[i], s5_b_glu[i])
            x = x + jnp.concatenate([a_out, b_out.astype(a_out.dtype)], axis=-1) @ ab_w_out[i]
        else:
            x = x + mla(rmsnorm(x, mla_norm[i]), positions, mla_w_in[i], mla_q_norm[i],
                        mla_kv_norm[i], mla_w_uq[i], mla_w_ukv[i], mla_w_o[i])
        x = x + memory_cross_attention(rmsnorm(x, xa_norm[layer]), rmsnorm(mem, xa_mem_norm[layer]),
                                       xa_w_q[layer], xa_w_kv[layer], xa_w_o[layer])
        x = x + peer_ffn(rmsnorm(x, ffn_norm[layer]), peer_w_query[layer], peer_sub_keys[layer],
                         peer_u[layer], peer_v[layer])
    return rmsnorm(x, final_norm)
```

```cpp
#include <hip/hip_runtime.h>
#include <cstdio>
#include <cstdint>

#ifndef MK_ONE_LAUNCH
#define MK_ONE_LAUNCH 0
#endif
#ifndef FAST_GEMM
#define FAST_GEMM 1
#endif
#ifndef FAST_ATTN
#define FAST_ATTN 1
#endif

#ifndef EN_S5
#define EN_S5 1
#endif
#ifndef EN_DIFF
#define EN_DIFF 1
#endif
#ifndef EN_MLA
#define EN_MLA 1
#endif
#ifndef EN_PEER
#define EN_PEER 1
#endif
#ifndef EN_GEMM
#define EN_GEMM 1
#endif
#ifndef EN_PRO
#define EN_PRO 1
#endif
#ifndef GSITE
#define GSITE -1
#endif
#define GAS __attribute__((address_space(1)))
#define LAS __attribute__((address_space(3)))
#define DI __device__ __forceinline__
typedef unsigned short bf16_t;
typedef short bf16x8 __attribute__((ext_vector_type(8)));
typedef short s16x4 __attribute__((ext_vector_type(4)));
typedef float f32x2 __attribute__((ext_vector_type(2)));
typedef float f32x4 __attribute__((ext_vector_type(4)));
typedef float f32x16 __attribute__((ext_vector_type(16)));
typedef unsigned u32x2 __attribute__((ext_vector_type(2)));
typedef unsigned u32x4 __attribute__((ext_vector_type(4)));
typedef __bf16 bf16x2_t __attribute__((ext_vector_type(2)));

constexpr int BATCH = 16, SEQ = 2048, DM = 2048, T = BATCH * SEQ, MEM_LEN = 256, MT = BATCH * MEM_LEN;
constexpr int DIFF_HEADS = 12, DIFF_W = 1536, S5_W = 512, AB_IN = 5120;
constexpr int MLA_HEADS = 16, MLA_QR = 768, MLA_KVR = 256, MLA_IN = 1088, MLA_IN_PAD = 1280;
constexpr int PEER_NE = 16384;
constexpr float NORM_EPS = 1e-6f;
constexpr int ROPE_POS = 3072;
constexpr int NWAVES = 8, NTHREADS = 512;

constexpr size_t MiB = 1u << 20;
constexpr size_t WS_CTL = 0, CTL_BYTES = 1 * MiB;
constexpr size_t WS_ROPE = 1 * MiB;
constexpr size_t WS_ABIN_T = 2 * MiB, WS_ABOUT_T = 22 * MiB, WS_GLU_T = 30 * MiB, WS_MLAIN_T = 31 * MiB, WS_UQ_T = 36 * MiB, WS_UKV_T = 41 * MiB, WS_MLAO_T = 43 * MiB;
constexpr size_t WS_LW = 51 * MiB, LW_STRIDE = 40 * MiB;
constexpr size_t LW_XQ = 0, LW_XKV = 8 * MiB, LW_XO = 24 * MiB, LW_PEER = 32 * MiB;
constexpr size_t WS_KVX = 131 * MiB, KVX_STRIDE = 32 * MiB;
constexpr size_t WS_POOL = 195 * MiB;
constexpr size_t P_H = WS_POOL;
constexpr size_t P_PROJ = WS_POOL + 128 * MiB;
constexpr size_t P_CONCAT = WS_POOL + 448 * MiB;
constexpr size_t P_GBUF = WS_POOL + 576 * MiB;
constexpr size_t P_MLAPROJ = WS_POOL + 128 * MiB;
constexpr size_t P_CQN = WS_POOL + 208 * MiB;
constexpr size_t P_CKVN = WS_POOL + 256 * MiB;
constexpr size_t P_KROPE = WS_POOL + 272 * MiB;
constexpr size_t P_Q = WS_POOL + 288 * MiB;
constexpr size_t P_KV = WS_POOL + 480 * MiB;
constexpr size_t P_QX = WS_POOL + 128 * MiB;
constexpr size_t P_S = WS_POOL + 256 * MiB;
constexpr size_t P_P = WS_POOL + 384 * MiB;
constexpr size_t P_OX = WS_POOL + 448 * MiB;
constexpr size_t P_SC = WS_POOL + 128 * MiB;
constexpr size_t P_UT = WS_POOL + 704 * MiB;
constexpr size_t P_VT = WS_POOL + 768 * MiB;
constexpr size_t P_MEMN = WS_POOL + 608 * MiB;
constexpr size_t P_WQB = WS_POOL + 640 * MiB;
constexpr size_t P_SK = WS_POOL + 656 * MiB;
constexpr size_t WS_END = WS_POOL + 832 * MiB;
constexpr int CW_BAR = 4096, CW_CTR = 16384;

constexpr int RING_BYTES = 131072, LDSCTL_OFF = RING_BYTES, LDS_BYTES = 147456;

DI unsigned pk2(float lo, float hi) { f32x2 v = {lo, hi}; bf16x2_t b = __builtin_convertvector(v, bf16x2_t); return __builtin_bit_cast(unsigned, b); }
DI float bflo(unsigned u) { return __uint_as_float(u << 16); }
DI float bfhi(unsigned u) { return __uint_as_float(u & 0xffff0000u); }
DI float bf2f(bf16_t b) { return __uint_as_float(((unsigned)b) << 16); }
DI bf16_t f2bf(float f) { return (bf16_t)(pk2(f, 0.f) & 0xffffu); }
DI float dot2bf(unsigned a, unsigned b, float c) { return __builtin_amdgcn_fdot2_f32_bf16(__builtin_bit_cast(bf16x2_t, a), __builtin_bit_cast(bf16x2_t, b), c, false); }
DI float wave_sum(float v) {
#pragma unroll
    for (int o = 1; o < 64; o <<= 1) v += __shfl_xor(v, o);
    return v;
}
DI float gelu_erf(float v) { return 0.5f * v * (1.0f + erff(v * 0.70710678118654752f)); }
DI float swap32_max(float x) { auto rr = __builtin_amdgcn_permlane32_swap(__float_as_uint(x), __float_as_uint(x), false, false); return fmaxf(__uint_as_float(rr[0]), __uint_as_float(rr[1])); }
DI float swap32_sum(float x) { auto rr = __builtin_amdgcn_permlane32_swap(__float_as_uint(x), __float_as_uint(x), false, false); return __uint_as_float(rr[0]) + __uint_as_float(rr[1]); }
#define LDS_WAIT() asm volatile("s_waitcnt lgkmcnt(0)" ::: "memory")
#define VM_WAIT() asm volatile("s_waitcnt vmcnt(0)" ::: "memory")

#define XB_TMO      128
#define XB_XCNT(j)  (256  + 64 * (j))
#define XB_XSUB(j)  (1280 + 64 * (j))
#define XB_XGEN(j)  (2304 + 64 * (j))
#define XB_TOP      3328
#define XB_TOPGEN   3392
#define XCD_BAR_WORDS 3456
#define XB_SPIN_CAP (1u << 20)
DI unsigned xb_ld(unsigned* p)              { return __hip_atomic_load(p, __ATOMIC_RELAXED, __HIP_MEMORY_SCOPE_AGENT); }
DI unsigned xb_add(unsigned* p, unsigned v) { return __hip_atomic_fetch_add(p, v, __ATOMIC_RELAXED, __HIP_MEMORY_SCOPE_AGENT); }
DI unsigned xb_xcc_id() { return (unsigned)__builtin_amdgcn_s_getreg((3 << 11) | 20) & 0xFu; }
#define XB_SPIN(cond, bar) do { unsigned _sp = 0; while (cond) { __builtin_amdgcn_s_sleep(1); \
    if ((++_sp & 255u) == 0u) { if (xb_ld(&(bar)[XB_TMO])) break; if (_sp > XB_SPIN_CAP) { atomicAdd(&(bar)[XB_TMO], 1u); break; } } } } while (0)
struct XcdBarrier { unsigned* bar; unsigned x; volatile LAS unsigned* st; };
DI XcdBarrier xcd_barrier_post(unsigned* bar, volatile LAS unsigned* st) {
    XcdBarrier b; b.bar = bar; b.x = xb_xcc_id(); b.st = st;
    if (threadIdx.x == 0) (void)xb_add(&bar[XB_XCNT(b.x)], 1u);
    return b;
}
DI void xcd_barrier_complete(unsigned* bar, unsigned x, unsigned& nloc, unsigned& nx) {
    const unsigned G = gridDim.x * gridDim.y * gridDim.z;
    unsigned sum, cnt, mine, sp = 0u;
    for (;;) {
        sum = 0u; cnt = 0u; mine = 0u;
#pragma unroll
        for (unsigned j = 0; j < 16; ++j) { const unsigned c = xb_ld(&bar[XB_XCNT(j)]); sum += c; cnt += (c > 0u) ? 1u : 0u; mine = (j == x) ? c : mine; }
        if (sum == G) break;
        __builtin_amdgcn_s_sleep(1);
        if ((++sp & 255u) == 0u) { if (xb_ld(&bar[XB_TMO])) break; if (sp > XB_SPIN_CAP) { atomicAdd(&bar[XB_TMO], 1u); break; } }
    }
    nloc = mine > 0u ? mine : 1u; nx = cnt > 0u ? cnt : 1u;
}
DI void xcd_barrier(const XcdBarrier& b) {
    asm volatile("s_waitcnt vmcnt(0)" ::: "memory");
    __syncthreads();
    if (threadIdx.x == 0) {
        unsigned* bar = b.bar;
        __builtin_amdgcn_s_waitcnt(0);
        unsigned nloc = b.st[0], nx = b.st[1];
        if (nloc == 0u) { xcd_barrier_complete(bar, b.x, nloc, nx); b.st[0] = nloc; b.st[1] = nx; }
        const unsigned old = xb_add(&bar[XB_XSUB(b.x)], 1u);
        const unsigned gen = old / nloc;
        if (old + 1u == (gen + 1u) * nloc) {
            __builtin_amdgcn_fence(__ATOMIC_RELEASE, "agent");
            asm volatile("s_waitcnt vmcnt(0)" ::: "memory");
            const unsigned og = xb_add(&bar[XB_TOP], 1u);
            const unsigned tg = og / nx;
            if (og + 1u == (tg + 1u) * nx) xb_add(&bar[XB_TOPGEN], 1u);
            else XB_SPIN(xb_ld(&bar[XB_TOPGEN]) == tg, bar);
            __builtin_amdgcn_fence(__ATOMIC_ACQUIRE, "agent");
            xb_add(&bar[XB_XGEN(b.x)], 1u);
            asm volatile("s_waitcnt vmcnt(0)" ::: "memory");
        } else {
            XB_SPIN(xb_ld(&bar[XB_XGEN(b.x)]) == gen, bar);
            __builtin_amdgcn_fence(__ATOMIC_ACQUIRE, "agent");
            asm volatile("s_waitcnt vmcnt(0)" ::: "memory");
        }
    }
    __syncthreads();
}

namespace g8 {
constexpr int BM = 256, BK = 64, HALF = 128, HTB = HALF * BK * 2, STAGE_BYTES = 8 * HTB, NXCD = 8, WGM = 8;
DI int lds_byte(int r, int c) { const int st = (r >> 4) * 2 + (c >> 5), rr = r & 15, cc = c & 31, ob = rr * 64 + cc * 2; return st * 1024 + (ob ^ (((ob >> 9) & 1) << 5)); }
DI void stage_rc(int b, int& R, int& C) { const int st = b / 1024, sb = b % 1024, swz = sb ^ (((sb >> 9) & 1) << 5); R = (st >> 1) * 16 + swz / 64; C = (st & 1) * 32 + (swz % 64) / 2; }
DI int perm32(int rho) { const int n = rho >> 4, i = rho & 15; return 8 * (i >> 2) + 4 * n + (i & 3); }

struct Unit { int zo, zi, pm, pn; };
struct Desc { const bf16_t* A; const bf16_t* Bt; int lda, ldb, K, nM, nN, nZo, nZi; long sAo, sAi, sBo, sBi; };
DI bool next_unit(const Desc& g, int i, int G, int c, Unit& u) {
    const int per = g.nM * g.nN, nwg = per * g.nZo * g.nZi;
    const long L = (long)i * G + c; if (L >= nwg) return false;
    int wgid = (int)L; { const int q = nwg / NXCD, r = nwg % NXCD, xcd = wgid % NXCD, off = wgid / NXCD; wgid = (xcd < r ? xcd * (q + 1) : r * (q + 1) + (xcd - r) * q) + off; }
    const int z = wgid / per, w = wgid % per;
    u.zo = z / g.nZi; u.zi = z % g.nZi;
    const int nig = WGM * g.nN, gid = w / nig, fm = gid * WGM, gsz = (g.nM - fm) < WGM ? (g.nM - fm) : WGM;
    u.pm = fm + ((w % nig) % gsz); u.pn = (w % nig) / gsz; return true;
}

template <class Epi>
DI void gemm_phase(LAS unsigned char* lds, const Desc g, const Epi& E, int G, int c) {
    const int tid = threadIdx.x, wid = __builtin_amdgcn_readfirstlane(tid >> 6), lane = tid & 63, wr = wid >> 2, wc = wid & 3, fr = lane & 15, fq = lane >> 4;
    const int K = g.K, nt = K / BK;
    unsigned voffA[2], voffB[2];
#pragma unroll
    for (int i = 0; i < 2; ++i) { int R, C; stage_rc(tid * 16 + i * 8192, R, C); const int Rb = (R & ~31) + perm32(R & 31);
        voffA[i] = (unsigned)(R * g.lda + C) * 2u; voffB[i] = (unsigned)(Rb * g.ldb + C) * 2u; }
    const size_t kstep = (size_t)(BK * 2);
    const size_t hstepA = (size_t)HALF * g.lda * 2, hstepB = (size_t)HALF * g.ldb * 2;
    const unsigned ldsw = (unsigned)wid * 1024u;
    const int aoff = lds_byte(wr * 64 + fr, fq * 8), boff = lds_byte(wc * 32 + fr, fq * 8);
#define PG8_SA(b, h) (((b) * 2 + (h)) * HTB)
#define PG8_SB(b, h) ((4 + (b) * 2 + (h)) * HTB)
#define PG8_STAGE(bufoff, gbase, voff) do { _Pragma("unroll") for (int _i = 0; _i < 2; ++_i) \
        __builtin_amdgcn_global_load_lds((const unsigned*)((const char*)(gbase) + (voff)[_i]), (LAS unsigned*)(lds + (bufoff) + ldsw + _i * 8192), 16, 0, 0); } while (0)
#define PG8_LDA(dst, b, h) do { _Pragma("unroll") for (int m = 0; m < 4; ++m) _Pragma("unroll") for (int k = 0; k < 2; ++k) dst[m][k] = *(const LAS bf16x8*)(lds + PG8_SA(b, h) + aoff + m * 2048 + k * 1024); } while (0)
#define PG8_LDB(dst, b, h) do { _Pragma("unroll") for (int n = 0; n < 2; ++n) _Pragma("unroll") for (int k = 0; k < 2; ++k) dst[n][k] = *(const LAS bf16x8*)(lds + PG8_SB(b, h) + boff + n * 2048 + k * 1024); } while (0)
#define PG8_MMA(ai, bj, At, Bt) do { __builtin_amdgcn_s_setprio(1); _Pragma("unroll") for (int m = 0; m < 4; ++m) _Pragma("unroll") for (int n = 0; n < 2; ++n) _Pragma("unroll") for (int k = 0; k < 2; ++k) \
        acc[ai][bj][m][n] = __builtin_amdgcn_mfma_f32_16x16x32_bf16(Bt[n][k], At[m][k], acc[ai][bj][m][n], 0, 0, 0); __builtin_amdgcn_s_setprio(0); } while (0)
#define PG8_WAIT_V(n) asm volatile("s_waitcnt vmcnt(" #n ")" ::: "memory")
#define PG8_WAIT_L(n) asm volatile("s_waitcnt lgkmcnt(" #n ")" ::: "memory")
#define PG8_BAR __builtin_amdgcn_s_barrier()
#define PG8_SCHED __builtin_amdgcn_sched_barrier(0)
#define PG8_APTR(u) ((const char*)g.A + ((size_t)(u).zo * g.sAo + (size_t)(u).zi * g.sAi + (size_t)(u).pm * BM * g.lda) * 2)
#define PG8_BPTR(u) ((const char*)g.Bt + ((size_t)(u).zo * g.sBo + (size_t)(u).zi * g.sBi + (size_t)(u).pn * BM * g.ldb) * 2)
    Unit cur, nxt; int ui = 0;
    if (!next_unit(g, 0, G, c, cur)) return;
    f32x4 acc[2][2][4][2];
#pragma unroll
    for (int a = 0; a < 2; ++a)
#pragma unroll
        for (int b = 0; b < 2; ++b)
#pragma unroll
            for (int m = 0; m < 4; ++m)
#pragma unroll
                for (int n = 0; n < 2; ++n) acc[a][b][m][n] = (f32x4){0.f, 0.f, 0.f, 0.f};
    bf16x8 At[4][2], B0[2][2], B1[2][2];
    const char* cA = PG8_APTR(cur); const char* cB = PG8_BPTR(cur);
    PG8_STAGE(PG8_SB(0, 0), cB, voffB); PG8_STAGE(PG8_SA(0, 0), cA, voffA); PG8_STAGE(PG8_SB(0, 1), cB + hstepB, voffB); PG8_STAGE(PG8_SA(0, 1), cA + hstepA, voffA);
    if (wr == 1) PG8_BAR;
    PG8_WAIT_V(4); PG8_BAR;
    PG8_STAGE(PG8_SB(1, 0), cB + kstep, voffB); PG8_STAGE(PG8_SA(1, 0), cA + kstep, voffA); PG8_STAGE(PG8_SB(1, 1), cB + hstepB + kstep, voffB);
    PG8_WAIT_V(6); PG8_BAR;
    for (;;) {
        const bool has_next = next_unit(g, ui + 1, G, c, nxt);
        const char* nA = has_next ? PG8_APTR(nxt) : cA; const char* nB = has_next ? PG8_BPTR(nxt) : cB;
        for (int t = 0; t < nt; t += 2) {
            const bool last = (t == nt - 2);
            const char* a1 = cA + (size_t)(t + 1) * kstep;
            const char* a2 = last ? nA : cA + (size_t)(t + 2) * kstep; const char* b2 = last ? nB : cB + (size_t)(t + 2) * kstep;
            const char* a3 = a2 + kstep; const char* b3 = b2 + kstep;
            PG8_LDB(B0, 0, 0); PG8_SCHED; PG8_LDA(At, 0, 0); PG8_STAGE(PG8_SA(1, 1), a1 + hstepA, voffA);
            PG8_WAIT_L(8); PG8_BAR; PG8_WAIT_L(0); PG8_MMA(0, 0, At, B0); PG8_BAR; PG8_SCHED;
            PG8_LDB(B1, 0, 1); PG8_STAGE(PG8_SB(0, 0), b2, voffB);
            PG8_BAR; PG8_WAIT_L(0); PG8_MMA(0, 1, At, B1); PG8_BAR;
            PG8_LDA(At, 0, 1); PG8_STAGE(PG8_SA(0, 0), a2, voffA);
            PG8_BAR; PG8_WAIT_L(0); PG8_MMA(1, 0, At, B0); PG8_BAR; PG8_SCHED;
            PG8_STAGE(PG8_SB(0, 1), b2 + hstepB, voffB);
            PG8_WAIT_V(6); PG8_BAR; PG8_MMA(1, 1, At, B1); PG8_BAR;
            PG8_LDB(B0, 1, 0); PG8_SCHED; PG8_LDA(At, 1, 0); PG8_STAGE(PG8_SA(0, 1), a2 + hstepA, voffA);
            PG8_WAIT_L(8); PG8_BAR; PG8_WAIT_L(0); PG8_MMA(0, 0, At, B0); PG8_BAR; PG8_SCHED;
            PG8_LDB(B1, 1, 1); PG8_STAGE(PG8_SB(1, 0), b3, voffB);
            PG8_BAR; PG8_WAIT_L(0); PG8_MMA(0, 1, At, B1); PG8_BAR;
            PG8_LDA(At, 1, 1); PG8_STAGE(PG8_SA(1, 0), a3, voffA);
            PG8_BAR; PG8_WAIT_L(0); PG8_MMA(1, 0, At, B0); PG8_BAR; PG8_SCHED;
            PG8_STAGE(PG8_SB(1, 1), b3 + hstepB, voffB);
            PG8_WAIT_V(6); PG8_BAR; PG8_MMA(1, 1, At, B1); PG8_BAR;
        }
        {
            const int row0 = cur.pm * BM + wr * 64 + fr, col0 = cur.pn * BM + wc * 32 + 8 * fq;
#pragma unroll
            for (int ai = 0; ai < 2; ++ai)
#pragma unroll
                for (int m = 0; m < 4; ++m)
#pragma unroll
                    for (int bj = 0; bj < 2; ++bj) E.oct(cur.zo, cur.zi, row0 + ai * HALF + m * 16, col0 + bj * HALF, acc[ai][bj][m][0], acc[ai][bj][m][1]);
        }
        if (!has_next) break;
#pragma unroll
        for (int a = 0; a < 2; ++a)
#pragma unroll
            for (int b = 0; b < 2; ++b)
#pragma unroll
                for (int m = 0; m < 4; ++m)
#pragma unroll
                    for (int n = 0; n < 2; ++n) acc[a][b][m][n] = (f32x4){0.f, 0.f, 0.f, 0.f};
        cur = nxt; cA = nA; cB = nB; ++ui;
    }
    PG8_WAIT_V(0);
    if (wr == 0) PG8_BAR;
    PG8_BAR;
#undef PG8_SA
#undef PG8_SB
#undef PG8_STAGE
#undef PG8_LDA
#undef PG8_LDB
#undef PG8_MMA
#undef PG8_WAIT_V
#undef PG8_WAIT_L
#undef PG8_BAR
#undef PG8_SCHED
#undef PG8_APTR
#undef PG8_BPTR
}

template <class Epi>
DI void naive_gemm(const Desc g, const Epi& E, int G, int c) {
    const int M = g.nM * BM, N = g.nN * BM, n8 = N / 8, nZ = g.nZo * g.nZi;
    const long total = (long)nZ * M * n8;
    for (long idx = (long)c * NTHREADS + threadIdx.x; idx < total; idx += (long)G * NTHREADS) {
        const int col = (int)(idx % n8) * 8; const int row = (int)((idx / n8) % M); const int z = (int)(idx / ((long)n8 * M));
        const int zo = z / g.nZi, zi = z % g.nZi;
        const bf16_t* a = g.A + (size_t)zo * g.sAo + (size_t)zi * g.sAi + (size_t)row * g.lda;
        const bf16_t* b = g.Bt + (size_t)zo * g.sBo + (size_t)zi * g.sBi + (size_t)col * g.ldb;
        float acc[8];
#pragma unroll
        for (int j = 0; j < 8; ++j) acc[j] = 0.f;
        for (int k = 0; k < g.K; k += 8) {
            const u32x4 av = *(const u32x4*)(a + k);
#pragma unroll
            for (int j = 0; j < 8; ++j) { const u32x4 bv = *(const u32x4*)(b + (size_t)j * g.ldb + k);
                float s = acc[j]; s = dot2bf(av.x, bv.x, s); s = dot2bf(av.y, bv.y, s); s = dot2bf(av.z, bv.z, s); s = dot2bf(av.w, bv.w, s); acc[j] = s; }
        }
        E.oct(zo, zi, row, col, (f32x4){acc[0], acc[1], acc[2], acc[3]}, (f32x4){acc[4], acc[5], acc[6], acc[7]});
    }
}
template <class Epi>
DI void gemm(LAS unsigned char* lds, const Desc g, const Epi& E, int G, int c) {
#if !EN_GEMM
    return;
#elif FAST_GEMM
    gemm_phase(lds, g, E, G, c);
#else
    naive_gemm(g, E, G, c);
#endif
}
}

struct EpiBf16 {
    bf16_t* O; long ldc, sZo, sZi; float scale;
    DI void oct(int zo, int zi, int row, int col, f32x4 lo, f32x4 hi) const {
        bf16_t* p = O + (size_t)zo * sZo + (size_t)zi * sZi + (size_t)row * ldc + col;
        u32x4 w; w.x = pk2(lo[0] * scale, lo[1] * scale); w.y = pk2(lo[2] * scale, lo[3] * scale); w.z = pk2(hi[0] * scale, hi[1] * scale); w.w = pk2(hi[2] * scale, hi[3] * scale);
        *(u32x4*)p = w;
    }
};
struct EpiF32 {
    float* O; long ldc, sZo, sZi; float scale;
    DI void oct(int zo, int zi, int row, int col, f32x4 lo, f32x4 hi) const {
        float* p = O + (size_t)zo * sZo + (size_t)zi * sZi + (size_t)row * ldc + col;
        *(f32x4*)p = lo * scale; *(f32x4*)(p + 4) = hi * scale;
    }
};
struct EpiResid {
    const float* resid; float* out; long ldc;
    DI void oct(int, int, int row, int col, f32x4 lo, f32x4 hi) const {
        const size_t o = (size_t)row * ldc + col;
        const f32x4 r0 = *(const f32x4*)(resid + o), r1 = *(const f32x4*)(resid + o + 4);
        *(f32x4*)(out + o) = r0 + lo; *(f32x4*)(out + o + 4) = r1 + hi;
    }
};
template <int MODE> struct EpiRope {
    bf16_t* O; long ldc; const int* pos; const f32x2* tab;
    DI void oct(int, int, int row, int col, f32x4 lo, f32x4 hi) const {
        bool rope; int j0;
        if (MODE == 0) { rope = col < 2 * DIFF_W; j0 = col & 63; } else { const int c = col % 192; rope = c >= 128; j0 = c - 128; }
        if (rope) {
            int p = pos[row]; p = p < 0 ? 0 : (p > ROPE_POS - 1 ? ROPE_POS - 1 : p);
            const f32x4* tp = (const f32x4*)(tab + (size_t)p * 32 + (j0 >> 1));
            const f32x4 t0 = tp[0], t1 = tp[1];
            f32x4 a = lo, b = hi;
            lo[0] = a[0] * t0[0] - a[1] * t0[1]; lo[1] = a[1] * t0[0] + a[0] * t0[1];
            lo[2] = a[2] * t0[2] - a[3] * t0[3]; lo[3] = a[3] * t0[2] + a[2] * t0[3];
            hi[0] = b[0] * t1[0] - b[1] * t1[1]; hi[1] = b[1] * t1[0] + b[0] * t1[1];
            hi[2] = b[2] * t1[2] - b[3] * t1[3]; hi[3] = b[3] * t1[2] + b[2] * t1[3];
        }
        u32x4 w; w.x = pk2(lo[0], lo[1]); w.y = pk2(lo[2], lo[3]); w.z = pk2(hi[0], hi[1]); w.w = pk2(hi[2], hi[3]);
        *(u32x4*)(O + (size_t)row * ldc + col) = w;
    }
};
struct EpiGlu {
    const bf16_t* gbuf; const float* bias; bf16_t* out;
    DI void oct(int, int, int row, int col, f32x4 lo, f32x4 hi) const {
        const u32x4 gv = *(const u32x4*)(gbuf + (size_t)row * S5_W + col);
        const f32x4 b0 = *(const f32x4*)(bias + col), b1 = *(const f32x4*)(bias + col + 4);
        float g[8] = {bflo(gv.x), bfhi(gv.x), bflo(gv.y), bfhi(gv.y), bflo(gv.z), bfhi(gv.z), bflo(gv.w), bfhi(gv.w)};
        float a[8] = {lo[0] + b0[0], lo[1] + b0[1], lo[2] + b0[2], lo[3] + b0[3], hi[0] + b1[0], hi[1] + b1[1], hi[2] + b1[2], hi[3] + b1[3]};
        float r[8];
#pragma unroll
        for (int j = 0; j < 8; ++j) r[j] = g[j] / (1.0f + __expf(-a[j]));
        u32x4 w; w.x = pk2(r[0], r[1]); w.y = pk2(r[2], r[3]); w.z = pk2(r[4], r[5]); w.w = pk2(r[6], r[7]);
        *(u32x4*)(out + (size_t)row * DM + DIFF_W + col) = w;
    }
};

struct Params {
    const float* in[39];
    float* out; unsigned char* ws;
    int ph_lo, ph_hi;
};
enum { I_X = 0, I_MEM, I_POS, I_AB_NORM, I_AB_WIN, I_AB_WOUT, I_LQ1, I_LK1, I_LQ2, I_LK2, I_SUBLN, I_S5_ARE, I_S5_AIM, I_S5_LOGSTEP, I_S5_BRE, I_S5_BIM, I_S5_CRE, I_S5_CIM, I_S5_D,
       I_S5_WGLU, I_S5_BGLU, I_MLA_NORM, I_MLA_WIN, I_MLA_QNORM, I_MLA_KVNORM, I_MLA_WUQ, I_MLA_WUKV, I_MLA_WO, I_XA_NORM, I_XA_MEMNORM, I_XA_WQ, I_XA_WKV, I_XA_WO, I_FFN_NORM,
       I_PEER_WQ, I_PEER_SK, I_PEER_U, I_PEER_V, I_FINAL_NORM };

struct Ctx { LAS unsigned char* lds; int tid, lane, wave, blk, G; };

DI void rms_rows_2048(const Ctx& C, const float* src, const float* gain, bf16_t* dst, int nrows) {
    for (int r = C.blk * NWAVES + C.wave; r < nrows; r += C.G * NWAVES) {
        const f32x4* xr = (const f32x4*)(src + (size_t)r * DM) + C.lane;
        f32x4 v[8]; float ss = 0.f;
#pragma unroll
        for (int j = 0; j < 8; ++j) { v[j] = xr[64 * j]; ss += (v[j][0] * v[j][0] + v[j][1] * v[j][1]) + (v[j][2] * v[j][2] + v[j][3] * v[j][3]); }
        const float sc = rsqrtf(wave_sum(ss) * (1.0f / DM) + NORM_EPS);
        u32x2* o = (u32x2*)(dst + (size_t)r * DM) + C.lane;
#pragma unroll
        for (int j = 0; j < 8; ++j) { const f32x4 g = *((const f32x4*)gain + C.lane + 64 * j);
            u32x2 w; w.x = pk2(v[j][0] * sc * g[0], v[j][1] * sc * g[1]); w.y = pk2(v[j][2] * sc * g[2], v[j][3] * sc * g[3]); o[64 * j] = w; }
    }
}
DI void rms_rows_final(const Ctx& C, float* x, const float* gain, int nrows) {
    for (int r = C.blk * NWAVES + C.wave; r < nrows; r += C.G * NWAVES) {
        f32x4* xr = (f32x4*)(x + (size_t)r * DM) + C.lane;
        f32x4 v[8]; float ss = 0.f;
#pragma unroll
        for (int j = 0; j < 8; ++j) { v[j] = xr[64 * j]; ss += (v[j][0] * v[j][0] + v[j][1] * v[j][1]) + (v[j][2] * v[j][2] + v[j][3] * v[j][3]); }
        const float sc = rsqrtf(wave_sum(ss) * (1.0f / DM) + NORM_EPS);
#pragma unroll
        for (int j = 0; j < 8; ++j) { const f32x4 g = *((const f32x4*)gain + C.lane + 64 * j); xr[64 * j] = v[j] * sc * g; }
    }
}

DI int srccol(int kind, int n) {
    if (kind == 1) { if (n < 2 * DIFF_W) { const int j = n & 63; return (n & ~63) + (j >> 1) + 32 * (j & 1); } return n; }
    if (kind == 2) { if (n >= MLA_IN) return -1; if (n >= 1024) { const int j = n - 1024; return 1024 + (j >> 1) + 32 * (j & 1); } return n; }
    if (kind == 3) { const int c = n % 192; if (c >= 128) { const int j = c - 128; return n - c + 128 + (j >> 1) + 32 * (j & 1); } return n; }
    return n;
}
DI void transpose_item(const float* W, int K, int Nsrc, bf16_t* Wt, int nblk, int kind, LAS float* scr, int item, int lane) {
    const int kb = item / nblk, nb = item % nblk, k0 = 64 * kb, n0 = 32 * nb;
    const int src = srccol(kind, n0 + (lane & 31));
#pragma unroll 8
    for (int i = 0; i < 32; ++i) { const int kk = 2 * i + (lane >> 5); scr[kk * 33 + (lane & 31)] = (src >= 0) ? W[(size_t)(k0 + kk) * Nsrc + src] : 0.f; }
    LDS_WAIT(); asm volatile("" ::: "memory");
    const int c = lane & 7;
#pragma unroll
    for (int j = 0; j < 4; ++j) { const int n = (lane >> 3) + 8 * j; const LAS float* s = scr + (8 * c) * 33 + n;
        u32x4 o; o.x = pk2(s[0 * 33], s[1 * 33]); o.y = pk2(s[2 * 33], s[3 * 33]); o.z = pk2(s[4 * 33], s[5 * 33]); o.w = pk2(s[6 * 33], s[7 * 33]);
        *(u32x4*)(Wt + (size_t)(n0 + n) * K + k0 + 8 * c) = o; }
    LDS_WAIT(); asm volatile("" ::: "memory");
}
DI void cvt_bf16(const Ctx& C, const float* src, bf16_t* dst, size_t n8) {
    for (size_t i = (size_t)C.blk * NTHREADS + C.tid; i < n8; i += (size_t)C.G * NTHREADS) {
        const f32x4 a = *(const f32x4*)(src + i * 8), b = *(const f32x4*)(src + i * 8 + 4);
        u32x4 w; w.x = pk2(a[0], a[1]); w.y = pk2(a[2], a[3]); w.z = pk2(b[0], b[1]); w.w = pk2(b[2], b[3]);
        *(u32x4*)(dst + i * 8) = w;
    }
}

DI void phase_prologue(const Ctx& C, const Params& P) {
    unsigned char* ws = P.ws;
    LAS float* scr = (LAS float*)(C.lds + C.wave * 8448);
    const int gw = C.blk * NWAVES + C.wave, NGW = C.G * NWAVES;
    int base = 0;
#define TJOB(Wp, K_, Nsrc_, Nout_, kind_, dst_) do { const int nblk_ = (Nout_) / 32, nit_ = ((K_) / 64) * nblk_; \
        int first_ = (gw - base % NGW + NGW) % NGW; \
        for (int it = first_; it < nit_; it += NGW) transpose_item((Wp), (K_), (Nsrc_), (bf16_t*)(dst_), nblk_, (kind_), scr, it, C.lane); base += nit_; } while (0)
    TJOB(P.in[I_AB_WIN], DM, AB_IN, AB_IN, 1, ws + WS_ABIN_T);
    TJOB(P.in[I_AB_WOUT], DM, DM, DM, 0, ws + WS_ABOUT_T);
    TJOB(P.in[I_S5_WGLU], S5_W, S5_W, S5_W, 0, ws + WS_GLU_T);
    TJOB(P.in[I_MLA_WIN], DM, MLA_IN, MLA_IN_PAD, 2, ws + WS_MLAIN_T);
    TJOB(P.in[I_MLA_WUQ], MLA_QR, 3072, 3072, 3, ws + WS_UQ_T);
    TJOB(P.in[I_MLA_WUKV], MLA_KVR, 4096, 4096, 0, ws + WS_UKV_T);
    TJOB(P.in[I_MLA_WO], DM, DM, DM, 0, ws + WS_MLAO_T);
    for (int l = 0; l < 2; ++l) {
        TJOB(P.in[I_XA_WQ] + (size_t)l * DM * DM, DM, DM, DM, 0, ws + WS_LW + l * LW_STRIDE + LW_XQ);
        TJOB(P.in[I_XA_WKV] + (size_t)l * DM * 2 * DM, DM, 2 * DM, 2 * DM, 0, ws + WS_LW + l * LW_STRIDE + LW_XKV);
        TJOB(P.in[I_XA_WO] + (size_t)l * DM * DM, DM, DM, DM, 0, ws + WS_LW + l * LW_STRIDE + LW_XO);
    }
#undef TJOB
    {
        f32x2* tab = (f32x2*)(ws + WS_ROPE);
        for (int i = C.blk * NTHREADS + C.tid; i < ROPE_POS * 32; i += C.G * NTHREADS) {
            const int p = i >> 5, f = i & 31;
            const float inv = powf(10000.0f, -(float)f * (2.0f / 64.0f));
            const float ang = (float)p * inv;
            tab[i] = (f32x2){(float)cos((double)ang), (float)sin((double)ang)};
        }
    }
    cvt_bf16(C, P.in[I_PEER_WQ], (bf16_t*)(ws + P_WQB), (size_t)2 * DM * DM / 8);
    {
        bf16_t* sk = (bf16_t*)(ws + P_SK); const float* skin = P.in[I_PEER_SK];
        for (int i = C.blk * NTHREADS + C.tid; i < 2 * 8 * 256 * 256 / 8; i += C.G * NTHREADS) {
            const int q8 = (i & 31) * 8, np = (i >> 5) & 255, lh = i >> 13;
            const int c = np >> 7, n = np & 127, c2 = q8 >> 7, q = q8 & 127;
            u32x4 w = {0u, 0u, 0u, 0u};
            if (c == c2) { const float* s = skin + ((((size_t)lh * 2 + c) * 128 + n) * 128 + q);
                const f32x4 a = *(const f32x4*)s, b = *(const f32x4*)(s + 4);
                w.x = pk2(a[0], a[1]); w.y = pk2(a[2], a[3]); w.z = pk2(b[0], b[1]); w.w = pk2(b[2], b[3]); }
            *(u32x4*)(sk + (size_t)i * 8) = w;
        }
    }
    cvt_bf16(C, P.in[I_PEER_U], (bf16_t*)(ws + P_UT), (size_t)PEER_NE * DM / 8);
    cvt_bf16(C, P.in[I_PEER_V], (bf16_t*)(ws + P_VT), (size_t)PEER_NE * DM / 8);
    for (int l = 0; l < 2; ++l) rms_rows_2048(C, P.in[I_MEM], P.in[I_XA_MEMNORM] + l * DM, (bf16_t*)(ws + P_MEMN) + (size_t)l * MT * DM, MT);
}

DI void phase_s5(const Ctx& C, const Params& P) {
    unsigned char* ws = P.ws;
    const bf16_t* proj = (const bf16_t*)(ws + P_PROJ); bf16_t* gbuf = (bf16_t*)(ws + P_GBUF);
    LAS unsigned char* my = C.lds + C.wave * 8192;
    LAS float* U = (LAS float*)my;
    LAS bf16_t* H = (LAS bf16_t*)(my + 1024);
    const int lane = C.lane, n = lane;
    for (int task = C.wave * C.G + C.blk; task < BATCH * 32; task += C.G * NWAVES) {
        const int b = task >> 5, g = task & 31;
        const float a_re = P.in[I_S5_ARE][g * 64 + n], a_im = P.in[I_S5_AIM][g * 64 + n];
        const float step = expf(P.in[I_S5_LOGSTEP][g]);
        const float mag = expf(a_re * step);
        const float ab_re = mag * cosf(a_im * step), ab_im = mag * sinf(a_im * step);
        const float den = a_re * a_re + a_im * a_im, num_re = ab_re - 1.0f;
        const float f_re = (num_re * a_re + ab_im * a_im) / den, f_im = (ab_im * a_re - num_re * a_im) / den;
        float bbr[16], bbi[16];
        {
            const float* br = P.in[I_S5_BRE] + ((size_t)g * 64 + n) * 16; const float* bi = P.in[I_S5_BIM] + ((size_t)g * 64 + n) * 16;
#pragma unroll
            for (int p = 0; p < 16; ++p) { const float x = br[p], y = bi[p]; bbr[p] = f_re * x - f_im * y; bbi[p] = f_re * y + f_im * x; }
        }
        bf16x8 cf[4];
        {
            const int p = lane & 15, kq = lane >> 4;
#pragma unroll
            for (int kk = 0; kk < 4; ++kk) {
                const int k = 32 * kk + 8 * kq; const bool im = k >= 64;
                const float* src = (im ? P.in[I_S5_CIM] : P.in[I_S5_CRE]) + ((size_t)g * 16 + p) * 64 + (k & 63);
                const float sg = im ? -1.f : 1.f;
                const f32x4 a = *(const f32x4*)src, bq = *(const f32x4*)(src + 4);
                u32x4 w; w.x = pk2(sg * a[0], sg * a[1]); w.y = pk2(sg * a[2], sg * a[3]); w.z = pk2(sg * bq[0], sg * bq[1]); w.w = pk2(sg * bq[2], sg * bq[3]);
                cf[kk] = __builtin_bit_cast(bf16x8, w);
            }
        }
        const float dcoef = P.in[I_S5_D][g * 16 + (lane & 15)];
        float h_re = 0.f, h_im = 0.f;
        const bf16_t* ub = proj + (size_t)b * SEQ * AB_IN + 3 * DIFF_W + g * 16;
        for (int s0 = 0; s0 < SEQ; s0 += 16) {
            {
                const int st = lane >> 2, pp = (lane & 3) * 4;
                const u32x2 uv = *(const u32x2*)(ub + (size_t)(s0 + st) * AB_IN + pp);
                *(LAS f32x4*)(U + st * 16 + pp) = (f32x4){bflo(uv.x), bfhi(uv.x), bflo(uv.y), bfhi(uv.y)};
            }
            LDS_WAIT(); asm volatile("" ::: "memory");
#pragma unroll 4
            for (int st = 0; st < 16; ++st) {
                const f32x4 u0 = *(const LAS f32x4*)(U + st * 16), u1 = *(const LAS f32x4*)(U + st * 16 + 4), u2 = *(const LAS f32x4*)(U + st * 16 + 8), u3 = *(const LAS f32x4*)(U + st * 16 + 12);
                const float uu[16] = {u0[0], u0[1], u0[2], u0[3], u1[0], u1[1], u1[2], u1[3], u2[0], u2[1], u2[2], u2[3], u3[0], u3[1], u3[2], u3[3]};
                float br = 0.f, bi = 0.f;
#pragma unroll
                for (int p = 0; p < 16; ++p) { br = fmaf(bbr[p], uu[p], br); bi = fmaf(bbi[p], uu[p], bi); }
                const float nr = ab_re * h_re - ab_im * h_im + br, ni = ab_re * h_im + ab_im * h_re + bi;
                h_re = nr; h_im = ni;
                H[st * 136 + n] = f2bf(h_re); H[st * 136 + 64 + n] = f2bf(h_im);
            }
            LDS_WAIT(); asm volatile("" ::: "memory");
            f32x4 acc = {0.f, 0.f, 0.f, 0.f};
#pragma unroll
            for (int kk = 0; kk < 4; ++kk) {
                const bf16x8 af = *(const LAS bf16x8*)((LAS unsigned char*)H + (lane & 15) * 272 + (32 * kk + 8 * (lane >> 4)) * 2);
                acc = __builtin_amdgcn_mfma_f32_16x16x32_bf16(af, cf[kk], acc, 0, 0, 0);
            }
#pragma unroll
            for (int r = 0; r < 4; ++r) {
                const int st = (lane >> 4) * 4 + r, p = lane & 15;
                const float y = acc[r] + dcoef * U[st * 16 + p];
                gbuf[(size_t)(b * SEQ + s0 + st) * S5_W + g * 16 + p] = f2bf(gelu_erf(y));
            }
            LDS_WAIT(); asm volatile("" ::: "memory");
        }
    }
}

struct AttnArgs { const bf16_t* Qn; const bf16_t* Qr; const bf16_t* Kn; const bf16_t* Kr; const bf16_t* V; int ldq, ldkn, ldkr, ldv; };
DI int crow(int r, int hi) { return (r & 3) + 8 * (r >> 2) + 4 * hi; }
template <int DK> DI int koff(int row, int ch) { return DK == 64 ? row * 128 + 16 * (ch ^ ((row >> 1) & 7)) : row * 256 + 16 * (ch ^ (row & 15)); }
DI int voff(int row, int ch) { return 256 * row + 16 * (ch ^ (((row & 3) << 2) | ((row >> 2) & 3))); }
DI bf16x8 pack8(const f32x16& p, int s) {
    u32x4 w; w.x = pk2(p[8 * s + 0], p[8 * s + 1]); w.y = pk2(p[8 * s + 2], p[8 * s + 3]); w.z = pk2(p[8 * s + 4], p[8 * s + 5]); w.w = pk2(p[8 * s + 6], p[8 * s + 7]);
    return __builtin_bit_cast(bf16x8, w);
}
DI s16x4 vtr(const LAS unsigned char* p) { return __builtin_bit_cast(s16x4, __builtin_amdgcn_ds_read_tr16_b64_v4i16((LAS s16x4*)p)); }

template <int DKN, int DKR>
DI void attn_core(const AttnArgs& a, int q0, LAS unsigned char* lds, float scale, f32x16 (&o)[4]) {
    const int tid = threadIdx.x, wid = __builtin_amdgcn_readfirstlane(tid >> 6), lane = tid & 63, r32 = lane & 31, hi = lane >> 5;
    constexpr int CN = DKN / 8, NLK = CN * 64 / NTHREADS, KNB = 64 * DKN * 2, KRB = 64 * DKR * 2, VOFF = KNB + KRB, BUF = VOFF + 16384;
    static_assert(2 * BUF <= RING_BYTES, "attention LDS");
    bf16x8 qn[DKN / 16]; bf16x8 qr[DKR ? DKR / 16 : 1];
    {
        const bf16_t* qp = a.Qn + (size_t)(q0 + 32 * wid + r32) * a.ldq + hi * 8;
#pragma unroll
        for (int d0 = 0; d0 < DKN / 16; ++d0) qn[d0] = *(const bf16x8*)(qp + d0 * 16);
        if (DKR) { const bf16_t* qp2 = a.Qr + (size_t)(q0 + 32 * wid + r32) * a.ldq + hi * 8;
#pragma unroll
            for (int d0 = 0; d0 < DKR / 16; ++d0) qr[d0] = *(const bf16x8*)(qp2 + d0 * 16); }
    }
    const int NT = (q0 + 256) / 64, NTw = (q0 + 32 * wid + 31) / 64 + 1;
    u32x4 skn[NLK], skr, sv[2];
#define AT_LOAD(t) do { _Pragma("unroll") for (int i_ = 0; i_ < NLK; ++i_) { const int id_ = tid + NTHREADS * i_, row_ = id_ / CN, ch_ = id_ % CN; \
            skn[i_] = *(const u32x4*)(a.Kn + (size_t)((t) * 64 + row_) * a.ldkn + ch_ * 8); } \
        if (DKR) { const int row_ = tid >> 3, ch_ = tid & 7; skr = *(const u32x4*)(a.Kr + (size_t)((t) * 64 + row_) * a.ldkr + ch_ * 8); } \
        _Pragma("unroll") for (int i_ = 0; i_ < 2; ++i_) { const int id_ = tid + NTHREADS * i_, row_ = id_ >> 4, ch_ = id_ & 15; \
            sv[i_] = *(const u32x4*)(a.V + (size_t)((t) * 64 + row_) * a.ldv + ch_ * 8); } } while (0)
#define AT_WRITE(bf) do { LAS unsigned char* bb_ = lds + (bf) * BUF; \
        _Pragma("unroll") for (int i_ = 0; i_ < NLK; ++i_) { const int id_ = tid + NTHREADS * i_, row_ = id_ / CN, ch_ = id_ % CN; *(LAS u32x4*)(bb_ + koff<DKN>(row_, ch_)) = skn[i_]; } \
        if (DKR) { const int row_ = tid >> 3, ch_ = tid & 7; *(LAS u32x4*)(bb_ + KNB + koff<64>(row_, ch_)) = skr; } \
        _Pragma("unroll") for (int i_ = 0; i_ < 2; ++i_) { const int id_ = tid + NTHREADS * i_, row_ = id_ >> 4, ch_ = id_ & 15; *(LAS u32x4*)(bb_ + VOFF + voff(row_, ch_)) = sv[i_]; } } while (0)
    const float Cs = scale * 1.4426950408889634f;
    float m_run = -1e30f, l_run = 0.f;
#pragma unroll
    for (int blk = 0; blk < 4; ++blk)
#pragma unroll
        for (int r = 0; r < 16; ++r) o[blk][r] = 0.f;
    AT_LOAD(0); AT_WRITE(0); if (NT > 1) AT_LOAD(1);
    for (int t = 0; t < NT; ++t) {
        __syncthreads();
        if (t + 1 < NT) AT_WRITE((t + 1) & 1);
        if (t + 2 < NT) AT_LOAD(t + 2);
        if (t < NTw) {
            const LAS unsigned char* base = lds + (t & 1) * BUF;
            int r32v = r32, lanev = lane; asm volatile("" : "+v"(r32v), "+v"(lanev));
            int vb[4][2];
            {
                const int i = lanev & 15, q_ = i >> 2, p_ = i & 3, grp1 = (lanev >> 4) & 1, hv = lanev >> 5, low2 = 2 * grp1 + (p_ >> 1);
#pragma unroll
                for (int blk = 0; blk < 4; ++blk)
#pragma unroll
                    for (int x = 0; x < 2; ++x) vb[blk][x] = VOFF + 256 * (8 * x + 4 * hv + q_) + 16 * (4 * (blk ^ q_) + (low2 ^ (hv + 2 * x))) + 8 * (p_ & 1);
            }
            f32x16 p0, p1;
#pragma unroll
            for (int r = 0; r < 16; ++r) { p0[r] = 0.f; p1[r] = 0.f; }
#pragma unroll
            for (int d0 = 0; d0 < DKN / 16; ++d0) {
                const bf16x8 b0 = *(const LAS bf16x8*)(base + koff<DKN>(r32v, 2 * d0 + hi)), b1 = *(const LAS bf16x8*)(base + koff<DKN>(32 + r32v, 2 * d0 + hi));
                p0 = __builtin_amdgcn_mfma_f32_32x32x16_bf16(b0, qn[d0], p0, 0, 0, 0); p1 = __builtin_amdgcn_mfma_f32_32x32x16_bf16(b1, qn[d0], p1, 0, 0, 0);
            }
            if (DKR) {
#pragma unroll
                for (int d0 = 0; d0 < DKR / 16; ++d0) {
                    const bf16x8 b0 = *(const LAS bf16x8*)(base + KNB + koff<64>(r32v, 2 * d0 + hi)), b1 = *(const LAS bf16x8*)(base + KNB + koff<64>(32 + r32v, 2 * d0 + hi));
                    p0 = __builtin_amdgcn_mfma_f32_32x32x16_bf16(b0, qr[d0], p0, 0, 0, 0); p1 = __builtin_amdgcn_mfma_f32_32x32x16_bf16(b1, qr[d0], p1, 0, 0, 0);
                }
            }
            if (t == NTw - 1) {
                const int qrel = q0 + 32 * wid + r32 - 64 * t;
#pragma unroll
                for (int r = 0; r < 16; ++r) { const int kv = crow(r, hi); if (kv > qrel) p0[r] = -INFINITY; if (kv + 32 > qrel) p1[r] = -INFINITY; }
            }
            float pmax = p0[0];
#pragma unroll
            for (int r = 1; r < 16; ++r) pmax = fmaxf(pmax, p0[r]);
#pragma unroll
            for (int r = 0; r < 16; ++r) pmax = fmaxf(pmax, p1[r]);
            pmax = swap32_max(pmax);
            const float mn = fmaxf(m_run, pmax);
            const float alpha = __builtin_amdgcn_exp2f((m_run - mn) * Cs);
            m_run = mn;
            const float mnC = -mn * Cs;
            float ps = 0.f;
#pragma unroll
            for (int r = 0; r < 16; ++r) { p0[r] = __builtin_amdgcn_exp2f(fmaf(p0[r], Cs, mnC)); p1[r] = __builtin_amdgcn_exp2f(fmaf(p1[r], Cs, mnC)); ps += p0[r] + p1[r]; }
            l_run = l_run * alpha + ps;
            if (!__all(alpha == 1.0f)) {
#pragma unroll
                for (int blk = 0; blk < 4; ++blk)
#pragma unroll
                    for (int r = 0; r < 16; ++r) o[blk][r] *= alpha;
            }
            bf16x8 pb[4]; pb[0] = pack8(p0, 0); pb[1] = pack8(p0, 1); pb[2] = pack8(p1, 0); pb[3] = pack8(p1, 1);
#pragma unroll
            for (int blk = 0; blk < 4; ++blk) {
                s16x4 lo[4], hh[4];
#pragma unroll
                for (int ks = 0; ks < 4; ++ks) { lo[ks] = vtr(base + vb[blk][0] + 4096 * ks); hh[ks] = vtr(base + vb[blk][1] + 4096 * ks); }
#pragma unroll
                for (int ks = 0; ks < 4; ++ks) {
                    const bf16x8 af = {lo[ks][0], lo[ks][1], lo[ks][2], lo[ks][3], hh[ks][0], hh[ks][1], hh[ks][2], hh[ks][3]};
                    o[blk] = __builtin_amdgcn_mfma_f32_32x32x16_bf16(af, pb[ks], o[blk], 0, 0, 0);
                }
                __builtin_amdgcn_sched_barrier(0);
            }
        }
    }
    __syncthreads();
    const float linv = 1.0f / swap32_sum(l_run);
#pragma unroll
    for (int blk = 0; blk < 4; ++blk)
#pragma unroll
        for (int r = 0; r < 16; ++r) o[blk][r] *= linv;
#undef AT_LOAD
#undef AT_WRITE
}
DI void attn_store(const f32x16 (&o)[4], bf16_t* dst, int ld, int q0) {
    const int tid = threadIdx.x, wid = tid >> 6, lane = tid & 63, r32 = lane & 31, hi = lane >> 5;
    bf16_t* rp = dst + (size_t)(q0 + 32 * wid + r32) * ld;
#pragma unroll
    for (int blk = 0; blk < 4; ++blk)
#pragma unroll
        for (int g = 0; g < 4; ++g) {
            u32x2 w; w.x = pk2(o[blk][4 * g], o[blk][4 * g + 1]); w.y = pk2(o[blk][4 * g + 2], o[blk][4 * g + 3]);
            *(u32x2*)(rp + 32 * blk + 8 * g + 4 * hi) = w;
        }
}
DI int queue_pop(const Ctx& C, unsigned* ctr, int total) {
    volatile LAS int* slot = (volatile LAS int*)(C.lds + LDSCTL_OFF + 64);
    __syncthreads();
    if (C.tid == 0) *slot = (int)__hip_atomic_fetch_add(ctr, 1u, __ATOMIC_RELAXED, __HIP_MEMORY_SCOPE_AGENT);
    __syncthreads();
    const int u = *slot;
    return u < total ? u : -1;
}
DI float diff_lambda(const Params& P) {
    float s1 = 0.f, s2 = 0.f;
    for (int i = 0; i < 64; ++i) { s1 += P.in[I_LQ1][i] * P.in[I_LK1][i]; s2 += P.in[I_LQ2][i] * P.in[I_LK2][i]; }
    return expf(s1) - expf(s2) + 0.2f;
}

#if FAST_ATTN
DI void phase_diff_attn(const Ctx& C, const Params& P) {
    unsigned char* ws = P.ws;
    const bf16_t* proj = (const bf16_t*)(ws + P_PROJ); bf16_t* concat = (bf16_t*)(ws + P_CONCAT);
    unsigned* ctr = (unsigned*)(ws + WS_CTL) + CW_CTR;
    const float lam = diff_lambda(P);
    const int NBH = BATCH * DIFF_HEADS, total = NBH * 8;
    const int lane = C.lane, r32 = lane & 31, hi = lane >> 5;
    for (;;) {
        const int u = queue_pop(C, ctr, total); if (u < 0) break;
        const int qb = 7 - u / NBH, bh = u % NBH, b = bh / DIFF_HEADS, h = bh % DIFF_HEADS;
        const bf16_t* base = proj + (size_t)b * SEQ * AB_IN;
        AttnArgs a; a.ldq = AB_IN; a.ldkn = AB_IN; a.ldkr = 0; a.ldv = AB_IN; a.Qr = nullptr; a.Kr = nullptr;
        a.V = base + 2 * DIFF_W + h * 128;
        f32x16 o2[4];
        bf16_t* dst = concat + (size_t)b * SEQ * DM + h * 128;
        a.Qn = base + h * 128; a.Kn = base + DIFF_W + h * 128;
        attn_core<64, 0>(a, qb * 256, C.lds, 0.125f, o2);
        attn_store(o2, dst, DM, qb * 256);
        a.Qn = base + h * 128 + 64; a.Kn = base + DIFF_W + h * 128 + 64;
        attn_core<64, 0>(a, qb * 256, C.lds, 0.125f, o2);
        float ss = 0.f;
        {
            const bf16_t* rp = dst + (size_t)(qb * 256 + 32 * C.wave + r32) * DM;
#pragma unroll
            for (int blk = 0; blk < 4; ++blk)
#pragma unroll
                for (int g = 0; g < 4; ++g) {
                    const u32x2 w = *(const u32x2*)(rp + 32 * blk + 8 * g + 4 * hi);
                    const float o1v[4] = {bflo(w.x), bfhi(w.x), bflo(w.y), bfhi(w.y)};
#pragma unroll
                    for (int j = 0; j < 4; ++j) { const float v = o1v[j] - lam * o2[blk][4 * g + j]; o2[blk][4 * g + j] = v; ss += v * v; }
                }
        }
        ss = swap32_sum(ss);
        const float rs = rsqrtf(ss * (1.0f / 128.0f) + NORM_EPS) * 0.8f;
        const float* sub = P.in[I_SUBLN];
#pragma unroll
        for (int blk = 0; blk < 4; ++blk)
#pragma unroll
            for (int r = 0; r < 16; ++r) o2[blk][r] *= rs * sub[32 * blk + crow(r, hi)];
        attn_store(o2, dst, DM, qb * 256);
    }
}
DI void phase_mla_attn(const Ctx& C, const Params& P) {
    unsigned char* ws = P.ws;
    const bf16_t* q = (const bf16_t*)(ws + P_Q); const bf16_t* kv = (const bf16_t*)(ws + P_KV); const bf16_t* kr = (const bf16_t*)(ws + P_KROPE);
    bf16_t* ob = (bf16_t*)(ws + P_H);
    unsigned* ctr = (unsigned*)(ws + WS_CTL) + CW_CTR + 64;
    const int NBH = BATCH * MLA_HEADS, total = NBH * 8;
    for (;;) {
        const int u = queue_pop(C, ctr, total); if (u < 0) break;
        const int qb = 7 - u / NBH, bh = u % NBH, b = bh / MLA_HEADS, h = bh % MLA_HEADS;
        AttnArgs a; a.ldq = 3072; a.ldkn = 4096; a.ldkr = 64; a.ldv = 4096;
        a.Qn = q + (size_t)b * SEQ * 3072 + h * 192; a.Qr = a.Qn + 128;
        a.Kn = kv + (size_t)b * SEQ * 4096 + h * 256; a.V = a.Kn + 128; a.Kr = kr + (size_t)b * SEQ * 64;
        f32x16 o[4];
        attn_core<128, 64>(a, qb * 256, C.lds, 0.07216878364870322f, o);
        attn_store(o, ob + (size_t)b * SEQ * DM + h * 128, DM, qb * 256);
    }
}
#else
template <int DK> DI void naive_attn_row(const bf16_t* qrow, const bf16_t* qrow2, const bf16_t* Kn, int ldkn, const bf16_t* Kr, int ldkr, const bf16_t* V, int ldv, int nkeys, float scale, int lane, float& o0, float& o1) {
    float qv[3];
#pragma unroll
    for (int j = 0; j < 3; ++j) { const int d = lane + 64 * j; qv[j] = 0.f; if (d < DK) qv[j] = (DK == 192 && d >= 128) ? bf2f(qrow2[d - 128]) : bf2f(qrow[d]); }
    float m = -1e30f, l = 0.f; o0 = 0.f; o1 = 0.f;
    for (int k = 0; k < nkeys; ++k) {
        float s = 0.f;
#pragma unroll
        for (int j = 0; j < 3; ++j) { const int d = lane + 64 * j; if (d < DK) { const float kvv = (DK == 192 && d >= 128) ? bf2f(Kr[(size_t)k * ldkr + d - 128]) : bf2f(Kn[(size_t)k * ldkn + d]); s += qv[j] * kvv; } }
        s = wave_sum(s) * scale;
        const float mn = fmaxf(m, s), al = expf(m - mn), p = expf(s - mn);
        m = mn; l = l * al + p;
        o0 = o0 * al + p * bf2f(V[(size_t)k * ldv + lane]); o1 = o1 * al + p * bf2f(V[(size_t)k * ldv + 64 + lane]);
    }
    o0 /= l; o1 /= l;
}
DI void phase_diff_attn(const Ctx& C, const Params& P) {
    unsigned char* ws = P.ws;
    const bf16_t* proj = (const bf16_t*)(ws + P_PROJ); bf16_t* concat = (bf16_t*)(ws + P_CONCAT);
    const float lam = diff_lambda(P);
    const int lane = C.lane;
    for (int it = C.blk * NWAVES + C.wave; it < BATCH * DIFF_HEADS * SEQ; it += C.G * NWAVES) {
        const int s = it % SEQ, bh = it / SEQ, b = bh / DIFF_HEADS, h = bh % DIFF_HEADS;
        const bf16_t* base = proj + (size_t)b * SEQ * AB_IN;
        const bf16_t* qrow = base + (size_t)s * AB_IN + h * 128;
        float a0, a1, b0, b1;
        naive_attn_row<64>(qrow, nullptr, base + DIFF_W + h * 128, AB_IN, nullptr, 0, base + 2 * DIFF_W + h * 128, AB_IN, s + 1, 0.125f, lane, a0, a1);
        naive_attn_row<64>(qrow + 64, nullptr, base + DIFF_W + h * 128 + 64, AB_IN, nullptr, 0, base + 2 * DIFF_W + h * 128, AB_IN, s + 1, 0.125f, lane, b0, b1);
        const float v0 = a0 - lam * b0, v1 = a1 - lam * b1;
        const float ss = wave_sum(v0 * v0 + v1 * v1);
        const float rs = rsqrtf(ss * (1.0f / 128.0f) + NORM_EPS) * 0.8f;
        bf16_t* orow = concat + (size_t)(b * SEQ + s) * DM + h * 128;
        orow[lane] = f2bf(v0 * rs * P.in[I_SUBLN][lane]); orow[64 + lane] = f2bf(v1 * rs * P.in[I_SUBLN][64 + lane]);
    }
}
DI void phase_mla_attn(const Ctx& C, const Params& P) {
    unsigned char* ws = P.ws;
    const bf16_t* q = (const bf16_t*)(ws + P_Q); const bf16_t* kv = (const bf16_t*)(ws + P_KV); const bf16_t* kr = (const bf16_t*)(ws + P_KROPE);
    bf16_t* ob = (bf16_t*)(ws + P_H);
    const int lane = C.lane;
    for (int it = C.blk * NWAVES + C.wave; it < BATCH * MLA_HEADS * SEQ; it += C.G * NWAVES) {
        const int s = it % SEQ, bh = it / SEQ, b = bh / MLA_HEADS, h = bh % MLA_HEADS;
        const bf16_t* qrow = q + (size_t)(b * SEQ + s) * 3072 + h * 192;
        const bf16_t* kn = kv + (size_t)b * SEQ * 4096 + h * 256;
        float a0, a1;
        naive_attn_row<192>(qrow, qrow + 128, kn, 4096, kr + (size_t)b * SEQ * 64, 64, kn + 128, 4096, s + 1, 0.07216878364870322f, lane, a0, a1);
        bf16_t* orow = ob + (size_t)(b * SEQ + s) * DM + h * 128;
        orow[lane] = f2bf(a0); orow[64 + lane] = f2bf(a1);
    }
}
#endif

DI void phase_mla_rows(const Ctx& C, const Params& P) {
    unsigned char* ws = P.ws;
    const bf16_t* mp = (const bf16_t*)(ws + P_MLAPROJ); bf16_t* cqn = (bf16_t*)(ws + P_CQN); bf16_t* ckvn = (bf16_t*)(ws + P_CKVN); bf16_t* krp = (bf16_t*)(ws + P_KROPE);
    const f32x2* tab = (const f32x2*)(ws + WS_ROPE);
    const int lane = C.lane;
    for (int r = C.blk * NWAVES + C.wave; r < T; r += C.G * NWAVES) {
        const bf16_t* row = mp + (size_t)r * MLA_IN_PAD;
        float v[12]; float ss = 0.f;
#pragma unroll
        for (int j = 0; j < 3; ++j) { const u32x2 w = *(const u32x2*)(row + 4 * (lane + 64 * j)); v[4 * j] = bflo(w.x); v[4 * j + 1] = bfhi(w.x); v[4 * j + 2] = bflo(w.y); v[4 * j + 3] = bfhi(w.y); }
#pragma unroll
        for (int j = 0; j < 12; ++j) ss += v[j] * v[j];
        float sc = rsqrtf(wave_sum(ss) * (1.0f / MLA_QR) + NORM_EPS);
#pragma unroll
        for (int j = 0; j < 3; ++j) { const f32x4 g = *(const f32x4*)(P.in[I_MLA_QNORM] + 4 * (lane + 64 * j));
            u32x2 w; w.x = pk2(v[4 * j] * sc * g[0], v[4 * j + 1] * sc * g[1]); w.y = pk2(v[4 * j + 2] * sc * g[2], v[4 * j + 3] * sc * g[3]);
            *(u32x2*)(cqn + (size_t)r * MLA_QR + 4 * (lane + 64 * j)) = w; }
        {
            const u32x2 w = *(const u32x2*)(row + MLA_QR + 4 * lane);
            const float a0 = bflo(w.x), a1 = bfhi(w.x), a2 = bflo(w.y), a3 = bfhi(w.y);
            const float s2 = rsqrtf(wave_sum(a0 * a0 + a1 * a1 + a2 * a2 + a3 * a3) * (1.0f / MLA_KVR) + NORM_EPS);
            const f32x4 g = *(const f32x4*)(P.in[I_MLA_KVNORM] + 4 * lane);
            u32x2 o; o.x = pk2(a0 * s2 * g[0], a1 * s2 * g[1]); o.y = pk2(a2 * s2 * g[2], a3 * s2 * g[3]);
            *(u32x2*)(ckvn + (size_t)r * MLA_KVR + 4 * lane) = o;
        }
        if (lane < 32) {
            const unsigned w = *(const unsigned*)(row + 1024 + 2 * lane);
            int p = ((const int*)P.in[I_POS])[r]; p = p < 0 ? 0 : (p > ROPE_POS - 1 ? ROPE_POS - 1 : p);
            const f32x2 cs = tab[(size_t)p * 32 + lane];
            const float x1 = bflo(w), x2 = bfhi(w);
            *(unsigned*)(krp + (size_t)r * 64 + 2 * lane) = pk2(x1 * cs[0] - x2 * cs[1], x2 * cs[0] + x1 * cs[1]);
        }
    }
}

DI void phase_xa_softmax(const Ctx& C, const Params& P) {
    unsigned char* ws = P.ws;
    const float* S = (const float*)(ws + P_S); bf16_t* Pb = (bf16_t*)(ws + P_P);
    const int lane = C.lane, hd = lane >> 4, li = lane & 15;
    for (int r = C.blk * NWAVES + C.wave; r < T; r += C.G * NWAVES) {
        const float* row = S + (size_t)r * 1024 + hd * 256;
        f32x4 v[4]; float mx = -1e30f;
#pragma unroll
        for (int j = 0; j < 4; ++j) { v[j] = *(const f32x4*)(row + 4 * (li + 16 * j)); mx = fmaxf(mx, fmaxf(fmaxf(v[j][0], v[j][1]), fmaxf(v[j][2], v[j][3]))); }
#pragma unroll
        for (int o = 1; o < 16; o <<= 1) mx = fmaxf(mx, __shfl_xor(mx, o));
        float sm = 0.f;
#pragma unroll
        for (int j = 0; j < 4; ++j) { v[j][0] = __expf(v[j][0] - mx); v[j][1] = __expf(v[j][1] - mx); v[j][2] = __expf(v[j][2] - mx); v[j][3] = __expf(v[j][3] - mx); sm += (v[j][0] + v[j][1]) + (v[j][2] + v[j][3]); }
#pragma unroll
        for (int o = 1; o < 16; o <<= 1) sm += __shfl_xor(sm, o);
        const float inv = 1.0f / sm;
        bf16_t* orow = Pb + (size_t)r * 1024 + hd * 256;
#pragma unroll
        for (int j = 0; j < 4; ++j) { u32x2 w; w.x = pk2(v[j][0] * inv, v[j][1] * inv); w.y = pk2(v[j][2] * inv, v[j][3] * inv); *(u32x2*)(orow + 4 * (li + 16 * j)) = w; }
    }
}

DI void phase_peer(const Ctx& C, const Params& P) {
    unsigned char* ws = P.ws;
    const float* sc = (const float*)(ws + P_SC); const bf16_t* hb = (const bf16_t*)(ws + P_H);
    const bf16_t* ut = (const bf16_t*)(ws + P_UT); const bf16_t* vt = (const bf16_t*)(ws + P_VT);
    float* xo = P.out;
    LAS unsigned char* my = C.lds + C.wave * 4096;
    LAS float* top_s = (LAS float*)my;
    LAS int* top_i = (LAS int*)(my + 1024);
    LAS int* best_e = (LAS int*)(my + 2048);
    LAS float* best_g = (LAS float*)(my + 2560);
    LAS float* best_s = (LAS float*)(my + 3072);
    LAS int* best_p = (LAS int*)(my + 3584);
    const int lane = C.lane;
    for (int tok = C.blk * NWAVES + C.wave; tok < T; tok += C.G * NWAVES) {
        {
            const int g = lane >> 2, qd = lane & 3;
            float v[32];
            const f32x4* sp = (const f32x4*)(sc + (size_t)tok * 2048 + g * 128 + qd * 32);
#pragma unroll
            for (int j = 0; j < 8; ++j) { const f32x4 x = sp[j]; v[4 * j] = x[0]; v[4 * j + 1] = x[1]; v[4 * j + 2] = x[2]; v[4 * j + 3] = x[3]; }
            for (int r = 0; r < 16; ++r) {
                float bv = v[0]; int bj = 0;
#pragma unroll
                for (int j = 1; j < 32; ++j) { const bool gt = v[j] > bv; bv = gt ? v[j] : bv; bj = gt ? j : bj; }
                int bn = qd * 32 + bj;
#pragma unroll
                for (int off = 1; off <= 2; off <<= 1) { const float ov = __shfl_xor(bv, off); const int on = __shfl_xor(bn, off); const bool tk = (ov > bv) || (ov == bv && on < bn); bv = tk ? ov : bv; bn = tk ? on : bn; }
                if (qd == 0) { top_s[g * 16 + r] = bv; top_i[g * 16 + r] = bn; }
                const int rem = ((bn >> 5) == qd) ? (bn & 31) : -1;
#pragma unroll
                for (int j = 0; j < 32; ++j) v[j] = (j == rem) ? -INFINITY : v[j];
            }
        }
        LDS_WAIT(); asm volatile("" ::: "memory");
        {
            const int h = lane >> 3, sub = lane & 7;
            float v[32];
            const float s00 = top_s[(2 * h) * 16 + 2 * sub], s01 = top_s[(2 * h) * 16 + 2 * sub + 1];
#pragma unroll
            for (int k2 = 0; k2 < 16; ++k2) { const float s1 = top_s[(2 * h + 1) * 16 + k2]; v[k2] = s00 + s1; v[16 + k2] = s01 + s1; }
            for (int r = 0; r < 16; ++r) {
                float bv = v[0]; int bj = 0;
#pragma unroll
                for (int j = 1; j < 32; ++j) { const bool gt = v[j] > bv; bv = gt ? v[j] : bv; bj = gt ? j : bj; }
                int bn = sub * 32 + bj;
#pragma unroll
                for (int off = 1; off <= 4; off <<= 1) { const float ov = __shfl_xor(bv, off); const int on = __shfl_xor(bn, off); const bool tk = (ov > bv) || (ov == bv && on < bn); bv = tk ? ov : bv; bn = tk ? on : bn; }
                if (sub == 0) { best_s[h * 16 + r] = bv; best_p[h * 16 + r] = bn; }
                const int rem = ((bn >> 5) == sub) ? (bn & 31) : -1;
#pragma unroll
                for (int j = 0; j < 32; ++j) v[j] = (j == rem) ? -INFINITY : v[j];
            }
        }
        LDS_WAIT(); asm volatile("" ::: "memory");
#pragma unroll
        for (int e2 = 0; e2 < 2; ++e2) {
            const int idx = lane + 64 * e2, h = idx >> 4;
            float mx = -1e30f;
            for (int k = 0; k < 16; ++k) mx = fmaxf(mx, best_s[h * 16 + k]);
            float sm = 0.f;
            for (int k = 0; k < 16; ++k) sm += __expf(best_s[h * 16 + k] - mx);
            const float gate = __expf(best_s[idx] - mx) / sm;
            const int pos = best_p[idx], k1 = pos >> 4, k2 = pos & 15;
            best_e[idx] = top_i[(2 * h) * 16 + k1] * 128 + top_i[(2 * h + 1) * 16 + k2];
            best_g[idx] = gate;
        }
        LDS_WAIT(); asm volatile("" ::: "memory");
        u32x4 tv[4];
#pragma unroll
        for (int i = 0; i < 4; ++i) tv[i] = *(const u32x4*)(hb + (size_t)tok * DM + 8 * (lane + 64 * i));
        for (int k0 = 0; k0 < 128; k0 += 4) {
            u32x4 rw[4][4];
#pragma unroll
            for (int kk = 0; kk < 4; ++kk) { const int e = __builtin_amdgcn_readfirstlane(best_e[k0 + kk]); const bf16_t* rp = ut + (size_t)e * DM;
#pragma unroll
                for (int i = 0; i < 4; ++i) rw[kk][i] = *(const u32x4*)(rp + 8 * (lane + 64 * i)); }
            float d[4];
#pragma unroll
            for (int kk = 0; kk < 4; ++kk) { float s = 0.f;
#pragma unroll
                for (int i = 0; i < 4; ++i) { s = dot2bf(rw[kk][i].x, tv[i].x, s); s = dot2bf(rw[kk][i].y, tv[i].y, s); s = dot2bf(rw[kk][i].z, tv[i].z, s); s = dot2bf(rw[kk][i].w, tv[i].w, s); }
                d[kk] = wave_sum(s); }
            if (lane < 4) { const float act = lane == 0 ? d[0] : lane == 1 ? d[1] : lane == 2 ? d[2] : d[3]; best_g[k0 + lane] *= gelu_erf(act); }
        }
        LDS_WAIT(); asm volatile("" ::: "memory");
        float acc[32];
#pragma unroll
        for (int j = 0; j < 32; ++j) acc[j] = 0.f;
        for (int k0 = 0; k0 < 128; k0 += 4) {
            u32x4 rw[4][4]; float wk[4];
#pragma unroll
            for (int kk = 0; kk < 4; ++kk) { const int e = __builtin_amdgcn_readfirstlane(best_e[k0 + kk]); wk[kk] = best_g[k0 + kk]; const bf16_t* rp = vt + (size_t)e * DM;
#pragma unroll
                for (int i = 0; i < 4; ++i) rw[kk][i] = *(const u32x4*)(rp + 8 * (lane + 64 * i)); }
#pragma unroll
            for (int kk = 0; kk < 4; ++kk)
#pragma unroll
                for (int i = 0; i < 4; ++i) {
                    acc[8 * i + 0] = fmaf(wk[kk], bflo(rw[kk][i].x), acc[8 * i + 0]); acc[8 * i + 1] = fmaf(wk[kk], bfhi(rw[kk][i].x), acc[8 * i + 1]);
                    acc[8 * i + 2] = fmaf(wk[kk], bflo(rw[kk][i].y), acc[8 * i + 2]); acc[8 * i + 3] = fmaf(wk[kk], bfhi(rw[kk][i].y), acc[8 * i + 3]);
                    acc[8 * i + 4] = fmaf(wk[kk], bflo(rw[kk][i].z), acc[8 * i + 4]); acc[8 * i + 5] = fmaf(wk[kk], bfhi(rw[kk][i].z), acc[8 * i + 5]);
                    acc[8 * i + 6] = fmaf(wk[kk], bflo(rw[kk][i].w), acc[8 * i + 6]); acc[8 * i + 7] = fmaf(wk[kk], bfhi(rw[kk][i].w), acc[8 * i + 7]);
                }
        }
        float* xr = xo + (size_t)tok * DM;
#pragma unroll
        for (int i = 0; i < 4; ++i) { f32x4* p = (f32x4*)(xr + 8 * (lane + 64 * i));
            f32x4 a = p[0], b = p[1];
            a[0] += acc[8 * i]; a[1] += acc[8 * i + 1]; a[2] += acc[8 * i + 2]; a[3] += acc[8 * i + 3];
            b[0] += acc[8 * i + 4]; b[1] += acc[8 * i + 5]; b[2] += acc[8 * i + 6]; b[3] += acc[8 * i + 7];
            p[0] = a; p[1] = b; }
        LDS_WAIT(); asm volatile("" ::: "memory");
    }
}

constexpr int N_PHASES = 33;
__global__ void __launch_bounds__(NTHREADS, 2) mk_fwd(Params P) {
    extern __shared__ __attribute__((aligned(16))) unsigned char lds_raw[];
    Ctx C; C.lds = (LAS unsigned char*)lds_raw; C.tid = threadIdx.x; C.lane = C.tid & 63; C.wave = __builtin_amdgcn_readfirstlane(C.tid >> 6); C.blk = blockIdx.x; C.G = gridDim.x;
    unsigned char* ws = P.ws;
    for (int u = C.tid; u < (LDS_BYTES - LDSCTL_OFF) / 4; u += NTHREADS) ((LAS unsigned*)(C.lds + LDSCTL_OFF))[u] = 0u;
    __syncthreads();
    XcdBarrier bar; bar.bar = (unsigned*)(ws + WS_CTL) + CW_BAR; bar.x = 0; bar.st = nullptr;
    const bool one = (P.ph_hi - P.ph_lo) > 1;
    if (one) bar = xcd_barrier_post((unsigned*)(ws + WS_CTL) + CW_BAR, (volatile LAS unsigned*)(C.lds + LDSCTL_OFF));
    const int lo = P.ph_lo, hi = P.ph_hi;
#define IN(k) (lo <= (k) && (k) < hi)
#define SEAM(k) do { if (IN(k) && IN((k) + 1)) xcd_barrier(bar); } while (0)
    bf16_t* hbuf = (bf16_t*)(ws + P_H);
    const int* pos = (const int*)P.in[I_POS];
    const f32x2* rtab = (const f32x2*)(ws + WS_ROPE);

    if (IN(0)) { if (EN_PRO) phase_prologue(C, P); } SEAM(0);
    if (IN(1)) {
        {
            g8::Desc g{(const bf16_t*)(ws + P_MEMN), (const bf16_t*)(ws + WS_LW + LW_XKV), DM, DM, DM, MT / 256, DM / 256, 2, 1, (long)MT * DM, 0, (long)(LW_STRIDE / 2), 0};
            EpiBf16 E{(bf16_t*)(ws + WS_KVX), DM, (long)(KVX_STRIDE / 2), 0, 1.0f};
            if (GSITE < 0 || GSITE == 1) g8::gemm(C.lds, g, E, C.G, C.blk);
        }
        {
            g8::Desc g{(const bf16_t*)(ws + WS_LW + LW_XKV) + (size_t)DM * DM, (const bf16_t*)(ws + P_MEMN), DM, DM, DM, DM / 256, MT / 256, 2, 1, (long)(LW_STRIDE / 2), 0, (long)MT * DM, 0};
            EpiBf16 E{(bf16_t*)(ws + WS_KVX + 16 * MiB), MT, (long)(KVX_STRIDE / 2), 0, 1.0f};
            if (GSITE < 0 || GSITE == 2) g8::gemm(C.lds, g, E, C.G, C.blk);
        }
        {
            g8::Desc g{(const bf16_t*)(ws + P_SK), (const bf16_t*)(ws + P_WQB), 256, DM, 256, 1, DM / 256, 2, 8, 8L * 65536, 65536, (long)DM * DM, 256};
            EpiBf16 E{(bf16_t*)(ws + WS_LW + LW_PEER), DM, (long)(LW_STRIDE / 2), 256L * DM, 1.0f};
            if (GSITE < 0 || GSITE == 3) g8::gemm(C.lds, g, E, C.G, C.blk);
        }
    }
    SEAM(1);

    {
        constexpr int l = 0, pb = 2; (void)l;

            if (IN(pb + 0)) rms_rows_2048(C, P.in[I_X], P.in[I_AB_NORM], hbuf, T);
            SEAM(pb + 0);
            if (IN(pb + 1)) {
                g8::Desc g{hbuf, (const bf16_t*)(ws + WS_ABIN_T), DM, DM, DM, T / 256, AB_IN / 256, 1, 1, 0, 0, 0, 0};
                EpiRope<0> E{(bf16_t*)(ws + P_PROJ), AB_IN, pos, rtab};
                if (GSITE < 0 || GSITE == 4) g8::gemm(C.lds, g, E, C.G, C.blk);
            }
            SEAM(pb + 1);
            if (IN(pb + 2)) { if (EN_S5) phase_s5(C, P); }
            SEAM(pb + 2);
            if (IN(pb + 3)) { if (EN_DIFF) phase_diff_attn(C, P); }
            SEAM(pb + 3);
            if (IN(pb + 4)) {
                g8::Desc g{(const bf16_t*)(ws + P_GBUF), (const bf16_t*)(ws + WS_GLU_T), S5_W, S5_W, S5_W, T / 256, S5_W / 256, 1, 1, 0, 0, 0, 0};
                EpiGlu E{(const bf16_t*)(ws + P_GBUF), P.in[I_S5_BGLU], (bf16_t*)(ws + P_CONCAT)};
                if (GSITE < 0 || GSITE == 5) g8::gemm(C.lds, g, E, C.G, C.blk);
            }
            SEAM(pb + 4);
            if (IN(pb + 5)) {
                g8::Desc g{(const bf16_t*)(ws + P_CONCAT), (const bf16_t*)(ws + WS_ABOUT_T), DM, DM, DM, T / 256, DM / 256, 1, 1, 0, 0, 0, 0};
                EpiResid E{P.in[I_X], P.out, DM};
                if (GSITE < 0 || GSITE == 6) g8::gemm(C.lds, g, E, C.G, C.blk);
            }
            SEAM(pb + 5);
    }
    {
        constexpr int l = 0, pb = 2; (void)l;
        const unsigned char* lw = ws + WS_LW + (size_t)l * LW_STRIDE;
        if (IN(pb + 6)) rms_rows_2048(C, P.out, P.in[I_XA_NORM] + l * DM, hbuf, T);
        SEAM(pb + 6);
        if (IN(pb + 7)) {
            g8::Desc g{hbuf, (const bf16_t*)(lw + LW_XQ), DM, DM, DM, T / 256, DM / 256, 1, 1, 0, 0, 0, 0};
            EpiBf16 E{(bf16_t*)(ws + P_QX), DM, 0, 0, 1.0f};
            if (GSITE < 0 || GSITE == 11) g8::gemm(C.lds, g, E, C.G, C.blk);
        }
        SEAM(pb + 7);
        if (IN(pb + 8)) {
            g8::Desc g{(const bf16_t*)(ws + P_QX), (const bf16_t*)(ws + WS_KVX + (size_t)l * KVX_STRIDE), DM, DM, 512, SEQ / 256, 1, BATCH, 4, (long)SEQ * DM, 512, (long)MEM_LEN * DM, 512};
            EpiF32 E{(float*)(ws + P_S), 1024, (long)SEQ * 1024, 256, 0.04419417382415922f};
            if (GSITE < 0 || GSITE == 12) g8::gemm(C.lds, g, E, C.G, C.blk);
        }
        SEAM(pb + 8);
        if (IN(pb + 9)) {
            phase_xa_softmax(C, P);
            if (l == 1) {
                cvt_bf16(C, P.in[I_PEER_U] + (size_t)PEER_NE * DM, (bf16_t*)(ws + P_UT), (size_t)PEER_NE * DM / 8);
                cvt_bf16(C, P.in[I_PEER_V] + (size_t)PEER_NE * DM, (bf16_t*)(ws + P_VT), (size_t)PEER_NE * DM / 8);
            }
        }
        SEAM(pb + 9);
        if (IN(pb + 10)) {
            g8::Desc g{(const bf16_t*)(ws + P_P), (const bf16_t*)(ws + WS_KVX + (size_t)l * KVX_STRIDE + 16 * MiB), 1024, MT, 256, SEQ / 256, 2, BATCH, 4, (long)SEQ * 1024, 256, 256, 512L * MT};
            EpiBf16 E{(bf16_t*)(ws + P_OX), DM, (long)SEQ * DM, 512, 1.0f};
            if (GSITE < 0 || GSITE == 13) g8::gemm(C.lds, g, E, C.G, C.blk);
        }
        SEAM(pb + 10);
        if (IN(pb + 11)) {
            g8::Desc g{(const bf16_t*)(ws + P_OX), (const bf16_t*)(lw + LW_XO), DM, DM, DM, T / 256, DM / 256, 1, 1, 0, 0, 0, 0};
            EpiResid E{P.out, P.out, DM};
            if (GSITE < 0 || GSITE == 14) g8::gemm(C.lds, g, E, C.G, C.blk);
        }
        SEAM(pb + 11);
        if (IN(pb + 12)) rms_rows_2048(C, P.out, P.in[I_FFN_NORM] + l * DM, hbuf, T);
        SEAM(pb + 12);
        if (IN(pb + 13)) {
            g8::Desc g{hbuf, (const bf16_t*)(lw + LW_PEER), DM, DM, DM, T / 256, DM / 256, 1, 1, 0, 0, 0, 0};
            EpiF32 E{(float*)(ws + P_SC), DM, 0, 0, 1.0f};
            if (GSITE < 0 || GSITE == 15) g8::gemm(C.lds, g, E, C.G, C.blk);
        }
        SEAM(pb + 13);
        if (IN(pb + 14)) { if (EN_PEER) phase_peer(C, P); }
        SEAM(pb + 14);
    }
    {
        constexpr int l = 1, pb = 17; (void)l;

            if (IN(pb + 0)) rms_rows_2048(C, P.out, P.in[I_MLA_NORM], hbuf, T);
            SEAM(pb + 0);
            if (IN(pb + 1)) {
                g8::Desc g{hbuf, (const bf16_t*)(ws + WS_MLAIN_T), DM, DM, DM, T / 256, MLA_IN_PAD / 256, 1, 1, 0, 0, 0, 0};
                EpiBf16 E{(bf16_t*)(ws + P_MLAPROJ), MLA_IN_PAD, 0, 0, 1.0f};
                if (GSITE < 0 || GSITE == 7) g8::gemm(C.lds, g, E, C.G, C.blk);
            }
            SEAM(pb + 1);
            if (IN(pb + 2)) phase_mla_rows(C, P);
            SEAM(pb + 2);
            if (IN(pb + 3)) {
                {
                    g8::Desc g{(const bf16_t*)(ws + P_CQN), (const bf16_t*)(ws + WS_UQ_T), MLA_QR, MLA_QR, MLA_QR, T / 256, 3072 / 256, 1, 1, 0, 0, 0, 0};
                    EpiRope<1> E{(bf16_t*)(ws + P_Q), 3072, pos, rtab};
                    if (GSITE < 0 || GSITE == 8) g8::gemm(C.lds, g, E, C.G, C.blk);
                }
                {
                    g8::Desc g{(const bf16_t*)(ws + P_CKVN), (const bf16_t*)(ws + WS_UKV_T), MLA_KVR, MLA_KVR, MLA_KVR, T / 256, 4096 / 256, 1, 1, 0, 0, 0, 0};
                    EpiBf16 E{(bf16_t*)(ws + P_KV), 4096, 0, 0, 1.0f};
                    if (GSITE < 0 || GSITE == 9) g8::gemm(C.lds, g, E, C.G, C.blk);
                }
            }
            SEAM(pb + 3);
            if (IN(pb + 4)) { if (EN_MLA) phase_mla_attn(C, P); }
            SEAM(pb + 4);
            if (IN(pb + 5)) {
                g8::Desc g{hbuf, (const bf16_t*)(ws + WS_MLAO_T), DM, DM, DM, T / 256, DM / 256, 1, 1, 0, 0, 0, 0};
                EpiResid E{P.out, P.out, DM};
                if (GSITE < 0 || GSITE == 10) g8::gemm(C.lds, g, E, C.G, C.blk);
            }
            SEAM(pb + 5);
    }
    {
        constexpr int l = 1, pb = 17; (void)l;
        const unsigned char* lw = ws + WS_LW + (size_t)l * LW_STRIDE;
        if (IN(pb + 6)) rms_rows_2048(C, P.out, P.in[I_XA_NORM] + l * DM, hbuf, T);
        SEAM(pb + 6);
        if (IN(pb + 7)) {
            g8::Desc g{hbuf, (const bf16_t*)(lw + LW_XQ), DM, DM, DM, T / 256, DM / 256, 1, 1, 0, 0, 0, 0};
            EpiBf16 E{(bf16_t*)(ws + P_QX), DM, 0, 0, 1.0f};
            if (GSITE < 0 || GSITE == 11) g8::gemm(C.lds, g, E, C.G, C.blk);
        }
        SEAM(pb + 7);
        if (IN(pb + 8)) {
            g8::Desc g{(const bf16_t*)(ws + P_QX), (const bf16_t*)(ws + WS_KVX + (size_t)l * KVX_STRIDE), DM, DM, 512, SEQ / 256, 1, BATCH, 4, (long)SEQ * DM, 512, (long)MEM_LEN * DM, 512};
            EpiF32 E{(float*)(ws + P_S), 1024, (long)SEQ * 1024, 256, 0.04419417382415922f};
            if (GSITE < 0 || GSITE == 12) g8::gemm(C.lds, g, E, C.G, C.blk);
        }
        SEAM(pb + 8);
        if (IN(pb + 9)) {
            phase_xa_softmax(C, P);
            if (l == 1) {
                cvt_bf16(C, P.in[I_PEER_U] + (size_t)PEER_NE * DM, (bf16_t*)(ws + P_UT), (size_t)PEER_NE * DM / 8);
                cvt_bf16(C, P.in[I_PEER_V] + (size_t)PEER_NE * DM, (bf16_t*)(ws + P_VT), (size_t)PEER_NE * DM / 8);
            }
        }
        SEAM(pb + 9);
        if (IN(pb + 10)) {
            g8::Desc g{(const bf16_t*)(ws + P_P), (const bf16_t*)(ws + WS_KVX + (size_t)l * KVX_STRIDE + 16 * MiB), 1024, MT, 256, SEQ / 256, 2, BATCH, 4, (long)SEQ * 1024, 256, 256, 512L * MT};
            EpiBf16 E{(bf16_t*)(ws + P_OX), DM, (long)SEQ * DM, 512, 1.0f};
            if (GSITE < 0 || GSITE == 13) g8::gemm(C.lds, g, E, C.G, C.blk);
        }
        SEAM(pb + 10);
        if (IN(pb + 11)) {
            g8::Desc g{(const bf16_t*)(ws + P_OX), (const bf16_t*)(lw + LW_XO), DM, DM, DM, T / 256, DM / 256, 1, 1, 0, 0, 0, 0};
            EpiResid E{P.out, P.out, DM};
            if (GSITE < 0 || GSITE == 14) g8::gemm(C.lds, g, E, C.G, C.blk);
        }
        SEAM(pb + 11);
        if (IN(pb + 12)) rms_rows_2048(C, P.out, P.in[I_FFN_NORM] + l * DM, hbuf, T);
        SEAM(pb + 12);
        if (IN(pb + 13)) {
            g8::Desc g{hbuf, (const bf16_t*)(lw + LW_PEER), DM, DM, DM, T / 256, DM / 256, 1, 1, 0, 0, 0, 0};
            EpiF32 E{(float*)(ws + P_SC), DM, 0, 0, 1.0f};
            if (GSITE < 0 || GSITE == 15) g8::gemm(C.lds, g, E, C.G, C.blk);
        }
        SEAM(pb + 13);
        if (IN(pb + 14)) { if (EN_PEER) phase_peer(C, P); }
        SEAM(pb + 14);
    }
    if (IN(32)) rms_rows_final(C, P.out, P.in[I_FINAL_NORM], T);
#undef IN
#undef SEAM
}

extern "C" void kernel_launch(void* const* d_in, const int* in_sizes, int n_in, void* d_out, int out_size, void* d_ws, size_t ws_size, hipStream_t stream) {
    static int grid = 0;
    if (grid == 0) {
        if (n_in != 39 || in_sizes[0] != T * DM || out_size != T * DM || ws_size < WS_END) {
            fprintf(stderr, "kernel_launch: unexpected shapes (n_in %d in0 %d out %d ws %zu, need ws >= %zu); nothing launched\n", n_in, n_in > 0 ? in_sizes[0] : -1, out_size, ws_size, (size_t)WS_END);
            grid = -1; return; }
        int dev = 0, cus = 0;
        if (hipGetDevice(&dev) != hipSuccess || hipDeviceGetAttribute(&cus, hipDeviceAttributeMultiprocessorCount, dev) != hipSuccess) { grid = -1; return; }
        if (hipFuncSetAttribute((const void*)mk_fwd, hipFuncAttributeMaxDynamicSharedMemorySize, LDS_BYTES) != hipSuccess) { fprintf(stderr, "kernel_launch: hipFuncSetAttribute failed\n"); grid = -1; return; }
        int per_cu = 0;
        if (hipOccupancyMaxActiveBlocksPerMultiprocessor(&per_cu, (const void*)mk_fwd, NTHREADS, LDS_BYTES) != hipSuccess || per_cu < 1)
            fprintf(stderr, "kernel_launch: occupancy query reports %d blocks per CU\n", per_cu);
        (void)hipGetLastError();
        grid = cus;
    }
    if (grid < 0) return;
    (void)hipMemsetAsync((char*)d_ws + WS_CTL, 0, CTL_BYTES, stream);
    Params p{};
    for (int i = 0; i < 39; ++i) p.in[i] = (const float*)d_in[i];
    p.out = (float*)d_out; p.ws = (unsigned char*)d_ws;
#if MK_ONE_LAUNCH
    p.ph_lo = 0; p.ph_hi = N_PHASES;
    hipLaunchKernelGGL(mk_fwd, dim3(grid), dim3(NTHREADS), LDS_BYTES, stream, p);
#else
    for (int ph = 0; ph < N_PHASES; ++ph) { p.ph_lo = ph; p.ph_hi = ph + 1; hipLaunchKernelGGL(mk_fwd, dim3(grid), dim3(NTHREADS), LDS_BYTES, stream, p); }
#endif
    const hipError_t le = hipPeekAtLastError();
    if (le != hipSuccess) fprintf(stderr, "kernel_launch: launch failed: %s\n", hipGetErrorName(le));
}
```

```cpp
#include <hip/hip_runtime.h>
#include <cstdio>
#include <cstdint>

#ifndef MK_ONE_LAUNCH
#define MK_ONE_LAUNCH 1
#endif
#ifndef FAST_GEMM
#define FAST_GEMM 1
#endif
#ifndef FAST_ATTN
#define FAST_ATTN 1
#endif

#ifndef EN_S5
#define EN_S5 1
#endif
#ifndef EN_DIFF
#define EN_DIFF 1
#endif
#ifndef EN_MLA
#define EN_MLA 1
#endif
#ifndef EN_PEER
#define EN_PEER 1
#endif
#ifndef EN_GEMM
#define EN_GEMM 1
#endif
#ifndef EN_PRO
#define EN_PRO 1
#endif
#ifndef GSITE
#define GSITE -1
#endif
#define GAS __attribute__((address_space(1)))
#define LAS __attribute__((address_space(3)))
#define DI __device__ __forceinline__
typedef unsigned short bf16_t;
typedef short bf16x8 __attribute__((ext_vector_type(8)));
typedef short s16x4 __attribute__((ext_vector_type(4)));
typedef float f32x2 __attribute__((ext_vector_type(2)));
typedef float f32x4 __attribute__((ext_vector_type(4)));
typedef float f32x16 __attribute__((ext_vector_type(16)));
typedef unsigned u32x2 __attribute__((ext_vector_type(2)));
typedef unsigned u32x4 __attribute__((ext_vector_type(4)));
typedef __bf16 bf16x2_t __attribute__((ext_vector_type(2)));

constexpr int BATCH = 16, SEQ = 2048, DM = 2048, T = BATCH * SEQ, MEM_LEN = 256, MT = BATCH * MEM_LEN;
constexpr int DIFF_HEADS = 12, DIFF_W = 1536, S5_W = 512, AB_IN = 5120;
constexpr int MLA_HEADS = 16, MLA_QR = 768, MLA_KVR = 256, MLA_IN = 1088, MLA_IN_PAD = 1280;
constexpr int PEER_NE = 16384;
constexpr float NORM_EPS = 1e-6f;
constexpr int ROPE_POS = 3072;
constexpr int NWAVES = 8, NTHREADS = 512;

constexpr size_t MiB = 1u << 20;
constexpr size_t WS_CTL = 0, CTL_BYTES = 1 * MiB;
constexpr size_t WS_ROPE = 1 * MiB;
constexpr size_t WS_ABIN_T = 2 * MiB, WS_ABOUT_T = 22 * MiB, WS_GLU_T = 30 * MiB, WS_MLAIN_T = 31 * MiB, WS_UQ_T = 36 * MiB, WS_UKV_T = 41 * MiB, WS_MLAO_T = 43 * MiB;
constexpr size_t WS_LW = 51 * MiB, LW_STRIDE = 40 * MiB;
constexpr size_t LW_XQ = 0, LW_XKV = 8 * MiB, LW_XO = 24 * MiB, LW_PEER = 32 * MiB;
constexpr size_t WS_KVX = 131 * MiB, KVX_STRIDE = 32 * MiB;
constexpr size_t WS_POOL = 195 * MiB;
constexpr size_t P_H = WS_POOL;
constexpr size_t P_PROJ = WS_POOL + 128 * MiB;
constexpr size_t P_CONCAT = WS_POOL + 448 * MiB;
constexpr size_t P_GBUF = WS_POOL + 576 * MiB;
constexpr size_t P_MLAPROJ = WS_POOL + 128 * MiB;
constexpr size_t P_CQN = WS_POOL + 208 * MiB;
constexpr size_t P_CKVN = WS_POOL + 256 * MiB;
constexpr size_t P_KROPE = WS_POOL + 272 * MiB;
constexpr size_t P_Q = WS_POOL + 288 * MiB;
constexpr size_t P_KV = WS_POOL + 480 * MiB;
constexpr size_t P_QX = WS_POOL + 128 * MiB;
constexpr size_t P_S = WS_POOL + 256 * MiB;
constexpr size_t P_P = WS_POOL + 384 * MiB;
constexpr size_t P_OX = WS_POOL + 448 * MiB;
constexpr size_t P_SC = WS_POOL + 128 * MiB;
constexpr size_t P_UT = WS_POOL + 704 * MiB;
constexpr size_t P_VT = WS_POOL + 768 * MiB;
constexpr size_t P_MEMN = WS_POOL + 608 * MiB;
constexpr size_t P_WQB = WS_POOL + 640 * MiB;
constexpr size_t P_SK = WS_POOL + 656 * MiB;
constexpr size_t WS_END = WS_POOL + 832 * MiB;
constexpr int CW_BAR = 4096, CW_CTR = 16384;

constexpr int RING_BYTES = 131072, LDSCTL_OFF = RING_BYTES, LDS_BYTES = 147456;

DI unsigned pk2(float lo, float hi) { f32x2 v = {lo, hi}; bf16x2_t b = __builtin_convertvector(v, bf16x2_t); return __builtin_bit_cast(unsigned, b); }
DI float bflo(unsigned u) { return __uint_as_float(u << 16); }
DI float bfhi(unsigned u) { return __uint_as_float(u & 0xffff0000u); }
DI float bf2f(bf16_t b) { return __uint_as_float(((unsigned)b) << 16); }
DI bf16_t f2bf(float f) { return (bf16_t)(pk2(f, 0.f) & 0xffffu); }
DI float dot2bf(unsigned a, unsigned b, float c) { return __builtin_amdgcn_fdot2_f32_bf16(__builtin_bit_cast(bf16x2_t, a), __builtin_bit_cast(bf16x2_t, b), c, false); }
DI float wave_sum(float v) {
#pragma unroll
    for (int o = 1; o < 64; o <<= 1) v += __shfl_xor(v, o);
    return v;
}
DI float gelu_erf(float v) { return 0.5f * v * (1.0f + erff(v * 0.70710678118654752f)); }
DI float swap32_max(float x) { auto rr = __builtin_amdgcn_permlane32_swap(__float_as_uint(x), __float_as_uint(x), false, false); return fmaxf(__uint_as_float(rr[0]), __uint_as_float(rr[1])); }
DI float swap32_sum(float x) { auto rr = __builtin_amdgcn_permlane32_swap(__float_as_uint(x), __float_as_uint(x), false, false); return __uint_as_float(rr[0]) + __uint_as_float(rr[1]); }
#define LDS_WAIT() asm volatile("s_waitcnt lgkmcnt(0)" ::: "memory")
#define VM_WAIT() asm volatile("s_waitcnt vmcnt(0)" ::: "memory")

#define XB_TMO      128
#define XB_XCNT(j)  (256  + 64 * (j))
#define XB_XSUB(j)  (1280 + 64 * (j))
#define XB_XGEN(j)  (2304 + 64 * (j))
#define XB_TOP      3328
#define XB_TOPGEN   3392
#define XCD_BAR_WORDS 3456
#define XB_SPIN_CAP (1u << 20)
DI unsigned xb_ld(unsigned* p)              { return __hip_atomic_load(p, __ATOMIC_RELAXED, __HIP_MEMORY_SCOPE_AGENT); }
DI unsigned xb_add(unsigned* p, unsigned v) { return __hip_atomic_fetch_add(p, v, __ATOMIC_RELAXED, __HIP_MEMORY_SCOPE_AGENT); }
DI unsigned xb_xcc_id() { return (unsigned)__builtin_amdgcn_s_getreg((3 << 11) | 20) & 0xFu; }
#define XB_SPIN(cond, bar) do { unsigned _sp = 0; while (cond) { __builtin_amdgcn_s_sleep(1); \
    if ((++_sp & 255u) == 0u) { if (xb_ld(&(bar)[XB_TMO])) break; if (_sp > XB_SPIN_CAP) { atomicAdd(&(bar)[XB_TMO], 1u); break; } } } } while (0)
struct XcdBarrier { unsigned* bar; unsigned x; volatile LAS unsigned* st; };
DI XcdBarrier xcd_barrier_post(unsigned* bar, volatile LAS unsigned* st) {
    XcdBarrier b; b.bar = bar; b.x = xb_xcc_id(); b.st = st;
    if (threadIdx.x == 0) (void)xb_add(&bar[XB_XCNT(b.x)], 1u);
    return b;
}
DI void xcd_barrier_complete(unsigned* bar, unsigned x, unsigned& nloc, unsigned& nx) {
    const unsigned G = gridDim.x * gridDim.y * gridDim.z;
    unsigned sum, cnt, mine, sp = 0u;
    for (;;) {
        sum = 0u; cnt = 0u; mine = 0u;
#pragma unroll
        for (unsigned j = 0; j < 16; ++j) { const unsigned c = xb_ld(&bar[XB_XCNT(j)]); sum += c; cnt += (c > 0u) ? 1u : 0u; mine = (j == x) ? c : mine; }
        if (sum == G) break;
        __builtin_amdgcn_s_sleep(1);
        if ((++sp & 255u) == 0u) { if (xb_ld(&bar[XB_TMO])) break; if (sp > XB_SPIN_CAP) { atomicAdd(&bar[XB_TMO], 1u); break; } }
    }
    nloc = mine > 0u ? mine : 1u; nx = cnt > 0u ? cnt : 1u;
}
DI void xcd_barrier(const XcdBarrier& b) {
    asm volatile("s_waitcnt vmcnt(0)" ::: "memory");
    __syncthreads();
    if (threadIdx.x == 0) {
        unsigned* bar = b.bar;
        __builtin_amdgcn_s_waitcnt(0);
        unsigned nloc = b.st[0], nx = b.st[1];
        if (nloc == 0u) { xcd_barrier_complete(bar, b.x, nloc, nx); b.st[0] = nloc; b.st[1] = nx; }
        const unsigned old = xb_add(&bar[XB_XSUB(b.x)], 1u);
        const unsigned gen = old / nloc;
        if (old + 1u == (gen + 1u) * nloc) {
            __builtin_amdgcn_fence(__ATOMIC_RELEASE, "agent");
            asm volatile("s_waitcnt vmcnt(0)" ::: "memory");
            const unsigned og = xb_add(&bar[XB_TOP], 1u);
            const unsigned tg = og / nx;
            if (og + 1u == (tg + 1u) * nx) xb_add(&bar[XB_TOPGEN], 1u);
            else XB_SPIN(xb_ld(&bar[XB_TOPGEN]) == tg, bar);
            __builtin_amdgcn_fence(__ATOMIC_ACQUIRE, "agent");
            xb_add(&bar[XB_XGEN(b.x)], 1u);
            asm volatile("s_waitcnt vmcnt(0)" ::: "memory");
        } else {
            XB_SPIN(xb_ld(&bar[XB_XGEN(b.x)]) == gen, bar);
            __builtin_amdgcn_fence(__ATOMIC_ACQUIRE, "agent");
            asm volatile("s_waitcnt vmcnt(0)" ::: "memory");
        }
    }
    __syncthreads();
}

namespace g8 {
constexpr int BM = 256, BK = 64, HALF = 128, HTB = HALF * BK * 2, STAGE_BYTES = 8 * HTB, NXCD = 8, WGM = 8;
DI int lds_byte(int r, int c) { const int st = (r >> 4) * 2 + (c >> 5), rr = r & 15, cc = c & 31, ob = rr * 64 + cc * 2; return st * 1024 + (ob ^ (((ob >> 9) & 1) << 5)); }
DI void stage_rc(int b, int& R, int& C) { const int st = b / 1024, sb = b % 1024, swz = sb ^ (((sb >> 9) & 1) << 5); R = (st >> 1) * 16 + swz / 64; C = (st & 1) * 32 + (swz % 64) / 2; }
DI int perm32(int rho) { const int n = rho >> 4, i = rho & 15; return 8 * (i >> 2) + 4 * n + (i & 3); }

struct Unit { int zo, zi, pm, pn; };
struct Desc { const bf16_t* A; const bf16_t* Bt; int lda, ldb, K, nM, nN, nZo, nZi; long sAo, sAi, sBo, sBi; };
DI bool next_unit(const Desc& g, int i, int G, int c, Unit& u) {
    const int per = g.nM * g.nN, nwg = per * g.nZo * g.nZi;
    const long L = (long)i * G + c; if (L >= nwg) return false;
    int wgid = (int)L; { const int q = nwg / NXCD, r = nwg % NXCD, xcd = wgid % NXCD, off = wgid / NXCD; wgid = (xcd < r ? xcd * (q + 1) : r * (q + 1) + (xcd - r) * q) + off; }
    const int z = wgid / per, w = wgid % per;
    u.zo = z / g.nZi; u.zi = z % g.nZi;
    const int nig = WGM * g.nN, gid = w / nig, fm = gid * WGM, gsz = (g.nM - fm) < WGM ? (g.nM - fm) : WGM;
    u.pm = fm + ((w % nig) % gsz); u.pn = (w % nig) / gsz; return true;
}

template <class Epi>
DI void gemm_phase(LAS unsigned char* lds, const Desc g, const Epi& E, int G, int c) {
    const int tid = threadIdx.x, wid = __builtin_amdgcn_readfirstlane(tid >> 6), lane = tid & 63, wr = wid >> 2, wc = wid & 3, fr = lane & 15, fq = lane >> 4;
    const int K = g.K, nt = K / BK;
    unsigned voffA[2], voffB[2];
#pragma unroll
    for (int i = 0; i < 2; ++i) { int R, C; stage_rc(tid * 16 + i * 8192, R, C); const int Rb = (R & ~31) + perm32(R & 31);
        voffA[i] = (unsigned)(R * g.lda + C) * 2u; voffB[i] = (unsigned)(Rb * g.ldb + C) * 2u; }
    const size_t kstep = (size_t)(BK * 2);
    const size_t hstepA = (size_t)HALF * g.lda * 2, hstepB = (size_t)HALF * g.ldb * 2;
    const unsigned ldsw = (unsigned)wid * 1024u;
    const int aoff = lds_byte(wr * 64 + fr, fq * 8), boff = lds_byte(wc * 32 + fr, fq * 8);
#define PG8_SA(b, h) (((b) * 2 + (h)) * HTB)
#define PG8_SB(b, h) ((4 + (b) * 2 + (h)) * HTB)
#define PG8_STAGE(bufoff, gbase, voff) do { _Pragma("unroll") for (int _i = 0; _i < 2; ++_i) \
        __builtin_amdgcn_global_load_lds((const unsigned*)((const char*)(gbase) + (voff)[_i]), (LAS unsigned*)(lds + (bufoff) + ldsw + _i * 8192), 16, 0, 0); } while (0)
#define PG8_LDA(dst, b, h) do { _Pragma("unroll") for (int m = 0; m < 4; ++m) _Pragma("unroll") for (int k = 0; k < 2; ++k) dst[m][k] = *(const LAS bf16x8*)(lds + PG8_SA(b, h) + aoff + m * 2048 + k * 1024); } while (0)
#define PG8_LDB(dst, b, h) do { _Pragma("unroll") for (int n = 0; n < 2; ++n) _Pragma("unroll") for (int k = 0; k < 2; ++k) dst[n][k] = *(const LAS bf16x8*)(lds + PG8_SB(b, h) + boff + n * 2048 + k * 1024); } while (0)
#define PG8_MMA(ai, bj, At, Bt) do { __builtin_amdgcn_s_setprio(1); _Pragma("unroll") for (int m = 0; m < 4; ++m) _Pragma("unroll") for (int n = 0; n < 2; ++n) _Pragma("unroll") for (int k = 0; k < 2; ++k) \
        acc[ai][bj][m][n] = __builtin_amdgcn_mfma_f32_16x16x32_bf16(Bt[n][k], At[m][k], acc[ai][bj][m][n], 0, 0, 0); __builtin_amdgcn_s_setprio(0); } while (0)
#define PG8_WAIT_V(n) asm volatile("s_waitcnt vmcnt(" #n ")" ::: "memory")
#define PG8_WAIT_L(n) asm volatile("s_waitcnt lgkmcnt(" #n ")" ::: "memory")
#define PG8_BAR __builtin_amdgcn_s_barrier()
#define PG8_SCHED __builtin_amdgcn_sched_barrier(0)
#define PG8_APTR(u) ((const char*)g.A + ((size_t)(u).zo * g.sAo + (size_t)(u).zi * g.sAi + (size_t)(u).pm * BM * g.lda) * 2)
#define PG8_BPTR(u) ((const char*)g.Bt + ((size_t)(u).zo * g.sBo + (size_t)(u).zi * g.sBi + (size_t)(u).pn * BM * g.ldb) * 2)
    Unit cur, nxt; int ui = 0;
    if (!next_unit(g, 0, G, c, cur)) return;
    f32x4 acc[2][2][4][2];
#pragma unroll
    for (int a = 0; a < 2; ++a)
#pragma unroll
        for (int b = 0; b < 2; ++b)
#pragma unroll
            for (int m = 0; m < 4; ++m)
#pragma unroll
                for (int n = 0; n < 2; ++n) acc[a][b][m][n] = (f32x4){0.f, 0.f, 0.f, 0.f};
    bf16x8 At[4][2], B0[2][2], B1[2][2];
    const char* cA = PG8_APTR(cur); const char* cB = PG8_BPTR(cur);
    PG8_STAGE(PG8_SB(0, 0), cB, voffB); PG8_STAGE(PG8_SA(0, 0), cA, voffA); PG8_STAGE(PG8_SB(0, 1), cB + hstepB, voffB); PG8_STAGE(PG8_SA(0, 1), cA + hstepA, voffA);
    if (wr == 1) PG8_BAR;
    PG8_WAIT_V(4); PG8_BAR;
    PG8_STAGE(PG8_SB(1, 0), cB + kstep, voffB); PG8_STAGE(PG8_SA(1, 0), cA + kstep, voffA); PG8_STAGE(PG8_SB(1, 1), cB + hstepB + kstep, voffB);
    PG8_WAIT_V(6); PG8_BAR;
    for (;;) {
        const bool has_next = next_unit(g, ui + 1, G, c, nxt);
        const char* nA = has_next ? PG8_APTR(nxt) : cA; const char* nB = has_next ? PG8_BPTR(nxt) : cB;
        for (int t = 0; t < nt; t += 2) {
            const bool last = (t == nt - 2);
            const char* a1 = cA + (size_t)(t + 1) * kstep;
            const char* a2 = last ? nA : cA + (size_t)(t + 2) * kstep; const char* b2 = last ? nB : cB + (size_t)(t + 2) * kstep;
            const char* a3 = a2 + kstep; const char* b3 = b2 + kstep;
            PG8_LDB(B0, 0, 0); PG8_SCHED; PG8_LDA(At, 0, 0); PG8_STAGE(PG8_SA(1, 1), a1 + hstepA, voffA);
            PG8_WAIT_L(8); PG8_BAR; PG8_WAIT_L(0); PG8_MMA(0, 0, At, B0); PG8_BAR; PG8_SCHED;
            PG8_LDB(B1, 0, 1); PG8_STAGE(PG8_SB(0, 0), b2, voffB);
            PG8_BAR; PG8_WAIT_L(0); PG8_MMA(0, 1, At, B1); PG8_BAR;
            PG8_LDA(At, 0, 1); PG8_STAGE(PG8_SA(0, 0), a2, voffA);
            PG8_BAR; PG8_WAIT_L(0); PG8_MMA(1, 0, At, B0); PG8_BAR; PG8_SCHED;
            PG8_STAGE(PG8_SB(0, 1), b2 + hstepB, voffB);
            PG8_WAIT_V(6); PG8_BAR; PG8_MMA(1, 1, At, B1); PG8_BAR;
            PG8_LDB(B0, 1, 0); PG8_SCHED; PG8_LDA(At, 1, 0); PG8_STAGE(PG8_SA(0, 1), a2 + hstepA, voffA);
            PG8_WAIT_L(8); PG8_BAR; PG8_WAIT_L(0); PG8_MMA(0, 0, At, B0); PG8_BAR; PG8_SCHED;
            PG8_LDB(B1, 1, 1); PG8_STAGE(PG8_SB(1, 0), b3, voffB);
            PG8_BAR; PG8_WAIT_L(0); PG8_MMA(0, 1, At, B1); PG8_BAR;
            PG8_LDA(At, 1, 1); PG8_STAGE(PG8_SA(1, 0), a3, voffA);
            PG8_BAR; PG8_WAIT_L(0); PG8_MMA(1, 0, At, B0); PG8_BAR; PG8_SCHED;
            PG8_STAGE(PG8_SB(1, 1), b3 + hstepB, voffB);
            PG8_WAIT_V(6); PG8_BAR; PG8_MMA(1, 1, At, B1); PG8_BAR;
        }
        {
            const int row0 = cur.pm * BM + wr * 64 + fr, col0 = cur.pn * BM + wc * 32 + 8 * fq;
#pragma unroll
            for (int ai = 0; ai < 2; ++ai)
#pragma unroll
                for (int m = 0; m < 4; ++m)
#pragma unroll
                    for (int bj = 0; bj < 2; ++bj) E.oct(cur.zo, cur.zi, row0 + ai * HALF + m * 16, col0 + bj * HALF, acc[ai][bj][m][0], acc[ai][bj][m][1]);
        }
        if (!has_next) break;
#pragma unroll
        for (int a = 0; a < 2; ++a)
#pragma unroll
            for (int b = 0; b < 2; ++b)
#pragma unroll
                for (int m = 0; m < 4; ++m)
#pragma unroll
                    for (int n = 0; n < 2; ++n) acc[a][b][m][n] = (f32x4){0.f, 0.f, 0.f, 0.f};
        cur = nxt; cA = nA; cB = nB; ++ui;
    }
    PG8_WAIT_V(0);
    if (wr == 0) PG8_BAR;
    PG8_BAR;
#undef PG8_SA
#undef PG8_SB
#undef PG8_STAGE
#undef PG8_LDA
#undef PG8_LDB
#undef PG8_MMA
#undef PG8_WAIT_V
#undef PG8_WAIT_L
#undef PG8_BAR
#undef PG8_SCHED
#undef PG8_APTR
#undef PG8_BPTR
}

template <class Epi>
DI void naive_gemm(const Desc g, const Epi& E, int G, int c) {
    const int M = g.nM * BM, N = g.nN * BM, n8 = N / 8, nZ = g.nZo * g.nZi;
    const long total = (long)nZ * M * n8;
    for (long idx = (long)c * NTHREADS + threadIdx.x; idx < total; idx += (long)G * NTHREADS) {
        const int col = (int)(idx % n8) * 8; const int row = (int)((idx / n8) % M); const int z = (int)(idx / ((long)n8 * M));
        const int zo = z / g.nZi, zi = z % g.nZi;
        const bf16_t* a = g.A + (size_t)zo * g.sAo + (size_t)zi * g.sAi + (size_t)row * g.lda;
        const bf16_t* b = g.Bt + (size_t)zo * g.sBo + (size_t)zi * g.sBi + (size_t)col * g.ldb;
        float acc[8];
#pragma unroll
        for (int j = 0; j < 8; ++j) acc[j] = 0.f;
        for (int k = 0; k < g.K; k += 8) {
            const u32x4 av = *(const u32x4*)(a + k);
#pragma unroll
            for (int j = 0; j < 8; ++j) { const u32x4 bv = *(const u32x4*)(b + (size_t)j * g.ldb + k);
                float s = acc[j]; s = dot2bf(av.x, bv.x, s); s = dot2bf(av.y, bv.y, s); s = dot2bf(av.z, bv.z, s); s = dot2bf(av.w, bv.w, s); acc[j] = s; }
        }
        E.oct(zo, zi, row, col, (f32x4){acc[0], acc[1], acc[2], acc[3]}, (f32x4){acc[4], acc[5], acc[6], acc[7]});
    }
}
template <class Epi>
DI void gemm(LAS unsigned char* lds, const Desc g, const Epi& E, int G, int c) {
#if !EN_GEMM
    return;
#elif FAST_GEMM
    gemm_phase(lds, g, E, G, c);
#else
    naive_gemm(g, E, G, c);
#endif
}
}

struct EpiBf16 {
    bf16_t* O; long ldc, sZo, sZi; float scale;
    DI void oct(int zo, int zi, int row, int col, f32x4 lo, f32x4 hi) const {
        bf16_t* p = O + (size_t)zo * sZo + (size_t)zi * sZi + (size_t)row * ldc + col;
        u32x4 w; w.x = pk2(lo[0] * scale, lo[1] * scale); w.y = pk2(lo[2] * scale, lo[3] * scale); w.z = pk2(hi[0] * scale, hi[1] * scale); w.w = pk2(hi[2] * scale, hi[3] * scale);
        *(u32x4*)p = w;
    }
};
struct EpiF32 {
    float* O; long ldc, sZo, sZi; float scale;
    DI void oct(int zo, int zi, int row, int col, f32x4 lo, f32x4 hi) const {
        float* p = O + (size_t)zo * sZo + (size_t)zi * sZi + (size_t)row * ldc + col;
        *(f32x4*)p = lo * scale; *(f32x4*)(p + 4) = hi * scale;
    }
};
struct EpiResid {
    const float* resid; float* out; long ldc;
    DI void oct(int, int, int row, int col, f32x4 lo, f32x4 hi) const {
        const size_t o = (size_t)row * ldc + col;
        const f32x4 r0 = *(const f32x4*)(resid + o), r1 = *(const f32x4*)(resid + o + 4);
        *(f32x4*)(out + o) = r0 + lo; *(f32x4*)(out + o + 4) = r1 + hi;
    }
};
template <int MODE> struct EpiRope {
    bf16_t* O; long ldc; const int* pos; const f32x2* tab;
    DI void oct(int, int, int row, int col, f32x4 lo, f32x4 hi) const {
        bool rope; int j0;
        if (MODE == 0) { rope = col < 2 * DIFF_W; j0 = col & 63; } else { const int c = col % 192; rope = c >= 128; j0 = c - 128; }
        if (rope) {
            int p = pos[row]; p = p < 0 ? 0 : (p > ROPE_POS - 1 ? ROPE_POS - 1 : p);
            const f32x4* tp = (const f32x4*)(tab + (size_t)p * 32 + (j0 >> 1));
            const f32x4 t0 = tp[0], t1 = tp[1];
            f32x4 a = lo, b = hi;
            lo[0] = a[0] * t0[0] - a[1] * t0[1]; lo[1] = a[1] * t0[0] + a[0] * t0[1];
            lo[2] = a[2] * t0[2] - a[3] * t0[3]; lo[3] = a[3] * t0[2] + a[2] * t0[3];
            hi[0] = b[0] * t1[0] - b[1] * t1[1]; hi[1] = b[1] * t1[0] + b[0] * t1[1];
            hi[2] = b[2] * t1[2] - b[3] * t1[3]; hi[3] = b[3] * t1[2] + b[2] * t1[3];
        }
        u32x4 w; w.x = pk2(lo[0], lo[1]); w.y = pk2(lo[2], lo[3]); w.z = pk2(hi[0], hi[1]); w.w = pk2(hi[2], hi[3]);
        *(u32x4*)(O + (size_t)row * ldc + col) = w;
    }
};
struct EpiGlu {
    const bf16_t* gbuf; const float* bias; bf16_t* out;
    DI void oct(int, int, int row, int col, f32x4 lo, f32x4 hi) const {
        const u32x4 gv = *(const u32x4*)(gbuf + (size_t)row * S5_W + col);
        const f32x4 b0 = *(const f32x4*)(bias + col), b1 = *(const f32x4*)(bias + col + 4);
        float g[8] = {bflo(gv.x), bfhi(gv.x), bflo(gv.y), bfhi(gv.y), bflo(gv.z), bfhi(gv.z), bflo(gv.w), bfhi(gv.w)};
        float a[8] = {lo[0] + b0[0], lo[1] + b0[1], lo[2] + b0[2], lo[3] + b0[3], hi[0] + b1[0], hi[1] + b1[1], hi[2] + b1[2], hi[3] + b1[3]};
        float r[8];
#pragma unroll
        for (int j = 0; j < 8; ++j) r[j] = g[j] / (1.0f + __expf(-a[j]));
        u32x4 w; w.x = pk2(r[0], r[1]); w.y = pk2(r[2], r[3]); w.z = pk2(r[4], r[5]); w.w = pk2(r[6], r[7]);
        *(u32x4*)(out + (size_t)row * DM + DIFF_W + col) = w;
    }
};

struct Params {
    const float* in[39];
    float* out; unsigned char* ws;
    int ph_lo, ph_hi;
};
enum { I_X = 0, I_MEM, I_POS, I_AB_NORM, I_AB_WIN, I_AB_WOUT, I_LQ1, I_LK1, I_LQ2, I_LK2, I_SUBLN, I_S5_ARE, I_S5_AIM, I_S5_LOGSTEP, I_S5_BRE, I_S5_BIM, I_S5_CRE, I_S5_CIM, I_S5_D,
       I_S5_WGLU, I_S5_BGLU, I_MLA_NORM, I_MLA_WIN, I_MLA_QNORM, I_MLA_KVNORM, I_MLA_WUQ, I_MLA_WUKV, I_MLA_WO, I_XA_NORM, I_XA_MEMNORM, I_XA_WQ, I_XA_WKV, I_XA_WO, I_FFN_NORM,
       I_PEER_WQ, I_PEER_SK, I_PEER_U, I_PEER_V, I_FINAL_NORM };

struct Ctx { LAS unsigned char* lds; int tid, lane, wave, blk, G; };

DI void rms_rows_2048(const Ctx& C, const float* src, const float* gain, bf16_t* dst, int nrows) {
    for (int r = C.blk * NWAVES + C.wave; r < nrows; r += C.G * NWAVES) {
        const f32x4* xr = (const f32x4*)(src + (size_t)r * DM) + C.lane;
        f32x4 v[8]; float ss = 0.f;
#pragma unroll
        for (int j = 0; j < 8; ++j) { v[j] = xr[64 * j]; ss += (v[j][0] * v[j][0] + v[j][1] * v[j][1]) + (v[j][2] * v[j][2] + v[j][3] * v[j][3]); }
        const float sc = rsqrtf(wave_sum(ss) * (1.0f / DM) + NORM_EPS);
        u32x2* o = (u32x2*)(dst + (size_t)r * DM) + C.lane;
#pragma unroll
        for (int j = 0; j < 8; ++j) { const f32x4 g = *((const f32x4*)gain + C.lane + 64 * j);
            u32x2 w; w.x = pk2(v[j][0] * sc * g[0], v[j][1] * sc * g[1]); w.y = pk2(v[j][2] * sc * g[2], v[j][3] * sc * g[3]); o[64 * j] = w; }
    }
}
DI void rms_rows_final(const Ctx& C, float* x, const float* gain, int nrows) {
    for (int r = C.blk * NWAVES + C.wave; r < nrows; r += C.G * NWAVES) {
        f32x4* xr = (f32x4*)(x + (size_t)r * DM) + C.lane;
        f32x4 v[8]; float ss = 0.f;
#pragma unroll
        for (int j = 0; j < 8; ++j) { v[j] = xr[64 * j]; ss += (v[j][0] * v[j][0] + v[j][1] * v[j][1]) + (v[j][2] * v[j][2] + v[j][3] * v[j][3]); }
        const float sc = rsqrtf(wave_sum(ss) * (1.0f / DM) + NORM_EPS);
#pragma unroll
        for (int j = 0; j < 8; ++j) { const f32x4 g = *((const f32x4*)gain + C.lane + 64 * j); xr[64 * j] = v[j] * sc * g; }
    }
}

DI int srccol(int kind, int n) {
    if (kind == 1) { if (n < 2 * DIFF_W) { const int j = n & 63; return (n & ~63) + (j >> 1) + 32 * (j & 1); } return n; }
    if (kind == 2) { if (n >= MLA_IN) return -1; if (n >= 1024) { const int j = n - 1024; return 1024 + (j >> 1) + 32 * (j & 1); } return n; }
    if (kind == 3) { const int c = n % 192; if (c >= 128) { const int j = c - 128; return n - c + 128 + (j >> 1) + 32 * (j & 1); } return n; }
    return n;
}
DI void transpose_item(const float* W, int K, int Nsrc, bf16_t* Wt, int nblk, int kind, LAS float* scr, int item, int lane) {
    const int kb = item / nblk, nb = item % nblk, k0 = 64 * kb, n0 = 32 * nb;
    const int src = srccol(kind, n0 + (lane & 31));
#pragma unroll 8
    for (int i = 0; i < 32; ++i) { const int kk = 2 * i + (lane >> 5); scr[kk * 33 + (lane & 31)] = (src >= 0) ? W[(size_t)(k0 + kk) * Nsrc + src] : 0.f; }
    LDS_WAIT(); asm volatile("" ::: "memory");
    const int c = lane & 7;
#pragma unroll
    for (int j = 0; j < 4; ++j) { const int n = (lane >> 3) + 8 * j; const LAS float* s = scr + (8 * c) * 33 + n;
        u32x4 o; o.x = pk2(s[0 * 33], s[1 * 33]); o.y = pk2(s[2 * 33], s[3 * 33]); o.z = pk2(s[4 * 33], s[5 * 33]); o.w = pk2(s[6 * 33], s[7 * 33]);
        *(u32x4*)(Wt + (size_t)(n0 + n) * K + k0 + 8 * c) = o; }
    LDS_WAIT(); asm volatile("" ::: "memory");
}
DI void cvt_bf16(const Ctx& C, const float* src, bf16_t* dst, size_t n8) {
    for (size_t i = (size_t)C.blk * NTHREADS + C.tid; i < n8; i += (size_t)C.G * NTHREADS) {
        const f32x4 a = *(const f32x4*)(src + i * 8), b = *(const f32x4*)(src + i * 8 + 4);
        u32x4 w; w.x = pk2(a[0], a[1]); w.y = pk2(a[2], a[3]); w.z = pk2(b[0], b[1]); w.w = pk2(b[2], b[3]);
        *(u32x4*)(dst + i * 8) = w;
    }
}

DI void phase_prologue(const Ctx& C, const Params& P) {
    unsigned char* ws = P.ws;
    LAS float* scr = (LAS float*)(C.lds + C.wave * 8448);
    const int gw = C.blk * NWAVES + C.wave, NGW = C.G * NWAVES;
    int base = 0;
#define TJOB(Wp, K_, Nsrc_, Nout_, kind_, dst_) do { const int nblk_ = (Nout_) / 32, nit_ = ((K_) / 64) * nblk_; \
        int first_ = (gw - base % NGW + NGW) % NGW; \
        for (int it = first_; it < nit_; it += NGW) transpose_item((Wp), (K_), (Nsrc_), (bf16_t*)(dst_), nblk_, (kind_), scr, it, C.lane); base += nit_; } while (0)
    TJOB(P.in[I_AB_WIN], DM, AB_IN, AB_IN, 1, ws + WS_ABIN_T);
    TJOB(P.in[I_AB_WOUT], DM, DM, DM, 0, ws + WS_ABOUT_T);
    TJOB(P.in[I_S5_WGLU], S5_W, S5_W, S5_W, 0, ws + WS_GLU_T);
    TJOB(P.in[I_MLA_WIN], DM, MLA_IN, MLA_IN_PAD, 2, ws + WS_MLAIN_T);
    TJOB(P.in[I_MLA_WUQ], MLA_QR, 3072, 3072, 3, ws + WS_UQ_T);
    TJOB(P.in[I_MLA_WUKV], MLA_KVR, 4096, 4096, 0, ws + WS_UKV_T);
    TJOB(P.in[I_MLA_WO], DM, DM, DM, 0, ws + WS_MLAO_T);
    for (int l = 0; l < 2; ++l) {
        TJOB(P.in[I_XA_WQ] + (size_t)l * DM * DM, DM, DM, DM, 0, ws + WS_LW + l * LW_STRIDE + LW_XQ);
        TJOB(P.in[I_XA_WKV] + (size_t)l * DM * 2 * DM, DM, 2 * DM, 2 * DM, 0, ws + WS_LW + l * LW_STRIDE + LW_XKV);
        TJOB(P.in[I_XA_WO] + (size_t)l * DM * DM, DM, DM, DM, 0, ws + WS_LW + l * LW_STRIDE + LW_XO);
    }
#undef TJOB
    {
        f32x2* tab = (f32x2*)(ws + WS_ROPE);
        for (int i = C.blk * NTHREADS + C.tid; i < ROPE_POS * 32; i += C.G * NTHREADS) {
            const int p = i >> 5, f = i & 31;
            const float inv = powf(10000.0f, -(float)f * (2.0f / 64.0f));
            const float ang = (float)p * inv;
            tab[i] = (f32x2){(float)cos((double)ang), (float)sin((double)ang)};
        }
    }
    cvt_bf16(C, P.in[I_PEER_WQ], (bf16_t*)(ws + P_WQB), (size_t)2 * DM * DM / 8);
    {
        bf16_t* sk = (bf16_t*)(ws + P_SK); const float* skin = P.in[I_PEER_SK];
        for (int i = C.blk * NTHREADS + C.tid; i < 2 * 8 * 256 * 256 / 8; i += C.G * NTHREADS) {
            const int q8 = (i & 31) * 8, np = (i >> 5) & 255, lh = i >> 13;
            const int c = np >> 7, n = np & 127, c2 = q8 >> 7, q = q8 & 127;
            u32x4 w = {0u, 0u, 0u, 0u};
            if (c == c2) { const float* s = skin + ((((size_t)lh * 2 + c) * 128 + n) * 128 + q);
                const f32x4 a = *(const f32x4*)s, b = *(const f32x4*)(s + 4);
                w.x = pk2(a[0], a[1]); w.y = pk2(a[2], a[3]); w.z = pk2(b[0], b[1]); w.w = pk2(b[2], b[3]); }
            *(u32x4*)(sk + (size_t)i * 8) = w;
        }
    }
    cvt_bf16(C, P.in[I_PEER_U], (bf16_t*)(ws + P_UT), (size_t)PEER_NE * DM / 8);
    cvt_bf16(C, P.in[I_PEER_V], (bf16_t*)(ws + P_VT), (size_t)PEER_NE * DM / 8);
    for (int l = 0; l < 2; ++l) rms_rows_2048(C, P.in[I_MEM], P.in[I_XA_MEMNORM] + l * DM, (bf16_t*)(ws + P_MEMN) + (size_t)l * MT * DM, MT);
}

DI void phase_s5(const Ctx& C, const Params& P) {
    unsigned char* ws = P.ws;
    const bf16_t* proj = (const bf16_t*)(ws + P_PROJ); bf16_t* gbuf = (bf16_t*)(ws + P_GBUF);
    LAS unsigned char* my = C.lds + C.wave * 8192;
    LAS float* U = (LAS float*)my;
    LAS bf16_t* H = (LAS bf16_t*)(my + 1024);
    const int lane = C.lane, n = lane;
    for (int task = C.wave * C.G + C.blk; task < BATCH * 32; task += C.G * NWAVES) {
        const int b = task >> 5, g = task & 31;
        const float a_re = P.in[I_S5_ARE][g * 64 + n], a_im = P.in[I_S5_AIM][g * 64 + n];
        const float step = expf(P.in[I_S5_LOGSTEP][g]);
        const float mag = expf(a_re * step);
        const float ab_re = mag * cosf(a_im * step), ab_im = mag * sinf(a_im * step);
        const float den = a_re * a_re + a_im * a_im, num_re = ab_re - 1.0f;
        const float f_re = (num_re * a_re + ab_im * a_im) / den, f_im = (ab_im * a_re - num_re * a_im) / den;
        float bbr[16], bbi[16];
        {
            const float* br = P.in[I_S5_BRE] + ((size_t)g * 64 + n) * 16; const float* bi = P.in[I_S5_BIM] + ((size_t)g * 64 + n) * 16;
#pragma unroll
            for (int p = 0; p < 16; ++p) { const float x = br[p], y = bi[p]; bbr[p] = f_re * x - f_im * y; bbi[p] = f_re * y + f_im * x; }
        }
        bf16x8 cf[4];
        {
            const int p = lane & 15, kq = lane >> 4;
#pragma unroll
            for (int kk = 0; kk < 4; ++kk) {
                const int k = 32 * kk + 8 * kq; const bool im = k >= 64;
                const float* src = (im ? P.in[I_S5_CIM] : P.in[I_S5_CRE]) + ((size_t)g * 16 + p) * 64 + (k & 63);
                const float sg = im ? -1.f : 1.f;
                const f32x4 a = *(const f32x4*)src, bq = *(const f32x4*)(src + 4);
                u32x4 w; w.x = pk2(sg * a[0], sg * a[1]); w.y = pk2(sg * a[2], sg * a[3]); w.z = pk2(sg * bq[0], sg * bq[1]); w.w = pk2(sg * bq[2], sg * bq[3]);
                cf[kk] = __builtin_bit_cast(bf16x8, w);
            }
        }
        const float dcoef = P.in[I_S5_D][g * 16 + (lane & 15)];
        float h_re = 0.f, h_im = 0.f;
        const bf16_t* ub = proj + (size_t)b * SEQ * AB_IN + 3 * DIFF_W + g * 16;
        for (int s0 = 0; s0 < SEQ; s0 += 16) {
            {
                const int st = lane >> 2, pp = (lane & 3) * 4;
                const u32x2 uv = *(const u32x2*)(ub + (size_t)(s0 + st) * AB_IN + pp);
                *(LAS f32x4*)(U + st * 16 + pp) = (f32x4){bflo(uv.x), bfhi(uv.x), bflo(uv.y), bfhi(uv.y)};
            }
            LDS_WAIT(); asm volatile("" ::: "memory");
#pragma unroll 4
            for (int st = 0; st < 16; ++st) {
                const f32x4 u0 = *(const LAS f32x4*)(U + st * 16), u1 = *(const LAS f32x4*)(U + st * 16 + 4), u2 = *(const LAS f32x4*)(U + st * 16 + 8), u3 = *(const LAS f32x4*)(U + st * 16 + 12);
                const float uu[16] = {u0[0], u0[1], u0[2], u0[3], u1[0], u1[1], u1[2], u1[3], u2[0], u2[1], u2[2], u2[3], u3[0], u3[1], u3[2], u3[3]};
                float br = 0.f, bi = 0.f;
#pragma unroll
                for (int p = 0; p < 16; ++p) { br = fmaf(bbr[p], uu[p], br); bi = fmaf(bbi[p], uu[p], bi); }
                const float nr = ab_re * h_re - ab_im * h_im + br, ni = ab_re * h_im + ab_im * h_re + bi;
                h_re = nr; h_im = ni;
                H[st * 136 + n] = f2bf(h_re); H[st * 136 + 64 + n] = f2bf(h_im);
            }
            LDS_WAIT(); asm volatile("" ::: "memory");
            f32x4 acc = {0.f, 0.f, 0.f, 0.f};
#pragma unroll
            for (int kk = 0; kk < 4; ++kk) {
                const bf16x8 af = *(const LAS bf16x8*)((LAS unsigned char*)H + (lane & 15) * 272 + (32 * kk + 8 * (lane >> 4)) * 2);
                acc = __builtin_amdgcn_mfma_f32_16x16x32_bf16(af, cf[kk], acc, 0, 0, 0);
            }
#pragma unroll
            for (int r = 0; r < 4; ++r) {
                const int st = (lane >> 4) * 4 + r, p = lane & 15;
                const float y = acc[r] + dcoef * U[st * 16 + p];
                gbuf[(size_t)(b * SEQ + s0 + st) * S5_W + g * 16 + p] = f2bf(gelu_erf(y));
            }
            LDS_WAIT(); asm volatile("" ::: "memory");
        }
    }
}

struct AttnArgs { const bf16_t* Qn; const bf16_t* Qr; const bf16_t* Kn; const bf16_t* Kr; const bf16_t* V; int ldq, ldkn, ldkr, ldv; };
DI int crow(int r, int hi) { return (r & 3) + 8 * (r >> 2) + 4 * hi; }
template <int DK> DI int koff(int row, int ch) { return DK == 64 ? row * 128 + 16 * (ch ^ ((row >> 1) & 7)) : row * 256 + 16 * (ch ^ (row & 15)); }
DI int voff(int row, int ch) { return 256 * row + 16 * (ch ^ (((row & 3) << 2) | ((row >> 2) & 3))); }
DI bf16x8 pack8(const f32x16& p, int s) {
    u32x4 w; w.x = pk2(p[8 * s + 0], p[8 * s + 1]); w.y = pk2(p[8 * s + 2], p[8 * s + 3]); w.z = pk2(p[8 * s + 4], p[8 * s + 5]); w.w = pk2(p[8 * s + 6], p[8 * s + 7]);
    return __builtin_bit_cast(bf16x8, w);
}
DI s16x4 vtr(const LAS unsigned char* p) { return __builtin_bit_cast(s16x4, __builtin_amdgcn_ds_read_tr16_b64_v4i16((LAS s16x4*)p)); }

template <int DKN, int DKR>
DI void attn_core(const AttnArgs& a, int q0, LAS unsigned char* lds, float scale, f32x16 (&o)[4]) {
    const int tid = threadIdx.x, wid = __builtin_amdgcn_readfirstlane(tid >> 6), lane = tid & 63, r32 = lane & 31, hi = lane >> 5;
    constexpr int CN = DKN / 8, NLK = CN * 64 / NTHREADS, KNB = 64 * DKN * 2, KRB = 64 * DKR * 2, VOFF = KNB + KRB, BUF = VOFF + 16384;
    static_assert(2 * BUF <= RING_BYTES, "attention LDS");
    bf16x8 qn[DKN / 16]; bf16x8 qr[DKR ? DKR / 16 : 1];
    {
        const bf16_t* qp = a.Qn + (size_t)(q0 + 32 * wid + r32) * a.ldq + hi * 8;
#pragma unroll
        for (int d0 = 0; d0 < DKN / 16; ++d0) qn[d0] = *(const bf16x8*)(qp + d0 * 16);
        if (DKR) { const bf16_t* qp2 = a.Qr + (size_t)(q0 + 32 * wid + r32) * a.ldq + hi * 8;
#pragma unroll
            for (int d0 = 0; d0 < DKR / 16; ++d0) qr[d0] = *(const bf16x8*)(qp2 + d0 * 16); }
    }
    const int NT = (q0 + 256) / 64, NTw = (q0 + 32 * wid + 31) / 64 + 1;
    u32x4 skn[NLK], skr, sv[2];
#define AT_LOAD(t) do { _Pragma("unroll") for (int i_ = 0; i_ < NLK; ++i_) { const int id_ = tid + NTHREADS * i_, row_ = id_ / CN, ch_ = id_ % CN; \
            skn[i_] = *(const u32x4*)(a.Kn + (size_t)((t) * 64 + row_) * a.ldkn + ch_ * 8); } \
        if (DKR) { const int row_ = tid >> 3, ch_ = tid & 7; skr = *(const u32x4*)(a.Kr + (size_t)((t) * 64 + row_) * a.ldkr + ch_ * 8); } \
        _Pragma("unroll") for (int i_ = 0; i_ < 2; ++i_) { const int id_ = tid + NTHREADS * i_, row_ = id_ >> 4, ch_ = id_ & 15; \
            sv[i_] = *(const u32x4*)(a.V + (size_t)((t) * 64 + row_) * a.ldv + ch_ * 8); } } while (0)
#define AT_WRITE(bf) do { LAS unsigned char* bb_ = lds + (bf) * BUF; \
        _Pragma("unroll") for (int i_ = 0; i_ < NLK; ++i_) { const int id_ = tid + NTHREADS * i_, row_ = id_ / CN, ch_ = id_ % CN; *(LAS u32x4*)(bb_ + koff<DKN>(row_, ch_)) = skn[i_]; } \
        if (DKR) { const int row_ = tid >> 3, ch_ = tid & 7; *(LAS u32x4*)(bb_ + KNB + koff<64>(row_, ch_)) = skr; } \
        _Pragma("unroll") for (int i_ = 0; i_ < 2; ++i_) { const int id_ = tid + NTHREADS * i_, row_ = id_ >> 4, ch_ = id_ & 15; *(LAS u32x4*)(bb_ + VOFF + voff(row_, ch_)) = sv[i_]; } } while (0)
    const float Cs = scale * 1.4426950408889634f;
    float m_run = -1e30f, l_run = 0.f;
#pragma unroll
    for (int blk = 0; blk < 4; ++blk)
#pragma unroll
        for (int r = 0; r < 16; ++r) o[blk][r] = 0.f;
    AT_LOAD(0); AT_WRITE(0); if (NT > 1) AT_LOAD(1);
    for (int t = 0; t < NT; ++t) {
        __syncthreads();
        if (t + 1 < NT) AT_WRITE((t + 1) & 1);
        if (t + 2 < NT) AT_LOAD(t + 2);
        if (t < NTw) {
            const LAS unsigned char* base = lds + (t & 1) * BUF;
            int r32v = r32, lanev = lane; asm volatile("" : "+v"(r32v), "+v"(lanev));
            int vb[4][2];
            {
                const int i = lanev & 15, q_ = i >> 2, p_ = i & 3, grp1 = (lanev >> 4) & 1, hv = lanev >> 5, low2 = 2 * grp1 + (p_ >> 1);
#pragma unroll
                for (int blk = 0; blk < 4; ++blk)
#pragma unroll
                    for (int x = 0; x < 2; ++x) vb[blk][x] = VOFF + 256 * (8 * x + 4 * hv + q_) + 16 * (4 * (blk ^ q_) + (low2 ^ (hv + 2 * x))) + 8 * (p_ & 1);
            }
            f32x16 p0, p1;
#pragma unroll
            for (int r = 0; r < 16; ++r) { p0[r] = 0.f; p1[r] = 0.f; }
#pragma unroll
            for (int d0 = 0; d0 < DKN / 16; ++d0) {
                const bf16x8 b0 = *(const LAS bf16x8*)(base + koff<DKN>(r32v, 2 * d0 + hi)), b1 = *(const LAS bf16x8*)(base + koff<DKN>(32 + r32v, 2 * d0 + hi));
                p0 = __builtin_amdgcn_mfma_f32_32x32x16_bf16(b0, qn[d0], p0, 0, 0, 0); p1 = __builtin_amdgcn_mfma_f32_32x32x16_bf16(b1, qn[d0], p1, 0, 0, 0);
            }
            if (DKR) {
#pragma unroll
                for (int d0 = 0; d0 < DKR / 16; ++d0) {
                    const bf16x8 b0 = *(const LAS bf16x8*)(base + KNB + koff<64>(r32v, 2 * d0 + hi)), b1 = *(const LAS bf16x8*)(base + KNB + koff<64>(32 + r32v, 2 * d0 + hi));
                    p0 = __builtin_amdgcn_mfma_f32_32x32x16_bf16(b0, qr[d0], p0, 0, 0, 0); p1 = __builtin_amdgcn_mfma_f32_32x32x16_bf16(b1, qr[d0], p1, 0, 0, 0);
                }
            }
            if (t == NTw - 1) {
                const int qrel = q0 + 32 * wid + r32 - 64 * t;
#pragma unroll
                for (int r = 0; r < 16; ++r) { const int kv = crow(r, hi); if (kv > qrel) p0[r] = -INFINITY; if (kv + 32 > qrel) p1[r] = -INFINITY; }
            }
            float pmax = p0[0];
#pragma unroll
            for (int r = 1; r < 16; ++r) pmax = fmaxf(pmax, p0[r]);
#pragma unroll
            for (int r = 0; r < 16; ++r) pmax = fmaxf(pmax, p1[r]);
            pmax = swap32_max(pmax);
            const float mn = fmaxf(m_run, pmax);
            const float alpha = __builtin_amdgcn_exp2f((m_run - mn) * Cs);
            m_run = mn;
            const float mnC = -mn * Cs;
            float ps = 0.f;
#pragma unroll
            for (int r = 0; r < 16; ++r) { p0[r] = __builtin_amdgcn_exp2f(fmaf(p0[r], Cs, mnC)); p1[r] = __builtin_amdgcn_exp2f(fmaf(p1[r], Cs, mnC)); ps += p0[r] + p1[r]; }
            l_run = l_run * alpha + ps;
            if (!__all(alpha == 1.0f)) {
#pragma unroll
                for (int blk = 0; blk < 4; ++blk)
#pragma unroll
                    for (int r = 0; r < 16; ++r) o[blk][r] *= alpha;
            }
            bf16x8 pb[4]; pb[0] = pack8(p0, 0); pb[1] = pack8(p0, 1); pb[2] = pack8(p1, 0); pb[3] = pack8(p1, 1);
#pragma unroll
            for (int blk = 0; blk < 4; ++blk) {
                s16x4 lo[4], hh[4];
#pragma unroll
                for (int ks = 0; ks < 4; ++ks) { lo[ks] = vtr(base + vb[blk][0] + 4096 * ks); hh[ks] = vtr(base + vb[blk][1] + 4096 * ks); }
#pragma unroll
                for (int ks = 0; ks < 4; ++ks) {
                    const bf16x8 af = {lo[ks][0], lo[ks][1], lo[ks][2], lo[ks][3], hh[ks][0], hh[ks][1], hh[ks][2], hh[ks][3]};
                    o[blk] = __builtin_amdgcn_mfma_f32_32x32x16_bf16(af, pb[ks], o[blk], 0, 0, 0);
                }
                __builtin_amdgcn_sched_barrier(0);
            }
        }
    }
    __syncthreads();
    const float linv = 1.0f / swap32_sum(l_run);
#pragma unroll
    for (int blk = 0; blk < 4; ++blk)
#pragma unroll
        for (int r = 0; r < 16; ++r) o[blk][r] *= linv;
#undef AT_LOAD
#undef AT_WRITE
}
DI void attn_store(const f32x16 (&o)[4], bf16_t* dst, int ld, int q0) {
    const int tid = threadIdx.x, wid = tid >> 6, lane = tid & 63, r32 = lane & 31, hi = lane >> 5;
    bf16_t* rp = dst + (size_t)(q0 + 32 * wid + r32) * ld;
#pragma unroll
    for (int blk = 0; blk < 4; ++blk)
#pragma unroll
        for (int g = 0; g < 4; ++g) {
            u32x2 w; w.x = pk2(o[blk][4 * g], o[blk][4 * g + 1]); w.y = pk2(o[blk][4 * g + 2], o[blk][4 * g + 3]);
            *(u32x2*)(rp + 32 * blk + 8 * g + 4 * hi) = w;
        }
}
DI int queue_pop(const Ctx& C, unsigned* ctr, int total) {
    volatile LAS int* slot = (volatile LAS int*)(C.lds + LDSCTL_OFF + 64);
    __syncthreads();
    if (C.tid == 0) *slot = (int)__hip_atomic_fetch_add(ctr, 1u, __ATOMIC_RELAXED, __HIP_MEMORY_SCOPE_AGENT);
    __syncthreads();
    const int u = *slot;
    return u < total ? u : -1;
}
DI float diff_lambda(const Params& P) {
    float s1 = 0.f, s2 = 0.f;
    for (int i = 0; i < 64; ++i) { s1 += P.in[I_LQ1][i] * P.in[I_LK1][i]; s2 += P.in[I_LQ2][i] * P.in[I_LK2][i]; }
    return expf(s1) - expf(s2) + 0.2f;
}

#if FAST_ATTN
DI void phase_diff_attn(const Ctx& C, const Params& P) {
    unsigned char* ws = P.ws;
    const bf16_t* proj = (const bf16_t*)(ws + P_PROJ); bf16_t* concat = (bf16_t*)(ws + P_CONCAT);
    unsigned* ctr = (unsigned*)(ws + WS_CTL) + CW_CTR;
    const float lam = diff_lambda(P);
    const int NBH = BATCH * DIFF_HEADS, total = NBH * 8;
    const int lane = C.lane, r32 = lane & 31, hi = lane >> 5;
    for (;;) {
        const int u = queue_pop(C, ctr, total); if (u < 0) break;
        const int qb = 7 - u / NBH, bh = u % NBH, b = bh / DIFF_HEADS, h = bh % DIFF_HEADS;
        const bf16_t* base = proj + (size_t)b * SEQ * AB_IN;
        AttnArgs a; a.ldq = AB_IN; a.ldkn = AB_IN; a.ldkr = 0; a.ldv = AB_IN; a.Qr = nullptr; a.Kr = nullptr;
        a.V = base + 2 * DIFF_W + h * 128;
        f32x16 o2[4];
        bf16_t* dst = concat + (size_t)b * SEQ * DM + h * 128;
        a.Qn = base + h * 128; a.Kn = base + DIFF_W + h * 128;
        attn_core<64, 0>(a, qb * 256, C.lds, 0.125f, o2);
        attn_store(o2, dst, DM, qb * 256);
        a.Qn = base + h * 128 + 64; a.Kn = base + DIFF_W + h * 128 + 64;
        attn_core<64, 0>(a, qb * 256, C.lds, 0.125f, o2);
        float ss = 0.f;
        {
            const bf16_t* rp = dst + (size_t)(qb * 256 + 32 * C.wave + r32) * DM;
#pragma unroll
            for (int blk = 0; blk < 4; ++blk)
#pragma unroll
                for (int g = 0; g < 4; ++g) {
                    const u32x2 w = *(const u32x2*)(rp + 32 * blk + 8 * g + 4 * hi);
                    const float o1v[4] = {bflo(w.x), bfhi(w.x), bflo(w.y), bfhi(w.y)};
#pragma unroll
                    for (int j = 0; j < 4; ++j) { const float v = o1v[j] - lam * o2[blk][4 * g + j]; o2[blk][4 * g + j] = v; ss += v * v; }
                }
        }
        ss = swap32_sum(ss);
        const float rs = rsqrtf(ss * (1.0f / 128.0f) + NORM_EPS) * 0.8f;
        const float* sub = P.in[I_SUBLN];
#pragma unroll
        for (int blk = 0; blk < 4; ++blk)
#pragma unroll
            for (int r = 0; r < 16; ++r) o2[blk][r] *= rs * sub[32 * blk + crow(r, hi)];
        attn_store(o2, dst, DM, qb * 256);
    }
}
DI void phase_mla_attn(const Ctx& C, const Params& P) {
    unsigned char* ws = P.ws;
    const bf16_t* q = (const bf16_t*)(ws + P_Q); const bf16_t* kv = (const bf16_t*)(ws + P_KV); const bf16_t* kr = (const bf16_t*)(ws + P_KROPE);
    bf16_t* ob = (bf16_t*)(ws + P_H);
    unsigned* ctr = (unsigned*)(ws + WS_CTL) + CW_CTR + 64;
    const int NBH = BATCH * MLA_HEADS, total = NBH * 8;
    for (;;) {
        const int u = queue_pop(C, ctr, total); if (u < 0) break;
        const int qb = 7 - u / NBH, bh = u % NBH, b = bh / MLA_HEADS, h = bh % MLA_HEADS;
        AttnArgs a; a.ldq = 3072; a.ldkn = 4096; a.ldkr = 64; a.ldv = 4096;
        a.Qn = q + (size_t)b * SEQ * 3072 + h * 192; a.Qr = a.Qn + 128;
        a.Kn = kv + (size_t)b * SEQ * 4096 + h * 256; a.V = a.Kn + 128; a.Kr = kr + (size_t)b * SEQ * 64;
        f32x16 o[4];
        attn_core<128, 64>(a, qb * 256, C.lds, 0.07216878364870322f, o);
        attn_store(o, ob + (size_t)b * SEQ * DM + h * 128, DM, qb * 256);
    }
}
#else
template <int DK> DI void naive_attn_row(const bf16_t* qrow, const bf16_t* qrow2, const bf16_t* Kn, int ldkn, const bf16_t* Kr, int ldkr, const bf16_t* V, int ldv, int nkeys, float scale, int lane, float& o0, float& o1) {
    float qv[3];
#pragma unroll
    for (int j = 0; j < 3; ++j) { const int d = lane + 64 * j; qv[j] = 0.f; if (d < DK) qv[j] = (DK == 192 && d >= 128) ? bf2f(qrow2[d - 128]) : bf2f(qrow[d]); }
    float m = -1e30f, l = 0.f; o0 = 0.f; o1 = 0.f;
    for (int k = 0; k < nkeys; ++k) {
        float s = 0.f;
#pragma unroll
        for (int j = 0; j < 3; ++j) { const int d = lane + 64 * j; if (d < DK) { const float kvv = (DK == 192 && d >= 128) ? bf2f(Kr[(size_t)k * ldkr + d - 128]) : bf2f(Kn[(size_t)k * ldkn + d]); s += qv[j] * kvv; } }
        s = wave_sum(s) * scale;
        const float mn = fmaxf(m, s), al = expf(m - mn), p = expf(s - mn);
        m = mn; l = l * al + p;
        o0 = o0 * al + p * bf2f(V[(size_t)k * ldv + lane]); o1 = o1 * al + p * bf2f(V[(size_t)k * ldv + 64 + lane]);
    }
    o0 /= l; o1 /= l;
}
DI void phase_diff_attn(const Ctx& C, const Params& P) {
    unsigned char* ws = P.ws;
    const bf16_t* proj = (const bf16_t*)(ws + P_PROJ); bf16_t* concat = (bf16_t*)(ws + P_CONCAT);
    const float lam = diff_lambda(P);
    const int lane = C.lane;
    for (int it = C.blk * NWAVES + C.wave; it < BATCH * DIFF_HEADS * SEQ; it += C.G * NWAVES) {
        const int s = it % SEQ, bh = it / SEQ, b = bh / DIFF_HEADS, h = bh % DIFF_HEADS;
        const bf16_t* base = proj + (size_t)b * SEQ * AB_IN;
        const bf16_t* qrow = base + (size_t)s * AB_IN + h * 128;
        float a0, a1, b0, b1;
        naive_attn_row<64>(qrow, nullptr, base + DIFF_W + h * 128, AB_IN, nullptr, 0, base + 2 * DIFF_W + h * 128, AB_IN, s + 1, 0.125f, lane, a0, a1);
        naive_attn_row<64>(qrow + 64, nullptr, base + DIFF_W + h * 128 + 64, AB_IN, nullptr, 0, base + 2 * DIFF_W + h * 128, AB_IN, s + 1, 0.125f, lane, b0, b1);
        const float v0 = a0 - lam * b0, v1 = a1 - lam * b1;
        const float ss = wave_sum(v0 * v0 + v1 * v1);
        const float rs = rsqrtf(ss * (1.0f / 128.0f) + NORM_EPS) * 0.8f;
        bf16_t* orow = concat + (size_t)(b * SEQ + s) * DM + h * 128;
        orow[lane] = f2bf(v0 * rs * P.in[I_SUBLN][lane]); orow[64 + lane] = f2bf(v1 * rs * P.in[I_SUBLN][64 + lane]);
    }
}
DI void phase_mla_attn(const Ctx& C, const Params& P) {
    unsigned char* ws = P.ws;
    const bf16_t* q = (const bf16_t*)(ws + P_Q); const bf16_t* kv = (const bf16_t*)(ws + P_KV); const bf16_t* kr = (const bf16_t*)(ws + P_KROPE);
    bf16_t* ob = (bf16_t*)(ws + P_H);
    const int lane = C.lane;
    for (int it = C.blk * NWAVES + C.wave; it < BATCH * MLA_HEADS * SEQ; it += C.G * NWAVES) {
        const int s = it % SEQ, bh = it / SEQ, b = bh / MLA_HEADS, h = bh % MLA_HEADS;
        const bf16_t* qrow = q + (size_t)(b * SEQ + s) * 3072 + h * 192;
        const bf16_t* kn = kv + (size_t)b * SEQ * 4096 + h * 256;
        float a0, a1;
        naive_attn_row<192>(qrow, qrow + 128, kn, 4096, kr + (size_t)b * SEQ * 64, 64, kn + 128, 4096, s + 1, 0.07216878364870322f, lane, a0, a1);
        bf16_t* orow = ob + (size_t)(b * SEQ + s) * DM + h * 128;
        orow[lane] = f2bf(a0); orow[64 + lane] = f2bf(a1);
    }
}
#endif

DI void phase_mla_rows(const Ctx& C, const Params& P) {
    unsigned char* ws = P.ws;
    const bf16_t* mp = (const bf16_t*)(ws + P_MLAPROJ); bf16_t* cqn = (bf16_t*)(ws + P_CQN); bf16_t* ckvn = (bf16_t*)(ws + P_CKVN); bf16_t* krp = (bf16_t*)(ws + P_KROPE);
    const f32x2* tab = (const f32x2*)(ws + WS_ROPE);
    const int lane = C.lane;
    for (int r = C.blk * NWAVES + C.wave; r < T; r += C.G * NWAVES) {
        const bf16_t* row = mp + (size_t)r * MLA_IN_PAD;
        float v[12]; float ss = 0.f;
#pragma unroll
        for (int j = 0; j < 3; ++j) { const u32x2 w = *(const u32x2*)(row + 4 * (lane + 64 * j)); v[4 * j] = bflo(w.x); v[4 * j + 1] = bfhi(w.x); v[4 * j + 2] = bflo(w.y); v[4 * j + 3] = bfhi(w.y); }
#pragma unroll
        for (int j = 0; j < 12; ++j) ss += v[j] * v[j];
        float sc = rsqrtf(wave_sum(ss) * (1.0f / MLA_QR) + NORM_EPS);
#pragma unroll
        for (int j = 0; j < 3; ++j) { const f32x4 g = *(const f32x4*)(P.in[I_MLA_QNORM] + 4 * (lane + 64 * j));
            u32x2 w; w.x = pk2(v[4 * j] * sc * g[0], v[4 * j + 1] * sc * g[1]); w.y = pk2(v[4 * j + 2] * sc * g[2], v[4 * j + 3] * sc * g[3]);
            *(u32x2*)(cqn + (size_t)r * MLA_QR + 4 * (lane + 64 * j)) = w; }
        {
            const u32x2 w = *(const u32x2*)(row + MLA_QR + 4 * lane);
            const float a0 = bflo(w.x), a1 = bfhi(w.x), a2 = bflo(w.y), a3 = bfhi(w.y);
            const float s2 = rsqrtf(wave_sum(a0 * a0 + a1 * a1 + a2 * a2 + a3 * a3) * (1.0f / MLA_KVR) + NORM_EPS);
            const f32x4 g = *(const f32x4*)(P.in[I_MLA_KVNORM] + 4 * lane);
            u32x2 o; o.x = pk2(a0 * s2 * g[0], a1 * s2 * g[1]); o.y = pk2(a2 * s2 * g[2], a3 * s2 * g[3]);
            *(u32x2*)(ckvn + (size_t)r * MLA_KVR + 4 * lane) = o;
        }
        if (lane < 32) {
            const unsigned w = *(const unsigned*)(row + 1024 + 2 * lane);
            int p = ((const int*)P.in[I_POS])[r]; p = p < 0 ? 0 : (p > ROPE_POS - 1 ? ROPE_POS - 1 : p);
            const f32x2 cs = tab[(size_t)p * 32 + lane];
            const float x1 = bflo(w), x2 = bfhi(w);
            *(unsigned*)(krp + (size_t)r * 64 + 2 * lane) = pk2(x1 * cs[0] - x2 * cs[1], x2 * cs[0] + x1 * cs[1]);
        }
    }
}

DI void phase_xa_softmax(const Ctx& C, const Params& P) {
    unsigned char* ws = P.ws;
    const float* S = (const float*)(ws + P_S); bf16_t* Pb = (bf16_t*)(ws + P_P);
    const int lane = C.lane, hd = lane >> 4, li = lane & 15;
    for (int r = C.blk * NWAVES + C.wave; r < T; r += C.G * NWAVES) {
        const float* row = S + (size_t)r * 1024 + hd * 256;
        f32x4 v[4]; float mx = -1e30f;
#pragma unroll
        for (int j = 0; j < 4; ++j) { v[j] = *(const f32x4*)(row + 4 * (li + 16 * j)); mx = fmaxf(mx, fmaxf(fmaxf(v[j][0], v[j][1]), fmaxf(v[j][2], v[j][3]))); }
#pragma unroll
        for (int o = 1; o < 16; o <<= 1) mx = fmaxf(mx, __shfl_xor(mx, o));
        float sm = 0.f;
#pragma unroll
        for (int j = 0; j < 4; ++j) { v[j][0] = __expf(v[j][0] - mx); v[j][1] = __expf(v[j][1] - mx); v[j][2] = __expf(v[j][2] - mx); v[j][3] = __expf(v[j][3] - mx); sm += (v[j][0] + v[j][1]) + (v[j][2] + v[j][3]); }
#pragma unroll
        for (int o = 1; o < 16; o <<= 1) sm += __shfl_xor(sm, o);
        const float inv = 1.0f / sm;
        bf16_t* orow = Pb + (size_t)r * 1024 + hd * 256;
#pragma unroll
        for (int j = 0; j < 4; ++j) { u32x2 w; w.x = pk2(v[j][0] * inv, v[j][1] * inv); w.y = pk2(v[j][2] * inv, v[j][3] * inv); *(u32x2*)(orow + 4 * (li + 16 * j)) = w; }
    }
}

DI void phase_peer(const Ctx& C, const Params& P) {
    unsigned char* ws = P.ws;
    const float* sc = (const float*)(ws + P_SC); const bf16_t* hb = (const bf16_t*)(ws + P_H);
    const bf16_t* ut = (const bf16_t*)(ws + P_UT); const bf16_t* vt = (const bf16_t*)(ws + P_VT);
    float* xo = P.out;
    LAS unsigned char* my = C.lds + C.wave * 4096;
    LAS float* top_s = (LAS float*)my;
    LAS int* top_i = (LAS int*)(my + 1024);
    LAS int* best_e = (LAS int*)(my + 2048);
    LAS float* best_g = (LAS float*)(my + 2560);
    LAS float* best_s = (LAS float*)(my + 3072);
    LAS int* best_p = (LAS int*)(my + 3584);
    const int lane = C.lane;
    for (int tok = C.blk * NWAVES + C.wave; tok < T; tok += C.G * NWAVES) {
        {
            const int g = lane >> 2, qd = lane & 3;
            float v[32];
            const f32x4* sp = (const f32x4*)(sc + (size_t)tok * 2048 + g * 128 + qd * 32);
#pragma unroll
            for (int j = 0; j < 8; ++j) { const f32x4 x = sp[j]; v[4 * j] = x[0]; v[4 * j + 1] = x[1]; v[4 * j + 2] = x[2]; v[4 * j + 3] = x[3]; }
            for (int r = 0; r < 16; ++r) {
                float bv = v[0]; int bj = 0;
#pragma unroll
                for (int j = 1; j < 32; ++j) { const bool gt = v[j] > bv; bv = gt ? v[j] : bv; bj = gt ? j : bj; }
                int bn = qd * 32 + bj;
#pragma unroll
                for (int off = 1; off <= 2; off <<= 1) { const float ov = __shfl_xor(bv, off); const int on = __shfl_xor(bn, off); const bool tk = (ov > bv) || (ov == bv && on < bn); bv = tk ? ov : bv; bn = tk ? on : bn; }
                if (qd == 0) { top_s[g * 16 + r] = bv; top_i[g * 16 + r] = bn; }
                const int rem = ((bn >> 5) == qd) ? (bn & 31) : -1;
#pragma unroll
                for (int j = 0; j < 32; ++j) v[j] = (j == rem) ? -INFINITY : v[j];
            }
        }
        LDS_WAIT(); asm volatile("" ::: "memory");
        {
            const int h = lane >> 3, sub = lane & 7;
            float v[32];
            const float s00 = top_s[(2 * h) * 16 + 2 * sub], s01 = top_s[(2 * h) * 16 + 2 * sub + 1];
#pragma unroll
            for (int k2 = 0; k2 < 16; ++k2) { const float s1 = top_s[(2 * h + 1) * 16 + k2]; v[k2] = s00 + s1; v[16 + k2] = s01 + s1; }
            for (int r = 0; r < 16; ++r) {
                float bv = v[0]; int bj = 0;
#pragma unroll
                for (int j = 1; j < 32; ++j) { const bool gt = v[j] > bv; bv = gt ? v[j] : bv; bj = gt ? j : bj; }
                int bn = sub * 32 + bj;
#pragma unroll
                for (int off = 1; off <= 4; off <<= 1) { const float ov = __shfl_xor(bv, off); const int on = __shfl_xor(bn, off); const bool tk = (ov > bv) || (ov == bv && on < bn); bv = tk ? ov : bv; bn = tk ? on : bn; }
                if (sub == 0) { best_s[h * 16 + r] = bv; best_p[h * 16 + r] = bn; }
                const int rem = ((bn >> 5) == sub) ? (bn & 31) : -1;
#pragma unroll
                for (int j = 0; j < 32; ++j) v[j] = (j == rem) ? -INFINITY : v[j];
            }
        }
        LDS_WAIT(); asm volatile("" ::: "memory");
#pragma unroll
        for (int e2 = 0; e2 < 2; ++e2) {
            const int idx = lane + 64 * e2, h = idx >> 4;
            float mx = -1e30f;
            for (int k = 0; k < 16; ++k) mx = fmaxf(mx, best_s[h * 16 + k]);
            float sm = 0.f;
            for (int k = 0; k < 16; ++k) sm += __expf(best_s[h * 16 + k] - mx);
            const float gate = __expf(best_s[idx] - mx) / sm;
            const int pos = best_p[idx], k1 = pos >> 4, k2 = pos & 15;
            best_e[idx] = top_i[(2 * h) * 16 + k1] * 128 + top_i[(2 * h + 1) * 16 + k2];
            best_g[idx] = gate;
        }
        LDS_WAIT(); asm volatile("" ::: "memory");
        u32x4 tv[4];
#pragma unroll
        for (int i = 0; i < 4; ++i) tv[i] = *(const u32x4*)(hb + (size_t)tok * DM + 8 * (lane + 64 * i));
        for (int k0 = 0; k0 < 128; k0 += 4) {
            u32x4 rw[4][4];
#pragma unroll
            for (int kk = 0; kk < 4; ++kk) { const int e = __builtin_amdgcn_readfirstlane(best_e[k0 + kk]); const bf16_t* rp = ut + (size_t)e * DM;
#pragma unroll
                for (int i = 0; i < 4; ++i) rw[kk][i] = *(const u32x4*)(rp + 8 * (lane + 64 * i)); }
            float d[4];
#pragma unroll
            for (int kk = 0; kk < 4; ++kk) { float s = 0.f;
#pragma unroll
                for (int i = 0; i < 4; ++i) { s = dot2bf(rw[kk][i].x, tv[i].x, s); s = dot2bf(rw[kk][i].y, tv[i].y, s); s = dot2bf(rw[kk][i].z, tv[i].z, s); s = dot2bf(rw[kk][i].w, tv[i].w, s); }
                d[kk] = wave_sum(s); }
            if (lane < 4) { const float act = lane == 0 ? d[0] : lane == 1 ? d[1] : lane == 2 ? d[2] : d[3]; best_g[k0 + lane] *= gelu_erf(act); }
        }
        LDS_WAIT(); asm volatile("" ::: "memory");
        float acc[32];
#pragma unroll
        for (int j = 0; j < 32; ++j) acc[j] = 0.f;
        for (int k0 = 0; k0 < 128; k0 += 4) {
            u32x4 rw[4][4]; float wk[4];
#pragma unroll
            for (int kk = 0; kk < 4; ++kk) { const int e = __builtin_amdgcn_readfirstlane(best_e[k0 + kk]); wk[kk] = best_g[k0 + kk]; const bf16_t* rp = vt + (size_t)e * DM;
#pragma unroll
                for (int i = 0; i < 4; ++i) rw[kk][i] = *(const u32x4*)(rp + 8 * (lane + 64 * i)); }
#pragma unroll
            for (int kk = 0; kk < 4; ++kk)
#pragma unroll
                for (int i = 0; i < 4; ++i) {
                    acc[8 * i + 0] = fmaf(wk[kk], bflo(rw[kk][i].x), acc[8 * i + 0]); acc[8 * i + 1] = fmaf(wk[kk], bfhi(rw[kk][i].x), acc[8 * i + 1]);
                    acc[8 * i + 2] = fmaf(wk[kk], bflo(rw[kk][i].y), acc[8 * i + 2]); acc[8 * i + 3] = fmaf(wk[kk], bfhi(rw[kk][i].y), acc[8 * i + 3]);
                    acc[8 * i + 4] = fmaf(wk[kk], bflo(rw[kk][i].z), acc[8 * i + 4]); acc[8 * i + 5] = fmaf(wk[kk], bfhi(rw[kk][i].z), acc[8 * i + 5]);
                    acc[8 * i + 6] = fmaf(wk[kk], bflo(rw[kk][i].w), acc[8 * i + 6]); acc[8 * i + 7] = fmaf(wk[kk], bfhi(rw[kk][i].w), acc[8 * i + 7]);
                }
        }
        float* xr = xo + (size_t)tok * DM;
#pragma unroll
        for (int i = 0; i < 4; ++i) { f32x4* p = (f32x4*)(xr + 8 * (lane + 64 * i));
            f32x4 a = p[0], b = p[1];
            a[0] += acc[8 * i]; a[1] += acc[8 * i + 1]; a[2] += acc[8 * i + 2]; a[3] += acc[8 * i + 3];
            b[0] += acc[8 * i + 4]; b[1] += acc[8 * i + 5]; b[2] += acc[8 * i + 6]; b[3] += acc[8 * i + 7];
            p[0] = a; p[1] = b; }
        LDS_WAIT(); asm volatile("" ::: "memory");
    }
}

constexpr int N_PHASES = 33;
__global__ void __launch_bounds__(NTHREADS, 2) mk_fwd(Params P) {
    extern __shared__ __attribute__((aligned(16))) unsigned char lds_raw[];
    Ctx C; C.lds = (LAS unsigned char*)lds_raw; C.tid = threadIdx.x; C.lane = C.tid & 63; C.wave = __builtin_amdgcn_readfirstlane(C.tid >> 6); C.blk = blockIdx.x; C.G = gridDim.x;
    unsigned char* ws = P.ws;
    for (int u = C.tid; u < (LDS_BYTES - LDSCTL_OFF) / 4; u += NTHREADS) ((LAS unsigned*)(C.lds + LDSCTL_OFF))[u] = 0u;
    __syncthreads();
    XcdBarrier bar; bar.bar = (unsigned*)(ws + WS_CTL) + CW_BAR; bar.x = 0; bar.st = nullptr;
    const bool one = (P.ph_hi - P.ph_lo) > 1;
    if (one) bar = xcd_barrier_post((unsigned*)(ws + WS_CTL) + CW_BAR, (volatile LAS unsigned*)(C.lds + LDSCTL_OFF));
    const int lo = P.ph_lo, hi = P.ph_hi;
#define IN(k) (lo <= (k) && (k) < hi)
#define SEAM(k) do { if (IN(k) && IN((k) + 1)) xcd_barrier(bar); } while (0)
    bf16_t* hbuf = (bf16_t*)(ws + P_H);
    const int* pos = (const int*)P.in[I_POS];
    const f32x2* rtab = (const f32x2*)(ws + WS_ROPE);

    if (IN(0)) { if (EN_PRO) phase_prologue(C, P); } SEAM(0);
    if (IN(1)) {
        {
            g8::Desc g{(const bf16_t*)(ws + P_MEMN), (const bf16_t*)(ws + WS_LW + LW_XKV), DM, DM, DM, MT / 256, DM / 256, 2, 1, (long)MT * DM, 0, (long)(LW_STRIDE / 2), 0};
            EpiBf16 E{(bf16_t*)(ws + WS_KVX), DM, (long)(KVX_STRIDE / 2), 0, 1.0f};
            if (GSITE < 0 || GSITE == 1) g8::gemm(C.lds, g, E, C.G, C.blk);
        }
        {
            g8::Desc g{(const bf16_t*)(ws + WS_LW + LW_XKV) + (size_t)DM * DM, (const bf16_t*)(ws + P_MEMN), DM, DM, DM, DM / 256, MT / 256, 2, 1, (long)(LW_STRIDE / 2), 0, (long)MT * DM, 0};
            EpiBf16 E{(bf16_t*)(ws + WS_KVX + 16 * MiB), MT, (long)(KVX_STRIDE / 2), 0, 1.0f};
            if (GSITE < 0 || GSITE == 2) g8::gemm(C.lds, g, E, C.G, C.blk);
        }
        {
            g8::Desc g{(const bf16_t*)(ws + P_SK), (const bf16_t*)(ws + P_WQB), 256, DM, 256, 1, DM / 256, 2, 8, 8L * 65536, 65536, (long)DM * DM, 256};
            EpiBf16 E{(bf16_t*)(ws + WS_LW + LW_PEER), DM, (long)(LW_STRIDE / 2), 256L * DM, 1.0f};
            if (GSITE < 0 || GSITE == 3) g8::gemm(C.lds, g, E, C.G, C.blk);
        }
    }
    SEAM(1);

    {
        constexpr int l = 0, pb = 2; (void)l;

            if (IN(pb + 0)) rms_rows_2048(C, P.in[I_X], P.in[I_AB_NORM], hbuf, T);
            SEAM(pb + 0);
            if (IN(pb + 1)) {
                g8::Desc g{hbuf, (const bf16_t*)(ws + WS_ABIN_T), DM, DM, DM, T / 256, AB_IN / 256, 1, 1, 0, 0, 0, 0};
                EpiRope<0> E{(bf16_t*)(ws + P_PROJ), AB_IN, pos, rtab};
                if (GSITE < 0 || GSITE == 4) g8::gemm(C.lds, g, E, C.G, C.blk);
            }
            SEAM(pb + 1);
            if (IN(pb + 2)) { if (EN_S5) phase_s5(C, P); }
            SEAM(pb + 2);
            if (IN(pb + 3)) { if (EN_DIFF) phase_diff_attn(C, P); }
            SEAM(pb + 3);
            if (IN(pb + 4)) {
                g8::Desc g{(const bf16_t*)(ws + P_GBUF), (const bf16_t*)(ws + WS_GLU_T), S5_W, S5_W, S5_W, T / 256, S5_W / 256, 1, 1, 0, 0, 0, 0};
                EpiGlu E{(const bf16_t*)(ws + P_GBUF), P.in[I_S5_BGLU], (bf16_t*)(ws + P_CONCAT)};
                if (GSITE < 0 || GSITE == 5) g8::gemm(C.lds, g, E, C.G, C.blk);
            }
            SEAM(pb + 4);
            if (IN(pb + 5)) {
                g8::Desc g{(const bf16_t*)(ws + P_CONCAT), (const bf16_t*)(ws + WS_ABOUT_T), DM, DM, DM, T / 256, DM / 256, 1, 1, 0, 0, 0, 0};
                EpiResid E{P.in[I_X], P.out, DM};
                if (GSITE < 0 || GSITE == 6) g8::gemm(C.lds, g, E, C.G, C.blk);
            }
            SEAM(pb + 5);
    }
    {
        constexpr int l = 0, pb = 2; (void)l;
        const unsigned char* lw = ws + WS_LW + (size_t)l * LW_STRIDE;
        if (IN(pb + 6)) rms_rows_2048(C, P.out, P.in[I_XA_NORM] + l * DM, hbuf, T);
        SEAM(pb + 6);
        if (IN(pb + 7)) {
            g8::Desc g{hbuf, (const bf16_t*)(lw + LW_XQ), DM, DM, DM, T / 256, DM / 256, 1, 1, 0, 0, 0, 0};
            EpiBf16 E{(bf16_t*)(ws + P_QX), DM, 0, 0, 1.0f};
            if (GSITE < 0 || GSITE == 11) g8::gemm(C.lds, g, E, C.G, C.blk);
        }
        SEAM(pb + 7);
        if (IN(pb + 8)) {
            g8::Desc g{(const bf16_t*)(ws + P_QX), (const bf16_t*)(ws + WS_KVX + (size_t)l * KVX_STRIDE), DM, DM, 512, SEQ / 256, 1, BATCH, 4, (long)SEQ * DM, 512, (long)MEM_LEN * DM, 512};
            EpiF32 E{(float*)(ws + P_S), 1024, (long)SEQ * 1024, 256, 0.04419417382415922f};
            if (GSITE < 0 || GSITE == 12) g8::gemm(C.lds, g, E, C.G, C.blk);
        }
        SEAM(pb + 8);
        if (IN(pb + 9)) {
            phase_xa_softmax(C, P);
            if (l == 1) {
                cvt_bf16(C, P.in[I_PEER_U] + (size_t)PEER_NE * DM, (bf16_t*)(ws + P_UT), (size_t)PEER_NE * DM / 8);
                cvt_bf16(C, P.in[I_PEER_V] + (size_t)PEER_NE * DM, (bf16_t*)(ws + P_VT), (size_t)PEER_NE * DM / 8);
            }
        }
        SEAM(pb + 9);
        if (IN(pb + 10)) {
            g8::Desc g{(const bf16_t*)(ws + P_P), (const bf16_t*)(ws + WS_KVX + (size_t)l * KVX_STRIDE + 16 * MiB), 1024, MT, 256, SEQ / 256, 2, BATCH, 4, (long)SEQ * 1024, 256, 256, 512L * MT};
            EpiBf16 E{(bf16_t*)(ws + P_OX), DM, (long)SEQ * DM, 512, 1.0f};
            if (GSITE < 0 || GSITE == 13) g8::gemm(C.lds, g, E, C.G, C.blk);
        }
        SEAM(pb + 10);
        if (IN(pb + 11)) {
            g8::Desc g{(const bf16_t*)(ws + P_OX), (const bf16_t*)(lw + LW_XO), DM, DM, DM, T / 256, DM / 256, 1, 1, 0, 0, 0, 0};
            EpiResid E{P.out, P.out, DM};
            if (GSITE < 0 || GSITE == 14) g8::gemm(C.lds, g, E, C.G, C.blk);
        }
        SEAM(pb + 11);
        if (IN(pb + 12)) rms_rows_2048(C, P.out, P.in[I_FFN_NORM] + l * DM, hbuf, T);
        SEAM(pb + 12);
        if (IN(pb + 13)) {
            g8::Desc g{hbuf, (const bf16_t*)(lw + LW_PEER), DM, DM, DM, T / 256, DM / 256, 1, 1, 0, 0, 0, 0};
            EpiF32 E{(float*)(ws + P_SC), DM, 0, 0, 1.0f};
            if (GSITE < 0 || GSITE == 15) g8::gemm(C.lds, g, E, C.G, C.blk);
        }
        SEAM(pb + 13);
        if (IN(pb + 14)) { if (EN_PEER) phase_peer(C, P); }
        SEAM(pb + 14);
    }
    {
        constexpr int l = 1, pb = 17; (void)l;

            if (IN(pb + 0)) rms_rows_2048(C, P.out, P.in[I_MLA_NORM], hbuf, T);
            SEAM(pb + 0);
            if (IN(pb + 1)) {
                g8::Desc g{hbuf, (const bf16_t*)(ws + WS_MLAIN_T), DM, DM, DM, T / 256, MLA_IN_PAD / 256, 1, 1, 0, 0, 0, 0};
                EpiBf16 E{(bf16_t*)(ws + P_MLAPROJ), MLA_IN_PAD, 0, 0, 1.0f};
                if (GSITE < 0 || GSITE == 7) g8::gemm(C.lds, g, E, C.G, C.blk);
            }
            SEAM(pb + 1);
            if (IN(pb + 2)) phase_mla_rows(C, P);
            SEAM(pb + 2);
            if (IN(pb + 3)) {
                {
                    g8::Desc g{(const bf16_t*)(ws + P_CQN), (const bf16_t*)(ws + WS_UQ_T), MLA_QR, MLA_QR, MLA_QR, T / 256, 3072 / 256, 1, 1, 0, 0, 0, 0};
                    EpiRope<1> E{(bf16_t*)(ws + P_Q), 3072, pos, rtab};
                    if (GSITE < 0 || GSITE == 8) g8::gemm(C.lds, g, E, C.G, C.blk);
                }
                {
                    g8::Desc g{(const bf16_t*)(ws + P_CKVN), (const bf16_t*)(ws + WS_UKV_T), MLA_KVR, MLA_KVR, MLA_KVR, T / 256, 4096 / 256, 1, 1, 0, 0, 0, 0};
                    EpiBf16 E{(bf16_t*)(ws + P_KV), 4096, 0, 0, 1.0f};
                    if (GSITE < 0 || GSITE == 9) g8::gemm(C.lds, g, E, C.G, C.blk);
                }
            }
            SEAM(pb + 3);
            if (IN(pb + 4)) { if (EN_MLA) phase_mla_attn(C, P); }
            SEAM(pb + 4);
            if (IN(pb + 5)) {
                g8::Desc g{hbuf, (const bf16_t*)(ws + WS_MLAO_T), DM, DM, DM, T / 256, DM / 256, 1, 1, 0, 0, 0, 0};
                EpiResid E{P.out, P.out, DM};
                if (GSITE < 0 || GSITE == 10) g8::gemm(C.lds, g, E, C.G, C.blk);
            }
            SEAM(pb + 5);
    }
    {
        constexpr int l = 1, pb = 17; (void)l;
        const unsigned char* lw = ws + WS_LW + (size_t)l * LW_STRIDE;
        if (IN(pb + 6)) rms_rows_2048(C, P.out, P.in[I_XA_NORM] + l * DM, hbuf, T);
        SEAM(pb + 6);
        if (IN(pb + 7)) {
            g8::Desc g{hbuf, (const bf16_t*)(lw + LW_XQ), DM, DM, DM, T / 256, DM / 256, 1, 1, 0, 0, 0, 0};
            EpiBf16 E{(bf16_t*)(ws + P_QX), DM, 0, 0, 1.0f};
            if (GSITE < 0 || GSITE == 11) g8::gemm(C.lds, g, E, C.G, C.blk);
        }
        SEAM(pb + 7);
        if (IN(pb + 8)) {
            g8::Desc g{(const bf16_t*)(ws + P_QX), (const bf16_t*)(ws + WS_KVX + (size_t)l * KVX_STRIDE), DM, DM, 512, SEQ / 256, 1, BATCH, 4, (long)SEQ * DM, 512, (long)MEM_LEN * DM, 512};
            EpiF32 E{(float*)(ws + P_S), 1024, (long)SEQ * 1024, 256, 0.04419417382415922f};
            if (GSITE < 0 || GSITE == 12) g8::gemm(C.lds, g, E, C.G, C.blk);
        }
        SEAM(pb + 8);
        if (IN(pb + 9)) {
            phase_xa_softmax(C, P);
            if (l == 1) {
                cvt_bf16(C, P.in[I_PEER_U] + (size_t)PEER_NE * DM, (bf16_t*)(ws + P_UT), (size_t)PEER_NE * DM / 8);
                cvt_bf16(C, P.in[I_PEER_V] + (size_t)PEER_NE * DM, (bf16_t*)(ws + P_VT), (size_t)PEER_NE * DM / 8);
            }
        }
        SEAM(pb + 9);
        if (IN(pb + 10)) {
            g8::Desc g{(const bf16_t*)(ws + P_P), (const bf16_t*)(ws + WS_KVX + (size_t)l * KVX_STRIDE + 16 * MiB), 1024, MT, 256, SEQ / 256, 2, BATCH, 4, (long)SEQ * 1024, 256, 256, 512L * MT};
            EpiBf16 E{(bf16_t*)(ws + P_OX), DM, (long)SEQ * DM, 512, 1.0f};
            if (GSITE < 0 || GSITE == 13) g8::gemm(C.lds, g, E, C.G, C.blk);
        }
        SEAM(pb + 10);
        if (IN(pb + 11)) {
            g8::Desc g{(const bf16_t*)(ws + P_OX), (const bf16_t*)(lw + LW_XO), DM, DM, DM, T / 256, DM / 256, 1, 1, 0, 0, 0, 0};
            EpiResid E{P.out, P.out, DM};
            if (GSITE < 0 || GSITE == 14) g8::gemm(C.lds, g, E, C.G, C.blk);
        }
        SEAM(pb + 11);
        if (IN(pb + 12)) rms_rows_2048(C, P.out, P.in[I_FFN_NORM] + l * DM, hbuf, T);
        SEAM(pb + 12);
        if (IN(pb + 13)) {
            g8::Desc g{hbuf, (const bf16_t*)(lw + LW_PEER), DM, DM, DM, T / 256, DM / 256, 1, 1, 0, 0, 0, 0};
            EpiF32 E{(float*)(ws + P_SC), DM, 0, 0, 1.0f};
            if (GSITE < 0 || GSITE == 15) g8::gemm(C.lds, g, E, C.G, C.blk);
        }
        SEAM(pb + 13);
        if (IN(pb + 14)) { if (EN_PEER) phase_peer(C, P); }
        SEAM(pb + 14);
    }
    if (IN(32)) rms_rows_final(C, P.out, P.in[I_FINAL_NORM], T);
#undef IN
#undef SEAM
}

extern "C" void kernel_launch(void* const* d_in, const int* in_sizes, int n_in, void* d_out, int out_size, void* d_ws, size_t ws_size, hipStream_t stream) {
    static int grid = 0;
    if (grid == 0) {
        if (n_in != 39 || in_sizes[0] != T * DM || out_size != T * DM || ws_size < WS_END) {
            fprintf(stderr, "kernel_launch: unexpected shapes (n_in %d in0 %d out %d ws %zu, need ws >= %zu); nothing launched\n", n_in, n_in > 0 ? in_sizes[0] : -1, out_size, ws_size, (size_t)WS_END);
            grid = -1; return; }
        int dev = 0, cus = 0;
        if (hipGetDevice(&dev) != hipSuccess || hipDeviceGetAttribute(&cus, hipDeviceAttributeMultiprocessorCount, dev) != hipSuccess) { grid = -1; return; }
        if (hipFuncSetAttribute((const void*)mk_fwd, hipFuncAttributeMaxDynamicSharedMemorySize, LDS_BYTES) != hipSuccess) { fprintf(stderr, "kernel_launch: hipFuncSetAttribute failed\n"); grid = -1; return; }
        int per_cu = 0;
        if (hipOccupancyMaxActiveBlocksPerMultiprocessor(&per_cu, (const void*)mk_fwd, NTHREADS, LDS_BYTES) != hipSuccess || per_cu < 1)
            fprintf(stderr, "kernel_launch: occupancy query reports %d blocks per CU\n", per_cu);
        (void)hipGetLastError();
        grid = cus;
    }
    if (grid < 0) return;
    (void)hipMemsetAsync((char*)d_ws + WS_CTL, 0, CTL_BYTES, stream);
    Params p{};
    for (int i = 0; i < 39; ++i) p.in[i] = (const float*)d_in[i];
    p.out = (float*)d_out; p.ws = (unsigned char*)d_ws;
#if MK_ONE_LAUNCH
    p.ph_lo = 0; p.ph_hi = N_PHASES;
    hipLaunchKernelGGL(mk_fwd, dim3(grid), dim3(NTHREADS), LDS_BYTES, stream, p);
#else
    for (int ph = 0; ph < N_PHASES; ++ph) { p.ph_lo = ph; p.ph_hi = ph + 1; hipLaunchKernelGGL(mk_fwd, dim3(grid), dim3(NTHREADS), LDS_BYTES, stream, p); }
#endif
    const hipError_t le = hipPeekAtLastError();
    if (le != hipSuccess) fprintf(stderr, "kernel_launch: launch failed: %s\n", hipGetErrorName(le));
}
```

```cpp
#include <hip/hip_runtime.h>
#include <cstdio>
#include <cstdint>

#ifndef MK_ONE_LAUNCH
#define MK_ONE_LAUNCH 1
#endif
#ifndef FAST_GEMM
#define FAST_GEMM 1
#endif
#ifndef FAST_ATTN
#define FAST_ATTN 1
#endif

#ifndef EN_S5
#define EN_S5 1
#endif
#ifndef EN_DIFF
#define EN_DIFF 1
#endif
#ifndef EN_MLA
#define EN_MLA 1
#endif
#ifndef EN_PEER
#define EN_PEER 1
#endif
#ifndef EN_GEMM
#define EN_GEMM 1
#endif
#ifndef EN_PRO
#define EN_PRO 1
#endif
#ifndef PEER_FP8
#define PEER_FP8 1
#endif
#ifndef PROBE_PEER2
#define PROBE_PEER2 0
#endif
#ifndef GSITE
#define GSITE -1
#endif
#define GAS __attribute__((address_space(1)))
#define LAS __attribute__((address_space(3)))
#define DI __device__ __forceinline__
typedef unsigned short bf16_t;
typedef short bf16x8 __attribute__((ext_vector_type(8)));
typedef short s16x4 __attribute__((ext_vector_type(4)));
typedef float f32x2 __attribute__((ext_vector_type(2)));
typedef float f32x4 __attribute__((ext_vector_type(4)));
typedef float f32x16 __attribute__((ext_vector_type(16)));
typedef unsigned u32x2 __attribute__((ext_vector_type(2)));
typedef unsigned u32x4 __attribute__((ext_vector_type(4)));
typedef __bf16 bf16x2_t __attribute__((ext_vector_type(2)));

constexpr int BATCH = 16, SEQ = 2048, DM = 2048, T = BATCH * SEQ, MEM_LEN = 256, MT = BATCH * MEM_LEN;
constexpr int DIFF_HEADS = 12, DIFF_W = 1536, S5_W = 512, AB_IN = 5120;
constexpr int MLA_HEADS = 16, MLA_QR = 768, MLA_KVR = 256, MLA_IN = 1088, MLA_IN_PAD = 1280;
constexpr int PEER_NE = 16384;
constexpr float NORM_EPS = 1e-6f;
constexpr int ROPE_POS = 3072;
constexpr int NWAVES = 8, NTHREADS = 512;

constexpr size_t MiB = 1u << 20;
constexpr size_t WS_CTL = 0, CTL_BYTES = 1 * MiB;
constexpr size_t WS_ROPE = 1 * MiB;
constexpr size_t WS_ABIN_T = 2 * MiB, WS_ABOUT_T = 22 * MiB, WS_GLU_T = 30 * MiB, WS_MLAIN_T = 31 * MiB, WS_UQ_T = 36 * MiB, WS_UKV_T = 41 * MiB, WS_MLAO_T = 43 * MiB;
constexpr size_t WS_LW = 51 * MiB, LW_STRIDE = 40 * MiB;
constexpr size_t LW_XQ = 0, LW_XKV = 8 * MiB, LW_XO = 24 * MiB, LW_PEER = 32 * MiB;
constexpr size_t WS_KVX = 131 * MiB, KVX_STRIDE = 32 * MiB;
constexpr size_t WS_POOL = 195 * MiB;
constexpr size_t P_H = WS_POOL;
constexpr size_t P_PROJ = WS_POOL + 128 * MiB;
constexpr size_t P_CONCAT = WS_POOL + 448 * MiB;
constexpr size_t P_GBUF = WS_POOL + 576 * MiB;
constexpr size_t P_MLAPROJ = WS_POOL + 128 * MiB;
constexpr size_t P_CQN = WS_POOL + 208 * MiB;
constexpr size_t P_CKVN = WS_POOL + 256 * MiB;
constexpr size_t P_KROPE = WS_POOL + 272 * MiB;
constexpr size_t P_Q = WS_POOL + 288 * MiB;
constexpr size_t P_KV = WS_POOL + 480 * MiB;
constexpr size_t P_QX = WS_POOL + 128 * MiB;
constexpr size_t P_S = WS_POOL + 256 * MiB;
constexpr size_t P_P = WS_POOL + 384 * MiB;
constexpr size_t P_OX = WS_POOL + 448 * MiB;
constexpr size_t P_SC = WS_POOL + 128 * MiB;
constexpr size_t P_UT = WS_POOL + 704 * MiB;
constexpr size_t P_VT = WS_POOL + 768 * MiB;
constexpr size_t P_MEMN = WS_POOL + 608 * MiB;
constexpr size_t P_WQB = WS_POOL + 640 * MiB;
constexpr size_t P_SK = WS_POOL + 656 * MiB;
constexpr size_t WS_END = WS_POOL + 832 * MiB;
constexpr int CW_BAR = 4096, CW_CTR = 16384;

constexpr int RING_BYTES = 131072, LDSCTL_OFF = RING_BYTES, LDS_BYTES = 147456;

DI unsigned pk2(float lo, float hi) { f32x2 v = {lo, hi}; bf16x2_t b = __builtin_convertvector(v, bf16x2_t); return __builtin_bit_cast(unsigned, b); }
DI float bflo(unsigned u) { return __uint_as_float(u << 16); }
DI float bfhi(unsigned u) { return __uint_as_float(u & 0xffff0000u); }
DI float bf2f(bf16_t b) { return __uint_as_float(((unsigned)b) << 16); }
DI bf16_t f2bf(float f) { return (bf16_t)(pk2(f, 0.f) & 0xffffu); }
DI float dot2bf(unsigned a, unsigned b, float c) { return __builtin_amdgcn_fdot2_f32_bf16(__builtin_bit_cast(bf16x2_t, a), __builtin_bit_cast(bf16x2_t, b), c, false); }
DI float wave_sum(float v) {
#pragma unroll
    for (int o = 1; o < 64; o <<= 1) v += __shfl_xor(v, o);
    return v;
}
DI float gelu_erf(float v) { return 0.5f * v * (1.0f + erff(v * 0.70710678118654752f)); }
DI float swap32_max(float x) { auto rr = __builtin_amdgcn_permlane32_swap(__float_as_uint(x), __float_as_uint(x), false, false); return fmaxf(__uint_as_float(rr[0]), __uint_as_float(rr[1])); }
DI float swap32_sum(float x) { auto rr = __builtin_amdgcn_permlane32_swap(__float_as_uint(x), __float_as_uint(x), false, false); return __uint_as_float(rr[0]) + __uint_as_float(rr[1]); }
#define LDS_WAIT() asm volatile("s_waitcnt lgkmcnt(0)" ::: "memory")
#define VM_WAIT() asm volatile("s_waitcnt vmcnt(0)" ::: "memory")

#define XB_TMO      128
#define XB_XCNT(j)  (256  + 64 * (j))
#define XB_XSUB(j)  (1280 + 64 * (j))
#define XB_XGEN(j)  (2304 + 64 * (j))
#define XB_TOP      3328
#define XB_TOPGEN   3392
#define XCD_BAR_WORDS 3456
#define XB_SPIN_CAP (1u << 20)
DI unsigned xb_ld(unsigned* p)              { return __hip_atomic_load(p, __ATOMIC_RELAXED, __HIP_MEMORY_SCOPE_AGENT); }
DI unsigned xb_add(unsigned* p, unsigned v) { return __hip_atomic_fetch_add(p, v, __ATOMIC_RELAXED, __HIP_MEMORY_SCOPE_AGENT); }
DI unsigned xb_xcc_id() { return (unsigned)__builtin_amdgcn_s_getreg((3 << 11) | 20) & 0xFu; }
#define XB_SPIN(cond, bar) do { unsigned _sp = 0; while (cond) { __builtin_amdgcn_s_sleep(1); \
    if ((++_sp & 255u) == 0u) { if (xb_ld(&(bar)[XB_TMO])) break; if (_sp > XB_SPIN_CAP) { atomicAdd(&(bar)[XB_TMO], 1u); break; } } } } while (0)
struct XcdBarrier { unsigned* bar; unsigned x; volatile LAS unsigned* st; };
DI XcdBarrier xcd_barrier_post(unsigned* bar, volatile LAS unsigned* st) {
    XcdBarrier b; b.bar = bar; b.x = xb_xcc_id(); b.st = st;
    if (threadIdx.x == 0) (void)xb_add(&bar[XB_XCNT(b.x)], 1u);
    return b;
}
DI void xcd_barrier_complete(unsigned* bar, unsigned x, unsigned& nloc, unsigned& nx) {
    const unsigned G = gridDim.x * gridDim.y * gridDim.z;
    unsigned sum, cnt, mine, sp = 0u;
    for (;;) {
        sum = 0u; cnt = 0u; mine = 0u;
#pragma unroll
        for (unsigned j = 0; j < 16; ++j) { const unsigned c = xb_ld(&bar[XB_XCNT(j)]); sum += c; cnt += (c > 0u) ? 1u : 0u; mine = (j == x) ? c : mine; }
        if (sum == G) break;
        __builtin_amdgcn_s_sleep(1);
        if ((++sp & 255u) == 0u) { if (xb_ld(&bar[XB_TMO])) break; if (sp > XB_SPIN_CAP) { atomicAdd(&bar[XB_TMO], 1u); break; } }
    }
    nloc = mine > 0u ? mine : 1u; nx = cnt > 0u ? cnt : 1u;
}
DI void xcd_barrier(const XcdBarrier& b) {
    asm volatile("s_waitcnt vmcnt(0)" ::: "memory");
    __syncthreads();
    if (threadIdx.x == 0) {
        unsigned* bar = b.bar;
        __builtin_amdgcn_s_waitcnt(0);
        unsigned nloc = b.st[0], nx = b.st[1];
        if (nloc == 0u) { xcd_barrier_complete(bar, b.x, nloc, nx); b.st[0] = nloc; b.st[1] = nx; }
        const unsigned old = xb_add(&bar[XB_XSUB(b.x)], 1u);
        const unsigned gen = old / nloc;
        if (old + 1u == (gen + 1u) * nloc) {
            __builtin_amdgcn_fence(__ATOMIC_RELEASE, "agent");
            asm volatile("s_waitcnt vmcnt(0)" ::: "memory");
            const unsigned og = xb_add(&bar[XB_TOP], 1u);
            const unsigned tg = og / nx;
            if (og + 1u == (tg + 1u) * nx) xb_add(&bar[XB_TOPGEN], 1u);
            else XB_SPIN(xb_ld(&bar[XB_TOPGEN]) == tg, bar);
            __builtin_amdgcn_fence(__ATOMIC_ACQUIRE, "agent");
            xb_add(&bar[XB_XGEN(b.x)], 1u);
            asm volatile("s_waitcnt vmcnt(0)" ::: "memory");
        } else {
            XB_SPIN(xb_ld(&bar[XB_XGEN(b.x)]) == gen, bar);
            __builtin_amdgcn_fence(__ATOMIC_ACQUIRE, "agent");
            asm volatile("s_waitcnt vmcnt(0)" ::: "memory");
        }
    }
    __syncthreads();
}

namespace g8 {
constexpr int BM = 256, BK = 64, HALF = 128, HTB = HALF * BK * 2, STAGE_BYTES = 8 * HTB, NXCD = 8, WGM = 8;
DI int lds_byte(int r, int c) { const int st = (r >> 4) * 2 + (c >> 5), rr = r & 15, cc = c & 31, ob = rr * 64 + cc * 2; return st * 1024 + (ob ^ (((ob >> 9) & 1) << 5)); }
DI void stage_rc(int b, int& R, int& C) { const int st = b / 1024, sb = b % 1024, swz = sb ^ (((sb >> 9) & 1) << 5); R = (st >> 1) * 16 + swz / 64; C = (st & 1) * 32 + (swz % 64) / 2; }
DI int perm32(int rho) { const int n = rho >> 4, i = rho & 15; return 8 * (i >> 2) + 4 * n + (i & 3); }

struct Unit { int zo, zi, pm, pn; };
struct Desc { const bf16_t* A; const bf16_t* Bt; int lda, ldb, K, nM, nN, nZo, nZi; long sAo, sAi, sBo, sBi; };
DI bool next_unit(const Desc& g, int i, int G, int c, Unit& u) {
    const int per = g.nM * g.nN, nwg = per * g.nZo * g.nZi;
    const long L = (long)i * G + c; if (L >= nwg) return false;
    int wgid = (int)L; { const int q = nwg / NXCD, r = nwg % NXCD, xcd = wgid % NXCD, off = wgid / NXCD; wgid = (xcd < r ? xcd * (q + 1) : r * (q + 1) + (xcd - r) * q) + off; }
    const int z = wgid / per, w = wgid % per;
    u.zo = z / g.nZi; u.zi = z % g.nZi;
    const int nig = WGM * g.nN, gid = w / nig, fm = gid * WGM, gsz = (g.nM - fm) < WGM ? (g.nM - fm) : WGM;
    u.pm = fm + ((w % nig) % gsz); u.pn = (w % nig) / gsz; return true;
}

template <class Epi>
DI void gemm_phase(LAS unsigned char* lds, const Desc g, const Epi& E, int G, int c) {
    const int tid = threadIdx.x, wid = __builtin_amdgcn_readfirstlane(tid >> 6), lane = tid & 63, wr = wid >> 2, wc = wid & 3, fr = lane & 15, fq = lane >> 4;
    const int K = g.K, nt = K / BK;
    unsigned voffA[2], voffB[2];
#pragma unroll
    for (int i = 0; i < 2; ++i) { int R, C; stage_rc(tid * 16 + i * 8192, R, C); const int Rb = (R & ~31) + perm32(R & 31);
        voffA[i] = (unsigned)(R * g.lda + C) * 2u; voffB[i] = (unsigned)(Rb * g.ldb + C) * 2u; }
    const size_t kstep = (size_t)(BK * 2);
    const size_t hstepA = (size_t)HALF * g.lda * 2, hstepB = (size_t)HALF * g.ldb * 2;
    const unsigned ldsw = (unsigned)wid * 1024u;
    const int aoff = lds_byte(wr * 64 + fr, fq * 8), boff = lds_byte(wc * 32 + fr, fq * 8);
#define PG8_SA(b, h) (((b) * 2 + (h)) * HTB)
#define PG8_SB(b, h) ((4 + (b) * 2 + (h)) * HTB)
#define PG8_STAGE(bufoff, gbase, voff) do { _Pragma("unroll") for (int _i = 0; _i < 2; ++_i) \
        __builtin_amdgcn_global_load_lds((const unsigned*)((const char*)(gbase) + (voff)[_i]), (LAS unsigned*)(lds + (bufoff) + ldsw + _i * 8192), 16, 0, 0); } while (0)
#define PG8_LDA(dst, b, h) do { _Pragma("unroll") for (int m = 0; m < 4; ++m) _Pragma("unroll") for (int k = 0; k < 2; ++k) dst[m][k] = *(const LAS bf16x8*)(lds + PG8_SA(b, h) + aoff + m * 2048 + k * 1024); } while (0)
#define PG8_LDB(dst, b, h) do { _Pragma("unroll") for (int n = 0; n < 2; ++n) _Pragma("unroll") for (int k = 0; k < 2; ++k) dst[n][k] = *(const LAS bf16x8*)(lds + PG8_SB(b, h) + boff + n * 2048 + k * 1024); } while (0)
#define PG8_MMA(ai, bj, At, Bt) do { __builtin_amdgcn_s_setprio(1); _Pragma("unroll") for (int m = 0; m < 4; ++m) _Pragma("unroll") for (int n = 0; n < 2; ++n) _Pragma("unroll") for (int k = 0; k < 2; ++k) \
        acc[ai][bj][m][n] = __builtin_amdgcn_mfma_f32_16x16x32_bf16(Bt[n][k], At[m][k], acc[ai][bj][m][n], 0, 0, 0); __builtin_amdgcn_s_setprio(0); } while (0)
#define PG8_WAIT_V(n) asm volatile("s_waitcnt vmcnt(" #n ")" ::: "memory")
#define PG8_WAIT_L(n) asm volatile("s_waitcnt lgkmcnt(" #n ")" ::: "memory")
#define PG8_BAR __builtin_amdgcn_s_barrier()
#define PG8_SCHED __builtin_amdgcn_sched_barrier(0)
#define PG8_APTR(u) ((const char*)g.A + ((size_t)(u).zo * g.sAo + (size_t)(u).zi * g.sAi + (size_t)(u).pm * BM * g.lda) * 2)
#define PG8_BPTR(u) ((const char*)g.Bt + ((size_t)(u).zo * g.sBo + (size_t)(u).zi * g.sBi + (size_t)(u).pn * BM * g.ldb) * 2)
    Unit cur, nxt; int ui = 0;
    if (!next_unit(g, 0, G, c, cur)) return;
    f32x4 acc[2][2][4][2];
#pragma unroll
    for (int a = 0; a < 2; ++a)
#pragma unroll
        for (int b = 0; b < 2; ++b)
#pragma unroll
            for (int m = 0; m < 4; ++m)
#pragma unroll
                for (int n = 0; n < 2; ++n) acc[a][b][m][n] = (f32x4){0.f, 0.f, 0.f, 0.f};
    bf16x8 At[4][2], B0[2][2], B1[2][2];
    const char* cA = PG8_APTR(cur); const char* cB = PG8_BPTR(cur);
    PG8_STAGE(PG8_SB(0, 0), cB, voffB); PG8_STAGE(PG8_SA(0, 0), cA, voffA); PG8_STAGE(PG8_SB(0, 1), cB + hstepB, voffB); PG8_STAGE(PG8_SA(0, 1), cA + hstepA, voffA);
    if (wr == 1) PG8_BAR;
    PG8_WAIT_V(4); PG8_BAR;
    PG8_STAGE(PG8_SB(1, 0), cB + kstep, voffB); PG8_STAGE(PG8_SA(1, 0), cA + kstep, voffA); PG8_STAGE(PG8_SB(1, 1), cB + hstepB + kstep, voffB);
    PG8_WAIT_V(6); PG8_BAR;
    for (;;) {
        const bool has_next = next_unit(g, ui + 1, G, c, nxt);
        const char* nA = has_next ? PG8_APTR(nxt) : cA; const char* nB = has_next ? PG8_BPTR(nxt) : cB;
        for (int t = 0; t < nt; t += 2) {
            const bool last = (t == nt - 2);
            const char* a1 = cA + (size_t)(t + 1) * kstep;
            const char* a2 = last ? nA : cA + (size_t)(t + 2) * kstep; const char* b2 = last ? nB : cB + (size_t)(t + 2) * kstep;
            const char* a3 = a2 + kstep; const char* b3 = b2 + kstep;
            PG8_LDB(B0, 0, 0); PG8_SCHED; PG8_LDA(At, 0, 0); PG8_STAGE(PG8_SA(1, 1), a1 + hstepA, voffA);
            PG8_WAIT_L(8); PG8_BAR; PG8_WAIT_L(0); PG8_MMA(0, 0, At, B0); PG8_BAR; PG8_SCHED;
            PG8_LDB(B1, 0, 1); PG8_STAGE(PG8_SB(0, 0), b2, voffB);
            PG8_BAR; PG8_WAIT_L(0); PG8_MMA(0, 1, At, B1); PG8_BAR;
            PG8_LDA(At, 0, 1); PG8_STAGE(PG8_SA(0, 0), a2, voffA);
            PG8_BAR; PG8_WAIT_L(0); PG8_MMA(1, 0, At, B0); PG8_BAR; PG8_SCHED;
            PG8_STAGE(PG8_SB(0, 1), b2 + hstepB, voffB);
            PG8_WAIT_V(6); PG8_BAR; PG8_MMA(1, 1, At, B1); PG8_BAR;
            PG8_LDB(B0, 1, 0); PG8_SCHED; PG8_LDA(At, 1, 0); PG8_STAGE(PG8_SA(0, 1), a2 + hstepA, voffA);
            PG8_WAIT_L(8); PG8_BAR; PG8_WAIT_L(0); PG8_MMA(0, 0, At, B0); PG8_BAR; PG8_SCHED;
            PG8_LDB(B1, 1, 1); PG8_STAGE(PG8_SB(1, 0), b3, voffB);
            PG8_BAR; PG8_WAIT_L(0); PG8_MMA(0, 1, At, B1); PG8_BAR;
            PG8_LDA(At, 1, 1); PG8_STAGE(PG8_SA(1, 0), a3, voffA);
            PG8_BAR; PG8_WAIT_L(0); PG8_MMA(1, 0, At, B0); PG8_BAR; PG8_SCHED;
            PG8_STAGE(PG8_SB(1, 1), b3 + hstepB, voffB);
            PG8_WAIT_V(6); PG8_BAR; PG8_MMA(1, 1, At, B1); PG8_BAR;
        }
        {
            const int row0 = cur.pm * BM + wr * 64 + fr, col0 = cur.pn * BM + wc * 32 + 8 * fq;
#pragma unroll
            for (int ai = 0; ai < 2; ++ai)
#pragma unroll
                for (int m = 0; m < 4; ++m)
#pragma unroll
                    for (int bj = 0; bj < 2; ++bj) E.oct(cur.zo, cur.zi, row0 + ai * HALF + m * 16, col0 + bj * HALF, acc[ai][bj][m][0], acc[ai][bj][m][1]);
        }
        if (!has_next) break;
#pragma unroll
        for (int a = 0; a < 2; ++a)
#pragma unroll
            for (int b = 0; b < 2; ++b)
#pragma unroll
                for (int m = 0; m < 4; ++m)
#pragma unroll
                    for (int n = 0; n < 2; ++n) acc[a][b][m][n] = (f32x4){0.f, 0.f, 0.f, 0.f};
        cur = nxt; cA = nA; cB = nB; ++ui;
    }
    PG8_WAIT_V(0);
    if (wr == 0) PG8_BAR;
    PG8_BAR;
#undef PG8_SA
#undef PG8_SB
#undef PG8_STAGE
#undef PG8_LDA
#undef PG8_LDB
#undef PG8_MMA
#undef PG8_WAIT_V
#undef PG8_WAIT_L
#undef PG8_BAR
#undef PG8_SCHED
#undef PG8_APTR
#undef PG8_BPTR
}

template <class Epi>
DI void naive_gemm(const Desc g, const Epi& E, int G, int c) {
    const int M = g.nM * BM, N = g.nN * BM, n8 = N / 8, nZ = g.nZo * g.nZi;
    const long total = (long)nZ * M * n8;
    for (long idx = (long)c * NTHREADS + threadIdx.x; idx < total; idx += (long)G * NTHREADS) {
        const int col = (int)(idx % n8) * 8; const int row = (int)((idx / n8) % M); const int z = (int)(idx / ((long)n8 * M));
        const int zo = z / g.nZi, zi = z % g.nZi;
        const bf16_t* a = g.A + (size_t)zo * g.sAo + (size_t)zi * g.sAi + (size_t)row * g.lda;
        const bf16_t* b = g.Bt + (size_t)zo * g.sBo + (size_t)zi * g.sBi + (size_t)col * g.ldb;
        float acc[8];
#pragma unroll
        for (int j = 0; j < 8; ++j) acc[j] = 0.f;
        for (int k = 0; k < g.K; k += 8) {
            const u32x4 av = *(const u32x4*)(a + k);
#pragma unroll
            for (int j = 0; j < 8; ++j) { const u32x4 bv = *(const u32x4*)(b + (size_t)j * g.ldb + k);
                float s = acc[j]; s = dot2bf(av.x, bv.x, s); s = dot2bf(av.y, bv.y, s); s = dot2bf(av.z, bv.z, s); s = dot2bf(av.w, bv.w, s); acc[j] = s; }
        }
        E.oct(zo, zi, row, col, (f32x4){acc[0], acc[1], acc[2], acc[3]}, (f32x4){acc[4], acc[5], acc[6], acc[7]});
    }
}
template <class Epi>
DI void gemm(LAS unsigned char* lds, const Desc g, const Epi& E, int G, int c) {
#if !EN_GEMM
    return;
#elif FAST_GEMM
    gemm_phase(lds, g, E, G, c);
#else
    naive_gemm(g, E, G, c);
#endif
}
}

struct EpiBf16 {
    bf16_t* O; long ldc, sZo, sZi; float scale;
    DI void oct(int zo, int zi, int row, int col, f32x4 lo, f32x4 hi) const {
        bf16_t* p = O + (size_t)zo * sZo + (size_t)zi * sZi + (size_t)row * ldc + col;
        u32x4 w; w.x = pk2(lo[0] * scale, lo[1] * scale); w.y = pk2(lo[2] * scale, lo[3] * scale); w.z = pk2(hi[0] * scale, hi[1] * scale); w.w = pk2(hi[2] * scale, hi[3] * scale);
        *(u32x4*)p = w;
    }
};
struct EpiF32 {
    float* O; long ldc, sZo, sZi; float scale;
    DI void oct(int zo, int zi, int row, int col, f32x4 lo, f32x4 hi) const {
        float* p = O + (size_t)zo * sZo + (size_t)zi * sZi + (size_t)row * ldc + col;
        *(f32x4*)p = lo * scale; *(f32x4*)(p + 4) = hi * scale;
    }
};
struct EpiResid {
    const float* resid; float* out; long ldc;
    DI void oct(int, int, int row, int col, f32x4 lo, f32x4 hi) const {
        const size_t o = (size_t)row * ldc + col;
        const f32x4 r0 = *(const f32x4*)(resid + o), r1 = *(const f32x4*)(resid + o + 4);
        *(f32x4*)(out + o) = r0 + lo; *(f32x4*)(out + o + 4) = r1 + hi;
    }
};
template <int MODE> struct EpiRope {
    bf16_t* O; long ldc; const int* pos; const f32x2* tab;
    DI void oct(int, int, int row, int col, f32x4 lo, f32x4 hi) const {
        bool rope; int j0;
        if (MODE == 0) { rope = col < 2 * DIFF_W; j0 = col & 63; } else { const int c = col % 192; rope = c >= 128; j0 = c - 128; }
        if (rope) {
            int p = pos[row]; p = p < 0 ? 0 : (p > ROPE_POS - 1 ? ROPE_POS - 1 : p);
            const f32x4* tp = (const f32x4*)(tab + (size_t)p * 32 + (j0 >> 1));
            const f32x4 t0 = tp[0], t1 = tp[1];
            f32x4 a = lo, b = hi;
            lo[0] = a[0] * t0[0] - a[1] * t0[1]; lo[1] = a[1] * t0[0] + a[0] * t0[1];
            lo[2] = a[2] * t0[2] - a[3] * t0[3]; lo[3] = a[3] * t0[2] + a[2] * t0[3];
            hi[0] = b[0] * t1[0] - b[1] * t1[1]; hi[1] = b[1] * t1[0] + b[0] * t1[1];
            hi[2] = b[2] * t1[2] - b[3] * t1[3]; hi[3] = b[3] * t1[2] + b[2] * t1[3];
        }
        u32x4 w; w.x = pk2(lo[0], lo[1]); w.y = pk2(lo[2], lo[3]); w.z = pk2(hi[0], hi[1]); w.w = pk2(hi[2], hi[3]);
        *(u32x4*)(O + (size_t)row * ldc + col) = w;
    }
};
struct EpiGlu {
    const bf16_t* gbuf; const float* bias; bf16_t* out;
    DI void oct(int, int, int row, int col, f32x4 lo, f32x4 hi) const {
        const u32x4 gv = *(const u32x4*)(gbuf + (size_t)row * S5_W + col);
        const f32x4 b0 = *(const f32x4*)(bias + col), b1 = *(const f32x4*)(bias + col + 4);
        float g[8] = {bflo(gv.x), bfhi(gv.x), bflo(gv.y), bfhi(gv.y), bflo(gv.z), bfhi(gv.z), bflo(gv.w), bfhi(gv.w)};
        float a[8] = {lo[0] + b0[0], lo[1] + b0[1], lo[2] + b0[2], lo[3] + b0[3], hi[0] + b1[0], hi[1] + b1[1], hi[2] + b1[2], hi[3] + b1[3]};
        float r[8];
#pragma unroll
        for (int j = 0; j < 8; ++j) r[j] = g[j] / (1.0f + __expf(-a[j]));
        u32x4 w; w.x = pk2(r[0], r[1]); w.y = pk2(r[2], r[3]); w.z = pk2(r[4], r[5]); w.w = pk2(r[6], r[7]);
        *(u32x4*)(out + (size_t)row * DM + DIFF_W + col) = w;
    }
};

struct Params {
    const float* in[39];
    float* out; unsigned char* ws;
    int ph_lo, ph_hi;
};
enum { I_X = 0, I_MEM, I_POS, I_AB_NORM, I_AB_WIN, I_AB_WOUT, I_LQ1, I_LK1, I_LQ2, I_LK2, I_SUBLN, I_S5_ARE, I_S5_AIM, I_S5_LOGSTEP, I_S5_BRE, I_S5_BIM, I_S5_CRE, I_S5_CIM, I_S5_D,
       I_S5_WGLU, I_S5_BGLU, I_MLA_NORM, I_MLA_WIN, I_MLA_QNORM, I_MLA_KVNORM, I_MLA_WUQ, I_MLA_WUKV, I_MLA_WO, I_XA_NORM, I_XA_MEMNORM, I_XA_WQ, I_XA_WKV, I_XA_WO, I_FFN_NORM,
       I_PEER_WQ, I_PEER_SK, I_PEER_U, I_PEER_V, I_FINAL_NORM };

struct Ctx { LAS unsigned char* lds; int tid, lane, wave, blk, G; };

DI void rms_rows_2048(const Ctx& C, const float* src, const float* gain, bf16_t* dst, int nrows) {
    for (int r = C.blk * NWAVES + C.wave; r < nrows; r += C.G * NWAVES) {
        const f32x4* xr = (const f32x4*)(src + (size_t)r * DM) + C.lane;
        f32x4 v[8]; float ss = 0.f;
#pragma unroll
        for (int j = 0; j < 8; ++j) { v[j] = xr[64 * j]; ss += (v[j][0] * v[j][0] + v[j][1] * v[j][1]) + (v[j][2] * v[j][2] + v[j][3] * v[j][3]); }
        const float sc = rsqrtf(wave_sum(ss) * (1.0f / DM) + NORM_EPS);
        u32x2* o = (u32x2*)(dst + (size_t)r * DM) + C.lane;
#pragma unroll
        for (int j = 0; j < 8; ++j) { const f32x4 g = *((const f32x4*)gain + C.lane + 64 * j);
            u32x2 w; w.x = pk2(v[j][0] * sc * g[0], v[j][1] * sc * g[1]); w.y = pk2(v[j][2] * sc * g[2], v[j][3] * sc * g[3]); o[64 * j] = w; }
    }
}
DI void rms_rows_final(const Ctx& C, float* x, const float* gain, int nrows) {
    for (int r = C.blk * NWAVES + C.wave; r < nrows; r += C.G * NWAVES) {
        f32x4* xr = (f32x4*)(x + (size_t)r * DM) + C.lane;
        f32x4 v[8]; float ss = 0.f;
#pragma unroll
        for (int j = 0; j < 8; ++j) { v[j] = xr[64 * j]; ss += (v[j][0] * v[j][0] + v[j][1] * v[j][1]) + (v[j][2] * v[j][2] + v[j][3] * v[j][3]); }
        const float sc = rsqrtf(wave_sum(ss) * (1.0f / DM) + NORM_EPS);
#pragma unroll
        for (int j = 0; j < 8; ++j) { const f32x4 g = *((const f32x4*)gain + C.lane + 64 * j); xr[64 * j] = v[j] * sc * g; }
    }
}

DI int srccol(int kind, int n) {
    if (kind == 1) { if (n < 2 * DIFF_W) { const int j = n & 63; return (n & ~63) + (j >> 1) + 32 * (j & 1); } return n; }
    if (kind == 2) { if (n >= MLA_IN) return -1; if (n >= 1024) { const int j = n - 1024; return 1024 + (j >> 1) + 32 * (j & 1); } return n; }
    if (kind == 3) { const int c = n % 192; if (c >= 128) { const int j = c - 128; return n - c + 128 + (j >> 1) + 32 * (j & 1); } return n; }
    return n;
}
DI void transpose_item(const float* W, int K, int Nsrc, bf16_t* Wt, int nblk, int kind, LAS float* scr, int item, int lane) {
    const int kb = item / nblk, nb = item % nblk, k0 = 64 * kb, n0 = 32 * nb;
    const int src = srccol(kind, n0 + (lane & 31));
#pragma unroll 8
    for (int i = 0; i < 32; ++i) { const int kk = 2 * i + (lane >> 5); scr[kk * 33 + (lane & 31)] = (src >= 0) ? W[(size_t)(k0 + kk) * Nsrc + src] : 0.f; }
    LDS_WAIT(); asm volatile("" ::: "memory");
    const int c = lane & 7;
#pragma unroll
    for (int j = 0; j < 4; ++j) { const int n = (lane >> 3) + 8 * j; const LAS float* s = scr + (8 * c) * 33 + n;
        u32x4 o; o.x = pk2(s[0 * 33], s[1 * 33]); o.y = pk2(s[2 * 33], s[3 * 33]); o.z = pk2(s[4 * 33], s[5 * 33]); o.w = pk2(s[6 * 33], s[7 * 33]);
        *(u32x4*)(Wt + (size_t)(n0 + n) * K + k0 + 8 * c) = o; }
    LDS_WAIT(); asm volatile("" ::: "memory");
}
DI void cvt_bf16(const Ctx& C, const float* src, bf16_t* dst, size_t n8) {
    for (size_t i = (size_t)C.blk * NTHREADS + C.tid; i < n8; i += (size_t)C.G * NTHREADS) {
        const f32x4 a = *(const f32x4*)(src + i * 8), b = *(const f32x4*)(src + i * 8 + 4);
        u32x4 w; w.x = pk2(a[0], a[1]); w.y = pk2(a[2], a[3]); w.z = pk2(b[0], b[1]); w.w = pk2(b[2], b[3]);
        *(u32x4*)(dst + i * 8) = w;
    }
}


DI void cvt_fp8_rows(const Ctx& C, const float* src, unsigned char* dst, float* isc, int nrows) {
    for (int r = C.blk * NWAVES + C.wave; r < nrows; r += C.G * NWAVES) {
        const f32x4* xr = (const f32x4*)(src + (size_t)r * DM) + C.lane;
        f32x4 v[8]; float am = 0.f;
#pragma unroll
        for (int j = 0; j < 8; ++j) { v[j] = xr[64 * j]; am = fmaxf(am, fmaxf(fmaxf(fabsf(v[j][0]), fabsf(v[j][1])), fmaxf(fabsf(v[j][2]), fabsf(v[j][3])))); }
#pragma unroll
        for (int o = 1; o < 64; o <<= 1) am = fmaxf(am, __shfl_xor(am, o));
        const float e = am > 0.f ? floorf(log2f(448.0f / am)) : 0.f;
        const float scale = exp2f(e);
        if (C.lane == 0) isc[r] = exp2f(-e);
        unsigned* o = (unsigned*)(dst + (size_t)r * DM) + C.lane;
#pragma unroll
        for (int j = 0; j < 8; ++j) { int w = 0; w = __builtin_amdgcn_cvt_pk_fp8_f32(v[j][0] * scale, v[j][1] * scale, w, false); w = __builtin_amdgcn_cvt_pk_fp8_f32(v[j][2] * scale, v[j][3] * scale, w, true); o[64 * j] = (unsigned)w; }
    }
}

DI void convert_tables(const Ctx& C, const Params& P, int l) {
    unsigned char* ws = P.ws;
#if PEER_FP8
    cvt_fp8_rows(C, P.in[I_PEER_U] + (size_t)l * PEER_NE * DM, ws + P_UT, (float*)(ws + P_UT + 32 * MiB), PEER_NE);
    cvt_fp8_rows(C, P.in[I_PEER_V] + (size_t)l * PEER_NE * DM, ws + P_VT, (float*)(ws + P_VT + 32 * MiB), PEER_NE);
#else
    cvt_bf16(C, P.in[I_PEER_U] + (size_t)l * PEER_NE * DM, (bf16_t*)(ws + P_UT), (size_t)PEER_NE * DM / 8);
    cvt_bf16(C, P.in[I_PEER_V] + (size_t)l * PEER_NE * DM, (bf16_t*)(ws + P_VT), (size_t)PEER_NE * DM / 8);
#endif
}

DI void phase_prologue(const Ctx& C, const Params& P) {
    unsigned char* ws = P.ws;
    LAS float* scr = (LAS float*)(C.lds + C.wave * 8448);
    const int gw = C.blk * NWAVES + C.wave, NGW = C.G * NWAVES;
    int base = 0;
#define TJOB(Wp, K_, Nsrc_, Nout_, kind_, dst_) do { const int nblk_ = (Nout_) / 32, nit_ = ((K_) / 64) * nblk_; \
        int first_ = (gw - base % NGW + NGW) % NGW; \
        for (int it = first_; it < nit_; it += NGW) transpose_item((Wp), (K_), (Nsrc_), (bf16_t*)(dst_), nblk_, (kind_), scr, it, C.lane); base += nit_; } while (0)
    TJOB(P.in[I_AB_WIN], DM, AB_IN, AB_IN, 1, ws + WS_ABIN_T);
    TJOB(P.in[I_AB_WOUT], DM, DM, DM, 0, ws + WS_ABOUT_T);
    TJOB(P.in[I_S5_WGLU], S5_W, S5_W, S5_W, 0, ws + WS_GLU_T);
    TJOB(P.in[I_MLA_WIN], DM, MLA_IN, MLA_IN_PAD, 2, ws + WS_MLAIN_T);
    TJOB(P.in[I_MLA_WUQ], MLA_QR, 3072, 3072, 3, ws + WS_UQ_T);
    TJOB(P.in[I_MLA_WUKV], MLA_KVR, 4096, 4096, 0, ws + WS_UKV_T);
    TJOB(P.in[I_MLA_WO], DM, DM, DM, 0, ws + WS_MLAO_T);
    for (int l = 0; l < 2; ++l) {
        TJOB(P.in[I_XA_WQ] + (size_t)l * DM * DM, DM, DM, DM, 0, ws + WS_LW + l * LW_STRIDE + LW_XQ);
        TJOB(P.in[I_XA_WKV] + (size_t)l * DM * 2 * DM, DM, 2 * DM, 2 * DM, 0, ws + WS_LW + l * LW_STRIDE + LW_XKV);
        TJOB(P.in[I_XA_WO] + (size_t)l * DM * DM, DM, DM, DM, 0, ws + WS_LW + l * LW_STRIDE + LW_XO);
    }
#undef TJOB
    {
        f32x2* tab = (f32x2*)(ws + WS_ROPE);
        for (int i = C.blk * NTHREADS + C.tid; i < ROPE_POS * 32; i += C.G * NTHREADS) {
            const int p = i >> 5, f = i & 31;
            const float inv = powf(10000.0f, -(float)f * (2.0f / 64.0f));
            const float ang = (float)p * inv;
            tab[i] = (f32x2){(float)cos((double)ang), (float)sin((double)ang)};
        }
    }
    cvt_bf16(C, P.in[I_PEER_WQ], (bf16_t*)(ws + P_WQB), (size_t)2 * DM * DM / 8);
    {
        bf16_t* sk = (bf16_t*)(ws + P_SK); const float* skin = P.in[I_PEER_SK];
        for (int i = C.blk * NTHREADS + C.tid; i < 2 * 8 * 256 * 256 / 8; i += C.G * NTHREADS) {
            const int q8 = (i & 31) * 8, np = (i >> 5) & 255, lh = i >> 13;
            const int c = np >> 7, n = np & 127, c2 = q8 >> 7, q = q8 & 127;
            u32x4 w = {0u, 0u, 0u, 0u};
            if (c == c2) { const float* s = skin + ((((size_t)lh * 2 + c) * 128 + n) * 128 + q);
                const f32x4 a = *(const f32x4*)s, b = *(const f32x4*)(s + 4);
                w.x = pk2(a[0], a[1]); w.y = pk2(a[2], a[3]); w.z = pk2(b[0], b[1]); w.w = pk2(b[2], b[3]); }
            *(u32x4*)(sk + (size_t)i * 8) = w;
        }
    }
    convert_tables(C, P, 0);
    for (int l = 0; l < 2; ++l) rms_rows_2048(C, P.in[I_MEM], P.in[I_XA_MEMNORM] + l * DM, (bf16_t*)(ws + P_MEMN) + (size_t)l * MT * DM, MT);
}

DI void phase_s5(const Ctx& C, const Params& P) {
    unsigned char* ws = P.ws;
    const bf16_t* proj = (const bf16_t*)(ws + P_PROJ); bf16_t* gbuf = (bf16_t*)(ws + P_GBUF);
    LAS unsigned char* my = C.lds + C.wave * 8192;
    LAS float* U = (LAS float*)my;
    LAS bf16_t* H = (LAS bf16_t*)(my + 1024);
    const int lane = C.lane, n = lane;
    for (int task = C.wave * C.G + C.blk; task < BATCH * 32; task += C.G * NWAVES) {
        const int b = task >> 5, g = task & 31;
        const float a_re = P.in[I_S5_ARE][g * 64 + n], a_im = P.in[I_S5_AIM][g * 64 + n];
        const float step = expf(P.in[I_S5_LOGSTEP][g]);
        const float mag = expf(a_re * step);
        const float ab_re = mag * cosf(a_im * step), ab_im = mag * sinf(a_im * step);
        const float den = a_re * a_re + a_im * a_im, num_re = ab_re - 1.0f;
        const float f_re = (num_re * a_re + ab_im * a_im) / den, f_im = (ab_im * a_re - num_re * a_im) / den;
        float bbr[16], bbi[16];
        {
            const float* br = P.in[I_S5_BRE] + ((size_t)g * 64 + n) * 16; const float* bi = P.in[I_S5_BIM] + ((size_t)g * 64 + n) * 16;
#pragma unroll
            for (int p = 0; p < 16; ++p) { const float x = br[p], y = bi[p]; bbr[p] = f_re * x - f_im * y; bbi[p] = f_re * y + f_im * x; }
        }
        bf16x8 cf[4];
        {
            const int p = lane & 15, kq = lane >> 4;
#pragma unroll
            for (int kk = 0; kk < 4; ++kk) {
                const int k = 32 * kk + 8 * kq; const bool im = k >= 64;
                const float* src = (im ? P.in[I_S5_CIM] : P.in[I_S5_CRE]) + ((size_t)g * 16 + p) * 64 + (k & 63);
                const float sg = im ? -1.f : 1.f;
                const f32x4 a = *(const f32x4*)src, bq = *(const f32x4*)(src + 4);
                u32x4 w; w.x = pk2(sg * a[0], sg * a[1]); w.y = pk2(sg * a[2], sg * a[3]); w.z = pk2(sg * bq[0], sg * bq[1]); w.w = pk2(sg * bq[2], sg * bq[3]);
                cf[kk] = __builtin_bit_cast(bf16x8, w);
            }
        }
        const float dcoef = P.in[I_S5_D][g * 16 + (lane & 15)];
        float h_re = 0.f, h_im = 0.f;
        const bf16_t* ub = proj + (size_t)b * SEQ * AB_IN + 3 * DIFF_W + g * 16;
        for (int s0 = 0; s0 < SEQ; s0 += 16) {
            {
                const int st = lane >> 2, pp = (lane & 3) * 4;
                const u32x2 uv = *(const u32x2*)(ub + (size_t)(s0 + st) * AB_IN + pp);
                *(LAS f32x4*)(U + st * 16 + pp) = (f32x4){bflo(uv.x), bfhi(uv.x), bflo(uv.y), bfhi(uv.y)};
            }
            LDS_WAIT(); asm volatile("" ::: "memory");
#pragma unroll 4
            for (int st = 0; st < 16; ++st) {
                const f32x4 u0 = *(const LAS f32x4*)(U + st * 16), u1 = *(const LAS f32x4*)(U + st * 16 + 4), u2 = *(const LAS f32x4*)(U + st * 16 + 8), u3 = *(const LAS f32x4*)(U + st * 16 + 12);
                const float uu[16] = {u0[0], u0[1], u0[2], u0[3], u1[0], u1[1], u1[2], u1[3], u2[0], u2[1], u2[2], u2[3], u3[0], u3[1], u3[2], u3[3]};
                float br = 0.f, bi = 0.f;
#pragma unroll
                for (int p = 0; p < 16; ++p) { br = fmaf(bbr[p], uu[p], br); bi = fmaf(bbi[p], uu[p], bi); }
                const float nr = ab_re * h_re - ab_im * h_im + br, ni = ab_re * h_im + ab_im * h_re + bi;
                h_re = nr; h_im = ni;
                H[st * 136 + n] = f2bf(h_re); H[st * 136 + 64 + n] = f2bf(h_im);
            }
            LDS_WAIT(); asm volatile("" ::: "memory");
            f32x4 acc = {0.f, 0.f, 0.f, 0.f};
#pragma unroll
            for (int kk = 0; kk < 4; ++kk) {
                const bf16x8 af = *(const LAS bf16x8*)((LAS unsigned char*)H + (lane & 15) * 272 + (32 * kk + 8 * (lane >> 4)) * 2);
                acc = __builtin_amdgcn_mfma_f32_16x16x32_bf16(af, cf[kk], acc, 0, 0, 0);
            }
#pragma unroll
            for (int r = 0; r < 4; ++r) {
                const int st = (lane >> 4) * 4 + r, p = lane & 15;
                const float y = acc[r] + dcoef * U[st * 16 + p];
                gbuf[(size_t)(b * SEQ + s0 + st) * S5_W + g * 16 + p] = f2bf(gelu_erf(y));
            }
            LDS_WAIT(); asm volatile("" ::: "memory");
        }
    }
}

struct AttnArgs { const bf16_t* Qn; const bf16_t* Qr; const bf16_t* Kn; const bf16_t* Kr; const bf16_t* V; int ldq, ldkn, ldkr, ldv; };
DI int crow(int r, int hi) { return (r & 3) + 8 * (r >> 2) + 4 * hi; }
template <int DK> DI int koff(int row, int ch) { return DK == 64 ? row * 128 + 16 * (ch ^ ((row >> 1) & 7)) : row * 256 + 16 * (ch ^ (row & 15)); }
DI int voff(int row, int ch) { return 256 * row + 16 * (ch ^ (((row & 3) << 2) | ((row >> 2) & 3))); }
DI bf16x8 pack8(const f32x16& p, int s) {
    u32x4 w; w.x = pk2(p[8 * s + 0], p[8 * s + 1]); w.y = pk2(p[8 * s + 2], p[8 * s + 3]); w.z = pk2(p[8 * s + 4], p[8 * s + 5]); w.w = pk2(p[8 * s + 6], p[8 * s + 7]);
    return __builtin_bit_cast(bf16x8, w);
}
DI s16x4 vtr(const LAS unsigned char* p) { return __builtin_bit_cast(s16x4, __builtin_amdgcn_ds_read_tr16_b64_v4i16((LAS s16x4*)p)); }

template <int DKN, int DKR>
DI void attn_core(const AttnArgs& a, int q0, LAS unsigned char* lds, float scale, f32x16 (&o)[4]) {
    const int tid = threadIdx.x, wid = __builtin_amdgcn_readfirstlane(tid >> 6), lane = tid & 63, r32 = lane & 31, hi = lane >> 5;
    constexpr int CN = DKN / 8, NLK = CN * 64 / NTHREADS, KNB = 64 * DKN * 2, KRB = 64 * DKR * 2, VOFF = KNB + KRB, BUF = VOFF + 16384;
    static_assert(2 * BUF <= RING_BYTES, "attention LDS");
    bf16x8 qn[DKN / 16]; bf16x8 qr[DKR ? DKR / 16 : 1];
    {
        const bf16_t* qp = a.Qn + (size_t)(q0 + 32 * wid + r32) * a.ldq + hi * 8;
#pragma unroll
        for (int d0 = 0; d0 < DKN / 16; ++d0) qn[d0] = *(const bf16x8*)(qp + d0 * 16);
        if (DKR) { const bf16_t* qp2 = a.Qr + (size_t)(q0 + 32 * wid + r32) * a.ldq + hi * 8;
#pragma unroll
            for (int d0 = 0; d0 < DKR / 16; ++d0) qr[d0] = *(const bf16x8*)(qp2 + d0 * 16); }
    }
    const int NT = (q0 + 256) / 64, NTw = (q0 + 32 * wid + 31) / 64 + 1;
    u32x4 skn[NLK], skr, sv[2];
#define AT_LOAD(t) do { _Pragma("unroll") for (int i_ = 0; i_ < NLK; ++i_) { const int id_ = tid + NTHREADS * i_, row_ = id_ / CN, ch_ = id_ % CN; \
            skn[i_] = *(const u32x4*)(a.Kn + (size_t)((t) * 64 + row_) * a.ldkn + ch_ * 8); } \
        if (DKR) { const int row_ = tid >> 3, ch_ = tid & 7; skr = *(const u32x4*)(a.Kr + (size_t)((t) * 64 + row_) * a.ldkr + ch_ * 8); } \
        _Pragma("unroll") for (int i_ = 0; i_ < 2; ++i_) { const int id_ = tid + NTHREADS * i_, row_ = id_ >> 4, ch_ = id_ & 15; \
            sv[i_] = *(const u32x4*)(a.V + (size_t)((t) * 64 + row_) * a.ldv + ch_ * 8); } } while (0)
#define AT_WRITE(bf) do { LAS unsigned char* bb_ = lds + (bf) * BUF; \
        _Pragma("unroll") for (int i_ = 0; i_ < NLK; ++i_) { const int id_ = tid + NTHREADS * i_, row_ = id_ / CN, ch_ = id_ % CN; *(LAS u32x4*)(bb_ + koff<DKN>(row_, ch_)) = skn[i_]; } \
        if (DKR) { const int row_ = tid >> 3, ch_ = tid & 7; *(LAS u32x4*)(bb_ + KNB + koff<64>(row_, ch_)) = skr; } \
        _Pragma("unroll") for (int i_ = 0; i_ < 2; ++i_) { const int id_ = tid + NTHREADS * i_, row_ = id_ >> 4, ch_ = id_ & 15; *(LAS u32x4*)(bb_ + VOFF + voff(row_, ch_)) = sv[i_]; } } while (0)
    const float Cs = scale * 1.4426950408889634f;
    float m_run = -1e30f, l_run = 0.f;
#pragma unroll
    for (int blk = 0; blk < 4; ++blk)
#pragma unroll
        for (int r = 0; r < 16; ++r) o[blk][r] = 0.f;
    AT_LOAD(0); AT_WRITE(0); if (NT > 1) AT_LOAD(1);
    for (int t = 0; t < NT; ++t) {
        __syncthreads();
        if (t + 1 < NT) AT_WRITE((t + 1) & 1);
        if (t + 2 < NT) AT_LOAD(t + 2);
        if (t < NTw) {
            const LAS unsigned char* base = lds + (t & 1) * BUF;
            int r32v = r32, lanev = lane; asm volatile("" : "+v"(r32v), "+v"(lanev));
            int vb[4][2];
            {
                const int i = lanev & 15, q_ = i >> 2, p_ = i & 3, grp1 = (lanev >> 4) & 1, hv = lanev >> 5, low2 = 2 * grp1 + (p_ >> 1);
#pragma unroll
                for (int blk = 0; blk < 4; ++blk)
#pragma unroll
                    for (int x = 0; x < 2; ++x) vb[blk][x] = VOFF + 256 * (8 * x + 4 * hv + q_) + 16 * (4 * (blk ^ q_) + (low2 ^ (hv + 2 * x))) + 8 * (p_ & 1);
            }
            f32x16 p0, p1;
#pragma unroll
            for (int r = 0; r < 16; ++r) { p0[r] = 0.f; p1[r] = 0.f; }
#pragma unroll
            for (int d0 = 0; d0 < DKN / 16; ++d0) {
                const bf16x8 b0 = *(const LAS bf16x8*)(base + koff<DKN>(r32v, 2 * d0 + hi)), b1 = *(const LAS bf16x8*)(base + koff<DKN>(32 + r32v, 2 * d0 + hi));
                p0 = __builtin_amdgcn_mfma_f32_32x32x16_bf16(b0, qn[d0], p0, 0, 0, 0); p1 = __builtin_amdgcn_mfma_f32_32x32x16_bf16(b1, qn[d0], p1, 0, 0, 0);
            }
            if (DKR) {
#pragma unroll
                for (int d0 = 0; d0 < DKR / 16; ++d0) {
                    const bf16x8 b0 = *(const LAS bf16x8*)(base + KNB + koff<64>(r32v, 2 * d0 + hi)), b1 = *(const LAS bf16x8*)(base + KNB + koff<64>(32 + r32v, 2 * d0 + hi));
                    p0 = __builtin_amdgcn_mfma_f32_32x32x16_bf16(b0, qr[d0], p0, 0, 0, 0); p1 = __builtin_amdgcn_mfma_f32_32x32x16_bf16(b1, qr[d0], p1, 0, 0, 0);
                }
            }
            if (t == NTw - 1) {
                const int qrel = q0 + 32 * wid + r32 - 64 * t;
#pragma unroll
                for (int r = 0; r < 16; ++r) { const int kv = crow(r, hi); if (kv > qrel) p0[r] = -INFINITY; if (kv + 32 > qrel) p1[r] = -INFINITY; }
            }
            float pmax = p0[0];
#pragma unroll
            for (int r = 1; r < 16; ++r) pmax = fmaxf(pmax, p0[r]);
#pragma unroll
            for (int r = 0; r < 16; ++r) pmax = fmaxf(pmax, p1[r]);
            pmax = swap32_max(pmax);
            const float mn = fmaxf(m_run, pmax);
            const float alpha = __builtin_amdgcn_exp2f((m_run - mn) * Cs);
            m_run = mn;
            const float mnC = -mn * Cs;
            float ps = 0.f;
#pragma unroll
            for (int r = 0; r < 16; ++r) { p0[r] = __builtin_amdgcn_exp2f(fmaf(p0[r], Cs, mnC)); p1[r] = __builtin_amdgcn_exp2f(fmaf(p1[r], Cs, mnC)); ps += p0[r] + p1[r]; }
            l_run = l_run * alpha + ps;
            if (!__all(alpha == 1.0f)) {
#pragma unroll
                for (int blk = 0; blk < 4; ++blk)
#pragma unroll
                    for (int r = 0; r < 16; ++r) o[blk][r] *= alpha;
            }
            bf16x8 pb[4]; pb[0] = pack8(p0, 0); pb[1] = pack8(p0, 1); pb[2] = pack8(p1, 0); pb[3] = pack8(p1, 1);
#pragma unroll
            for (int blk = 0; blk < 4; ++blk) {
                s16x4 lo[4], hh[4];
#pragma unroll
                for (int ks = 0; ks < 4; ++ks) { lo[ks] = vtr(base + vb[blk][0] + 4096 * ks); hh[ks] = vtr(base + vb[blk][1] + 4096 * ks); }
#pragma unroll
                for (int ks = 0; ks < 4; ++ks) {
                    const bf16x8 af = {lo[ks][0], lo[ks][1], lo[ks][2], lo[ks][3], hh[ks][0], hh[ks][1], hh[ks][2], hh[ks][3]};
                    o[blk] = __builtin_amdgcn_mfma_f32_32x32x16_bf16(af, pb[ks], o[blk], 0, 0, 0);
                }
                __builtin_amdgcn_sched_barrier(0);
            }
        }
    }
    __syncthreads();
    const float linv = 1.0f / swap32_sum(l_run);
#pragma unroll
    for (int blk = 0; blk < 4; ++blk)
#pragma unroll
        for (int r = 0; r < 16; ++r) o[blk][r] *= linv;
#undef AT_LOAD
#undef AT_WRITE
}
DI void attn_store(const f32x16 (&o)[4], bf16_t* dst, int ld, int q0) {
    const int tid = threadIdx.x, wid = tid >> 6, lane = tid & 63, r32 = lane & 31, hi = lane >> 5;
    bf16_t* rp = dst + (size_t)(q0 + 32 * wid + r32) * ld;
#pragma unroll
    for (int blk = 0; blk < 4; ++blk)
#pragma unroll
        for (int g = 0; g < 4; ++g) {
            u32x2 w; w.x = pk2(o[blk][4 * g], o[blk][4 * g + 1]); w.y = pk2(o[blk][4 * g + 2], o[blk][4 * g + 3]);
            *(u32x2*)(rp + 32 * blk + 8 * g + 4 * hi) = w;
        }
}
DI int queue_pop(const Ctx& C, unsigned* ctr, int total) {
    volatile LAS int* slot = (volatile LAS int*)(C.lds + LDSCTL_OFF + 64);
    __syncthreads();
    if (C.tid == 0) *slot = (int)__hip_atomic_fetch_add(ctr, 1u, __ATOMIC_RELAXED, __HIP_MEMORY_SCOPE_AGENT);
    __syncthreads();
    const int u = *slot;
    return u < total ? u : -1;
}
DI float diff_lambda(const Params& P) {
    float s1 = 0.f, s2 = 0.f;
    for (int i = 0; i < 64; ++i) { s1 += P.in[I_LQ1][i] * P.in[I_LK1][i]; s2 += P.in[I_LQ2][i] * P.in[I_LK2][i]; }
    return expf(s1) - expf(s2) + 0.2f;
}

#if FAST_ATTN
DI void phase_diff_attn(const Ctx& C, const Params& P) {
    unsigned char* ws = P.ws;
    const bf16_t* proj = (const bf16_t*)(ws + P_PROJ); bf16_t* concat = (bf16_t*)(ws + P_CONCAT);
    unsigned* ctr = (unsigned*)(ws + WS_CTL) + CW_CTR;
    const float lam = diff_lambda(P);
    const int NBH = BATCH * DIFF_HEADS, total = NBH * 8;
    const int lane = C.lane, r32 = lane & 31, hi = lane >> 5;
    for (;;) {
        const int u = queue_pop(C, ctr, total); if (u < 0) break;
        const int qb = 7 - u / NBH, bh = u % NBH, b = bh / DIFF_HEADS, h = bh % DIFF_HEADS;
        const bf16_t* base = proj + (size_t)b * SEQ * AB_IN;
        AttnArgs a; a.ldq = AB_IN; a.ldkn = AB_IN; a.ldkr = 0; a.ldv = AB_IN; a.Qr = nullptr; a.Kr = nullptr;
        a.V = base + 2 * DIFF_W + h * 128;
        f32x16 o2[4];
        bf16_t* dst = concat + (size_t)b * SEQ * DM + h * 128;
        a.Qn = base + h * 128; a.Kn = base + DIFF_W + h * 128;
        attn_core<64, 0>(a, qb * 256, C.lds, 0.125f, o2);
        attn_store(o2, dst, DM, qb * 256);
        a.Qn = base + h * 128 + 64; a.Kn = base + DIFF_W + h * 128 + 64;
        attn_core<64, 0>(a, qb * 256, C.lds, 0.125f, o2);
        float ss = 0.f;
        {
            const bf16_t* rp = dst + (size_t)(qb * 256 + 32 * C.wave + r32) * DM;
#pragma unroll
            for (int blk = 0; blk < 4; ++blk)
#pragma unroll
                for (int g = 0; g < 4; ++g) {
                    const u32x2 w = *(const u32x2*)(rp + 32 * blk + 8 * g + 4 * hi);
                    const float o1v[4] = {bflo(w.x), bfhi(w.x), bflo(w.y), bfhi(w.y)};
#pragma unroll
                    for (int j = 0; j < 4; ++j) { const float v = o1v[j] - lam * o2[blk][4 * g + j]; o2[blk][4 * g + j] = v; ss += v * v; }
                }
        }
        ss = swap32_sum(ss);
        const float rs = rsqrtf(ss * (1.0f / 128.0f) + NORM_EPS) * 0.8f;
        const float* sub = P.in[I_SUBLN];
#pragma unroll
        for (int blk = 0; blk < 4; ++blk)
#pragma unroll
            for (int r = 0; r < 16; ++r) o2[blk][r] *= rs * sub[32 * blk + crow(r, hi)];
        attn_store(o2, dst, DM, qb * 256);
    }
}
DI void phase_mla_attn(const Ctx& C, const Params& P) {
    unsigned char* ws = P.ws;
    const bf16_t* q = (const bf16_t*)(ws + P_Q); const bf16_t* kv = (const bf16_t*)(ws + P_KV); const bf16_t* kr = (const bf16_t*)(ws + P_KROPE);
    bf16_t* ob = (bf16_t*)(ws + P_H);
    unsigned* ctr = (unsigned*)(ws + WS_CTL) + CW_CTR + 64;
    const int NBH = BATCH * MLA_HEADS, total = NBH * 8;
    for (;;) {
        const int u = queue_pop(C, ctr, total); if (u < 0) break;
        const int qb = 7 - u / NBH, bh = u % NBH, b = bh / MLA_HEADS, h = bh % MLA_HEADS;
        AttnArgs a; a.ldq = 3072; a.ldkn = 4096; a.ldkr = 64; a.ldv = 4096;
        a.Qn = q + (size_t)b * SEQ * 3072 + h * 192; a.Qr = a.Qn + 128;
        a.Kn = kv + (size_t)b * SEQ * 4096 + h * 256; a.V = a.Kn + 128; a.Kr = kr + (size_t)b * SEQ * 64;
        f32x16 o[4];
        attn_core<128, 64>(a, qb * 256, C.lds, 0.07216878364870322f, o);
        attn_store(o, ob + (size_t)b * SEQ * DM + h * 128, DM, qb * 256);
    }
}
#else
template <int DK> DI void naive_attn_row(const bf16_t* qrow, const bf16_t* qrow2, const bf16_t* Kn, int ldkn, const bf16_t* Kr, int ldkr, const bf16_t* V, int ldv, int nkeys, float scale, int lane, float& o0, float& o1) {
    float qv[3];
#pragma unroll
    for (int j = 0; j < 3; ++j) { const int d = lane + 64 * j; qv[j] = 0.f; if (d < DK) qv[j] = (DK == 192 && d >= 128) ? bf2f(qrow2[d - 128]) : bf2f(qrow[d]); }
    float m = -1e30f, l = 0.f; o0 = 0.f; o1 = 0.f;
    for (int k = 0; k < nkeys; ++k) {
        float s = 0.f;
#pragma unroll
        for (int j = 0; j < 3; ++j) { const int d = lane + 64 * j; if (d < DK) { const float kvv = (DK == 192 && d >= 128) ? bf2f(Kr[(size_t)k * ldkr + d - 128]) : bf2f(Kn[(size_t)k * ldkn + d]); s += qv[j] * kvv; } }
        s = wave_sum(s) * scale;
        const float mn = fmaxf(m, s), al = expf(m - mn), p = expf(s - mn);
        m = mn; l = l * al + p;
        o0 = o0 * al + p * bf2f(V[(size_t)k * ldv + lane]); o1 = o1 * al + p * bf2f(V[(size_t)k * ldv + 64 + lane]);
    }
    o0 /= l; o1 /= l;
}
DI void phase_diff_attn(const Ctx& C, const Params& P) {
    unsigned char* ws = P.ws;
    const bf16_t* proj = (const bf16_t*)(ws + P_PROJ); bf16_t* concat = (bf16_t*)(ws + P_CONCAT);
    const float lam = diff_lambda(P);
    const int lane = C.lane;
    for (int it = C.blk * NWAVES + C.wave; it < BATCH * DIFF_HEADS * SEQ; it += C.G * NWAVES) {
        const int s = it % SEQ, bh = it / SEQ, b = bh / DIFF_HEADS, h = bh % DIFF_HEADS;
        const bf16_t* base = proj + (size_t)b * SEQ * AB_IN;
        const bf16_t* qrow = base + (size_t)s * AB_IN + h * 128;
        float a0, a1, b0, b1;
        naive_attn_row<64>(qrow, nullptr, base + DIFF_W + h * 128, AB_IN, nullptr, 0, base + 2 * DIFF_W + h * 128, AB_IN, s + 1, 0.125f, lane, a0, a1);
        naive_attn_row<64>(qrow + 64, nullptr, base + DIFF_W + h * 128 + 64, AB_IN, nullptr, 0, base + 2 * DIFF_W + h * 128, AB_IN, s + 1, 0.125f, lane, b0, b1);
        const float v0 = a0 - lam * b0, v1 = a1 - lam * b1;
        const float ss = wave_sum(v0 * v0 + v1 * v1);
        const float rs = rsqrtf(ss * (1.0f / 128.0f) + NORM_EPS) * 0.8f;
        bf16_t* orow = concat + (size_t)(b * SEQ + s) * DM + h * 128;
        orow[lane] = f2bf(v0 * rs * P.in[I_SUBLN][lane]); orow[64 + lane] = f2bf(v1 * rs * P.in[I_SUBLN][64 + lane]);
    }
}
DI void phase_mla_attn(const Ctx& C, const Params& P) {
    unsigned char* ws = P.ws;
    const bf16_t* q = (const bf16_t*)(ws + P_Q); const bf16_t* kv = (const bf16_t*)(ws + P_KV); const bf16_t* kr = (const bf16_t*)(ws + P_KROPE);
    bf16_t* ob = (bf16_t*)(ws + P_H);
    const int lane = C.lane;
    for (int it = C.blk * NWAVES + C.wave; it < BATCH * MLA_HEADS * SEQ; it += C.G * NWAVES) {
        const int s = it % SEQ, bh = it / SEQ, b = bh / MLA_HEADS, h = bh % MLA_HEADS;
        const bf16_t* qrow = q + (size_t)(b * SEQ + s) * 3072 + h * 192;
        const bf16_t* kn = kv + (size_t)b * SEQ * 4096 + h * 256;
        float a0, a1;
        naive_attn_row<192>(qrow, qrow + 128, kn, 4096, kr + (size_t)b * SEQ * 64, 64, kn + 128, 4096, s + 1, 0.07216878364870322f, lane, a0, a1);
        bf16_t* orow = ob + (size_t)(b * SEQ + s) * DM + h * 128;
        orow[lane] = f2bf(a0); orow[64 + lane] = f2bf(a1);
    }
}
#endif

DI void phase_mla_rows(const Ctx& C, const Params& P) {
    unsigned char* ws = P.ws;
    const bf16_t* mp = (const bf16_t*)(ws + P_MLAPROJ); bf16_t* cqn = (bf16_t*)(ws + P_CQN); bf16_t* ckvn = (bf16_t*)(ws + P_CKVN); bf16_t* krp = (bf16_t*)(ws + P_KROPE);
    const f32x2* tab = (const f32x2*)(ws + WS_ROPE);
    const int lane = C.lane;
    for (int r = C.blk * NWAVES + C.wave; r < T; r += C.G * NWAVES) {
        const bf16_t* row = mp + (size_t)r * MLA_IN_PAD;
        float v[12]; float ss = 0.f;
#pragma unroll
        for (int j = 0; j < 3; ++j) { const u32x2 w = *(const u32x2*)(row + 4 * (lane + 64 * j)); v[4 * j] = bflo(w.x); v[4 * j + 1] = bfhi(w.x); v[4 * j + 2] = bflo(w.y); v[4 * j + 3] = bfhi(w.y); }
#pragma unroll
        for (int j = 0; j < 12; ++j) ss += v[j] * v[j];
        float sc = rsqrtf(wave_sum(ss) * (1.0f / MLA_QR) + NORM_EPS);
#pragma unroll
        for (int j = 0; j < 3; ++j) { const f32x4 g = *(const f32x4*)(P.in[I_MLA_QNORM] + 4 * (lane + 64 * j));
            u32x2 w; w.x = pk2(v[4 * j] * sc * g[0], v[4 * j + 1] * sc * g[1]); w.y = pk2(v[4 * j + 2] * sc * g[2], v[4 * j + 3] * sc * g[3]);
            *(u32x2*)(cqn + (size_t)r * MLA_QR + 4 * (lane + 64 * j)) = w; }
        {
            const u32x2 w = *(const u32x2*)(row + MLA_QR + 4 * lane);
            const float a0 = bflo(w.x), a1 = bfhi(w.x), a2 = bflo(w.y), a3 = bfhi(w.y);
            const float s2 = rsqrtf(wave_sum(a0 * a0 + a1 * a1 + a2 * a2 + a3 * a3) * (1.0f / MLA_KVR) + NORM_EPS);
            const f32x4 g = *(const f32x4*)(P.in[I_MLA_KVNORM] + 4 * lane);
            u32x2 o; o.x = pk2(a0 * s2 * g[0], a1 * s2 * g[1]); o.y = pk2(a2 * s2 * g[2], a3 * s2 * g[3]);
            *(u32x2*)(ckvn + (size_t)r * MLA_KVR + 4 * lane) = o;
        }
        if (lane < 32) {
            const unsigned w = *(const unsigned*)(row + 1024 + 2 * lane);
            int p = ((const int*)P.in[I_POS])[r]; p = p < 0 ? 0 : (p > ROPE_POS - 1 ? ROPE_POS - 1 : p);
            const f32x2 cs = tab[(size_t)p * 32 + lane];
            const float x1 = bflo(w), x2 = bfhi(w);
            *(unsigned*)(krp + (size_t)r * 64 + 2 * lane) = pk2(x1 * cs[0] - x2 * cs[1], x2 * cs[0] + x1 * cs[1]);
        }
    }
}

DI void phase_xa_softmax(const Ctx& C, const Params& P) {
    unsigned char* ws = P.ws;
    const float* S = (const float*)(ws + P_S); bf16_t* Pb = (bf16_t*)(ws + P_P);
    const int lane = C.lane, hd = lane >> 4, li = lane & 15;
    for (int r = C.blk * NWAVES + C.wave; r < T; r += C.G * NWAVES) {
        const float* row = S + (size_t)r * 1024 + hd * 256;
        f32x4 v[4]; float mx = -1e30f;
#pragma unroll
        for (int j = 0; j < 4; ++j) { v[j] = *(const f32x4*)(row + 4 * (li + 16 * j)); mx = fmaxf(mx, fmaxf(fmaxf(v[j][0], v[j][1]), fmaxf(v[j][2], v[j][3]))); }
#pragma unroll
        for (int o = 1; o < 16; o <<= 1) mx = fmaxf(mx, __shfl_xor(mx, o));
        float sm = 0.f;
#pragma unroll
        for (int j = 0; j < 4; ++j) { v[j][0] = __expf(v[j][0] - mx); v[j][1] = __expf(v[j][1] - mx); v[j][2] = __expf(v[j][2] - mx); v[j][3] = __expf(v[j][3] - mx); sm += (v[j][0] + v[j][1]) + (v[j][2] + v[j][3]); }
#pragma unroll
        for (int o = 1; o < 16; o <<= 1) sm += __shfl_xor(sm, o);
        const float inv = 1.0f / sm;
        bf16_t* orow = Pb + (size_t)r * 1024 + hd * 256;
#pragma unroll
        for (int j = 0; j < 4; ++j) { u32x2 w; w.x = pk2(v[j][0] * inv, v[j][1] * inv); w.y = pk2(v[j][2] * inv, v[j][3] * inv); *(u32x2*)(orow + 4 * (li + 16 * j)) = w; }
    }
}

template <bool STORE> DI void phase_peer(const Ctx& C, const Params& P) {
    unsigned char* ws = P.ws;
    const float* sc = (const float*)(ws + P_SC); const bf16_t* hb = (const bf16_t*)(ws + P_H);
    const bf16_t* ut = (const bf16_t*)(ws + P_UT); const bf16_t* vt = (const bf16_t*)(ws + P_VT);
    float* xo = P.out;
    LAS unsigned char* my = C.lds + C.wave * 4096;
    LAS float* top_s = (LAS float*)my;
    LAS int* top_i = (LAS int*)(my + 1024);
    LAS int* best_e = (LAS int*)(my + 2048);
    LAS float* best_g = (LAS float*)(my + 2560);
    LAS float* best_s = (LAS float*)(my + 3072);
    LAS int* best_p = (LAS int*)(my + 3584);
    const int lane = C.lane;
    for (int tok = C.blk * NWAVES + C.wave; tok < T; tok += C.G * NWAVES) {
        {
            const int g = lane >> 2, qd = lane & 3;
            float v[32];
            const f32x4* sp = (const f32x4*)(sc + (size_t)tok * 2048 + g * 128 + qd * 32);
#pragma unroll
            for (int j = 0; j < 8; ++j) { const f32x4 x = sp[j]; v[4 * j] = x[0]; v[4 * j + 1] = x[1]; v[4 * j + 2] = x[2]; v[4 * j + 3] = x[3]; }
            for (int r = 0; r < 16; ++r) {
                float bv = v[0]; int bj = 0;
#pragma unroll
                for (int j = 1; j < 32; ++j) { const bool gt = v[j] > bv; bv = gt ? v[j] : bv; bj = gt ? j : bj; }
                int bn = qd * 32 + bj;
#pragma unroll
                for (int off = 1; off <= 2; off <<= 1) { const float ov = __shfl_xor(bv, off); const int on = __shfl_xor(bn, off); const bool tk = (ov > bv) || (ov == bv && on < bn); bv = tk ? ov : bv; bn = tk ? on : bn; }
                if (qd == 0) { top_s[g * 16 + r] = bv; top_i[g * 16 + r] = bn; }
                const int rem = ((bn >> 5) == qd) ? (bn & 31) : -1;
#pragma unroll
                for (int j = 0; j < 32; ++j) v[j] = (j == rem) ? -INFINITY : v[j];
            }
        }
        LDS_WAIT(); asm volatile("" ::: "memory");
        {
            const int h = lane >> 3, sub = lane & 7;
            float v[32];
            const float s00 = top_s[(2 * h) * 16 + 2 * sub], s01 = top_s[(2 * h) * 16 + 2 * sub + 1];
#pragma unroll
            for (int k2 = 0; k2 < 16; ++k2) { const float s1 = top_s[(2 * h + 1) * 16 + k2]; v[k2] = s00 + s1; v[16 + k2] = s01 + s1; }
            for (int r = 0; r < 16; ++r) {
                float bv = v[0]; int bj = 0;
#pragma unroll
                for (int j = 1; j < 32; ++j) { const bool gt = v[j] > bv; bv = gt ? v[j] : bv; bj = gt ? j : bj; }
                int bn = sub * 32 + bj;
#pragma unroll
                for (int off = 1; off <= 4; off <<= 1) { const float ov = __shfl_xor(bv, off); const int on = __shfl_xor(bn, off); const bool tk = (ov > bv) || (ov == bv && on < bn); bv = tk ? ov : bv; bn = tk ? on : bn; }
                if (sub == 0) { best_s[h * 16 + r] = bv; best_p[h * 16 + r] = bn; }
                const int rem = ((bn >> 5) == sub) ? (bn & 31) : -1;
#pragma unroll
                for (int j = 0; j < 32; ++j) v[j] = (j == rem) ? -INFINITY : v[j];
            }
        }
        LDS_WAIT(); asm volatile("" ::: "memory");
#pragma unroll
        for (int e2 = 0; e2 < 2; ++e2) {
            const int idx = lane + 64 * e2, h = idx >> 4;
            float mx = -1e30f;
            for (int k = 0; k < 16; ++k) mx = fmaxf(mx, best_s[h * 16 + k]);
            float sm = 0.f;
            for (int k = 0; k < 16; ++k) sm += __expf(best_s[h * 16 + k] - mx);
            const float gate = __expf(best_s[idx] - mx) / sm;
            const int pos = best_p[idx], k1 = pos >> 4, k2 = pos & 15;
            best_e[idx] = top_i[(2 * h) * 16 + k1] * 128 + top_i[(2 * h + 1) * 16 + k2];
            best_g[idx] = gate;
        }
        LDS_WAIT(); asm volatile("" ::: "memory");
#if PEER_FP8
        float tf[32];
#pragma unroll
        for (int i = 0; i < 2; ++i) { const u32x4* tp = (const u32x4*)(hb + (size_t)tok * DM + 16 * (lane + 64 * i));
            const u32x4 a = tp[0], b = tp[1];
            tf[16 * i + 0] = bflo(a.x); tf[16 * i + 1] = bfhi(a.x); tf[16 * i + 2] = bflo(a.y); tf[16 * i + 3] = bfhi(a.y); tf[16 * i + 4] = bflo(a.z); tf[16 * i + 5] = bfhi(a.z); tf[16 * i + 6] = bflo(a.w); tf[16 * i + 7] = bfhi(a.w);
            tf[16 * i + 8] = bflo(b.x); tf[16 * i + 9] = bfhi(b.x); tf[16 * i + 10] = bflo(b.y); tf[16 * i + 11] = bfhi(b.y); tf[16 * i + 12] = bflo(b.z); tf[16 * i + 13] = bfhi(b.z); tf[16 * i + 14] = bflo(b.w); tf[16 * i + 15] = bfhi(b.w); }
        const unsigned char* ut8 = (const unsigned char*)ut; const unsigned char* vt8 = (const unsigned char*)vt;
        const float* usc = (const float*)(ut8 + 32 * MiB); const float* vsc = (const float*)(vt8 + 32 * MiB);
        for (int k0 = 0; k0 < 128; k0 += 8) {
            u32x4 rw[8][2];
#pragma unroll
            for (int kk = 0; kk < 8; ++kk) { const int e = __builtin_amdgcn_readfirstlane(best_e[k0 + kk]); const unsigned char* rp = ut8 + (size_t)e * DM;
#pragma unroll
                for (int i = 0; i < 2; ++i) rw[kk][i] = *(const u32x4*)(rp + 16 * (lane + 64 * i)); }
            float d[8];
#pragma unroll
            for (int kk = 0; kk < 8; ++kk) { float s0 = 0.f, s1 = 0.f;
#pragma unroll
                for (int i = 0; i < 2; ++i) {
                    const unsigned w4[4] = {rw[kk][i].x, rw[kk][i].y, rw[kk][i].z, rw[kk][i].w};
#pragma unroll
                    for (int q = 0; q < 4; ++q) { const f32x2 lo = __builtin_amdgcn_cvt_pk_f32_fp8((int)w4[q], false), hi2 = __builtin_amdgcn_cvt_pk_f32_fp8((int)w4[q], true);
                        s0 = fmaf(lo[0], tf[16 * i + 4 * q], s0); s1 = fmaf(lo[1], tf[16 * i + 4 * q + 1], s1); s0 = fmaf(hi2[0], tf[16 * i + 4 * q + 2], s0); s1 = fmaf(hi2[1], tf[16 * i + 4 * q + 3], s1); }
                }
                d[kk] = s0 + s1; }
            float n4[4], n2[2], r1;
            { const bool b0 = lane & 1;
#pragma unroll
              for (int j = 0; j < 4; ++j) { const float snd = b0 ? d[j] : d[4 + j], kp = b0 ? d[4 + j] : d[j]; n4[j] = kp + __shfl_xor(snd, 1); } }
            { const bool b1 = lane & 2;
#pragma unroll
              for (int j = 0; j < 2; ++j) { const float snd = b1 ? n4[j] : n4[2 + j], kp = b1 ? n4[2 + j] : n4[j]; n2[j] = kp + __shfl_xor(snd, 2); } }
            { const bool b2 = lane & 4; const float snd = b2 ? n2[0] : n2[1], kp = b2 ? n2[1] : n2[0]; r1 = kp + __shfl_xor(snd, 4); }
            r1 += __shfl_xor(r1, 8); r1 += __shfl_xor(r1, 16); r1 += __shfl_xor(r1, 32);
            if (lane < 8) { const int idx = k0 + 4 * (lane & 1) + 2 * ((lane >> 1) & 1) + ((lane >> 2) & 1); const float act = r1 * usc[best_e[idx]]; best_g[idx] *= gelu_erf(act); }
        }
        LDS_WAIT(); asm volatile("" ::: "memory");
        float acc[32];
#pragma unroll
        for (int j = 0; j < 32; ++j) acc[j] = 0.f;
        for (int k0 = 0; k0 < 128; k0 += 8) {
            u32x4 rw[8][2]; float wk[8];
#pragma unroll
            for (int kk = 0; kk < 8; ++kk) { const int e = __builtin_amdgcn_readfirstlane(best_e[k0 + kk]); wk[kk] = best_g[k0 + kk] * vsc[e]; const unsigned char* rp = vt8 + (size_t)e * DM;
#pragma unroll
                for (int i = 0; i < 2; ++i) rw[kk][i] = *(const u32x4*)(rp + 16 * (lane + 64 * i)); }
#pragma unroll
            for (int kk = 0; kk < 8; ++kk)
#pragma unroll
                for (int i = 0; i < 2; ++i) {
                    const unsigned w4[4] = {rw[kk][i].x, rw[kk][i].y, rw[kk][i].z, rw[kk][i].w};
#pragma unroll
                    for (int q = 0; q < 4; ++q) { const f32x2 lo = __builtin_amdgcn_cvt_pk_f32_fp8((int)w4[q], false), hi2 = __builtin_amdgcn_cvt_pk_f32_fp8((int)w4[q], true);
                        acc[16 * i + 4 * q] = fmaf(wk[kk], lo[0], acc[16 * i + 4 * q]); acc[16 * i + 4 * q + 1] = fmaf(wk[kk], lo[1], acc[16 * i + 4 * q + 1]);
                        acc[16 * i + 4 * q + 2] = fmaf(wk[kk], hi2[0], acc[16 * i + 4 * q + 2]); acc[16 * i + 4 * q + 3] = fmaf(wk[kk], hi2[1], acc[16 * i + 4 * q + 3]); }
                }
        }
#else
        u32x4 tv[4];
#pragma unroll
        for (int i = 0; i < 4; ++i) tv[i] = *(const u32x4*)(hb + (size_t)tok * DM + 8 * (lane + 64 * i));
        for (int k0 = 0; k0 < 128; k0 += 4) {
            u32x4 rw[4][4];
#pragma unroll
            for (int kk = 0; kk < 4; ++kk) { const int e = __builtin_amdgcn_readfirstlane(best_e[k0 + kk]); const bf16_t* rp = ut + (size_t)e * DM;
#pragma unroll
                for (int i = 0; i < 4; ++i) rw[kk][i] = *(const u32x4*)(rp + 8 * (lane + 64 * i)); }
            float d[4];
#pragma unroll
            for (int kk = 0; kk < 4; ++kk) { float s = 0.f;
#pragma unroll
                for (int i = 0; i < 4; ++i) { s = dot2bf(rw[kk][i].x, tv[i].x, s); s = dot2bf(rw[kk][i].y, tv[i].y, s); s = dot2bf(rw[kk][i].z, tv[i].z, s); s = dot2bf(rw[kk][i].w, tv[i].w, s); }
                d[kk] = wave_sum(s); }
            if (lane < 4) { const float act = lane == 0 ? d[0] : lane == 1 ? d[1] : lane == 2 ? d[2] : d[3]; best_g[k0 + lane] *= gelu_erf(act); }
        }
        LDS_WAIT(); asm volatile("" ::: "memory");
        float acc[32];
#pragma unroll
        for (int j = 0; j < 32; ++j) acc[j] = 0.f;
        for (int k0 = 0; k0 < 128; k0 += 4) {
            u32x4 rw[4][4]; float wk[4];
#pragma unroll
            for (int kk = 0; kk < 4; ++kk) { const int e = __builtin_amdgcn_readfirstlane(best_e[k0 + kk]); wk[kk] = best_g[k0 + kk]; const bf16_t* rp = vt + (size_t)e * DM;
#pragma unroll
                for (int i = 0; i < 4; ++i) rw[kk][i] = *(const u32x4*)(rp + 8 * (lane + 64 * i)); }
#pragma unroll
            for (int kk = 0; kk < 4; ++kk)
#pragma unroll
                for (int i = 0; i < 4; ++i) {
                    acc[8 * i + 0] = fmaf(wk[kk], bflo(rw[kk][i].x), acc[8 * i + 0]); acc[8 * i + 1] = fmaf(wk[kk], bfhi(rw[kk][i].x), acc[8 * i + 1]);
                    acc[8 * i + 2] = fmaf(wk[kk], bflo(rw[kk][i].y), acc[8 * i + 2]); acc[8 * i + 3] = fmaf(wk[kk], bfhi(rw[kk][i].y), acc[8 * i + 3]);
                    acc[8 * i + 4] = fmaf(wk[kk], bflo(rw[kk][i].z), acc[8 * i + 4]); acc[8 * i + 5] = fmaf(wk[kk], bfhi(rw[kk][i].z), acc[8 * i + 5]);
                    acc[8 * i + 6] = fmaf(wk[kk], bflo(rw[kk][i].w), acc[8 * i + 6]); acc[8 * i + 7] = fmaf(wk[kk], bfhi(rw[kk][i].w), acc[8 * i + 7]);
                }
        }
#endif
        float* xr = xo + (size_t)tok * DM;
        if (!STORE) {
#pragma unroll
            for (int j = 0; j < 32; ++j) asm volatile("" :: "v"(acc[j]));
        } else {
#if PEER_FP8
#pragma unroll
            for (int i = 0; i < 2; ++i) { f32x4* p = (f32x4*)(xr + 16 * (lane + 64 * i));
#pragma unroll
                for (int q = 0; q < 4; ++q) { f32x4 a = p[q]; a[0] += acc[16 * i + 4 * q]; a[1] += acc[16 * i + 4 * q + 1]; a[2] += acc[16 * i + 4 * q + 2]; a[3] += acc[16 * i + 4 * q + 3]; p[q] = a; } }
#else
#pragma unroll
            for (int i = 0; i < 4; ++i) { f32x4* p = (f32x4*)(xr + 8 * (lane + 64 * i));
                f32x4 a = p[0], b = p[1];
                a[0] += acc[8 * i]; a[1] += acc[8 * i + 1]; a[2] += acc[8 * i + 2]; a[3] += acc[8 * i + 3];
                b[0] += acc[8 * i + 4]; b[1] += acc[8 * i + 5]; b[2] += acc[8 * i + 6]; b[3] += acc[8 * i + 7];
                p[0] = a; p[1] = b; }
#endif
        }
        LDS_WAIT(); asm volatile("" ::: "memory");
    }
}

constexpr int N_PHASES = 33;
__global__ void __launch_bounds__(NTHREADS, 2) mk_fwd(Params P) {
    extern __shared__ __attribute__((aligned(16))) unsigned char lds_raw[];
    Ctx C; C.lds = (LAS unsigned char*)lds_raw; C.tid = threadIdx.x; C.lane = C.tid & 63; C.wave = __builtin_amdgcn_readfirstlane(C.tid >> 6); C.blk = blockIdx.x; C.G = gridDim.x;
    unsigned char* ws = P.ws;
    for (int u = C.tid; u < (LDS_BYTES - LDSCTL_OFF) / 4; u += NTHREADS) ((LAS unsigned*)(C.lds + LDSCTL_OFF))[u] = 0u;
    __syncthreads();
    XcdBarrier bar; bar.bar = (unsigned*)(ws + WS_CTL) + CW_BAR; bar.x = 0; bar.st = nullptr;
    const bool one = (P.ph_hi - P.ph_lo) > 1;
    if (one) bar = xcd_barrier_post((unsigned*)(ws + WS_CTL) + CW_BAR, (volatile LAS unsigned*)(C.lds + LDSCTL_OFF));
    const int lo = P.ph_lo, hi = P.ph_hi;
#define IN(k) (lo <= (k) && (k) < hi)
#define SEAM(k) do { if (IN(k) && IN((k) + 1)) xcd_barrier(bar); } while (0)
    bf16_t* hbuf = (bf16_t*)(ws + P_H);
    const int* pos = (const int*)P.in[I_POS];
    const f32x2* rtab = (const f32x2*)(ws + WS_ROPE);

    if (IN(0)) { if (EN_PRO) phase_prologue(C, P); } SEAM(0);
    if (IN(1)) {
        {
            g8::Desc g{(const bf16_t*)(ws + P_MEMN), (const bf16_t*)(ws + WS_LW + LW_XKV), DM, DM, DM, MT / 256, DM / 256, 2, 1, (long)MT * DM, 0, (long)(LW_STRIDE / 2), 0};
            EpiBf16 E{(bf16_t*)(ws + WS_KVX), DM, (long)(KVX_STRIDE / 2), 0, 1.0f};
            if (GSITE < 0 || GSITE == 1) g8::gemm(C.lds, g, E, C.G, C.blk);
        }
        {
            g8::Desc g{(const bf16_t*)(ws + WS_LW + LW_XKV) + (size_t)DM * DM, (const bf16_t*)(ws + P_MEMN), DM, DM, DM, DM / 256, MT / 256, 2, 1, (long)(LW_STRIDE / 2), 0, (long)MT * DM, 0};
            EpiBf16 E{(bf16_t*)(ws + WS_KVX + 16 * MiB), MT, (long)(KVX_STRIDE / 2), 0, 1.0f};
            if (GSITE < 0 || GSITE == 2) g8::gemm(C.lds, g, E, C.G, C.blk);
        }
        {
            g8::Desc g{(const bf16_t*)(ws + P_SK), (const bf16_t*)(ws + P_WQB), 256, DM, 256, 1, DM / 256, 2, 8, 8L * 65536, 65536, (long)DM * DM, 256};
            EpiBf16 E{(bf16_t*)(ws + WS_LW + LW_PEER), DM, (long)(LW_STRIDE / 2), 256L * DM, 1.0f};
            if (GSITE < 0 || GSITE == 3) g8::gemm(C.lds, g, E, C.G, C.blk);
        }
    }
    SEAM(1);

    {
        constexpr int l = 0, pb = 2; (void)l;

            if (IN(pb + 0)) rms_rows_2048(C, P.in[I_X], P.in[I_AB_NORM], hbuf, T);
            SEAM(pb + 0);
            if (IN(pb + 1)) {
                g8::Desc g{hbuf, (const bf16_t*)(ws + WS_ABIN_T), DM, DM, DM, T / 256, AB_IN / 256, 1, 1, 0, 0, 0, 0};
                EpiRope<0> E{(bf16_t*)(ws + P_PROJ), AB_IN, pos, rtab};
                if (GSITE < 0 || GSITE == 4) g8::gemm(C.lds, g, E, C.G, C.blk);
            }
            SEAM(pb + 1);
            if (IN(pb + 2)) { if (EN_S5) phase_s5(C, P); }
            SEAM(pb + 2);
            if (IN(pb + 3)) { if (EN_DIFF) phase_diff_attn(C, P); }
            SEAM(pb + 3);
            if (IN(pb + 4)) {
                g8::Desc g{(const bf16_t*)(ws + P_GBUF), (const bf16_t*)(ws + WS_GLU_T), S5_W, S5_W, S5_W, T / 256, S5_W / 256, 1, 1, 0, 0, 0, 0};
                EpiGlu E{(const bf16_t*)(ws + P_GBUF), P.in[I_S5_BGLU], (bf16_t*)(ws + P_CONCAT)};
                if (GSITE < 0 || GSITE == 5) g8::gemm(C.lds, g, E, C.G, C.blk);
            }
            SEAM(pb + 4);
            if (IN(pb + 5)) {
                g8::Desc g{(const bf16_t*)(ws + P_CONCAT), (const bf16_t*)(ws + WS_ABOUT_T), DM, DM, DM, T / 256, DM / 256, 1, 1, 0, 0, 0, 0};
                EpiResid E{P.in[I_X], P.out, DM};
                if (GSITE < 0 || GSITE == 6) g8::gemm(C.lds, g, E, C.G, C.blk);
            }
            SEAM(pb + 5);
    }
    {
        constexpr int l = 0, pb = 2; (void)l;
        const unsigned char* lw = ws + WS_LW + (size_t)l * LW_STRIDE;
        if (IN(pb + 6)) rms_rows_2048(C, P.out, P.in[I_XA_NORM] + l * DM, hbuf, T);
        SEAM(pb + 6);
        if (IN(pb + 7)) {
            g8::Desc g{hbuf, (const bf16_t*)(lw + LW_XQ), DM, DM, DM, T / 256, DM / 256, 1, 1, 0, 0, 0, 0};
            EpiBf16 E{(bf16_t*)(ws + P_QX), DM, 0, 0, 1.0f};
            if (GSITE < 0 || GSITE == 11) g8::gemm(C.lds, g, E, C.G, C.blk);
        }
        SEAM(pb + 7);
        if (IN(pb + 8)) {
            g8::Desc g{(const bf16_t*)(ws + P_QX), (const bf16_t*)(ws + WS_KVX + (size_t)l * KVX_STRIDE), DM, DM, 512, SEQ / 256, 1, BATCH, 4, (long)SEQ * DM, 512, (long)MEM_LEN * DM, 512};
            EpiF32 E{(float*)(ws + P_S), 1024, (long)SEQ * 1024, 256, 0.04419417382415922f};
            if (GSITE < 0 || GSITE == 12) g8::gemm(C.lds, g, E, C.G, C.blk);
        }
        SEAM(pb + 8);
        if (IN(pb + 9)) {
            phase_xa_softmax(C, P);
            if (l == 1) {
                convert_tables(C, P, 1);
            }
        }
        SEAM(pb + 9);
        if (IN(pb + 10)) {
            g8::Desc g{(const bf16_t*)(ws + P_P), (const bf16_t*)(ws + WS_KVX + (size_t)l * KVX_STRIDE + 16 * MiB), 1024, MT, 256, SEQ / 256, 2, BATCH, 4, (long)SEQ * 1024, 256, 256, 512L * MT};
            EpiBf16 E{(bf16_t*)(ws + P_OX), DM, (long)SEQ * DM, 512, 1.0f};
            if (GSITE < 0 || GSITE == 13) g8::gemm(C.lds, g, E, C.G, C.blk);
        }
        SEAM(pb + 10);
        if (IN(pb + 11)) {
            g8::Desc g{(const bf16_t*)(ws + P_OX), (const bf16_t*)(lw + LW_XO), DM, DM, DM, T / 256, DM / 256, 1, 1, 0, 0, 0, 0};
            EpiResid E{P.out, P.out, DM};
            if (GSITE < 0 || GSITE == 14) g8::gemm(C.lds, g, E, C.G, C.blk);
        }
        SEAM(pb + 11);
        if (IN(pb + 12)) rms_rows_2048(C, P.out, P.in[I_FFN_NORM] + l * DM, hbuf, T);
        SEAM(pb + 12);
        if (IN(pb + 13)) {
            g8::Desc g{hbuf, (const bf16_t*)(lw + LW_PEER), DM, DM, DM, T / 256, DM / 256, 1, 1, 0, 0, 0, 0};
            EpiF32 E{(float*)(ws + P_SC), DM, 0, 0, 1.0f};
            if (GSITE < 0 || GSITE == 15) g8::gemm(C.lds, g, E, C.G, C.blk);
        }
        SEAM(pb + 13);
        if (IN(pb + 14)) { if (EN_PEER) { if (PROBE_PEER2) { phase_peer<false>(C, P); __syncthreads(); } phase_peer<true>(C, P); } }
        SEAM(pb + 14);
    }
    {
        constexpr int l = 1, pb = 17; (void)l;

            if (IN(pb + 0)) rms_rows_2048(C, P.out, P.in[I_MLA_NORM], hbuf, T);
            SEAM(pb + 0);
            if (IN(pb + 1)) {
                g8::Desc g{hbuf, (const bf16_t*)(ws + WS_MLAIN_T), DM, DM, DM, T / 256, MLA_IN_PAD / 256, 1, 1, 0, 0, 0, 0};
                EpiBf16 E{(bf16_t*)(ws + P_MLAPROJ), MLA_IN_PAD, 0, 0, 1.0f};
                if (GSITE < 0 || GSITE == 7) g8::gemm(C.lds, g, E, C.G, C.blk);
            }
            SEAM(pb + 1);
            if (IN(pb + 2)) phase_mla_rows(C, P);
            SEAM(pb + 2);
            if (IN(pb + 3)) {
                {
                    g8::Desc g{(const bf16_t*)(ws + P_CQN), (const bf16_t*)(ws + WS_UQ_T), MLA_QR, MLA_QR, MLA_QR, T / 256, 3072 / 256, 1, 1, 0, 0, 0, 0};
                    EpiRope<1> E{(bf16_t*)(ws + P_Q), 3072, pos, rtab};
                    if (GSITE < 0 || GSITE == 8) g8::gemm(C.lds, g, E, C.G, C.blk);
                }
                {
                    g8::Desc g{(const bf16_t*)(ws + P_CKVN), (const bf16_t*)(ws + WS_UKV_T), MLA_KVR, MLA_KVR, MLA_KVR, T / 256, 4096 / 256, 1, 1, 0, 0, 0, 0};
                    EpiBf16 E{(bf16_t*)(ws + P_KV), 4096, 0, 0, 1.0f};
                    if (GSITE < 0 || GSITE == 9) g8::gemm(C.lds, g, E, C.G, C.blk);
                }
            }
            SEAM(pb + 3);
            if (IN(pb + 4)) { if (EN_MLA) phase_mla_attn(C, P); }
            SEAM(pb + 4);
            if (IN(pb + 5)) {
                g8::Desc g{hbuf, (const bf16_t*)(ws + WS_MLAO_T), DM, DM, DM, T / 256, DM / 256, 1, 1, 0, 0, 0, 0};
                EpiResid E{P.out, P.out, DM};
                if (GSITE < 0 || GSITE == 10) g8::gemm(C.lds, g, E, C.G, C.blk);
            }
            SEAM(pb + 5);
    }
    {
        constexpr int l = 1, pb = 17; (void)l;
        const unsigned char* lw = ws + WS_LW + (size_t)l * LW_STRIDE;
        if (IN(pb + 6)) rms_rows_2048(C, P.out, P.in[I_XA_NORM] + l * DM, hbuf, T);
        SEAM(pb + 6);
        if (IN(pb + 7)) {
            g8::Desc g{hbuf, (const bf16_t*)(lw + LW_XQ), DM, DM, DM, T / 256, DM / 256, 1, 1, 0, 0, 0, 0};
            EpiBf16 E{(bf16_t*)(ws + P_QX), DM, 0, 0, 1.0f};
            if (GSITE < 0 || GSITE == 11) g8::gemm(C.lds, g, E, C.G, C.blk);
        }
        SEAM(pb + 7);
        if (IN(pb + 8)) {
            g8::Desc g{(const bf16_t*)(ws + P_QX), (const bf16_t*)(ws + WS_KVX + (size_t)l * KVX_STRIDE), DM, DM, 512, SEQ / 256, 1, BATCH, 4, (long)SEQ * DM, 512, (long)MEM_LEN * DM, 512};
            EpiF32 E{(float*)(ws + P_S), 1024, (long)SEQ * 1024, 256, 0.04419417382415922f};
            if (GSITE < 0 || GSITE == 12) g8::gemm(C.lds, g, E, C.G, C.blk);
        }
        SEAM(pb + 8);
        if (IN(pb + 9)) {
            phase_xa_softmax(C, P);
            if (l == 1) {
                convert_tables(C, P, 1);
            }
        }
        SEAM(pb + 9);
        if (IN(pb + 10)) {
            g8::Desc g{(const bf16_t*)(ws + P_P), (const bf16_t*)(ws + WS_KVX + (size_t)l * KVX_STRIDE + 16 * MiB), 1024, MT, 256, SEQ / 256, 2, BATCH, 4, (long)SEQ * 1024, 256, 256, 512L * MT};
            EpiBf16 E{(bf16_t*)(ws + P_OX), DM, (long)SEQ * DM, 512, 1.0f};
            if (GSITE < 0 || GSITE == 13) g8::gemm(C.lds, g, E, C.G, C.blk);
        }
        SEAM(pb + 10);
        if (IN(pb + 11)) {
            g8::Desc g{(const bf16_t*)(ws + P_OX), (const bf16_t*)(lw + LW_XO), DM, DM, DM, T / 256, DM / 256, 1, 1, 0, 0, 0, 0};
            EpiResid E{P.out, P.out, DM};
            if (GSITE < 0 || GSITE == 14) g8::gemm(C.lds, g, E, C.G, C.blk);
        }
        SEAM(pb + 11);
        if (IN(pb + 12)) rms_rows_2048(C, P.out, P.in[I_FFN_NORM] + l * DM, hbuf, T);
        SEAM(pb + 12);
        if (IN(pb + 13)) {
            g8::Desc g{hbuf, (const bf16_t*)(lw + LW_PEER), DM, DM, DM, T / 256, DM / 256, 1, 1, 0, 0, 0, 0};
            EpiF32 E{(float*)(ws + P_SC), DM, 0, 0, 1.0f};
            if (GSITE < 0 || GSITE == 15) g8::gemm(C.lds, g, E, C.G, C.blk);
        }
        SEAM(pb + 13);
        if (IN(pb + 14)) { if (EN_PEER) { if (PROBE_PEER2) { phase_peer<false>(C, P); __syncthreads(); } phase_peer<true>(C, P); } }
        SEAM(pb + 14);
    }
    if (IN(32)) rms_rows_final(C, P.out, P.in[I_FINAL_NORM], T);
#undef IN
#undef SEAM
}

extern "C" void kernel_launch(void* const* d_in, const int* in_sizes, int n_in, void* d_out, int out_size, void* d_ws, size_t ws_size, hipStream_t stream) {
    static int grid = 0;
    if (grid == 0) {
        if (n_in != 39 || in_sizes[0] != T * DM || out_size != T * DM || ws_size < WS_END) {
            fprintf(stderr, "kernel_launch: unexpected shapes (n_in %d in0 %d out %d ws %zu, need ws >= %zu); nothing launched\n", n_in, n_in > 0 ? in_sizes[0] : -1, out_size, ws_size, (size_t)WS_END);
            grid = -1; return; }
        int dev = 0, cus = 0;
        if (hipGetDevice(&dev) != hipSuccess || hipDeviceGetAttribute(&cus, hipDeviceAttributeMultiprocessorCount, dev) != hipSuccess) { grid = -1; return; }
        if (hipFuncSetAttribute((const void*)mk_fwd, hipFuncAttributeMaxDynamicSharedMemorySize, LDS_BYTES) != hipSuccess) { fprintf(stderr, "kernel_launch: hipFuncSetAttribute failed\n"); grid = -1; return; }
        int per_cu = 0;
        if (hipOccupancyMaxActiveBlocksPerMultiprocessor(&per_cu, (const void*)mk_fwd, NTHREADS, LDS_BYTES) != hipSuccess || per_cu < 1)
            fprintf(stderr, "kernel_launch: occupancy query reports %d blocks per CU\n", per_cu);
        (void)hipGetLastError();
        grid = cus;
    }
    if (grid < 0) return;
    (void)hipMemsetAsync((char*)d_ws + WS_CTL, 0, CTL_BYTES, stream);
    Params p{};
    for (int i = 0; i < 39; ++i) p.in[i] = (const float*)d_in[i];
    p.out = (float*)d_out; p.ws = (unsigned char*)d_ws;
#if MK_ONE_LAUNCH
    p.ph_lo = 0; p.ph_hi = N_PHASES;
    hipLaunchKernelGGL(mk_fwd, dim3(grid), dim3(NTHREADS), LDS_BYTES, stream, p);
#else
    for (int ph = 0; ph < N_PHASES; ++ph) { p.ph_lo = ph; p.ph_hi = ph + 1; hipLaunchKernelGGL(mk_fwd, dim3(grid), dim3(NTHREADS), LDS_BYTES, stream, p); }
#endif
    const hipError_t le = hipPeekAtLastError();
    if (le != hipSuccess) fprintf(stderr, "kernel_launch: launch failed: %s\n", hipGetErrorName(le));
}
```

```cpp
#include <hip/hip_runtime.h>
#include <cstdio>
#include <cstdint>

#ifndef MK_ONE_LAUNCH
#define MK_ONE_LAUNCH 1
#endif
#ifndef FAST_GEMM
#define FAST_GEMM 1
#endif
#ifndef FAST_ATTN
#define FAST_ATTN 1
#endif

#ifndef EN_S5
#define EN_S5 1
#endif
#ifndef EN_DIFF
#define EN_DIFF 1
#endif
#ifndef EN_MLA
#define EN_MLA 1
#endif
#ifndef EN_PEER
#define EN_PEER 1
#endif
#ifndef EN_GEMM
#define EN_GEMM 1
#endif
#ifndef EN_PRO
#define EN_PRO 1
#endif
#ifndef PEER_FP8
#define PEER_FP8 1
#endif
#ifndef PROBE
#define PROBE 0
#endif
#ifndef PROBE_PEER2
#define PROBE_PEER2 0
#endif
#ifndef GSITE
#define GSITE -1
#endif
#define GAS __attribute__((address_space(1)))
#define LAS __attribute__((address_space(3)))
#define DI __device__ __forceinline__
typedef unsigned short bf16_t;
typedef short bf16x8 __attribute__((ext_vector_type(8)));
typedef short s16x4 __attribute__((ext_vector_type(4)));
typedef float f32x2 __attribute__((ext_vector_type(2)));
typedef float f32x4 __attribute__((ext_vector_type(4)));
typedef float f32x16 __attribute__((ext_vector_type(16)));
typedef unsigned u32x2 __attribute__((ext_vector_type(2)));
typedef unsigned u32x4 __attribute__((ext_vector_type(4)));
typedef __bf16 bf16x2_t __attribute__((ext_vector_type(2)));

constexpr int BATCH = 16, SEQ = 2048, DM = 2048, T = BATCH * SEQ, MEM_LEN = 256, MT = BATCH * MEM_LEN;
constexpr int DIFF_HEADS = 12, DIFF_W = 1536, S5_W = 512, AB_IN = 5120;
constexpr int MLA_HEADS = 16, MLA_QR = 768, MLA_KVR = 256, MLA_IN = 1088, MLA_IN_PAD = 1280;
constexpr int PEER_NE = 16384;
constexpr float NORM_EPS = 1e-6f;
constexpr int ROPE_POS = 3072;
constexpr int NWAVES = 8, NTHREADS = 512;

constexpr size_t MiB = 1u << 20;
constexpr size_t WS_CTL = 0, CTL_BYTES = 1 * MiB;
constexpr size_t WS_ROPE = 1 * MiB;
constexpr size_t WS_ABIN_T = 2 * MiB, WS_ABOUT_T = 22 * MiB, WS_GLU_T = 30 * MiB, WS_MLAIN_T = 31 * MiB, WS_UQ_T = 36 * MiB, WS_UKV_T = 41 * MiB, WS_MLAO_T = 43 * MiB;
constexpr size_t WS_LW = 51 * MiB, LW_STRIDE = 40 * MiB;
constexpr size_t LW_XQ = 0, LW_XKV = 8 * MiB, LW_XO = 24 * MiB, LW_PEER = 32 * MiB;
constexpr size_t WS_KVX = 131 * MiB, KVX_STRIDE = 32 * MiB;
constexpr size_t WS_POOL = 195 * MiB;
constexpr size_t P_H = WS_POOL;
constexpr size_t P_PROJ = WS_POOL + 128 * MiB;
constexpr size_t P_CONCAT = WS_POOL + 448 * MiB;
constexpr size_t P_GBUF = WS_POOL + 576 * MiB;
constexpr size_t P_MLAPROJ = WS_POOL + 128 * MiB;
constexpr size_t P_CQN = WS_POOL + 208 * MiB;
constexpr size_t P_CKVN = WS_POOL + 256 * MiB;
constexpr size_t P_KROPE = WS_POOL + 272 * MiB;
constexpr size_t P_Q = WS_POOL + 288 * MiB;
constexpr size_t P_KV = WS_POOL + 480 * MiB;
constexpr size_t P_QX = WS_POOL + 128 * MiB;
constexpr size_t P_S = WS_POOL + 256 * MiB;
constexpr size_t P_P = WS_POOL + 384 * MiB;
constexpr size_t P_OX = WS_POOL + 448 * MiB;
constexpr size_t P_SC = WS_POOL + 128 * MiB;
constexpr size_t P_UT = WS_POOL + 704 * MiB;
constexpr size_t P_VT = WS_POOL + 768 * MiB;
constexpr size_t P_MEMN = WS_POOL + 608 * MiB;
constexpr size_t P_WQB = WS_POOL + 640 * MiB;
constexpr size_t P_SK = WS_POOL + 656 * MiB;
constexpr size_t WS_END = WS_POOL + 832 * MiB;
constexpr int CW_BAR = 4096, CW_CTR = 16384;

constexpr int RING_BYTES = 131072, LDSCTL_OFF = RING_BYTES, LDS_BYTES = 147456;

DI unsigned pk2(float lo, float hi) { f32x2 v = {lo, hi}; bf16x2_t b = __builtin_convertvector(v, bf16x2_t); return __builtin_bit_cast(unsigned, b); }
DI float bflo(unsigned u) { return __uint_as_float(u << 16); }
DI float bfhi(unsigned u) { return __uint_as_float(u & 0xffff0000u); }
DI float bf2f(bf16_t b) { return __uint_as_float(((unsigned)b) << 16); }
DI bf16_t f2bf(float f) { return (bf16_t)(pk2(f, 0.f) & 0xffffu); }
DI float dot2bf(unsigned a, unsigned b, float c) { return __builtin_amdgcn_fdot2_f32_bf16(__builtin_bit_cast(bf16x2_t, a), __builtin_bit_cast(bf16x2_t, b), c, false); }
DI float wave_sum(float v) {
#pragma unroll
    for (int o = 1; o < 64; o <<= 1) v += __shfl_xor(v, o);
    return v;
}
DI float gelu_erf(float v) { return 0.5f * v * (1.0f + erff(v * 0.70710678118654752f)); }
DI float swap32_max(float x) { auto rr = __builtin_amdgcn_permlane32_swap(__float_as_uint(x), __float_as_uint(x), false, false); return fmaxf(__uint_as_float(rr[0]), __uint_as_float(rr[1])); }
DI float swap32_sum(float x) { auto rr = __builtin_amdgcn_permlane32_swap(__float_as_uint(x), __float_as_uint(x), false, false); return __uint_as_float(rr[0]) + __uint_as_float(rr[1]); }
#define LDS_WAIT() asm volatile("s_waitcnt lgkmcnt(0)" ::: "memory")
#define VM_WAIT() asm volatile("s_waitcnt vmcnt(0)" ::: "memory")

#define XB_TMO      128
#define XB_XCNT(j)  (256  + 64 * (j))
#define XB_XSUB(j)  (1280 + 64 * (j))
#define XB_XGEN(j)  (2304 + 64 * (j))
#define XB_TOP      3328
#define XB_TOPGEN   3392
#define XCD_BAR_WORDS 3456
#define XB_SPIN_CAP (1u << 20)
DI unsigned xb_ld(unsigned* p)              { return __hip_atomic_load(p, __ATOMIC_RELAXED, __HIP_MEMORY_SCOPE_AGENT); }
DI unsigned xb_add(unsigned* p, unsigned v) { return __hip_atomic_fetch_add(p, v, __ATOMIC_RELAXED, __HIP_MEMORY_SCOPE_AGENT); }
DI unsigned xb_xcc_id() { return (unsigned)__builtin_amdgcn_s_getreg((3 << 11) | 20) & 0xFu; }
#define XB_SPIN(cond, bar) do { unsigned _sp = 0; while (cond) { __builtin_amdgcn_s_sleep(1); \
    if ((++_sp & 255u) == 0u) { if (xb_ld(&(bar)[XB_TMO])) break; if (_sp > XB_SPIN_CAP) { atomicAdd(&(bar)[XB_TMO], 1u); break; } } } } while (0)
struct XcdBarrier { unsigned* bar; unsigned x; volatile LAS unsigned* st; };
DI XcdBarrier xcd_barrier_post(unsigned* bar, volatile LAS unsigned* st) {
    XcdBarrier b; b.bar = bar; b.x = xb_xcc_id(); b.st = st;
    if (threadIdx.x == 0) (void)xb_add(&bar[XB_XCNT(b.x)], 1u);
    return b;
}
DI void xcd_barrier_complete(unsigned* bar, unsigned x, unsigned& nloc, unsigned& nx) {
    const unsigned G = gridDim.x * gridDim.y * gridDim.z;
    unsigned sum, cnt, mine, sp = 0u;
    for (;;) {
        sum = 0u; cnt = 0u; mine = 0u;
#pragma unroll
        for (unsigned j = 0; j < 16; ++j) { const unsigned c = xb_ld(&bar[XB_XCNT(j)]); sum += c; cnt += (c > 0u) ? 1u : 0u; mine = (j == x) ? c : mine; }
        if (sum == G) break;
        __builtin_amdgcn_s_sleep(1);
        if ((++sp & 255u) == 0u) { if (xb_ld(&bar[XB_TMO])) break; if (sp > XB_SPIN_CAP) { atomicAdd(&bar[XB_TMO], 1u); break; } }
    }
    nloc = mine > 0u ? mine : 1u; nx = cnt > 0u ? cnt : 1u;
}
DI void xcd_barrier(const XcdBarrier& b) {
    asm volatile("s_waitcnt vmcnt(0)" ::: "memory");
    __syncthreads();
    if (threadIdx.x == 0) {
        unsigned* bar = b.bar;
        __builtin_amdgcn_s_waitcnt(0);
        unsigned nloc = b.st[0], nx = b.st[1];
        if (nloc == 0u) { xcd_barrier_complete(bar, b.x, nloc, nx); b.st[0] = nloc; b.st[1] = nx; }
        const unsigned old = xb_add(&bar[XB_XSUB(b.x)], 1u);
        const unsigned gen = old / nloc;
        if (old + 1u == (gen + 1u) * nloc) {
            __builtin_amdgcn_fence(__ATOMIC_RELEASE, "agent");
            asm volatile("s_waitcnt vmcnt(0)" ::: "memory");
            const unsigned og = xb_add(&bar[XB_TOP], 1u);
            const unsigned tg = og / nx;
            if (og + 1u == (tg + 1u) * nx) xb_add(&bar[XB_TOPGEN], 1u);
            else XB_SPIN(xb_ld(&bar[XB_TOPGEN]) == tg, bar);
            __builtin_amdgcn_fence(__ATOMIC_ACQUIRE, "agent");
            xb_add(&bar[XB_XGEN(b.x)], 1u);
            asm volatile("s_waitcnt vmcnt(0)" ::: "memory");
        } else {
            XB_SPIN(xb_ld(&bar[XB_XGEN(b.x)]) == gen, bar);
            __builtin_amdgcn_fence(__ATOMIC_ACQUIRE, "agent");
            asm volatile("s_waitcnt vmcnt(0)" ::: "memory");
        }
    }
    __syncthreads();
}

namespace g8 {
constexpr int BM = 256, BK = 64, HALF = 128, HTB = HALF * BK * 2, STAGE_BYTES = 8 * HTB, NXCD = 8, WGM = 8;
DI int lds_byte(int r, int c) { const int st = (r >> 4) * 2 + (c >> 5), rr = r & 15, cc = c & 31, ob = rr * 64 + cc * 2; return st * 1024 + (ob ^ (((ob >> 9) & 1) << 5)); }
DI void stage_rc(int b, int& R, int& C) { const int st = b / 1024, sb = b % 1024, swz = sb ^ (((sb >> 9) & 1) << 5); R = (st >> 1) * 16 + swz / 64; C = (st & 1) * 32 + (swz % 64) / 2; }
DI int perm32(int rho) { const int n = rho >> 4, i = rho & 15; return 8 * (i >> 2) + 4 * n + (i & 3); }

struct Unit { int zo, zi, pm, pn; };
struct Desc { const bf16_t* A; const bf16_t* Bt; int lda, ldb, K, nM, nN, nZo, nZi; long sAo, sAi, sBo, sBi; };
DI bool next_unit(const Desc& g, int i, int G, int c, Unit& u) {
    const int per = g.nM * g.nN, nwg = per * g.nZo * g.nZi;
    const long L = (long)i * G + c; if (L >= nwg) return false;
    int wgid = (int)L; { const int q = nwg / NXCD, r = nwg % NXCD, xcd = wgid % NXCD, off = wgid / NXCD; wgid = (xcd < r ? xcd * (q + 1) : r * (q + 1) + (xcd - r) * q) + off; }
    const int z = wgid / per, w = wgid % per;
    u.zo = z / g.nZi; u.zi = z % g.nZi;
    const int nig = WGM * g.nN, gid = w / nig, fm = gid * WGM, gsz = (g.nM - fm) < WGM ? (g.nM - fm) : WGM;
    u.pm = fm + ((w % nig) % gsz); u.pn = (w % nig) / gsz; return true;
}

template <class Epi>
DI void gemm_phase(LAS unsigned char* lds, const Desc g, const Epi& E, int G, int c) {
    const int tid = threadIdx.x, wid = __builtin_amdgcn_readfirstlane(tid >> 6), lane = tid & 63, wr = wid >> 2, wc = wid & 3, fr = lane & 15, fq = lane >> 4;
    const int K = g.K, nt = K / BK;
    unsigned voffA[2], voffB[2];
#pragma unroll
    for (int i = 0; i < 2; ++i) { int R, C; stage_rc(tid * 16 + i * 8192, R, C); const int Rb = (R & ~31) + perm32(R & 31);
        voffA[i] = (unsigned)(R * g.lda + C) * 2u; voffB[i] = (unsigned)(Rb * g.ldb + C) * 2u; }
    const size_t kstep = (size_t)(BK * 2);
    const size_t hstepA = (size_t)HALF * g.lda * 2, hstepB = (size_t)HALF * g.ldb * 2;
    const unsigned ldsw = (unsigned)wid * 1024u;
    const int aoff = lds_byte(wr * 64 + fr, fq * 8), boff = lds_byte(wc * 32 + fr, fq * 8);
#define PG8_SA(b, h) (((b) * 2 + (h)) * HTB)
#define PG8_SB(b, h) ((4 + (b) * 2 + (h)) * HTB)
#define PG8_STAGE(bufoff, gbase, voff) do { _Pragma("unroll") for (int _i = 0; _i < 2; ++_i) \
        __builtin_amdgcn_global_load_lds((const unsigned*)((const char*)(gbase) + (voff)[_i]), (LAS unsigned*)(lds + (bufoff) + ldsw + _i * 8192), 16, 0, 0); } while (0)
#define PG8_LDA(dst, b, h) do { _Pragma("unroll") for (int m = 0; m < 4; ++m) _Pragma("unroll") for (int k = 0; k < 2; ++k) dst[m][k] = *(const LAS bf16x8*)(lds + PG8_SA(b, h) + aoff + m * 2048 + k * 1024); } while (0)
#define PG8_LDB(dst, b, h) do { _Pragma("unroll") for (int n = 0; n < 2; ++n) _Pragma("unroll") for (int k = 0; k < 2; ++k) dst[n][k] = *(const LAS bf16x8*)(lds + PG8_SB(b, h) + boff + n * 2048 + k * 1024); } while (0)
#define PG8_MMA(ai, bj, At, Bt) do { __builtin_amdgcn_s_setprio(1); _Pragma("unroll") for (int m = 0; m < 4; ++m) _Pragma("unroll") for (int n = 0; n < 2; ++n) _Pragma("unroll") for (int k = 0; k < 2; ++k) \
        acc[ai][bj][m][n] = __builtin_amdgcn_mfma_f32_16x16x32_bf16(Bt[n][k], At[m][k], acc[ai][bj][m][n], 0, 0, 0); __builtin_amdgcn_s_setprio(0); } while (0)
#define PG8_WAIT_V(n) asm volatile("s_waitcnt vmcnt(" #n ")" ::: "memory")
#define PG8_WAIT_L(n) asm volatile("s_waitcnt lgkmcnt(" #n ")" ::: "memory")
#define PG8_BAR __builtin_amdgcn_s_barrier()
#define PG8_SCHED __builtin_amdgcn_sched_barrier(0)
#define PG8_APTR(u) ((const char*)g.A + ((size_t)(u).zo * g.sAo + (size_t)(u).zi * g.sAi + (size_t)(u).pm * BM * g.lda) * 2)
#define PG8_BPTR(u) ((const char*)g.Bt + ((size_t)(u).zo * g.sBo + (size_t)(u).zi * g.sBi + (size_t)(u).pn * BM * g.ldb) * 2)
    Unit cur, nxt; int ui = 0;
    if (!next_unit(g, 0, G, c, cur)) return;
    f32x4 acc[2][2][4][2];
#pragma unroll
    for (int a = 0; a < 2; ++a)
#pragma unroll
        for (int b = 0; b < 2; ++b)
#pragma unroll
            for (int m = 0; m < 4; ++m)
#pragma unroll
                for (int n = 0; n < 2; ++n) acc[a][b][m][n] = (f32x4){0.f, 0.f, 0.f, 0.f};
    bf16x8 At[4][2], B0[2][2], B1[2][2];
    const char* cA = PG8_APTR(cur); const char* cB = PG8_BPTR(cur);
    PG8_STAGE(PG8_SB(0, 0), cB, voffB); PG8_STAGE(PG8_SA(0, 0), cA, voffA); PG8_STAGE(PG8_SB(0, 1), cB + hstepB, voffB); PG8_STAGE(PG8_SA(0, 1), cA + hstepA, voffA);
    if (wr == 1) PG8_BAR;
    PG8_WAIT_V(4); PG8_BAR;
    PG8_STAGE(PG8_SB(1, 0), cB + kstep, voffB); PG8_STAGE(PG8_SA(1, 0), cA + kstep, voffA); PG8_STAGE(PG8_SB(1, 1), cB + hstepB + kstep, voffB);
    PG8_WAIT_V(6); PG8_BAR;
    for (;;) {
        const bool has_next = next_unit(g, ui + 1, G, c, nxt);
        const char* nA = has_next ? PG8_APTR(nxt) : cA; const char* nB = has_next ? PG8_BPTR(nxt) : cB;
        for (int t = 0; t < nt; t += 2) {
            const bool last = (t == nt - 2);
            const char* a1 = cA + (size_t)(t + 1) * kstep;
            const char* a2 = last ? nA : cA + (size_t)(t + 2) * kstep; const char* b2 = last ? nB : cB + (size_t)(t + 2) * kstep;
            const char* a3 = a2 + kstep; const char* b3 = b2 + kstep;
            PG8_LDB(B0, 0, 0); PG8_SCHED; PG8_LDA(At, 0, 0); PG8_STAGE(PG8_SA(1, 1), a1 + hstepA, voffA);
            PG8_WAIT_L(8); PG8_BAR; PG8_WAIT_L(0); PG8_MMA(0, 0, At, B0); PG8_BAR; PG8_SCHED;
            PG8_LDB(B1, 0, 1); PG8_STAGE(PG8_SB(0, 0), b2, voffB);
            PG8_BAR; PG8_WAIT_L(0); PG8_MMA(0, 1, At, B1); PG8_BAR;
            PG8_LDA(At, 0, 1); PG8_STAGE(PG8_SA(0, 0), a2, voffA);
            PG8_BAR; PG8_WAIT_L(0); PG8_MMA(1, 0, At, B0); PG8_BAR; PG8_SCHED;
            PG8_STAGE(PG8_SB(0, 1), b2 + hstepB, voffB);
            PG8_WAIT_V(6); PG8_BAR; PG8_MMA(1, 1, At, B1); PG8_BAR;
            PG8_LDB(B0, 1, 0); PG8_SCHED; PG8_LDA(At, 1, 0); PG8_STAGE(PG8_SA(0, 1), a2 + hstepA, voffA);
            PG8_WAIT_L(8); PG8_BAR; PG8_WAIT_L(0); PG8_MMA(0, 0, At, B0); PG8_BAR; PG8_SCHED;
            PG8_LDB(B1, 1, 1); PG8_STAGE(PG8_SB(1, 0), b3, voffB);
            PG8_BAR; PG8_WAIT_L(0); PG8_MMA(0, 1, At, B1); PG8_BAR;
            PG8_LDA(At, 1, 1); PG8_STAGE(PG8_SA(1, 0), a3, voffA);
            PG8_BAR; PG8_WAIT_L(0); PG8_MMA(1, 0, At, B0); PG8_BAR; PG8_SCHED;
            PG8_STAGE(PG8_SB(1, 1), b3 + hstepB, voffB);
            PG8_WAIT_V(6); PG8_BAR; PG8_MMA(1, 1, At, B1); PG8_BAR;
        }
        {
            const int row0 = cur.pm * BM + wr * 64 + fr, col0 = cur.pn * BM + wc * 32 + 8 * fq;
#pragma unroll
            for (int ai = 0; ai < 2; ++ai)
#pragma unroll
                for (int m = 0; m < 4; ++m)
#pragma unroll
                    for (int bj = 0; bj < 2; ++bj) E.oct(cur.zo, cur.zi, row0 + ai * HALF + m * 16, col0 + bj * HALF, acc[ai][bj][m][0], acc[ai][bj][m][1]);
        }
        if (!has_next) break;
#pragma unroll
        for (int a = 0; a < 2; ++a)
#pragma unroll
            for (int b = 0; b < 2; ++b)
#pragma unroll
                for (int m = 0; m < 4; ++m)
#pragma unroll
                    for (int n = 0; n < 2; ++n) acc[a][b][m][n] = (f32x4){0.f, 0.f, 0.f, 0.f};
        cur = nxt; cA = nA; cB = nB; ++ui;
    }
    PG8_WAIT_V(0);
    if (wr == 0) PG8_BAR;
    PG8_BAR;
#undef PG8_SA
#undef PG8_SB
#undef PG8_STAGE
#undef PG8_LDA
#undef PG8_LDB
#undef PG8_MMA
#undef PG8_WAIT_V
#undef PG8_WAIT_L
#undef PG8_BAR
#undef PG8_SCHED
#undef PG8_APTR
#undef PG8_BPTR
}

template <class Epi>
DI void naive_gemm(const Desc g, const Epi& E, int G, int c) {
    const int M = g.nM * BM, N = g.nN * BM, n8 = N / 8, nZ = g.nZo * g.nZi;
    const long total = (long)nZ * M * n8;
    for (long idx = (long)c * NTHREADS + threadIdx.x; idx < total; idx += (long)G * NTHREADS) {
        const int col = (int)(idx % n8) * 8; const int row = (int)((idx / n8) % M); const int z = (int)(idx / ((long)n8 * M));
        const int zo = z / g.nZi, zi = z % g.nZi;
        const bf16_t* a = g.A + (size_t)zo * g.sAo + (size_t)zi * g.sAi + (size_t)row * g.lda;
        const bf16_t* b = g.Bt + (size_t)zo * g.sBo + (size_t)zi * g.sBi + (size_t)col * g.ldb;
        float acc[8];
#pragma unroll
        for (int j = 0; j < 8; ++j) acc[j] = 0.f;
        for (int k = 0; k < g.K; k += 8) {
            const u32x4 av = *(const u32x4*)(a + k);
#pragma unroll
            for (int j = 0; j < 8; ++j) { const u32x4 bv = *(const u32x4*)(b + (size_t)j * g.ldb + k);
                float s = acc[j]; s = dot2bf(av.x, bv.x, s); s = dot2bf(av.y, bv.y, s); s = dot2bf(av.z, bv.z, s); s = dot2bf(av.w, bv.w, s); acc[j] = s; }
        }
        E.oct(zo, zi, row, col, (f32x4){acc[0], acc[1], acc[2], acc[3]}, (f32x4){acc[4], acc[5], acc[6], acc[7]});
    }
}
template <class Epi>
DI void gemm(LAS unsigned char* lds, const Desc g, const Epi& E, int G, int c) {
#if !EN_GEMM
    return;
#elif FAST_GEMM
    gemm_phase(lds, g, E, G, c);
#else
    naive_gemm(g, E, G, c);
#endif
}
}

struct EpiBf16 {
    bf16_t* O; long ldc, sZo, sZi; float scale;
    DI void oct(int zo, int zi, int row, int col, f32x4 lo, f32x4 hi) const {
        bf16_t* p = O + (size_t)zo * sZo + (size_t)zi * sZi + (size_t)row * ldc + col;
        u32x4 w; w.x = pk2(lo[0] * scale, lo[1] * scale); w.y = pk2(lo[2] * scale, lo[3] * scale); w.z = pk2(hi[0] * scale, hi[1] * scale); w.w = pk2(hi[2] * scale, hi[3] * scale);
        *(u32x4*)p = w;
    }
};
struct EpiF32 {
    float* O; long ldc, sZo, sZi; float scale;
    DI void oct(int zo, int zi, int row, int col, f32x4 lo, f32x4 hi) const {
        float* p = O + (size_t)zo * sZo + (size_t)zi * sZi + (size_t)row * ldc + col;
        *(f32x4*)p = lo * scale; *(f32x4*)(p + 4) = hi * scale;
    }
};
struct EpiResid {
    const float* resid; float* out; long ldc;
    DI void oct(int, int, int row, int col, f32x4 lo, f32x4 hi) const {
        const size_t o = (size_t)row * ldc + col;
        const f32x4 r0 = *(const f32x4*)(resid + o), r1 = *(const f32x4*)(resid + o + 4);
        *(f32x4*)(out + o) = r0 + lo; *(f32x4*)(out + o + 4) = r1 + hi;
    }
};
template <int MODE> struct EpiRope {
    bf16_t* O; long ldc; const int* pos; const f32x2* tab;
    DI void oct(int, int, int row, int col, f32x4 lo, f32x4 hi) const {
        bool rope; int j0;
        if (MODE == 0) { rope = col < 2 * DIFF_W; j0 = col & 63; } else { const int c = col % 192; rope = c >= 128; j0 = c - 128; }
        if (rope) {
            int p = pos[row]; p = p < 0 ? 0 : (p > ROPE_POS - 1 ? ROPE_POS - 1 : p);
            const f32x4* tp = (const f32x4*)(tab + (size_t)p * 32 + (j0 >> 1));
            const f32x4 t0 = tp[0], t1 = tp[1];
            f32x4 a = lo, b = hi;
            lo[0] = a[0] * t0[0] - a[1] * t0[1]; lo[1] = a[1] * t0[0] + a[0] * t0[1];
            lo[2] = a[2] * t0[2] - a[3] * t0[3]; lo[3] = a[3] * t0[2] + a[2] * t0[3];
            hi[0] = b[0] * t1[0] - b[1] * t1[1]; hi[1] = b[1] * t1[0] + b[0] * t1[1];
            hi[2] = b[2] * t1[2] - b[3] * t1[3]; hi[3] = b[3] * t1[2] + b[2] * t1[3];
        }
        u32x4 w; w.x = pk2(lo[0], lo[1]); w.y = pk2(lo[2], lo[3]); w.z = pk2(hi[0], hi[1]); w.w = pk2(hi[2], hi[3]);
        *(u32x4*)(O + (size_t)row * ldc + col) = w;
    }
};
struct EpiGlu {
    const bf16_t* gbuf; const float* bias; bf16_t* out;
    DI void oct(int, int, int row, int col, f32x4 lo, f32x4 hi) const {
        const u32x4 gv = *(const u32x4*)(gbuf + (size_t)row * S5_W + col);
        const f32x4 b0 = *(const f32x4*)(bias + col), b1 = *(const f32x4*)(bias + col + 4);
        float g[8] = {bflo(gv.x), bfhi(gv.x), bflo(gv.y), bfhi(gv.y), bflo(gv.z), bfhi(gv.z), bflo(gv.w), bfhi(gv.w)};
        float a[8] = {lo[0] + b0[0], lo[1] + b0[1], lo[2] + b0[2], lo[3] + b0[3], hi[0] + b1[0], hi[1] + b1[1], hi[2] + b1[2], hi[3] + b1[3]};
        float r[8];
#pragma unroll
        for (int j = 0; j < 8; ++j) r[j] = g[j] / (1.0f + __expf(-a[j]));
        u32x4 w; w.x = pk2(r[0], r[1]); w.y = pk2(r[2], r[3]); w.z = pk2(r[4], r[5]); w.w = pk2(r[6], r[7]);
        *(u32x4*)(out + (size_t)row * DM + DIFF_W + col) = w;
    }
};

struct EpiNull { DI void oct(int, int, int, int, f32x4 lo, f32x4 hi) const { asm volatile("" :: "v"(lo), "v"(hi)); } };
struct Params {
    const float* in[39];
    float* out; unsigned char* ws;
    int ph_lo, ph_hi;
};
enum { I_X = 0, I_MEM, I_POS, I_AB_NORM, I_AB_WIN, I_AB_WOUT, I_LQ1, I_LK1, I_LQ2, I_LK2, I_SUBLN, I_S5_ARE, I_S5_AIM, I_S5_LOGSTEP, I_S5_BRE, I_S5_BIM, I_S5_CRE, I_S5_CIM, I_S5_D,
       I_S5_WGLU, I_S5_BGLU, I_MLA_NORM, I_MLA_WIN, I_MLA_QNORM, I_MLA_KVNORM, I_MLA_WUQ, I_MLA_WUKV, I_MLA_WO, I_XA_NORM, I_XA_MEMNORM, I_XA_WQ, I_XA_WKV, I_XA_WO, I_FFN_NORM,
       I_PEER_WQ, I_PEER_SK, I_PEER_U, I_PEER_V, I_FINAL_NORM };

struct Ctx { LAS unsigned char* lds; int tid, lane, wave, blk, G; };

DI void rms_rows_2048(const Ctx& C, const float* src, const float* gain, bf16_t* dst, int nrows) {
    for (int r = C.blk * NWAVES + C.wave; r < nrows; r += C.G * NWAVES) {
        const f32x4* xr = (const f32x4*)(src + (size_t)r * DM) + C.lane;
        f32x4 v[8]; float ss = 0.f;
#pragma unroll
        for (int j = 0; j < 8; ++j) { v[j] = xr[64 * j]; ss += (v[j][0] * v[j][0] + v[j][1] * v[j][1]) + (v[j][2] * v[j][2] + v[j][3] * v[j][3]); }
        const float sc = rsqrtf(wave_sum(ss) * (1.0f / DM) + NORM_EPS);
        u32x2* o = (u32x2*)(dst + (size_t)r * DM) + C.lane;
#pragma unroll
        for (int j = 0; j < 8; ++j) { const f32x4 g = *((const f32x4*)gain + C.lane + 64 * j);
            u32x2 w; w.x = pk2(v[j][0] * sc * g[0], v[j][1] * sc * g[1]); w.y = pk2(v[j][2] * sc * g[2], v[j][3] * sc * g[3]); o[64 * j] = w; }
    }
}
DI void rms_rows_final(const Ctx& C, float* x, const float* gain, int nrows) {
    for (int r = C.blk * NWAVES + C.wave; r < nrows; r += C.G * NWAVES) {
        f32x4* xr = (f32x4*)(x + (size_t)r * DM) + C.lane;
        f32x4 v[8]; float ss = 0.f;
#pragma unroll
        for (int j = 0; j < 8; ++j) { v[j] = xr[64 * j]; ss += (v[j][0] * v[j][0] + v[j][1] * v[j][1]) + (v[j][2] * v[j][2] + v[j][3] * v[j][3]); }
        const float sc = rsqrtf(wave_sum(ss) * (1.0f / DM) + NORM_EPS);
#pragma unroll
        for (int j = 0; j < 8; ++j) { const f32x4 g = *((const f32x4*)gain + C.lane + 64 * j); xr[64 * j] = v[j] * sc * g; }
    }
}

DI int srccol(int kind, int n) {
    if (kind == 1) { if (n < 2 * DIFF_W) { const int j = n & 63; return (n & ~63) + (j >> 1) + 32 * (j & 1); } return n; }
    if (kind == 2) { if (n >= MLA_IN) return -1; if (n >= 1024) { const int j = n - 1024; return 1024 + (j >> 1) + 32 * (j & 1); } return n; }
    if (kind == 3) { const int c = n % 192; if (c >= 128) { const int j = c - 128; return n - c + 128 + (j >> 1) + 32 * (j & 1); } return n; }
    return n;
}
DI void transpose_item(const float* W, int K, int Nsrc, bf16_t* Wt, int nblk, int kind, LAS float* scr, int item, int lane) {
    const int kb = item / nblk, nb = item % nblk, k0 = 64 * kb, n0 = 32 * nb;
    const int src = srccol(kind, n0 + (lane & 31));
#pragma unroll 8
    for (int i = 0; i < 32; ++i) { const int kk = 2 * i + (lane >> 5); scr[kk * 33 + (lane & 31)] = (src >= 0) ? W[(size_t)(k0 + kk) * Nsrc + src] : 0.f; }
    LDS_WAIT(); asm volatile("" ::: "memory");
    const int c = lane & 7;
#pragma unroll
    for (int j = 0; j < 4; ++j) { const int n = (lane >> 3) + 8 * j; const LAS float* s = scr + (8 * c) * 33 + n;
        u32x4 o; o.x = pk2(s[0 * 33], s[1 * 33]); o.y = pk2(s[2 * 33], s[3 * 33]); o.z = pk2(s[4 * 33], s[5 * 33]); o.w = pk2(s[6 * 33], s[7 * 33]);
        *(u32x4*)(Wt + (size_t)(n0 + n) * K + k0 + 8 * c) = o; }
    LDS_WAIT(); asm volatile("" ::: "memory");
}
DI void cvt_bf16(const Ctx& C, const float* src, bf16_t* dst, size_t n8) {
    for (size_t i = (size_t)C.blk * NTHREADS + C.tid; i < n8; i += (size_t)C.G * NTHREADS) {
        const f32x4 a = *(const f32x4*)(src + i * 8), b = *(const f32x4*)(src + i * 8 + 4);
        u32x4 w; w.x = pk2(a[0], a[1]); w.y = pk2(a[2], a[3]); w.z = pk2(b[0], b[1]); w.w = pk2(b[2], b[3]);
        *(u32x4*)(dst + i * 8) = w;
    }
}


DI void cvt_fp8_rows(const Ctx& C, const float* src, unsigned char* dst, float* isc, int nrows) {
    for (int r = C.blk * NWAVES + C.wave; r < nrows; r += C.G * NWAVES) {
        const f32x4* xr = (const f32x4*)(src + (size_t)r * DM) + C.lane;
        f32x4 v[8]; float am = 0.f;
#pragma unroll
        for (int j = 0; j < 8; ++j) { v[j] = xr[64 * j]; am = fmaxf(am, fmaxf(fmaxf(fabsf(v[j][0]), fabsf(v[j][1])), fmaxf(fabsf(v[j][2]), fabsf(v[j][3])))); }
#pragma unroll
        for (int o = 1; o < 64; o <<= 1) am = fmaxf(am, __shfl_xor(am, o));
        const float e = am > 0.f ? floorf(log2f(448.0f / am)) : 0.f;
        const float scale = exp2f(e);
        if (C.lane == 0) isc[r] = exp2f(-e);
        unsigned* o = (unsigned*)(dst + (size_t)r * DM) + C.lane;
#pragma unroll
        for (int j = 0; j < 8; ++j) { int w = 0; w = __builtin_amdgcn_cvt_pk_fp8_f32(v[j][0] * scale, v[j][1] * scale, w, false); w = __builtin_amdgcn_cvt_pk_fp8_f32(v[j][2] * scale, v[j][3] * scale, w, true); o[64 * j] = (unsigned)w; }
    }
}

DI void convert_tables(const Ctx& C, const Params& P, int l) {
    unsigned char* ws = P.ws;
#if PEER_FP8
    cvt_fp8_rows(C, P.in[I_PEER_U] + (size_t)l * PEER_NE * DM, ws + P_UT, (float*)(ws + P_UT + 32 * MiB), PEER_NE);
    cvt_fp8_rows(C, P.in[I_PEER_V] + (size_t)l * PEER_NE * DM, ws + P_VT, (float*)(ws + P_VT + 32 * MiB), PEER_NE);
#else
    cvt_bf16(C, P.in[I_PEER_U] + (size_t)l * PEER_NE * DM, (bf16_t*)(ws + P_UT), (size_t)PEER_NE * DM / 8);
    cvt_bf16(C, P.in[I_PEER_V] + (size_t)l * PEER_NE * DM, (bf16_t*)(ws + P_VT), (size_t)PEER_NE * DM / 8);
#endif
}

DI void phase_prologue(const Ctx& C, const Params& P) {
    unsigned char* ws = P.ws;
    LAS float* scr = (LAS float*)(C.lds + C.wave * 8448);
    const int gw = C.blk * NWAVES + C.wave, NGW = C.G * NWAVES;
    int base = 0;
#define TJOB(Wp, K_, Nsrc_, Nout_, kind_, dst_) do { const int nblk_ = (Nout_) / 32, nit_ = ((K_) / 64) * nblk_; \
        int first_ = (gw - base % NGW + NGW) % NGW; \
        for (int it = first_; it < nit_; it += NGW) transpose_item((Wp), (K_), (Nsrc_), (bf16_t*)(dst_), nblk_, (kind_), scr, it, C.lane); base += nit_; } while (0)
    TJOB(P.in[I_AB_WIN], DM, AB_IN, AB_IN, 1, ws + WS_ABIN_T);
    TJOB(P.in[I_AB_WOUT], DM, DM, DM, 0, ws + WS_ABOUT_T);
    TJOB(P.in[I_S5_WGLU], S5_W, S5_W, S5_W, 0, ws + WS_GLU_T);
    TJOB(P.in[I_MLA_WIN], DM, MLA_IN, MLA_IN_PAD, 2, ws + WS_MLAIN_T);
    TJOB(P.in[I_MLA_WUQ], MLA_QR, 3072, 3072, 3, ws + WS_UQ_T);
    TJOB(P.in[I_MLA_WUKV], MLA_KVR, 4096, 4096, 0, ws + WS_UKV_T);
    TJOB(P.in[I_MLA_WO], DM, DM, DM, 0, ws + WS_MLAO_T);
    for (int l = 0; l < 2; ++l) {
        TJOB(P.in[I_XA_WQ] + (size_t)l * DM * DM, DM, DM, DM, 0, ws + WS_LW + l * LW_STRIDE + LW_XQ);
        TJOB(P.in[I_XA_WKV] + (size_t)l * DM * 2 * DM, DM, 2 * DM, 2 * DM, 0, ws + WS_LW + l * LW_STRIDE + LW_XKV);
        TJOB(P.in[I_XA_WO] + (size_t)l * DM * DM, DM, DM, DM, 0, ws + WS_LW + l * LW_STRIDE + LW_XO);
    }
#undef TJOB
    {
        f32x2* tab = (f32x2*)(ws + WS_ROPE);
        for (int i = C.blk * NTHREADS + C.tid; i < ROPE_POS * 32; i += C.G * NTHREADS) {
            const int p = i >> 5, f = i & 31;
            const float inv = powf(10000.0f, -(float)f * (2.0f / 64.0f));
            const float ang = (float)p * inv;
            tab[i] = (f32x2){(float)cos((double)ang), (float)sin((double)ang)};
        }
    }
    cvt_bf16(C, P.in[I_PEER_WQ], (bf16_t*)(ws + P_WQB), (size_t)2 * DM * DM / 8);
    {
        bf16_t* sk = (bf16_t*)(ws + P_SK); const float* skin = P.in[I_PEER_SK];
        for (int i = C.blk * NTHREADS + C.tid; i < 2 * 8 * 256 * 256 / 8; i += C.G * NTHREADS) {
            const int q8 = (i & 31) * 8, np = (i >> 5) & 255, lh = i >> 13;
            const int c = np >> 7, n = np & 127, c2 = q8 >> 7, q = q8 & 127;
            u32x4 w = {0u, 0u, 0u, 0u};
            if (c == c2) { const float* s = skin + ((((size_t)lh * 2 + c) * 128 + n) * 128 + q);
                const f32x4 a = *(const f32x4*)s, b = *(const f32x4*)(s + 4);
                w.x = pk2(a[0], a[1]); w.y = pk2(a[2], a[3]); w.z = pk2(b[0], b[1]); w.w = pk2(b[2], b[3]); }
            *(u32x4*)(sk + (size_t)i * 8) = w;
        }
    }
    convert_tables(C, P, 0);
    for (int l = 0; l < 2; ++l) rms_rows_2048(C, P.in[I_MEM], P.in[I_XA_MEMNORM] + l * DM, (bf16_t*)(ws + P_MEMN) + (size_t)l * MT * DM, MT);
}

DI void phase_s5(const Ctx& C, const Params& P, int first, int last, int stride_w, int stride) {
    unsigned char* ws = P.ws;
    const bf16_t* proj = (const bf16_t*)(ws + P_PROJ); bf16_t* gbuf = (bf16_t*)(ws + P_GBUF);
    LAS unsigned char* my = C.lds + C.wave * 8192;
    LAS float* U = (LAS float*)my;
    LAS bf16_t* H = (LAS bf16_t*)(my + 1024);
    const int lane = C.lane, n = lane;
    for (int task = first + C.wave * stride_w; task < last; task += stride) {
        const int b = task >> 5, g = task & 31;
        const float a_re = P.in[I_S5_ARE][g * 64 + n], a_im = P.in[I_S5_AIM][g * 64 + n];
        const float step = expf(P.in[I_S5_LOGSTEP][g]);
        const float mag = expf(a_re * step);
        const float ab_re = mag * cosf(a_im * step), ab_im = mag * sinf(a_im * step);
        const float den = a_re * a_re + a_im * a_im, num_re = ab_re - 1.0f;
        const float f_re = (num_re * a_re + ab_im * a_im) / den, f_im = (ab_im * a_re - num_re * a_im) / den;
        float bbr[16], bbi[16];
        {
            const float* br = P.in[I_S5_BRE] + ((size_t)g * 64 + n) * 16; const float* bi = P.in[I_S5_BIM] + ((size_t)g * 64 + n) * 16;
#pragma unroll
            for (int p = 0; p < 16; ++p) { const float x = br[p], y = bi[p]; bbr[p] = f_re * x - f_im * y; bbi[p] = f_re * y + f_im * x; }
        }
        bf16x8 cf[4];
        {
            const int p = lane & 15, kq = lane >> 4;
#pragma unroll
            for (int kk = 0; kk < 4; ++kk) {
                const int k = 32 * kk + 8 * kq; const bool im = k >= 64;
                const float* src = (im ? P.in[I_S5_CIM] : P.in[I_S5_CRE]) + ((size_t)g * 16 + p) * 64 + (k & 63);
                const float sg = im ? -1.f : 1.f;
                const f32x4 a = *(const f32x4*)src, bq = *(const f32x4*)(src + 4);
                u32x4 w; w.x = pk2(sg * a[0], sg * a[1]); w.y = pk2(sg * a[2], sg * a[3]); w.z = pk2(sg * bq[0], sg * bq[1]); w.w = pk2(sg * bq[2], sg * bq[3]);
                cf[kk] = __builtin_bit_cast(bf16x8, w);
            }
        }
        const float dcoef = P.in[I_S5_D][g * 16 + (lane & 15)];
        float h_re = 0.f, h_im = 0.f;
        const bf16_t* ub = proj + (size_t)b * SEQ * AB_IN + 3 * DIFF_W + g * 16;
        for (int s0 = 0; s0 < SEQ; s0 += 16) {
            {
                const int st = lane >> 2, pp = (lane & 3) * 4;
                const u32x2 uv = *(const u32x2*)(ub + (size_t)(s0 + st) * AB_IN + pp);
                *(LAS f32x4*)(U + st * 16 + pp) = (f32x4){bflo(uv.x), bfhi(uv.x), bflo(uv.y), bfhi(uv.y)};
            }
            LDS_WAIT(); asm volatile("" ::: "memory");
#pragma unroll 4
            for (int st = 0; st < 16; ++st) {
                const f32x4 u0 = *(const LAS f32x4*)(U + st * 16), u1 = *(const LAS f32x4*)(U + st * 16 + 4), u2 = *(const LAS f32x4*)(U + st * 16 + 8), u3 = *(const LAS f32x4*)(U + st * 16 + 12);
                const float uu[16] = {u0[0], u0[1], u0[2], u0[3], u1[0], u1[1], u1[2], u1[3], u2[0], u2[1], u2[2], u2[3], u3[0], u3[1], u3[2], u3[3]};
                float br = 0.f, bi = 0.f;
#pragma unroll
                for (int p = 0; p < 16; ++p) { br = fmaf(bbr[p], uu[p], br); bi = fmaf(bbi[p], uu[p], bi); }
                const float nr = ab_re * h_re - ab_im * h_im + br, ni = ab_re * h_im + ab_im * h_re + bi;
                h_re = nr; h_im = ni;
                H[st * 136 + n] = f2bf(h_re); H[st * 136 + 64 + n] = f2bf(h_im);
            }
            LDS_WAIT(); asm volatile("" ::: "memory");
            f32x4 acc = {0.f, 0.f, 0.f, 0.f};
#pragma unroll
            for (int kk = 0; kk < 4; ++kk) {
                const bf16x8 af = *(const LAS bf16x8*)((LAS unsigned char*)H + (lane & 15) * 272 + (32 * kk + 8 * (lane >> 4)) * 2);
                acc = __builtin_amdgcn_mfma_f32_16x16x32_bf16(af, cf[kk], acc, 0, 0, 0);
            }
#pragma unroll
            for (int r = 0; r < 4; ++r) {
                const int st = (lane >> 4) * 4 + r, p = lane & 15;
                const float y = acc[r] + dcoef * U[st * 16 + p];
                gbuf[(size_t)(b * SEQ + s0 + st) * S5_W + g * 16 + p] = f2bf(gelu_erf(y));
            }
            LDS_WAIT(); asm volatile("" ::: "memory");
        }
    }
}

struct AttnArgs { const bf16_t* Qn; const bf16_t* Qr; const bf16_t* Kn; const bf16_t* Kr; const bf16_t* V; int ldq, ldkn, ldkr, ldv; };
DI int crow(int r, int hi) { return (r & 3) + 8 * (r >> 2) + 4 * hi; }
template <int DK> DI int koff(int row, int ch) { return DK == 64 ? row * 128 + 16 * (ch ^ ((row >> 1) & 7)) : row * 256 + 16 * (ch ^ (row & 15)); }
DI int voff(int row, int ch) { return 256 * row + 16 * (ch ^ (((row & 3) << 2) | ((row >> 2) & 3))); }
DI bf16x8 pack8(const f32x16& p, int s) {
    u32x4 w; w.x = pk2(p[8 * s + 0], p[8 * s + 1]); w.y = pk2(p[8 * s + 2], p[8 * s + 3]); w.z = pk2(p[8 * s + 4], p[8 * s + 5]); w.w = pk2(p[8 * s + 6], p[8 * s + 7]);
    return __builtin_bit_cast(bf16x8, w);
}
DI s16x4 vtr(const LAS unsigned char* p) { return __builtin_bit_cast(s16x4, __builtin_amdgcn_ds_read_tr16_b64_v4i16((LAS s16x4*)p)); }

template <int DKN, int DKR>
DI void attn_core(const AttnArgs& a, int q0, LAS unsigned char* lds, float scale, f32x16 (&o)[4]) {
    const int tid = threadIdx.x, wid = __builtin_amdgcn_readfirstlane(tid >> 6), lane = tid & 63, r32 = lane & 31, hi = lane >> 5;
    constexpr int CN = DKN / 8, NLK = CN * 64 / NTHREADS, KNB = 64 * DKN * 2, KRB = 64 * DKR * 2, VOFF = KNB + KRB, BUF = VOFF + 16384;
    static_assert(2 * BUF <= RING_BYTES, "attention LDS");
    bf16x8 qn[DKN / 16]; bf16x8 qr[DKR ? DKR / 16 : 1];
    {
        const bf16_t* qp = a.Qn + (size_t)(q0 + 32 * wid + r32) * a.ldq + hi * 8;
#pragma unroll
        for (int d0 = 0; d0 < DKN / 16; ++d0) qn[d0] = *(const bf16x8*)(qp + d0 * 16);
        if (DKR) { const bf16_t* qp2 = a.Qr + (size_t)(q0 + 32 * wid + r32) * a.ldq + hi * 8;
#pragma unroll
            for (int d0 = 0; d0 < DKR / 16; ++d0) qr[d0] = *(const bf16x8*)(qp2 + d0 * 16); }
    }
    const int NT = (q0 + 256) / 64, NTw = (q0 + 32 * wid + 31) / 64 + 1;
    u32x4 skn[NLK], skr, sv[2];
#define AT_LOAD(t) do { _Pragma("unroll") for (int i_ = 0; i_ < NLK; ++i_) { const int id_ = tid + NTHREADS * i_, row_ = id_ / CN, ch_ = id_ % CN; \
            skn[i_] = *(const u32x4*)(a.Kn + (size_t)((t) * 64 + row_) * a.ldkn + ch_ * 8); } \
        if (DKR) { const int row_ = tid >> 3, ch_ = tid & 7; skr = *(const u32x4*)(a.Kr + (size_t)((t) * 64 + row_) * a.ldkr + ch_ * 8); } \
        _Pragma("unroll") for (int i_ = 0; i_ < 2; ++i_) { const int id_ = tid + NTHREADS * i_, row_ = id_ >> 4, ch_ = id_ & 15; \
            sv[i_] = *(const u32x4*)(a.V + (size_t)((t) * 64 + row_) * a.ldv + ch_ * 8); } } while (0)
#define AT_WRITE(bf) do { LAS unsigned char* bb_ = lds + (bf) * BUF; \
        _Pragma("unroll") for (int i_ = 0; i_ < NLK; ++i_) { const int id_ = tid + NTHREADS * i_, row_ = id_ / CN, ch_ = id_ % CN; *(LAS u32x4*)(bb_ + koff<DKN>(row_, ch_)) = skn[i_]; } \
        if (DKR) { const int row_ = tid >> 3, ch_ = tid & 7; *(LAS u32x4*)(bb_ + KNB + koff<64>(row_, ch_)) = skr; } \
        _Pragma("unroll") for (int i_ = 0; i_ < 2; ++i_) { const int id_ = tid + NTHREADS * i_, row_ = id_ >> 4, ch_ = id_ & 15; *(LAS u32x4*)(bb_ + VOFF + voff(row_, ch_)) = sv[i_]; } } while (0)
    const float Cs = scale * 1.4426950408889634f;
    float m_run = -1e30f, l_run = 0.f;
#pragma unroll
    for (int blk = 0; blk < 4; ++blk)
#pragma unroll
        for (int r = 0; r < 16; ++r) o[blk][r] = 0.f;
    AT_LOAD(0); AT_WRITE(0); if (NT > 1) AT_LOAD(1);
    for (int t = 0; t < NT; ++t) {
        __syncthreads();
        if (t + 1 < NT) AT_WRITE((t + 1) & 1);
        if (t + 2 < NT) AT_LOAD(t + 2);
        if (t < NTw) {
            const LAS unsigned char* base = lds + (t & 1) * BUF;
            int r32v = r32, lanev = lane; asm volatile("" : "+v"(r32v), "+v"(lanev));
            int vb[4][2];
            {
                const int i = lanev & 15, q_ = i >> 2, p_ = i & 3, grp1 = (lanev >> 4) & 1, hv = lanev >> 5, low2 = 2 * grp1 + (p_ >> 1);
#pragma unroll
                for (int blk = 0; blk < 4; ++blk)
#pragma unroll
                    for (int x = 0; x < 2; ++x) vb[blk][x] = VOFF + 256 * (8 * x + 4 * hv + q_) + 16 * (4 * (blk ^ q_) + (low2 ^ (hv + 2 * x))) + 8 * (p_ & 1);
            }
            f32x16 p0, p1;
#pragma unroll
            for (int r = 0; r < 16; ++r) { p0[r] = 0.f; p1[r] = 0.f; }
#pragma unroll
            for (int d0 = 0; d0 < DKN / 16; ++d0) {
                const bf16x8 b0 = *(const LAS bf16x8*)(base + koff<DKN>(r32v, 2 * d0 + hi)), b1 = *(const LAS bf16x8*)(base + koff<DKN>(32 + r32v, 2 * d0 + hi));
                p0 = __builtin_amdgcn_mfma_f32_32x32x16_bf16(b0, qn[d0], p0, 0, 0, 0); p1 = __builtin_amdgcn_mfma_f32_32x32x16_bf16(b1, qn[d0], p1, 0, 0, 0);
            }
            if (DKR) {
#pragma unroll
                for (int d0 = 0; d0 < DKR / 16; ++d0) {
                    const bf16x8 b0 = *(const LAS bf16x8*)(base + KNB + koff<64>(r32v, 2 * d0 + hi)), b1 = *(const LAS bf16x8*)(base + KNB + koff<64>(32 + r32v, 2 * d0 + hi));
                    p0 = __builtin_amdgcn_mfma_f32_32x32x16_bf16(b0, qr[d0], p0, 0, 0, 0); p1 = __builtin_amdgcn_mfma_f32_32x32x16_bf16(b1, qr[d0], p1, 0, 0, 0);
                }
            }
            if (t == NTw - 1) {
                const int qrel = q0 + 32 * wid + r32 - 64 * t;
#pragma unroll
                for (int r = 0; r < 16; ++r) { const int kv = crow(r, hi); if (kv > qrel) p0[r] = -INFINITY; if (kv + 32 > qrel) p1[r] = -INFINITY; }
            }
            float pmax = p0[0];
#pragma unroll
            for (int r = 1; r < 16; ++r) pmax = fmaxf(pmax, p0[r]);
#pragma unroll
            for (int r = 0; r < 16; ++r) pmax = fmaxf(pmax, p1[r]);
            pmax = swap32_max(pmax);
            const float mn = fmaxf(m_run, pmax);
            const float alpha = __builtin_amdgcn_exp2f((m_run - mn) * Cs);
            m_run = mn;
            const float mnC = -mn * Cs;
            float ps = 0.f;
#pragma unroll
            for (int r = 0; r < 16; ++r) { p0[r] = __builtin_amdgcn_exp2f(fmaf(p0[r], Cs, mnC)); p1[r] = __builtin_amdgcn_exp2f(fmaf(p1[r], Cs, mnC)); ps += p0[r] + p1[r]; }
            l_run = l_run * alpha + ps;
            if (!__all(alpha == 1.0f)) {
#pragma unroll
                for (int blk = 0; blk < 4; ++blk)
#pragma unroll
                    for (int r = 0; r < 16; ++r) o[blk][r] *= alpha;
            }
            bf16x8 pb[4]; pb[0] = pack8(p0, 0); pb[1] = pack8(p0, 1); pb[2] = pack8(p1, 0); pb[3] = pack8(p1, 1);
#pragma unroll
            for (int blk = 0; blk < 4; ++blk) {
                s16x4 lo[4], hh[4];
#pragma unroll
                for (int ks = 0; ks < 4; ++ks) { lo[ks] = vtr(base + vb[blk][0] + 4096 * ks); hh[ks] = vtr(base + vb[blk][1] + 4096 * ks); }
#pragma unroll
                for (int ks = 0; ks < 4; ++ks) {
                    const bf16x8 af = {lo[ks][0], lo[ks][1], lo[ks][2], lo[ks][3], hh[ks][0], hh[ks][1], hh[ks][2], hh[ks][3]};
                    o[blk] = __builtin_amdgcn_mfma_f32_32x32x16_bf16(af, pb[ks], o[blk], 0, 0, 0);
                }
                __builtin_amdgcn_sched_barrier(0);
            }
        }
    }
    __syncthreads();
    const float linv = 1.0f / swap32_sum(l_run);
#pragma unroll
    for (int blk = 0; blk < 4; ++blk)
#pragma unroll
        for (int r = 0; r < 16; ++r) o[blk][r] *= linv;
#undef AT_LOAD
#undef AT_WRITE
}
DI void attn_store(const f32x16 (&o)[4], bf16_t* dst, int ld, int q0) {
    const int tid = threadIdx.x, wid = tid >> 6, lane = tid & 63, r32 = lane & 31, hi = lane >> 5;
    bf16_t* rp = dst + (size_t)(q0 + 32 * wid + r32) * ld;
#pragma unroll
    for (int blk = 0; blk < 4; ++blk)
#pragma unroll
        for (int g = 0; g < 4; ++g) {
            u32x2 w; w.x = pk2(o[blk][4 * g], o[blk][4 * g + 1]); w.y = pk2(o[blk][4 * g + 2], o[blk][4 * g + 3]);
            *(u32x2*)(rp + 32 * blk + 8 * g + 4 * hi) = w;
        }
}
DI int queue_pop(const Ctx& C, unsigned* ctr, int total) {
    volatile LAS int* slot = (volatile LAS int*)(C.lds + LDSCTL_OFF + 64);
    __syncthreads();
    if (C.tid == 0) *slot = (int)__hip_atomic_fetch_add(ctr, 1u, __ATOMIC_RELAXED, __HIP_MEMORY_SCOPE_AGENT);
    __syncthreads();
    const int u = *slot;
    return u < total ? u : -1;
}
DI float diff_lambda(const Params& P) {
    float s1 = 0.f, s2 = 0.f;
    for (int i = 0; i < 64; ++i) { s1 += P.in[I_LQ1][i] * P.in[I_LK1][i]; s2 += P.in[I_LQ2][i] * P.in[I_LK2][i]; }
    return expf(s1) - expf(s2) + 0.2f;
}

#if FAST_ATTN
DI void phase_diff_attn(const Ctx& C, const Params& P, int qi) {
    unsigned char* ws = P.ws;
    const bf16_t* proj = (const bf16_t*)(ws + P_PROJ); bf16_t* concat = (bf16_t*)(ws + P_CONCAT);
    unsigned* ctr = (unsigned*)(ws + WS_CTL) + CW_CTR + 64 * qi;
    const float lam = diff_lambda(P);
    const int NBH = BATCH * DIFF_HEADS, NS5 = BATCH * 32 / NWAVES, total = NS5 + NBH * 8;
    const int lane = C.lane, r32 = lane & 31, hi = lane >> 5;
    for (;;) {
        int u = queue_pop(C, ctr, total); if (u < 0) break;
        if (u < NS5) { phase_s5(C, P, u * NWAVES, u * NWAVES + NWAVES, 1, NWAVES); continue; }
        u -= NS5;
        const int qb = 7 - u / NBH, bh = u % NBH, b = bh / DIFF_HEADS, h = bh % DIFF_HEADS;
        const bf16_t* base = proj + (size_t)b * SEQ * AB_IN;
        AttnArgs a; a.ldq = AB_IN; a.ldkn = AB_IN; a.ldkr = 0; a.ldv = AB_IN; a.Qr = nullptr; a.Kr = nullptr;
        a.V = base + 2 * DIFF_W + h * 128;
        f32x16 o2[4];
        bf16_t* dst = concat + (size_t)b * SEQ * DM + h * 128;
        a.Qn = base + h * 128; a.Kn = base + DIFF_W + h * 128;
        attn_core<64, 0>(a, qb * 256, C.lds, 0.125f, o2);
        attn_store(o2, dst, DM, qb * 256);
        a.Qn = base + h * 128 + 64; a.Kn = base + DIFF_W + h * 128 + 64;
        attn_core<64, 0>(a, qb * 256, C.lds, 0.125f, o2);
        float ss = 0.f;
        {
            const bf16_t* rp = dst + (size_t)(qb * 256 + 32 * C.wave + r32) * DM;
#pragma unroll
            for (int blk = 0; blk < 4; ++blk)
#pragma unroll
                for (int g = 0; g < 4; ++g) {
                    const u32x2 w = *(const u32x2*)(rp + 32 * blk + 8 * g + 4 * hi);
                    const float o1v[4] = {bflo(w.x), bfhi(w.x), bflo(w.y), bfhi(w.y)};
#pragma unroll
                    for (int j = 0; j < 4; ++j) { const float v = o1v[j] - lam * o2[blk][4 * g + j]; o2[blk][4 * g + j] = v; ss += v * v; }
                }
        }
        ss = swap32_sum(ss);
        const float rs = rsqrtf(ss * (1.0f / 128.0f) + NORM_EPS) * 0.8f;
        const float* sub = P.in[I_SUBLN];
#pragma unroll
        for (int blk = 0; blk < 4; ++blk)
#pragma unroll
            for (int r = 0; r < 16; ++r) o2[blk][r] *= rs * sub[32 * blk + crow(r, hi)];
        attn_store(o2, dst, DM, qb * 256);
    }
}
DI void phase_mla_attn(const Ctx& C, const Params& P, int qi) {
    unsigned char* ws = P.ws;
    const bf16_t* q = (const bf16_t*)(ws + P_Q); const bf16_t* kv = (const bf16_t*)(ws + P_KV); const bf16_t* kr = (const bf16_t*)(ws + P_KROPE);
    bf16_t* ob = (bf16_t*)(ws + P_H);
    unsigned* ctr = (unsigned*)(ws + WS_CTL) + CW_CTR + 64 * qi;
    const int NBH = BATCH * MLA_HEADS, total = NBH * 8;
    for (;;) {
        const int u = queue_pop(C, ctr, total); if (u < 0) break;
        const int qb = 7 - u / NBH, bh = u % NBH, b = bh / MLA_HEADS, h = bh % MLA_HEADS;
        AttnArgs a; a.ldq = 3072; a.ldkn = 4096; a.ldkr = 64; a.ldv = 4096;
        a.Qn = q + (size_t)b * SEQ * 3072 + h * 192; a.Qr = a.Qn + 128;
        a.Kn = kv + (size_t)b * SEQ * 4096 + h * 256; a.V = a.Kn + 128; a.Kr = kr + (size_t)b * SEQ * 64;
        f32x16 o[4];
        attn_core<128, 64>(a, qb * 256, C.lds, 0.07216878364870322f, o);
        attn_store(o, ob + (size_t)b * SEQ * DM + h * 128, DM, qb * 256);
    }
}
#else
template <int DK> DI void naive_attn_row(const bf16_t* qrow, const bf16_t* qrow2, const bf16_t* Kn, int ldkn, const bf16_t* Kr, int ldkr, const bf16_t* V, int ldv, int nkeys, float scale, int lane, float& o0, float& o1) {
    float qv[3];
#pragma unroll
    for (int j = 0; j < 3; ++j) { const int d = lane + 64 * j; qv[j] = 0.f; if (d < DK) qv[j] = (DK == 192 && d >= 128) ? bf2f(qrow2[d - 128]) : bf2f(qrow[d]); }
    float m = -1e30f, l = 0.f; o0 = 0.f; o1 = 0.f;
    for (int k = 0; k < nkeys; ++k) {
        float s = 0.f;
#pragma unroll
        for (int j = 0; j < 3; ++j) { const int d = lane + 64 * j; if (d < DK) { const float kvv = (DK == 192 && d >= 128) ? bf2f(Kr[(size_t)k * ldkr + d - 128]) : bf2f(Kn[(size_t)k * ldkn + d]); s += qv[j] * kvv; } }
        s = wave_sum(s) * scale;
        const float mn = fmaxf(m, s), al = expf(m - mn), p = expf(s - mn);
        m = mn; l = l * al + p;
        o0 = o0 * al + p * bf2f(V[(size_t)k * ldv + lane]); o1 = o1 * al + p * bf2f(V[(size_t)k * ldv + 64 + lane]);
    }
    o0 /= l; o1 /= l;
}
DI void phase_diff_attn(const Ctx& C, const Params& P, int) {
    unsigned char* ws = P.ws;
    const bf16_t* proj = (const bf16_t*)(ws + P_PROJ); bf16_t* concat = (bf16_t*)(ws + P_CONCAT);
    const float lam = diff_lambda(P);
    const int lane = C.lane;
    for (int it = C.blk * NWAVES + C.wave; it < BATCH * DIFF_HEADS * SEQ; it += C.G * NWAVES) {
        const int s = it % SEQ, bh = it / SEQ, b = bh / DIFF_HEADS, h = bh % DIFF_HEADS;
        const bf16_t* base = proj + (size_t)b * SEQ * AB_IN;
        const bf16_t* qrow = base + (size_t)s * AB_IN + h * 128;
        float a0, a1, b0, b1;
        naive_attn_row<64>(qrow, nullptr, base + DIFF_W + h * 128, AB_IN, nullptr, 0, base + 2 * DIFF_W + h * 128, AB_IN, s + 1, 0.125f, lane, a0, a1);
        naive_attn_row<64>(qrow + 64, nullptr, base + DIFF_W + h * 128 + 64, AB_IN, nullptr, 0, base + 2 * DIFF_W + h * 128, AB_IN, s + 1, 0.125f, lane, b0, b1);
        const float v0 = a0 - lam * b0, v1 = a1 - lam * b1;
        const float ss = wave_sum(v0 * v0 + v1 * v1);
        const float rs = rsqrtf(ss * (1.0f / 128.0f) + NORM_EPS) * 0.8f;
        bf16_t* orow = concat + (size_t)(b * SEQ + s) * DM + h * 128;
        orow[lane] = f2bf(v0 * rs * P.in[I_SUBLN][lane]); orow[64 + lane] = f2bf(v1 * rs * P.in[I_SUBLN][64 + lane]);
    }
}
DI void phase_mla_attn(const Ctx& C, const Params& P, int) {
    unsigned char* ws = P.ws;
    const bf16_t* q = (const bf16_t*)(ws + P_Q); const bf16_t* kv = (const bf16_t*)(ws + P_KV); const bf16_t* kr = (const bf16_t*)(ws + P_KROPE);
    bf16_t* ob = (bf16_t*)(ws + P_H);
    const int lane = C.lane;
    for (int it = C.blk * NWAVES + C.wave; it < BATCH * MLA_HEADS * SEQ; it += C.G * NWAVES) {
        const int s = it % SEQ, bh = it / SEQ, b = bh / MLA_HEADS, h = bh % MLA_HEADS;
        const bf16_t* qrow = q + (size_t)(b * SEQ + s) * 3072 + h * 192;
        const bf16_t* kn = kv + (size_t)b * SEQ * 4096 + h * 256;
        float a0, a1;
        naive_attn_row<192>(qrow, qrow + 128, kn, 4096, kr + (size_t)b * SEQ * 64, 64, kn + 128, 4096, s + 1, 0.07216878364870322f, lane, a0, a1);
        bf16_t* orow = ob + (size_t)(b * SEQ + s) * DM + h * 128;
        orow[lane] = f2bf(a0); orow[64 + lane] = f2bf(a1);
    }
}
#endif

DI void phase_mla_rows(const Ctx& C, const Params& P) {
    unsigned char* ws = P.ws;
    const bf16_t* mp = (const bf16_t*)(ws + P_MLAPROJ); bf16_t* cqn = (bf16_t*)(ws + P_CQN); bf16_t* ckvn = (bf16_t*)(ws + P_CKVN); bf16_t* krp = (bf16_t*)(ws + P_KROPE);
    const f32x2* tab = (const f32x2*)(ws + WS_ROPE);
    const int lane = C.lane;
    for (int r = C.blk * NWAVES + C.wave; r < T; r += C.G * NWAVES) {
        const bf16_t* row = mp + (size_t)r * MLA_IN_PAD;
        float v[12]; float ss = 0.f;
#pragma unroll
        for (int j = 0; j < 3; ++j) { const u32x2 w = *(const u32x2*)(row + 4 * (lane + 64 * j)); v[4 * j] = bflo(w.x); v[4 * j + 1] = bfhi(w.x); v[4 * j + 2] = bflo(w.y); v[4 * j + 3] = bfhi(w.y); }
#pragma unroll
        for (int j = 0; j < 12; ++j) ss += v[j] * v[j];
        float sc = rsqrtf(wave_sum(ss) * (1.0f / MLA_QR) + NORM_EPS);
#pragma unroll
        for (int j = 0; j < 3; ++j) { const f32x4 g = *(const f32x4*)(P.in[I_MLA_QNORM] + 4 * (lane + 64 * j));
            u32x2 w; w.x = pk2(v[4 * j] * sc * g[0], v[4 * j + 1] * sc * g[1]); w.y = pk2(v[4 * j + 2] * sc * g[2], v[4 * j + 3] * sc * g[3]);
            *(u32x2*)(cqn + (size_t)r * MLA_QR + 4 * (lane + 64 * j)) = w; }
        {
            const u32x2 w = *(const u32x2*)(row + MLA_QR + 4 * lane);
            const float a0 = bflo(w.x), a1 = bfhi(w.x), a2 = bflo(w.y), a3 = bfhi(w.y);
            const float s2 = rsqrtf(wave_sum(a0 * a0 + a1 * a1 + a2 * a2 + a3 * a3) * (1.0f / MLA_KVR) + NORM_EPS);
            const f32x4 g = *(const f32x4*)(P.in[I_MLA_KVNORM] + 4 * lane);
            u32x2 o; o.x = pk2(a0 * s2 * g[0], a1 * s2 * g[1]); o.y = pk2(a2 * s2 * g[2], a3 * s2 * g[3]);
            *(u32x2*)(ckvn + (size_t)r * MLA_KVR + 4 * lane) = o;
        }
        if (lane < 32) {
            const unsigned w = *(const unsigned*)(row + 1024 + 2 * lane);
            int p = ((const int*)P.in[I_POS])[r]; p = p < 0 ? 0 : (p > ROPE_POS - 1 ? ROPE_POS - 1 : p);
            const f32x2 cs = tab[(size_t)p * 32 + lane];
            const float x1 = bflo(w), x2 = bfhi(w);
            *(unsigned*)(krp + (size_t)r * 64 + 2 * lane) = pk2(x1 * cs[0] - x2 * cs[1], x2 * cs[0] + x1 * cs[1]);
        }
    }
}

DI void phase_xa_softmax(const Ctx& C, const Params& P) {
    unsigned char* ws = P.ws;
    const float* S = (const float*)(ws + P_S); bf16_t* Pb = (bf16_t*)(ws + P_P);
    const int lane = C.lane, hd = lane >> 4, li = lane & 15;
    for (int r = C.blk * NWAVES + C.wave; r < T; r += C.G * NWAVES) {
        const float* row = S + (size_t)r * 1024 + hd * 256;
        f32x4 v[4]; float mx = -1e30f;
#pragma unroll
        for (int j = 0; j < 4; ++j) { v[j] = *(const f32x4*)(row + 4 * (li + 16 * j)); mx = fmaxf(mx, fmaxf(fmaxf(v[j][0], v[j][1]), fmaxf(v[j][2], v[j][3]))); }
#pragma unroll
        for (int o = 1; o < 16; o <<= 1) mx = fmaxf(mx, __shfl_xor(mx, o));
        float sm = 0.f;
#pragma unroll
        for (int j = 0; j < 4; ++j) { v[j][0] = __expf(v[j][0] - mx); v[j][1] = __expf(v[j][1] - mx); v[j][2] = __expf(v[j][2] - mx); v[j][3] = __expf(v[j][3] - mx); sm += (v[j][0] + v[j][1]) + (v[j][2] + v[j][3]); }
#pragma unroll
        for (int o = 1; o < 16; o <<= 1) sm += __shfl_xor(sm, o);
        const float inv = 1.0f / sm;
        bf16_t* orow = Pb + (size_t)r * 1024 + hd * 256;
#pragma unroll
        for (int j = 0; j < 4; ++j) { u32x2 w; w.x = pk2(v[j][0] * inv, v[j][1] * inv); w.y = pk2(v[j][2] * inv, v[j][3] * inv); *(u32x2*)(orow + 4 * (li + 16 * j)) = w; }
    }
}

template <bool STORE> DI void phase_peer(const Ctx& C, const Params& P) {
    unsigned char* ws = P.ws;
    const float* sc = (const float*)(ws + P_SC); const bf16_t* hb = (const bf16_t*)(ws + P_H);
    const bf16_t* ut = (const bf16_t*)(ws + P_UT); const bf16_t* vt = (const bf16_t*)(ws + P_VT);
    float* xo = P.out;
    LAS unsigned char* my = C.lds + C.wave * 4096;
    LAS float* top_s = (LAS float*)my;
    LAS int* top_i = (LAS int*)(my + 1024);
    LAS int* best_e = (LAS int*)(my + 2048);
    LAS float* best_g = (LAS float*)(my + 2560);
    LAS float* best_s = (LAS float*)(my + 3072);
    LAS int* best_p = (LAS int*)(my + 3584);
    const int lane = C.lane;
    for (int tok = C.blk * NWAVES + C.wave; tok < T; tok += C.G * NWAVES) {
        for (int rep = 0; rep < (PROBE == 6 ? 2 : 1); ++rep) {
        {
            const int g = lane >> 2, qd = lane & 3;
            float v[32];
            const f32x4* sp = (const f32x4*)(sc + (size_t)tok * 2048 + g * 128 + qd * 32);
#pragma unroll
            for (int j = 0; j < 8; ++j) { const f32x4 x = sp[j]; v[4 * j] = x[0]; v[4 * j + 1] = x[1]; v[4 * j + 2] = x[2]; v[4 * j + 3] = x[3]; }
            for (int r = 0; r < 16; ++r) {
                float bv = v[0]; int bj = 0;
#pragma unroll
                for (int j = 1; j < 32; ++j) { const bool gt = v[j] > bv; bv = gt ? v[j] : bv; bj = gt ? j : bj; }
                int bn = qd * 32 + bj;
#pragma unroll
                for (int off = 1; off <= 2; off <<= 1) { const float ov = __shfl_xor(bv, off); const int on = __shfl_xor(bn, off); const bool tk = (ov > bv) || (ov == bv && on < bn); bv = tk ? ov : bv; bn = tk ? on : bn; }
                if (qd == 0) { top_s[g * 16 + r] = bv; top_i[g * 16 + r] = bn; }
                const int rem = ((bn >> 5) == qd) ? (bn & 31) : -1;
#pragma unroll
                for (int j = 0; j < 32; ++j) v[j] = (j == rem) ? -INFINITY : v[j];
            }
        }
        LDS_WAIT(); asm volatile("" ::: "memory");
        {
            const int h = lane >> 3, sub = lane & 7;
            float v[32];
            const float s00 = top_s[(2 * h) * 16 + 2 * sub], s01 = top_s[(2 * h) * 16 + 2 * sub + 1];
#pragma unroll
            for (int k2 = 0; k2 < 16; ++k2) { const float s1 = top_s[(2 * h + 1) * 16 + k2]; v[k2] = s00 + s1; v[16 + k2] = s01 + s1; }
            for (int r = 0; r < 16; ++r) {
                float bv = v[0]; int bj = 0;
#pragma unroll
                for (int j = 1; j < 32; ++j) { const bool gt = v[j] > bv; bv = gt ? v[j] : bv; bj = gt ? j : bj; }
                int bn = sub * 32 + bj;
#pragma unroll
                for (int off = 1; off <= 4; off <<= 1) { const float ov = __shfl_xor(bv, off); const int on = __shfl_xor(bn, off); const bool tk = (ov > bv) || (ov == bv && on < bn); bv = tk ? ov : bv; bn = tk ? on : bn; }
                if (sub == 0) { best_s[h * 16 + r] = bv; best_p[h * 16 + r] = bn; }
                const int rem = ((bn >> 5) == sub) ? (bn & 31) : -1;
#pragma unroll
                for (int j = 0; j < 32; ++j) v[j] = (j == rem) ? -INFINITY : v[j];
            }
        }
        LDS_WAIT(); asm volatile("" ::: "memory");
#pragma unroll
        for (int e2 = 0; e2 < 2; ++e2) {
            const int idx = lane + 64 * e2, h = idx >> 4;
            float mx = -1e30f;
            for (int k = 0; k < 16; ++k) mx = fmaxf(mx, best_s[h * 16 + k]);
            float sm = 0.f;
            for (int k = 0; k < 16; ++k) sm += __expf(best_s[h * 16 + k] - mx);
            const float gate = __expf(best_s[idx] - mx) / sm;
            const int pos = best_p[idx], k1 = pos >> 4, k2 = pos & 15;
            best_e[idx] = top_i[(2 * h) * 16 + k1] * 128 + top_i[(2 * h + 1) * 16 + k2];
            best_g[idx] = gate;
        }
        LDS_WAIT(); asm volatile("" ::: "memory");
        }
#if PEER_FP8
        float tf[32];
#pragma unroll
        for (int i = 0; i < 2; ++i) { const u32x4* tp = (const u32x4*)(hb + (size_t)tok * DM + 16 * (lane + 64 * i));
            const u32x4 a = tp[0], b = tp[1];
            tf[16 * i + 0] = bflo(a.x); tf[16 * i + 1] = bfhi(a.x); tf[16 * i + 2] = bflo(a.y); tf[16 * i + 3] = bfhi(a.y); tf[16 * i + 4] = bflo(a.z); tf[16 * i + 5] = bfhi(a.z); tf[16 * i + 6] = bflo(a.w); tf[16 * i + 7] = bfhi(a.w);
            tf[16 * i + 8] = bflo(b.x); tf[16 * i + 9] = bfhi(b.x); tf[16 * i + 10] = bflo(b.y); tf[16 * i + 11] = bfhi(b.y); tf[16 * i + 12] = bflo(b.z); tf[16 * i + 13] = bfhi(b.z); tf[16 * i + 14] = bflo(b.w); tf[16 * i + 15] = bfhi(b.w); }
        const unsigned char* ut8 = (const unsigned char*)ut; const unsigned char* vt8 = (const unsigned char*)vt;
        const float* usc = (const float*)(ut8 + 32 * MiB); const float* vsc = (const float*)(vt8 + 32 * MiB);
        for (int k0 = 0; k0 < 128; k0 += 8) {
            u32x4 rw[8][2];
#pragma unroll
            for (int kk = 0; kk < 8; ++kk) { const int e = __builtin_amdgcn_readfirstlane(best_e[k0 + kk]); const unsigned char* rp = ut8 + (size_t)e * DM;
#pragma unroll
                for (int i = 0; i < 2; ++i) rw[kk][i] = *(const u32x4*)(rp + 16 * (lane + 64 * i)); }
            float d[8];
#pragma unroll
            for (int kk = 0; kk < 8; ++kk) { float s0 = 0.f, s1 = 0.f;
#pragma unroll
                for (int i = 0; i < 2; ++i) {
                    const unsigned w4[4] = {rw[kk][i].x, rw[kk][i].y, rw[kk][i].z, rw[kk][i].w};
#pragma unroll
                    for (int q = 0; q < 4; ++q) { const f32x2 lo = __builtin_amdgcn_cvt_pk_f32_fp8((int)w4[q], false), hi2 = __builtin_amdgcn_cvt_pk_f32_fp8((int)w4[q], true);
                        s0 = fmaf(lo[0], tf[16 * i + 4 * q], s0); s1 = fmaf(lo[1], tf[16 * i + 4 * q + 1], s1); s0 = fmaf(hi2[0], tf[16 * i + 4 * q + 2], s0); s1 = fmaf(hi2[1], tf[16 * i + 4 * q + 3], s1); }
                }
                d[kk] = s0 + s1; }
            float n4[4], n2[2], r1;
            { const bool b0 = lane & 1;
#pragma unroll
              for (int j = 0; j < 4; ++j) { const float snd = b0 ? d[j] : d[4 + j], kp = b0 ? d[4 + j] : d[j]; n4[j] = kp + __shfl_xor(snd, 1); } }
            { const bool b1 = lane & 2;
#pragma unroll
              for (int j = 0; j < 2; ++j) { const float snd = b1 ? n4[j] : n4[2 + j], kp = b1 ? n4[2 + j] : n4[j]; n2[j] = kp + __shfl_xor(snd, 2); } }
            { const bool b2 = lane & 4; const float snd = b2 ? n2[0] : n2[1], kp = b2 ? n2[1] : n2[0]; r1 = kp + __shfl_xor(snd, 4); }
            r1 += __shfl_xor(r1, 8); r1 += __shfl_xor(r1, 16); r1 += __shfl_xor(r1, 32);
            if (lane < 8) { const int idx = k0 + 4 * (lane & 1) + 2 * ((lane >> 1) & 1) + ((lane >> 2) & 1); const float act = r1 * usc[best_e[idx]]; best_g[idx] *= gelu_erf(act); }
        }
        LDS_WAIT(); asm volatile("" ::: "memory");
        float acc[32];
#pragma unroll
        for (int j = 0; j < 32; ++j) acc[j] = 0.f;
        for (int k0 = 0; k0 < 128; k0 += 8) {
            u32x4 rw[8][2]; float wk[8];
#pragma unroll
            for (int kk = 0; kk < 8; ++kk) { const int e = __builtin_amdgcn_readfirstlane(best_e[k0 + kk]); wk[kk] = best_g[k0 + kk] * vsc[e]; const unsigned char* rp = vt8 + (size_t)e * DM;
#pragma unroll
                for (int i = 0; i < 2; ++i) rw[kk][i] = *(const u32x4*)(rp + 16 * (lane + 64 * i)); }
#pragma unroll
            for (int kk = 0; kk < 8; ++kk)
#pragma unroll
                for (int i = 0; i < 2; ++i) {
                    const unsigned w4[4] = {rw[kk][i].x, rw[kk][i].y, rw[kk][i].z, rw[kk][i].w};
#pragma unroll
                    for (int q = 0; q < 4; ++q) { const f32x2 lo = __builtin_amdgcn_cvt_pk_f32_fp8((int)w4[q], false), hi2 = __builtin_amdgcn_cvt_pk_f32_fp8((int)w4[q], true);
                        acc[16 * i + 4 * q] = fmaf(wk[kk], lo[0], acc[16 * i + 4 * q]); acc[16 * i + 4 * q + 1] = fmaf(wk[kk], lo[1], acc[16 * i + 4 * q + 1]);
                        acc[16 * i + 4 * q + 2] = fmaf(wk[kk], hi2[0], acc[16 * i + 4 * q + 2]); acc[16 * i + 4 * q + 3] = fmaf(wk[kk], hi2[1], acc[16 * i + 4 * q + 3]); }
                }
        }
#else
        u32x4 tv[4];
#pragma unroll
        for (int i = 0; i < 4; ++i) tv[i] = *(const u32x4*)(hb + (size_t)tok * DM + 8 * (lane + 64 * i));
        for (int k0 = 0; k0 < 128; k0 += 4) {
            u32x4 rw[4][4];
#pragma unroll
            for (int kk = 0; kk < 4; ++kk) { const int e = __builtin_amdgcn_readfirstlane(best_e[k0 + kk]); const bf16_t* rp = ut + (size_t)e * DM;
#pragma unroll
                for (int i = 0; i < 4; ++i) rw[kk][i] = *(const u32x4*)(rp + 8 * (lane + 64 * i)); }
            float d[4];
#pragma unroll
            for (int kk = 0; kk < 4; ++kk) { float s = 0.f;
#pragma unroll
                for (int i = 0; i < 4; ++i) { s = dot2bf(rw[kk][i].x, tv[i].x, s); s = dot2bf(rw[kk][i].y, tv[i].y, s); s = dot2bf(rw[kk][i].z, tv[i].z, s); s = dot2bf(rw[kk][i].w, tv[i].w, s); }
                d[kk] = wave_sum(s); }
            if (lane < 4) { const float act = lane == 0 ? d[0] : lane == 1 ? d[1] : lane == 2 ? d[2] : d[3]; best_g[k0 + lane] *= gelu_erf(act); }
        }
        LDS_WAIT(); asm volatile("" ::: "memory");
        float acc[32];
#pragma unroll
        for (int j = 0; j < 32; ++j) acc[j] = 0.f;
        for (int k0 = 0; k0 < 128; k0 += 4) {
            u32x4 rw[4][4]; float wk[4];
#pragma unroll
            for (int kk = 0; kk < 4; ++kk) { const int e = __builtin_amdgcn_readfirstlane(best_e[k0 + kk]); wk[kk] = best_g[k0 + kk]; const bf16_t* rp = vt + (size_t)e * DM;
#pragma unroll
                for (int i = 0; i < 4; ++i) rw[kk][i] = *(const u32x4*)(rp + 8 * (lane + 64 * i)); }
#pragma unroll
            for (int kk = 0; kk < 4; ++kk)
#pragma unroll
                for (int i = 0; i < 4; ++i) {
                    acc[8 * i + 0] = fmaf(wk[kk], bflo(rw[kk][i].x), acc[8 * i + 0]); acc[8 * i + 1] = fmaf(wk[kk], bfhi(rw[kk][i].x), acc[8 * i + 1]);
                    acc[8 * i + 2] = fmaf(wk[kk], bflo(rw[kk][i].y), acc[8 * i + 2]); acc[8 * i + 3] = fmaf(wk[kk], bfhi(rw[kk][i].y), acc[8 * i + 3]);
                    acc[8 * i + 4] = fmaf(wk[kk], bflo(rw[kk][i].z), acc[8 * i + 4]); acc[8 * i + 5] = fmaf(wk[kk], bfhi(rw[kk][i].z), acc[8 * i + 5]);
                    acc[8 * i + 6] = fmaf(wk[kk], bflo(rw[kk][i].w), acc[8 * i + 6]); acc[8 * i + 7] = fmaf(wk[kk], bfhi(rw[kk][i].w), acc[8 * i + 7]);
                }
        }
#endif
        float* xr = xo + (size_t)tok * DM;
        if (!STORE) {
#pragma unroll
            for (int j = 0; j < 32; ++j) asm volatile("" :: "v"(acc[j]));
        } else {
#if PEER_FP8
#pragma unroll
            for (int i = 0; i < 2; ++i) { f32x4* p = (f32x4*)(xr + 16 * (lane + 64 * i));
#pragma unroll
                for (int q = 0; q < 4; ++q) { f32x4 a = p[q]; a[0] += acc[16 * i + 4 * q]; a[1] += acc[16 * i + 4 * q + 1]; a[2] += acc[16 * i + 4 * q + 2]; a[3] += acc[16 * i + 4 * q + 3]; p[q] = a; } }
#else
#pragma unroll
            for (int i = 0; i < 4; ++i) { f32x4* p = (f32x4*)(xr + 8 * (lane + 64 * i));
                f32x4 a = p[0], b = p[1];
                a[0] += acc[8 * i]; a[1] += acc[8 * i + 1]; a[2] += acc[8 * i + 2]; a[3] += acc[8 * i + 3];
                b[0] += acc[8 * i + 4]; b[1] += acc[8 * i + 5]; b[2] += acc[8 * i + 6]; b[3] += acc[8 * i + 7];
                p[0] = a; p[1] = b; }
#endif
        }
        LDS_WAIT(); asm volatile("" ::: "memory");
    }
}

constexpr int N_PHASES = 33;
__global__ void __launch_bounds__(NTHREADS, 2) mk_fwd(Params P) {
    extern __shared__ __attribute__((aligned(16))) unsigned char lds_raw[];
    Ctx C; C.lds = (LAS unsigned char*)lds_raw; C.tid = threadIdx.x; C.lane = C.tid & 63; C.wave = __builtin_amdgcn_readfirstlane(C.tid >> 6); C.blk = blockIdx.x; C.G = gridDim.x;
    unsigned char* ws = P.ws;
    for (int u = C.tid; u < (LDS_BYTES - LDSCTL_OFF) / 4; u += NTHREADS) ((LAS unsigned*)(C.lds + LDSCTL_OFF))[u] = 0u;
    __syncthreads();
    XcdBarrier bar; bar.bar = (unsigned*)(ws + WS_CTL) + CW_BAR; bar.x = 0; bar.st = nullptr;
    const bool one = (P.ph_hi - P.ph_lo) > 1;
    if (one) bar = xcd_barrier_post((unsigned*)(ws + WS_CTL) + CW_BAR, (volatile LAS unsigned*)(C.lds + LDSCTL_OFF));
    const int lo = P.ph_lo, hi = P.ph_hi;
#define IN(k) (lo <= (k) && (k) < hi)
#define SEAM(k) do { if (IN(k) && IN((k) + 1)) xcd_barrier(bar); } while (0)
    bf16_t* hbuf = (bf16_t*)(ws + P_H);
    const int* pos = (const int*)P.in[I_POS];
    const f32x2* rtab = (const f32x2*)(ws + WS_ROPE);

    if (IN(0)) { if (EN_PRO) { if (PROBE == 3) { phase_prologue(C, P); __syncthreads(); } phase_prologue(C, P); } } SEAM(0);
    if (IN(1)) {
        {
            g8::Desc g{(const bf16_t*)(ws + P_MEMN), (const bf16_t*)(ws + WS_LW + LW_XKV), DM, DM, DM, MT / 256, DM / 256, 2, 1, (long)MT * DM, 0, (long)(LW_STRIDE / 2), 0};
            EpiBf16 E{(bf16_t*)(ws + WS_KVX), DM, (long)(KVX_STRIDE / 2), 0, 1.0f};
            if (PROBE == 1) { EpiNull En; g8::gemm(C.lds, g, En, C.G, C.blk); } if (GSITE < 0 || GSITE == 1) g8::gemm(C.lds, g, E, C.G, C.blk);
        }
        {
            g8::Desc g{(const bf16_t*)(ws + WS_LW + LW_XKV) + (size_t)DM * DM, (const bf16_t*)(ws + P_MEMN), DM, DM, DM, DM / 256, MT / 256, 2, 1, (long)(LW_STRIDE / 2), 0, (long)MT * DM, 0};
            EpiBf16 E{(bf16_t*)(ws + WS_KVX + 16 * MiB), MT, (long)(KVX_STRIDE / 2), 0, 1.0f};
            if (PROBE == 1) { EpiNull En; g8::gemm(C.lds, g, En, C.G, C.blk); } if (GSITE < 0 || GSITE == 2) g8::gemm(C.lds, g, E, C.G, C.blk);
        }
        {
            g8::Desc g{(const bf16_t*)(ws + P_SK), (const bf16_t*)(ws + P_WQB), 256, DM, 256, 1, DM / 256, 2, 8, 8L * 65536, 65536, (long)DM * DM, 256};
            EpiBf16 E{(bf16_t*)(ws + WS_LW + LW_PEER), DM, (long)(LW_STRIDE / 2), 256L * DM, 1.0f};
            if (PROBE == 1) { EpiNull En; g8::gemm(C.lds, g, En, C.G, C.blk); } if (GSITE < 0 || GSITE == 3) g8::gemm(C.lds, g, E, C.G, C.blk);
        }
    }
    SEAM(1);

    {
        constexpr int l = 0, pb = 2; (void)l;

            if (IN(pb + 0)) { if (PROBE == 5) rms_rows_2048(C, P.in[I_X], P.in[I_AB_NORM], hbuf, T); rms_rows_2048(C, P.in[I_X], P.in[I_AB_NORM], hbuf, T); }
            SEAM(pb + 0);
            if (IN(pb + 1)) {
                g8::Desc g{hbuf, (const bf16_t*)(ws + WS_ABIN_T), DM, DM, DM, T / 256, AB_IN / 256, 1, 1, 0, 0, 0, 0};
                EpiRope<0> E{(bf16_t*)(ws + P_PROJ), AB_IN, pos, rtab};
                if (PROBE == 1) { EpiNull En; g8::gemm(C.lds, g, En, C.G, C.blk); } if (GSITE < 0 || GSITE == 4) g8::gemm(C.lds, g, E, C.G, C.blk);
            }
            SEAM(pb + 1);
            SEAM(pb + 2);
            if (IN(pb + 3)) { if (EN_DIFF) { if (PROBE == 2) phase_diff_attn(C, P, 2); phase_diff_attn(C, P, 0); } }
            SEAM(pb + 3);
            if (IN(pb + 4)) {
                g8::Desc g{(const bf16_t*)(ws + P_GBUF), (const bf16_t*)(ws + WS_GLU_T), S5_W, S5_W, S5_W, T / 256, S5_W / 256, 1, 1, 0, 0, 0, 0};
                EpiGlu E{(const bf16_t*)(ws + P_GBUF), P.in[I_S5_BGLU], (bf16_t*)(ws + P_CONCAT)};
                if (PROBE == 1) { EpiNull En; g8::gemm(C.lds, g, En, C.G, C.blk); } if (GSITE < 0 || GSITE == 5) g8::gemm(C.lds, g, E, C.G, C.blk);
            }
            SEAM(pb + 4);
            if (IN(pb + 5)) {
                g8::Desc g{(const bf16_t*)(ws + P_CONCAT), (const bf16_t*)(ws + WS_ABOUT_T), DM, DM, DM, T / 256, DM / 256, 1, 1, 0, 0, 0, 0};
                EpiResid E{P.in[I_X], P.out, DM};
                if (PROBE == 1) { EpiNull En; g8::gemm(C.lds, g, En, C.G, C.blk); } if (GSITE < 0 || GSITE == 6) g8::gemm(C.lds, g, E, C.G, C.blk);
            }
            SEAM(pb + 5);
    }
    {
        constexpr int l = 0, pb = 2; (void)l;
        const unsigned char* lw = ws + WS_LW + (size_t)l * LW_STRIDE;
        if (IN(pb + 6)) { if (PROBE == 5) rms_rows_2048(C, P.out, P.in[I_XA_NORM] + l * DM, hbuf, T); rms_rows_2048(C, P.out, P.in[I_XA_NORM] + l * DM, hbuf, T); }
        SEAM(pb + 6);
        if (IN(pb + 7)) {
            g8::Desc g{hbuf, (const bf16_t*)(lw + LW_XQ), DM, DM, DM, T / 256, DM / 256, 1, 1, 0, 0, 0, 0};
            EpiBf16 E{(bf16_t*)(ws + P_QX), DM, 0, 0, 1.0f};
            if (PROBE == 1) { EpiNull En; g8::gemm(C.lds, g, En, C.G, C.blk); } if (GSITE < 0 || GSITE == 11) g8::gemm(C.lds, g, E, C.G, C.blk);
        }
        SEAM(pb + 7);
        if (IN(pb + 8)) {
            g8::Desc g{(const bf16_t*)(ws + P_QX), (const bf16_t*)(ws + WS_KVX + (size_t)l * KVX_STRIDE), DM, DM, 512, SEQ / 256, 1, BATCH, 4, (long)SEQ * DM, 512, (long)MEM_LEN * DM, 512};
            EpiF32 E{(float*)(ws + P_S), 1024, (long)SEQ * 1024, 256, 0.04419417382415922f};
            if (PROBE == 1) { EpiNull En; g8::gemm(C.lds, g, En, C.G, C.blk); } if (GSITE < 0 || GSITE == 12) g8::gemm(C.lds, g, E, C.G, C.blk);
        }
        SEAM(pb + 8);
        if (IN(pb + 9)) {
            if (PROBE == 5) phase_xa_softmax(C, P);
            phase_xa_softmax(C, P);
            if (l == 1) {
                convert_tables(C, P, 1);
            }
        }
        SEAM(pb + 9);
        if (IN(pb + 10)) {
            g8::Desc g{(const bf16_t*)(ws + P_P), (const bf16_t*)(ws + WS_KVX + (size_t)l * KVX_STRIDE + 16 * MiB), 1024, MT, 256, SEQ / 256, 2, BATCH, 4, (long)SEQ * 1024, 256, 256, 512L * MT};
            EpiBf16 E{(bf16_t*)(ws + P_OX), DM, (long)SEQ * DM, 512, 1.0f};
            if (PROBE == 1) { EpiNull En; g8::gemm(C.lds, g, En, C.G, C.blk); } if (GSITE < 0 || GSITE == 13) g8::gemm(C.lds, g, E, C.G, C.blk);
        }
        SEAM(pb + 10);
        if (IN(pb + 11)) {
            g8::Desc g{(const bf16_t*)(ws + P_OX), (const bf16_t*)(lw + LW_XO), DM, DM, DM, T / 256, DM / 256, 1, 1, 0, 0, 0, 0};
            EpiResid E{P.out, P.out, DM};
            if (PROBE == 1) { EpiNull En; g8::gemm(C.lds, g, En, C.G, C.blk); } if (GSITE < 0 || GSITE == 14) g8::gemm(C.lds, g, E, C.G, C.blk);
        }
        SEAM(pb + 11);
        if (IN(pb + 12)) { if (PROBE == 5) rms_rows_2048(C, P.out, P.in[I_FFN_NORM] + l * DM, hbuf, T); rms_rows_2048(C, P.out, P.in[I_FFN_NORM] + l * DM, hbuf, T); }
        SEAM(pb + 12);
        if (IN(pb + 13)) {
            g8::Desc g{hbuf, (const bf16_t*)(lw + LW_PEER), DM, DM, DM, T / 256, DM / 256, 1, 1, 0, 0, 0, 0};
            EpiF32 E{(float*)(ws + P_SC), DM, 0, 0, 1.0f};
            if (PROBE == 1) { EpiNull En; g8::gemm(C.lds, g, En, C.G, C.blk); } if (GSITE < 0 || GSITE == 15) g8::gemm(C.lds, g, E, C.G, C.blk);
        }
        SEAM(pb + 13);
        if (IN(pb + 14)) { if (EN_PEER) { if (PROBE_PEER2) { phase_peer<false>(C, P); __syncthreads(); } phase_peer<true>(C, P); } }
        SEAM(pb + 14);
    }
    {
        constexpr int l = 1, pb = 17; (void)l;

            if (IN(pb + 0)) { if (PROBE == 5) rms_rows_2048(C, P.out, P.in[I_MLA_NORM], hbuf, T); rms_rows_2048(C, P.out, P.in[I_MLA_NORM], hbuf, T); }
            SEAM(pb + 0);
            if (IN(pb + 1)) {
                g8::Desc g{hbuf, (const bf16_t*)(ws + WS_MLAIN_T), DM, DM, DM, T / 256, MLA_IN_PAD / 256, 1, 1, 0, 0, 0, 0};
                EpiBf16 E{(bf16_t*)(ws + P_MLAPROJ), MLA_IN_PAD, 0, 0, 1.0f};
                if (PROBE == 1) { EpiNull En; g8::gemm(C.lds, g, En, C.G, C.blk); } if (GSITE < 0 || GSITE == 7) g8::gemm(C.lds, g, E, C.G, C.blk);
            }
            SEAM(pb + 1);
            if (IN(pb + 2)) { if (PROBE == 5) phase_mla_rows(C, P); phase_mla_rows(C, P); }
            SEAM(pb + 2);
            if (IN(pb + 3)) {
                {
                    g8::Desc g{(const bf16_t*)(ws + P_CQN), (const bf16_t*)(ws + WS_UQ_T), MLA_QR, MLA_QR, MLA_QR, T / 256, 3072 / 256, 1, 1, 0, 0, 0, 0};
                    EpiRope<1> E{(bf16_t*)(ws + P_Q), 3072, pos, rtab};
                    if (PROBE == 1) { EpiNull En; g8::gemm(C.lds, g, En, C.G, C.blk); } if (GSITE < 0 || GSITE == 8) g8::gemm(C.lds, g, E, C.G, C.blk);
                }
                {
                    g8::Desc g{(const bf16_t*)(ws + P_CKVN), (const bf16_t*)(ws + WS_UKV_T), MLA_KVR, MLA_KVR, MLA_KVR, T / 256, 4096 / 256, 1, 1, 0, 0, 0, 0};
                    EpiBf16 E{(bf16_t*)(ws + P_KV), 4096, 0, 0, 1.0f};
                    if (PROBE == 1) { EpiNull En; g8::gemm(C.lds, g, En, C.G, C.blk); } if (GSITE < 0 || GSITE == 9) g8::gemm(C.lds, g, E, C.G, C.blk);
                }
            }
            SEAM(pb + 3);
            if (IN(pb + 4)) { if (EN_MLA) { if (PROBE == 2) phase_mla_attn(C, P, 3); phase_mla_attn(C, P, 1); } }
            SEAM(pb + 4);
            if (IN(pb + 5)) {
                g8::Desc g{hbuf, (const bf16_t*)(ws + WS_MLAO_T), DM, DM, DM, T / 256, DM / 256, 1, 1, 0, 0, 0, 0};
                EpiResid E{P.out, P.out, DM};
                if (PROBE == 1) { EpiNull En; g8::gemm(C.lds, g, En, C.G, C.blk); } if (GSITE < 0 || GSITE == 10) g8::gemm(C.lds, g, E, C.G, C.blk);
            }
            SEAM(pb + 5);
    }
    {
        constexpr int l = 1, pb = 17; (void)l;
        const unsigned char* lw = ws + WS_LW + (size_t)l * LW_STRIDE;
        if (IN(pb + 6)) { if (PROBE == 5) rms_rows_2048(C, P.out, P.in[I_XA_NORM] + l * DM, hbuf, T); rms_rows_2048(C, P.out, P.in[I_XA_NORM] + l * DM, hbuf, T); }
        SEAM(pb + 6);
        if (IN(pb + 7)) {
            g8::Desc g{hbuf, (const bf16_t*)(lw + LW_XQ), DM, DM, DM, T / 256, DM / 256, 1, 1, 0, 0, 0, 0};
            EpiBf16 E{(bf16_t*)(ws + P_QX), DM, 0, 0, 1.0f};
            if (PROBE == 1) { EpiNull En; g8::gemm(C.lds, g, En, C.G, C.blk); } if (GSITE < 0 || GSITE == 11) g8::gemm(C.lds, g, E, C.G, C.blk);
        }
        SEAM(pb + 7);
        if (IN(pb + 8)) {
            g8::Desc g{(const bf16_t*)(ws + P_QX), (const bf16_t*)(ws + WS_KVX + (size_t)l * KVX_STRIDE), DM, DM, 512, SEQ / 256, 1, BATCH, 4, (long)SEQ * DM, 512, (long)MEM_LEN * DM, 512};
            EpiF32 E{(float*)(ws + P_S), 1024, (long)SEQ * 1024, 256, 0.04419417382415922f};
            if (PROBE == 1) { EpiNull En; g8::gemm(C.lds, g, En, C.G, C.blk); } if (GSITE < 0 || GSITE == 12) g8::gemm(C.lds, g, E, C.G, C.blk);
        }
        SEAM(pb + 8);
        if (IN(pb + 9)) {
            if (PROBE == 5) phase_xa_softmax(C, P);
            phase_xa_softmax(C, P);
            if (l == 1) {
                convert_tables(C, P, 1);
            }
        }
        SEAM(pb + 9);
        if (IN(pb + 10)) {
            g8::Desc g{(const bf16_t*)(ws + P_P), (const bf16_t*)(ws + WS_KVX + (size_t)l * KVX_STRIDE + 16 * MiB), 1024, MT, 256, SEQ / 256, 2, BATCH, 4, (long)SEQ * 1024, 256, 256, 512L * MT};
            EpiBf16 E{(bf16_t*)(ws + P_OX), DM, (long)SEQ * DM, 512, 1.0f};
            if (PROBE == 1) { EpiNull En; g8::gemm(C.lds, g, En, C.G, C.blk); } if (GSITE < 0 || GSITE == 13) g8::gemm(C.lds, g, E, C.G, C.blk);
        }
        SEAM(pb + 10);
        if (IN(pb + 11)) {
            g8::Desc g{(const bf16_t*)(ws + P_OX), (const bf16_t*)(lw + LW_XO), DM, DM, DM, T / 256, DM / 256, 1, 1, 0, 0, 0, 0};
            EpiResid E{P.out, P.out, DM};
            if (PROBE == 1) { EpiNull En; g8::gemm(C.lds, g, En, C.G, C.blk); } if (GSITE < 0 || GSITE == 14) g8::gemm(C.lds, g, E, C.G, C.blk);
        }
        SEAM(pb + 11);
        if (IN(pb + 12)) { if (PROBE == 5) rms_rows_2048(C, P.out, P.in[I_FFN_NORM] + l * DM, hbuf, T); rms_rows_2048(C, P.out, P.in[I_FFN_NORM] + l * DM, hbuf, T); }
        SEAM(pb + 12);
        if (IN(pb + 13)) {
            g8::Desc g{hbuf, (const bf16_t*)(lw + LW_PEER), DM, DM, DM, T / 256, DM / 256, 1, 1, 0, 0, 0, 0};
            EpiF32 E{(float*)(ws + P_SC), DM, 0, 0, 1.0f};
            if (PROBE == 1) { EpiNull En; g8::gemm(C.lds, g, En, C.G, C.blk); } if (GSITE < 0 || GSITE == 15) g8::gemm(C.lds, g, E, C.G, C.blk);
        }
        SEAM(pb + 13);
        if (IN(pb + 14)) { if (EN_PEER) { if (PROBE_PEER2) { phase_peer<false>(C, P); __syncthreads(); } phase_peer<true>(C, P); } }
        SEAM(pb + 14);
    }
    if (IN(32)) rms_rows_final(C, P.out, P.in[I_FINAL_NORM], T);
#undef IN
#undef SEAM
}

extern "C" void kernel_launch(void* const* d_in, const int* in_sizes, int n_in, void* d_out, int out_size, void* d_ws, size_t ws_size, hipStream_t stream) {
    static int grid = 0;
    if (grid == 0) {
        if (n_in != 39 || in_sizes[0] != T * DM || out_size != T * DM || ws_size < WS_END) {
            fprintf(stderr, "kernel_launch: unexpected shapes (n_in %d in0 %d out %d ws %zu, need ws >= %zu); nothing launched\n", n_in, n_in > 0 ? in_sizes[0] : -1, out_size, ws_size, (size_t)WS_END);
            grid = -1; return; }
        int dev = 0, cus = 0;
        if (hipGetDevice(&dev) != hipSuccess || hipDeviceGetAttribute(&cus, hipDeviceAttributeMultiprocessorCount, dev) != hipSuccess) { grid = -1; return; }
        if (hipFuncSetAttribute((const void*)mk_fwd, hipFuncAttributeMaxDynamicSharedMemorySize, LDS_BYTES) != hipSuccess) { fprintf(stderr, "kernel_launch: hipFuncSetAttribute failed\n"); grid = -1; return; }
        int per_cu = 0;
        if (hipOccupancyMaxActiveBlocksPerMultiprocessor(&per_cu, (const void*)mk_fwd, NTHREADS, LDS_BYTES) != hipSuccess || per_cu < 1)
            fprintf(stderr, "kernel_launch: occupancy query reports %d blocks per CU\n", per_cu);
        (void)hipGetLastError();
        grid = cus;
    }
    if (grid < 0) return;
    (void)hipMemsetAsync((char*)d_ws + WS_CTL, 0, CTL_BYTES, stream);
    Params p{};
    for (int i = 0; i < 39; ++i) p.in[i] = (const float*)d_in[i];
    p.out = (float*)d_out; p.ws = (unsigned char*)d_ws;
#if MK_ONE_LAUNCH
    p.ph_lo = 0; p.ph_hi = N_PHASES;
    hipLaunchKernelGGL(mk_fwd, dim3(grid), dim3(NTHREADS), LDS_BYTES, stream, p);
#else
    for (int ph = 0; ph < N_PHASES; ++ph) { p.ph_lo = ph; p.ph_hi = ph + 1; hipLaunchKernelGGL(mk_fwd, dim3(grid), dim3(NTHREADS), LDS_BYTES, stream, p); }
#endif
    const hipError_t le = hipPeekAtLastError();
    if (le != hipSuccess) fprintf(stderr, "kernel_launch: launch failed: %s\n", hipGetErrorName(le));
}
```

```cpp
#include <hip/hip_runtime.h>
#include <cstdio>
#include <cstdint>

#ifndef MK_ONE_LAUNCH
#define MK_ONE_LAUNCH 1
#endif
#ifndef FAST_GEMM
#define FAST_GEMM 1
#endif
#ifndef FAST_ATTN
#define FAST_ATTN 1
#endif

#ifndef EN_TOPK
#define EN_TOPK 1
#endif
#ifndef EN_PU
#define EN_PU 1
#endif
#ifndef EN_PV
#define EN_PV 1
#endif
#ifndef EN_S5
#define EN_S5 1
#endif
#ifndef EN_DIFF
#define EN_DIFF 1
#endif
#ifndef EN_MLA
#define EN_MLA 1
#endif
#ifndef EN_PEER
#define EN_PEER 1
#endif
#ifndef EN_GEMM
#define EN_GEMM 1
#endif
#ifndef EN_PRO
#define EN_PRO 1
#endif
#ifndef PEER_FP8
#define PEER_FP8 1
#endif
#ifndef PROBE
#define PROBE 0
#endif
#ifndef PEER_SLICED
#define PEER_SLICED 1
#endif
#ifndef PROBE_PEER2
#define PROBE_PEER2 0
#endif
#ifndef GSITE
#define GSITE -1
#endif
#define GAS __attribute__((address_space(1)))
#define LAS __attribute__((address_space(3)))
#define DI __device__ __forceinline__
typedef unsigned short bf16_t;
typedef short bf16x8 __attribute__((ext_vector_type(8)));
typedef short s16x4 __attribute__((ext_vector_type(4)));
typedef float f32x2 __attribute__((ext_vector_type(2)));
typedef float f32x4 __attribute__((ext_vector_type(4)));
typedef float f32x16 __attribute__((ext_vector_type(16)));
typedef unsigned u32x2 __attribute__((ext_vector_type(2)));
typedef unsigned u32x4 __attribute__((ext_vector_type(4)));
typedef __bf16 bf16x2_t __attribute__((ext_vector_type(2)));

constexpr int BATCH = 16, SEQ = 2048, DM = 2048, T = BATCH * SEQ, MEM_LEN = 256, MT = BATCH * MEM_LEN;
constexpr int DIFF_HEADS = 12, DIFF_W = 1536, S5_W = 512, AB_IN = 5120;
constexpr int MLA_HEADS = 16, MLA_QR = 768, MLA_KVR = 256, MLA_IN = 1088, MLA_IN_PAD = 1280;
constexpr int PEER_NE = 16384;
constexpr float NORM_EPS = 1e-6f;
constexpr int ROPE_POS = 3072;
constexpr int NWAVES = 8, NTHREADS = 512;

constexpr size_t MiB = 1u << 20;
constexpr size_t WS_CTL = 0, CTL_BYTES = 1 * MiB;
constexpr size_t WS_ROPE = 1 * MiB;
constexpr size_t WS_ABIN_T = 2 * MiB, WS_ABOUT_T = 22 * MiB, WS_GLU_T = 30 * MiB, WS_MLAIN_T = 31 * MiB, WS_UQ_T = 36 * MiB, WS_UKV_T = 41 * MiB, WS_MLAO_T = 43 * MiB;
constexpr size_t WS_LW = 51 * MiB, LW_STRIDE = 40 * MiB;
constexpr size_t LW_XQ = 0, LW_XKV = 8 * MiB, LW_XO = 24 * MiB, LW_PEER = 32 * MiB;
constexpr size_t WS_KVX = 131 * MiB, KVX_STRIDE = 32 * MiB;
constexpr size_t WS_POOL = 195 * MiB;
constexpr size_t P_H = WS_POOL;
constexpr size_t P_PROJ = WS_POOL + 128 * MiB;
constexpr size_t P_CONCAT = WS_POOL + 448 * MiB;
constexpr size_t P_GBUF = WS_POOL + 576 * MiB;
constexpr size_t P_MLAPROJ = WS_POOL + 128 * MiB;
constexpr size_t P_CQN = WS_POOL + 208 * MiB;
constexpr size_t P_CKVN = WS_POOL + 256 * MiB;
constexpr size_t P_KROPE = WS_POOL + 272 * MiB;
constexpr size_t P_Q = WS_POOL + 288 * MiB;
constexpr size_t P_KV = WS_POOL + 480 * MiB;
constexpr size_t P_QX = WS_POOL + 128 * MiB;
constexpr size_t P_S = WS_POOL + 256 * MiB;
constexpr size_t P_P = WS_POOL + 384 * MiB;
constexpr size_t P_OX = WS_POOL + 448 * MiB;
constexpr size_t P_SC = WS_POOL + 128 * MiB;
constexpr size_t P_UT = WS_POOL + 704 * MiB;
constexpr size_t P_VT = WS_POOL + 768 * MiB;
constexpr size_t P_PE_E = WS_POOL + 384 * MiB;
constexpr size_t P_PE_G = WS_POOL + 400 * MiB;
constexpr size_t P_PE_ACT = WS_POOL + 416 * MiB;
constexpr size_t P_MEMN = WS_POOL + 608 * MiB;
constexpr size_t P_WQB = WS_POOL + 640 * MiB;
constexpr size_t P_SK = WS_POOL + 656 * MiB;
constexpr size_t WS_END = WS_POOL + 832 * MiB;
constexpr int CW_BAR = 4096, CW_CTR = 16384;

constexpr int RING_BYTES = 131072, LDSCTL_OFF = RING_BYTES, LDS_BYTES = 147456;

DI unsigned pk2(float lo, float hi) { f32x2 v = {lo, hi}; bf16x2_t b = __builtin_convertvector(v, bf16x2_t); return __builtin_bit_cast(unsigned, b); }
DI float bflo(unsigned u) { return __uint_as_float(u << 16); }
DI float bfhi(unsigned u) { return __uint_as_float(u & 0xffff0000u); }
DI float bf2f(bf16_t b) { return __uint_as_float(((unsigned)b) << 16); }
DI bf16_t f2bf(float f) { return (bf16_t)(pk2(f, 0.f) & 0xffffu); }
DI float dot2bf(unsigned a, unsigned b, float c) { return __builtin_amdgcn_fdot2_f32_bf16(__builtin_bit_cast(bf16x2_t, a), __builtin_bit_cast(bf16x2_t, b), c, false); }
DI int opaque_tid() { int t; asm volatile("v_mov_b32 %0, %1" : "=v"(t) : "v"(threadIdx.x)); return t; }
DI float wave_sum(float v) {
#pragma unroll
    for (int o = 1; o < 64; o <<= 1) v += __shfl_xor(v, o);
    return v;
}
DI float gelu_erf(float v) { return 0.5f * v * (1.0f + erff(v * 0.70710678118654752f)); }
DI float swap32_max(float x) { auto rr = __builtin_amdgcn_permlane32_swap(__float_as_uint(x), __float_as_uint(x), false, false); return fmaxf(__uint_as_float(rr[0]), __uint_as_float(rr[1])); }
DI float swap32_sum(float x) { auto rr = __builtin_amdgcn_permlane32_swap(__float_as_uint(x), __float_as_uint(x), false, false); return __uint_as_float(rr[0]) + __uint_as_float(rr[1]); }
#define LDS_WAIT() asm volatile("s_waitcnt lgkmcnt(0)" ::: "memory")
#define VM_WAIT() asm volatile("s_waitcnt vmcnt(0)" ::: "memory")

#define XB_TMO      128
#define XB_XCNT(j)  (256  + 64 * (j))
#define XB_XSUB(j)  (1280 + 64 * (j))
#define XB_XGEN(j)  (2304 + 64 * (j))
#define XB_TOP      3328
#define XB_TOPGEN   3392
#define XCD_BAR_WORDS 3456
#define XB_SPIN_CAP (1u << 20)
DI unsigned xb_ld(unsigned* p)              { return __hip_atomic_load(p, __ATOMIC_RELAXED, __HIP_MEMORY_SCOPE_AGENT); }
DI unsigned xb_add(unsigned* p, unsigned v) { return __hip_atomic_fetch_add(p, v, __ATOMIC_RELAXED, __HIP_MEMORY_SCOPE_AGENT); }
DI unsigned xb_xcc_id() { return (unsigned)__builtin_amdgcn_s_getreg((3 << 11) | 20) & 0xFu; }
#define XB_SPIN(cond, bar) do { unsigned _sp = 0; while (cond) { __builtin_amdgcn_s_sleep(1); \
    if ((++_sp & 255u) == 0u) { if (xb_ld(&(bar)[XB_TMO])) break; if (_sp > XB_SPIN_CAP) { atomicAdd(&(bar)[XB_TMO], 1u); break; } } } } while (0)
struct XcdBarrier { unsigned* bar; unsigned x; volatile LAS unsigned* st; };
DI XcdBarrier xcd_barrier_post(unsigned* bar, volatile LAS unsigned* st) {
    XcdBarrier b; b.bar = bar; b.x = xb_xcc_id(); b.st = st;
    if (threadIdx.x == 0) (void)xb_add(&bar[XB_XCNT(b.x)], 1u);
    return b;
}
DI void xcd_barrier_complete(unsigned* bar, unsigned x, unsigned& nloc, unsigned& nx) {
    const unsigned G = gridDim.x * gridDim.y * gridDim.z;
    unsigned sum, cnt, mine, sp = 0u;
    for (;;) {
        sum = 0u; cnt = 0u; mine = 0u;
#pragma unroll
        for (unsigned j = 0; j < 16; ++j) { const unsigned c = xb_ld(&bar[XB_XCNT(j)]); sum += c; cnt += (c > 0u) ? 1u : 0u; mine = (j == x) ? c : mine; }
        if (sum == G) break;
        __builtin_amdgcn_s_sleep(1);
        if ((++sp & 255u) == 0u) { if (xb_ld(&bar[XB_TMO])) break; if (sp > XB_SPIN_CAP) { atomicAdd(&bar[XB_TMO], 1u); break; } }
    }
    nloc = mine > 0u ? mine : 1u; nx = cnt > 0u ? cnt : 1u;
}
DI void xcd_barrier(const XcdBarrier& b) {
    asm volatile("s_waitcnt vmcnt(0)" ::: "memory");
    __syncthreads();
    if (threadIdx.x == 0) {
        unsigned* bar = b.bar;
        __builtin_amdgcn_s_waitcnt(0);
        unsigned nloc = b.st[0], nx = b.st[1];
        if (nloc == 0u) { xcd_barrier_complete(bar, b.x, nloc, nx); b.st[0] = nloc; b.st[1] = nx; }
        const unsigned old = xb_add(&bar[XB_XSUB(b.x)], 1u);
        const unsigned gen = old / nloc;
        if (old + 1u == (gen + 1u) * nloc) {
            __builtin_amdgcn_fence(__ATOMIC_RELEASE, "agent");
            asm volatile("s_waitcnt vmcnt(0)" ::: "memory");
            const unsigned og = xb_add(&bar[XB_TOP], 1u);
            const unsigned tg = og / nx;
            if (og + 1u == (tg + 1u) * nx) xb_add(&bar[XB_TOPGEN], 1u);
            else XB_SPIN(xb_ld(&bar[XB_TOPGEN]) == tg, bar);
            __builtin_amdgcn_fence(__ATOMIC_ACQUIRE, "agent");
            xb_add(&bar[XB_XGEN(b.x)], 1u);
            asm volatile("s_waitcnt vmcnt(0)" ::: "memory");
        } else {
            XB_SPIN(xb_ld(&bar[XB_XGEN(b.x)]) == gen, bar);
            __builtin_amdgcn_fence(__ATOMIC_ACQUIRE, "agent");
            asm volatile("s_waitcnt vmcnt(0)" ::: "memory");
        }
    }
    __syncthreads();
}

namespace g8 {
constexpr int BM = 256, BK = 64, HALF = 128, HTB = HALF * BK * 2, STAGE_BYTES = 8 * HTB, NXCD = 8, WGM = 8;
DI int lds_byte(int r, int c) { const int st = (r >> 4) * 2 + (c >> 5), rr = r & 15, cc = c & 31, ob = rr * 64 + cc * 2; return st * 1024 + (ob ^ (((ob >> 9) & 1) << 5)); }
DI void stage_rc(int b, int& R, int& C) { const int st = b / 1024, sb = b % 1024, swz = sb ^ (((sb >> 9) & 1) << 5); R = (st >> 1) * 16 + swz / 64; C = (st & 1) * 32 + (swz % 64) / 2; }
DI int perm32(int rho) { const int n = rho >> 4, i = rho & 15; return 8 * (i >> 2) + 4 * n + (i & 3); }

struct Unit { int zo, zi, pm, pn; };
struct Desc { const bf16_t* A; const bf16_t* Bt; int lda, ldb, K, nM, nN, nZo, nZi; long sAo, sAi, sBo, sBi; };
DI bool next_unit(const Desc& g, int i, int G, int c, Unit& u) {
    const int per = g.nM * g.nN, nwg = per * g.nZo * g.nZi;
    const long L = (long)i * G + c; if (L >= nwg) return false;
    int wgid = (int)L; { const int q = nwg / NXCD, r = nwg % NXCD, xcd = wgid % NXCD, off = wgid / NXCD; wgid = (xcd < r ? xcd * (q + 1) : r * (q + 1) + (xcd - r) * q) + off; }
    const int z = wgid / per, w = wgid % per;
    u.zo = z / g.nZi; u.zi = z % g.nZi;
    const int nig = WGM * g.nN, gid = w / nig, fm = gid * WGM, gsz = (g.nM - fm) < WGM ? (g.nM - fm) : WGM;
    u.pm = fm + ((w % nig) % gsz); u.pn = (w % nig) / gsz; return true;
}

template <class Epi>
DI void gemm_phase(LAS unsigned char* lds, const Desc g, const Epi& E, int G, int c) {
    const int tid = opaque_tid(), wid = __builtin_amdgcn_readfirstlane(tid >> 6), lane = tid & 63, wr = wid >> 2, wc = wid & 3, fr = lane & 15, fq = lane >> 4;
    const int K = g.K, nt = K / BK;
    unsigned voffA[2], voffB[2];
#pragma unroll
    for (int i = 0; i < 2; ++i) { int R, C; stage_rc(tid * 16 + i * 8192, R, C); const int Rb = (R & ~31) + perm32(R & 31);
        voffA[i] = (unsigned)(R * g.lda + C) * 2u; voffB[i] = (unsigned)(Rb * g.ldb + C) * 2u; }
    const size_t kstep = (size_t)(BK * 2);
    const size_t hstepA = (size_t)HALF * g.lda * 2, hstepB = (size_t)HALF * g.ldb * 2;
    const unsigned ldsw = (unsigned)wid * 1024u;
    const int aoff = lds_byte(wr * 64 + fr, fq * 8), boff = lds_byte(wc * 32 + fr, fq * 8);
#define PG8_SA(b, h) (((b) * 2 + (h)) * HTB)
#define PG8_SB(b, h) ((4 + (b) * 2 + (h)) * HTB)
#define PG8_STAGE(bufoff, gbase, voff) do { _Pragma("unroll") for (int _i = 0; _i < 2; ++_i) \
        __builtin_amdgcn_global_load_lds((const unsigned*)((const char*)(gbase) + (voff)[_i]), (LAS unsigned*)(lds + (bufoff) + ldsw + _i * 8192), 16, 0, 0); } while (0)
#define PG8_LDA(dst, b, h) do { _Pragma("unroll") for (int m = 0; m < 4; ++m) _Pragma("unroll") for (int k = 0; k < 2; ++k) dst[m][k] = *(const LAS bf16x8*)(lds + PG8_SA(b, h) + aoff + m * 2048 + k * 1024); } while (0)
#define PG8_LDB(dst, b, h) do { _Pragma("unroll") for (int n = 0; n < 2; ++n) _Pragma("unroll") for (int k = 0; k < 2; ++k) dst[n][k] = *(const LAS bf16x8*)(lds + PG8_SB(b, h) + boff + n * 2048 + k * 1024); } while (0)
#define PG8_MMA(ai, bj, At, Bt) do { __builtin_amdgcn_s_setprio(1); _Pragma("unroll") for (int m = 0; m < 4; ++m) _Pragma("unroll") for (int n = 0; n < 2; ++n) _Pragma("unroll") for (int k = 0; k < 2; ++k) \
        acc[ai][bj][m][n] = __builtin_amdgcn_mfma_f32_16x16x32_bf16(Bt[n][k], At[m][k], acc[ai][bj][m][n], 0, 0, 0); __builtin_amdgcn_s_setprio(0); } while (0)
#define PG8_WAIT_V(n) asm volatile("s_waitcnt vmcnt(" #n ")" ::: "memory")
#define PG8_WAIT_L(n) asm volatile("s_waitcnt lgkmcnt(" #n ")" ::: "memory")
#define PG8_BAR __builtin_amdgcn_s_barrier()
#define PG8_SCHED __builtin_amdgcn_sched_barrier(0)
#define PG8_APTR(u) ((const char*)g.A + ((size_t)(u).zo * g.sAo + (size_t)(u).zi * g.sAi + (size_t)(u).pm * BM * g.lda) * 2)
#define PG8_BPTR(u) ((const char*)g.Bt + ((size_t)(u).zo * g.sBo + (size_t)(u).zi * g.sBi + (size_t)(u).pn * BM * g.ldb) * 2)
    Unit cur, nxt; int ui = 0;
    if (!next_unit(g, 0, G, c, cur)) return;
    f32x4 acc[2][2][4][2];
#pragma unroll
    for (int a = 0; a < 2; ++a)
#pragma unroll
        for (int b = 0; b < 2; ++b)
#pragma unroll
            for (int m = 0; m < 4; ++m)
#pragma unroll
                for (int n = 0; n < 2; ++n) acc[a][b][m][n] = (f32x4){0.f, 0.f, 0.f, 0.f};
    bf16x8 At[4][2], B0[2][2], B1[2][2];
    const char* cA = PG8_APTR(cur); const char* cB = PG8_BPTR(cur);
    PG8_STAGE(PG8_SB(0, 0), cB, voffB); PG8_STAGE(PG8_SA(0, 0), cA, voffA); PG8_STAGE(PG8_SB(0, 1), cB + hstepB, voffB); PG8_STAGE(PG8_SA(0, 1), cA + hstepA, voffA);
    if (wr == 1) PG8_BAR;
    PG8_WAIT_V(4); PG8_BAR;
    PG8_STAGE(PG8_SB(1, 0), cB + kstep, voffB); PG8_STAGE(PG8_SA(1, 0), cA + kstep, voffA); PG8_STAGE(PG8_SB(1, 1), cB + hstepB + kstep, voffB);
    PG8_WAIT_V(6); PG8_BAR;
    for (;;) {
        const bool has_next = next_unit(g, ui + 1, G, c, nxt);
        const char* nA = has_next ? PG8_APTR(nxt) : cA; const char* nB = has_next ? PG8_BPTR(nxt) : cB;
        for (int t = 0; t < nt; t += 2) {
            const bool last = (t == nt - 2);
            const char* a1 = cA + (size_t)(t + 1) * kstep;
            const char* a2 = last ? nA : cA + (size_t)(t + 2) * kstep; const char* b2 = last ? nB : cB + (size_t)(t + 2) * kstep;
            const char* a3 = a2 + kstep; const char* b3 = b2 + kstep;
            PG8_LDB(B0, 0, 0); PG8_SCHED; PG8_LDA(At, 0, 0); PG8_STAGE(PG8_SA(1, 1), a1 + hstepA, voffA);
            PG8_WAIT_L(8); PG8_BAR; PG8_WAIT_L(0); PG8_MMA(0, 0, At, B0); PG8_BAR; PG8_SCHED;
            PG8_LDB(B1, 0, 1); PG8_STAGE(PG8_SB(0, 0), b2, voffB);
            PG8_BAR; PG8_WAIT_L(0); PG8_MMA(0, 1, At, B1); PG8_BAR;
            PG8_LDA(At, 0, 1); PG8_STAGE(PG8_SA(0, 0), a2, voffA);
            PG8_BAR; PG8_WAIT_L(0); PG8_MMA(1, 0, At, B0); PG8_BAR; PG8_SCHED;
            PG8_STAGE(PG8_SB(0, 1), b2 + hstepB, voffB);
            PG8_WAIT_V(6); PG8_BAR; PG8_MMA(1, 1, At, B1); PG8_BAR;
            PG8_LDB(B0, 1, 0); PG8_SCHED; PG8_LDA(At, 1, 0); PG8_STAGE(PG8_SA(0, 1), a2 + hstepA, voffA);
            PG8_WAIT_L(8); PG8_BAR; PG8_WAIT_L(0); PG8_MMA(0, 0, At, B0); PG8_BAR; PG8_SCHED;
            PG8_LDB(B1, 1, 1); PG8_STAGE(PG8_SB(1, 0), b3, voffB);
            PG8_BAR; PG8_WAIT_L(0); PG8_MMA(0, 1, At, B1); PG8_BAR;
            PG8_LDA(At, 1, 1); PG8_STAGE(PG8_SA(1, 0), a3, voffA);
            PG8_BAR; PG8_WAIT_L(0); PG8_MMA(1, 0, At, B0); PG8_BAR; PG8_SCHED;
            PG8_STAGE(PG8_SB(1, 1), b3 + hstepB, voffB);
            PG8_WAIT_V(6); PG8_BAR; PG8_MMA(1, 1, At, B1); PG8_BAR;
        }
        {
            const int row0 = cur.pm * BM + wr * 64 + fr, col0 = cur.pn * BM + wc * 32 + 8 * fq;
#pragma unroll
            for (int ai = 0; ai < 2; ++ai)
#pragma unroll
                for (int m = 0; m < 4; ++m)
#pragma unroll
                    for (int bj = 0; bj < 2; ++bj) E.oct(cur.zo, cur.zi, row0 + ai * HALF + m * 16, col0 + bj * HALF, acc[ai][bj][m][0], acc[ai][bj][m][1]);
        }
        if (!has_next) break;
#pragma unroll
        for (int a = 0; a < 2; ++a)
#pragma unroll
            for (int b = 0; b < 2; ++b)
#pragma unroll
                for (int m = 0; m < 4; ++m)
#pragma unroll
                    for (int n = 0; n < 2; ++n) acc[a][b][m][n] = (f32x4){0.f, 0.f, 0.f, 0.f};
        cur = nxt; cA = nA; cB = nB; ++ui;
    }
    PG8_WAIT_V(0);
    if (wr == 0) PG8_BAR;
    PG8_BAR;
#undef PG8_SA
#undef PG8_SB
#undef PG8_STAGE
#undef PG8_LDA
#undef PG8_LDB
#undef PG8_MMA
#undef PG8_WAIT_V
#undef PG8_WAIT_L
#undef PG8_BAR
#undef PG8_SCHED
#undef PG8_APTR
#undef PG8_BPTR
}

template <class Epi>
DI void naive_gemm(const Desc g, const Epi& E, int G, int c) {
    const int M = g.nM * BM, N = g.nN * BM, n8 = N / 8, nZ = g.nZo * g.nZi;
    const long total = (long)nZ * M * n8;
    for (long idx = (long)c * NTHREADS + threadIdx.x; idx < total; idx += (long)G * NTHREADS) {
        const int col = (int)(idx % n8) * 8; const int row = (int)((idx / n8) % M); const int z = (int)(idx / ((long)n8 * M));
        const int zo = z / g.nZi, zi = z % g.nZi;
        const bf16_t* a = g.A + (size_t)zo * g.sAo + (size_t)zi * g.sAi + (size_t)row * g.lda;
        const bf16_t* b = g.Bt + (size_t)zo * g.sBo + (size_t)zi * g.sBi + (size_t)col * g.ldb;
        float acc[8];
#pragma unroll
        for (int j = 0; j < 8; ++j) acc[j] = 0.f;
        for (int k = 0; k < g.K; k += 8) {
            const u32x4 av = *(const u32x4*)(a + k);
#pragma unroll
            for (int j = 0; j < 8; ++j) { const u32x4 bv = *(const u32x4*)(b + (size_t)j * g.ldb + k);
                float s = acc[j]; s = dot2bf(av.x, bv.x, s); s = dot2bf(av.y, bv.y, s); s = dot2bf(av.z, bv.z, s); s = dot2bf(av.w, bv.w, s); acc[j] = s; }
        }
        E.oct(zo, zi, row, col, (f32x4){acc[0], acc[1], acc[2], acc[3]}, (f32x4){acc[4], acc[5], acc[6], acc[7]});
    }
}
template <class Epi>
DI void gemm(LAS unsigned char* lds, const Desc g, const Epi& E, int G, int c) {
#if !EN_GEMM
    return;
#elif FAST_GEMM
    gemm_phase(lds, g, E, G, c);
#else
    naive_gemm(g, E, G, c);
#endif
}
}

struct EpiBf16 {
    bf16_t* O; long ldc, sZo, sZi; float scale;
    DI void oct(int zo, int zi, int row, int col, f32x4 lo, f32x4 hi) const {
        bf16_t* p = O + (size_t)zo * sZo + (size_t)zi * sZi + (size_t)row * ldc + col;
        u32x4 w; w.x = pk2(lo[0] * scale, lo[1] * scale); w.y = pk2(lo[2] * scale, lo[3] * scale); w.z = pk2(hi[0] * scale, hi[1] * scale); w.w = pk2(hi[2] * scale, hi[3] * scale);
        *(u32x4*)p = w;
    }
};
struct EpiF32 {
    float* O; long ldc, sZo, sZi; float scale;
    DI void oct(int zo, int zi, int row, int col, f32x4 lo, f32x4 hi) const {
        float* p = O + (size_t)zo * sZo + (size_t)zi * sZi + (size_t)row * ldc + col;
        *(f32x4*)p = lo * scale; *(f32x4*)(p + 4) = hi * scale;
    }
};
struct EpiResid {
    const float* resid; float* out; long ldc;
    DI void oct(int, int, int row, int col, f32x4 lo, f32x4 hi) const {
        const size_t o = (size_t)row * ldc + col;
        const f32x4 r0 = *(const f32x4*)(resid + o), r1 = *(const f32x4*)(resid + o + 4);
        *(f32x4*)(out + o) = r0 + lo; *(f32x4*)(out + o + 4) = r1 + hi;
    }
};
template <int MODE> struct EpiRope {
    bf16_t* O; long ldc; const int* pos; const f32x2* tab;
    DI void oct(int, int, int row, int col, f32x4 lo, f32x4 hi) const {
        bool rope; int j0;
        if (MODE == 0) { rope = col < 2 * DIFF_W; j0 = col & 63; } else { const int c = col % 192; rope = c >= 128; j0 = c - 128; }
        if (rope) {
            int p = pos[row]; p = p < 0 ? 0 : (p > ROPE_POS - 1 ? ROPE_POS - 1 : p);
            const f32x4* tp = (const f32x4*)(tab + (size_t)p * 32 + (j0 >> 1));
            const f32x4 t0 = tp[0], t1 = tp[1];
            f32x4 a = lo, b = hi;
            lo[0] = a[0] * t0[0] - a[1] * t0[1]; lo[1] = a[1] * t0[0] + a[0] * t0[1];
            lo[2] = a[2] * t0[2] - a[3] * t0[3]; lo[3] = a[3] * t0[2] + a[2] * t0[3];
            hi[0] = b[0] * t1[0] - b[1] * t1[1]; hi[1] = b[1] * t1[0] + b[0] * t1[1];
            hi[2] = b[2] * t1[2] - b[3] * t1[3]; hi[3] = b[3] * t1[2] + b[2] * t1[3];
        }
        u32x4 w; w.x = pk2(lo[0], lo[1]); w.y = pk2(lo[2], lo[3]); w.z = pk2(hi[0], hi[1]); w.w = pk2(hi[2], hi[3]);
        *(u32x4*)(O + (size_t)row * ldc + col) = w;
    }
};
struct EpiGlu {
    const bf16_t* gbuf; const float* bias; bf16_t* out;
    DI void oct(int, int, int row, int col, f32x4 lo, f32x4 hi) const {
        const u32x4 gv = *(const u32x4*)(gbuf + (size_t)row * S5_W + col);
        const f32x4 b0 = *(const f32x4*)(bias + col), b1 = *(const f32x4*)(bias + col + 4);
        float g[8] = {bflo(gv.x), bfhi(gv.x), bflo(gv.y), bfhi(gv.y), bflo(gv.z), bfhi(gv.z), bflo(gv.w), bfhi(gv.w)};
        float a[8] = {lo[0] + b0[0], lo[1] + b0[1], lo[2] + b0[2], lo[3] + b0[3], hi[0] + b1[0], hi[1] + b1[1], hi[2] + b1[2], hi[3] + b1[3]};
        float r[8];
#pragma unroll
        for (int j = 0; j < 8; ++j) r[j] = g[j] / (1.0f + __expf(-a[j]));
        u32x4 w; w.x = pk2(r[0], r[1]); w.y = pk2(r[2], r[3]); w.z = pk2(r[4], r[5]); w.w = pk2(r[6], r[7]);
        *(u32x4*)(out + (size_t)row * DM + DIFF_W + col) = w;
    }
};

struct EpiNull { DI void oct(int, int, int, int, f32x4 lo, f32x4 hi) const { asm volatile("" :: "v"(lo), "v"(hi)); } };
struct Params {
    const float* in[39];
    float* out; unsigned char* ws;
    int ph_lo, ph_hi;
};
enum { I_X = 0, I_MEM, I_POS, I_AB_NORM, I_AB_WIN, I_AB_WOUT, I_LQ1, I_LK1, I_LQ2, I_LK2, I_SUBLN, I_S5_ARE, I_S5_AIM, I_S5_LOGSTEP, I_S5_BRE, I_S5_BIM, I_S5_CRE, I_S5_CIM, I_S5_D,
       I_S5_WGLU, I_S5_BGLU, I_MLA_NORM, I_MLA_WIN, I_MLA_QNORM, I_MLA_KVNORM, I_MLA_WUQ, I_MLA_WUKV, I_MLA_WO, I_XA_NORM, I_XA_MEMNORM, I_XA_WQ, I_XA_WKV, I_XA_WO, I_FFN_NORM,
       I_PEER_WQ, I_PEER_SK, I_PEER_U, I_PEER_V, I_FINAL_NORM };

struct Ctx { LAS unsigned char* lds; int tid, lane, wave, blk, G; };
DI Ctx fresh(const Ctx& C0) { Ctx C = C0; C.tid = opaque_tid(); C.lane = C.tid & 63; return C; }

DI void rms_rows_2048(const Ctx& C0, const float* src, const float* gain, bf16_t* dst, int nrows) {
    const Ctx C = fresh(C0);
    for (int r = C.blk * NWAVES + C.wave; r < nrows; r += C.G * NWAVES) {
        const f32x4* xr = (const f32x4*)(src + (size_t)r * DM) + C.lane;
        f32x4 v[8]; float ss = 0.f;
#pragma unroll
        for (int j = 0; j < 8; ++j) { v[j] = xr[64 * j]; ss += (v[j][0] * v[j][0] + v[j][1] * v[j][1]) + (v[j][2] * v[j][2] + v[j][3] * v[j][3]); }
        const float sc = rsqrtf(wave_sum(ss) * (1.0f / DM) + NORM_EPS);
        u32x2* o = (u32x2*)(dst + (size_t)r * DM) + C.lane;
#pragma unroll
        for (int j = 0; j < 8; ++j) { const f32x4 g = *((const f32x4*)gain + C.lane + 64 * j);
            u32x2 w; w.x = pk2(v[j][0] * sc * g[0], v[j][1] * sc * g[1]); w.y = pk2(v[j][2] * sc * g[2], v[j][3] * sc * g[3]); o[64 * j] = w; }
    }
}
DI void rms_rows_final(const Ctx& C0, float* x, const float* gain, int nrows) {
    const Ctx C = fresh(C0);
    for (int r = C.blk * NWAVES + C.wave; r < nrows; r += C.G * NWAVES) {
        f32x4* xr = (f32x4*)(x + (size_t)r * DM) + C.lane;
        f32x4 v[8]; float ss = 0.f;
#pragma unroll
        for (int j = 0; j < 8; ++j) { v[j] = xr[64 * j]; ss += (v[j][0] * v[j][0] + v[j][1] * v[j][1]) + (v[j][2] * v[j][2] + v[j][3] * v[j][3]); }
        const float sc = rsqrtf(wave_sum(ss) * (1.0f / DM) + NORM_EPS);
#pragma unroll
        for (int j = 0; j < 8; ++j) { const f32x4 g = *((const f32x4*)gain + C.lane + 64 * j); xr[64 * j] = v[j] * sc * g; }
    }
}

DI int srccol(int kind, int n) {
    if (kind == 1) { if (n < 2 * DIFF_W) { const int j = n & 63; return (n & ~63) + (j >> 1) + 32 * (j & 1); } return n; }
    if (kind == 2) { if (n >= MLA_IN) return -1; if (n >= 1024) { const int j = n - 1024; return 1024 + (j >> 1) + 32 * (j & 1); } return n; }
    if (kind == 3) { const int c = n % 192; if (c >= 128) { const int j = c - 128; return n - c + 128 + (j >> 1) + 32 * (j & 1); } return n; }
    return n;
}
DI void transpose_item(const float* W, int K, int Nsrc, bf16_t* Wt, int nblk, int kind, LAS float* scr, int item, int lane) {
    const int kb = item / nblk, nb = item % nblk, k0 = 64 * kb, n0 = 32 * nb;
    const int src = srccol(kind, n0 + (lane & 31));
#pragma unroll 8
    for (int i = 0; i < 32; ++i) { const int kk = 2 * i + (lane >> 5); scr[kk * 33 + (lane & 31)] = (src >= 0) ? W[(size_t)(k0 + kk) * Nsrc + src] : 0.f; }
    LDS_WAIT(); asm volatile("" ::: "memory");
    const int c = lane & 7;
#pragma unroll
    for (int j = 0; j < 4; ++j) { const int n = (lane >> 3) + 8 * j; const LAS float* s = scr + (8 * c) * 33 + n;
        u32x4 o; o.x = pk2(s[0 * 33], s[1 * 33]); o.y = pk2(s[2 * 33], s[3 * 33]); o.z = pk2(s[4 * 33], s[5 * 33]); o.w = pk2(s[6 * 33], s[7 * 33]);
        *(u32x4*)(Wt + (size_t)(n0 + n) * K + k0 + 8 * c) = o; }
    LDS_WAIT(); asm volatile("" ::: "memory");
}
DI void cvt_bf16(const Ctx& C0, const float* src, bf16_t* dst, size_t n8) {
    const Ctx C = fresh(C0);
    for (size_t i = (size_t)C.blk * NTHREADS + C.tid; i < n8; i += (size_t)C.G * NTHREADS) {
        const f32x4 a = *(const f32x4*)(src + i * 8), b = *(const f32x4*)(src + i * 8 + 4);
        u32x4 w; w.x = pk2(a[0], a[1]); w.y = pk2(a[2], a[3]); w.z = pk2(b[0], b[1]); w.w = pk2(b[2], b[3]);
        *(u32x4*)(dst + i * 8) = w;
    }
}


DI void cvt_fp8_rows(const Ctx& C0, const float* src, unsigned char* dst, float* isc, int nrows) {
    const Ctx C = fresh(C0);
    for (int r = C.blk * NWAVES + C.wave; r < nrows; r += C.G * NWAVES) {
        const f32x4* xr = (const f32x4*)(src + (size_t)r * DM) + C.lane;
        f32x4 v[8]; float am = 0.f;
#pragma unroll
        for (int j = 0; j < 8; ++j) { v[j] = xr[64 * j]; am = fmaxf(am, fmaxf(fmaxf(fabsf(v[j][0]), fabsf(v[j][1])), fmaxf(fabsf(v[j][2]), fabsf(v[j][3])))); }
#pragma unroll
        for (int o = 1; o < 64; o <<= 1) am = fmaxf(am, __shfl_xor(am, o));
        const float e = am > 0.f ? floorf(log2f(448.0f / am)) : 0.f;
        const float scale = exp2f(e);
        if (C.lane == 0) isc[r] = exp2f(-e);
#if PEER_SLICED
        unsigned* o = (unsigned*)(dst + (size_t)(C.lane >> 5) * ((size_t)PEER_NE * 128) + (size_t)r * 128) + (C.lane & 31);
#pragma unroll
        for (int j = 0; j < 8; ++j) { int w = 0; w = __builtin_amdgcn_cvt_pk_fp8_f32(v[j][0] * scale, v[j][1] * scale, w, false); w = __builtin_amdgcn_cvt_pk_fp8_f32(v[j][2] * scale, v[j][3] * scale, w, true); o[(size_t)2 * j * (PEER_NE * 128 / 4)] = (unsigned)w; }
#else
        unsigned* o = (unsigned*)(dst + (size_t)r * DM) + C.lane;
#pragma unroll
        for (int j = 0; j < 8; ++j) { int w = 0; w = __builtin_amdgcn_cvt_pk_fp8_f32(v[j][0] * scale, v[j][1] * scale, w, false); w = __builtin_amdgcn_cvt_pk_fp8_f32(v[j][2] * scale, v[j][3] * scale, w, true); o[64 * j] = (unsigned)w; }
#endif
    }
}

DI void convert_tables(const Ctx& C, const Params& P, int l) {
    unsigned char* ws = P.ws;
#if PEER_FP8
    cvt_fp8_rows(C, P.in[I_PEER_U] + (size_t)l * PEER_NE * DM, ws + P_UT, (float*)(ws + P_UT + 32 * MiB), PEER_NE);
    cvt_fp8_rows(C, P.in[I_PEER_V] + (size_t)l * PEER_NE * DM, ws + P_VT, (float*)(ws + P_VT + 32 * MiB), PEER_NE);
#else
    cvt_bf16(C, P.in[I_PEER_U] + (size_t)l * PEER_NE * DM, (bf16_t*)(ws + P_UT), (size_t)PEER_NE * DM / 8);
    cvt_bf16(C, P.in[I_PEER_V] + (size_t)l * PEER_NE * DM, (bf16_t*)(ws + P_VT), (size_t)PEER_NE * DM / 8);
#endif
}

DI void phase_prologue(const Ctx& C0, const Params& P) {
    const Ctx C = fresh(C0);
    unsigned char* ws = P.ws;
    LAS float* scr = (LAS float*)(C.lds + C.wave * 8448);
    const int gw = C.blk * NWAVES + C.wave, NGW = C.G * NWAVES;
    int base = 0;
#define TJOB(Wp, K_, Nsrc_, Nout_, kind_, dst_) do { const int nblk_ = (Nout_) / 32, nit_ = ((K_) / 64) * nblk_; \
        int first_ = (gw - base % NGW + NGW) % NGW; \
        for (int it = first_; it < nit_; it += NGW) transpose_item((Wp), (K_), (Nsrc_), (bf16_t*)(dst_), nblk_, (kind_), scr, it, C.lane); base += nit_; } while (0)
    TJOB(P.in[I_AB_WIN], DM, AB_IN, AB_IN, 1, ws + WS_ABIN_T);
    TJOB(P.in[I_AB_WOUT], DM, DM, DM, 0, ws + WS_ABOUT_T);
    TJOB(P.in[I_S5_WGLU], S5_W, S5_W, S5_W, 0, ws + WS_GLU_T);
    TJOB(P.in[I_MLA_WIN], DM, MLA_IN, MLA_IN_PAD, 2, ws + WS_MLAIN_T);
    TJOB(P.in[I_MLA_WUQ], MLA_QR, 3072, 3072, 3, ws + WS_UQ_T);
    TJOB(P.in[I_MLA_WUKV], MLA_KVR, 4096, 4096, 0, ws + WS_UKV_T);
    TJOB(P.in[I_MLA_WO], DM, DM, DM, 0, ws + WS_MLAO_T);
    for (int l = 0; l < 2; ++l) {
        TJOB(P.in[I_XA_WQ] + (size_t)l * DM * DM, DM, DM, DM, 0, ws + WS_LW + l * LW_STRIDE + LW_XQ);
        TJOB(P.in[I_XA_WKV] + (size_t)l * DM * 2 * DM, DM, 2 * DM, 2 * DM, 0, ws + WS_LW + l * LW_STRIDE + LW_XKV);
        TJOB(P.in[I_XA_WO] + (size_t)l * DM * DM, DM, DM, DM, 0, ws + WS_LW + l * LW_STRIDE + LW_XO);
    }
#undef TJOB
    {
        f32x2* tab = (f32x2*)(ws + WS_ROPE);
        for (int i = C.blk * NTHREADS + C.tid; i < ROPE_POS * 32; i += C.G * NTHREADS) {
            const int p = i >> 5, f = i & 31;
            const float inv = powf(10000.0f, -(float)f * (2.0f / 64.0f));
            const float ang = (float)p * inv;
            tab[i] = (f32x2){(float)cos((double)ang), (float)sin((double)ang)};
        }
    }
    cvt_bf16(C, P.in[I_PEER_WQ], (bf16_t*)(ws + P_WQB), (size_t)2 * DM * DM / 8);
    {
        bf16_t* sk = (bf16_t*)(ws + P_SK); const float* skin = P.in[I_PEER_SK];
        for (int i = C.blk * NTHREADS + C.tid; i < 2 * 8 * 256 * 256 / 8; i += C.G * NTHREADS) {
            const int q8 = (i & 31) * 8, np = (i >> 5) & 255, lh = i >> 13;
            const int c = np >> 7, n = np & 127, c2 = q8 >> 7, q = q8 & 127;
            u32x4 w = {0u, 0u, 0u, 0u};
            if (c == c2) { const float* s = skin + ((((size_t)lh * 2 + c) * 128 + n) * 128 + q);
                const f32x4 a = *(const f32x4*)s, b = *(const f32x4*)(s + 4);
                w.x = pk2(a[0], a[1]); w.y = pk2(a[2], a[3]); w.z = pk2(b[0], b[1]); w.w = pk2(b[2], b[3]); }
            *(u32x4*)(sk + (size_t)i * 8) = w;
        }
    }
    convert_tables(C, P, 0);
    for (int l = 0; l < 2; ++l) rms_rows_2048(C, P.in[I_MEM], P.in[I_XA_MEMNORM] + l * DM, (bf16_t*)(ws + P_MEMN) + (size_t)l * MT * DM, MT);
}

DI void phase_s5(const Ctx& C0, const Params& P, int first, int last, int stride_w, int stride) {
    const Ctx C = fresh(C0);
    unsigned char* ws = P.ws;
    const bf16_t* proj = (const bf16_t*)(ws + P_PROJ); bf16_t* gbuf = (bf16_t*)(ws + P_GBUF);
    LAS unsigned char* my = C.lds + C.wave * 8192;
    LAS float* U = (LAS float*)my;
    LAS bf16_t* H = (LAS bf16_t*)(my + 1024);
    const int lane = C.lane, n = lane;
    for (int task = first + C.wave * stride_w; task < last; task += stride) {
        const int b = task >> 5, g = task & 31;
        const float a_re = P.in[I_S5_ARE][g * 64 + n], a_im = P.in[I_S5_AIM][g * 64 + n];
        const float step = expf(P.in[I_S5_LOGSTEP][g]);
        const float mag = expf(a_re * step);
        const float ab_re = mag * cosf(a_im * step), ab_im = mag * sinf(a_im * step);
        const float den = a_re * a_re + a_im * a_im, num_re = ab_re - 1.0f;
        const float f_re = (num_re * a_re + ab_im * a_im) / den, f_im = (ab_im * a_re - num_re * a_im) / den;
        float bbr[16], bbi[16];
        {
            const float* br = P.in[I_S5_BRE] + ((size_t)g * 64 + n) * 16; const float* bi = P.in[I_S5_BIM] + ((size_t)g * 64 + n) * 16;
#pragma unroll
            for (int p = 0; p < 16; ++p) { const float x = br[p], y = bi[p]; bbr[p] = f_re * x - f_im * y; bbi[p] = f_re * y + f_im * x; }
        }
        bf16x8 cf[4];
        {
            const int p = lane & 15, kq = lane >> 4;
#pragma unroll
            for (int kk = 0; kk < 4; ++kk) {
                const int k = 32 * kk + 8 * kq; const bool im = k >= 64;
                const float* src = (im ? P.in[I_S5_CIM] : P.in[I_S5_CRE]) + ((size_t)g * 16 + p) * 64 + (k & 63);
                const float sg = im ? -1.f : 1.f;
                const f32x4 a = *(const f32x4*)src, bq = *(const f32x4*)(src + 4);
                u32x4 w; w.x = pk2(sg * a[0], sg * a[1]); w.y = pk2(sg * a[2], sg * a[3]); w.z = pk2(sg * bq[0], sg * bq[1]); w.w = pk2(sg * bq[2], sg * bq[3]);
                cf[kk] = __builtin_bit_cast(bf16x8, w);
            }
        }
        const float dcoef = P.in[I_S5_D][g * 16 + (lane & 15)];
        float h_re = 0.f, h_im = 0.f;
        const bf16_t* ub = proj + (size_t)b * SEQ * AB_IN + 3 * DIFF_W + g * 16;
        for (int s0 = 0; s0 < SEQ; s0 += 16) {
            {
                const int st = lane >> 2, pp = (lane & 3) * 4;
                const u32x2 uv = *(const u32x2*)(ub + (size_t)(s0 + st) * AB_IN + pp);
                *(LAS f32x4*)(U + st * 16 + pp) = (f32x4){bflo(uv.x), bfhi(uv.x), bflo(uv.y), bfhi(uv.y)};
            }
            LDS_WAIT(); asm volatile("" ::: "memory");
#pragma unroll 4
            for (int st = 0; st < 16; ++st) {
                const f32x4 u0 = *(const LAS f32x4*)(U + st * 16), u1 = *(const LAS f32x4*)(U + st * 16 + 4), u2 = *(const LAS f32x4*)(U + st * 16 + 8), u3 = *(const LAS f32x4*)(U + st * 16 + 12);
                const float uu[16] = {u0[0], u0[1], u0[2], u0[3], u1[0], u1[1], u1[2], u1[3], u2[0], u2[1], u2[2], u2[3], u3[0], u3[1], u3[2], u3[3]};
                float br = 0.f, bi = 0.f;
#pragma unroll
                for (int p = 0; p < 16; ++p) { br = fmaf(bbr[p], uu[p], br); bi = fmaf(bbi[p], uu[p], bi); }
                const float nr = ab_re * h_re - ab_im * h_im + br, ni = ab_re * h_im + ab_im * h_re + bi;
                h_re = nr; h_im = ni;
                H[st * 136 + n] = f2bf(h_re); H[st * 136 + 64 + n] = f2bf(h_im);
            }
            LDS_WAIT(); asm volatile("" ::: "memory");
            f32x4 acc = {0.f, 0.f, 0.f, 0.f};
#pragma unroll
            for (int kk = 0; kk < 4; ++kk) {
                const bf16x8 af = *(const LAS bf16x8*)((LAS unsigned char*)H + (lane & 15) * 272 + (32 * kk + 8 * (lane >> 4)) * 2);
                acc = __builtin_amdgcn_mfma_f32_16x16x32_bf16(af, cf[kk], acc, 0, 0, 0);
            }
#pragma unroll
            for (int r = 0; r < 4; ++r) {
                const int st = (lane >> 4) * 4 + r, p = lane & 15;
                const float y = acc[r] + dcoef * U[st * 16 + p];
                gbuf[(size_t)(b * SEQ + s0 + st) * S5_W + g * 16 + p] = f2bf(gelu_erf(y));
            }
            LDS_WAIT(); asm volatile("" ::: "memory");
        }
    }
}

struct AttnArgs { const bf16_t* Qn; const bf16_t* Qr; const bf16_t* Kn; const bf16_t* Kr; const bf16_t* V; int ldq, ldkn, ldkr, ldv; };
DI int crow(int r, int hi) { return (r & 3) + 8 * (r >> 2) + 4 * hi; }
template <int DK> DI int koff(int row, int ch) { return DK == 64 ? row * 128 + 16 * (ch ^ ((row >> 1) & 7)) : row * 256 + 16 * (ch ^ (row & 15)); }
DI int voff(int row, int ch) { return 256 * row + 16 * (ch ^ (((row & 3) << 2) | ((row >> 2) & 3))); }
DI bf16x8 pack8(const f32x16& p, int s) {
    u32x4 w; w.x = pk2(p[8 * s + 0], p[8 * s + 1]); w.y = pk2(p[8 * s + 2], p[8 * s + 3]); w.z = pk2(p[8 * s + 4], p[8 * s + 5]); w.w = pk2(p[8 * s + 6], p[8 * s + 7]);
    return __builtin_bit_cast(bf16x8, w);
}
DI s16x4 vtr(const LAS unsigned char* p) { return __builtin_bit_cast(s16x4, __builtin_amdgcn_ds_read_tr16_b64_v4i16((LAS s16x4*)p)); }

template <int DKN, int DKR>
DI void attn_core(const AttnArgs& a, int q0, LAS unsigned char* lds, float scale, f32x16 (&o)[4]) {
    const int tid = opaque_tid(), wid = __builtin_amdgcn_readfirstlane(tid >> 6), lane = tid & 63, r32 = lane & 31, hi = lane >> 5;
    constexpr int CN = DKN / 8, NLK = CN * 64 / NTHREADS, KNB = 64 * DKN * 2, KRB = 64 * DKR * 2, VOFF = KNB + KRB, BUF = VOFF + 16384;
    static_assert(2 * BUF <= RING_BYTES, "attention LDS");
    bf16x8 qn[DKN / 16]; bf16x8 qr[DKR ? DKR / 16 : 1];
    {
        const bf16_t* qp = a.Qn + (size_t)(q0 + 32 * wid + r32) * a.ldq + hi * 8;
#pragma unroll
        for (int d0 = 0; d0 < DKN / 16; ++d0) qn[d0] = *(const bf16x8*)(qp + d0 * 16);
        if (DKR) { const bf16_t* qp2 = a.Qr + (size_t)(q0 + 32 * wid + r32) * a.ldq + hi * 8;
#pragma unroll
            for (int d0 = 0; d0 < DKR / 16; ++d0) qr[d0] = *(const bf16x8*)(qp2 + d0 * 16); }
    }
    const int NT = (q0 + 256) / 64, NTw = (q0 + 32 * wid + 31) / 64 + 1;
    u32x4 skn[NLK], skr, sv[2];
#define AT_LOAD(t) do { _Pragma("unroll") for (int i_ = 0; i_ < NLK; ++i_) { const int id_ = tid + NTHREADS * i_, row_ = id_ / CN, ch_ = id_ % CN; \
            skn[i_] = *(const u32x4*)(a.Kn + (size_t)((t) * 64 + row_) * a.ldkn + ch_ * 8); } \
        if (DKR) { const int row_ = tid >> 3, ch_ = tid & 7; skr = *(const u32x4*)(a.Kr + (size_t)((t) * 64 + row_) * a.ldkr + ch_ * 8); } \
        _Pragma("unroll") for (int i_ = 0; i_ < 2; ++i_) { const int id_ = tid + NTHREADS * i_, row_ = id_ >> 4, ch_ = id_ & 15; \
            sv[i_] = *(const u32x4*)(a.V + (size_t)((t) * 64 + row_) * a.ldv + ch_ * 8); } } while (0)
#define AT_WRITE(bf) do { LAS unsigned char* bb_ = lds + (bf) * BUF; \
        _Pragma("unroll") for (int i_ = 0; i_ < NLK; ++i_) { const int id_ = tid + NTHREADS * i_, row_ = id_ / CN, ch_ = id_ % CN; *(LAS u32x4*)(bb_ + koff<DKN>(row_, ch_)) = skn[i_]; } \
        if (DKR) { const int row_ = tid >> 3, ch_ = tid & 7; *(LAS u32x4*)(bb_ + KNB + koff<64>(row_, ch_)) = skr; } \
        _Pragma("unroll") for (int i_ = 0; i_ < 2; ++i_) { const int id_ = tid + NTHREADS * i_, row_ = id_ >> 4, ch_ = id_ & 15; *(LAS u32x4*)(bb_ + VOFF + voff(row_, ch_)) = sv[i_]; } } while (0)
    const float Cs = scale * 1.4426950408889634f;
    float m_run = -1e30f, l_run = 0.f;
#pragma unroll
    for (int blk = 0; blk < 4; ++blk)
#pragma unroll
        for (int r = 0; r < 16; ++r) o[blk][r] = 0.f;
    AT_LOAD(0); AT_WRITE(0); if (NT > 1) AT_LOAD(1);
    for (int t = 0; t < NT; ++t) {
        __syncthreads();
        if (t + 1 < NT) AT_WRITE((t + 1) & 1);
        if (t + 2 < NT) AT_LOAD(t + 2);
        if (t < NTw) {
            const LAS unsigned char* base = lds + (t & 1) * BUF;
            int r32v = r32, lanev = lane; asm volatile("" : "+v"(r32v), "+v"(lanev));
            int vb[4][2];
            {
                const int i = lanev & 15, q_ = i >> 2, p_ = i & 3, grp1 = (lanev >> 4) & 1, hv = lanev >> 5, low2 = 2 * grp1 + (p_ >> 1);
#pragma unroll
                for (int blk = 0; blk < 4; ++blk)
#pragma unroll
                    for (int x = 0; x < 2; ++x) vb[blk][x] = VOFF + 256 * (8 * x + 4 * hv + q_) + 16 * (4 * (blk ^ q_) + (low2 ^ (hv + 2 * x))) + 8 * (p_ & 1);
            }
            f32x16 p0, p1;
#pragma unroll
            for (int r = 0; r < 16; ++r) { p0[r] = 0.f; p1[r] = 0.f; }
#pragma unroll
            for (int d0 = 0; d0 < DKN / 16; ++d0) {
                const bf16x8 b0 = *(const LAS bf16x8*)(base + koff<DKN>(r32v, 2 * d0 + hi)), b1 = *(const LAS bf16x8*)(base + koff<DKN>(32 + r32v, 2 * d0 + hi));
                p0 = __builtin_amdgcn_mfma_f32_32x32x16_bf16(b0, qn[d0], p0, 0, 0, 0); p1 = __builtin_amdgcn_mfma_f32_32x32x16_bf16(b1, qn[d0], p1, 0, 0, 0);
            }
            if (DKR) {
#pragma unroll
                for (int d0 = 0; d0 < DKR / 16; ++d0) {
                    const bf16x8 b0 = *(const LAS bf16x8*)(base + KNB + koff<64>(r32v, 2 * d0 + hi)), b1 = *(const LAS bf16x8*)(base + KNB + koff<64>(32 + r32v, 2 * d0 + hi));
                    p0 = __builtin_amdgcn_mfma_f32_32x32x16_bf16(b0, qr[d0], p0, 0, 0, 0); p1 = __builtin_amdgcn_mfma_f32_32x32x16_bf16(b1, qr[d0], p1, 0, 0, 0);
                }
            }
            if (t == NTw - 1) {
                const int qrel = q0 + 32 * wid + r32 - 64 * t;
#pragma unroll
                for (int r = 0; r < 16; ++r) { const int kv = crow(r, hi); if (kv > qrel) p0[r] = -INFINITY; if (kv + 32 > qrel) p1[r] = -INFINITY; }
            }
            float pmax = p0[0];
#pragma unroll
            for (int r = 1; r < 16; ++r) pmax = fmaxf(pmax, p0[r]);
#pragma unroll
            for (int r = 0; r < 16; ++r) pmax = fmaxf(pmax, p1[r]);
            pmax = swap32_max(pmax);
            const float mn = fmaxf(m_run, pmax);
            const float alpha = __builtin_amdgcn_exp2f((m_run - mn) * Cs);
            m_run = mn;
            const float mnC = -mn * Cs;
            float ps = 0.f;
#pragma unroll
            for (int r = 0; r < 16; ++r) { p0[r] = __builtin_amdgcn_exp2f(fmaf(p0[r], Cs, mnC)); p1[r] = __builtin_amdgcn_exp2f(fmaf(p1[r], Cs, mnC)); ps += p0[r] + p1[r]; }
            l_run = l_run * alpha + ps;
            if (!__all(alpha == 1.0f)) {
#pragma unroll
                for (int blk = 0; blk < 4; ++blk)
#pragma unroll
                    for (int r = 0; r < 16; ++r) o[blk][r] *= alpha;
            }
            bf16x8 pb[4]; pb[0] = pack8(p0, 0); pb[1] = pack8(p0, 1); pb[2] = pack8(p1, 0); pb[3] = pack8(p1, 1);
#pragma unroll
            for (int blk = 0; blk < 4; ++blk) {
                s16x4 lo[4], hh[4];
#pragma unroll
                for (int ks = 0; ks < 4; ++ks) { lo[ks] = vtr(base + vb[blk][0] + 4096 * ks); hh[ks] = vtr(base + vb[blk][1] + 4096 * ks); }
#pragma unroll
                for (int ks = 0; ks < 4; ++ks) {
                    const bf16x8 af = {lo[ks][0], lo[ks][1], lo[ks][2], lo[ks][3], hh[ks][0], hh[ks][1], hh[ks][2], hh[ks][3]};
                    o[blk] = __builtin_amdgcn_mfma_f32_32x32x16_bf16(af, pb[ks], o[blk], 0, 0, 0);
                }
                __builtin_amdgcn_sched_barrier(0);
            }
        }
    }
    __syncthreads();
    const float linv = 1.0f / swap32_sum(l_run);
#pragma unroll
    for (int blk = 0; blk < 4; ++blk)
#pragma unroll
        for (int r = 0; r < 16; ++r) o[blk][r] *= linv;
#undef AT_LOAD
#undef AT_WRITE
}
DI void attn_store(const f32x16 (&o)[4], bf16_t* dst, int ld, int q0) {
    const int tid = opaque_tid(), wid = tid >> 6, lane = tid & 63, r32 = lane & 31, hi = lane >> 5;
    bf16_t* rp = dst + (size_t)(q0 + 32 * wid + r32) * ld;
#pragma unroll
    for (int blk = 0; blk < 4; ++blk)
#pragma unroll
        for (int g = 0; g < 4; ++g) {
            u32x2 w; w.x = pk2(o[blk][4 * g], o[blk][4 * g + 1]); w.y = pk2(o[blk][4 * g + 2], o[blk][4 * g + 3]);
            *(u32x2*)(rp + 32 * blk + 8 * g + 4 * hi) = w;
        }
}
DI int queue_pop(const Ctx& C0, unsigned* ctr, int total) {
    const Ctx C = fresh(C0);
    volatile LAS int* slot = (volatile LAS int*)(C.lds + LDSCTL_OFF + 64);
    __syncthreads();
    if (C.tid == 0) *slot = (int)__hip_atomic_fetch_add(ctr, 1u, __ATOMIC_RELAXED, __HIP_MEMORY_SCOPE_AGENT);
    __syncthreads();
    const int u = *slot;
    return u < total ? u : -1;
}
DI float diff_lambda(const Params& P) {
    float s1 = 0.f, s2 = 0.f;
    for (int i = 0; i < 64; ++i) { s1 += P.in[I_LQ1][i] * P.in[I_LK1][i]; s2 += P.in[I_LQ2][i] * P.in[I_LK2][i]; }
    return expf(s1) - expf(s2) + 0.2f;
}

#if FAST_ATTN
DI void phase_diff_attn(const Ctx& C0, const Params& P, int qi) {
    const Ctx C = fresh(C0);
    unsigned char* ws = P.ws;
    const bf16_t* proj = (const bf16_t*)(ws + P_PROJ); bf16_t* concat = (bf16_t*)(ws + P_CONCAT);
    unsigned* ctr = (unsigned*)(ws + WS_CTL) + CW_CTR + 64 * qi;
    const float lam = diff_lambda(P);
    const int NBH = BATCH * DIFF_HEADS, NS5 = BATCH * 32 / NWAVES, total = NS5 + NBH * 8;
    const int lane = C.lane, r32 = lane & 31, hi = lane >> 5;
    for (;;) {
        int u = queue_pop(C, ctr, total); if (u < 0) break;
        if (u < NS5) { phase_s5(C, P, u * NWAVES, u * NWAVES + NWAVES, 1, NWAVES); continue; }
        u -= NS5;
        const int qb = 7 - u / NBH, bh = u % NBH, b = bh / DIFF_HEADS, h = bh % DIFF_HEADS;
        const bf16_t* base = proj + (size_t)b * SEQ * AB_IN;
        AttnArgs a; a.ldq = AB_IN; a.ldkn = AB_IN; a.ldkr = 0; a.ldv = AB_IN; a.Qr = nullptr; a.Kr = nullptr;
        a.V = base + 2 * DIFF_W + h * 128;
        f32x16 o2[4];
        bf16_t* dst = concat + (size_t)b * SEQ * DM + h * 128;
        a.Qn = base + h * 128; a.Kn = base + DIFF_W + h * 128;
        attn_core<64, 0>(a, qb * 256, C.lds, 0.125f, o2);
        attn_store(o2, dst, DM, qb * 256);
        a.Qn = base + h * 128 + 64; a.Kn = base + DIFF_W + h * 128 + 64;
        attn_core<64, 0>(a, qb * 256, C.lds, 0.125f, o2);
        float ss = 0.f;
        {
            const bf16_t* rp = dst + (size_t)(qb * 256 + 32 * C.wave + r32) * DM;
#pragma unroll
            for (int blk = 0; blk < 4; ++blk)
#pragma unroll
                for (int g = 0; g < 4; ++g) {
                    const u32x2 w = *(const u32x2*)(rp + 32 * blk + 8 * g + 4 * hi);
                    const float o1v[4] = {bflo(w.x), bfhi(w.x), bflo(w.y), bfhi(w.y)};
#pragma unroll
                    for (int j = 0; j < 4; ++j) { const float v = o1v[j] - lam * o2[blk][4 * g + j]; o2[blk][4 * g + j] = v; ss += v * v; }
                }
        }
        ss = swap32_sum(ss);
        const float rs = rsqrtf(ss * (1.0f / 128.0f) + NORM_EPS) * 0.8f;
        const float* sub = P.in[I_SUBLN];
#pragma unroll
        for (int blk = 0; blk < 4; ++blk)
#pragma unroll
            for (int r = 0; r < 16; ++r) o2[blk][r] *= rs * sub[32 * blk + crow(r, hi)];
        attn_store(o2, dst, DM, qb * 256);
    }
}
DI void phase_mla_attn(const Ctx& C0, const Params& P, int qi) {
    const Ctx C = fresh(C0);
    unsigned char* ws = P.ws;
    const bf16_t* q = (const bf16_t*)(ws + P_Q); const bf16_t* kv = (const bf16_t*)(ws + P_KV); const bf16_t* kr = (const bf16_t*)(ws + P_KROPE);
    bf16_t* ob = (bf16_t*)(ws + P_H);
    unsigned* ctr = (unsigned*)(ws + WS_CTL) + CW_CTR + 64 * qi;
    const int NBH = BATCH * MLA_HEADS, total = NBH * 8;
    for (;;) {
        const int u = queue_pop(C, ctr, total); if (u < 0) break;
        const int qb = 7 - u / NBH, bh = u % NBH, b = bh / MLA_HEADS, h = bh % MLA_HEADS;
        AttnArgs a; a.ldq = 3072; a.ldkn = 4096; a.ldkr = 64; a.ldv = 4096;
        a.Qn = q + (size_t)b * SEQ * 3072 + h * 192; a.Qr = a.Qn + 128;
        a.Kn = kv + (size_t)b * SEQ * 4096 + h * 256; a.V = a.Kn + 128; a.Kr = kr + (size_t)b * SEQ * 64;
        f32x16 o[4];
        attn_core<128, 64>(a, qb * 256, C.lds, 0.07216878364870322f, o);
        attn_store(o, ob + (size_t)b * SEQ * DM + h * 128, DM, qb * 256);
    }
}
#else
template <int DK> DI void naive_attn_row(const bf16_t* qrow, const bf16_t* qrow2, const bf16_t* Kn, int ldkn, const bf16_t* Kr, int ldkr, const bf16_t* V, int ldv, int nkeys, float scale, int lane, float& o0, float& o1) {
    float qv[3];
#pragma unroll
    for (int j = 0; j < 3; ++j) { const int d = lane + 64 * j; qv[j] = 0.f; if (d < DK) qv[j] = (DK == 192 && d >= 128) ? bf2f(qrow2[d - 128]) : bf2f(qrow[d]); }
    float m = -1e30f, l = 0.f; o0 = 0.f; o1 = 0.f;
    for (int k = 0; k < nkeys; ++k) {
        float s = 0.f;
#pragma unroll
        for (int j = 0; j < 3; ++j) { const int d = lane + 64 * j; if (d < DK) { const float kvv = (DK == 192 && d >= 128) ? bf2f(Kr[(size_t)k * ldkr + d - 128]) : bf2f(Kn[(size_t)k * ldkn + d]); s += qv[j] * kvv; } }
        s = wave_sum(s) * scale;
        const float mn = fmaxf(m, s), al = expf(m - mn), p = expf(s - mn);
        m = mn; l = l * al + p;
        o0 = o0 * al + p * bf2f(V[(size_t)k * ldv + lane]); o1 = o1 * al + p * bf2f(V[(size_t)k * ldv + 64 + lane]);
    }
    o0 /= l; o1 /= l;
}
DI void phase_diff_attn(const Ctx& C, const Params& P, int) {
    unsigned char* ws = P.ws;
    const bf16_t* proj = (const bf16_t*)(ws + P_PROJ); bf16_t* concat = (bf16_t*)(ws + P_CONCAT);
    const float lam = diff_lambda(P);
    const int lane = C.lane;
    for (int it = C.blk * NWAVES + C.wave; it < BATCH * DIFF_HEADS * SEQ; it += C.G * NWAVES) {
        const int s = it % SEQ, bh = it / SEQ, b = bh / DIFF_HEADS, h = bh % DIFF_HEADS;
        const bf16_t* base = proj + (size_t)b * SEQ * AB_IN;
        const bf16_t* qrow = base + (size_t)s * AB_IN + h * 128;
        float a0, a1, b0, b1;
        naive_attn_row<64>(qrow, nullptr, base + DIFF_W + h * 128, AB_IN, nullptr, 0, base + 2 * DIFF_W + h * 128, AB_IN, s + 1, 0.125f, lane, a0, a1);
        naive_attn_row<64>(qrow + 64, nullptr, base + DIFF_W + h * 128 + 64, AB_IN, nullptr, 0, base + 2 * DIFF_W + h * 128, AB_IN, s + 1, 0.125f, lane, b0, b1);
        const float v0 = a0 - lam * b0, v1 = a1 - lam * b1;
        const float ss = wave_sum(v0 * v0 + v1 * v1);
        const float rs = rsqrtf(ss * (1.0f / 128.0f) + NORM_EPS) * 0.8f;
        bf16_t* orow = concat + (size_t)(b * SEQ + s) * DM + h * 128;
        orow[lane] = f2bf(v0 * rs * P.in[I_SUBLN][lane]); orow[64 + lane] = f2bf(v1 * rs * P.in[I_SUBLN][64 + lane]);
    }
}
DI void phase_mla_attn(const Ctx& C, const Params& P, int) {
    unsigned char* ws = P.ws;
    const bf16_t* q = (const bf16_t*)(ws + P_Q); const bf16_t* kv = (const bf16_t*)(ws + P_KV); const bf16_t* kr = (const bf16_t*)(ws + P_KROPE);
    bf16_t* ob = (bf16_t*)(ws + P_H);
    const int lane = C.lane;
    for (int it = C.blk * NWAVES + C.wave; it < BATCH * MLA_HEADS * SEQ; it += C.G * NWAVES) {
        const int s = it % SEQ, bh = it / SEQ, b = bh / MLA_HEADS, h = bh % MLA_HEADS;
        const bf16_t* qrow = q + (size_t)(b * SEQ + s) * 3072 + h * 192;
        const bf16_t* kn = kv + (size_t)b * SEQ * 4096 + h * 256;
        float a0, a1;
        naive_attn_row<192>(qrow, qrow + 128, kn, 4096, kr + (size_t)b * SEQ * 64, 64, kn + 128, 4096, s + 1, 0.07216878364870322f, lane, a0, a1);
        bf16_t* orow = ob + (size_t)(b * SEQ + s) * DM + h * 128;
        orow[lane] = f2bf(a0); orow[64 + lane] = f2bf(a1);
    }
}
#endif

DI void phase_mla_rows(const Ctx& C0, const Params& P) {
    const Ctx C = fresh(C0);
    unsigned char* ws = P.ws;
    const bf16_t* mp = (const bf16_t*)(ws + P_MLAPROJ); bf16_t* cqn = (bf16_t*)(ws + P_CQN); bf16_t* ckvn = (bf16_t*)(ws + P_CKVN); bf16_t* krp = (bf16_t*)(ws + P_KROPE);
    const f32x2* tab = (const f32x2*)(ws + WS_ROPE);
    const int lane = C.lane;
    for (int r = C.blk * NWAVES + C.wave; r < T; r += C.G * NWAVES) {
        const bf16_t* row = mp + (size_t)r * MLA_IN_PAD;
        float v[12]; float ss = 0.f;
#pragma unroll
        for (int j = 0; j < 3; ++j) { const u32x2 w = *(const u32x2*)(row + 4 * (lane + 64 * j)); v[4 * j] = bflo(w.x); v[4 * j + 1] = bfhi(w.x); v[4 * j + 2] = bflo(w.y); v[4 * j + 3] = bfhi(w.y); }
#pragma unroll
        for (int j = 0; j < 12; ++j) ss += v[j] * v[j];
        float sc = rsqrtf(wave_sum(ss) * (1.0f / MLA_QR) + NORM_EPS);
#pragma unroll
        for (int j = 0; j < 3; ++j) { const f32x4 g = *(const f32x4*)(P.in[I_MLA_QNORM] + 4 * (lane + 64 * j));
            u32x2 w; w.x = pk2(v[4 * j] * sc * g[0], v[4 * j + 1] * sc * g[1]); w.y = pk2(v[4 * j + 2] * sc * g[2], v[4 * j + 3] * sc * g[3]);
            *(u32x2*)(cqn + (size_t)r * MLA_QR + 4 * (lane + 64 * j)) = w; }
        {
            const u32x2 w = *(const u32x2*)(row + MLA_QR + 4 * lane);
            const float a0 = bflo(w.x), a1 = bfhi(w.x), a2 = bflo(w.y), a3 = bfhi(w.y);
            const float s2 = rsqrtf(wave_sum(a0 * a0 + a1 * a1 + a2 * a2 + a3 * a3) * (1.0f / MLA_KVR) + NORM_EPS);
            const f32x4 g = *(const f32x4*)(P.in[I_MLA_KVNORM] + 4 * lane);
            u32x2 o; o.x = pk2(a0 * s2 * g[0], a1 * s2 * g[1]); o.y = pk2(a2 * s2 * g[2], a3 * s2 * g[3]);
            *(u32x2*)(ckvn + (size_t)r * MLA_KVR + 4 * lane) = o;
        }
        if (lane < 32) {
            const unsigned w = *(const unsigned*)(row + 1024 + 2 * lane);
            int p = ((const int*)P.in[I_POS])[r]; p = p < 0 ? 0 : (p > ROPE_POS - 1 ? ROPE_POS - 1 : p);
            const f32x2 cs = tab[(size_t)p * 32 + lane];
            const float x1 = bflo(w), x2 = bfhi(w);
            *(unsigned*)(krp + (size_t)r * 64 + 2 * lane) = pk2(x1 * cs[0] - x2 * cs[1], x2 * cs[0] + x1 * cs[1]);
        }
    }
}

DI void phase_xa_softmax(const Ctx& C0, const Params& P) {
    const Ctx C = fresh(C0);
    unsigned char* ws = P.ws;
    const float* S = (const float*)(ws + P_S); bf16_t* Pb = (bf16_t*)(ws + P_P);
    const int lane = C.lane, hd = lane >> 4, li = lane & 15;
    for (int r = C.blk * NWAVES + C.wave; r < T; r += C.G * NWAVES) {
        const float* row = S + (size_t)r * 1024 + hd * 256;
        f32x4 v[4]; float mx = -1e30f;
#pragma unroll
        for (int j = 0; j < 4; ++j) { v[j] = *(const f32x4*)(row + 4 * (li + 16 * j)); mx = fmaxf(mx, fmaxf(fmaxf(v[j][0], v[j][1]), fmaxf(v[j][2], v[j][3]))); }
#pragma unroll
        for (int o = 1; o < 16; o <<= 1) mx = fmaxf(mx, __shfl_xor(mx, o));
        float sm = 0.f;
#pragma unroll
        for (int j = 0; j < 4; ++j) { v[j][0] = __expf(v[j][0] - mx); v[j][1] = __expf(v[j][1] - mx); v[j][2] = __expf(v[j][2] - mx); v[j][3] = __expf(v[j][3] - mx); sm += (v[j][0] + v[j][1]) + (v[j][2] + v[j][3]); }
#pragma unroll
        for (int o = 1; o < 16; o <<= 1) sm += __shfl_xor(sm, o);
        const float inv = 1.0f / sm;
        bf16_t* orow = Pb + (size_t)r * 1024 + hd * 256;
#pragma unroll
        for (int j = 0; j < 4; ++j) { u32x2 w; w.x = pk2(v[j][0] * inv, v[j][1] * inv); w.y = pk2(v[j][2] * inv, v[j][3] * inv); *(u32x2*)(orow + 4 * (li + 16 * j)) = w; }
    }
}

template <bool STORE> DI void phase_peer(const Ctx& C0, const Params& P) {
    const Ctx C = fresh(C0);
    unsigned char* ws = P.ws;
    const float* sc = (const float*)(ws + P_SC); const bf16_t* hb = (const bf16_t*)(ws + P_H);
    const bf16_t* ut = (const bf16_t*)(ws + P_UT); const bf16_t* vt = (const bf16_t*)(ws + P_VT);
    float* xo = P.out;
    LAS unsigned char* my = C.lds + C.wave * 4096;
    LAS float* top_s = (LAS float*)my;
    LAS int* top_i = (LAS int*)(my + 1024);
    LAS int* best_e = (LAS int*)(my + 2048);
    LAS float* best_g = (LAS float*)(my + 2560);
    LAS float* best_s = (LAS float*)(my + 3072);
    LAS int* best_p = (LAS int*)(my + 3584);
    const int lane = C.lane;
    for (int tok = C.blk * NWAVES + C.wave; tok < T; tok += C.G * NWAVES) {
        for (int rep = 0; rep < (PROBE == 6 ? 2 : 1); ++rep) {
        {
            const int g = lane >> 2, qd = lane & 3;
            float v[32];
            const f32x4* sp = (const f32x4*)(sc + (size_t)tok * 2048 + g * 128 + qd * 32);
#pragma unroll
            for (int j = 0; j < 8; ++j) { const f32x4 x = sp[j]; v[4 * j] = x[0]; v[4 * j + 1] = x[1]; v[4 * j + 2] = x[2]; v[4 * j + 3] = x[3]; }
            for (int r = 0; r < 16; ++r) {
                float bv = v[0]; int bj = 0;
#pragma unroll
                for (int j = 1; j < 32; ++j) { const bool gt = v[j] > bv; bv = gt ? v[j] : bv; bj = gt ? j : bj; }
                int bn = qd * 32 + bj;
#pragma unroll
                for (int off = 1; off <= 2; off <<= 1) { const float ov = __shfl_xor(bv, off); const int on = __shfl_xor(bn, off); const bool tk = (ov > bv) || (ov == bv && on < bn); bv = tk ? ov : bv; bn = tk ? on : bn; }
                if (qd == 0) { top_s[g * 16 + r] = bv; top_i[g * 16 + r] = bn; }
                const int rem = ((bn >> 5) == qd) ? (bn & 31) : -1;
#pragma unroll
                for (int j = 0; j < 32; ++j) v[j] = (j == rem) ? -INFINITY : v[j];
            }
        }
        LDS_WAIT(); asm volatile("" ::: "memory");
        {
            const int h = lane >> 3, sub = lane & 7;
            float v[32];
            const float s00 = top_s[(2 * h) * 16 + 2 * sub], s01 = top_s[(2 * h) * 16 + 2 * sub + 1];
#pragma unroll
            for (int k2 = 0; k2 < 16; ++k2) { const float s1 = top_s[(2 * h + 1) * 16 + k2]; v[k2] = s00 + s1; v[16 + k2] = s01 + s1; }
            for (int r = 0; r < 16; ++r) {
                float bv = v[0]; int bj = 0;
#pragma unroll
                for (int j = 1; j < 32; ++j) { const bool gt = v[j] > bv; bv = gt ? v[j] : bv; bj = gt ? j : bj; }
                int bn = sub * 32 + bj;
#pragma unroll
                for (int off = 1; off <= 4; off <<= 1) { const float ov = __shfl_xor(bv, off); const int on = __shfl_xor(bn, off); const bool tk = (ov > bv) || (ov == bv && on < bn); bv = tk ? ov : bv; bn = tk ? on : bn; }
                if (sub == 0) { best_s[h * 16 + r] = bv; best_p[h * 16 + r] = bn; }
                const int rem = ((bn >> 5) == sub) ? (bn & 31) : -1;
#pragma unroll
                for (int j = 0; j < 32; ++j) v[j] = (j == rem) ? -INFINITY : v[j];
            }
        }
        LDS_WAIT(); asm volatile("" ::: "memory");
#pragma unroll
        for (int e2 = 0; e2 < 2; ++e2) {
            const int idx = lane + 64 * e2, h = idx >> 4;
            float mx = -1e30f;
            for (int k = 0; k < 16; ++k) mx = fmaxf(mx, best_s[h * 16 + k]);
            float sm = 0.f;
            for (int k = 0; k < 16; ++k) sm += __expf(best_s[h * 16 + k] - mx);
            const float gate = __expf(best_s[idx] - mx) / sm;
            const int pos = best_p[idx], k1 = pos >> 4, k2 = pos & 15;
            best_e[idx] = top_i[(2 * h) * 16 + k1] * 128 + top_i[(2 * h + 1) * 16 + k2];
            best_g[idx] = gate;
        }
        LDS_WAIT(); asm volatile("" ::: "memory");
        }
#if PEER_SLICED
        {
            int* pe = (int*)(ws + P_PE_E) + (size_t)tok * 128; float* pg = (float*)(ws + P_PE_G) + (size_t)tok * 128; float* pa = (float*)(ws + P_PE_ACT) + (size_t)tok * 128;
            pe[lane] = best_e[lane]; pe[64 + lane] = best_e[64 + lane]; pg[lane] = best_g[lane]; pg[64 + lane] = best_g[64 + lane];
        }
#else
#if PEER_FP8
        float tf[32];
#pragma unroll
        for (int i = 0; i < 2; ++i) { const u32x4* tp = (const u32x4*)(hb + (size_t)tok * DM + 16 * (lane + 64 * i));
            const u32x4 a = tp[0], b = tp[1];
            tf[16 * i + 0] = bflo(a.x); tf[16 * i + 1] = bfhi(a.x); tf[16 * i + 2] = bflo(a.y); tf[16 * i + 3] = bfhi(a.y); tf[16 * i + 4] = bflo(a.z); tf[16 * i + 5] = bfhi(a.z); tf[16 * i + 6] = bflo(a.w); tf[16 * i + 7] = bfhi(a.w);
            tf[16 * i + 8] = bflo(b.x); tf[16 * i + 9] = bfhi(b.x); tf[16 * i + 10] = bflo(b.y); tf[16 * i + 11] = bfhi(b.y); tf[16 * i + 12] = bflo(b.z); tf[16 * i + 13] = bfhi(b.z); tf[16 * i + 14] = bflo(b.w); tf[16 * i + 15] = bfhi(b.w); }
        const unsigned char* ut8 = (const unsigned char*)ut; const unsigned char* vt8 = (const unsigned char*)vt;
        const float* usc = (const float*)(ut8 + 32 * MiB); const float* vsc = (const float*)(vt8 + 32 * MiB);
        for (int k0 = 0; k0 < 128; k0 += 8) {
            u32x4 rw[8][2];
#pragma unroll
            for (int kk = 0; kk < 8; ++kk) { const int e = __builtin_amdgcn_readfirstlane(best_e[k0 + kk]); const unsigned char* rp = ut8 + (size_t)e * DM;
#pragma unroll
                for (int i = 0; i < 2; ++i) rw[kk][i] = *(const u32x4*)(rp + 16 * (lane + 64 * i)); }
            float d[8];
#pragma unroll
            for (int kk = 0; kk < 8; ++kk) { float s0 = 0.f, s1 = 0.f;
#pragma unroll
                for (int i = 0; i < 2; ++i) {
                    const unsigned w4[4] = {rw[kk][i].x, rw[kk][i].y, rw[kk][i].z, rw[kk][i].w};
#pragma unroll
                    for (int q = 0; q < 4; ++q) { const f32x2 lo = __builtin_amdgcn_cvt_pk_f32_fp8((int)w4[q], false), hi2 = __builtin_amdgcn_cvt_pk_f32_fp8((int)w4[q], true);
                        s0 = fmaf(lo[0], tf[16 * i + 4 * q], s0); s1 = fmaf(lo[1], tf[16 * i + 4 * q + 1], s1); s0 = fmaf(hi2[0], tf[16 * i + 4 * q + 2], s0); s1 = fmaf(hi2[1], tf[16 * i + 4 * q + 3], s1); }
                }
                d[kk] = s0 + s1; }
            float n4[4], n2[2], r1;
            { const bool b0 = lane & 1;
#pragma unroll
              for (int j = 0; j < 4; ++j) { const float snd = b0 ? d[j] : d[4 + j], kp = b0 ? d[4 + j] : d[j]; n4[j] = kp + __shfl_xor(snd, 1); } }
            { const bool b1 = lane & 2;
#pragma unroll
              for (int j = 0; j < 2; ++j) { const float snd = b1 ? n4[j] : n4[2 + j], kp = b1 ? n4[2 + j] : n4[j]; n2[j] = kp + __shfl_xor(snd, 2); } }
            { const bool b2 = lane & 4; const float snd = b2 ? n2[0] : n2[1], kp = b2 ? n2[1] : n2[0]; r1 = kp + __shfl_xor(snd, 4); }
            r1 += __shfl_xor(r1, 8); r1 += __shfl_xor(r1, 16); r1 += __shfl_xor(r1, 32);
            if (lane < 8) { const int idx = k0 + 4 * (lane & 1) + 2 * ((lane >> 1) & 1) + ((lane >> 2) & 1); const float act = r1 * usc[best_e[idx]]; best_g[idx] *= gelu_erf(act); }
        }
        LDS_WAIT(); asm volatile("" ::: "memory");
        float acc[32];
#pragma unroll
        for (int j = 0; j < 32; ++j) acc[j] = 0.f;
        for (int k0 = 0; k0 < 128; k0 += 8) {
            u32x4 rw[8][2]; float wk[8];
#pragma unroll
            for (int kk = 0; kk < 8; ++kk) { const int e = __builtin_amdgcn_readfirstlane(best_e[k0 + kk]); wk[kk] = best_g[k0 + kk] * vsc[e]; const unsigned char* rp = vt8 + (size_t)e * DM;
#pragma unroll
                for (int i = 0; i < 2; ++i) rw[kk][i] = *(const u32x4*)(rp + 16 * (lane + 64 * i)); }
#pragma unroll
            for (int kk = 0; kk < 8; ++kk)
#pragma unroll
                for (int i = 0; i < 2; ++i) {
                    const unsigned w4[4] = {rw[kk][i].x, rw[kk][i].y, rw[kk][i].z, rw[kk][i].w};
#pragma unroll
                    for (int q = 0; q < 4; ++q) { const f32x2 lo = __builtin_amdgcn_cvt_pk_f32_fp8((int)w4[q], false), hi2 = __builtin_amdgcn_cvt_pk_f32_fp8((int)w4[q], true);
                        acc[16 * i + 4 * q] = fmaf(wk[kk], lo[0], acc[16 * i + 4 * q]); acc[16 * i + 4 * q + 1] = fmaf(wk[kk], lo[1], acc[16 * i + 4 * q + 1]);
                        acc[16 * i + 4 * q + 2] = fmaf(wk[kk], hi2[0], acc[16 * i + 4 * q + 2]); acc[16 * i + 4 * q + 3] = fmaf(wk[kk], hi2[1], acc[16 * i + 4 * q + 3]); }
                }
        }
#else
        u32x4 tv[4];
#pragma unroll
        for (int i = 0; i < 4; ++i) tv[i] = *(const u32x4*)(hb + (size_t)tok * DM + 8 * (lane + 64 * i));
        for (int k0 = 0; k0 < 128; k0 += 4) {
            u32x4 rw[4][4];
#pragma unroll
            for (int kk = 0; kk < 4; ++kk) { const int e = __builtin_amdgcn_readfirstlane(best_e[k0 + kk]); const bf16_t* rp = ut + (size_t)e * DM;
#pragma unroll
                for (int i = 0; i < 4; ++i) rw[kk][i] = *(const u32x4*)(rp + 8 * (lane + 64 * i)); }
            float d[4];
#pragma unroll
            for (int kk = 0; kk < 4; ++kk) { float s = 0.f;
#pragma unroll
                for (int i = 0; i < 4; ++i) { s = dot2bf(rw[kk][i].x, tv[i].x, s); s = dot2bf(rw[kk][i].y, tv[i].y, s); s = dot2bf(rw[kk][i].z, tv[i].z, s); s = dot2bf(rw[kk][i].w, tv[i].w, s); }
                d[kk] = wave_sum(s); }
            if (lane < 4) { const float act = lane == 0 ? d[0] : lane == 1 ? d[1] : lane == 2 ? d[2] : d[3]; best_g[k0 + lane] *= gelu_erf(act); }
        }
        LDS_WAIT(); asm volatile("" ::: "memory");
        float acc[32];
#pragma unroll
        for (int j = 0; j < 32; ++j) acc[j] = 0.f;
        for (int k0 = 0; k0 < 128; k0 += 4) {
            u32x4 rw[4][4]; float wk[4];
#pragma unroll
            for (int kk = 0; kk < 4; ++kk) { const int e = __builtin_amdgcn_readfirstlane(best_e[k0 + kk]); wk[kk] = best_g[k0 + kk]; const bf16_t* rp = vt + (size_t)e * DM;
#pragma unroll
                for (int i = 0; i < 4; ++i) rw[kk][i] = *(const u32x4*)(rp + 8 * (lane + 64 * i)); }
#pragma unroll
            for (int kk = 0; kk < 4; ++kk)
#pragma unroll
                for (int i = 0; i < 4; ++i) {
                    acc[8 * i + 0] = fmaf(wk[kk], bflo(rw[kk][i].x), acc[8 * i + 0]); acc[8 * i + 1] = fmaf(wk[kk], bfhi(rw[kk][i].x), acc[8 * i + 1]);
                    acc[8 * i + 2] = fmaf(wk[kk], bflo(rw[kk][i].y), acc[8 * i + 2]); acc[8 * i + 3] = fmaf(wk[kk], bfhi(rw[kk][i].y), acc[8 * i + 3]);
                    acc[8 * i + 4] = fmaf(wk[kk], bflo(rw[kk][i].z), acc[8 * i + 4]); acc[8 * i + 5] = fmaf(wk[kk], bfhi(rw[kk][i].z), acc[8 * i + 5]);
                    acc[8 * i + 6] = fmaf(wk[kk], bflo(rw[kk][i].w), acc[8 * i + 6]); acc[8 * i + 7] = fmaf(wk[kk], bfhi(rw[kk][i].w), acc[8 * i + 7]);
                }
        }
#endif
        float* xr = xo + (size_t)tok * DM;
        if (!STORE) {
#pragma unroll
            for (int j = 0; j < 32; ++j) asm volatile("" :: "v"(acc[j]));
        } else {
#if PEER_FP8
#pragma unroll
            for (int i = 0; i < 2; ++i) { f32x4* p = (f32x4*)(xr + 16 * (lane + 64 * i));
#pragma unroll
                for (int q = 0; q < 4; ++q) { f32x4 a = p[q]; a[0] += acc[16 * i + 4 * q]; a[1] += acc[16 * i + 4 * q + 1]; a[2] += acc[16 * i + 4 * q + 2]; a[3] += acc[16 * i + 4 * q + 3]; p[q] = a; } }
#else
#pragma unroll
            for (int i = 0; i < 4; ++i) { f32x4* p = (f32x4*)(xr + 8 * (lane + 64 * i));
                f32x4 a = p[0], b = p[1];
                a[0] += acc[8 * i]; a[1] += acc[8 * i + 1]; a[2] += acc[8 * i + 2]; a[3] += acc[8 * i + 3];
                b[0] += acc[8 * i + 4]; b[1] += acc[8 * i + 5]; b[2] += acc[8 * i + 6]; b[3] += acc[8 * i + 7];
                p[0] = a; p[1] = b; }
#endif
        }
#endif
        LDS_WAIT(); asm volatile("" ::: "memory");
    }
}


#if PEER_SLICED
DI int peer_cj(int j) { return ((j >> 3) & 1) | (((j >> 2) & 1) << 1) | (((j >> 1) & 1) << 2); }
constexpr int PEER_CHUNK = 128, PEER_NCHUNK = T / PEER_CHUNK;
DI int peer_cjh(int half, int jj) { return half | (((jj >> 2) & 1) << 1) | (((jj >> 1) & 1) << 2); }
#define PEER_ISSUE(RW, ELO, EHI, HALF) do { _Pragma("unroll") for (int jj = 0; jj < 8; ++jj) { \
        const int e_ = __shfl((jj & 1) ? (EHI) : (ELO), (lane & ~7) | peer_cjh((HALF), jj)); \
        RW[jj] = *(const u32x4*)(tabs + (size_t)e_ * 128); } } while (0)
template <int SIDE  >
DI void phase_peer_sliced(const Ctx& C0, const Params& P, int qbase) {
    const Ctx C = fresh(C0);
    unsigned char* ws = P.ws;
    const bf16_t* hb = (const bf16_t*)(ws + P_H);
    const unsigned char* tab8 = ws + (SIDE == 0 ? P_UT : P_VT);
    const int* pe = (const int*)(ws + P_PE_E); const float* pg = (const float*)(ws + P_PE_G);
    float* xo = P.out;
    const int lane = C.lane, a = lane >> 3, c = lane & 7;
    const int x = (int)(xb_xcc_id() & 7u);
    for (int i = 0; i < 16; ++i) {
        const int s = ((x + (i >> 1)) & 7) + 8 * (i & 1);
        unsigned* ctr = (unsigned*)(ws + WS_CTL) + CW_CTR + 64 * (qbase + s);
        const unsigned char* tabs = tab8 + (size_t)s * ((size_t)PEER_NE * 128) + 16 * c;
        for (;;) {
            const int ch = queue_pop(C, ctr, PEER_NCHUNK); if (ch < 0) break;
            const int tok0 = ch * PEER_CHUNK + C.wave;
            constexpr int NTOK = PEER_CHUNK / NWAVES;
            u32x4 rwA[8], rwB[8];
            int e_lo = pe[(size_t)tok0 * 128 + lane], e_hi = pe[(size_t)tok0 * 128 + 64 + lane];
            u32x4 ta, tb; float w_lo = 0.f, w_hi = 0.f;
            if (SIDE == 0) { const u32x4* tp = (const u32x4*)(hb + (size_t)tok0 * DM + s * 128 + 16 * c); ta = tp[0]; tb = tp[1]; }
            else { w_lo = pg[(size_t)tok0 * 128 + lane]; w_hi = pg[(size_t)tok0 * 128 + 64 + lane]; }
            PEER_ISSUE(rwA, e_lo, e_hi, 0);
#pragma unroll 1
            for (int it = 0; it < NTOK; ++it) {
                const int tok = tok0 + NWAVES * it, ntok = (it + 1 < NTOK) ? tok + NWAVES : tok;
                f32x2* xp = (f32x2*)(xo + (size_t)tok * DM + s * 128 + 16 * c + 8 * (a & 1) + 4 * ((a >> 1) & 1) + 2 * ((a >> 2) & 1));
                f32x2 xv = {0.f, 0.f}; if (SIDE == 1) xv = *xp;
                const int ne_lo = pe[(size_t)ntok * 128 + lane], ne_hi = pe[(size_t)ntok * 128 + 64 + lane];
                u32x4 nta, ntb; float nw_lo = 0.f, nw_hi = 0.f;
                if (SIDE == 0) { const u32x4* tp = (const u32x4*)(hb + (size_t)ntok * DM + s * 128 + 16 * c); nta = tp[0]; ntb = tp[1]; }
                else { nw_lo = pg[(size_t)ntok * 128 + lane]; nw_hi = pg[(size_t)ntok * 128 + 64 + lane]; }
                PEER_ISSUE(rwB, e_lo, e_hi, 1);
                if (SIDE == 0) {
                    const float tf[16] = {bflo(ta.x), bfhi(ta.x), bflo(ta.y), bfhi(ta.y), bflo(ta.z), bfhi(ta.z), bflo(ta.w), bfhi(ta.w), bflo(tb.x), bfhi(tb.x), bflo(tb.y), bfhi(tb.y), bflo(tb.z), bfhi(tb.z), bflo(tb.w), bfhi(tb.w)};
                    float d[16];
#define PEER_DOT(RW, HALF) do { _Pragma("unroll") for (int jj = 0; jj < 8; ++jj) { const unsigned w4[4] = {RW[jj].x, RW[jj].y, RW[jj].z, RW[jj].w}; float s0 = 0.f, s1 = 0.f; \
                        _Pragma("unroll") for (int q = 0; q < 4; ++q) { const f32x2 lo = __builtin_amdgcn_cvt_pk_f32_fp8((int)w4[q], false), hi2 = __builtin_amdgcn_cvt_pk_f32_fp8((int)w4[q], true); \
                            s0 = fmaf(lo[0], tf[4 * q], s0); s1 = fmaf(lo[1], tf[4 * q + 1], s1); s0 = fmaf(hi2[0], tf[4 * q + 2], s0); s1 = fmaf(hi2[1], tf[4 * q + 3], s1); } \
                        d[8 * (HALF) + jj] = s0 + s1; } } while (0)
                    PEER_DOT(rwA, 0);
                    PEER_ISSUE(rwA, ne_lo, ne_hi, 0);
                    PEER_DOT(rwB, 1);
#undef PEER_DOT
                    float n8[8], n4[4], n2[2];
                    { const bool b = c & 1;
#pragma unroll
                      for (int j = 0; j < 8; ++j) { const float snd = b ? d[j] : d[8 + j], kp = b ? d[8 + j] : d[j]; n8[j] = kp + __shfl_xor(snd, 1); } }
                    { const bool b = c & 2;
#pragma unroll
                      for (int j = 0; j < 4; ++j) { const float snd = b ? n8[j] : n8[4 + j], kp = b ? n8[4 + j] : n8[j]; n4[j] = kp + __shfl_xor(snd, 2); } }
                    { const bool b = c & 4;
#pragma unroll
                      for (int j = 0; j < 2; ++j) { const float snd = b ? n4[j] : n4[2 + j], kp = b ? n4[2 + j] : n4[j]; n2[j] = kp + __shfl_xor(snd, 4); } }
                    float* pp = (float*)(ws + P_SC) + ((size_t)s * T + tok) * 128;
                    pp[lane] = n2[0]; pp[64 + lane] = n2[1];
                } else {
                    float acc[16];
#pragma unroll
                    for (int q = 0; q < 16; ++q) acc[q] = 0.f;
#define PEER_AXPY(RW, HALF) do { _Pragma("unroll") for (int jj = 0; jj < 8; ++jj) { const float wj = __shfl((jj & 1) ? w_hi : w_lo, (lane & ~7) | peer_cjh((HALF), jj)); \
                        const unsigned w4[4] = {RW[jj].x, RW[jj].y, RW[jj].z, RW[jj].w}; \
                        _Pragma("unroll") for (int q = 0; q < 4; ++q) { const f32x2 lo = __builtin_amdgcn_cvt_pk_f32_fp8((int)w4[q], false), hi2 = __builtin_amdgcn_cvt_pk_f32_fp8((int)w4[q], true); \
                            acc[4 * q] = fmaf(wj, lo[0], acc[4 * q]); acc[4 * q + 1] = fmaf(wj, lo[1], acc[4 * q + 1]); acc[4 * q + 2] = fmaf(wj, hi2[0], acc[4 * q + 2]); acc[4 * q + 3] = fmaf(wj, hi2[1], acc[4 * q + 3]); } } } while (0)
                    PEER_AXPY(rwA, 0);
                    PEER_ISSUE(rwA, ne_lo, ne_hi, 0);
                    PEER_AXPY(rwB, 1);
#undef PEER_AXPY
                    float n8[8], n4[4], n2[2];
                    { const bool b = a & 1;
#pragma unroll
                      for (int q = 0; q < 8; ++q) { const float snd = b ? acc[q] : acc[8 + q], kp = b ? acc[8 + q] : acc[q]; n8[q] = kp + __shfl_xor(snd, 8); } }
                    { const bool b = a & 2;
#pragma unroll
                      for (int q = 0; q < 4; ++q) { const float snd = b ? n8[q] : n8[4 + q], kp = b ? n8[4 + q] : n8[q]; n4[q] = kp + __shfl_xor(snd, 16); } }
                    { const bool b = a & 4;
#pragma unroll
                      for (int q = 0; q < 2; ++q) { const float snd = b ? n4[q] : n4[2 + q], kp = b ? n4[2 + q] : n4[q]; n2[q] = kp + __shfl_xor(snd, 32); } }
                    xv[0] += n2[0]; xv[1] += n2[1]; *xp = xv;
                }
                e_lo = ne_lo; e_hi = ne_hi;
                if (SIDE == 0) { ta = nta; tb = ntb; } else { w_lo = nw_lo; w_hi = nw_hi; }
            }
        }
    }
}
#undef PEER_ISSUE

DI void phase_peer_combine(const Ctx& C0, const Params& P) {
    const Ctx C = fresh(C0);
    unsigned char* ws = P.ws;
    const float* usc = (const float*)(ws + P_UT + 32 * MiB); const float* vsc = (const float*)(ws + P_VT + 32 * MiB);
    const int* pe = (const int*)(ws + P_PE_E); float* pg = (float*)(ws + P_PE_G); const float* part = (const float*)(ws + P_SC);
    for (size_t i = (size_t)C.blk * NTHREADS + C.tid; i < (size_t)T * 128; i += (size_t)C.G * NTHREADS) {
        float a = 0.f;
#pragma unroll
        for (int s = 0; s < 16; ++s) a += part[(size_t)s * T * 128 + i];
        const int e = pe[i];
        pg[i] = pg[i] * gelu_erf(a * usc[e]) * vsc[e];
    }
}
#endif

constexpr int N_PHASES = 39;
__global__ void __launch_bounds__(NTHREADS, 2) mk_fwd(Params P) {
    extern __shared__ __attribute__((aligned(16))) unsigned char lds_raw[];
    Ctx C; C.lds = (LAS unsigned char*)lds_raw; C.tid = threadIdx.x; C.lane = C.tid & 63; C.wave = __builtin_amdgcn_readfirstlane(C.tid >> 6); C.blk = blockIdx.x; C.G = gridDim.x;
    unsigned char* ws = P.ws;
    for (int u = C.tid; u < (LDS_BYTES - LDSCTL_OFF) / 4; u += NTHREADS) ((LAS unsigned*)(C.lds + LDSCTL_OFF))[u] = 0u;
    __syncthreads();
    XcdBarrier bar; bar.bar = (unsigned*)(ws + WS_CTL) + CW_BAR; bar.x = 0; bar.st = nullptr;
    const bool one = (P.ph_hi - P.ph_lo) > 1;
    if (one) bar = xcd_barrier_post((unsigned*)(ws + WS_CTL) + CW_BAR, (volatile LAS unsigned*)(C.lds + LDSCTL_OFF));
    const int lo = P.ph_lo, hi = P.ph_hi;
#define IN(k) (lo <= (k) && (k) < hi)
#define SEAM(k) do { if (IN(k) && IN((k) + 1)) xcd_barrier(bar); } while (0)
    bf16_t* hbuf = (bf16_t*)(ws + P_H);
    const int* pos = (const int*)P.in[I_POS];
    const f32x2* rtab = (const f32x2*)(ws + WS_ROPE);

    if (IN(0)) { if (EN_PRO) { if (PROBE == 3) { phase_prologue(C, P); __syncthreads(); } phase_prologue(C, P); } } SEAM(0);
    if (IN(1)) {
        {
            g8::Desc g{(const bf16_t*)(ws + P_MEMN), (const bf16_t*)(ws + WS_LW + LW_XKV), DM, DM, DM, MT / 256, DM / 256, 2, 1, (long)MT * DM, 0, (long)(LW_STRIDE / 2), 0};
            EpiBf16 E{(bf16_t*)(ws + WS_KVX), DM, (long)(KVX_STRIDE / 2), 0, 1.0f};
            if (PROBE == 1) { EpiNull En; g8::gemm(C.lds, g, En, C.G, C.blk); } if (GSITE < 0 || GSITE == 1) g8::gemm(C.lds, g, E, C.G, C.blk);
        }
        {
            g8::Desc g{(const bf16_t*)(ws + WS_LW + LW_XKV) + (size_t)DM * DM, (const bf16_t*)(ws + P_MEMN), DM, DM, DM, DM / 256, MT / 256, 2, 1, (long)(LW_STRIDE / 2), 0, (long)MT * DM, 0};
            EpiBf16 E{(bf16_t*)(ws + WS_KVX + 16 * MiB), MT, (long)(KVX_STRIDE / 2), 0, 1.0f};
            if (PROBE == 1) { EpiNull En; g8::gemm(C.lds, g, En, C.G, C.blk); } if (GSITE < 0 || GSITE == 2) g8::gemm(C.lds, g, E, C.G, C.blk);
        }
        {
            g8::Desc g{(const bf16_t*)(ws + P_SK), (const bf16_t*)(ws + P_WQB), 256, DM, 256, 1, DM / 256, 2, 8, 8L * 65536, 65536, (long)DM * DM, 256};
            EpiBf16 E{(bf16_t*)(ws + WS_LW + LW_PEER), DM, (long)(LW_STRIDE / 2), 256L * DM, 1.0f};
            if (PROBE == 1) { EpiNull En; g8::gemm(C.lds, g, En, C.G, C.blk); } if (GSITE < 0 || GSITE == 3) g8::gemm(C.lds, g, E, C.G, C.blk);
        }
    }
    SEAM(1);

    {
        constexpr int l = 0, pb = 2; (void)l;

            if (IN(pb + 0)) { if (PROBE == 5) rms_rows_2048(C, P.in[I_X], P.in[I_AB_NORM], hbuf, T); rms_rows_2048(C, P.in[I_X], P.in[I_AB_NORM], hbuf, T); }
            SEAM(pb + 0);
            if (IN(pb + 1)) {
                g8::Desc g{hbuf, (const bf16_t*)(ws + WS_ABIN_T), DM, DM, DM, T / 256, AB_IN / 256, 1, 1, 0, 0, 0, 0};
                EpiRope<0> E{(bf16_t*)(ws + P_PROJ), AB_IN, pos, rtab};
                if (PROBE == 1) { EpiNull En; g8::gemm(C.lds, g, En, C.G, C.blk); } if (GSITE < 0 || GSITE == 4) g8::gemm(C.lds, g, E, C.G, C.blk);
            }
            SEAM(pb + 1);
            if (IN(pb + 3)) { if (EN_DIFF) { if (PROBE == 2) phase_diff_attn(C, P, 2); phase_diff_attn(C, P, 0); } }
            SEAM(pb + 3);
            if (IN(pb + 4)) {
                g8::Desc g{(const bf16_t*)(ws + P_GBUF), (const bf16_t*)(ws + WS_GLU_T), S5_W, S5_W, S5_W, T / 256, S5_W / 256, 1, 1, 0, 0, 0, 0};
                EpiGlu E{(const bf16_t*)(ws + P_GBUF), P.in[I_S5_BGLU], (bf16_t*)(ws + P_CONCAT)};
                if (PROBE == 1) { EpiNull En; g8::gemm(C.lds, g, En, C.G, C.blk); } if (GSITE < 0 || GSITE == 5) g8::gemm(C.lds, g, E, C.G, C.blk);
            }
            SEAM(pb + 4);
            if (IN(pb + 5)) {
                g8::Desc g{(const bf16_t*)(ws + P_CONCAT), (const bf16_t*)(ws + WS_ABOUT_T), DM, DM, DM, T / 256, DM / 256, 1, 1, 0, 0, 0, 0};
                EpiResid E{P.in[I_X], P.out, DM};
                if (PROBE == 1) { EpiNull En; g8::gemm(C.lds, g, En, C.G, C.blk); } if (GSITE < 0 || GSITE == 6) g8::gemm(C.lds, g, E, C.G, C.blk);
            }
            SEAM(pb + 5);
    }
    {
        constexpr int l = 0, pb = 2; (void)l;
        const unsigned char* lw = ws + WS_LW + (size_t)l * LW_STRIDE;
        if (IN(pb + 6)) { if (PROBE == 5) rms_rows_2048(C, P.out, P.in[I_XA_NORM] + l * DM, hbuf, T); rms_rows_2048(C, P.out, P.in[I_XA_NORM] + l * DM, hbuf, T); }
        SEAM(pb + 6);
        if (IN(pb + 7)) {
            g8::Desc g{hbuf, (const bf16_t*)(lw + LW_XQ), DM, DM, DM, T / 256, DM / 256, 1, 1, 0, 0, 0, 0};
            EpiBf16 E{(bf16_t*)(ws + P_QX), DM, 0, 0, 1.0f};
            if (PROBE == 1) { EpiNull En; g8::gemm(C.lds, g, En, C.G, C.blk); } if (GSITE < 0 || GSITE == 11) g8::gemm(C.lds, g, E, C.G, C.blk);
        }
        SEAM(pb + 7);
        if (IN(pb + 8)) {
            g8::Desc g{(const bf16_t*)(ws + P_QX), (const bf16_t*)(ws + WS_KVX + (size_t)l * KVX_STRIDE), DM, DM, 512, SEQ / 256, 1, BATCH, 4, (long)SEQ * DM, 512, (long)MEM_LEN * DM, 512};
            EpiF32 E{(float*)(ws + P_S), 1024, (long)SEQ * 1024, 256, 0.04419417382415922f};
            if (PROBE == 1) { EpiNull En; g8::gemm(C.lds, g, En, C.G, C.blk); } if (GSITE < 0 || GSITE == 12) g8::gemm(C.lds, g, E, C.G, C.blk);
        }
        SEAM(pb + 8);
        if (IN(pb + 9)) {
            if (PROBE == 5) phase_xa_softmax(C, P);
            phase_xa_softmax(C, P);
            if (l == 1) {
                convert_tables(C, P, 1);
            }
        }
        SEAM(pb + 9);
        if (IN(pb + 10)) {
            g8::Desc g{(const bf16_t*)(ws + P_P), (const bf16_t*)(ws + WS_KVX + (size_t)l * KVX_STRIDE + 16 * MiB), 1024, MT, 256, SEQ / 256, 2, BATCH, 4, (long)SEQ * 1024, 256, 256, 512L * MT};
            EpiBf16 E{(bf16_t*)(ws + P_OX), DM, (long)SEQ * DM, 512, 1.0f};
            if (PROBE == 1) { EpiNull En; g8::gemm(C.lds, g, En, C.G, C.blk); } if (GSITE < 0 || GSITE == 13) g8::gemm(C.lds, g, E, C.G, C.blk);
        }
        SEAM(pb + 10);
        if (IN(pb + 11)) {
            g8::Desc g{(const bf16_t*)(ws + P_OX), (const bf16_t*)(lw + LW_XO), DM, DM, DM, T / 256, DM / 256, 1, 1, 0, 0, 0, 0};
            EpiResid E{P.out, P.out, DM};
            if (PROBE == 1) { EpiNull En; g8::gemm(C.lds, g, En, C.G, C.blk); } if (GSITE < 0 || GSITE == 14) g8::gemm(C.lds, g, E, C.G, C.blk);
        }
        SEAM(pb + 11);
        if (IN(pb + 12)) { if (PROBE == 5) rms_rows_2048(C, P.out, P.in[I_FFN_NORM] + l * DM, hbuf, T); rms_rows_2048(C, P.out, P.in[I_FFN_NORM] + l * DM, hbuf, T); }
        SEAM(pb + 12);
        if (IN(pb + 13)) {
            g8::Desc g{hbuf, (const bf16_t*)(lw + LW_PEER), DM, DM, DM, T / 256, DM / 256, 1, 1, 0, 0, 0, 0};
            EpiF32 E{(float*)(ws + P_SC), DM, 0, 0, 1.0f};
            if (PROBE == 1) { EpiNull En; g8::gemm(C.lds, g, En, C.G, C.blk); } if (GSITE < 0 || GSITE == 15) g8::gemm(C.lds, g, E, C.G, C.blk);
        }
        SEAM(pb + 13);
        if (IN(pb + 14)) { if (EN_PEER && EN_TOPK) phase_peer<true>(C, P); }
        SEAM(pb + 14);
#if PEER_SLICED
        if (IN(pb + 15)) { if (EN_PEER && EN_PU) phase_peer_sliced<0>(C, P, 8 + 32 * l); }
        SEAM(pb + 15);
        if (IN(pb + 16)) { if (EN_PEER) phase_peer_combine(C, P); }
        SEAM(pb + 16);
        if (IN(pb + 17)) { if (EN_PEER && EN_PV) phase_peer_sliced<1>(C, P, 8 + 32 * l + 16); }
        SEAM(pb + 17);
#endif
    }
    {
        constexpr int l = 1, pb = 20; (void)l;

            if (IN(pb + 0)) { if (PROBE == 5) rms_rows_2048(C, P.out, P.in[I_MLA_NORM], hbuf, T); rms_rows_2048(C, P.out, P.in[I_MLA_NORM], hbuf, T); }
            SEAM(pb + 0);
            if (IN(pb + 1)) {
                g8::Desc g{hbuf, (const bf16_t*)(ws + WS_MLAIN_T), DM, DM, DM, T / 256, MLA_IN_PAD / 256, 1, 1, 0, 0, 0, 0};
                EpiBf16 E{(bf16_t*)(ws + P_MLAPROJ), MLA_IN_PAD, 0, 0, 1.0f};
                if (PROBE == 1) { EpiNull En; g8::gemm(C.lds, g, En, C.G, C.blk); } if (GSITE < 0 || GSITE == 7) g8::gemm(C.lds, g, E, C.G, C.blk);
            }
            SEAM(pb + 1);
            if (IN(pb + 2)) { if (PROBE == 5) phase_mla_rows(C, P); phase_mla_rows(C, P); }
            SEAM(pb + 2);
            if (IN(pb + 3)) {
                {
                    g8::Desc g{(const bf16_t*)(ws + P_CQN), (const bf16_t*)(ws + WS_UQ_T), MLA_QR, MLA_QR, MLA_QR, T / 256, 3072 / 256, 1, 1, 0, 0, 0, 0};
                    EpiRope<1> E{(bf16_t*)(ws + P_Q), 3072, pos, rtab};
                    if (PROBE == 1) { EpiNull En; g8::gemm(C.lds, g, En, C.G, C.blk); } if (GSITE < 0 || GSITE == 8) g8::gemm(C.lds, g, E, C.G, C.blk);
                }
                {
                    g8::Desc g{(const bf16_t*)(ws + P_CKVN), (const bf16_t*)(ws + WS_UKV_T), MLA_KVR, MLA_KVR, MLA_KVR, T / 256, 4096 / 256, 1, 1, 0, 0, 0, 0};
                    EpiBf16 E{(bf16_t*)(ws + P_KV), 4096, 0, 0, 1.0f};
                    if (PROBE == 1) { EpiNull En; g8::gemm(C.lds, g, En, C.G, C.blk); } if (GSITE < 0 || GSITE == 9) g8::gemm(C.lds, g, E, C.G, C.blk);
                }
            }
            SEAM(pb + 3);
            if (IN(pb + 4)) { if (EN_MLA) { if (PROBE == 2) phase_mla_attn(C, P, 3); phase_mla_attn(C, P, 1); } }
            SEAM(pb + 4);
            if (IN(pb + 5)) {
                g8::Desc g{hbuf, (const bf16_t*)(ws + WS_MLAO_T), DM, DM, DM, T / 256, DM / 256, 1, 1, 0, 0, 0, 0};
                EpiResid E{P.out, P.out, DM};
                if (PROBE == 1) { EpiNull En; g8::gemm(C.lds, g, En, C.G, C.blk); } if (GSITE < 0 || GSITE == 10) g8::gemm(C.lds, g, E, C.G, C.blk);
            }
            SEAM(pb + 5);
    }
    {
        constexpr int l = 1, pb = 20; (void)l;
        const unsigned char* lw = ws + WS_LW + (size_t)l * LW_STRIDE;
        if (IN(pb + 6)) { if (PROBE == 5) rms_rows_2048(C, P.out, P.in[I_XA_NORM] + l * DM, hbuf, T); rms_rows_2048(C, P.out, P.in[I_XA_NORM] + l * DM, hbuf, T); }
        SEAM(pb + 6);
        if (IN(pb + 7)) {
            g8::Desc g{hbuf, (const bf16_t*)(lw + LW_XQ), DM, DM, DM, T / 256, DM / 256, 1, 1, 0, 0, 0, 0};
            EpiBf16 E{(bf16_t*)(ws + P_QX), DM, 0, 0, 1.0f};
            if (PROBE == 1) { EpiNull En; g8::gemm(C.lds, g, En, C.G, C.blk); } if (GSITE < 0 || GSITE == 11) g8::gemm(C.lds, g, E, C.G, C.blk);
        }
        SEAM(pb + 7);
        if (IN(pb + 8)) {
            g8::Desc g{(const bf16_t*)(ws + P_QX), (const bf16_t*)(ws + WS_KVX + (size_t)l * KVX_STRIDE), DM, DM, 512, SEQ / 256, 1, BATCH, 4, (long)SEQ * DM, 512, (long)MEM_LEN * DM, 512};
            EpiF32 E{(float*)(ws + P_S), 1024, (long)SEQ * 1024, 256, 0.04419417382415922f};
            if (PROBE == 1) { EpiNull En; g8::gemm(C.lds, g, En, C.G, C.blk); } if (GSITE < 0 || GSITE == 12) g8::gemm(C.lds, g, E, C.G, C.blk);
        }
        SEAM(pb + 8);
        if (IN(pb + 9)) {
            if (PROBE == 5) phase_xa_softmax(C, P);
            phase_xa_softmax(C, P);
            if (l == 1) {
                convert_tables(C, P, 1);
            }
        }
        SEAM(pb + 9);
        if (IN(pb + 10)) {
            g8::Desc g{(const bf16_t*)(ws + P_P), (const bf16_t*)(ws + WS_KVX + (size_t)l * KVX_STRIDE + 16 * MiB), 1024, MT, 256, SEQ / 256, 2, BATCH, 4, (long)SEQ * 1024, 256, 256, 512L * MT};
            EpiBf16 E{(bf16_t*)(ws + P_OX), DM, (long)SEQ * DM, 512, 1.0f};
            if (PROBE == 1) { EpiNull En; g8::gemm(C.lds, g, En, C.G, C.blk); } if (GSITE < 0 || GSITE == 13) g8::gemm(C.lds, g, E, C.G, C.blk);
        }
        SEAM(pb + 10);
        if (IN(pb + 11)) {
            g8::Desc g{(const bf16_t*)(ws + P_OX), (const bf16_t*)(lw + LW_XO), DM, DM, DM, T / 256, DM / 256, 1, 1, 0, 0, 0, 0};
            EpiResid E{P.out, P.out, DM};
            if (PROBE == 1) { EpiNull En; g8::gemm(C.lds, g, En, C.G, C.blk); } if (GSITE < 0 || GSITE == 14) g8::gemm(C.lds, g, E, C.G, C.blk);
        }
        SEAM(pb + 11);
        if (IN(pb + 12)) { if (PROBE == 5) rms_rows_2048(C, P.out, P.in[I_FFN_NORM] + l * DM, hbuf, T); rms_rows_2048(C, P.out, P.in[I_FFN_NORM] + l * DM, hbuf, T); }
        SEAM(pb + 12);
        if (IN(pb + 13)) {
            g8::Desc g{hbuf, (const bf16_t*)(lw + LW_PEER), DM, DM, DM, T / 256, DM / 256, 1, 1, 0, 0, 0, 0};
            EpiF32 E{(float*)(ws + P_SC), DM, 0, 0, 1.0f};
            if (PROBE == 1) { EpiNull En; g8::gemm(C.lds, g, En, C.G, C.blk); } if (GSITE < 0 || GSITE == 15) g8::gemm(C.lds, g, E, C.G, C.blk);
        }
        SEAM(pb + 13);
        if (IN(pb + 14)) { if (EN_PEER && EN_TOPK) phase_peer<true>(C, P); }
        SEAM(pb + 14);
#if PEER_SLICED
        if (IN(pb + 15)) { if (EN_PEER && EN_PU) phase_peer_sliced<0>(C, P, 8 + 32 * l); }
        SEAM(pb + 15);
        if (IN(pb + 16)) { if (EN_PEER) phase_peer_combine(C, P); }
        SEAM(pb + 16);
        if (IN(pb + 17)) { if (EN_PEER && EN_PV) phase_peer_sliced<1>(C, P, 8 + 32 * l + 16); }
        SEAM(pb + 17);
#endif
    }
    if (IN(38)) rms_rows_final(C, P.out, P.in[I_FINAL_NORM], T);
#undef IN
#undef SEAM
}

extern "C" void kernel_launch(void* const* d_in, const int* in_sizes, int n_in, void* d_out, int out_size, void* d_ws, size_t ws_size, hipStream_t stream) {
    static int grid = 0;
    if (grid == 0) {
        if (n_in != 39 || in_sizes[0] != T * DM || out_size != T * DM || ws_size < WS_END) {
            fprintf(stderr, "kernel_launch: unexpected shapes (n_in %d in0 %d out %d ws %zu, need ws >= %zu); nothing launched\n", n_in, n_in > 0 ? in_sizes[0] : -1, out_size, ws_size, (size_t)WS_END);
            grid = -1; return; }
        int dev = 0, cus = 0;
        if (hipGetDevice(&dev) != hipSuccess || hipDeviceGetAttribute(&cus, hipDeviceAttributeMultiprocessorCount, dev) != hipSuccess) { grid = -1; return; }
        if (hipFuncSetAttribute((const void*)mk_fwd, hipFuncAttributeMaxDynamicSharedMemorySize, LDS_BYTES) != hipSuccess) { fprintf(stderr, "kernel_launch: hipFuncSetAttribute failed\n"); grid = -1; return; }
        int per_cu = 0;
        if (hipOccupancyMaxActiveBlocksPerMultiprocessor(&per_cu, (const void*)mk_fwd, NTHREADS, LDS_BYTES) != hipSuccess || per_cu < 1)
            fprintf(stderr, "kernel_launch: occupancy query reports %d blocks per CU\n", per_cu);
        (void)hipGetLastError();
        grid = cus;
    }
    if (grid < 0) return;
    (void)hipMemsetAsync((char*)d_ws + WS_CTL, 0, CTL_BYTES, stream);
    Params p{};
    for (int i = 0; i < 39; ++i) p.in[i] = (const float*)d_in[i];
    p.out = (float*)d_out; p.ws = (unsigned char*)d_ws;
#if MK_ONE_LAUNCH
    p.ph_lo = 0; p.ph_hi = N_PHASES;
    hipLaunchKernelGGL(mk_fwd, dim3(grid), dim3(NTHREADS), LDS_BYTES, stream, p);
#else
    for (int ph = 0; ph < N_PHASES; ++ph) { p.ph_lo = ph; p.ph_hi = ph + 1; hipLaunchKernelGGL(mk_fwd, dim3(grid), dim3(NTHREADS), LDS_BYTES, stream, p); }
#endif
    const hipError_t le = hipPeekAtLastError();
    if (le != hipSuccess) fprintf(stderr, "kernel_launch: launch failed: %s\n", hipGetErrorName(le));
}
```

```cpp
#include <hip/hip_runtime.h>
#include <cstdio>
#include <cstdint>

#ifndef MK_ONE_LAUNCH
#define MK_ONE_LAUNCH 1
#endif
#ifndef FAST_GEMM
#define FAST_GEMM 1
#endif
#ifndef FAST_ATTN
#define FAST_ATTN 1
#endif

#ifndef EN_TOPK
#define EN_TOPK 1
#endif
#ifndef EN_PU
#define EN_PU 1
#endif
#ifndef EN_PV
#define EN_PV 1
#endif
#ifndef EN_S5
#define EN_S5 1
#endif
#ifndef EN_DIFF
#define EN_DIFF 1
#endif
#ifndef EN_MLA
#define EN_MLA 1
#endif
#ifndef EN_PEER
#define EN_PEER 1
#endif
#ifndef EN_GEMM
#define EN_GEMM 1
#endif
#ifndef EN_PRO
#define EN_PRO 1
#endif
#ifndef PEER_FP8
#define PEER_FP8 1
#endif
#ifndef PROBE
#define PROBE 0
#endif
#ifndef PEER_SLICED
#define PEER_SLICED 1
#endif
#ifndef PROBE_PEER2
#define PROBE_PEER2 0
#endif
#ifndef GSITE
#define GSITE -1
#endif
#define GAS __attribute__((address_space(1)))
#define LAS __attribute__((address_space(3)))
#define DI __device__ __forceinline__
typedef unsigned short bf16_t;
typedef short bf16x8 __attribute__((ext_vector_type(8)));
typedef short s16x4 __attribute__((ext_vector_type(4)));
typedef float f32x2 __attribute__((ext_vector_type(2)));
typedef float f32x4 __attribute__((ext_vector_type(4)));
typedef float f32x16 __attribute__((ext_vector_type(16)));
typedef unsigned u32x2 __attribute__((ext_vector_type(2)));
typedef unsigned u32x4 __attribute__((ext_vector_type(4)));
typedef __bf16 bf16x2_t __attribute__((ext_vector_type(2)));

constexpr int BATCH = 16, SEQ = 2048, DM = 2048, T = BATCH * SEQ, MEM_LEN = 256, MT = BATCH * MEM_LEN;
constexpr int DIFF_HEADS = 12, DIFF_W = 1536, S5_W = 512, AB_IN = 5120;
constexpr int MLA_HEADS = 16, MLA_QR = 768, MLA_KVR = 256, MLA_IN = 1088, MLA_IN_PAD = 1280;
constexpr int PEER_NE = 16384;
constexpr float NORM_EPS = 1e-6f;
constexpr int ROPE_POS = 3072;
constexpr int NWAVES = 8, NTHREADS = 512;

constexpr size_t MiB = 1u << 20;
constexpr size_t WS_CTL = 0, CTL_BYTES = 1 * MiB;
constexpr size_t WS_ROPE = 1 * MiB;
constexpr size_t WS_ABIN_T = 2 * MiB, WS_ABOUT_T = 22 * MiB, WS_GLU_T = 30 * MiB, WS_MLAIN_T = 31 * MiB, WS_UQ_T = 36 * MiB, WS_UKV_T = 41 * MiB, WS_MLAO_T = 43 * MiB;
constexpr size_t WS_LW = 51 * MiB, LW_STRIDE = 40 * MiB;
constexpr size_t LW_XQ = 0, LW_XKV = 8 * MiB, LW_XO = 24 * MiB, LW_PEER = 32 * MiB;
constexpr size_t WS_KVX = 131 * MiB, KVX_STRIDE = 32 * MiB;
constexpr size_t WS_POOL = 195 * MiB;
constexpr size_t P_H = WS_POOL;
constexpr size_t P_PROJ = WS_POOL + 128 * MiB;
constexpr size_t P_CONCAT = WS_POOL + 448 * MiB;
constexpr size_t P_GBUF = WS_POOL + 576 * MiB;
constexpr size_t P_MLAPROJ = WS_POOL + 0 * MiB;
constexpr size_t P_CQN = WS_POOL + 80 * MiB;
constexpr size_t P_CKVN = WS_POOL + 128 * MiB;
constexpr size_t P_KROPE = WS_POOL + 144 * MiB;
constexpr size_t P_Q = WS_POOL + 152 * MiB;
constexpr size_t P_KV = WS_POOL + 344 * MiB;
constexpr size_t P_QX = WS_POOL + 128 * MiB;
constexpr size_t P_S = WS_POOL + 256 * MiB;
constexpr size_t P_P = WS_POOL + 384 * MiB;
constexpr size_t P_OX = WS_POOL + 448 * MiB;
constexpr size_t P_SC = WS_POOL + 128 * MiB;
constexpr size_t P_UT = WS_POOL + 608 * MiB;
constexpr size_t P_VT = WS_POOL + 642 * MiB;
constexpr size_t P_PE_E = WS_POOL + 384 * MiB;
constexpr size_t P_PE_G = WS_POOL + 400 * MiB;
constexpr size_t P_PE_T8 = WS_POOL + 432 * MiB;
constexpr size_t P_PE_TSC = WS_POOL + 496 * MiB;
constexpr size_t P_MEMN = WS_POOL + 128 * MiB;
constexpr size_t P_WQB = WS_POOL + 160 * MiB;
constexpr size_t P_SK = WS_POOL + 176 * MiB;
constexpr size_t P_SS = WS_POOL + 680 * MiB;
constexpr size_t P_XB = WS_POOL + 704 * MiB;
constexpr size_t WS_END = WS_POOL + 832 * MiB;
constexpr int CW_BAR = 4096, CW_CTR = 16384;

constexpr int RING_BYTES = 131072, LDSCTL_OFF = RING_BYTES, LDS_BYTES = 147456;

DI unsigned pk2(float lo, float hi) { f32x2 v = {lo, hi}; bf16x2_t b = __builtin_convertvector(v, bf16x2_t); return __builtin_bit_cast(unsigned, b); }
DI float bflo(unsigned u) { return __uint_as_float(u << 16); }
DI float bfhi(unsigned u) { return __uint_as_float(u & 0xffff0000u); }
DI float bf2f(bf16_t b) { return __uint_as_float(((unsigned)b) << 16); }
DI bf16_t f2bf(float f) { return (bf16_t)(pk2(f, 0.f) & 0xffffu); }
DI float dot2bf(unsigned a, unsigned b, float c) { return __builtin_amdgcn_fdot2_f32_bf16(__builtin_bit_cast(bf16x2_t, a), __builtin_bit_cast(bf16x2_t, b), c, false); }
DI int opaque_tid() { int t; asm volatile("v_mov_b32 %0, %1" : "=v"(t) : "v"(threadIdx.x)); return t; }
DI float wave_sum(float v) {
#pragma unroll
    for (int o = 1; o < 64; o <<= 1) v += __shfl_xor(v, o);
    return v;
}
DI float gelu_erf(float v) { return 0.5f * v * (1.0f + erff(v * 0.70710678118654752f)); }
DI float swap32_max(float x) { auto rr = __builtin_amdgcn_permlane32_swap(__float_as_uint(x), __float_as_uint(x), false, false); return fmaxf(__uint_as_float(rr[0]), __uint_as_float(rr[1])); }
DI float swap32_sum(float x) { auto rr = __builtin_amdgcn_permlane32_swap(__float_as_uint(x), __float_as_uint(x), false, false); return __uint_as_float(rr[0]) + __uint_as_float(rr[1]); }
#define LDS_WAIT() asm volatile("s_waitcnt lgkmcnt(0)" ::: "memory")
#define VM_WAIT() asm volatile("s_waitcnt vmcnt(0)" ::: "memory")

#define XB_TMO      128
#define XB_XCNT(j)  (256  + 64 * (j))
#define XB_XSUB(j)  (1280 + 64 * (j))
#define XB_XGEN(j)  (2304 + 64 * (j))
#define XB_TOP      3328
#define XB_TOPGEN   3392
#define XCD_BAR_WORDS 3456
#define XB_SPIN_CAP (1u << 20)
DI unsigned xb_ld(unsigned* p)              { return __hip_atomic_load(p, __ATOMIC_RELAXED, __HIP_MEMORY_SCOPE_AGENT); }
DI unsigned xb_add(unsigned* p, unsigned v) { return __hip_atomic_fetch_add(p, v, __ATOMIC_RELAXED, __HIP_MEMORY_SCOPE_AGENT); }
DI unsigned xb_xcc_id() { return (unsigned)__builtin_amdgcn_s_getreg((3 << 11) | 20) & 0xFu; }
#define XB_SPIN(cond, bar) do { unsigned _sp = 0; while (cond) { __builtin_amdgcn_s_sleep(1); \
    if ((++_sp & 255u) == 0u) { if (xb_ld(&(bar)[XB_TMO])) break; if (_sp > XB_SPIN_CAP) { atomicAdd(&(bar)[XB_TMO], 1u); break; } } } } while (0)
struct XcdBarrier { unsigned* bar; unsigned x; volatile LAS unsigned* st; };
DI XcdBarrier xcd_barrier_post(unsigned* bar, volatile LAS unsigned* st) {
    XcdBarrier b; b.bar = bar; b.x = xb_xcc_id(); b.st = st;
    if (threadIdx.x == 0) (void)xb_add(&bar[XB_XCNT(b.x)], 1u);
    return b;
}
DI void xcd_barrier_complete(unsigned* bar, unsigned x, unsigned& nloc, unsigned& nx) {
    const unsigned G = gridDim.x * gridDim.y * gridDim.z;
    unsigned sum, cnt, mine, sp = 0u;
    for (;;) {
        sum = 0u; cnt = 0u; mine = 0u;
#pragma unroll
        for (unsigned j = 0; j < 16; ++j) { const unsigned c = xb_ld(&bar[XB_XCNT(j)]); sum += c; cnt += (c > 0u) ? 1u : 0u; mine = (j == x) ? c : mine; }
        if (sum == G) break;
        __builtin_amdgcn_s_sleep(1);
        if ((++sp & 255u) == 0u) { if (xb_ld(&bar[XB_TMO])) break; if (sp > XB_SPIN_CAP) { atomicAdd(&bar[XB_TMO], 1u); break; } }
    }
    nloc = mine > 0u ? mine : 1u; nx = cnt > 0u ? cnt : 1u;
}
DI void xcd_barrier(const XcdBarrier& b) {
    asm volatile("s_waitcnt vmcnt(0)" ::: "memory");
    __syncthreads();
    if (threadIdx.x == 0) {
        unsigned* bar = b.bar;
        __builtin_amdgcn_s_waitcnt(0);
        unsigned nloc = b.st[0], nx = b.st[1];
        if (nloc == 0u) { xcd_barrier_complete(bar, b.x, nloc, nx); b.st[0] = nloc; b.st[1] = nx; }
        const unsigned old = xb_add(&bar[XB_XSUB(b.x)], 1u);
        const unsigned gen = old / nloc;
        if (old + 1u == (gen + 1u) * nloc) {
            __builtin_amdgcn_fence(__ATOMIC_RELEASE, "agent");
            asm volatile("s_waitcnt vmcnt(0)" ::: "memory");
            const unsigned og = xb_add(&bar[XB_TOP], 1u);
            const unsigned tg = og / nx;
            if (og + 1u == (tg + 1u) * nx) xb_add(&bar[XB_TOPGEN], 1u);
            else XB_SPIN(xb_ld(&bar[XB_TOPGEN]) == tg, bar);
            __builtin_amdgcn_fence(__ATOMIC_ACQUIRE, "agent");
            xb_add(&bar[XB_XGEN(b.x)], 1u);
            asm volatile("s_waitcnt vmcnt(0)" ::: "memory");
        } else {
            XB_SPIN(xb_ld(&bar[XB_XGEN(b.x)]) == gen, bar);
            __builtin_amdgcn_fence(__ATOMIC_ACQUIRE, "agent");
            asm volatile("s_waitcnt vmcnt(0)" ::: "memory");
        }
    }
    __syncthreads();
}

namespace g8 {
constexpr int BM = 256, BK = 64, HALF = 128, HTB = HALF * BK * 2, STAGE_BYTES = 8 * HTB, NXCD = 8, WGM = 8;
DI int lds_byte(int r, int c) { const int st = (r >> 4) * 2 + (c >> 5), rr = r & 15, cc = c & 31, ob = rr * 64 + cc * 2; return st * 1024 + (ob ^ (((ob >> 9) & 1) << 5)); }
DI void stage_rc(int b, int& R, int& C) { const int st = b / 1024, sb = b % 1024, swz = sb ^ (((sb >> 9) & 1) << 5); R = (st >> 1) * 16 + swz / 64; C = (st & 1) * 32 + (swz % 64) / 2; }
DI int perm32(int rho) { const int n = rho >> 4, i = rho & 15; return 8 * (i >> 2) + 4 * n + (i & 3); }

struct Unit { int zo, zi, pm, pn; };
struct Desc { const bf16_t* A; const bf16_t* Bt; int lda, ldb, K, nM, nN, nZo, nZi; long sAo, sAi, sBo, sBi; };
DI bool next_unit(const Desc& g, int i, int G, int c, Unit& u) {
    const int per = g.nM * g.nN, nwg = per * g.nZo * g.nZi;
    const long L = (long)i * G + c; if (L >= nwg) return false;
    int wgid = (int)L; { const int q = nwg / NXCD, r = nwg % NXCD, xcd = wgid % NXCD, off = wgid / NXCD; wgid = (xcd < r ? xcd * (q + 1) : r * (q + 1) + (xcd - r) * q) + off; }
    const int z = wgid / per, w = wgid % per;
    u.zo = z / g.nZi; u.zi = z % g.nZi;
    const int nig = WGM * g.nN, gid = w / nig, fm = gid * WGM, gsz = (g.nM - fm) < WGM ? (g.nM - fm) : WGM;
    u.pm = fm + ((w % nig) % gsz); u.pn = (w % nig) / gsz; return true;
}

template <class Epi>
DI void gemm_phase(LAS unsigned char* lds, const Desc g, const Epi& E, int G, int c) {
    const int tid = opaque_tid(), wid = __builtin_amdgcn_readfirstlane(tid >> 6), lane = tid & 63, wr = wid >> 2, wc = wid & 3, fr = lane & 15, fq = lane >> 4;
    const int K = g.K, nt = K / BK;
    unsigned voffA[2], voffB[2];
#pragma unroll
    for (int i = 0; i < 2; ++i) { int R, C; stage_rc(tid * 16 + i * 8192, R, C); const int Rb = (R & ~31) + perm32(R & 31);
        voffA[i] = (unsigned)(R * g.lda + C) * 2u; voffB[i] = (unsigned)(Rb * g.ldb + C) * 2u; }
    const size_t kstep = (size_t)(BK * 2);
    const size_t hstepA = (size_t)HALF * g.lda * 2, hstepB = (size_t)HALF * g.ldb * 2;
    const unsigned ldsw = (unsigned)wid * 1024u;
    const int aoff = lds_byte(wr * 64 + fr, fq * 8), boff = lds_byte(wc * 32 + fr, fq * 8);
#define PG8_SA(b, h) (((b) * 2 + (h)) * HTB)
#define PG8_SB(b, h) ((4 + (b) * 2 + (h)) * HTB)
#define PG8_STAGE(bufoff, gbase, voff) do { _Pragma("unroll") for (int _i = 0; _i < 2; ++_i) \
        __builtin_amdgcn_global_load_lds((const unsigned*)((const char*)(gbase) + (voff)[_i]), (LAS unsigned*)(lds + (bufoff) + ldsw + _i * 8192), 16, 0, 0); } while (0)
#define PG8_LDA(dst, b, h) do { _Pragma("unroll") for (int m = 0; m < 4; ++m) _Pragma("unroll") for (int k = 0; k < 2; ++k) dst[m][k] = *(const LAS bf16x8*)(lds + PG8_SA(b, h) + aoff + m * 2048 + k * 1024); } while (0)
#define PG8_LDB(dst, b, h) do { _Pragma("unroll") for (int n = 0; n < 2; ++n) _Pragma("unroll") for (int k = 0; k < 2; ++k) dst[n][k] = *(const LAS bf16x8*)(lds + PG8_SB(b, h) + boff + n * 2048 + k * 1024); } while (0)
#define PG8_MMA(ai, bj, At, Bt) do { __builtin_amdgcn_s_setprio(1); _Pragma("unroll") for (int m = 0; m < 4; ++m) _Pragma("unroll") for (int n = 0; n < 2; ++n) _Pragma("unroll") for (int k = 0; k < 2; ++k) \
        acc[ai][bj][m][n] = __builtin_amdgcn_mfma_f32_16x16x32_bf16(Bt[n][k], At[m][k], acc[ai][bj][m][n], 0, 0, 0); __builtin_amdgcn_s_setprio(0); } while (0)
#define PG8_WAIT_V(n) asm volatile("s_waitcnt vmcnt(" #n ")" ::: "memory")
#define PG8_WAIT_L(n) asm volatile("s_waitcnt lgkmcnt(" #n ")" ::: "memory")
#define PG8_BAR __builtin_amdgcn_s_barrier()
#define PG8_SCHED __builtin_amdgcn_sched_barrier(0)
#define PG8_APTR(u) ((const char*)g.A + ((size_t)(u).zo * g.sAo + (size_t)(u).zi * g.sAi + (size_t)(u).pm * BM * g.lda) * 2)
#define PG8_BPTR(u) ((const char*)g.Bt + ((size_t)(u).zo * g.sBo + (size_t)(u).zi * g.sBi + (size_t)(u).pn * BM * g.ldb) * 2)
    Unit cur, nxt; int ui = 0;
    if (!next_unit(g, 0, G, c, cur)) return;
    f32x4 acc[2][2][4][2];
#pragma unroll
    for (int a = 0; a < 2; ++a)
#pragma unroll
        for (int b = 0; b < 2; ++b)
#pragma unroll
            for (int m = 0; m < 4; ++m)
#pragma unroll
                for (int n = 0; n < 2; ++n) acc[a][b][m][n] = (f32x4){0.f, 0.f, 0.f, 0.f};
    bf16x8 At[4][2], B0[2][2], B1[2][2];
    const char* cA = PG8_APTR(cur); const char* cB = PG8_BPTR(cur);
    PG8_STAGE(PG8_SB(0, 0), cB, voffB); PG8_STAGE(PG8_SA(0, 0), cA, voffA); PG8_STAGE(PG8_SB(0, 1), cB + hstepB, voffB); PG8_STAGE(PG8_SA(0, 1), cA + hstepA, voffA);
    if (wr == 1) PG8_BAR;
    PG8_WAIT_V(4); PG8_BAR;
    PG8_STAGE(PG8_SB(1, 0), cB + kstep, voffB); PG8_STAGE(PG8_SA(1, 0), cA + kstep, voffA); PG8_STAGE(PG8_SB(1, 1), cB + hstepB + kstep, voffB);
    PG8_WAIT_V(6); PG8_BAR;
    for (;;) {
        const bool has_next = next_unit(g, ui + 1, G, c, nxt);
        const char* nA = has_next ? PG8_APTR(nxt) : cA; const char* nB = has_next ? PG8_BPTR(nxt) : cB;
        for (int t = 0; t < nt; t += 2) {
            const bool last = (t == nt - 2);
            const char* a1 = cA + (size_t)(t + 1) * kstep;
            const char* a2 = last ? nA : cA + (size_t)(t + 2) * kstep; const char* b2 = last ? nB : cB + (size_t)(t + 2) * kstep;
            const char* a3 = a2 + kstep; const char* b3 = b2 + kstep;
            PG8_LDB(B0, 0, 0); PG8_SCHED; PG8_LDA(At, 0, 0); PG8_STAGE(PG8_SA(1, 1), a1 + hstepA, voffA);
            PG8_WAIT_L(8); PG8_BAR; PG8_WAIT_L(0); PG8_MMA(0, 0, At, B0); PG8_BAR; PG8_SCHED;
            PG8_LDB(B1, 0, 1); PG8_STAGE(PG8_SB(0, 0), b2, voffB);
            PG8_BAR; PG8_WAIT_L(0); PG8_MMA(0, 1, At, B1); PG8_BAR;
            PG8_LDA(At, 0, 1); PG8_STAGE(PG8_SA(0, 0), a2, voffA);
            PG8_BAR; PG8_WAIT_L(0); PG8_MMA(1, 0, At, B0); PG8_BAR; PG8_SCHED;
            PG8_STAGE(PG8_SB(0, 1), b2 + hstepB, voffB);
            PG8_WAIT_V(6); PG8_BAR; PG8_MMA(1, 1, At, B1); PG8_BAR;
            PG8_LDB(B0, 1, 0); PG8_SCHED; PG8_LDA(At, 1, 0); PG8_STAGE(PG8_SA(0, 1), a2 + hstepA, voffA);
            PG8_WAIT_L(8); PG8_BAR; PG8_WAIT_L(0); PG8_MMA(0, 0, At, B0); PG8_BAR; PG8_SCHED;
            PG8_LDB(B1, 1, 1); PG8_STAGE(PG8_SB(1, 0), b3, voffB);
            PG8_BAR; PG8_WAIT_L(0); PG8_MMA(0, 1, At, B1); PG8_BAR;
            PG8_LDA(At, 1, 1); PG8_STAGE(PG8_SA(1, 0), a3, voffA);
            PG8_BAR; PG8_WAIT_L(0); PG8_MMA(1, 0, At, B0); PG8_BAR; PG8_SCHED;
            PG8_STAGE(PG8_SB(1, 1), b3 + hstepB, voffB);
            PG8_WAIT_V(6); PG8_BAR; PG8_MMA(1, 1, At, B1); PG8_BAR;
        }
        {
            const int row0 = cur.pm * BM + wr * 64 + fr, col0 = cur.pn * BM + wc * 32 + 8 * fq;
#pragma unroll
            for (int ai = 0; ai < 2; ++ai)
#pragma unroll
                for (int m = 0; m < 4; ++m) {
                    const int row = row0 + ai * HALF + m * 16;
                    const float ri = E.row_begin(cur.zo, cur.zi, row);
                    float ra = 0.f;
#pragma unroll
                    for (int bj = 0; bj < 2; ++bj) ra += E.oct(cur.zo, cur.zi, row, col0 + bj * HALF, acc[ai][bj][m][0], acc[ai][bj][m][1], ri);
                    E.row_end(row, cur.pn * 4 + wc, ra);
                }
        }
        if (!has_next) break;
#pragma unroll
        for (int a = 0; a < 2; ++a)
#pragma unroll
            for (int b = 0; b < 2; ++b)
#pragma unroll
                for (int m = 0; m < 4; ++m)
#pragma unroll
                    for (int n = 0; n < 2; ++n) acc[a][b][m][n] = (f32x4){0.f, 0.f, 0.f, 0.f};
        cur = nxt; cA = nA; cB = nB; ++ui;
    }
    PG8_WAIT_V(0);
    if (wr == 0) PG8_BAR;
    PG8_BAR;
#undef PG8_SA
#undef PG8_SB
#undef PG8_STAGE
#undef PG8_LDA
#undef PG8_LDB
#undef PG8_MMA
#undef PG8_WAIT_V
#undef PG8_WAIT_L
#undef PG8_BAR
#undef PG8_SCHED
#undef PG8_APTR
#undef PG8_BPTR
}

template <class Epi>
DI void naive_gemm(const Desc g, const Epi& E, int G, int c) {
    const int M = g.nM * BM, N = g.nN * BM, n8 = N / 8, nZ = g.nZo * g.nZi;
    const long total = (long)nZ * M * n8;
    for (long idx = (long)c * NTHREADS + threadIdx.x; idx < total; idx += (long)G * NTHREADS) {
        const int col = (int)(idx % n8) * 8; const int row = (int)((idx / n8) % M); const int z = (int)(idx / ((long)n8 * M));
        const int zo = z / g.nZi, zi = z % g.nZi;
        const bf16_t* a = g.A + (size_t)zo * g.sAo + (size_t)zi * g.sAi + (size_t)row * g.lda;
        const bf16_t* b = g.Bt + (size_t)zo * g.sBo + (size_t)zi * g.sBi + (size_t)col * g.ldb;
        float acc[8];
#pragma unroll
        for (int j = 0; j < 8; ++j) acc[j] = 0.f;
        for (int k = 0; k < g.K; k += 8) {
            const u32x4 av = *(const u32x4*)(a + k);
#pragma unroll
            for (int j = 0; j < 8; ++j) { const u32x4 bv = *(const u32x4*)(b + (size_t)j * g.ldb + k);
                float s = acc[j]; s = dot2bf(av.x, bv.x, s); s = dot2bf(av.y, bv.y, s); s = dot2bf(av.z, bv.z, s); s = dot2bf(av.w, bv.w, s); acc[j] = s; }
        }
        (void)E.oct(zo, zi, row, col, (f32x4){acc[0], acc[1], acc[2], acc[3]}, (f32x4){acc[4], acc[5], acc[6], acc[7]}, E.row_begin(zo, zi, row));
    }
}
template <class Epi>
DI void gemm(LAS unsigned char* lds, const Desc g, const Epi& E, int G, int c) {
#if !EN_GEMM
    return;
#elif FAST_GEMM
    gemm_phase(lds, g, E, G, c);
#else
    naive_gemm(g, E, G, c);
#endif
}
}

template <int NP> DI float row_rstd(const float* ss, int row) {
    const f32x4* p = (const f32x4*)(ss + (size_t)row * 32); float t = 0.f;
#pragma unroll
    for (int i = 0; i < NP / 4; ++i) { const f32x4 v = p[i]; t += (v[0] + v[1]) + (v[2] + v[3]); }
    return rsqrtf(t * (1.0f / DM) + NORM_EPS);
}
#define EPI_NO_ROW_BEGIN DI float row_begin(int, int, int) const { return 0.f; }
#define EPI_NO_ROW_END DI void row_end(int, int, float) const {}
template <int NP  > struct EpiBf16T {
    bf16_t* O; long ldc, sZo, sZi; float scale; const float* ss;
    EPI_NO_ROW_END
    DI float row_begin(int, int, int row) const { return NP ? row_rstd<NP ? NP : 4>(ss, row) * scale : scale; }
    DI float oct(int zo, int zi, int row, int col, f32x4 lo, f32x4 hi, float f) const {
        bf16_t* p = O + (size_t)zo * sZo + (size_t)zi * sZi + (size_t)row * ldc + col;
        u32x4 w; w.x = pk2(lo[0] * f, lo[1] * f); w.y = pk2(lo[2] * f, lo[3] * f); w.z = pk2(hi[0] * f, hi[1] * f); w.w = pk2(hi[2] * f, hi[3] * f);
        *(u32x4*)p = w; return 0.f;
    }
};
typedef EpiBf16T<0> EpiBf16;
template <int NP> struct EpiF32T {
    float* O; long ldc, sZo, sZi; float scale; const float* ss;
    EPI_NO_ROW_END
    DI float row_begin(int, int, int row) const { return NP ? row_rstd<NP ? NP : 4>(ss, row) * scale : scale; }
    DI float oct(int zo, int zi, int row, int col, f32x4 lo, f32x4 hi, float f) const {
        float* p = O + (size_t)zo * sZo + (size_t)zi * sZi + (size_t)row * ldc + col;
        *(f32x4*)p = lo * f; *(f32x4*)(p + 4) = hi * f; return 0.f;
    }
};
typedef EpiF32T<0> EpiF32;
template <bool F32SRC> struct EpiResidB {
    const float* xin; bf16_t* xb; float* ss;
    EPI_NO_ROW_BEGIN
    DI float oct(int, int, int row, int col, f32x4 lo, f32x4 hi, float) const {
        const size_t o = (size_t)row * DM + col;
        float r[8];
        if (F32SRC) { const f32x4 r0 = *(const f32x4*)(xin + o), r1 = *(const f32x4*)(xin + o + 4); r[0] = r0[0]; r[1] = r0[1]; r[2] = r0[2]; r[3] = r0[3]; r[4] = r1[0]; r[5] = r1[1]; r[6] = r1[2]; r[7] = r1[3]; }
        else { const u32x4 w = *(const u32x4*)(xb + o); r[0] = bflo(w.x); r[1] = bfhi(w.x); r[2] = bflo(w.y); r[3] = bfhi(w.y); r[4] = bflo(w.z); r[5] = bfhi(w.z); r[6] = bflo(w.w); r[7] = bfhi(w.w); }
        u32x4 w; w.x = pk2(r[0] + lo[0], r[1] + lo[1]); w.y = pk2(r[2] + lo[2], r[3] + lo[3]); w.z = pk2(r[4] + hi[0], r[5] + hi[1]); w.w = pk2(r[6] + hi[2], r[7] + hi[3]);
        *(u32x4*)(xb + o) = w;
        const float q0 = bflo(w.x), q1 = bfhi(w.x), q2 = bflo(w.y), q3 = bfhi(w.y), q4 = bflo(w.z), q5 = bfhi(w.z), q6 = bflo(w.w), q7 = bfhi(w.w);
        return ((q0 * q0 + q1 * q1) + (q2 * q2 + q3 * q3)) + ((q4 * q4 + q5 * q5) + (q6 * q6 + q7 * q7));
    }
    DI void row_end(int row, int slot, float ra) const {
        ra += __shfl_xor(ra, 16); ra += __shfl_xor(ra, 32);
        if ((threadIdx.x & 63) < 16) ss[(size_t)row * 32 + slot] = ra;
    }
};
template <int MODE> struct EpiRope {
    bf16_t* O; long ldc; const int* pos; const f32x2* tab;
    EPI_NO_ROW_BEGIN EPI_NO_ROW_END
    DI float oct(int, int, int row, int col, f32x4 lo, f32x4 hi, float) const {
        bool rope; int j0;
        if (MODE == 0) { rope = col < 2 * DIFF_W; j0 = col & 63; } else { const int c = col % 192; rope = c >= 128; j0 = c - 128; }
        if (rope) {
            int p = pos[row]; p = p < 0 ? 0 : (p > ROPE_POS - 1 ? ROPE_POS - 1 : p);
            const f32x4* tp = (const f32x4*)(tab + (size_t)p * 32 + (j0 >> 1));
            const f32x4 t0 = tp[0], t1 = tp[1];
            f32x4 a = lo, b = hi;
            lo[0] = a[0] * t0[0] - a[1] * t0[1]; lo[1] = a[1] * t0[0] + a[0] * t0[1];
            lo[2] = a[2] * t0[2] - a[3] * t0[3]; lo[3] = a[3] * t0[2] + a[2] * t0[3];
            hi[0] = b[0] * t1[0] - b[1] * t1[1]; hi[1] = b[1] * t1[0] + b[0] * t1[1];
            hi[2] = b[2] * t1[2] - b[3] * t1[3]; hi[3] = b[3] * t1[2] + b[2] * t1[3];
        }
        u32x4 w; w.x = pk2(lo[0], lo[1]); w.y = pk2(lo[2], lo[3]); w.z = pk2(hi[0], hi[1]); w.w = pk2(hi[2], hi[3]);
        *(u32x4*)(O + (size_t)row * ldc + col) = w; return 0.f;
    }
};
struct EpiGlu {
    const bf16_t* gbuf; const float* bias; bf16_t* out;
    EPI_NO_ROW_BEGIN EPI_NO_ROW_END
    DI float oct(int, int, int row, int col, f32x4 lo, f32x4 hi, float) const {
        const u32x4 gv = *(const u32x4*)(gbuf + (size_t)row * S5_W + col);
        const f32x4 b0 = *(const f32x4*)(bias + col), b1 = *(const f32x4*)(bias + col + 4);
        float g[8] = {bflo(gv.x), bfhi(gv.x), bflo(gv.y), bfhi(gv.y), bflo(gv.z), bfhi(gv.z), bflo(gv.w), bfhi(gv.w)};
        float a[8] = {lo[0] + b0[0], lo[1] + b0[1], lo[2] + b0[2], lo[3] + b0[3], hi[0] + b1[0], hi[1] + b1[1], hi[2] + b1[2], hi[3] + b1[3]};
        float r[8];
#pragma unroll
        for (int j = 0; j < 8; ++j) r[j] = g[j] / (1.0f + __expf(-a[j]));
        u32x4 w; w.x = pk2(r[0], r[1]); w.y = pk2(r[2], r[3]); w.z = pk2(r[4], r[5]); w.w = pk2(r[6], r[7]);
        *(u32x4*)(out + (size_t)row * DM + DIFF_W + col) = w; return 0.f;
    }
};
struct EpiNull { EPI_NO_ROW_BEGIN EPI_NO_ROW_END DI float oct(int, int, int, int, f32x4 lo, f32x4 hi, float) const { asm volatile("" :: "v"(lo), "v"(hi)); return 0.f; } };
struct Params {
    const float* in[39];
    float* out; unsigned char* ws;
    int ph_lo, ph_hi;
};
enum { I_X = 0, I_MEM, I_POS, I_AB_NORM, I_AB_WIN, I_AB_WOUT, I_LQ1, I_LK1, I_LQ2, I_LK2, I_SUBLN, I_S5_ARE, I_S5_AIM, I_S5_LOGSTEP, I_S5_BRE, I_S5_BIM, I_S5_CRE, I_S5_CIM, I_S5_D,
       I_S5_WGLU, I_S5_BGLU, I_MLA_NORM, I_MLA_WIN, I_MLA_QNORM, I_MLA_KVNORM, I_MLA_WUQ, I_MLA_WUKV, I_MLA_WO, I_XA_NORM, I_XA_MEMNORM, I_XA_WQ, I_XA_WKV, I_XA_WO, I_FFN_NORM,
       I_PEER_WQ, I_PEER_SK, I_PEER_U, I_PEER_V, I_FINAL_NORM };

struct Ctx { LAS unsigned char* lds; int tid, lane, wave, blk, G; };
DI Ctx fresh(const Ctx& C0) { Ctx C = C0; C.tid = opaque_tid(); C.lane = C.tid & 63; return C; }

DI void rms_rows_2048(const Ctx& C0, const float* src, const float* gain, bf16_t* dst, int nrows) {
    const Ctx C = fresh(C0);
    for (int r = C.blk * NWAVES + C.wave; r < nrows; r += C.G * NWAVES) {
        const f32x4* xr = (const f32x4*)(src + (size_t)r * DM) + C.lane;
        f32x4 v[8]; float ss = 0.f;
#pragma unroll
        for (int j = 0; j < 8; ++j) { v[j] = xr[64 * j]; ss += (v[j][0] * v[j][0] + v[j][1] * v[j][1]) + (v[j][2] * v[j][2] + v[j][3] * v[j][3]); }
        const float sc = rsqrtf(wave_sum(ss) * (1.0f / DM) + NORM_EPS);
        u32x2* o = (u32x2*)(dst + (size_t)r * DM) + C.lane;
#pragma unroll
        for (int j = 0; j < 8; ++j) { const f32x4 g = *((const f32x4*)gain + C.lane + 64 * j);
            u32x2 w; w.x = pk2(v[j][0] * sc * g[0], v[j][1] * sc * g[1]); w.y = pk2(v[j][2] * sc * g[2], v[j][3] * sc * g[3]); o[64 * j] = w; }
    }
}
DI void rms_rows_final(const Ctx& C0, const bf16_t* xbp, float* out, const float* gain, int nrows) {
    const Ctx C = fresh(C0);
    for (int r = C.blk * NWAVES + C.wave; r < nrows; r += C.G * NWAVES) {
        const u32x2* xr = (const u32x2*)(xbp + (size_t)r * DM) + C.lane;
        f32x4 v[8]; float ss = 0.f;
#pragma unroll
        for (int j = 0; j < 8; ++j) { const u32x2 w = xr[64 * j]; v[j] = (f32x4){bflo(w.x), bfhi(w.x), bflo(w.y), bfhi(w.y)}; ss += (v[j][0] * v[j][0] + v[j][1] * v[j][1]) + (v[j][2] * v[j][2] + v[j][3] * v[j][3]); }
        const float sc = rsqrtf(wave_sum(ss) * (1.0f / DM) + NORM_EPS);
        f32x4* o = (f32x4*)(out + (size_t)r * DM) + C.lane;
#pragma unroll
        for (int j = 0; j < 8; ++j) { const f32x4 g = *((const f32x4*)gain + C.lane + 64 * j); o[64 * j] = v[j] * sc * g; }
    }
}

DI int srccol(int kind, int n) {
    if (kind == 1) { if (n < 2 * DIFF_W) { const int j = n & 63; return (n & ~63) + (j >> 1) + 32 * (j & 1); } return n; }
    if (kind == 2) { if (n >= MLA_IN) return -1; if (n >= 1024) { const int j = n - 1024; return 1024 + (j >> 1) + 32 * (j & 1); } return n; }
    if (kind == 3) { const int c = n % 192; if (c >= 128) { const int j = c - 128; return n - c + 128 + (j >> 1) + 32 * (j & 1); } return n; }
    return n;
}
DI void transpose_item(const float* W, int K, int Nsrc, bf16_t* Wt, int nblk, int kind, const float* kgain, LAS float* scr, int item, int lane) {
    const int kb = item / nblk, nb = item % nblk, k0 = 64 * kb, n0 = 32 * nb;
    const int src = srccol(kind, n0 + (lane & 31));
#pragma unroll 8
    for (int i = 0; i < 32; ++i) { const int kk = 2 * i + (lane >> 5); scr[kk * 33 + (lane & 31)] = (src >= 0) ? W[(size_t)(k0 + kk) * Nsrc + src] * (kgain ? kgain[k0 + kk] : 1.0f) : 0.f; }
    LDS_WAIT(); asm volatile("" ::: "memory");
    const int c = lane & 7;
#pragma unroll
    for (int j = 0; j < 4; ++j) { const int n = (lane >> 3) + 8 * j; const LAS float* s = scr + (8 * c) * 33 + n;
        u32x4 o; o.x = pk2(s[0 * 33], s[1 * 33]); o.y = pk2(s[2 * 33], s[3 * 33]); o.z = pk2(s[4 * 33], s[5 * 33]); o.w = pk2(s[6 * 33], s[7 * 33]);
        *(u32x4*)(Wt + (size_t)(n0 + n) * K + k0 + 8 * c) = o; }
    LDS_WAIT(); asm volatile("" ::: "memory");
}
DI void cvt_bf16(const Ctx& C0, const float* src, bf16_t* dst, size_t n8) {
    const Ctx C = fresh(C0);
    for (size_t i = (size_t)C.blk * NTHREADS + C.tid; i < n8; i += (size_t)C.G * NTHREADS) {
        const f32x4 a = *(const f32x4*)(src + i * 8), b = *(const f32x4*)(src + i * 8 + 4);
        u32x4 w; w.x = pk2(a[0], a[1]); w.y = pk2(a[2], a[3]); w.z = pk2(b[0], b[1]); w.w = pk2(b[2], b[3]);
        *(u32x4*)(dst + i * 8) = w;
    }
}


DI void cvt_fp8_rows(const Ctx& C0, const float* src, unsigned char* dst, float* isc, int nrows) {
    const Ctx C = fresh(C0);
    for (int r = C.blk * NWAVES + C.wave; r < nrows; r += C.G * NWAVES) {
        const f32x4* xr = (const f32x4*)(src + (size_t)r * DM) + C.lane;
        f32x4 v[8]; float am = 0.f;
#pragma unroll
        for (int j = 0; j < 8; ++j) { v[j] = xr[64 * j]; am = fmaxf(am, fmaxf(fmaxf(fabsf(v[j][0]), fabsf(v[j][1])), fmaxf(fabsf(v[j][2]), fabsf(v[j][3])))); }
#pragma unroll
        for (int o = 1; o < 64; o <<= 1) am = fmaxf(am, __shfl_xor(am, o));
        const float e = am > 0.f ? floorf(log2f(448.0f / am)) : 0.f;
        const float scale = exp2f(e);
        if (C.lane == 0) isc[r] = exp2f(-e);
#if PEER_SLICED
        unsigned* o = (unsigned*)(dst + (size_t)(C.lane >> 5) * ((size_t)PEER_NE * 128) + (size_t)r * 128) + (C.lane & 31);
#pragma unroll
        for (int j = 0; j < 8; ++j) { int w = 0; w = __builtin_amdgcn_cvt_pk_fp8_f32(v[j][0] * scale, v[j][1] * scale, w, false); w = __builtin_amdgcn_cvt_pk_fp8_f32(v[j][2] * scale, v[j][3] * scale, w, true); o[(size_t)2 * j * (PEER_NE * 128 / 4)] = (unsigned)w; }
#else
        unsigned* o = (unsigned*)(dst + (size_t)r * DM) + C.lane;
#pragma unroll
        for (int j = 0; j < 8; ++j) { int w = 0; w = __builtin_amdgcn_cvt_pk_fp8_f32(v[j][0] * scale, v[j][1] * scale, w, false); w = __builtin_amdgcn_cvt_pk_fp8_f32(v[j][2] * scale, v[j][3] * scale, w, true); o[64 * j] = (unsigned)w; }
#endif
    }
}


DI void cvt_i8_rows(const Ctx& C0, const float* src, const float* cgain, unsigned char* dst, float* isc, int nrows) {
    const Ctx C = fresh(C0);
    for (int r = C.blk * NWAVES + C.wave; r < nrows; r += C.G * NWAVES) {
        const f32x4* xr = (const f32x4*)(src + (size_t)r * DM) + C.lane;
        f32x4 v[8]; float am = 0.f;
#pragma unroll
        for (int j = 0; j < 8; ++j) { v[j] = xr[64 * j] * *((const f32x4*)cgain + C.lane + 64 * j); am = fmaxf(am, fmaxf(fmaxf(fabsf(v[j][0]), fabsf(v[j][1])), fmaxf(fabsf(v[j][2]), fabsf(v[j][3])))); }
#pragma unroll
        for (int o = 1; o < 64; o <<= 1) am = fmaxf(am, __shfl_xor(am, o));
        const float scale = am > 0.f ? 127.0f / am : 0.f;
        if (C.lane == 0) isc[r] = am * (1.0f / 127.0f);
        unsigned* o = (unsigned*)(dst + (size_t)(C.lane >> 5) * ((size_t)PEER_NE * 128) + (size_t)r * 128) + (C.lane & 31);
#pragma unroll
        for (int j = 0; j < 8; ++j) { const int q0 = (int)rintf(v[j][0] * scale), q1 = (int)rintf(v[j][1] * scale), q2 = (int)rintf(v[j][2] * scale), q3 = (int)rintf(v[j][3] * scale);
            o[(size_t)2 * j * (PEER_NE * 128 / 4)] = (unsigned)(q0 & 255) | ((unsigned)(q1 & 255) << 8) | ((unsigned)(q2 & 255) << 16) | ((unsigned)(q3 & 255) << 24); }
    }
}

DI void convert_tables(const Ctx& C, const Params& P, int l) {
    unsigned char* ws = P.ws;
#if PEER_FP8
#if PEER_SLICED
    cvt_i8_rows(C, P.in[I_PEER_U] + (size_t)l * PEER_NE * DM, P.in[I_FFN_NORM] + l * DM, ws + P_UT, (float*)(ws + P_UT + 32 * MiB), PEER_NE);
#else
    cvt_fp8_rows(C, P.in[I_PEER_U] + (size_t)l * PEER_NE * DM, ws + P_UT, (float*)(ws + P_UT + 32 * MiB), PEER_NE);
#endif
    cvt_fp8_rows(C, P.in[I_PEER_V] + (size_t)l * PEER_NE * DM, ws + P_VT, (float*)(ws + P_VT + 32 * MiB), PEER_NE);
#else
    cvt_bf16(C, P.in[I_PEER_U] + (size_t)l * PEER_NE * DM, (bf16_t*)(ws + P_UT), (size_t)PEER_NE * DM / 8);
    cvt_bf16(C, P.in[I_PEER_V] + (size_t)l * PEER_NE * DM, (bf16_t*)(ws + P_VT), (size_t)PEER_NE * DM / 8);
#endif
}

DI void phase_prologue(const Ctx& C0, const Params& P) {
    const Ctx C = fresh(C0);
    unsigned char* ws = P.ws;
    LAS float* scr = (LAS float*)(C.lds + C.wave * 8448);
    const int gw = C.blk * NWAVES + C.wave, NGW = C.G * NWAVES;
    int base = 0;
#define TJOB(Wp, K_, Nsrc_, Nout_, kind_, dst_, kg_) do { const int nblk_ = (Nout_) / 32, nit_ = ((K_) / 64) * nblk_; \
        int first_ = (gw - base % NGW + NGW) % NGW; \
        for (int it = first_; it < nit_; it += NGW) transpose_item((Wp), (K_), (Nsrc_), (bf16_t*)(dst_), nblk_, (kind_), (kg_), scr, it, C.lane); base += nit_; } while (0)
    TJOB(P.in[I_AB_WIN], DM, AB_IN, AB_IN, 1, ws + WS_ABIN_T, nullptr);
    TJOB(P.in[I_AB_WOUT], DM, DM, DM, 0, ws + WS_ABOUT_T, nullptr);
    TJOB(P.in[I_S5_WGLU], S5_W, S5_W, S5_W, 0, ws + WS_GLU_T, nullptr);
    TJOB(P.in[I_MLA_WIN], DM, MLA_IN, MLA_IN_PAD, 2, ws + WS_MLAIN_T, P.in[I_MLA_NORM]);
    TJOB(P.in[I_MLA_WUQ], MLA_QR, 3072, 3072, 3, ws + WS_UQ_T, nullptr);
    TJOB(P.in[I_MLA_WUKV], MLA_KVR, 4096, 4096, 0, ws + WS_UKV_T, nullptr);
    TJOB(P.in[I_MLA_WO], DM, DM, DM, 0, ws + WS_MLAO_T, nullptr);
    for (int l = 0; l < 2; ++l) {
        TJOB(P.in[I_XA_WQ] + (size_t)l * DM * DM, DM, DM, DM, 0, ws + WS_LW + l * LW_STRIDE + LW_XQ, P.in[I_XA_NORM] + l * DM);
        TJOB(P.in[I_XA_WKV] + (size_t)l * DM * 2 * DM, DM, 2 * DM, 2 * DM, 0, ws + WS_LW + l * LW_STRIDE + LW_XKV, nullptr);
        TJOB(P.in[I_XA_WO] + (size_t)l * DM * DM, DM, DM, DM, 0, ws + WS_LW + l * LW_STRIDE + LW_XO, nullptr);
    }
#undef TJOB
    {
        f32x2* tab = (f32x2*)(ws + WS_ROPE);
        for (int i = C.blk * NTHREADS + C.tid; i < ROPE_POS * 32; i += C.G * NTHREADS) {
            const int p = i >> 5, f = i & 31;
            const float inv = powf(10000.0f, -(float)f * (2.0f / 64.0f));
            const float ang = (float)p * inv;
            tab[i] = (f32x2){(float)cos((double)ang), (float)sin((double)ang)};
        }
    }
    {
        const float* src = P.in[I_PEER_WQ]; bf16_t* dst = (bf16_t*)(ws + P_WQB);
        for (size_t i = (size_t)C.blk * NTHREADS + C.tid; i < (size_t)2 * DM * DM / 8; i += (size_t)C.G * NTHREADS) {
            const float g = P.in[I_FFN_NORM][i / (DM / 8)];
            const f32x4 a = *(const f32x4*)(src + i * 8), b = *(const f32x4*)(src + i * 8 + 4);
            u32x4 w; w.x = pk2(a[0] * g, a[1] * g); w.y = pk2(a[2] * g, a[3] * g); w.z = pk2(b[0] * g, b[1] * g); w.w = pk2(b[2] * g, b[3] * g);
            *(u32x4*)(dst + i * 8) = w;
        }
    }
    {
        bf16_t* sk = (bf16_t*)(ws + P_SK); const float* skin = P.in[I_PEER_SK];
        for (int i = C.blk * NTHREADS + C.tid; i < 2 * 8 * 256 * 256 / 8; i += C.G * NTHREADS) {
            const int q8 = (i & 31) * 8, np = (i >> 5) & 255, lh = i >> 13;
            const int c = np >> 7, n = np & 127, c2 = q8 >> 7, q = q8 & 127;
            u32x4 w = {0u, 0u, 0u, 0u};
            if (c == c2) { const float* s = skin + ((((size_t)lh * 2 + c) * 128 + n) * 128 + q);
                const f32x4 a = *(const f32x4*)s, b = *(const f32x4*)(s + 4);
                w.x = pk2(a[0], a[1]); w.y = pk2(a[2], a[3]); w.z = pk2(b[0], b[1]); w.w = pk2(b[2], b[3]); }
            *(u32x4*)(sk + (size_t)i * 8) = w;
        }
    }
    convert_tables(C, P, 0);
    for (int l = 0; l < 2; ++l) rms_rows_2048(C, P.in[I_MEM], P.in[I_XA_MEMNORM] + l * DM, (bf16_t*)(ws + P_MEMN) + (size_t)l * MT * DM, MT);
}

DI void phase_s5(const Ctx& C0, const Params& P, int first, int last, int stride_w, int stride) {
    const Ctx C = fresh(C0);
    unsigned char* ws = P.ws;
    const bf16_t* proj = (const bf16_t*)(ws + P_PROJ); bf16_t* gbuf = (bf16_t*)(ws + P_GBUF);
    LAS unsigned char* my = C.lds + C.wave * 8192;
    LAS float* U = (LAS float*)my;
    LAS bf16_t* H = (LAS bf16_t*)(my + 1024);
    const int lane = C.lane, n = lane;
    for (int task = first + C.wave * stride_w; task < last; task += stride) {
        const int b = task >> 5, g = task & 31;
        const float a_re = P.in[I_S5_ARE][g * 64 + n], a_im = P.in[I_S5_AIM][g * 64 + n];
        const float step = expf(P.in[I_S5_LOGSTEP][g]);
        const float mag = expf(a_re * step);
        const float ab_re = mag * cosf(a_im * step), ab_im = mag * sinf(a_im * step);
        const float den = a_re * a_re + a_im * a_im, num_re = ab_re - 1.0f;
        const float f_re = (num_re * a_re + ab_im * a_im) / den, f_im = (ab_im * a_re - num_re * a_im) / den;
        float bbr[16], bbi[16];
        {
            const float* br = P.in[I_S5_BRE] + ((size_t)g * 64 + n) * 16; const float* bi = P.in[I_S5_BIM] + ((size_t)g * 64 + n) * 16;
#pragma unroll
            for (int p = 0; p < 16; ++p) { const float x = br[p], y = bi[p]; bbr[p] = f_re * x - f_im * y; bbi[p] = f_re * y + f_im * x; }
        }
        bf16x8 cf[4];
        {
            const int p = lane & 15, kq = lane >> 4;
#pragma unroll
            for (int kk = 0; kk < 4; ++kk) {
                const int k = 32 * kk + 8 * kq; const bool im = k >= 64;
                const float* src = (im ? P.in[I_S5_CIM] : P.in[I_S5_CRE]) + ((size_t)g * 16 + p) * 64 + (k & 63);
                const float sg = im ? -1.f : 1.f;
                const f32x4 a = *(const f32x4*)src, bq = *(const f32x4*)(src + 4);
                u32x4 w; w.x = pk2(sg * a[0], sg * a[1]); w.y = pk2(sg * a[2], sg * a[3]); w.z = pk2(sg * bq[0], sg * bq[1]); w.w = pk2(sg * bq[2], sg * bq[3]);
                cf[kk] = __builtin_bit_cast(bf16x8, w);
            }
        }
        const float dcoef = P.in[I_S5_D][g * 16 + (lane & 15)];
        float h_re = 0.f, h_im = 0.f;
        const bf16_t* ub = proj + (size_t)b * SEQ * AB_IN + 3 * DIFF_W + g * 16;
        for (int s0 = 0; s0 < SEQ; s0 += 16) {
            {
                const int st = lane >> 2, pp = (lane & 3) * 4;
                const u32x2 uv = *(const u32x2*)(ub + (size_t)(s0 + st) * AB_IN + pp);
                *(LAS f32x4*)(U + st * 16 + pp) = (f32x4){bflo(uv.x), bfhi(uv.x), bflo(uv.y), bfhi(uv.y)};
            }
            LDS_WAIT(); asm volatile("" ::: "memory");
#pragma unroll 4
            for (int st = 0; st < 16; ++st) {
                const f32x4 u0 = *(const LAS f32x4*)(U + st * 16), u1 = *(const LAS f32x4*)(U + st * 16 + 4), u2 = *(const LAS f32x4*)(U + st * 16 + 8), u3 = *(const LAS f32x4*)(U + st * 16 + 12);
                const float uu[16] = {u0[0], u0[1], u0[2], u0[3], u1[0], u1[1], u1[2], u1[3], u2[0], u2[1], u2[2], u2[3], u3[0], u3[1], u3[2], u3[3]};
                float br = 0.f, bi = 0.f;
#pragma unroll
                for (int p = 0; p < 16; ++p) { br = fmaf(bbr[p], uu[p], br); bi = fmaf(bbi[p], uu[p], bi); }
                const float nr = ab_re * h_re - ab_im * h_im + br, ni = ab_re * h_im + ab_im * h_re + bi;
                h_re = nr; h_im = ni;
                H[st * 136 + n] = f2bf(h_re); H[st * 136 + 64 + n] = f2bf(h_im);
            }
            LDS_WAIT(); asm volatile("" ::: "memory");
            f32x4 acc = {0.f, 0.f, 0.f, 0.f};
#pragma unroll
            for (int kk = 0; kk < 4; ++kk) {
                const bf16x8 af = *(const LAS bf16x8*)((LAS unsigned char*)H + (lane & 15) * 272 + (32 * kk + 8 * (lane >> 4)) * 2);
                acc = __builtin_amdgcn_mfma_f32_16x16x32_bf16(af, cf[kk], acc, 0, 0, 0);
            }
#pragma unroll
            for (int r = 0; r < 4; ++r) {
                const int st = (lane >> 4) * 4 + r, p = lane & 15;
                const float y = acc[r] + dcoef * U[st * 16 + p];
                gbuf[(size_t)(b * SEQ + s0 + st) * S5_W + g * 16 + p] = f2bf(gelu_erf(y));
            }
            LDS_WAIT(); asm volatile("" ::: "memory");
        }
    }
}

struct AttnArgs { const bf16_t* Qn; const bf16_t* Qr; const bf16_t* Kn; const bf16_t* Kr; const bf16_t* V; int ldq, ldkn, ldkr, ldv; };
DI int crow(int r, int hi) { return (r & 3) + 8 * (r >> 2) + 4 * hi; }
template <int DK> DI int koff(int row, int ch) { return DK == 64 ? row * 128 + 16 * (ch ^ ((row >> 1) & 7)) : row * 256 + 16 * (ch ^ (row & 15)); }
DI int voff(int row, int ch) { return 256 * row + 16 * (ch ^ (((row & 3) << 2) | ((row >> 2) & 3))); }
DI bf16x8 pack8(const f32x16& p, int s) {
    u32x4 w; w.x = pk2(p[8 * s + 0], p[8 * s + 1]); w.y = pk2(p[8 * s + 2], p[8 * s + 3]); w.z = pk2(p[8 * s + 4], p[8 * s + 5]); w.w = pk2(p[8 * s + 6], p[8 * s + 7]);
    return __builtin_bit_cast(bf16x8, w);
}
DI s16x4 vtr(const LAS unsigned char* p) { return __builtin_bit_cast(s16x4, __builtin_amdgcn_ds_read_tr16_b64_v4i16((LAS s16x4*)p)); }

template <int DKN, int DKR>
DI void attn_core(const AttnArgs& a, int q0, LAS unsigned char* lds, float scale, f32x16 (&o)[4]) {
    const int tid = opaque_tid(), wid = __builtin_amdgcn_readfirstlane(tid >> 6), lane = tid & 63, r32 = lane & 31, hi = lane >> 5;
    constexpr int CN = DKN / 8, NLK = CN * 64 / NTHREADS, KNB = 64 * DKN * 2, KRB = 64 * DKR * 2, VOFF = KNB + KRB, BUF = VOFF + 16384;
    static_assert(2 * BUF <= RING_BYTES, "attention LDS");
    bf16x8 qn[DKN / 16]; bf16x8 qr[DKR ? DKR / 16 : 1];
    {
        const bf16_t* qp = a.Qn + (size_t)(q0 + 32 * wid + r32) * a.ldq + hi * 8;
#pragma unroll
        for (int d0 = 0; d0 < DKN / 16; ++d0) qn[d0] = *(const bf16x8*)(qp + d0 * 16);
        if (DKR) { const bf16_t* qp2 = a.Qr + (size_t)(q0 + 32 * wid + r32) * a.ldq + hi * 8;
#pragma unroll
            for (int d0 = 0; d0 < DKR / 16; ++d0) qr[d0] = *(const bf16x8*)(qp2 + d0 * 16); }
    }
    const int NT = (q0 + 256) / 64, NTw = (q0 + 32 * wid + 31) / 64 + 1;
    u32x4 skn[NLK], skr, sv[2];
#define AT_LOAD(t) do { _Pragma("unroll") for (int i_ = 0; i_ < NLK; ++i_) { const int id_ = tid + NTHREADS * i_, row_ = id_ / CN, ch_ = id_ % CN; \
            skn[i_] = *(const u32x4*)(a.Kn + (size_t)((t) * 64 + row_) * a.ldkn + ch_ * 8); } \
        if (DKR) { const int row_ = tid >> 3, ch_ = tid & 7; skr = *(const u32x4*)(a.Kr + (size_t)((t) * 64 + row_) * a.ldkr + ch_ * 8); } \
        _Pragma("unroll") for (int i_ = 0; i_ < 2; ++i_) { const int id_ = tid + NTHREADS * i_, row_ = id_ >> 4, ch_ = id_ & 15; \
            sv[i_] = *(const u32x4*)(a.V + (size_t)((t) * 64 + row_) * a.ldv + ch_ * 8); } } while (0)
#define AT_WRITE(bf) do { LAS unsigned char* bb_ = lds + (bf) * BUF; \
        _Pragma("unroll") for (int i_ = 0; i_ < NLK; ++i_) { const int id_ = tid + NTHREADS * i_, row_ = id_ / CN, ch_ = id_ % CN; *(LAS u32x4*)(bb_ + koff<DKN>(row_, ch_)) = skn[i_]; } \
        if (DKR) { const int row_ = tid >> 3, ch_ = tid & 7; *(LAS u32x4*)(bb_ + KNB + koff<64>(row_, ch_)) = skr; } \
        _Pragma("unroll") for (int i_ = 0; i_ < 2; ++i_) { const int id_ = tid + NTHREADS * i_, row_ = id_ >> 4, ch_ = id_ & 15; *(LAS u32x4*)(bb_ + VOFF + voff(row_, ch_)) = sv[i_]; } } while (0)
    const float Cs = scale * 1.4426950408889634f;
    float m_run = -1e30f, l_run = 0.f;
#pragma unroll
    for (int blk = 0; blk < 4; ++blk)
#pragma unroll
        for (int r = 0; r < 16; ++r) o[blk][r] = 0.f;
    AT_LOAD(0); AT_WRITE(0); if (NT > 1) AT_LOAD(1);
    for (int t = 0; t < NT; ++t) {
        __syncthreads();
        if (t + 1 < NT) AT_WRITE((t + 1) & 1);
        if (t + 2 < NT) AT_LOAD(t + 2);
        if (t < NTw) {
            const LAS unsigned char* base = lds + (t & 1) * BUF;
            int r32v = r32, lanev = lane; asm volatile("" : "+v"(r32v), "+v"(lanev));
            int vb[4][2];
            {
                const int i = lanev & 15, q_ = i >> 2, p_ = i & 3, grp1 = (lanev >> 4) & 1, hv = lanev >> 5, low2 = 2 * grp1 + (p_ >> 1);
#pragma unroll
                for (int blk = 0; blk < 4; ++blk)
#pragma unroll
                    for (int x = 0; x < 2; ++x) vb[blk][x] = VOFF + 256 * (8 * x + 4 * hv + q_) + 16 * (4 * (blk ^ q_) + (low2 ^ (hv + 2 * x))) + 8 * (p_ & 1);
            }
            f32x16 p0, p1;
#pragma unroll
            for (int r = 0; r < 16; ++r) { p0[r] = 0.f; p1[r] = 0.f; }
#pragma unroll
            for (int d0 = 0; d0 < DKN / 16; ++d0) {
                const bf16x8 b0 = *(const LAS bf16x8*)(base + koff<DKN>(r32v, 2 * d0 + hi)), b1 = *(const LAS bf16x8*)(base + koff<DKN>(32 + r32v, 2 * d0 + hi));
                p0 = __builtin_amdgcn_mfma_f32_32x32x16_bf16(b0, qn[d0], p0, 0, 0, 0); p1 = __builtin_amdgcn_mfma_f32_32x32x16_bf16(b1, qn[d0], p1, 0, 0, 0);
            }
            if (DKR) {
#pragma unroll
                for (int d0 = 0; d0 < DKR / 16; ++d0) {
                    const bf16x8 b0 = *(const LAS bf16x8*)(base + KNB + koff<64>(r32v, 2 * d0 + hi)), b1 = *(const LAS bf16x8*)(base + KNB + koff<64>(32 + r32v, 2 * d0 + hi));
                    p0 = __builtin_amdgcn_mfma_f32_32x32x16_bf16(b0, qr[d0], p0, 0, 0, 0); p1 = __builtin_amdgcn_mfma_f32_32x32x16_bf16(b1, qr[d0], p1, 0, 0, 0);
                }
            }
            if (t == NTw - 1) {
                const int qrel = q0 + 32 * wid + r32 - 64 * t;
#pragma unroll
                for (int r = 0; r < 16; ++r) { const int kv = crow(r, hi); if (kv > qrel) p0[r] = -INFINITY; if (kv + 32 > qrel) p1[r] = -INFINITY; }
            }
            float pmax = p0[0];
#pragma unroll
            for (int r = 1; r < 16; ++r) pmax = fmaxf(pmax, p0[r]);
#pragma unroll
            for (int r = 0; r < 16; ++r) pmax = fmaxf(pmax, p1[r]);
            pmax = swap32_max(pmax);
            const float mn = fmaxf(m_run, pmax);
            const float alpha = __builtin_amdgcn_exp2f((m_run - mn) * Cs);
            m_run = mn;
            const float mnC = -mn * Cs;
            float ps = 0.f;
#pragma unroll
            for (int r = 0; r < 16; ++r) { p0[r] = __builtin_amdgcn_exp2f(fmaf(p0[r], Cs, mnC)); p1[r] = __builtin_amdgcn_exp2f(fmaf(p1[r], Cs, mnC)); ps += p0[r] + p1[r]; }
            l_run = l_run * alpha + ps;
            if (!__all(alpha == 1.0f)) {
#pragma unroll
                for (int blk = 0; blk < 4; ++blk)
#pragma unroll
                    for (int r = 0; r < 16; ++r) o[blk][r] *= alpha;
            }
            bf16x8 pb[4]; pb[0] = pack8(p0, 0); pb[1] = pack8(p0, 1); pb[2] = pack8(p1, 0); pb[3] = pack8(p1, 1);
#pragma unroll
            for (int blk = 0; blk < 4; ++blk) {
                s16x4 lo[4], hh[4];
#pragma unroll
                for (int ks = 0; ks < 4; ++ks) { lo[ks] = vtr(base + vb[blk][0] + 4096 * ks); hh[ks] = vtr(base + vb[blk][1] + 4096 * ks); }
#pragma unroll
                for (int ks = 0; ks < 4; ++ks) {
                    const bf16x8 af = {lo[ks][0], lo[ks][1], lo[ks][2], lo[ks][3], hh[ks][0], hh[ks][1], hh[ks][2], hh[ks][3]};
                    o[blk] = __builtin_amdgcn_mfma_f32_32x32x16_bf16(af, pb[ks], o[blk], 0, 0, 0);
                }
                __builtin_amdgcn_sched_barrier(0);
            }
        }
    }
    __syncthreads();
    const float linv = 1.0f / swap32_sum(l_run);
#pragma unroll
    for (int blk = 0; blk < 4; ++blk)
#pragma unroll
        for (int r = 0; r < 16; ++r) o[blk][r] *= linv;
#undef AT_LOAD
#undef AT_WRITE
}
DI void attn_store(const f32x16 (&o)[4], bf16_t* dst, int ld, int q0) {
    const int tid = opaque_tid(), wid = tid >> 6, lane = tid & 63, r32 = lane & 31, hi = lane >> 5;
    bf16_t* rp = dst + (size_t)(q0 + 32 * wid + r32) * ld;
#pragma unroll
    for (int blk = 0; blk < 4; ++blk)
#pragma unroll
        for (int g = 0; g < 4; ++g) {
            u32x2 w; w.x = pk2(o[blk][4 * g], o[blk][4 * g + 1]); w.y = pk2(o[blk][4 * g + 2], o[blk][4 * g + 3]);
            *(u32x2*)(rp + 32 * blk + 8 * g + 4 * hi) = w;
        }
}
DI int queue_pop(const Ctx& C0, unsigned* ctr, int total) {
    const Ctx C = fresh(C0);
    volatile LAS int* slot = (volatile LAS int*)(C.lds + LDSCTL_OFF + 64);
    __syncthreads();
    if (C.tid == 0) *slot = (int)__hip_atomic_fetch_add(ctr, 1u, __ATOMIC_RELAXED, __HIP_MEMORY_SCOPE_AGENT);
    __syncthreads();
    const int u = *slot;
    return u < total ? u : -1;
}
DI float diff_lambda(const Params& P) {
    float s1 = 0.f, s2 = 0.f;
    for (int i = 0; i < 64; ++i) { s1 += P.in[I_LQ1][i] * P.in[I_LK1][i]; s2 += P.in[I_LQ2][i] * P.in[I_LK2][i]; }
    return expf(s1) - expf(s2) + 0.2f;
}

#if FAST_ATTN
DI void phase_diff_attn(const Ctx& C0, const Params& P, int qi) {
    const Ctx C = fresh(C0);
    unsigned char* ws = P.ws;
    const bf16_t* proj = (const bf16_t*)(ws + P_PROJ); bf16_t* concat = (bf16_t*)(ws + P_CONCAT);
    unsigned* ctr = (unsigned*)(ws + WS_CTL) + CW_CTR + 64 * qi;
    const float lam = diff_lambda(P);
    const int NBH = BATCH * DIFF_HEADS, NS5 = BATCH * 32 / NWAVES, total = NS5 + NBH * 8;
    const int lane = C.lane, r32 = lane & 31, hi = lane >> 5;
    for (;;) {
        int u = queue_pop(C, ctr, total); if (u < 0) break;
        if (u < NS5) { phase_s5(C, P, u * NWAVES, u * NWAVES + NWAVES, 1, NWAVES); continue; }
        u -= NS5;
        const int qb = 7 - u / NBH, bh = u % NBH, b = bh / DIFF_HEADS, h = bh % DIFF_HEADS;
        const bf16_t* base = proj + (size_t)b * SEQ * AB_IN;
        AttnArgs a; a.ldq = AB_IN; a.ldkn = AB_IN; a.ldkr = 0; a.ldv = AB_IN; a.Qr = nullptr; a.Kr = nullptr;
        a.V = base + 2 * DIFF_W + h * 128;
        f32x16 o2[4];
        bf16_t* dst = concat + (size_t)b * SEQ * DM + h * 128;
        a.Qn = base + h * 128; a.Kn = base + DIFF_W + h * 128;
        attn_core<64, 0>(a, qb * 256, C.lds, 0.125f, o2);
        attn_store(o2, dst, DM, qb * 256);
        a.Qn = base + h * 128 + 64; a.Kn = base + DIFF_W + h * 128 + 64;
        attn_core<64, 0>(a, qb * 256, C.lds, 0.125f, o2);
        float ss = 0.f;
        {
            const bf16_t* rp = dst + (size_t)(qb * 256 + 32 * C.wave + r32) * DM;
#pragma unroll
            for (int blk = 0; blk < 4; ++blk)
#pragma unroll
                for (int g = 0; g < 4; ++g) {
                    const u32x2 w = *(const u32x2*)(rp + 32 * blk + 8 * g + 4 * hi);
                    const float o1v[4] = {bflo(w.x), bfhi(w.x), bflo(w.y), bfhi(w.y)};
#pragma unroll
                    for (int j = 0; j < 4; ++j) { const float v = o1v[j] - lam * o2[blk][4 * g + j]; o2[blk][4 * g + j] = v; ss += v * v; }
                }
        }
        ss = swap32_sum(ss);
        const float rs = rsqrtf(ss * (1.0f / 128.0f) + NORM_EPS) * 0.8f;
        const float* sub = P.in[I_SUBLN];
#pragma unroll
        for (int blk = 0; blk < 4; ++blk)
#pragma unroll
            for (int r = 0; r < 16; ++r) o2[blk][r] *= rs * sub[32 * blk + crow(r, hi)];
        attn_store(o2, dst, DM, qb * 256);
    }
}
DI void phase_mla_attn(const Ctx& C0, const Params& P, int qi) {
    const Ctx C = fresh(C0);
    unsigned char* ws = P.ws;
    const bf16_t* q = (const bf16_t*)(ws + P_Q); const bf16_t* kv = (const bf16_t*)(ws + P_KV); const bf16_t* kr = (const bf16_t*)(ws + P_KROPE);
    bf16_t* ob = (bf16_t*)(ws + P_H);
    unsigned* ctr = (unsigned*)(ws + WS_CTL) + CW_CTR + 64 * qi;
    const int NBH = BATCH * MLA_HEADS, total = NBH * 8;
    for (;;) {
        const int u = queue_pop(C, ctr, total); if (u < 0) break;
        const int qb = 7 - u / NBH, bh = u % NBH, b = bh / MLA_HEADS, h = bh % MLA_HEADS;
        AttnArgs a; a.ldq = 3072; a.ldkn = 4096; a.ldkr = 64; a.ldv = 4096;
        a.Qn = q + (size_t)b * SEQ * 3072 + h * 192; a.Qr = a.Qn + 128;
        a.Kn = kv + (size_t)b * SEQ * 4096 + h * 256; a.V = a.Kn + 128; a.Kr = kr + (size_t)b * SEQ * 64;
        f32x16 o[4];
        attn_core<128, 64>(a, qb * 256, C.lds, 0.07216878364870322f, o);
        attn_store(o, ob + (size_t)b * SEQ * DM + h * 128, DM, qb * 256);
    }
}
#else
template <int DK> DI void naive_attn_row(const bf16_t* qrow, const bf16_t* qrow2, const bf16_t* Kn, int ldkn, const bf16_t* Kr, int ldkr, const bf16_t* V, int ldv, int nkeys, float scale, int lane, float& o0, float& o1) {
    float qv[3];
#pragma unroll
    for (int j = 0; j < 3; ++j) { const int d = lane + 64 * j; qv[j] = 0.f; if (d < DK) qv[j] = (DK == 192 && d >= 128) ? bf2f(qrow2[d - 128]) : bf2f(qrow[d]); }
    float m = -1e30f, l = 0.f; o0 = 0.f; o1 = 0.f;
    for (int k = 0; k < nkeys; ++k) {
        float s = 0.f;
#pragma unroll
        for (int j = 0; j < 3; ++j) { const int d = lane + 64 * j; if (d < DK) { const float kvv = (DK == 192 && d >= 128) ? bf2f(Kr[(size_t)k * ldkr + d - 128]) : bf2f(Kn[(size_t)k * ldkn + d]); s += qv[j] * kvv; } }
        s = wave_sum(s) * scale;
        const float mn = fmaxf(m, s), al = expf(m - mn), p = expf(s - mn);
        m = mn; l = l * al + p;
        o0 = o0 * al + p * bf2f(V[(size_t)k * ldv + lane]); o1 = o1 * al + p * bf2f(V[(size_t)k * ldv + 64 + lane]);
    }
    o0 /= l; o1 /= l;
}
DI void phase_diff_attn(const Ctx& C, const Params& P, int) {
    unsigned char* ws = P.ws;
    const bf16_t* proj = (const bf16_t*)(ws + P_PROJ); bf16_t* concat = (bf16_t*)(ws + P_CONCAT);
    const float lam = diff_lambda(P);
    const int lane = C.lane;
    for (int it = C.blk * NWAVES + C.wave; it < BATCH * DIFF_HEADS * SEQ; it += C.G * NWAVES) {
        const int s = it % SEQ, bh = it / SEQ, b = bh / DIFF_HEADS, h = bh % DIFF_HEADS;
        const bf16_t* base = proj + (size_t)b * SEQ * AB_IN;
        const bf16_t* qrow = base + (size_t)s * AB_IN + h * 128;
        float a0, a1, b0, b1;
        naive_attn_row<64>(qrow, nullptr, base + DIFF_W + h * 128, AB_IN, nullptr, 0, base + 2 * DIFF_W + h * 128, AB_IN, s + 1, 0.125f, lane, a0, a1);
        naive_attn_row<64>(qrow + 64, nullptr, base + DIFF_W + h * 128 + 64, AB_IN, nullptr, 0, base + 2 * DIFF_W + h * 128, AB_IN, s + 1, 0.125f, lane, b0, b1);
        const float v0 = a0 - lam * b0, v1 = a1 - lam * b1;
        const float ss = wave_sum(v0 * v0 + v1 * v1);
        const float rs = rsqrtf(ss * (1.0f / 128.0f) + NORM_EPS) * 0.8f;
        bf16_t* orow = concat + (size_t)(b * SEQ + s) * DM + h * 128;
        orow[lane] = f2bf(v0 * rs * P.in[I_SUBLN][lane]); orow[64 + lane] = f2bf(v1 * rs * P.in[I_SUBLN][64 + lane]);
    }
}
DI void phase_mla_attn(const Ctx& C, const Params& P, int) {
    unsigned char* ws = P.ws;
    const bf16_t* q = (const bf16_t*)(ws + P_Q); const bf16_t* kv = (const bf16_t*)(ws + P_KV); const bf16_t* kr = (const bf16_t*)(ws + P_KROPE);
    bf16_t* ob = (bf16_t*)(ws + P_H);
    const int lane = C.lane;
    for (int it = C.blk * NWAVES + C.wave; it < BATCH * MLA_HEADS * SEQ; it += C.G * NWAVES) {
        const int s = it % SEQ, bh = it / SEQ, b = bh / MLA_HEADS, h = bh % MLA_HEADS;
        const bf16_t* qrow = q + (size_t)(b * SEQ + s) * 3072 + h * 192;
        const bf16_t* kn = kv + (size_t)b * SEQ * 4096 + h * 256;
        float a0, a1;
        naive_attn_row<192>(qrow, qrow + 128, kn, 4096, kr + (size_t)b * SEQ * 64, 64, kn + 128, 4096, s + 1, 0.07216878364870322f, lane, a0, a1);
        bf16_t* orow = ob + (size_t)(b * SEQ + s) * DM + h * 128;
        orow[lane] = f2bf(a0); orow[64 + lane] = f2bf(a1);
    }
}
#endif

DI void phase_mla_rows(const Ctx& C0, const Params& P) {
    const Ctx C = fresh(C0);
    unsigned char* ws = P.ws;
    const bf16_t* mp = (const bf16_t*)(ws + P_MLAPROJ); bf16_t* cqn = (bf16_t*)(ws + P_CQN); bf16_t* ckvn = (bf16_t*)(ws + P_CKVN); bf16_t* krp = (bf16_t*)(ws + P_KROPE);
    const f32x2* tab = (const f32x2*)(ws + WS_ROPE);
    const int lane = C.lane;
    for (int r = C.blk * NWAVES + C.wave; r < T; r += C.G * NWAVES) {
        const bf16_t* row = mp + (size_t)r * MLA_IN_PAD;
        float v[12]; float ss = 0.f;
#pragma unroll
        for (int j = 0; j < 3; ++j) { const u32x2 w = *(const u32x2*)(row + 4 * (lane + 64 * j)); v[4 * j] = bflo(w.x); v[4 * j + 1] = bfhi(w.x); v[4 * j + 2] = bflo(w.y); v[4 * j + 3] = bfhi(w.y); }
#pragma unroll
        for (int j = 0; j < 12; ++j) ss += v[j] * v[j];
        float sc = rsqrtf(wave_sum(ss) * (1.0f / MLA_QR) + NORM_EPS);
#pragma unroll
        for (int j = 0; j < 3; ++j) { const f32x4 g = *(const f32x4*)(P.in[I_MLA_QNORM] + 4 * (lane + 64 * j));
            u32x2 w; w.x = pk2(v[4 * j] * sc * g[0], v[4 * j + 1] * sc * g[1]); w.y = pk2(v[4 * j + 2] * sc * g[2], v[4 * j + 3] * sc * g[3]);
            *(u32x2*)(cqn + (size_t)r * MLA_QR + 4 * (lane + 64 * j)) = w; }
        {
            const u32x2 w = *(const u32x2*)(row + MLA_QR + 4 * lane);
            const float a0 = bflo(w.x), a1 = bfhi(w.x), a2 = bflo(w.y), a3 = bfhi(w.y);
            const float s2 = rsqrtf(wave_sum(a0 * a0 + a1 * a1 + a2 * a2 + a3 * a3) * (1.0f / MLA_KVR) + NORM_EPS);
            const f32x4 g = *(const f32x4*)(P.in[I_MLA_KVNORM] + 4 * lane);
            u32x2 o; o.x = pk2(a0 * s2 * g[0], a1 * s2 * g[1]); o.y = pk2(a2 * s2 * g[2], a3 * s2 * g[3]);
            *(u32x2*)(ckvn + (size_t)r * MLA_KVR + 4 * lane) = o;
        }
        if (lane < 32) {
            const unsigned w = *(const unsigned*)(row + 1024 + 2 * lane);
            int p = ((const int*)P.in[I_POS])[r]; p = p < 0 ? 0 : (p > ROPE_POS - 1 ? ROPE_POS - 1 : p);
            const f32x2 cs = tab[(size_t)p * 32 + lane];
            const float x1 = bflo(w), x2 = bfhi(w);
            *(unsigned*)(krp + (size_t)r * 64 + 2 * lane) = pk2(x1 * cs[0] - x2 * cs[1], x2 * cs[0] + x1 * cs[1]);
        }
    }
}

DI void phase_xa_softmax(const Ctx& C0, const Params& P) {
    const Ctx C = fresh(C0);
    unsigned char* ws = P.ws;
    const float* S = (const float*)(ws + P_S); bf16_t* Pb = (bf16_t*)(ws + P_P);
    const int lane = C.lane, hd = lane >> 4, li = lane & 15;
    for (int r = C.blk * NWAVES + C.wave; r < T; r += C.G * NWAVES) {
        const float* row = S + (size_t)r * 1024 + hd * 256;
        f32x4 v[4]; float mx = -1e30f;
#pragma unroll
        for (int j = 0; j < 4; ++j) { v[j] = *(const f32x4*)(row + 4 * (li + 16 * j)); mx = fmaxf(mx, fmaxf(fmaxf(v[j][0], v[j][1]), fmaxf(v[j][2], v[j][3]))); }
#pragma unroll
        for (int o = 1; o < 16; o <<= 1) mx = fmaxf(mx, __shfl_xor(mx, o));
        float sm = 0.f;
#pragma unroll
        for (int j = 0; j < 4; ++j) { v[j][0] = __expf(v[j][0] - mx); v[j][1] = __expf(v[j][1] - mx); v[j][2] = __expf(v[j][2] - mx); v[j][3] = __expf(v[j][3] - mx); sm += (v[j][0] + v[j][1]) + (v[j][2] + v[j][3]); }
#pragma unroll
        for (int o = 1; o < 16; o <<= 1) sm += __shfl_xor(sm, o);
        const float inv = 1.0f / sm;
        bf16_t* orow = Pb + (size_t)r * 1024 + hd * 256;
#pragma unroll
        for (int j = 0; j < 4; ++j) { u32x2 w; w.x = pk2(v[j][0] * inv, v[j][1] * inv); w.y = pk2(v[j][2] * inv, v[j][3] * inv); *(u32x2*)(orow + 4 * (li + 16 * j)) = w; }
    }
}

template <bool STORE> DI void phase_peer(const Ctx& C0, const Params& P) {
    const Ctx C = fresh(C0);
    unsigned char* ws = P.ws;
    const float* sc = (const float*)(ws + P_SC); const bf16_t* hb = (const bf16_t*)(ws + P_H);
    const bf16_t* ut = (const bf16_t*)(ws + P_UT); const bf16_t* vt = (const bf16_t*)(ws + P_VT);
    float* xo = P.out;
    LAS unsigned char* my = C.lds + C.wave * 4096;
    LAS float* top_s = (LAS float*)my;
    LAS int* top_i = (LAS int*)(my + 1024);
    LAS int* best_e = (LAS int*)(my + 2048);
    LAS float* best_g = (LAS float*)(my + 2560);
    LAS float* best_s = (LAS float*)(my + 3072);
    LAS int* best_p = (LAS int*)(my + 3584);
    const int lane = C.lane;
    for (int tok = C.blk * NWAVES + C.wave; tok < T; tok += C.G * NWAVES) {
        for (int rep = 0; rep < (PROBE == 6 ? 2 : 1); ++rep) {
        {
            const int g = lane >> 2, qd = lane & 3;
            float v[32];
            const f32x4* sp = (const f32x4*)(sc + (size_t)tok * 2048 + g * 128 + qd * 32);
#pragma unroll
            for (int j = 0; j < 8; ++j) { const f32x4 x = sp[j]; v[4 * j] = x[0]; v[4 * j + 1] = x[1]; v[4 * j + 2] = x[2]; v[4 * j + 3] = x[3]; }
            for (int r = 0; r < 16; ++r) {
                float bv = v[0]; int bj = 0;
#pragma unroll
                for (int j = 1; j < 32; ++j) { const bool gt = v[j] > bv; bv = gt ? v[j] : bv; bj = gt ? j : bj; }
                int bn = qd * 32 + bj;
#pragma unroll
                for (int off = 1; off <= 2; off <<= 1) { const float ov = __shfl_xor(bv, off); const int on = __shfl_xor(bn, off); const bool tk = (ov > bv) || (ov == bv && on < bn); bv = tk ? ov : bv; bn = tk ? on : bn; }
                if (qd == 0) { top_s[g * 16 + r] = bv; top_i[g * 16 + r] = bn; }
                const int rem = ((bn >> 5) == qd) ? (bn & 31) : -1;
#pragma unroll
                for (int j = 0; j < 32; ++j) v[j] = (j == rem) ? -INFINITY : v[j];
            }
        }
        LDS_WAIT(); asm volatile("" ::: "memory");
        {
            const int h = lane >> 3, sub = lane & 7;
            float v[32];
            const float s00 = top_s[(2 * h) * 16 + 2 * sub], s01 = top_s[(2 * h) * 16 + 2 * sub + 1];
#pragma unroll
            for (int k2 = 0; k2 < 16; ++k2) { const float s1 = top_s[(2 * h + 1) * 16 + k2]; v[k2] = s00 + s1; v[16 + k2] = s01 + s1; }
            for (int r = 0; r < 16; ++r) {
                float bv = v[0]; int bj = 0;
#pragma unroll
                for (int j = 1; j < 32; ++j) { const bool gt = v[j] > bv; bv = gt ? v[j] : bv; bj = gt ? j : bj; }
                int bn = sub * 32 + bj;
#pragma unroll
                for (int off = 1; off <= 4; off <<= 1) { const float ov = __shfl_xor(bv, off); const int on = __shfl_xor(bn, off); const bool tk = (ov > bv) || (ov == bv && on < bn); bv = tk ? ov : bv; bn = tk ? on : bn; }
                if (sub == 0) { best_s[h * 16 + r] = bv; best_p[h * 16 + r] = bn; }
                const int rem = ((bn >> 5) == sub) ? (bn & 31) : -1;
#pragma unroll
                for (int j = 0; j < 32; ++j) v[j] = (j == rem) ? -INFINITY : v[j];
            }
        }
        LDS_WAIT(); asm volatile("" ::: "memory");
#pragma unroll
        for (int e2 = 0; e2 < 2; ++e2) {
            const int idx = lane + 64 * e2, h = idx >> 4;
            float mx = -1e30f;
            for (int k = 0; k < 16; ++k) mx = fmaxf(mx, best_s[h * 16 + k]);
            float sm = 0.f;
            for (int k = 0; k < 16; ++k) sm += __expf(best_s[h * 16 + k] - mx);
            const float gate = __expf(best_s[idx] - mx) / sm;
            const int pos = best_p[idx], k1 = pos >> 4, k2 = pos & 15;
            best_e[idx] = top_i[(2 * h) * 16 + k1] * 128 + top_i[(2 * h + 1) * 16 + k2];
            best_g[idx] = gate;
        }
        LDS_WAIT(); asm volatile("" ::: "memory");
        }
#if PEER_SLICED
        {
            int* pe = (int*)(ws + P_PE_E) + (size_t)tok * 128; float* pg = (float*)(ws + P_PE_G) + (size_t)tok * 128;
            pe[lane] = best_e[lane]; pe[64 + lane] = best_e[64 + lane]; pg[lane] = best_g[lane]; pg[64 + lane] = best_g[64 + lane];
            const u32x4* tp = (const u32x4*)((const bf16_t*)(ws + P_XB) + (size_t)tok * DM + 32 * lane);
            u32x4 tw[4]; float am = 0.f;
#pragma unroll
            for (int i = 0; i < 4; ++i) { tw[i] = tp[i]; const unsigned w4[4] = {tw[i].x, tw[i].y, tw[i].z, tw[i].w};
#pragma unroll
                for (int q = 0; q < 4; ++q) am = fmaxf(am, fmaxf(fabsf(bflo(w4[q])), fabsf(bfhi(w4[q])))); }
#pragma unroll
            for (int o = 1; o < 64; o <<= 1) am = fmaxf(am, __shfl_xor(am, o));
            const float tscale = am > 0.f ? 127.0f / am : 0.f;
            if (lane == 0) ((float*)(ws + P_PE_TSC))[tok] = am * (1.0f / 127.0f) * row_rstd<32>((const float*)(ws + P_SS), tok);
            unsigned qd[8];
#pragma unroll
            for (int i = 0; i < 4; ++i) { const unsigned w4[4] = {tw[i].x, tw[i].y, tw[i].z, tw[i].w};
#pragma unroll
                for (int h2 = 0; h2 < 2; ++h2) { const int q0 = (int)rintf(bflo(w4[2 * h2]) * tscale), q1 = (int)rintf(bfhi(w4[2 * h2]) * tscale), q2 = (int)rintf(bflo(w4[2 * h2 + 1]) * tscale), q3 = (int)rintf(bfhi(w4[2 * h2 + 1]) * tscale);
                    qd[2 * i + h2] = (unsigned)(q0 & 255) | ((unsigned)(q1 & 255) << 8) | ((unsigned)(q2 & 255) << 16) | ((unsigned)(q3 & 255) << 24); } }
            u32x4* t8p = (u32x4*)(ws + P_PE_T8 + (size_t)tok * DM + 32 * lane);
            t8p[0] = (u32x4){qd[0], qd[1], qd[2], qd[3]}; t8p[1] = (u32x4){qd[4], qd[5], qd[6], qd[7]};
        }
#else
#if PEER_FP8
        float tf[32];
#pragma unroll
        for (int i = 0; i < 2; ++i) { const u32x4* tp = (const u32x4*)(hb + (size_t)tok * DM + 16 * (lane + 64 * i));
            const u32x4 a = tp[0], b = tp[1];
            tf[16 * i + 0] = bflo(a.x); tf[16 * i + 1] = bfhi(a.x); tf[16 * i + 2] = bflo(a.y); tf[16 * i + 3] = bfhi(a.y); tf[16 * i + 4] = bflo(a.z); tf[16 * i + 5] = bfhi(a.z); tf[16 * i + 6] = bflo(a.w); tf[16 * i + 7] = bfhi(a.w);
            tf[16 * i + 8] = bflo(b.x); tf[16 * i + 9] = bfhi(b.x); tf[16 * i + 10] = bflo(b.y); tf[16 * i + 11] = bfhi(b.y); tf[16 * i + 12] = bflo(b.z); tf[16 * i + 13] = bfhi(b.z); tf[16 * i + 14] = bflo(b.w); tf[16 * i + 15] = bfhi(b.w); }
        const unsigned char* ut8 = (const unsigned char*)ut; const unsigned char* vt8 = (const unsigned char*)vt;
        const float* usc = (const float*)(ut8 + 32 * MiB); const float* vsc = (const float*)(vt8 + 32 * MiB);
        for (int k0 = 0; k0 < 128; k0 += 8) {
            u32x4 rw[8][2];
#pragma unroll
            for (int kk = 0; kk < 8; ++kk) { const int e = __builtin_amdgcn_readfirstlane(best_e[k0 + kk]); const unsigned char* rp = ut8 + (size_t)e * DM;
#pragma unroll
                for (int i = 0; i < 2; ++i) rw[kk][i] = *(const u32x4*)(rp + 16 * (lane + 64 * i)); }
            float d[8];
#pragma unroll
            for (int kk = 0; kk < 8; ++kk) { float s0 = 0.f, s1 = 0.f;
#pragma unroll
                for (int i = 0; i < 2; ++i) {
                    const unsigned w4[4] = {rw[kk][i].x, rw[kk][i].y, rw[kk][i].z, rw[kk][i].w};
#pragma unroll
                    for (int q = 0; q < 4; ++q) { const f32x2 lo = __builtin_amdgcn_cvt_pk_f32_fp8((int)w4[q], false), hi2 = __builtin_amdgcn_cvt_pk_f32_fp8((int)w4[q], true);
                        s0 = fmaf(lo[0], tf[16 * i + 4 * q], s0); s1 = fmaf(lo[1], tf[16 * i + 4 * q + 1], s1); s0 = fmaf(hi2[0], tf[16 * i + 4 * q + 2], s0); s1 = fmaf(hi2[1], tf[16 * i + 4 * q + 3], s1); }
                }
                d[kk] = s0 + s1; }
            float n4[4], n2[2], r1;
            { const bool b0 = lane & 1;
#pragma unroll
              for (int j = 0; j < 4; ++j) { const float snd = b0 ? d[j] : d[4 + j], kp = b0 ? d[4 + j] : d[j]; n4[j] = kp + __shfl_xor(snd, 1); } }
            { const bool b1 = lane & 2;
#pragma unroll
              for (int j = 0; j < 2; ++j) { const float snd = b1 ? n4[j] : n4[2 + j], kp = b1 ? n4[2 + j] : n4[j]; n2[j] = kp + __shfl_xor(snd, 2); } }
            { const bool b2 = lane & 4; const float snd = b2 ? n2[0] : n2[1], kp = b2 ? n2[1] : n2[0]; r1 = kp + __shfl_xor(snd, 4); }
            r1 += __shfl_xor(r1, 8); r1 += __shfl_xor(r1, 16); r1 += __shfl_xor(r1, 32);
            if (lane < 8) { const int idx = k0 + 4 * (lane & 1) + 2 * ((lane >> 1) & 1) + ((lane >> 2) & 1); const float act = r1 * usc[best_e[idx]]; best_g[idx] *= gelu_erf(act); }
        }
        LDS_WAIT(); asm volatile("" ::: "memory");
        float acc[32];
#pragma unroll
        for (int j = 0; j < 32; ++j) acc[j] = 0.f;
        for (int k0 = 0; k0 < 128; k0 += 8) {
            u32x4 rw[8][2]; float wk[8];
#pragma unroll
            for (int kk = 0; kk < 8; ++kk) { const int e = __builtin_amdgcn_readfirstlane(best_e[k0 + kk]); wk[kk] = best_g[k0 + kk] * vsc[e]; const unsigned char* rp = vt8 + (size_t)e * DM;
#pragma unroll
                for (int i = 0; i < 2; ++i) rw[kk][i] = *(const u32x4*)(rp + 16 * (lane + 64 * i)); }
#pragma unroll
            for (int kk = 0; kk < 8; ++kk)
#pragma unroll
                for (int i = 0; i < 2; ++i) {
                    const unsigned w4[4] = {rw[kk][i].x, rw[kk][i].y, rw[kk][i].z, rw[kk][i].w};
#pragma unroll
                    for (int q = 0; q < 4; ++q) { const f32x2 lo = __builtin_amdgcn_cvt_pk_f32_fp8((int)w4[q], false), hi2 = __builtin_amdgcn_cvt_pk_f32_fp8((int)w4[q], true);
                        acc[16 * i + 4 * q] = fmaf(wk[kk], lo[0], acc[16 * i + 4 * q]); acc[16 * i + 4 * q + 1] = fmaf(wk[kk], lo[1], acc[16 * i + 4 * q + 1]);
                        acc[16 * i + 4 * q + 2] = fmaf(wk[kk], hi2[0], acc[16 * i + 4 * q + 2]); acc[16 * i + 4 * q + 3] = fmaf(wk[kk], hi2[1], acc[16 * i + 4 * q + 3]); }
                }
        }
#else
        u32x4 tv[4];
#pragma unroll
        for (int i = 0; i < 4; ++i) tv[i] = *(const u32x4*)(hb + (size_t)tok * DM + 8 * (lane + 64 * i));
        for (int k0 = 0; k0 < 128; k0 += 4) {
            u32x4 rw[4][4];
#pragma unroll
            for (int kk = 0; kk < 4; ++kk) { const int e = __builtin_amdgcn_readfirstlane(best_e[k0 + kk]); const bf16_t* rp = ut + (size_t)e * DM;
#pragma unroll
                for (int i = 0; i < 4; ++i) rw[kk][i] = *(const u32x4*)(rp + 8 * (lane + 64 * i)); }
            float d[4];
#pragma unroll
            for (int kk = 0; kk < 4; ++kk) { float s = 0.f;
#pragma unroll
                for (int i = 0; i < 4; ++i) { s = dot2bf(rw[kk][i].x, tv[i].x, s); s = dot2bf(rw[kk][i].y, tv[i].y, s); s = dot2bf(rw[kk][i].z, tv[i].z, s); s = dot2bf(rw[kk][i].w, tv[i].w, s); }
                d[kk] = wave_sum(s); }
            if (lane < 4) { const float act = lane == 0 ? d[0] : lane == 1 ? d[1] : lane == 2 ? d[2] : d[3]; best_g[k0 + lane] *= gelu_erf(act); }
        }
        LDS_WAIT(); asm volatile("" ::: "memory");
        float acc[32];
#pragma unroll
        for (int j = 0; j < 32; ++j) acc[j] = 0.f;
        for (int k0 = 0; k0 < 128; k0 += 4) {
            u32x4 rw[4][4]; float wk[4];
#pragma unroll
            for (int kk = 0; kk < 4; ++kk) { const int e = __builtin_amdgcn_readfirstlane(best_e[k0 + kk]); wk[kk] = best_g[k0 + kk]; const bf16_t* rp = vt + (size_t)e * DM;
#pragma unroll
                for (int i = 0; i < 4; ++i) rw[kk][i] = *(const u32x4*)(rp + 8 * (lane + 64 * i)); }
#pragma unroll
            for (int kk = 0; kk < 4; ++kk)
#pragma unroll
                for (int i = 0; i < 4; ++i) {
                    acc[8 * i + 0] = fmaf(wk[kk], bflo(rw[kk][i].x), acc[8 * i + 0]); acc[8 * i + 1] = fmaf(wk[kk], bfhi(rw[kk][i].x), acc[8 * i + 1]);
                    acc[8 * i + 2] = fmaf(wk[kk], bflo(rw[kk][i].y), acc[8 * i + 2]); acc[8 * i + 3] = fmaf(wk[kk], bfhi(rw[kk][i].y), acc[8 * i + 3]);
                    acc[8 * i + 4] = fmaf(wk[kk], bflo(rw[kk][i].z), acc[8 * i + 4]); acc[8 * i + 5] = fmaf(wk[kk], bfhi(rw[kk][i].z), acc[8 * i + 5]);
                    acc[8 * i + 6] = fmaf(wk[kk], bflo(rw[kk][i].w), acc[8 * i + 6]); acc[8 * i + 7] = fmaf(wk[kk], bfhi(rw[kk][i].w), acc[8 * i + 7]);
                }
        }
#endif
        float* xr = xo + (size_t)tok * DM;
        if (!STORE) {
#pragma unroll
            for (int j = 0; j < 32; ++j) asm volatile("" :: "v"(acc[j]));
        } else {
#if PEER_FP8
#pragma unroll
            for (int i = 0; i < 2; ++i) { f32x4* p = (f32x4*)(xr + 16 * (lane + 64 * i));
#pragma unroll
                for (int q = 0; q < 4; ++q) { f32x4 a = p[q]; a[0] += acc[16 * i + 4 * q]; a[1] += acc[16 * i + 4 * q + 1]; a[2] += acc[16 * i + 4 * q + 2]; a[3] += acc[16 * i + 4 * q + 3]; p[q] = a; } }
#else
#pragma unroll
            for (int i = 0; i < 4; ++i) { f32x4* p = (f32x4*)(xr + 8 * (lane + 64 * i));
                f32x4 a = p[0], b = p[1];
                a[0] += acc[8 * i]; a[1] += acc[8 * i + 1]; a[2] += acc[8 * i + 2]; a[3] += acc[8 * i + 3];
                b[0] += acc[8 * i + 4]; b[1] += acc[8 * i + 5]; b[2] += acc[8 * i + 6]; b[3] += acc[8 * i + 7];
                p[0] = a; p[1] = b; }
#endif
        }
#endif
        LDS_WAIT(); asm volatile("" ::: "memory");
    }
}


#if PEER_SLICED
DI int peer_cj(int j) { return ((j >> 3) & 1) | (((j >> 2) & 1) << 1) | (((j >> 1) & 1) << 2); }
constexpr int PEER_CHUNK = 128, PEER_NCHUNK = T / PEER_CHUNK;
DI int peer_cjh(int half, int jj) { return half | (((jj >> 2) & 1) << 1) | (((jj >> 1) & 1) << 2); }
#define PEER_ISSUE(RW, ELO, EHI, HALF) do { _Pragma("unroll") for (int jj = 0; jj < 8; ++jj) { \
        const int e_ = __shfl((jj & 1) ? (EHI) : (ELO), (lane & ~7) | peer_cjh((HALF), jj)); \
        RW[jj] = *(const u32x4*)(tabs + (size_t)(MODE == 2 ? (e_ & 1) : e_) * 128); } } while (0)
template <int SIDE  , int MODE = 0  >
DI void phase_peer_sliced(const Ctx& C0, const Params& P, int qbase) {
    const Ctx C = fresh(C0);
    unsigned char* ws = P.ws;
    const bf16_t* hb = (const bf16_t*)(ws + P_H);
    const unsigned char* tab8 = ws + (SIDE == 0 ? P_UT : P_VT);
    const int* pe = (const int*)(ws + P_PE_E); const float* pg = (const float*)(ws + P_PE_G);
    const int lane = C.lane, a = lane >> 3, c = lane & 7;
    const int x = (int)(xb_xcc_id() & 7u);
    for (int i = 0; i < 16; ++i) {
        const int s = ((x + (i >> 1)) & 7) + 8 * (i & 1);
        unsigned* ctr = (unsigned*)(ws + WS_CTL) + CW_CTR + 64 * (qbase + s);
        const unsigned char* tabs = tab8 + (size_t)s * ((size_t)PEER_NE * 128) + 16 * c;
        for (;;) {
            const int ch = queue_pop(C, ctr, PEER_NCHUNK); if (ch < 0) break;
            const int tok0 = ch * PEER_CHUNK + C.wave;
            constexpr int NTOK = PEER_CHUNK / NWAVES;
            u32x4 rwA[8], rwB[8];
            int e_lo = pe[(size_t)tok0 * 128 + lane], e_hi = pe[(size_t)tok0 * 128 + 64 + lane];
            u32x4 ta, tb; float w_lo = 0.f, w_hi = 0.f;
            if (SIDE == 0) { ta = *(const u32x4*)(ws + P_PE_T8 + (size_t)tok0 * DM + s * 128 + 16 * c); tb = ta; }
            else { w_lo = pg[(size_t)tok0 * 128 + lane]; w_hi = pg[(size_t)tok0 * 128 + 64 + lane]; }
            PEER_ISSUE(rwA, e_lo, e_hi, 0);
#pragma unroll 1
            for (int it = 0; it < NTOK; ++it) {
                const int tok = tok0 + NWAVES * it, ntok = (it + 1 < NTOK) ? tok + NWAVES : tok;
                unsigned* xp = (unsigned*)((bf16_t*)(ws + P_XB) + (size_t)tok * DM + s * 128 + 16 * c + 8 * (a & 1) + 4 * ((a >> 1) & 1) + 2 * ((a >> 2) & 1));
                unsigned xw = 0u; if (SIDE == 1) xw = *xp;
                const int ne_lo = pe[(size_t)ntok * 128 + lane], ne_hi = pe[(size_t)ntok * 128 + 64 + lane];
                u32x4 nta, ntb; float nw_lo = 0.f, nw_hi = 0.f;
                if (SIDE == 0) { nta = *(const u32x4*)(ws + P_PE_T8 + (size_t)ntok * DM + s * 128 + 16 * c); ntb = nta; }
                else { nw_lo = pg[(size_t)ntok * 128 + lane]; nw_hi = pg[(size_t)ntok * 128 + 64 + lane]; }
                PEER_ISSUE(rwB, e_lo, e_hi, 1);
                if (SIDE == 0) {
                    int d[16];
#define PEER_DOT(RW, HALF) do { _Pragma("unroll") for (int jj = 0; jj < 8; ++jj) { int s0 = __builtin_amdgcn_sdot4((int)RW[jj].x, (int)ta.x, 0, false); s0 = __builtin_amdgcn_sdot4((int)RW[jj].y, (int)ta.y, s0, false); \
                        s0 = __builtin_amdgcn_sdot4((int)RW[jj].z, (int)ta.z, s0, false); s0 = __builtin_amdgcn_sdot4((int)RW[jj].w, (int)ta.w, s0, false); d[8 * (HALF) + jj] = s0; } } while (0)
                    if (MODE == 1) { _Pragma("unroll") for (int jj = 0; jj < 8; ++jj) { asm volatile("" :: "v"(rwA[jj])); d[jj] = 0; d[8 + jj] = 0; } } else PEER_DOT(rwA, 0);
                    PEER_ISSUE(rwA, ne_lo, ne_hi, 0);
                    if (MODE == 1) { _Pragma("unroll") for (int jj = 0; jj < 8; ++jj) asm volatile("" :: "v"(rwB[jj])); } else PEER_DOT(rwB, 1);
#undef PEER_DOT
                    int n8[8], n4[4], n2[2];
                    { const bool b = c & 1;
#pragma unroll
                      for (int j = 0; j < 8; ++j) { const int snd = b ? d[j] : d[8 + j], kp = b ? d[8 + j] : d[j]; n8[j] = kp + __shfl_xor(snd, 1); } }
                    { const bool b = c & 2;
#pragma unroll
                      for (int j = 0; j < 4; ++j) { const int snd = b ? n8[j] : n8[4 + j], kp = b ? n8[4 + j] : n8[j]; n4[j] = kp + __shfl_xor(snd, 2); } }
                    { const bool b = c & 4;
#pragma unroll
                      for (int j = 0; j < 2; ++j) { const int snd = b ? n4[j] : n4[2 + j], kp = b ? n4[2 + j] : n4[j]; n2[j] = kp + __shfl_xor(snd, 4); } }
                    int* pp = (int*)(ws + P_SC) + ((size_t)s * T + tok) * 128;
                    pp[lane] = n2[0]; pp[64 + lane] = n2[1];
                } else {
                    float acc[16];
#pragma unroll
                    for (int q = 0; q < 16; ++q) acc[q] = 0.f;
#define PEER_AXPY(RW, HALF) do { _Pragma("unroll") for (int jj = 0; jj < 8; ++jj) { const float wj = __shfl((jj & 1) ? w_hi : w_lo, (lane & ~7) | peer_cjh((HALF), jj)); \
                        unsigned w4[4] = {RW[jj].x, RW[jj].y, RW[jj].z, RW[jj].w}; \
                        asm volatile("" : "+v"(w4[0]), "+v"(w4[1]), "+v"(w4[2]), "+v"(w4[3]) : "v"(acc[0]), "v"(acc[15]));     \
                        _Pragma("unroll") for (int q = 0; q < 4; ++q) { const f32x2 lo = __builtin_amdgcn_cvt_pk_f32_fp8((int)w4[q], false), hi2 = __builtin_amdgcn_cvt_pk_f32_fp8((int)w4[q], true); \
                            acc[4 * q] = fmaf(wj, lo[0], acc[4 * q]); acc[4 * q + 1] = fmaf(wj, lo[1], acc[4 * q + 1]); acc[4 * q + 2] = fmaf(wj, hi2[0], acc[4 * q + 2]); acc[4 * q + 3] = fmaf(wj, hi2[1], acc[4 * q + 3]); } } } while (0)
                    if (MODE == 1) { _Pragma("unroll") for (int jj = 0; jj < 8; ++jj) asm volatile("" :: "v"(rwA[jj])); } else PEER_AXPY(rwA, 0);
                    PEER_ISSUE(rwA, ne_lo, ne_hi, 0);
                    if (MODE == 1) { _Pragma("unroll") for (int jj = 0; jj < 8; ++jj) asm volatile("" :: "v"(rwB[jj])); } else PEER_AXPY(rwB, 1);
#undef PEER_AXPY
                    float n8[8], n4[4], n2[2];
                    { const bool b = a & 1;
#pragma unroll
                      for (int q = 0; q < 8; ++q) { const float snd = b ? acc[q] : acc[8 + q], kp = b ? acc[8 + q] : acc[q]; n8[q] = kp + __shfl_xor(snd, 8); } }
                    { const bool b = a & 2;
#pragma unroll
                      for (int q = 0; q < 4; ++q) { const float snd = b ? n8[q] : n8[4 + q], kp = b ? n8[4 + q] : n8[q]; n4[q] = kp + __shfl_xor(snd, 16); } }
                    { const bool b = a & 4;
#pragma unroll
                      for (int q = 0; q < 2; ++q) { const float snd = b ? n4[q] : n4[2 + q], kp = b ? n4[2 + q] : n4[q]; n2[q] = kp + __shfl_xor(snd, 32); } }
                    const unsigned nw = pk2(bflo(xw) + n2[0], bfhi(xw) + n2[1]);
                    if (MODE == 0) { *xp = nw; const float q0 = bflo(nw), q1 = bfhi(nw); const float sq = wave_sum(q0 * q0 + q1 * q1); if (lane == 0) ((float*)(ws + P_SS))[(size_t)tok * 32 + s] = sq; }
                    else asm volatile("" :: "v"(nw));
                }
                e_lo = ne_lo; e_hi = ne_hi;
                if (SIDE == 0) { ta = nta; tb = ntb; } else { w_lo = nw_lo; w_hi = nw_hi; }
            }
        }
    }
}
#undef PEER_ISSUE

DI void phase_peer_combine(const Ctx& C0, const Params& P) {
    const Ctx C = fresh(C0);
    unsigned char* ws = P.ws;
    const float* usc = (const float*)(ws + P_UT + 32 * MiB); const float* vsc = (const float*)(ws + P_VT + 32 * MiB);
    const int* pe = (const int*)(ws + P_PE_E); float* pg = (float*)(ws + P_PE_G); const int* part = (const int*)(ws + P_SC); const float* tsc = (const float*)(ws + P_PE_TSC);
    for (size_t i = (size_t)C.blk * NTHREADS + C.tid; i < (size_t)T * 128; i += (size_t)C.G * NTHREADS) {
        int a = 0;
#pragma unroll
        for (int s = 0; s < 16; ++s) a += part[(size_t)s * T * 128 + i];
        const int e = pe[i];
        pg[i] = pg[i] * gelu_erf((float)a * usc[e] * tsc[i >> 7]) * vsc[e];
    }
}
#endif

constexpr int N_PHASES = 39;
__global__ void __launch_bounds__(NTHREADS, 2) mk_fwd(Params P) {
    extern __shared__ __attribute__((aligned(16))) unsigned char lds_raw[];
    Ctx C; C.lds = (LAS unsigned char*)lds_raw; C.tid = threadIdx.x; C.lane = C.tid & 63; C.wave = __builtin_amdgcn_readfirstlane(C.tid >> 6); C.blk = blockIdx.x; C.G = gridDim.x;
    unsigned char* ws = P.ws;
    for (int u = C.tid; u < (LDS_BYTES - LDSCTL_OFF) / 4; u += NTHREADS) ((LAS unsigned*)(C.lds + LDSCTL_OFF))[u] = 0u;
    __syncthreads();
    XcdBarrier bar; bar.bar = (unsigned*)(ws + WS_CTL) + CW_BAR; bar.x = 0; bar.st = nullptr;
    const bool one = (P.ph_hi - P.ph_lo) > 1;
    if (one) bar = xcd_barrier_post((unsigned*)(ws + WS_CTL) + CW_BAR, (volatile LAS unsigned*)(C.lds + LDSCTL_OFF));
    const int lo = P.ph_lo, hi = P.ph_hi;
#define IN(k) (lo <= (k) && (k) < hi)
#define SEAM(k) do { if (IN(k) && IN((k) + 1)) xcd_barrier(bar); } while (0)
    bf16_t* hbuf = (bf16_t*)(ws + P_H); bf16_t* xb = (bf16_t*)(ws + P_XB); float* ssp = (float*)(ws + P_SS);
    const int* pos = (const int*)P.in[I_POS];
    const f32x2* rtab = (const f32x2*)(ws + WS_ROPE);

    if (IN(0)) { if (EN_PRO) { if (PROBE == 3) { phase_prologue(C, P); __syncthreads(); } phase_prologue(C, P); } } SEAM(0);
    if (IN(1)) {
        {
            g8::Desc g{(const bf16_t*)(ws + P_MEMN), (const bf16_t*)(ws + WS_LW + LW_XKV), DM, DM, DM, MT / 256, DM / 256, 2, 1, (long)MT * DM, 0, (long)(LW_STRIDE / 2), 0};
            EpiBf16 E{(bf16_t*)(ws + WS_KVX), DM, (long)(KVX_STRIDE / 2), 0, 1.0f, nullptr};
            if (PROBE == 1) { EpiNull En; g8::gemm(C.lds, g, En, C.G, C.blk); } if (GSITE < 0 || GSITE == 1) g8::gemm(C.lds, g, E, C.G, C.blk);
        }
        {
            g8::Desc g{(const bf16_t*)(ws + WS_LW + LW_XKV) + (size_t)DM * DM, (const bf16_t*)(ws + P_MEMN), DM, DM, DM, DM / 256, MT / 256, 2, 1, (long)(LW_STRIDE / 2), 0, (long)MT * DM, 0};
            EpiBf16 E{(bf16_t*)(ws + WS_KVX + 16 * MiB), MT, (long)(KVX_STRIDE / 2), 0, 1.0f, nullptr};
            if (PROBE == 1) { EpiNull En; g8::gemm(C.lds, g, En, C.G, C.blk); } if (GSITE < 0 || GSITE == 2) g8::gemm(C.lds, g, E, C.G, C.blk);
        }
        {
            g8::Desc g{(const bf16_t*)(ws + P_SK), (const bf16_t*)(ws + P_WQB), 256, DM, 256, 1, DM / 256, 2, 8, 8L * 65536, 65536, (long)DM * DM, 256};
            EpiBf16 E{(bf16_t*)(ws + WS_LW + LW_PEER), DM, (long)(LW_STRIDE / 2), 256L * DM, 1.0f, nullptr};
            if (PROBE == 1) { EpiNull En; g8::gemm(C.lds, g, En, C.G, C.blk); } if (GSITE < 0 || GSITE == 3) g8::gemm(C.lds, g, E, C.G, C.blk);
        }
    }
    SEAM(1);

    {
        constexpr int l = 0, pb = 2; (void)l;

            if (IN(pb + 0)) rms_rows_2048(C, P.in[I_X], P.in[I_AB_NORM], hbuf, T);
            SEAM(pb + 0);
            if (IN(pb + 1)) {
                g8::Desc g{hbuf, (const bf16_t*)(ws + WS_ABIN_T), DM, DM, DM, T / 256, AB_IN / 256, 1, 1, 0, 0, 0, 0};
                EpiRope<0> E{(bf16_t*)(ws + P_PROJ), AB_IN, pos, rtab};
                if (PROBE == 1) { EpiNull En; g8::gemm(C.lds, g, En, C.G, C.blk); } if (GSITE < 0 || GSITE == 4) g8::gemm(C.lds, g, E, C.G, C.blk);
            }
            SEAM(pb + 1);
            if (IN(pb + 3)) { if (EN_DIFF) { if (PROBE == 2) phase_diff_attn(C, P, 2); phase_diff_attn(C, P, 0); } }
            SEAM(pb + 3);
            if (IN(pb + 4)) {
                g8::Desc g{(const bf16_t*)(ws + P_GBUF), (const bf16_t*)(ws + WS_GLU_T), S5_W, S5_W, S5_W, T / 256, S5_W / 256, 1, 1, 0, 0, 0, 0};
                EpiGlu E{(const bf16_t*)(ws + P_GBUF), P.in[I_S5_BGLU], (bf16_t*)(ws + P_CONCAT)};
                if (PROBE == 1) { EpiNull En; g8::gemm(C.lds, g, En, C.G, C.blk); } if (GSITE < 0 || GSITE == 5) g8::gemm(C.lds, g, E, C.G, C.blk);
            }
            SEAM(pb + 4);
            if (IN(pb + 5)) {
                g8::Desc g{(const bf16_t*)(ws + P_CONCAT), (const bf16_t*)(ws + WS_ABOUT_T), DM, DM, DM, T / 256, DM / 256, 1, 1, 0, 0, 0, 0};
                EpiResidB<true> E{P.in[I_X], xb, ssp};
                if (PROBE == 1) { EpiNull En; g8::gemm(C.lds, g, En, C.G, C.blk); } if (GSITE < 0 || GSITE == 6) g8::gemm(C.lds, g, E, C.G, C.blk);
            }
            SEAM(pb + 5);
    }
    {
        constexpr int l = 0, pb = 2; (void)l;
        const unsigned char* lw = ws + WS_LW + (size_t)l * LW_STRIDE;
        if (IN(pb + 7)) {
            g8::Desc g{xb, (const bf16_t*)(lw + LW_XQ), DM, DM, DM, T / 256, DM / 256, 1, 1, 0, 0, 0, 0};
            EpiBf16T<32> E{(bf16_t*)(ws + P_QX), DM, 0, 0, 1.0f, ssp};
            if (PROBE == 1) { EpiNull En; g8::gemm(C.lds, g, En, C.G, C.blk); } if (GSITE < 0 || GSITE == 11) g8::gemm(C.lds, g, E, C.G, C.blk);
        }
        SEAM(pb + 7);
        if (IN(pb + 8)) {
            g8::Desc g{(const bf16_t*)(ws + P_QX), (const bf16_t*)(ws + WS_KVX + (size_t)l * KVX_STRIDE), DM, DM, 512, SEQ / 256, 1, BATCH, 4, (long)SEQ * DM, 512, (long)MEM_LEN * DM, 512};
            EpiF32 E{(float*)(ws + P_S), 1024, (long)SEQ * 1024, 256, 0.04419417382415922f, nullptr};
            if (PROBE == 1) { EpiNull En; g8::gemm(C.lds, g, En, C.G, C.blk); } if (GSITE < 0 || GSITE == 12) g8::gemm(C.lds, g, E, C.G, C.blk);
        }
        SEAM(pb + 8);
        if (IN(pb + 9)) {
            if (PROBE == 5) phase_xa_softmax(C, P);
            phase_xa_softmax(C, P);
            if (l == 1) {
                convert_tables(C, P, 1);
            }
        }
        SEAM(pb + 9);
        if (IN(pb + 10)) {
            g8::Desc g{(const bf16_t*)(ws + P_P), (const bf16_t*)(ws + WS_KVX + (size_t)l * KVX_STRIDE + 16 * MiB), 1024, MT, 256, SEQ / 256, 2, BATCH, 4, (long)SEQ * 1024, 256, 256, 512L * MT};
            EpiBf16 E{(bf16_t*)(ws + P_OX), DM, (long)SEQ * DM, 512, 1.0f, nullptr};
            if (PROBE == 1) { EpiNull En; g8::gemm(C.lds, g, En, C.G, C.blk); } if (GSITE < 0 || GSITE == 13) g8::gemm(C.lds, g, E, C.G, C.blk);
        }
        SEAM(pb + 10);
        if (IN(pb + 11)) {
            g8::Desc g{(const bf16_t*)(ws + P_OX), (const bf16_t*)(lw + LW_XO), DM, DM, DM, T / 256, DM / 256, 1, 1, 0, 0, 0, 0};
            EpiResidB<false> E{nullptr, xb, ssp};
            if (PROBE == 1) { EpiNull En; g8::gemm(C.lds, g, En, C.G, C.blk); } if (GSITE < 0 || GSITE == 14) g8::gemm(C.lds, g, E, C.G, C.blk);
        }
        SEAM(pb + 11);
        if (IN(pb + 13)) {
            g8::Desc g{xb, (const bf16_t*)(lw + LW_PEER), DM, DM, DM, T / 256, DM / 256, 1, 1, 0, 0, 0, 0};
            EpiF32T<32> E{(float*)(ws + P_SC), DM, 0, 0, 1.0f, ssp};
            if (PROBE == 1) { EpiNull En; g8::gemm(C.lds, g, En, C.G, C.blk); } if (GSITE < 0 || GSITE == 15) g8::gemm(C.lds, g, E, C.G, C.blk);
        }
        SEAM(pb + 13);
        if (IN(pb + 14)) { if (EN_PEER && EN_TOPK) phase_peer<true>(C, P); }
        SEAM(pb + 14);
#if PEER_SLICED
        if (IN(pb + 15)) { if (EN_PEER && EN_PU) { if (PROBE >= 7 && PROBE <= 9) { phase_peer_sliced<0, PROBE - 7>(C, P, 8 + 32 * l + 64); __syncthreads(); } phase_peer_sliced<0>(C, P, 8 + 32 * l); } }
        SEAM(pb + 15);
        if (IN(pb + 16)) { if (EN_PEER) phase_peer_combine(C, P); }
        SEAM(pb + 16);
        if (IN(pb + 17)) { if (EN_PEER && EN_PV) { if (PROBE >= 10 && PROBE <= 12) { phase_peer_sliced<1, PROBE == 10 ? 3 : PROBE - 10>(C, P, 8 + 32 * l + 80); __syncthreads(); } phase_peer_sliced<1>(C, P, 8 + 32 * l + 16); } }
        SEAM(pb + 17);
#endif
    }
    {
        constexpr int l = 1, pb = 20; (void)l;

            if (IN(pb + 1)) {
                g8::Desc g{xb, (const bf16_t*)(ws + WS_MLAIN_T), DM, DM, DM, T / 256, MLA_IN_PAD / 256, 1, 1, 0, 0, 0, 0};
                EpiBf16T<16> E{(bf16_t*)(ws + P_MLAPROJ), MLA_IN_PAD, 0, 0, 1.0f, ssp};
                if (PROBE == 1) { EpiNull En; g8::gemm(C.lds, g, En, C.G, C.blk); } if (GSITE < 0 || GSITE == 7) g8::gemm(C.lds, g, E, C.G, C.blk);
            }
            SEAM(pb + 1);
            if (IN(pb + 2)) { if (PROBE == 5) phase_mla_rows(C, P); phase_mla_rows(C, P); }
            SEAM(pb + 2);
            if (IN(pb + 3)) {
                {
                    g8::Desc g{(const bf16_t*)(ws + P_CQN), (const bf16_t*)(ws + WS_UQ_T), MLA_QR, MLA_QR, MLA_QR, T / 256, 3072 / 256, 1, 1, 0, 0, 0, 0};
                    EpiRope<1> E{(bf16_t*)(ws + P_Q), 3072, pos, rtab};
                    if (PROBE == 1) { EpiNull En; g8::gemm(C.lds, g, En, C.G, C.blk); } if (GSITE < 0 || GSITE == 8) g8::gemm(C.lds, g, E, C.G, C.blk);
                }
                {
                    g8::Desc g{(const bf16_t*)(ws + P_CKVN), (const bf16_t*)(ws + WS_UKV_T), MLA_KVR, MLA_KVR, MLA_KVR, T / 256, 4096 / 256, 1, 1, 0, 0, 0, 0};
                    EpiBf16 E{(bf16_t*)(ws + P_KV), 4096, 0, 0, 1.0f, nullptr};
                    if (PROBE == 1) { EpiNull En; g8::gemm(C.lds, g, En, C.G, C.blk); } if (GSITE < 0 || GSITE == 9) g8::gemm(C.lds, g, E, C.G, C.blk);
                }
            }
            SEAM(pb + 3);
            if (IN(pb + 4)) { if (EN_MLA) { if (PROBE == 2) phase_mla_attn(C, P, 3); phase_mla_attn(C, P, 1); } }
            SEAM(pb + 4);
            if (IN(pb + 5)) {
                g8::Desc g{hbuf, (const bf16_t*)(ws + WS_MLAO_T), DM, DM, DM, T / 256, DM / 256, 1, 1, 0, 0, 0, 0};
                EpiResidB<false> E{nullptr, xb, ssp};
                if (PROBE == 1) { EpiNull En; g8::gemm(C.lds, g, En, C.G, C.blk); } if (GSITE < 0 || GSITE == 10) g8::gemm(C.lds, g, E, C.G, C.blk);
            }
            SEAM(pb + 5);
    }
    {
        constexpr int l = 1, pb = 20; (void)l;
        const unsigned char* lw = ws + WS_LW + (size_t)l * LW_STRIDE;
        if (IN(pb + 7)) {
            g8::Desc g{xb, (const bf16_t*)(lw + LW_XQ), DM, DM, DM, T / 256, DM / 256, 1, 1, 0, 0, 0, 0};
            EpiBf16T<32> E{(bf16_t*)(ws + P_QX), DM, 0, 0, 1.0f, ssp};
            if (PROBE == 1) { EpiNull En; g8::gemm(C.lds, g, En, C.G, C.blk); } if (GSITE < 0 || GSITE == 11) g8::gemm(C.lds, g, E, C.G, C.blk);
        }
        SEAM(pb + 7);
        if (IN(pb + 8)) {
            g8::Desc g{(const bf16_t*)(ws + P_QX), (const bf16_t*)(ws + WS_KVX + (size_t)l * KVX_STRIDE), DM, DM, 512, SEQ / 256, 1, BATCH, 4, (long)SEQ * DM, 512, (long)MEM_LEN * DM, 512};
            EpiF32 E{(float*)(ws + P_S), 1024, (long)SEQ * 1024, 256, 0.04419417382415922f, nullptr};
            if (PROBE == 1) { EpiNull En; g8::gemm(C.lds, g, En, C.G, C.blk); } if (GSITE < 0 || GSITE == 12) g8::gemm(C.lds, g, E, C.G, C.blk);
        }
        SEAM(pb + 8);
        if (IN(pb + 9)) {
            if (PROBE == 5) phase_xa_softmax(C, P);
            phase_xa_softmax(C, P);
            if (l == 1) {
                convert_tables(C, P, 1);
            }
        }
        SEAM(pb + 9);
        if (IN(pb + 10)) {
            g8::Desc g{(const bf16_t*)(ws + P_P), (const bf16_t*)(ws + WS_KVX + (size_t)l * KVX_STRIDE + 16 * MiB), 1024, MT, 256, SEQ / 256, 2, BATCH, 4, (long)SEQ * 1024, 256, 256, 512L * MT};
            EpiBf16 E{(bf16_t*)(ws + P_OX), DM, (long)SEQ * DM, 512, 1.0f, nullptr};
            if (PROBE == 1) { EpiNull En; g8::gemm(C.lds, g, En, C.G, C.blk); } if (GSITE < 0 || GSITE == 13) g8::gemm(C.lds, g, E, C.G, C.blk);
        }
        SEAM(pb + 10);
        if (IN(pb + 11)) {
            g8::Desc g{(const bf16_t*)(ws + P_OX), (const bf16_t*)(lw + LW_XO), DM, DM, DM, T / 256, DM / 256, 1, 1, 0, 0, 0, 0};
            EpiResidB<false> E{nullptr, xb, ssp};
            if (PROBE == 1) { EpiNull En; g8::gemm(C.lds, g, En, C.G, C.blk); } if (GSITE < 0 || GSITE == 14) g8::gemm(C.lds, g, E, C.G, C.blk);
        }
        SEAM(pb + 11);
        if (IN(pb + 13)) {
            g8::Desc g{xb, (const bf16_t*)(lw + LW_PEER), DM, DM, DM, T / 256, DM / 256, 1, 1, 0, 0, 0, 0};
            EpiF32T<32> E{(float*)(ws + P_SC), DM, 0, 0, 1.0f, ssp};
            if (PROBE == 1) { EpiNull En; g8::gemm(C.lds, g, En, C.G, C.blk); } if (GSITE < 0 || GSITE == 15) g8::gemm(C.lds, g, E, C.G, C.blk);
        }
        SEAM(pb + 13);
        if (IN(pb + 14)) { if (EN_PEER && EN_TOPK) phase_peer<true>(C, P); }
        SEAM(pb + 14);
#if PEER_SLICED
        if (IN(pb + 15)) { if (EN_PEER && EN_PU) { if (PROBE >= 7 && PROBE <= 9) { phase_peer_sliced<0, PROBE - 7>(C, P, 8 + 32 * l + 64); __syncthreads(); } phase_peer_sliced<0>(C, P, 8 + 32 * l); } }
        SEAM(pb + 15);
        if (IN(pb + 16)) { if (EN_PEER) phase_peer_combine(C, P); }
        SEAM(pb + 16);
        if (IN(pb + 17)) { if (EN_PEER && EN_PV) { if (PROBE >= 10 && PROBE <= 12) { phase_peer_sliced<1, PROBE == 10 ? 3 : PROBE - 10>(C, P, 8 + 32 * l + 80); __syncthreads(); } phase_peer_sliced<1>(C, P, 8 + 32 * l + 16); } }
        SEAM(pb + 17);
#endif
    }
    if (IN(38)) rms_rows_final(C, xb, P.out, P.in[I_FINAL_NORM], T);
#undef IN
#undef SEAM
}

extern "C" void kernel_launch(void* const* d_in, const int* in_sizes, int n_in, void* d_out, int out_size, void* d_ws, size_t ws_size, hipStream_t stream) {
    static int grid = 0;
    if (grid == 0) {
        if (n_in != 39 || in_sizes[0] != T * DM || out_size != T * DM || ws_size < WS_END) {
            fprintf(stderr, "kernel_launch: unexpected shapes (n_in %d in0 %d out %d ws %zu, need ws >= %zu); nothing launched\n", n_in, n_in > 0 ? in_sizes[0] : -1, out_size, ws_size, (size_t)WS_END);
            grid = -1; return; }
        int dev = 0, cus = 0;
        if (hipGetDevice(&dev) != hipSuccess || hipDeviceGetAttribute(&cus, hipDeviceAttributeMultiprocessorCount, dev) != hipSuccess) { grid = -1; return; }
        if (hipFuncSetAttribute((const void*)mk_fwd, hipFuncAttributeMaxDynamicSharedMemorySize, LDS_BYTES) != hipSuccess) { fprintf(stderr, "kernel_launch: hipFuncSetAttribute failed\n"); grid = -1; return; }
        int per_cu = 0;
        if (hipOccupancyMaxActiveBlocksPerMultiprocessor(&per_cu, (const void*)mk_fwd, NTHREADS, LDS_BYTES) != hipSuccess || per_cu < 1)
            fprintf(stderr, "kernel_launch: occupancy query reports %d blocks per CU\n", per_cu);
        (void)hipGetLastError();
        grid = cus;
    }
    if (grid < 0) return;
    (void)hipMemsetAsync((char*)d_ws + WS_CTL, 0, CTL_BYTES, stream);
    Params p{};
    for (int i = 0; i < 39; ++i) p.in[i] = (const float*)d_in[i];
    p.out = (float*)d_out; p.ws = (unsigned char*)d_ws;
#if MK_ONE_LAUNCH
    p.ph_lo = 0; p.ph_hi = N_PHASES;
    hipLaunchKernelGGL(mk_fwd, dim3(grid), dim3(NTHREADS), LDS_BYTES, stream, p);
#else
    for (int ph = 0; ph < N_PHASES; ++ph) { p.ph_lo = ph; p.ph_hi = ph + 1; hipLaunchKernelGGL(mk_fwd, dim3(grid), dim3(NTHREADS), LDS_BYTES, stream, p); }
#endif
    const hipError_t le = hipPeekAtLastError();
    if (le != hipSuccess) fprintf(stderr, "kernel_launch: launch failed: %s\n", hipGetErrorName(le));
}
```

```cpp
#include <hip/hip_runtime.h>
#include <cstdio>
#include <cstdint>

#ifndef MK_ONE_LAUNCH
#define MK_ONE_LAUNCH 1
#endif
#ifndef FAST_GEMM
#define FAST_GEMM 1
#endif
#ifndef FAST_ATTN
#define FAST_ATTN 1
#endif

#ifndef EN_TOPK
#define EN_TOPK 1
#endif
#ifndef EN_PU
#define EN_PU 1
#endif
#ifndef EN_PV
#define EN_PV 1
#endif
#ifndef EN_S5
#define EN_S5 1
#endif
#ifndef EN_DIFF
#define EN_DIFF 1
#endif
#ifndef EN_MLA
#define EN_MLA 1
#endif
#ifndef EN_PEER
#define EN_PEER 1
#endif
#ifndef EN_GEMM
#define EN_GEMM 1
#endif
#ifndef EN_PRO
#define EN_PRO 1
#endif
#ifndef PEER_FP8
#define PEER_FP8 1
#endif
#ifndef PROBE
#define PROBE 0
#endif
#ifndef PEER_SLICED
#define PEER_SLICED 1
#endif
#ifndef PROBE_PEER2
#define PROBE_PEER2 0
#endif
#ifndef GSITE
#define GSITE -1
#endif
#define GAS __attribute__((address_space(1)))
#define LAS __attribute__((address_space(3)))
#define DI __device__ __forceinline__
typedef unsigned short bf16_t;
typedef short bf16x8 __attribute__((ext_vector_type(8)));
typedef short s16x4 __attribute__((ext_vector_type(4)));
typedef float f32x2 __attribute__((ext_vector_type(2)));
typedef float f32x4 __attribute__((ext_vector_type(4)));
typedef float f32x16 __attribute__((ext_vector_type(16)));
typedef unsigned u32x2 __attribute__((ext_vector_type(2)));
typedef unsigned u32x4 __attribute__((ext_vector_type(4)));
typedef __bf16 bf16x2_t __attribute__((ext_vector_type(2)));

constexpr int BATCH = 16, SEQ = 2048, DM = 2048, T = BATCH * SEQ, MEM_LEN = 256, MT = BATCH * MEM_LEN;
constexpr int DIFF_HEADS = 12, DIFF_W = 1536, S5_W = 512, AB_IN = 5120;
constexpr int MLA_HEADS = 16, MLA_QR = 768, MLA_KVR = 256, MLA_IN = 1088, MLA_IN_PAD = 1280;
constexpr int PEER_NE = 16384;
constexpr float NORM_EPS = 1e-6f;
constexpr int ROPE_POS = 3072;
constexpr int NWAVES = 8, NTHREADS = 512;

constexpr size_t MiB = 1u << 20;
constexpr size_t WS_CTL = 0, CTL_BYTES = 1 * MiB;
constexpr size_t WS_ROPE = 1 * MiB;
constexpr size_t WS_ABIN_T = 2 * MiB, WS_ABOUT_T = 22 * MiB, WS_GLU_T = 30 * MiB, WS_MLAIN_T = 31 * MiB, WS_UQ_T = 36 * MiB, WS_UKV_T = 41 * MiB, WS_MLAO_T = 43 * MiB;
constexpr size_t WS_LW = 51 * MiB, LW_STRIDE = 40 * MiB;
constexpr size_t LW_XQ = 0, LW_XKV = 8 * MiB, LW_XO = 24 * MiB, LW_PEER = 32 * MiB;
constexpr size_t WS_KVX = 131 * MiB, KVX_STRIDE = 32 * MiB;
constexpr size_t WS_POOL = 195 * MiB;
constexpr size_t P_H = WS_POOL;
constexpr size_t P_PROJ = WS_POOL + 128 * MiB;
constexpr size_t P_CONCAT = WS_POOL + 448 * MiB;
constexpr size_t P_GBUF = WS_POOL + 576 * MiB;
constexpr size_t P_MLAPROJ = WS_POOL + 0 * MiB;
constexpr size_t P_CQN = WS_POOL + 80 * MiB;
constexpr size_t P_CKVN = WS_POOL + 128 * MiB;
constexpr size_t P_KROPE = WS_POOL + 144 * MiB;
constexpr size_t P_Q = WS_POOL + 152 * MiB;
constexpr size_t P_KV = WS_POOL + 344 * MiB;
constexpr size_t P_QX = WS_POOL + 128 * MiB;
constexpr size_t P_S = WS_POOL + 256 * MiB;
constexpr size_t P_P = WS_POOL + 384 * MiB;
constexpr size_t P_OX = WS_POOL + 448 * MiB;
constexpr size_t P_SC = WS_POOL + 128 * MiB;
constexpr size_t P_UT = WS_POOL + 608 * MiB;
constexpr size_t P_VT = WS_POOL + 642 * MiB;
constexpr size_t P_PE_E = WS_POOL + 384 * MiB;
constexpr size_t P_PE_G = WS_POOL + 400 * MiB;
constexpr size_t P_PE_T8 = WS_POOL + 432 * MiB;
constexpr size_t P_PE_TSC = WS_POOL + 496 * MiB;
constexpr size_t P_MEMN = WS_POOL + 448 * MiB;
constexpr size_t P_WQB = WS_POOL + 480 * MiB;
constexpr size_t P_SK = WS_POOL + 496 * MiB;
constexpr size_t P_SS = WS_POOL + 680 * MiB;
constexpr size_t P_XB = WS_POOL + 704 * MiB;
constexpr size_t WS_END = WS_POOL + 832 * MiB;
constexpr int CW_BAR = 4096, CW_CTR = 16384;

constexpr int RING_BYTES = 131072, LDSCTL_OFF = RING_BYTES, LDS_BYTES = 147456;

DI unsigned pk2(float lo, float hi) { f32x2 v = {lo, hi}; bf16x2_t b = __builtin_convertvector(v, bf16x2_t); return __builtin_bit_cast(unsigned, b); }
DI float bflo(unsigned u) { return __uint_as_float(u << 16); }
DI float bfhi(unsigned u) { return __uint_as_float(u & 0xffff0000u); }
DI float bf2f(bf16_t b) { return __uint_as_float(((unsigned)b) << 16); }
DI bf16_t f2bf(float f) { return (bf16_t)(pk2(f, 0.f) & 0xffffu); }
DI float dot2bf(unsigned a, unsigned b, float c) { return __builtin_amdgcn_fdot2_f32_bf16(__builtin_bit_cast(bf16x2_t, a), __builtin_bit_cast(bf16x2_t, b), c, false); }
DI int opaque_tid() { int t; asm volatile("v_mov_b32 %0, %1" : "=v"(t) : "v"(threadIdx.x)); return t; }
DI float wave_sum(float v) {
#pragma unroll
    for (int o = 1; o < 64; o <<= 1) v += __shfl_xor(v, o);
    return v;
}
DI float gelu_erf(float v) { return 0.5f * v * (1.0f + erff(v * 0.70710678118654752f)); }
DI float swap32_max(float x) { auto rr = __builtin_amdgcn_permlane32_swap(__float_as_uint(x), __float_as_uint(x), false, false); return fmaxf(__uint_as_float(rr[0]), __uint_as_float(rr[1])); }
DI float swap32_sum(float x) { auto rr = __builtin_amdgcn_permlane32_swap(__float_as_uint(x), __float_as_uint(x), false, false); return __uint_as_float(rr[0]) + __uint_as_float(rr[1]); }
#define LDS_WAIT() asm volatile("s_waitcnt lgkmcnt(0)" ::: "memory")
#define VM_WAIT() asm volatile("s_waitcnt vmcnt(0)" ::: "memory")

#define XB_TMO      128
#define XB_XCNT(j)  (256  + 64 * (j))
#define XB_XSUB(j)  (1280 + 64 * (j))
#define XB_XGEN(j)  (2304 + 64 * (j))
#define XB_TOP      3328
#define XB_TOPGEN   3392
#define XCD_BAR_WORDS 3456
#define XB_SPIN_CAP (1u << 20)
DI unsigned xb_ld(unsigned* p)              { return __hip_atomic_load(p, __ATOMIC_RELAXED, __HIP_MEMORY_SCOPE_AGENT); }
DI unsigned xb_add(unsigned* p, unsigned v) { return __hip_atomic_fetch_add(p, v, __ATOMIC_RELAXED, __HIP_MEMORY_SCOPE_AGENT); }
DI unsigned xb_xcc_id() { return (unsigned)__builtin_amdgcn_s_getreg((3 << 11) | 20) & 0xFu; }
#define XB_SPIN(cond, bar) do { unsigned _sp = 0; while (cond) { __builtin_amdgcn_s_sleep(1); \
    if ((++_sp & 255u) == 0u) { if (xb_ld(&(bar)[XB_TMO])) break; if (_sp > XB_SPIN_CAP) { atomicAdd(&(bar)[XB_TMO], 1u); break; } } } } while (0)
struct XcdBarrier { unsigned* bar; unsigned x; volatile LAS unsigned* st; };
DI XcdBarrier xcd_barrier_post(unsigned* bar, volatile LAS unsigned* st) {
    XcdBarrier b; b.bar = bar; b.x = xb_xcc_id(); b.st = st;
    if (threadIdx.x == 0) (void)xb_add(&bar[XB_XCNT(b.x)], 1u);
    return b;
}
DI void xcd_barrier_complete(unsigned* bar, unsigned x, unsigned& nloc, unsigned& nx) {
    const unsigned G = gridDim.x * gridDim.y * gridDim.z;
    unsigned sum, cnt, mine, sp = 0u;
    for (;;) {
        sum = 0u; cnt = 0u; mine = 0u;
#pragma unroll
        for (unsigned j = 0; j < 16; ++j) { const unsigned c = xb_ld(&bar[XB_XCNT(j)]); sum += c; cnt += (c > 0u) ? 1u : 0u; mine = (j == x) ? c : mine; }
        if (sum == G) break;
        __builtin_amdgcn_s_sleep(1);
        if ((++sp & 255u) == 0u) { if (xb_ld(&bar[XB_TMO])) break; if (sp > XB_SPIN_CAP) { atomicAdd(&bar[XB_TMO], 1u); break; } }
    }
    nloc = mine > 0u ? mine : 1u; nx = cnt > 0u ? cnt : 1u;
}
DI void xcd_barrier(const XcdBarrier& b) {
    asm volatile("s_waitcnt vmcnt(0)" ::: "memory");
    __syncthreads();
    if (threadIdx.x == 0) {
        unsigned* bar = b.bar;
        __builtin_amdgcn_s_waitcnt(0);
        unsigned nloc = b.st[0], nx = b.st[1];
        if (nloc == 0u) { xcd_barrier_complete(bar, b.x, nloc, nx); b.st[0] = nloc; b.st[1] = nx; }
        const unsigned old = xb_add(&bar[XB_XSUB(b.x)], 1u);
        const unsigned gen = old / nloc;
        if (old + 1u == (gen + 1u) * nloc) {
            __builtin_amdgcn_fence(__ATOMIC_RELEASE, "agent");
            asm volatile("s_waitcnt vmcnt(0)" ::: "memory");
            const unsigned og = xb_add(&bar[XB_TOP], 1u);
            const unsigned tg = og / nx;
            if (og + 1u == (tg + 1u) * nx) xb_add(&bar[XB_TOPGEN], 1u);
            else XB_SPIN(xb_ld(&bar[XB_TOPGEN]) == tg, bar);
            __builtin_amdgcn_fence(__ATOMIC_ACQUIRE, "agent");
            xb_add(&bar[XB_XGEN(b.x)], 1u);
            asm volatile("s_waitcnt vmcnt(0)" ::: "memory");
        } else {
            XB_SPIN(xb_ld(&bar[XB_XGEN(b.x)]) == gen, bar);
            __builtin_amdgcn_fence(__ATOMIC_ACQUIRE, "agent");
            asm volatile("s_waitcnt vmcnt(0)" ::: "memory");
        }
    }
    __syncthreads();
}

namespace g8 {
constexpr int BM = 256, BK = 64, HALF = 128, HTB = HALF * BK * 2, STAGE_BYTES = 8 * HTB, NXCD = 8, WGM = 8;
DI int lds_byte(int r, int c) { const int st = (r >> 4) * 2 + (c >> 5), rr = r & 15, cc = c & 31, ob = rr * 64 + cc * 2; return st * 1024 + (ob ^ (((ob >> 9) & 1) << 5)); }
DI void stage_rc(int b, int& R, int& C) { const int st = b / 1024, sb = b % 1024, swz = sb ^ (((sb >> 9) & 1) << 5); R = (st >> 1) * 16 + swz / 64; C = (st & 1) * 32 + (swz % 64) / 2; }
DI int perm32(int rho) { const int n = rho >> 4, i = rho & 15; return 8 * (i >> 2) + 4 * n + (i & 3); }

struct Unit { int zo, zi, pm, pn; };
struct Desc { const bf16_t* A; const bf16_t* Bt; int lda, ldb, K, nM, nN, nZo, nZi; long sAo, sAi, sBo, sBi; };
DI bool next_unit(const Desc& g, int i, int G, int c, Unit& u) {
    const int per = g.nM * g.nN, nwg = per * g.nZo * g.nZi;
    const long L = (long)i * G + c; if (L >= nwg) return false;
    int wgid = (int)L; { const int q = nwg / NXCD, r = nwg % NXCD, xcd = wgid % NXCD, off = wgid / NXCD; wgid = (xcd < r ? xcd * (q + 1) : r * (q + 1) + (xcd - r) * q) + off; }
    const int z = wgid / per, w = wgid % per;
    u.zo = z / g.nZi; u.zi = z % g.nZi;
    const int nig = WGM * g.nN, gid = w / nig, fm = gid * WGM, gsz = (g.nM - fm) < WGM ? (g.nM - fm) : WGM;
    u.pm = fm + ((w % nig) % gsz); u.pn = (w % nig) / gsz; return true;
}

template <class Epi>
DI void gemm_phase(LAS unsigned char* lds, const Desc g, const Epi& E, int G, int c) {
    const int tid = opaque_tid(), wid = __builtin_amdgcn_readfirstlane(tid >> 6), lane = tid & 63, wr = wid >> 2, wc = wid & 3, fr = lane & 15, fq = lane >> 4;
    const int K = g.K, nt = K / BK;
    unsigned voffA[2], voffB[2];
#pragma unroll
    for (int i = 0; i < 2; ++i) { int R, C; stage_rc(tid * 16 + i * 8192, R, C); const int Rb = (R & ~31) + perm32(R & 31);
        voffA[i] = (unsigned)(R * g.lda + C) * 2u; voffB[i] = (unsigned)(Rb * g.ldb + C) * 2u; }
    const size_t kstep = (size_t)(BK * 2);
    const size_t hstepA = (size_t)HALF * g.lda * 2, hstepB = (size_t)HALF * g.ldb * 2;
    const unsigned ldsw = (unsigned)wid * 1024u;
    const int aoff = lds_byte(wr * 64 + fr, fq * 8), boff = lds_byte(wc * 32 + fr, fq * 8);
#define PG8_SA(b, h) (((b) * 2 + (h)) * HTB)
#define PG8_SB(b, h) ((4 + (b) * 2 + (h)) * HTB)
#define PG8_STAGE(bufoff, gbase, voff) do { _Pragma("unroll") for (int _i = 0; _i < 2; ++_i) \
        __builtin_amdgcn_global_load_lds((const unsigned*)((const char*)(gbase) + (voff)[_i]), (LAS unsigned*)(lds + (bufoff) + ldsw + _i * 8192), 16, 0, 0); } while (0)
#define PG8_LDA(dst, b, h) do { _Pragma("unroll") for (int m = 0; m < 4; ++m) _Pragma("unroll") for (int k = 0; k < 2; ++k) dst[m][k] = *(const LAS bf16x8*)(lds + PG8_SA(b, h) + aoff + m * 2048 + k * 1024); } while (0)
#define PG8_LDB(dst, b, h) do { _Pragma("unroll") for (int n = 0; n < 2; ++n) _Pragma("unroll") for (int k = 0; k < 2; ++k) dst[n][k] = *(const LAS bf16x8*)(lds + PG8_SB(b, h) + boff + n * 2048 + k * 1024); } while (0)
#define PG8_MMA(ai, bj, At, Bt) do { __builtin_amdgcn_s_setprio(1); _Pragma("unroll") for (int m = 0; m < 4; ++m) _Pragma("unroll") for (int n = 0; n < 2; ++n) _Pragma("unroll") for (int k = 0; k < 2; ++k) \
        acc[ai][bj][m][n] = __builtin_amdgcn_mfma_f32_16x16x32_bf16(Bt[n][k], At[m][k], acc[ai][bj][m][n], 0, 0, 0); __builtin_amdgcn_s_setprio(0); } while (0)
#define PG8_WAIT_V(n) asm volatile("s_waitcnt vmcnt(" #n ")" ::: "memory")
#define PG8_WAIT_L(n) asm volatile("s_waitcnt lgkmcnt(" #n ")" ::: "memory")
#define PG8_BAR __builtin_amdgcn_s_barrier()
#define PG8_SCHED __builtin_amdgcn_sched_barrier(0)
#define PG8_APTR(u) ((const char*)g.A + ((size_t)(u).zo * g.sAo + (size_t)(u).zi * g.sAi + (size_t)(u).pm * BM * g.lda) * 2)
#define PG8_BPTR(u) ((const char*)g.Bt + ((size_t)(u).zo * g.sBo + (size_t)(u).zi * g.sBi + (size_t)(u).pn * BM * g.ldb) * 2)
    Unit cur, nxt; int ui = 0;
    if (!next_unit(g, 0, G, c, cur)) return;
    f32x4 acc[2][2][4][2];
#pragma unroll
    for (int a = 0; a < 2; ++a)
#pragma unroll
        for (int b = 0; b < 2; ++b)
#pragma unroll
            for (int m = 0; m < 4; ++m)
#pragma unroll
                for (int n = 0; n < 2; ++n) acc[a][b][m][n] = (f32x4){0.f, 0.f, 0.f, 0.f};
    bf16x8 At[4][2], B0[2][2], B1[2][2];
    const char* cA = PG8_APTR(cur); const char* cB = PG8_BPTR(cur);
    PG8_STAGE(PG8_SB(0, 0), cB, voffB); PG8_STAGE(PG8_SA(0, 0), cA, voffA); PG8_STAGE(PG8_SB(0, 1), cB + hstepB, voffB); PG8_STAGE(PG8_SA(0, 1), cA + hstepA, voffA);
    if (wr == 1) PG8_BAR;
    PG8_WAIT_V(4); PG8_BAR;
    PG8_STAGE(PG8_SB(1, 0), cB + kstep, voffB); PG8_STAGE(PG8_SA(1, 0), cA + kstep, voffA); PG8_STAGE(PG8_SB(1, 1), cB + hstepB + kstep, voffB);
    PG8_WAIT_V(6); PG8_BAR;
    for (;;) {
        const bool has_next = next_unit(g, ui + 1, G, c, nxt);
        const char* nA = has_next ? PG8_APTR(nxt) : cA; const char* nB = has_next ? PG8_BPTR(nxt) : cB;
        for (int t = 0; t < nt; t += 2) {
            const bool last = (t == nt - 2);
            const char* a1 = cA + (size_t)(t + 1) * kstep;
            const char* a2 = last ? nA : cA + (size_t)(t + 2) * kstep; const char* b2 = last ? nB : cB + (size_t)(t + 2) * kstep;
            const char* a3 = a2 + kstep; const char* b3 = b2 + kstep;
            PG8_LDB(B0, 0, 0); PG8_SCHED; PG8_LDA(At, 0, 0); PG8_STAGE(PG8_SA(1, 1), a1 + hstepA, voffA);
            PG8_WAIT_L(8); PG8_BAR; PG8_WAIT_L(0); PG8_MMA(0, 0, At, B0); PG8_BAR; PG8_SCHED;
            PG8_LDB(B1, 0, 1); PG8_STAGE(PG8_SB(0, 0), b2, voffB);
            PG8_BAR; PG8_WAIT_L(0); PG8_MMA(0, 1, At, B1); PG8_BAR;
            PG8_LDA(At, 0, 1); PG8_STAGE(PG8_SA(0, 0), a2, voffA);
            PG8_BAR; PG8_WAIT_L(0); PG8_MMA(1, 0, At, B0); PG8_BAR; PG8_SCHED;
            PG8_STAGE(PG8_SB(0, 1), b2 + hstepB, voffB);
            PG8_WAIT_V(6); PG8_BAR; PG8_MMA(1, 1, At, B1); PG8_BAR;
            PG8_LDB(B0, 1, 0); PG8_SCHED; PG8_LDA(At, 1, 0); PG8_STAGE(PG8_SA(0, 1), a2 + hstepA, voffA);
            PG8_WAIT_L(8); PG8_BAR; PG8_WAIT_L(0); PG8_MMA(0, 0, At, B0); PG8_BAR; PG8_SCHED;
            PG8_LDB(B1, 1, 1); PG8_STAGE(PG8_SB(1, 0), b3, voffB);
            PG8_BAR; PG8_WAIT_L(0); PG8_MMA(0, 1, At, B1); PG8_BAR;
            PG8_LDA(At, 1, 1); PG8_STAGE(PG8_SA(1, 0), a3, voffA);
            PG8_BAR; PG8_WAIT_L(0); PG8_MMA(1, 0, At, B0); PG8_BAR; PG8_SCHED;
            PG8_STAGE(PG8_SB(1, 1), b3 + hstepB, voffB);
            PG8_WAIT_V(6); PG8_BAR; PG8_MMA(1, 1, At, B1); PG8_BAR;
        }
        {
            const int row0 = cur.pm * BM + wr * 64 + fr, col0 = cur.pn * BM + wc * 32 + 8 * fq;
#pragma unroll
            for (int ai = 0; ai < 2; ++ai)
#pragma unroll
                for (int m = 0; m < 4; ++m) {
                    const int row = row0 + ai * HALF + m * 16;
                    const float ri = E.row_begin(cur.zo, cur.zi, row);
                    float ra = 0.f;
#pragma unroll
                    for (int bj = 0; bj < 2; ++bj) ra += E.oct(cur.zo, cur.zi, row, col0 + bj * HALF, acc[ai][bj][m][0], acc[ai][bj][m][1], ri);
                    E.row_end(row, cur.pn * 4 + wc, ra);
                }
        }
        if (!has_next) break;
#pragma unroll
        for (int a = 0; a < 2; ++a)
#pragma unroll
            for (int b = 0; b < 2; ++b)
#pragma unroll
                for (int m = 0; m < 4; ++m)
#pragma unroll
                    for (int n = 0; n < 2; ++n) acc[a][b][m][n] = (f32x4){0.f, 0.f, 0.f, 0.f};
        cur = nxt; cA = nA; cB = nB; ++ui;
    }
    PG8_WAIT_V(0);
    if (wr == 0) PG8_BAR;
    PG8_BAR;
#undef PG8_SA
#undef PG8_SB
#undef PG8_STAGE
#undef PG8_LDA
#undef PG8_LDB
#undef PG8_MMA
#undef PG8_WAIT_V
#undef PG8_WAIT_L
#undef PG8_BAR
#undef PG8_SCHED
#undef PG8_APTR
#undef PG8_BPTR
}

template <class Epi>
DI void naive_gemm(const Desc g, const Epi& E, int G, int c) {
    const int M = g.nM * BM, N = g.nN * BM, n8 = N / 8, nZ = g.nZo * g.nZi;
    const long total = (long)nZ * M * n8;
    for (long idx = (long)c * NTHREADS + threadIdx.x; idx < total; idx += (long)G * NTHREADS) {
        const int col = (int)(idx % n8) * 8; const int row = (int)((idx / n8) % M); const int z = (int)(idx / ((long)n8 * M));
        const int zo = z / g.nZi, zi = z % g.nZi;
        const bf16_t* a = g.A + (size_t)zo * g.sAo + (size_t)zi * g.sAi + (size_t)row * g.lda;
        const bf16_t* b = g.Bt + (size_t)zo * g.sBo + (size_t)zi * g.sBi + (size_t)col * g.ldb;
        float acc[8];
#pragma unroll
        for (int j = 0; j < 8; ++j) acc[j] = 0.f;
        for (int k = 0; k < g.K; k += 8) {
            const u32x4 av = *(const u32x4*)(a + k);
#pragma unroll
            for (int j = 0; j < 8; ++j) { const u32x4 bv = *(const u32x4*)(b + (size_t)j * g.ldb + k);
                float s = acc[j]; s = dot2bf(av.x, bv.x, s); s = dot2bf(av.y, bv.y, s); s = dot2bf(av.z, bv.z, s); s = dot2bf(av.w, bv.w, s); acc[j] = s; }
        }
        (void)E.oct(zo, zi, row, col, (f32x4){acc[0], acc[1], acc[2], acc[3]}, (f32x4){acc[4], acc[5], acc[6], acc[7]}, E.row_begin(zo, zi, row));
    }
}
template <class Epi>
DI void gemm(LAS unsigned char* lds, const Desc g, const Epi& E, int G, int c) {
#if !EN_GEMM
    return;
#elif FAST_GEMM
    gemm_phase(lds, g, E, G, c);
#else
    naive_gemm(g, E, G, c);
#endif
}
}

template <int NP> DI float row_rstd(const float* ss, int row) {
    const f32x4* p = (const f32x4*)(ss + (size_t)row * 32); float t = 0.f;
#pragma unroll
    for (int i = 0; i < NP / 4; ++i) { const f32x4 v = p[i]; t += (v[0] + v[1]) + (v[2] + v[3]); }
    return rsqrtf(t * (1.0f / DM) + NORM_EPS);
}
#define EPI_NO_ROW_BEGIN DI float row_begin(int, int, int) const { return 0.f; }
#define EPI_NO_ROW_END DI void row_end(int, int, float) const {}
template <int NP  > struct EpiBf16T {
    bf16_t* O; long ldc, sZo, sZi; float scale; const float* ss;
    EPI_NO_ROW_END
    DI float row_begin(int, int, int row) const { return NP ? row_rstd<NP ? NP : 4>(ss, row) * scale : scale; }
    DI float oct(int zo, int zi, int row, int col, f32x4 lo, f32x4 hi, float f) const {
        bf16_t* p = O + (size_t)zo * sZo + (size_t)zi * sZi + (size_t)row * ldc + col;
        u32x4 w; w.x = pk2(lo[0] * f, lo[1] * f); w.y = pk2(lo[2] * f, lo[3] * f); w.z = pk2(hi[0] * f, hi[1] * f); w.w = pk2(hi[2] * f, hi[3] * f);
        *(u32x4*)p = w; return 0.f;
    }
};
typedef EpiBf16T<0> EpiBf16;
template <int NP> struct EpiF32T {
    float* O; long ldc, sZo, sZi; float scale; const float* ss;
    EPI_NO_ROW_END
    DI float row_begin(int, int, int row) const { return NP ? row_rstd<NP ? NP : 4>(ss, row) * scale : scale; }
    DI float oct(int zo, int zi, int row, int col, f32x4 lo, f32x4 hi, float f) const {
        float* p = O + (size_t)zo * sZo + (size_t)zi * sZi + (size_t)row * ldc + col;
        *(f32x4*)p = lo * f; *(f32x4*)(p + 4) = hi * f; return 0.f;
    }
};
typedef EpiF32T<0> EpiF32;
template <bool F32SRC> struct EpiResidB {
    const float* xin; bf16_t* xb; float* ss;
    EPI_NO_ROW_BEGIN
    DI float oct(int, int, int row, int col, f32x4 lo, f32x4 hi, float) const {
        const size_t o = (size_t)row * DM + col;
        float r[8];
        if (F32SRC) { const f32x4 r0 = *(const f32x4*)(xin + o), r1 = *(const f32x4*)(xin + o + 4); r[0] = r0[0]; r[1] = r0[1]; r[2] = r0[2]; r[3] = r0[3]; r[4] = r1[0]; r[5] = r1[1]; r[6] = r1[2]; r[7] = r1[3]; }
        else { const u32x4 w = *(const u32x4*)(xb + o); r[0] = bflo(w.x); r[1] = bfhi(w.x); r[2] = bflo(w.y); r[3] = bfhi(w.y); r[4] = bflo(w.z); r[5] = bfhi(w.z); r[6] = bflo(w.w); r[7] = bfhi(w.w); }
        u32x4 w; w.x = pk2(r[0] + lo[0], r[1] + lo[1]); w.y = pk2(r[2] + lo[2], r[3] + lo[3]); w.z = pk2(r[4] + hi[0], r[5] + hi[1]); w.w = pk2(r[6] + hi[2], r[7] + hi[3]);
        *(u32x4*)(xb + o) = w;
        const float q0 = bflo(w.x), q1 = bfhi(w.x), q2 = bflo(w.y), q3 = bfhi(w.y), q4 = bflo(w.z), q5 = bfhi(w.z), q6 = bflo(w.w), q7 = bfhi(w.w);
        return ((q0 * q0 + q1 * q1) + (q2 * q2 + q3 * q3)) + ((q4 * q4 + q5 * q5) + (q6 * q6 + q7 * q7));
    }
    DI void row_end(int row, int slot, float ra) const {
        ra += __shfl_xor(ra, 16); ra += __shfl_xor(ra, 32);
        if ((threadIdx.x & 63) < 16) ss[(size_t)row * 32 + slot] = ra;
    }
};
template <int MODE> struct EpiRope {
    bf16_t* O; long ldc; const int* pos; const f32x2* tab;
    EPI_NO_ROW_BEGIN EPI_NO_ROW_END
    DI float oct(int, int, int row, int col, f32x4 lo, f32x4 hi, float) const {
        bool rope; int j0;
        if (MODE == 0) { rope = col < 2 * DIFF_W; j0 = col & 63; } else { const int c = col % 192; rope = c >= 128; j0 = c - 128; }
        if (rope) {
            int p = pos[row]; p = p < 0 ? 0 : (p > ROPE_POS - 1 ? ROPE_POS - 1 : p);
            const f32x4* tp = (const f32x4*)(tab + (size_t)p * 32 + (j0 >> 1));
            const f32x4 t0 = tp[0], t1 = tp[1];
            f32x4 a = lo, b = hi;
            lo[0] = a[0] * t0[0] - a[1] * t0[1]; lo[1] = a[1] * t0[0] + a[0] * t0[1];
            lo[2] = a[2] * t0[2] - a[3] * t0[3]; lo[3] = a[3] * t0[2] + a[2] * t0[3];
            hi[0] = b[0] * t1[0] - b[1] * t1[1]; hi[1] = b[1] * t1[0] + b[0] * t1[1];
            hi[2] = b[2] * t1[2] - b[3] * t1[3]; hi[3] = b[3] * t1[2] + b[2] * t1[3];
        }
        u32x4 w; w.x = pk2(lo[0], lo[1]); w.y = pk2(lo[2], lo[3]); w.z = pk2(hi[0], hi[1]); w.w = pk2(hi[2], hi[3]);
        *(u32x4*)(O + (size_t)row * ldc + col) = w; return 0.f;
    }
};
struct EpiGlu {
    const bf16_t* gbuf; const float* bias; bf16_t* out;
    EPI_NO_ROW_BEGIN EPI_NO_ROW_END
    DI float oct(int, int, int row, int col, f32x4 lo, f32x4 hi, float) const {
        const u32x4 gv = *(const u32x4*)(gbuf + (size_t)row * S5_W + col);
        const f32x4 b0 = *(const f32x4*)(bias + col), b1 = *(const f32x4*)(bias + col + 4);
        float g[8] = {bflo(gv.x), bfhi(gv.x), bflo(gv.y), bfhi(gv.y), bflo(gv.z), bfhi(gv.z), bflo(gv.w), bfhi(gv.w)};
        float a[8] = {lo[0] + b0[0], lo[1] + b0[1], lo[2] + b0[2], lo[3] + b0[3], hi[0] + b1[0], hi[1] + b1[1], hi[2] + b1[2], hi[3] + b1[3]};
        float r[8];
#pragma unroll
        for (int j = 0; j < 8; ++j) r[j] = g[j] / (1.0f + __expf(-a[j]));
        u32x4 w; w.x = pk2(r[0], r[1]); w.y = pk2(r[2], r[3]); w.z = pk2(r[4], r[5]); w.w = pk2(r[6], r[7]);
        *(u32x4*)(out + (size_t)row * DM + DIFF_W + col) = w; return 0.f;
    }
};
struct EpiNull { EPI_NO_ROW_BEGIN EPI_NO_ROW_END DI float oct(int, int, int, int, f32x4 lo, f32x4 hi, float) const { asm volatile("" :: "v"(lo), "v"(hi)); return 0.f; } };
struct Params {
    const float* in[39];
    float* out; unsigned char* ws;
    int ph_lo, ph_hi;
};
enum { I_X = 0, I_MEM, I_POS, I_AB_NORM, I_AB_WIN, I_AB_WOUT, I_LQ1, I_LK1, I_LQ2, I_LK2, I_SUBLN, I_S5_ARE, I_S5_AIM, I_S5_LOGSTEP, I_S5_BRE, I_S5_BIM, I_S5_CRE, I_S5_CIM, I_S5_D,
       I_S5_WGLU, I_S5_BGLU, I_MLA_NORM, I_MLA_WIN, I_MLA_QNORM, I_MLA_KVNORM, I_MLA_WUQ, I_MLA_WUKV, I_MLA_WO, I_XA_NORM, I_XA_MEMNORM, I_XA_WQ, I_XA_WKV, I_XA_WO, I_FFN_NORM,
       I_PEER_WQ, I_PEER_SK, I_PEER_U, I_PEER_V, I_FINAL_NORM };

struct Ctx { LAS unsigned char* lds; int tid, lane, wave, blk, G; };
DI Ctx fresh(const Ctx& C0) { Ctx C = C0; C.tid = opaque_tid(); C.lane = C.tid & 63; return C; }

DI void rms_rows_2048(const Ctx& C0, const float* src, const float* gain, bf16_t* dst, int nrows) {
    const Ctx C = fresh(C0);
    for (int r = C.blk * NWAVES + C.wave; r < nrows; r += C.G * NWAVES) {
        const f32x4* xr = (const f32x4*)(src + (size_t)r * DM) + C.lane;
        f32x4 v[8]; float ss = 0.f;
#pragma unroll
        for (int j = 0; j < 8; ++j) { v[j] = xr[64 * j]; ss += (v[j][0] * v[j][0] + v[j][1] * v[j][1]) + (v[j][2] * v[j][2] + v[j][3] * v[j][3]); }
        const float sc = rsqrtf(wave_sum(ss) * (1.0f / DM) + NORM_EPS);
        u32x2* o = (u32x2*)(dst + (size_t)r * DM) + C.lane;
#pragma unroll
        for (int j = 0; j < 8; ++j) { const f32x4 g = *((const f32x4*)gain + C.lane + 64 * j);
            u32x2 w; w.x = pk2(v[j][0] * sc * g[0], v[j][1] * sc * g[1]); w.y = pk2(v[j][2] * sc * g[2], v[j][3] * sc * g[3]); o[64 * j] = w; }
    }
}
DI void rms_rows_final(const Ctx& C0, const bf16_t* xbp, float* out, const float* gain, int nrows) {
    const Ctx C = fresh(C0);
    for (int r = C.blk * NWAVES + C.wave; r < nrows; r += C.G * NWAVES) {
        const u32x2* xr = (const u32x2*)(xbp + (size_t)r * DM) + C.lane;
        f32x4 v[8]; float ss = 0.f;
#pragma unroll
        for (int j = 0; j < 8; ++j) { const u32x2 w = xr[64 * j]; v[j] = (f32x4){bflo(w.x), bfhi(w.x), bflo(w.y), bfhi(w.y)}; ss += (v[j][0] * v[j][0] + v[j][1] * v[j][1]) + (v[j][2] * v[j][2] + v[j][3] * v[j][3]); }
        const float sc = rsqrtf(wave_sum(ss) * (1.0f / DM) + NORM_EPS);
        f32x4* o = (f32x4*)(out + (size_t)r * DM) + C.lane;
#pragma unroll
        for (int j = 0; j < 8; ++j) { const f32x4 g = *((const f32x4*)gain + C.lane + 64 * j); o[64 * j] = v[j] * sc * g; }
    }
}

DI int srccol(int kind, int n) {
    if (kind == 1) { if (n < 2 * DIFF_W) { const int j = n & 63; return (n & ~63) + (j >> 1) + 32 * (j & 1); } return n; }
    if (kind == 2) { if (n >= MLA_IN) return -1; if (n >= 1024) { const int j = n - 1024; return 1024 + (j >> 1) + 32 * (j & 1); } return n; }
    if (kind == 3) { const int c = n % 192; if (c >= 128) { const int j = c - 128; return n - c + 128 + (j >> 1) + 32 * (j & 1); } return n; }
    return n;
}
DI void transpose_item(const float* W, int K, int Nsrc, bf16_t* Wt, int nblk, int kind, const float* kgain, LAS float* scr, int item, int lane) {
    const int kb = item / nblk, nb = item % nblk, k0 = 64 * kb, n0 = 32 * nb;
    const int src = srccol(kind, n0 + (lane & 31));
#pragma unroll 8
    for (int i = 0; i < 32; ++i) { const int kk = 2 * i + (lane >> 5); scr[kk * 33 + (lane & 31)] = (src >= 0) ? W[(size_t)(k0 + kk) * Nsrc + src] * (kgain ? kgain[k0 + kk] : 1.0f) : 0.f; }
    LDS_WAIT(); asm volatile("" ::: "memory");
    const int c = lane & 7;
#pragma unroll
    for (int j = 0; j < 4; ++j) { const int n = (lane >> 3) + 8 * j; const LAS float* s = scr + (8 * c) * 33 + n;
        u32x4 o; o.x = pk2(s[0 * 33], s[1 * 33]); o.y = pk2(s[2 * 33], s[3 * 33]); o.z = pk2(s[4 * 33], s[5 * 33]); o.w = pk2(s[6 * 33], s[7 * 33]);
        *(u32x4*)(Wt + (size_t)(n0 + n) * K + k0 + 8 * c) = o; }
    LDS_WAIT(); asm volatile("" ::: "memory");
}
DI void cvt_bf16(const Ctx& C0, const float* src, bf16_t* dst, size_t n8) {
    const Ctx C = fresh(C0);
    for (size_t i = (size_t)C.blk * NTHREADS + C.tid; i < n8; i += (size_t)C.G * NTHREADS) {
        const f32x4 a = *(const f32x4*)(src + i * 8), b = *(const f32x4*)(src + i * 8 + 4);
        u32x4 w; w.x = pk2(a[0], a[1]); w.y = pk2(a[2], a[3]); w.z = pk2(b[0], b[1]); w.w = pk2(b[2], b[3]);
        *(u32x4*)(dst + i * 8) = w;
    }
}


DI void cvt_fp8_rows(const Ctx& C0, const float* src, unsigned char* dst, float* isc, int nrows) {
    const Ctx C = fresh(C0);
    for (int r = C.blk * NWAVES + C.wave; r < nrows; r += C.G * NWAVES) {
        const f32x4* xr = (const f32x4*)(src + (size_t)r * DM) + C.lane;
        f32x4 v[8]; float am = 0.f;
#pragma unroll
        for (int j = 0; j < 8; ++j) { v[j] = xr[64 * j]; am = fmaxf(am, fmaxf(fmaxf(fabsf(v[j][0]), fabsf(v[j][1])), fmaxf(fabsf(v[j][2]), fabsf(v[j][3])))); }
#pragma unroll
        for (int o = 1; o < 64; o <<= 1) am = fmaxf(am, __shfl_xor(am, o));
        const float e = am > 0.f ? floorf(log2f(448.0f / am)) : 0.f;
        const float scale = exp2f(e);
        if (C.lane == 0) isc[r] = exp2f(-e);
#if PEER_SLICED
        unsigned* o = (unsigned*)(dst + (size_t)(C.lane >> 5) * ((size_t)PEER_NE * 128) + (size_t)r * 128) + (C.lane & 31);
#pragma unroll
        for (int j = 0; j < 8; ++j) { int w = 0; w = __builtin_amdgcn_cvt_pk_fp8_f32(v[j][0] * scale, v[j][1] * scale, w, false); w = __builtin_amdgcn_cvt_pk_fp8_f32(v[j][2] * scale, v[j][3] * scale, w, true); o[(size_t)2 * j * (PEER_NE * 128 / 4)] = (unsigned)w; }
#else
        unsigned* o = (unsigned*)(dst + (size_t)r * DM) + C.lane;
#pragma unroll
        for (int j = 0; j < 8; ++j) { int w = 0; w = __builtin_amdgcn_cvt_pk_fp8_f32(v[j][0] * scale, v[j][1] * scale, w, false); w = __builtin_amdgcn_cvt_pk_fp8_f32(v[j][2] * scale, v[j][3] * scale, w, true); o[64 * j] = (unsigned)w; }
#endif
    }
}


DI void cvt_i8_rows(const Ctx& C0, const float* src, const float* cgain, unsigned char* dst, float* isc, int nrows) {
    const Ctx C = fresh(C0);
    for (int r = C.blk * NWAVES + C.wave; r < nrows; r += C.G * NWAVES) {
        const f32x4* xr = (const f32x4*)(src + (size_t)r * DM) + C.lane;
        f32x4 v[8]; float am = 0.f;
#pragma unroll
        for (int j = 0; j < 8; ++j) { v[j] = xr[64 * j] * *((const f32x4*)cgain + C.lane + 64 * j); am = fmaxf(am, fmaxf(fmaxf(fabsf(v[j][0]), fabsf(v[j][1])), fmaxf(fabsf(v[j][2]), fabsf(v[j][3])))); }
#pragma unroll
        for (int o = 1; o < 64; o <<= 1) am = fmaxf(am, __shfl_xor(am, o));
        const float scale = am > 0.f ? 127.0f / am : 0.f;
        if (C.lane == 0) isc[r] = am * (1.0f / 127.0f);
        unsigned* o = (unsigned*)(dst + (size_t)(C.lane >> 5) * ((size_t)PEER_NE * 128) + (size_t)r * 128) + (C.lane & 31);
#pragma unroll
        for (int j = 0; j < 8; ++j) { const int q0 = (int)rintf(v[j][0] * scale), q1 = (int)rintf(v[j][1] * scale), q2 = (int)rintf(v[j][2] * scale), q3 = (int)rintf(v[j][3] * scale);
            o[(size_t)2 * j * (PEER_NE * 128 / 4)] = (unsigned)(q0 & 255) | ((unsigned)(q1 & 255) << 8) | ((unsigned)(q2 & 255) << 16) | ((unsigned)(q3 & 255) << 24); }
    }
}

DI void convert_tables(const Ctx& C, const Params& P, int l) {
    unsigned char* ws = P.ws;
#if PEER_FP8
#if PEER_SLICED
    cvt_i8_rows(C, P.in[I_PEER_U] + (size_t)l * PEER_NE * DM, P.in[I_FFN_NORM] + l * DM, ws + P_UT, (float*)(ws + P_UT + 32 * MiB), PEER_NE);
#else
    cvt_fp8_rows(C, P.in[I_PEER_U] + (size_t)l * PEER_NE * DM, ws + P_UT, (float*)(ws + P_UT + 32 * MiB), PEER_NE);
#endif
    cvt_fp8_rows(C, P.in[I_PEER_V] + (size_t)l * PEER_NE * DM, ws + P_VT, (float*)(ws + P_VT + 32 * MiB), PEER_NE);
#else
    cvt_bf16(C, P.in[I_PEER_U] + (size_t)l * PEER_NE * DM, (bf16_t*)(ws + P_UT), (size_t)PEER_NE * DM / 8);
    cvt_bf16(C, P.in[I_PEER_V] + (size_t)l * PEER_NE * DM, (bf16_t*)(ws + P_VT), (size_t)PEER_NE * DM / 8);
#endif
}

DI void phase_prologue(const Ctx& C0, const Params& P) {
    const Ctx C = fresh(C0);
    unsigned char* ws = P.ws;
    LAS float* scr = (LAS float*)(C.lds + C.wave * 8448);
    const int gw = C.blk * NWAVES + C.wave, NGW = C.G * NWAVES;
    int base = 0;
#define TJOB(Wp, K_, Nsrc_, Nout_, kind_, dst_, kg_) do { const int nblk_ = (Nout_) / 32, nit_ = ((K_) / 64) * nblk_; \
        int first_ = (gw - base % NGW + NGW) % NGW; \
        for (int it = first_; it < nit_; it += NGW) transpose_item((Wp), (K_), (Nsrc_), (bf16_t*)(dst_), nblk_, (kind_), (kg_), scr, it, C.lane); base += nit_; } while (0)
    TJOB(P.in[I_AB_WIN], DM, AB_IN, AB_IN, 1, ws + WS_ABIN_T, nullptr);
    TJOB(P.in[I_AB_WOUT], DM, DM, DM, 0, ws + WS_ABOUT_T, nullptr);
    TJOB(P.in[I_S5_WGLU], S5_W, S5_W, S5_W, 0, ws + WS_GLU_T, nullptr);
    TJOB(P.in[I_MLA_WIN], DM, MLA_IN, MLA_IN_PAD, 2, ws + WS_MLAIN_T, P.in[I_MLA_NORM]);
    TJOB(P.in[I_MLA_WUQ], MLA_QR, 3072, 3072, 3, ws + WS_UQ_T, nullptr);
    TJOB(P.in[I_MLA_WUKV], MLA_KVR, 4096, 4096, 0, ws + WS_UKV_T, nullptr);
    TJOB(P.in[I_MLA_WO], DM, DM, DM, 0, ws + WS_MLAO_T, nullptr);
    for (int l = 0; l < 2; ++l) {
        TJOB(P.in[I_XA_WQ] + (size_t)l * DM * DM, DM, DM, DM, 0, ws + WS_LW + l * LW_STRIDE + LW_XQ, P.in[I_XA_NORM] + l * DM);
        TJOB(P.in[I_XA_WKV] + (size_t)l * DM * 2 * DM, DM, 2 * DM, 2 * DM, 0, ws + WS_LW + l * LW_STRIDE + LW_XKV, nullptr);
        TJOB(P.in[I_XA_WO] + (size_t)l * DM * DM, DM, DM, DM, 0, ws + WS_LW + l * LW_STRIDE + LW_XO, nullptr);
    }
#undef TJOB
    {
        f32x2* tab = (f32x2*)(ws + WS_ROPE);
        for (int i = C.blk * NTHREADS + C.tid; i < ROPE_POS * 32; i += C.G * NTHREADS) {
            const int p = i >> 5, f = i & 31;
            const float inv = powf(10000.0f, -(float)f * (2.0f / 64.0f));
            const float ang = (float)p * inv;
            tab[i] = (f32x2){(float)cos((double)ang), (float)sin((double)ang)};
        }
    }
    {
        const float* src = P.in[I_PEER_WQ]; bf16_t* dst = (bf16_t*)(ws + P_WQB);
        for (size_t i = (size_t)C.blk * NTHREADS + C.tid; i < (size_t)2 * DM * DM / 8; i += (size_t)C.G * NTHREADS) {
            const float g = P.in[I_FFN_NORM][i / (DM / 8)];
            const f32x4 a = *(const f32x4*)(src + i * 8), b = *(const f32x4*)(src + i * 8 + 4);
            u32x4 w; w.x = pk2(a[0] * g, a[1] * g); w.y = pk2(a[2] * g, a[3] * g); w.z = pk2(b[0] * g, b[1] * g); w.w = pk2(b[2] * g, b[3] * g);
            *(u32x4*)(dst + i * 8) = w;
        }
    }
    {
        bf16_t* sk = (bf16_t*)(ws + P_SK); const float* skin = P.in[I_PEER_SK];
        for (int i = C.blk * NTHREADS + C.tid; i < 2 * 8 * 256 * 256 / 8; i += C.G * NTHREADS) {
            const int q8 = (i & 31) * 8, np = (i >> 5) & 255, lh = i >> 13;
            const int c = np >> 7, n = np & 127, c2 = q8 >> 7, q = q8 & 127;
            u32x4 w = {0u, 0u, 0u, 0u};
            if (c == c2) { const float* s = skin + ((((size_t)lh * 2 + c) * 128 + n) * 128 + q);
                const f32x4 a = *(const f32x4*)s, b = *(const f32x4*)(s + 4);
                w.x = pk2(a[0], a[1]); w.y = pk2(a[2], a[3]); w.z = pk2(b[0], b[1]); w.w = pk2(b[2], b[3]); }
            *(u32x4*)(sk + (size_t)i * 8) = w;
        }
    }
    convert_tables(C, P, 0);
    for (int l = 0; l < 2; ++l) rms_rows_2048(C, P.in[I_MEM], P.in[I_XA_MEMNORM] + l * DM, (bf16_t*)(ws + P_MEMN) + (size_t)l * MT * DM, MT);
}

DI void phase_s5(const Ctx& C0, const Params& P, int first, int last, int stride_w, int stride) {
    const Ctx C = fresh(C0);
    unsigned char* ws = P.ws;
    const bf16_t* proj = (const bf16_t*)(ws + P_PROJ); bf16_t* gbuf = (bf16_t*)(ws + P_GBUF);
    LAS unsigned char* my = C.lds + C.wave * 8192;
    LAS float* U = (LAS float*)my;
    LAS bf16_t* H = (LAS bf16_t*)(my + 1024);
    const int lane = C.lane, n = lane;
    for (int task = first + C.wave * stride_w; task < last; task += stride) {
        const int b = task >> 5, g = task & 31;
        const float a_re = P.in[I_S5_ARE][g * 64 + n], a_im = P.in[I_S5_AIM][g * 64 + n];
        const float step = expf(P.in[I_S5_LOGSTEP][g]);
        const float mag = expf(a_re * step);
        const float ab_re = mag * cosf(a_im * step), ab_im = mag * sinf(a_im * step);
        const float den = a_re * a_re + a_im * a_im, num_re = ab_re - 1.0f;
        const float f_re = (num_re * a_re + ab_im * a_im) / den, f_im = (ab_im * a_re - num_re * a_im) / den;
        float bbr[16], bbi[16];
        {
            const float* br = P.in[I_S5_BRE] + ((size_t)g * 64 + n) * 16; const float* bi = P.in[I_S5_BIM] + ((size_t)g * 64 + n) * 16;
#pragma unroll
            for (int p = 0; p < 16; ++p) { const float x = br[p], y = bi[p]; bbr[p] = f_re * x - f_im * y; bbi[p] = f_re * y + f_im * x; }
        }
        bf16x8 cf[4];
        {
            const int p = lane & 15, kq = lane >> 4;
#pragma unroll
            for (int kk = 0; kk < 4; ++kk) {
                const int k = 32 * kk + 8 * kq; const bool im = k >= 64;
                const float* src = (im ? P.in[I_S5_CIM] : P.in[I_S5_CRE]) + ((size_t)g * 16 + p) * 64 + (k & 63);
                const float sg = im ? -1.f : 1.f;
                const f32x4 a = *(const f32x4*)src, bq = *(const f32x4*)(src + 4);
                u32x4 w; w.x = pk2(sg * a[0], sg * a[1]); w.y = pk2(sg * a[2], sg * a[3]); w.z = pk2(sg * bq[0], sg * bq[1]); w.w = pk2(sg * bq[2], sg * bq[3]);
                cf[kk] = __builtin_bit_cast(bf16x8, w);
            }
        }
        const float dcoef = P.in[I_S5_D][g * 16 + (lane & 15)];
        float h_re = 0.f, h_im = 0.f;
        const bf16_t* ub = proj + (size_t)b * SEQ * AB_IN + 3 * DIFF_W + g * 16;
        for (int s0 = 0; s0 < SEQ; s0 += 16) {
            {
                const int st = lane >> 2, pp = (lane & 3) * 4;
                const u32x2 uv = *(const u32x2*)(ub + (size_t)(s0 + st) * AB_IN + pp);
                *(LAS f32x4*)(U + st * 16 + pp) = (f32x4){bflo(uv.x), bfhi(uv.x), bflo(uv.y), bfhi(uv.y)};
            }
            LDS_WAIT(); asm volatile("" ::: "memory");
#pragma unroll 4
            for (int st = 0; st < 16; ++st) {
                const f32x4 u0 = *(const LAS f32x4*)(U + st * 16), u1 = *(const LAS f32x4*)(U + st * 16 + 4), u2 = *(const LAS f32x4*)(U + st * 16 + 8), u3 = *(const LAS f32x4*)(U + st * 16 + 12);
                const float uu[16] = {u0[0], u0[1], u0[2], u0[3], u1[0], u1[1], u1[2], u1[3], u2[0], u2[1], u2[2], u2[3], u3[0], u3[1], u3[2], u3[3]};
                float br = 0.f, bi = 0.f;
#pragma unroll
                for (int p = 0; p < 16; ++p) { br = fmaf(bbr[p], uu[p], br); bi = fmaf(bbi[p], uu[p], bi); }
                const float nr = ab_re * h_re - ab_im * h_im + br, ni = ab_re * h_im + ab_im * h_re + bi;
                h_re = nr; h_im = ni;
                H[st * 136 + n] = f2bf(h_re); H[st * 136 + 64 + n] = f2bf(h_im);
            }
            LDS_WAIT(); asm volatile("" ::: "memory");
            f32x4 acc = {0.f, 0.f, 0.f, 0.f};
#pragma unroll
            for (int kk = 0; kk < 4; ++kk) {
                const bf16x8 af = *(const LAS bf16x8*)((LAS unsigned char*)H + (lane & 15) * 272 + (32 * kk + 8 * (lane >> 4)) * 2);
                acc = __builtin_amdgcn_mfma_f32_16x16x32_bf16(af, cf[kk], acc, 0, 0, 0);
            }
#pragma unroll
            for (int r = 0; r < 4; ++r) {
                const int st = (lane >> 4) * 4 + r, p = lane & 15;
                const float y = acc[r] + dcoef * U[st * 16 + p];
                gbuf[(size_t)(b * SEQ + s0 + st) * S5_W + g * 16 + p] = f2bf(gelu_erf(y));
            }
            LDS_WAIT(); asm volatile("" ::: "memory");
        }
    }
}

struct AttnArgs { const bf16_t* Qn; const bf16_t* Qr; const bf16_t* Kn; const bf16_t* Kr; const bf16_t* V; int ldq, ldkn, ldkr, ldv; };
DI int crow(int r, int hi) { return (r & 3) + 8 * (r >> 2) + 4 * hi; }
template <int DK> DI int koff(int row, int ch) { return DK == 64 ? row * 128 + 16 * (ch ^ ((row >> 1) & 7)) : row * 256 + 16 * (ch ^ (row & 15)); }
DI int voff(int row, int ch) { return 256 * row + 16 * (ch ^ (((row & 3) << 2) | ((row >> 2) & 3))); }
DI bf16x8 pack8(const f32x16& p, int s) {
    u32x4 w; w.x = pk2(p[8 * s + 0], p[8 * s + 1]); w.y = pk2(p[8 * s + 2], p[8 * s + 3]); w.z = pk2(p[8 * s + 4], p[8 * s + 5]); w.w = pk2(p[8 * s + 6], p[8 * s + 7]);
    return __builtin_bit_cast(bf16x8, w);
}
DI s16x4 vtr(const LAS unsigned char* p) { return __builtin_bit_cast(s16x4, __builtin_amdgcn_ds_read_tr16_b64_v4i16((LAS s16x4*)p)); }

template <int DKN, int DKR>
DI void attn_core(const AttnArgs& a, int q0, LAS unsigned char* lds, float scale, f32x16 (&o)[4]) {
    const int tid = opaque_tid(), wid = __builtin_amdgcn_readfirstlane(tid >> 6), lane = tid & 63, r32 = lane & 31, hi = lane >> 5;
    constexpr int CN = DKN / 8, NLK = CN * 64 / NTHREADS, KNB = 64 * DKN * 2, KRB = 64 * DKR * 2, VOFF = KNB + KRB, BUF = VOFF + 16384;
    static_assert(2 * BUF <= RING_BYTES, "attention LDS");
    bf16x8 qn[DKN / 16]; bf16x8 qr[DKR ? DKR / 16 : 1];
    {
        const bf16_t* qp = a.Qn + (size_t)(q0 + 32 * wid + r32) * a.ldq + hi * 8;
#pragma unroll
        for (int d0 = 0; d0 < DKN / 16; ++d0) qn[d0] = *(const bf16x8*)(qp + d0 * 16);
        if (DKR) { const bf16_t* qp2 = a.Qr + (size_t)(q0 + 32 * wid + r32) * a.ldq + hi * 8;
#pragma unroll
            for (int d0 = 0; d0 < DKR / 16; ++d0) qr[d0] = *(const bf16x8*)(qp2 + d0 * 16); }
    }
    const int NT = (q0 + 256) / 64, NTw = (q0 + 32 * wid + 31) / 64 + 1;
    u32x4 skn[NLK], skr, sv[2];
#define AT_LOAD(t) do { _Pragma("unroll") for (int i_ = 0; i_ < NLK; ++i_) { const int id_ = tid + NTHREADS * i_, row_ = id_ / CN, ch_ = id_ % CN; \
            skn[i_] = *(const u32x4*)(a.Kn + (size_t)((t) * 64 + row_) * a.ldkn + ch_ * 8); } \
        if (DKR) { const int row_ = tid >> 3, ch_ = tid & 7; skr = *(const u32x4*)(a.Kr + (size_t)((t) * 64 + row_) * a.ldkr + ch_ * 8); } \
        _Pragma("unroll") for (int i_ = 0; i_ < 2; ++i_) { const int id_ = tid + NTHREADS * i_, row_ = id_ >> 4, ch_ = id_ & 15; \
            sv[i_] = *(const u32x4*)(a.V + (size_t)((t) * 64 + row_) * a.ldv + ch_ * 8); } } while (0)
#define AT_WRITE(bf) do { LAS unsigned char* bb_ = lds + (bf) * BUF; \
        _Pragma("unroll") for (int i_ = 0; i_ < NLK; ++i_) { const int id_ = tid + NTHREADS * i_, row_ = id_ / CN, ch_ = id_ % CN; *(LAS u32x4*)(bb_ + koff<DKN>(row_, ch_)) = skn[i_]; } \
        if (DKR) { const int row_ = tid >> 3, ch_ = tid & 7; *(LAS u32x4*)(bb_ + KNB + koff<64>(row_, ch_)) = skr; } \
        _Pragma("unroll") for (int i_ = 0; i_ < 2; ++i_) { const int id_ = tid + NTHREADS * i_, row_ = id_ >> 4, ch_ = id_ & 15; *(LAS u32x4*)(bb_ + VOFF + voff(row_, ch_)) = sv[i_]; } } while (0)
    const float Cs = scale * 1.4426950408889634f;
    float m_run = -1e30f, l_run = 0.f;
#pragma unroll
    for (int blk = 0; blk < 4; ++blk)
#pragma unroll
        for (int r = 0; r < 16; ++r) o[blk][r] = 0.f;
    AT_LOAD(0); AT_WRITE(0); if (NT > 1) AT_LOAD(1);
    for (int t = 0; t < NT; ++t) {
        __syncthreads();
        if (t + 1 < NT) AT_WRITE((t + 1) & 1);
        if (t + 2 < NT) AT_LOAD(t + 2);
        if (t < NTw) {
            const LAS unsigned char* base = lds + (t & 1) * BUF;
            int r32v = r32, lanev = lane; asm volatile("" : "+v"(r32v), "+v"(lanev));
            int vb[4][2];
            {
                const int i = lanev & 15, q_ = i >> 2, p_ = i & 3, grp1 = (lanev >> 4) & 1, hv = lanev >> 5, low2 = 2 * grp1 + (p_ >> 1);
#pragma unroll
                for (int blk = 0; blk < 4; ++blk)
#pragma unroll
                    for (int x = 0; x < 2; ++x) vb[blk][x] = VOFF + 256 * (8 * x + 4 * hv + q_) + 16 * (4 * (blk ^ q_) + (low2 ^ (hv + 2 * x))) + 8 * (p_ & 1);
            }
            f32x16 p0, p1;
#pragma unroll
            for (int r = 0; r < 16; ++r) { p0[r] = 0.f; p1[r] = 0.f; }
#pragma unroll
            for (int d0 = 0; d0 < DKN / 16; ++d0) {
                const bf16x8 b0 = *(const LAS bf16x8*)(base + koff<DKN>(r32v, 2 * d0 + hi)), b1 = *(const LAS bf16x8*)(base + koff<DKN>(32 + r32v, 2 * d0 + hi));
                p0 = __builtin_amdgcn_mfma_f32_32x32x16_bf16(b0, qn[d0], p0, 0, 0, 0); p1 = __builtin_amdgcn_mfma_f32_32x32x16_bf16(b1, qn[d0], p1, 0, 0, 0);
            }
            if (DKR) {
#pragma unroll
                for (int d0 = 0; d0 < DKR / 16; ++d0) {
                    const bf16x8 b0 = *(const LAS bf16x8*)(base + KNB + koff<64>(r32v, 2 * d0 + hi)), b1 = *(const LAS bf16x8*)(base + KNB + koff<64>(32 + r32v, 2 * d0 + hi));
                    p0 = __builtin_amdgcn_mfma_f32_32x32x16_bf16(b0, qr[d0], p0, 0, 0, 0); p1 = __builtin_amdgcn_mfma_f32_32x32x16_bf16(b1, qr[d0], p1, 0, 0, 0);
                }
            }
            if (t == NTw - 1) {
                const int qrel = q0 + 32 * wid + r32 - 64 * t;
#pragma unroll
                for (int r = 0; r < 16; ++r) { const int kv = crow(r, hi); if (kv > qrel) p0[r] = -INFINITY; if (kv + 32 > qrel) p1[r] = -INFINITY; }
            }
            float pmax = p0[0];
#pragma unroll
            for (int r = 1; r < 16; ++r) pmax = fmaxf(pmax, p0[r]);
#pragma unroll
            for (int r = 0; r < 16; ++r) pmax = fmaxf(pmax, p1[r]);
            pmax = swap32_max(pmax);
            const float mn = fmaxf(m_run, pmax);
            const float alpha = __builtin_amdgcn_exp2f((m_run - mn) * Cs);
            m_run = mn;
            const float mnC = -mn * Cs;
            float ps = 0.f;
#pragma unroll
            for (int r = 0; r < 16; ++r) { p0[r] = __builtin_amdgcn_exp2f(fmaf(p0[r], Cs, mnC)); p1[r] = __builtin_amdgcn_exp2f(fmaf(p1[r], Cs, mnC)); ps += p0[r] + p1[r]; }
            l_run = l_run * alpha + ps;
            if (!__all(alpha == 1.0f)) {
#pragma unroll
                for (int blk = 0; blk < 4; ++blk)
#pragma unroll
                    for (int r = 0; r < 16; ++r) o[blk][r] *= alpha;
            }
            bf16x8 pb[4]; pb[0] = pack8(p0, 0); pb[1] = pack8(p0, 1); pb[2] = pack8(p1, 0); pb[3] = pack8(p1, 1);
#pragma unroll
            for (int blk = 0; blk < 4; ++blk) {
                s16x4 lo[4], hh[4];
#pragma unroll
                for (int ks = 0; ks < 4; ++ks) { lo[ks] = vtr(base + vb[blk][0] + 4096 * ks); hh[ks] = vtr(base + vb[blk][1] + 4096 * ks); }
#pragma unroll
                for (int ks = 0; ks < 4; ++ks) {
                    const bf16x8 af = {lo[ks][0], lo[ks][1], lo[ks][2], lo[ks][3], hh[ks][0], hh[ks][1], hh[ks][2], hh[ks][3]};
                    o[blk] = __builtin_amdgcn_mfma_f32_32x32x16_bf16(af, pb[ks], o[blk], 0, 0, 0);
                }
                __builtin_amdgcn_sched_barrier(0);
            }
        }
    }
    __syncthreads();
    const float linv = 1.0f / swap32_sum(l_run);
#pragma unroll
    for (int blk = 0; blk < 4; ++blk)
#pragma unroll
        for (int r = 0; r < 16; ++r) o[blk][r] *= linv;
#undef AT_LOAD
#undef AT_WRITE
}
DI void attn_store(const f32x16 (&o)[4], bf16_t* dst, int ld, int q0) {
    const int tid = opaque_tid(), wid = tid >> 6, lane = tid & 63, r32 = lane & 31, hi = lane >> 5;
    bf16_t* rp = dst + (size_t)(q0 + 32 * wid + r32) * ld;
#pragma unroll
    for (int blk = 0; blk < 4; ++blk)
#pragma unroll
        for (int g = 0; g < 4; ++g) {
            u32x2 w; w.x = pk2(o[blk][4 * g], o[blk][4 * g + 1]); w.y = pk2(o[blk][4 * g + 2], o[blk][4 * g + 3]);
            *(u32x2*)(rp + 32 * blk + 8 * g + 4 * hi) = w;
        }
}
DI int queue_pop(const Ctx& C0, unsigned* ctr, int total) {
    const Ctx C = fresh(C0);
    volatile LAS int* slot = (volatile LAS int*)(C.lds + LDSCTL_OFF + 64);
    __syncthreads();
    if (C.tid == 0) *slot = (int)__hip_atomic_fetch_add(ctr, 1u, __ATOMIC_RELAXED, __HIP_MEMORY_SCOPE_AGENT);
    __syncthreads();
    const int u = *slot;
    return u < total ? u : -1;
}
DI float diff_lambda(const Params& P) {
    float s1 = 0.f, s2 = 0.f;
    for (int i = 0; i < 64; ++i) { s1 += P.in[I_LQ1][i] * P.in[I_LK1][i]; s2 += P.in[I_LQ2][i] * P.in[I_LK2][i]; }
    return expf(s1) - expf(s2) + 0.2f;
}

#if FAST_ATTN
DI void phase_diff_attn(const Ctx& C0, const Params& P, int qi) {
    const Ctx C = fresh(C0);
    unsigned char* ws = P.ws;
    const bf16_t* proj = (const bf16_t*)(ws + P_PROJ); bf16_t* concat = (bf16_t*)(ws + P_CONCAT);
    unsigned* ctr = (unsigned*)(ws + WS_CTL) + CW_CTR + 64 * qi;
    const float lam = diff_lambda(P);
    const int NBH = BATCH * DIFF_HEADS, NS5 = BATCH * 32 / NWAVES, total = NS5 + NBH * 8;
    const int lane = C.lane, r32 = lane & 31, hi = lane >> 5;
    for (;;) {
        int u = queue_pop(C, ctr, total); if (u < 0) break;
        if (u < NS5) { phase_s5(C, P, u * NWAVES, u * NWAVES + NWAVES, 1, NWAVES); continue; }
        u -= NS5;
        const int qb = 7 - u / NBH, bh = u % NBH, b = bh / DIFF_HEADS, h = bh % DIFF_HEADS;
        const bf16_t* base = proj + (size_t)b * SEQ * AB_IN;
        AttnArgs a; a.ldq = AB_IN; a.ldkn = AB_IN; a.ldkr = 0; a.ldv = AB_IN; a.Qr = nullptr; a.Kr = nullptr;
        a.V = base + 2 * DIFF_W + h * 128;
        f32x16 o2[4];
        bf16_t* dst = concat + (size_t)b * SEQ * DM + h * 128;
        a.Qn = base + h * 128; a.Kn = base + DIFF_W + h * 128;
        attn_core<64, 0>(a, qb * 256, C.lds, 0.125f, o2);
        attn_store(o2, dst, DM, qb * 256);
        a.Qn = base + h * 128 + 64; a.Kn = base + DIFF_W + h * 128 + 64;
        attn_core<64, 0>(a, qb * 256, C.lds, 0.125f, o2);
        float ss = 0.f;
        {
            const bf16_t* rp = dst + (size_t)(qb * 256 + 32 * C.wave + r32) * DM;
#pragma unroll
            for (int blk = 0; blk < 4; ++blk)
#pragma unroll
                for (int g = 0; g < 4; ++g) {
                    const u32x2 w = *(const u32x2*)(rp + 32 * blk + 8 * g + 4 * hi);
                    const float o1v[4] = {bflo(w.x), bfhi(w.x), bflo(w.y), bfhi(w.y)};
#pragma unroll
                    for (int j = 0; j < 4; ++j) { const float v = o1v[j] - lam * o2[blk][4 * g + j]; o2[blk][4 * g + j] = v; ss += v * v; }
                }
        }
        ss = swap32_sum(ss);
        const float rs = rsqrtf(ss * (1.0f / 128.0f) + NORM_EPS) * 0.8f;
        const float* sub = P.in[I_SUBLN];
#pragma unroll
        for (int blk = 0; blk < 4; ++blk)
#pragma unroll
            for (int r = 0; r < 16; ++r) o2[blk][r] *= rs * sub[32 * blk + crow(r, hi)];
        attn_store(o2, dst, DM, qb * 256);
    }
}
DI void phase_mla_attn(const Ctx& C0, const Params& P, int qi) {
    const Ctx C = fresh(C0);
    unsigned char* ws = P.ws;
    const bf16_t* q = (const bf16_t*)(ws + P_Q); const bf16_t* kv = (const bf16_t*)(ws + P_KV); const bf16_t* kr = (const bf16_t*)(ws + P_KROPE);
    bf16_t* ob = (bf16_t*)(ws + P_H);
    unsigned* ctr = (unsigned*)(ws + WS_CTL) + CW_CTR + 64 * qi;
    const int NBH = BATCH * MLA_HEADS, total = NBH * 8;
    for (;;) {
        const int u = queue_pop(C, ctr, total); if (u < 0) break;
        const int qb = 7 - u / NBH, bh = u % NBH, b = bh / MLA_HEADS, h = bh % MLA_HEADS;
        AttnArgs a; a.ldq = 3072; a.ldkn = 4096; a.ldkr = 64; a.ldv = 4096;
        a.Qn = q + (size_t)b * SEQ * 3072 + h * 192; a.Qr = a.Qn + 128;
        a.Kn = kv + (size_t)b * SEQ * 4096 + h * 256; a.V = a.Kn + 128; a.Kr = kr + (size_t)b * SEQ * 64;
        f32x16 o[4];
        attn_core<128, 64>(a, qb * 256, C.lds, 0.07216878364870322f, o);
        attn_store(o, ob + (size_t)b * SEQ * DM + h * 128, DM, qb * 256);
    }
}
#else
template <int DK> DI void naive_attn_row(const bf16_t* qrow, const bf16_t* qrow2, const bf16_t* Kn, int ldkn, const bf16_t* Kr, int ldkr, const bf16_t* V, int ldv, int nkeys, float scale, int lane, float& o0, float& o1) {
    float qv[3];
#pragma unroll
    for (int j = 0; j < 3; ++j) { const int d = lane + 64 * j; qv[j] = 0.f; if (d < DK) qv[j] = (DK == 192 && d >= 128) ? bf2f(qrow2[d - 128]) : bf2f(qrow[d]); }
    float m = -1e30f, l = 0.f; o0 = 0.f; o1 = 0.f;
    for (int k = 0; k < nkeys; ++k) {
        float s = 0.f;
#pragma unroll
        for (int j = 0; j < 3; ++j) { const int d = lane + 64 * j; if (d < DK) { const float kvv = (DK == 192 && d >= 128) ? bf2f(Kr[(size_t)k * ldkr + d - 128]) : bf2f(Kn[(size_t)k * ldkn + d]); s += qv[j] * kvv; } }
        s = wave_sum(s) * scale;
        const float mn = fmaxf(m, s), al = expf(m - mn), p = expf(s - mn);
        m = mn; l = l * al + p;
        o0 = o0 * al + p * bf2f(V[(size_t)k * ldv + lane]); o1 = o1 * al + p * bf2f(V[(size_t)k * ldv + 64 + lane]);
    }
    o0 /= l; o1 /= l;
}
DI void phase_diff_attn(const Ctx& C, const Params& P, int) {
    unsigned char* ws = P.ws;
    const bf16_t* proj = (const bf16_t*)(ws + P_PROJ); bf16_t* concat = (bf16_t*)(ws + P_CONCAT);
    const float lam = diff_lambda(P);
    const int lane = C.lane;
    for (int it = C.blk * NWAVES + C.wave; it < BATCH * DIFF_HEADS * SEQ; it += C.G * NWAVES) {
        const int s = it % SEQ, bh = it / SEQ, b = bh / DIFF_HEADS, h = bh % DIFF_HEADS;
        const bf16_t* base = proj + (size_t)b * SEQ * AB_IN;
        const bf16_t* qrow = base + (size_t)s * AB_IN + h * 128;
        float a0, a1, b0, b1;
        naive_attn_row<64>(qrow, nullptr, base + DIFF_W + h * 128, AB_IN, nullptr, 0, base + 2 * DIFF_W + h * 128, AB_IN, s + 1, 0.125f, lane, a0, a1);
        naive_attn_row<64>(qrow + 64, nullptr, base + DIFF_W + h * 128 + 64, AB_IN, nullptr, 0, base + 2 * DIFF_W + h * 128, AB_IN, s + 1, 0.125f, lane, b0, b1);
        const float v0 = a0 - lam * b0, v1 = a1 - lam * b1;
        const float ss = wave_sum(v0 * v0 + v1 * v1);
        const float rs = rsqrtf(ss * (1.0f / 128.0f) + NORM_EPS) * 0.8f;
        bf16_t* orow = concat + (size_t)(b * SEQ + s) * DM + h * 128;
        orow[lane] = f2bf(v0 * rs * P.in[I_SUBLN][lane]); orow[64 + lane] = f2bf(v1 * rs * P.in[I_SUBLN][64 + lane]);
    }
}
DI void phase_mla_attn(const Ctx& C, const Params& P, int) {
    unsigned char* ws = P.ws;
    const bf16_t* q = (const bf16_t*)(ws + P_Q); const bf16_t* kv = (const bf16_t*)(ws + P_KV); const bf16_t* kr = (const bf16_t*)(ws + P_KROPE);
    bf16_t* ob = (bf16_t*)(ws + P_H);
    const int lane = C.lane;
    for (int it = C.blk * NWAVES + C.wave; it < BATCH * MLA_HEADS * SEQ; it += C.G * NWAVES) {
        const int s = it % SEQ, bh = it / SEQ, b = bh / MLA_HEADS, h = bh % MLA_HEADS;
        const bf16_t* qrow = q + (size_t)(b * SEQ + s) * 3072 + h * 192;
        const bf16_t* kn = kv + (size_t)b * SEQ * 4096 + h * 256;
        float a0, a1;
        naive_attn_row<192>(qrow, qrow + 128, kn, 4096, kr + (size_t)b * SEQ * 64, 64, kn + 128, 4096, s + 1, 0.07216878364870322f, lane, a0, a1);
        bf16_t* orow = ob + (size_t)(b * SEQ + s) * DM + h * 128;
        orow[lane] = f2bf(a0); orow[64 + lane] = f2bf(a1);
    }
}
#endif

DI void phase_mla_rows(const Ctx& C0, const Params& P) {
    const Ctx C = fresh(C0);
    unsigned char* ws = P.ws;
    const bf16_t* mp = (const bf16_t*)(ws + P_MLAPROJ); bf16_t* cqn = (bf16_t*)(ws + P_CQN); bf16_t* ckvn = (bf16_t*)(ws + P_CKVN); bf16_t* krp = (bf16_t*)(ws + P_KROPE);
    const f32x2* tab = (const f32x2*)(ws + WS_ROPE);
    const int lane = C.lane;
    for (int r = C.blk * NWAVES + C.wave; r < T; r += C.G * NWAVES) {
        const bf16_t* row = mp + (size_t)r * MLA_IN_PAD;
        float v[12]; float ss = 0.f;
#pragma unroll
        for (int j = 0; j < 3; ++j) { const u32x2 w = *(const u32x2*)(row + 4 * (lane + 64 * j)); v[4 * j] = bflo(w.x); v[4 * j + 1] = bfhi(w.x); v[4 * j + 2] = bflo(w.y); v[4 * j + 3] = bfhi(w.y); }
#pragma unroll
        for (int j = 0; j < 12; ++j) ss += v[j] * v[j];
        float sc = rsqrtf(wave_sum(ss) * (1.0f / MLA_QR) + NORM_EPS);
#pragma unroll
        for (int j = 0; j < 3; ++j) { const f32x4 g = *(const f32x4*)(P.in[I_MLA_QNORM] + 4 * (lane + 64 * j));
            u32x2 w; w.x = pk2(v[4 * j] * sc * g[0], v[4 * j + 1] * sc * g[1]); w.y = pk2(v[4 * j + 2] * sc * g[2], v[4 * j + 3] * sc * g[3]);
            *(u32x2*)(cqn + (size_t)r * MLA_QR + 4 * (lane + 64 * j)) = w; }
        {
            const u32x2 w = *(const u32x2*)(row + MLA_QR + 4 * lane);
            const float a0 = bflo(w.x), a1 = bfhi(w.x), a2 = bflo(w.y), a3 = bfhi(w.y);
            const float s2 = rsqrtf(wave_sum(a0 * a0 + a1 * a1 + a2 * a2 + a3 * a3) * (1.0f / MLA_KVR) + NORM_EPS);
            const f32x4 g = *(const f32x4*)(P.in[I_MLA_KVNORM] + 4 * lane);
            u32x2 o; o.x = pk2(a0 * s2 * g[0], a1 * s2 * g[1]); o.y = pk2(a2 * s2 * g[2], a3 * s2 * g[3]);
            *(u32x2*)(ckvn + (size_t)r * MLA_KVR + 4 * lane) = o;
        }
        if (lane < 32) {
            const unsigned w = *(const unsigned*)(row + 1024 + 2 * lane);
            int p = ((const int*)P.in[I_POS])[r]; p = p < 0 ? 0 : (p > ROPE_POS - 1 ? ROPE_POS - 1 : p);
            const f32x2 cs = tab[(size_t)p * 32 + lane];
            const float x1 = bflo(w), x2 = bfhi(w);
            *(unsigned*)(krp + (size_t)r * 64 + 2 * lane) = pk2(x1 * cs[0] - x2 * cs[1], x2 * cs[0] + x1 * cs[1]);
        }
    }
}

DI void phase_xa_softmax(const Ctx& C0, const Params& P) {
    const Ctx C = fresh(C0);
    unsigned char* ws = P.ws;
    const float* S = (const float*)(ws + P_S); bf16_t* Pb = (bf16_t*)(ws + P_P);
    const int lane = C.lane, hd = lane >> 4, li = lane & 15;
    for (int r = C.blk * NWAVES + C.wave; r < T; r += C.G * NWAVES) {
        const float* row = S + (size_t)r * 1024 + hd * 256;
        f32x4 v[4]; float mx = -1e30f;
#pragma unroll
        for (int j = 0; j < 4; ++j) { v[j] = *(const f32x4*)(row + 4 * (li + 16 * j)); mx = fmaxf(mx, fmaxf(fmaxf(v[j][0], v[j][1]), fmaxf(v[j][2], v[j][3]))); }
#pragma unroll
        for (int o = 1; o < 16; o <<= 1) mx = fmaxf(mx, __shfl_xor(mx, o));
        float sm = 0.f;
#pragma unroll
        for (int j = 0; j < 4; ++j) { v[j][0] = __expf(v[j][0] - mx); v[j][1] = __expf(v[j][1] - mx); v[j][2] = __expf(v[j][2] - mx); v[j][3] = __expf(v[j][3] - mx); sm += (v[j][0] + v[j][1]) + (v[j][2] + v[j][3]); }
#pragma unroll
        for (int o = 1; o < 16; o <<= 1) sm += __shfl_xor(sm, o);
        const float inv = 1.0f / sm;
        bf16_t* orow = Pb + (size_t)r * 1024 + hd * 256;
#pragma unroll
        for (int j = 0; j < 4; ++j) { u32x2 w; w.x = pk2(v[j][0] * inv, v[j][1] * inv); w.y = pk2(v[j][2] * inv, v[j][3] * inv); *(u32x2*)(orow + 4 * (li + 16 * j)) = w; }
    }
}

template <bool STORE> DI void phase_peer(const Ctx& C0, const Params& P) {
    const Ctx C = fresh(C0);
    unsigned char* ws = P.ws;
    const float* sc = (const float*)(ws + P_SC); const bf16_t* hb = (const bf16_t*)(ws + P_H);
    const bf16_t* ut = (const bf16_t*)(ws + P_UT); const bf16_t* vt = (const bf16_t*)(ws + P_VT);
    float* xo = P.out;
    LAS unsigned char* my = C.lds + C.wave * 4096;
    LAS float* top_s = (LAS float*)my;
    LAS int* top_i = (LAS int*)(my + 1024);
    LAS int* best_e = (LAS int*)(my + 2048);
    LAS float* best_g = (LAS float*)(my + 2560);
    LAS float* best_s = (LAS float*)(my + 3072);
    LAS int* best_p = (LAS int*)(my + 3584);
    const int lane = C.lane;
    for (int tok = C.blk * NWAVES + C.wave; tok < T; tok += C.G * NWAVES) {
        for (int rep = 0; rep < (PROBE == 6 ? 2 : 1); ++rep) {
        {
            const int g = lane >> 2, qd = lane & 3;
            unsigned k[32];
            const f32x4* sp = (const f32x4*)(sc + (size_t)tok * 2048 + g * 128 + qd * 32);
#pragma unroll
            for (int j = 0; j < 8; ++j) { const f32x4 x = sp[j];
#pragma unroll
                for (int e = 0; e < 4; ++e) { unsigned u = __float_as_uint(x[e]); u ^= (unsigned)((int)u >> 31) | 0x80000000u; k[4 * j + e] = (u & ~127u) | (unsigned)(127 - (32 * qd + 4 * j + e)); } }
#pragma unroll
            for (int r = 0; r < 16; ++r) {
                unsigned m = k[0];
#pragma unroll
                for (int j = 1; j < 32; ++j) m = m > k[j] ? m : k[j];
                { const unsigned o1 = (unsigned)__shfl_xor((int)m, 1); m = m > o1 ? m : o1; const unsigned o2 = (unsigned)__shfl_xor((int)m, 2); m = m > o2 ? m : o2; }
                if (qd == 0) top_i[g * 16 + r] = 127 - (int)(m & 127u);
#pragma unroll
                for (int j = 0; j < 32; ++j) k[j] = (k[j] == m) ? 0u : k[j];
            }
        }
        LDS_WAIT(); asm volatile("" ::: "memory");
#pragma unroll
        for (int i = 0; i < 4; ++i) { const int e = lane + 64 * i; top_s[e] = sc[(size_t)tok * 2048 + (e >> 4) * 128 + top_i[e]]; }
        LDS_WAIT(); asm volatile("" ::: "memory");
        {
            const int h = lane >> 3, sub = lane & 7;
            unsigned k[32];
            const float s00 = top_s[(2 * h) * 16 + 2 * sub], s01 = top_s[(2 * h) * 16 + 2 * sub + 1];
#pragma unroll
            for (int k2 = 0; k2 < 16; ++k2) { const float s1 = top_s[(2 * h + 1) * 16 + k2];
                unsigned u0 = __float_as_uint(s00 + s1), u1 = __float_as_uint(s01 + s1);
                u0 ^= (unsigned)((int)u0 >> 31) | 0x80000000u; u1 ^= (unsigned)((int)u1 >> 31) | 0x80000000u;
                k[k2] = (u0 & ~255u) | (unsigned)(255 - (32 * sub + k2)); k[16 + k2] = (u1 & ~255u) | (unsigned)(255 - (32 * sub + 16 + k2)); }
#pragma unroll
            for (int r = 0; r < 16; ++r) {
                unsigned m = k[0];
#pragma unroll
                for (int j = 1; j < 32; ++j) m = m > k[j] ? m : k[j];
                { const unsigned o1 = (unsigned)__shfl_xor((int)m, 1); m = m > o1 ? m : o1; const unsigned o2 = (unsigned)__shfl_xor((int)m, 2); m = m > o2 ? m : o2; const unsigned o4 = (unsigned)__shfl_xor((int)m, 4); m = m > o4 ? m : o4; }
                if (sub == 0) best_p[h * 16 + r] = 255 - (int)(m & 255u);
#pragma unroll
                for (int j = 0; j < 32; ++j) k[j] = (k[j] == m) ? 0u : k[j];
            }
        }
        LDS_WAIT(); asm volatile("" ::: "memory");
#pragma unroll
        for (int e2 = 0; e2 < 2; ++e2) { const int idx = lane + 64 * e2, h = idx >> 4, pos = best_p[idx]; best_s[idx] = top_s[(2 * h) * 16 + (pos >> 4)] + top_s[(2 * h + 1) * 16 + (pos & 15)]; }
        LDS_WAIT(); asm volatile("" ::: "memory");
#pragma unroll
        for (int e2 = 0; e2 < 2; ++e2) {
            const int idx = lane + 64 * e2, h = idx >> 4;
            float mx = -1e30f;
            for (int k = 0; k < 16; ++k) mx = fmaxf(mx, best_s[h * 16 + k]);
            float sm = 0.f;
            for (int k = 0; k < 16; ++k) sm += __expf(best_s[h * 16 + k] - mx);
            const float gate = __expf(best_s[idx] - mx) / sm;
            const int pos = best_p[idx], k1 = pos >> 4, k2 = pos & 15;
            best_e[idx] = top_i[(2 * h) * 16 + k1] * 128 + top_i[(2 * h + 1) * 16 + k2];
            best_g[idx] = gate;
        }
        LDS_WAIT(); asm volatile("" ::: "memory");
        }
#if PEER_SLICED
        {
            int* pe = (int*)(ws + P_PE_E) + (size_t)tok * 128; float* pg = (float*)(ws + P_PE_G) + (size_t)tok * 128;
            pe[lane] = best_e[lane]; pe[64 + lane] = best_e[64 + lane]; pg[lane] = best_g[lane]; pg[64 + lane] = best_g[64 + lane];
            const u32x4* tp = (const u32x4*)((const bf16_t*)(ws + P_XB) + (size_t)tok * DM + 32 * lane);
            u32x4 tw[4]; float am = 0.f;
#pragma unroll
            for (int i = 0; i < 4; ++i) { tw[i] = tp[i]; const unsigned w4[4] = {tw[i].x, tw[i].y, tw[i].z, tw[i].w};
#pragma unroll
                for (int q = 0; q < 4; ++q) am = fmaxf(am, fmaxf(fabsf(bflo(w4[q])), fabsf(bfhi(w4[q])))); }
#pragma unroll
            for (int o = 1; o < 64; o <<= 1) am = fmaxf(am, __shfl_xor(am, o));
            const float tscale = am > 0.f ? 127.0f / am : 0.f;
            if (lane == 0) ((float*)(ws + P_PE_TSC))[tok] = am * (1.0f / 127.0f) * row_rstd<32>((const float*)(ws + P_SS), tok);
            unsigned qd[8];
#pragma unroll
            for (int i = 0; i < 4; ++i) { const unsigned w4[4] = {tw[i].x, tw[i].y, tw[i].z, tw[i].w};
#pragma unroll
                for (int h2 = 0; h2 < 2; ++h2) { const int q0 = (int)rintf(bflo(w4[2 * h2]) * tscale), q1 = (int)rintf(bfhi(w4[2 * h2]) * tscale), q2 = (int)rintf(bflo(w4[2 * h2 + 1]) * tscale), q3 = (int)rintf(bfhi(w4[2 * h2 + 1]) * tscale);
                    qd[2 * i + h2] = (unsigned)(q0 & 255) | ((unsigned)(q1 & 255) << 8) | ((unsigned)(q2 & 255) << 16) | ((unsigned)(q3 & 255) << 24); } }
            u32x4* t8p = (u32x4*)(ws + P_PE_T8 + (size_t)tok * DM + 32 * lane);
            t8p[0] = (u32x4){qd[0], qd[1], qd[2], qd[3]}; t8p[1] = (u32x4){qd[4], qd[5], qd[6], qd[7]};
        }
#else
#if PEER_FP8
        float tf[32];
#pragma unroll
        for (int i = 0; i < 2; ++i) { const u32x4* tp = (const u32x4*)(hb + (size_t)tok * DM + 16 * (lane + 64 * i));
            const u32x4 a = tp[0], b = tp[1];
            tf[16 * i + 0] = bflo(a.x); tf[16 * i + 1] = bfhi(a.x); tf[16 * i + 2] = bflo(a.y); tf[16 * i + 3] = bfhi(a.y); tf[16 * i + 4] = bflo(a.z); tf[16 * i + 5] = bfhi(a.z); tf[16 * i + 6] = bflo(a.w); tf[16 * i + 7] = bfhi(a.w);
            tf[16 * i + 8] = bflo(b.x); tf[16 * i + 9] = bfhi(b.x); tf[16 * i + 10] = bflo(b.y); tf[16 * i + 11] = bfhi(b.y); tf[16 * i + 12] = bflo(b.z); tf[16 * i + 13] = bfhi(b.z); tf[16 * i + 14] = bflo(b.w); tf[16 * i + 15] = bfhi(b.w); }
        const unsigned char* ut8 = (const unsigned char*)ut; const unsigned char* vt8 = (const unsigned char*)vt;
        const float* usc = (const float*)(ut8 + 32 * MiB); const float* vsc = (const float*)(vt8 + 32 * MiB);
        for (int k0 = 0; k0 < 128; k0 += 8) {
            u32x4 rw[8][2];
#pragma unroll
            for (int kk = 0; kk < 8; ++kk) { const int e = __builtin_amdgcn_readfirstlane(best_e[k0 + kk]); const unsigned char* rp = ut8 + (size_t)e * DM;
#pragma unroll
                for (int i = 0; i < 2; ++i) rw[kk][i] = *(const u32x4*)(rp + 16 * (lane + 64 * i)); }
            float d[8];
#pragma unroll
            for (int kk = 0; kk < 8; ++kk) { float s0 = 0.f, s1 = 0.f;
#pragma unroll
                for (int i = 0; i < 2; ++i) {
                    const unsigned w4[4] = {rw[kk][i].x, rw[kk][i].y, rw[kk][i].z, rw[kk][i].w};
#pragma unroll
                    for (int q = 0; q < 4; ++q) { const f32x2 lo = __builtin_amdgcn_cvt_pk_f32_fp8((int)w4[q], false), hi2 = __builtin_amdgcn_cvt_pk_f32_fp8((int)w4[q], true);
                        s0 = fmaf(lo[0], tf[16 * i + 4 * q], s0); s1 = fmaf(lo[1], tf[16 * i + 4 * q + 1], s1); s0 = fmaf(hi2[0], tf[16 * i + 4 * q + 2], s0); s1 = fmaf(hi2[1], tf[16 * i + 4 * q + 3], s1); }
                }
                d[kk] = s0 + s1; }
            float n4[4], n2[2], r1;
            { const bool b0 = lane & 1;
#pragma unroll
              for (int j = 0; j < 4; ++j) { const float snd = b0 ? d[j] : d[4 + j], kp = b0 ? d[4 + j] : d[j]; n4[j] = kp + __shfl_xor(snd, 1); } }
            { const bool b1 = lane & 2;
#pragma unroll
              for (int j = 0; j < 2; ++j) { const float snd = b1 ? n4[j] : n4[2 + j], kp = b1 ? n4[2 + j] : n4[j]; n2[j] = kp + __shfl_xor(snd, 2); } }
            { const bool b2 = lane & 4; const float snd = b2 ? n2[0] : n2[1], kp = b2 ? n2[1] : n2[0]; r1 = kp + __shfl_xor(snd, 4); }
            r1 += __shfl_xor(r1, 8); r1 += __shfl_xor(r1, 16); r1 += __shfl_xor(r1, 32);
            if (lane < 8) { const int idx = k0 + 4 * (lane & 1) + 2 * ((lane >> 1) & 1) + ((lane >> 2) & 1); const float act = r1 * usc[best_e[idx]]; best_g[idx] *= gelu_erf(act); }
        }
        LDS_WAIT(); asm volatile("" ::: "memory");
        float acc[32];
#pragma unroll
        for (int j = 0; j < 32; ++j) acc[j] = 0.f;
        for (int k0 = 0; k0 < 128; k0 += 8) {
            u32x4 rw[8][2]; float wk[8];
#pragma unroll
            for (int kk = 0; kk < 8; ++kk) { const int e = __builtin_amdgcn_readfirstlane(best_e[k0 + kk]); wk[kk] = best_g[k0 + kk] * vsc[e]; const unsigned char* rp = vt8 + (size_t)e * DM;
#pragma unroll
                for (int i = 0; i < 2; ++i) rw[kk][i] = *(const u32x4*)(rp + 16 * (lane + 64 * i)); }
#pragma unroll
            for (int kk = 0; kk < 8; ++kk)
#pragma unroll
                for (int i = 0; i < 2; ++i) {
                    const unsigned w4[4] = {rw[kk][i].x, rw[kk][i].y, rw[kk][i].z, rw[kk][i].w};
#pragma unroll
                    for (int q = 0; q < 4; ++q) { const f32x2 lo = __builtin_amdgcn_cvt_pk_f32_fp8((int)w4[q], false), hi2 = __builtin_amdgcn_cvt_pk_f32_fp8((int)w4[q], true);
                        acc[16 * i + 4 * q] = fmaf(wk[kk], lo[0], acc[16 * i + 4 * q]); acc[16 * i + 4 * q + 1] = fmaf(wk[kk], lo[1], acc[16 * i + 4 * q + 1]);
                        acc[16 * i + 4 * q + 2] = fmaf(wk[kk], hi2[0], acc[16 * i + 4 * q + 2]); acc[16 * i + 4 * q + 3] = fmaf(wk[kk], hi2[1], acc[16 * i + 4 * q + 3]); }
                }
        }
#else
        u32x4 tv[4];
#pragma unroll
        for (int i = 0; i < 4; ++i) tv[i] = *(const u32x4*)(hb + (size_t)tok * DM + 8 * (lane + 64 * i));
        for (int k0 = 0; k0 < 128; k0 += 4) {
            u32x4 rw[4][4];
#pragma unroll
            for (int kk = 0; kk < 4; ++kk) { const int e = __builtin_amdgcn_readfirstlane(best_e[k0 + kk]); const bf16_t* rp = ut + (size_t)e * DM;
#pragma unroll
                for (int i = 0; i < 4; ++i) rw[kk][i] = *(const u32x4*)(rp + 8 * (lane + 64 * i)); }
            float d[4];
#pragma unroll
            for (int kk = 0; kk < 4; ++kk) { float s = 0.f;
#pragma unroll
                for (int i = 0; i < 4; ++i) { s = dot2bf(rw[kk][i].x, tv[i].x, s); s = dot2bf(rw[kk][i].y, tv[i].y, s); s = dot2bf(rw[kk][i].z, tv[i].z, s); s = dot2bf(rw[kk][i].w, tv[i].w, s); }
                d[kk] = wave_sum(s); }
            if (lane < 4) { const float act = lane == 0 ? d[0] : lane == 1 ? d[1] : lane == 2 ? d[2] : d[3]; best_g[k0 + lane] *= gelu_erf(act); }
        }
        LDS_WAIT(); asm volatile("" ::: "memory");
        float acc[32];
#pragma unroll
        for (int j = 0; j < 32; ++j) acc[j] = 0.f;
        for (int k0 = 0; k0 < 128; k0 += 4) {
            u32x4 rw[4][4]; float wk[4];
#pragma unroll
            for (int kk = 0; kk < 4; ++kk) { const int e = __builtin_amdgcn_readfirstlane(best_e[k0 + kk]); wk[kk] = best_g[k0 + kk]; const bf16_t* rp = vt + (size_t)e * DM;
#pragma unroll
                for (int i = 0; i < 4; ++i) rw[kk][i] = *(const u32x4*)(rp + 8 * (lane + 64 * i)); }
#pragma unroll
            for (int kk = 0; kk < 4; ++kk)
#pragma unroll
                for (int i = 0; i < 4; ++i) {
                    acc[8 * i + 0] = fmaf(wk[kk], bflo(rw[kk][i].x), acc[8 * i + 0]); acc[8 * i + 1] = fmaf(wk[kk], bfhi(rw[kk][i].x), acc[8 * i + 1]);
                    acc[8 * i + 2] = fmaf(wk[kk], bflo(rw[kk][i].y), acc[8 * i + 2]); acc[8 * i + 3] = fmaf(wk[kk], bfhi(rw[kk][i].y), acc[8 * i + 3]);
                    acc[8 * i + 4] = fmaf(wk[kk], bflo(rw[kk][i].z), acc[8 * i + 4]); acc[8 * i + 5] = fmaf(wk[kk], bfhi(rw[kk][i].z), acc[8 * i + 5]);
                    acc[8 * i + 6] = fmaf(wk[kk], bflo(rw[kk][i].w), acc[8 * i + 6]); acc[8 * i + 7] = fmaf(wk[kk], bfhi(rw[kk][i].w), acc[8 * i + 7]);
                }
        }
#endif
        float* xr = xo + (size_t)tok * DM;
        if (!STORE) {
#pragma unroll
            for (int j = 0; j < 32; ++j) asm volatile("" :: "v"(acc[j]));
        } else {
#if PEER_FP8
#pragma unroll
            for (int i = 0; i < 2; ++i) { f32x4* p = (f32x4*)(xr + 16 * (lane + 64 * i));
#pragma unroll
                for (int q = 0; q < 4; ++q) { f32x4 a = p[q]; a[0] += acc[16 * i + 4 * q]; a[1] += acc[16 * i + 4 * q + 1]; a[2] += acc[16 * i + 4 * q + 2]; a[3] += acc[16 * i + 4 * q + 3]; p[q] = a; } }
#else
#pragma unroll
            for (int i = 0; i < 4; ++i) { f32x4* p = (f32x4*)(xr + 8 * (lane + 64 * i));
                f32x4 a = p[0], b = p[1];
                a[0] += acc[8 * i]; a[1] += acc[8 * i + 1]; a[2] += acc[8 * i + 2]; a[3] += acc[8 * i + 3];
                b[0] += acc[8 * i + 4]; b[1] += acc[8 * i + 5]; b[2] += acc[8 * i + 6]; b[3] += acc[8 * i + 7];
                p[0] = a; p[1] = b; }
#endif
        }
#endif
        LDS_WAIT(); asm volatile("" ::: "memory");
    }
}


#if PEER_SLICED
DI int peer_cj(int j) { return ((j >> 3) & 1) | (((j >> 2) & 1) << 1) | (((j >> 1) & 1) << 2); }
constexpr int PEER_CHUNK = 128, PEER_NCHUNK = T / PEER_CHUNK;
DI int peer_cjh(int half, int jj) { return half | (((jj >> 2) & 1) << 1) | (((jj >> 1) & 1) << 2); }
#define PEER_ISSUE(RW, ELO, EHI, HALF) do { _Pragma("unroll") for (int jj = 0; jj < 8; ++jj) { \
        const int e_ = __shfl((jj & 1) ? (EHI) : (ELO), (lane & ~7) | peer_cjh((HALF), jj)); \
        RW[jj] = *(const u32x4*)(tabs + (size_t)(MODE == 2 ? (e_ & 1) : e_) * 128); } } while (0)
template <int SIDE  , int MODE = 0  >
DI void phase_peer_sliced(const Ctx& C0, const Params& P, int qbase) {
    const Ctx C = fresh(C0);
    unsigned char* ws = P.ws;
    const bf16_t* hb = (const bf16_t*)(ws + P_H);
    const unsigned char* tab8 = ws + (SIDE == 0 ? P_UT : P_VT);
    const int* pe = (const int*)(ws + P_PE_E); const float* pg = (const float*)(ws + P_PE_G);
    const int lane = C.lane, a = lane >> 3, c = lane & 7;
    const int x = (int)(xb_xcc_id() & 7u);
    for (int i = 0; i < 16; ++i) {
        const int s = ((x + (i >> 1)) & 7) + 8 * (i & 1);
        unsigned* ctr = (unsigned*)(ws + WS_CTL) + CW_CTR + 64 * (qbase + s);
        const unsigned char* tabs = tab8 + (size_t)s * ((size_t)PEER_NE * 128) + 16 * c;
        for (;;) {
            const int ch = queue_pop(C, ctr, PEER_NCHUNK); if (ch < 0) break;
            const int tok0 = ch * PEER_CHUNK + C.wave;
            constexpr int NTOK = PEER_CHUNK / NWAVES;
            u32x4 rwA[8], rwB[8];
            int e_lo = pe[(size_t)tok0 * 128 + lane], e_hi = pe[(size_t)tok0 * 128 + 64 + lane];
            u32x4 ta, tb; float w_lo = 0.f, w_hi = 0.f;
            if (SIDE == 0) { ta = *(const u32x4*)(ws + P_PE_T8 + (size_t)tok0 * DM + s * 128 + 16 * c); tb = ta; }
            else { w_lo = pg[(size_t)tok0 * 128 + lane]; w_hi = pg[(size_t)tok0 * 128 + 64 + lane]; }
            PEER_ISSUE(rwA, e_lo, e_hi, 0);
#pragma unroll 1
            for (int it = 0; it < NTOK; ++it) {
                const int tok = tok0 + NWAVES * it, ntok = (it + 1 < NTOK) ? tok + NWAVES : tok;
                unsigned* xp = (unsigned*)((bf16_t*)(ws + P_XB) + (size_t)tok * DM + s * 128 + 16 * c + 8 * (a & 1) + 4 * ((a >> 1) & 1) + 2 * ((a >> 2) & 1));
                unsigned xw = 0u; if (SIDE == 1) xw = *xp;
                const int ne_lo = pe[(size_t)ntok * 128 + lane], ne_hi = pe[(size_t)ntok * 128 + 64 + lane];
                u32x4 nta, ntb; float nw_lo = 0.f, nw_hi = 0.f;
                if (SIDE == 0) { nta = *(const u32x4*)(ws + P_PE_T8 + (size_t)ntok * DM + s * 128 + 16 * c); ntb = nta; }
                else { nw_lo = pg[(size_t)ntok * 128 + lane]; nw_hi = pg[(size_t)ntok * 128 + 64 + lane]; }
                PEER_ISSUE(rwB, e_lo, e_hi, 1);
                if (SIDE == 0) {
                    int d[16];
#define PEER_DOT(RW, HALF) do { _Pragma("unroll") for (int jj = 0; jj < 8; ++jj) { int s0 = __builtin_amdgcn_sdot4((int)RW[jj].x, (int)ta.x, 0, false); s0 = __builtin_amdgcn_sdot4((int)RW[jj].y, (int)ta.y, s0, false); \
                        s0 = __builtin_amdgcn_sdot4((int)RW[jj].z, (int)ta.z, s0, false); s0 = __builtin_amdgcn_sdot4((int)RW[jj].w, (int)ta.w, s0, false); d[8 * (HALF) + jj] = s0; } } while (0)
                    if (MODE == 1) { _Pragma("unroll") for (int jj = 0; jj < 8; ++jj) { asm volatile("" :: "v"(rwA[jj])); d[jj] = 0; d[8 + jj] = 0; } } else PEER_DOT(rwA, 0);
                    PEER_ISSUE(rwA, ne_lo, ne_hi, 0);
                    if (MODE == 1) { _Pragma("unroll") for (int jj = 0; jj < 8; ++jj) asm volatile("" :: "v"(rwB[jj])); } else PEER_DOT(rwB, 1);
#undef PEER_DOT
                    int n8[8], n4[4], n2[2];
                    { const bool b = c & 1;
#pragma unroll
                      for (int j = 0; j < 8; ++j) { const int snd = b ? d[j] : d[8 + j], kp = b ? d[8 + j] : d[j]; n8[j] = kp + __shfl_xor(snd, 1); } }
                    { const bool b = c & 2;
#pragma unroll
                      for (int j = 0; j < 4; ++j) { const int snd = b ? n8[j] : n8[4 + j], kp = b ? n8[4 + j] : n8[j]; n4[j] = kp + __shfl_xor(snd, 2); } }
                    { const bool b = c & 4;
#pragma unroll
                      for (int j = 0; j < 2; ++j) { const int snd = b ? n4[j] : n4[2 + j], kp = b ? n4[2 + j] : n4[j]; n2[j] = kp + __shfl_xor(snd, 4); } }
                    int* pp = (int*)(ws + P_SC) + ((size_t)s * T + tok) * 128;
                    pp[lane] = n2[0]; pp[64 + lane] = n2[1];
                } else {
                    float acc[16];
#pragma unroll
                    for (int q = 0; q < 16; ++q) acc[q] = 0.f;
#define PEER_AXPY(RW, HALF) do { _Pragma("unroll") for (int jj = 0; jj < 8; ++jj) { const float wj = __shfl((jj & 1) ? w_hi : w_lo, (lane & ~7) | peer_cjh((HALF), jj)); \
                        unsigned w4[4] = {RW[jj].x, RW[jj].y, RW[jj].z, RW[jj].w}; \
                        asm volatile("" : "+v"(w4[0]), "+v"(w4[1]), "+v"(w4[2]), "+v"(w4[3]) : "v"(acc[0]), "v"(acc[15]));     \
                        _Pragma("unroll") for (int q = 0; q < 4; ++q) { const f32x2 lo = __builtin_amdgcn_cvt_pk_f32_fp8((int)w4[q], false), hi2 = __builtin_amdgcn_cvt_pk_f32_fp8((int)w4[q], true); \
                            acc[4 * q] = fmaf(wj, lo[0], acc[4 * q]); acc[4 * q + 1] = fmaf(wj, lo[1], acc[4 * q + 1]); acc[4 * q + 2] = fmaf(wj, hi2[0], acc[4 * q + 2]); acc[4 * q + 3] = fmaf(wj, hi2[1], acc[4 * q + 3]); } } } while (0)
                    if (MODE == 1) { _Pragma("unroll") for (int jj = 0; jj < 8; ++jj) asm volatile("" :: "v"(rwA[jj])); } else PEER_AXPY(rwA, 0);
                    PEER_ISSUE(rwA, ne_lo, ne_hi, 0);
                    if (MODE == 1) { _Pragma("unroll") for (int jj = 0; jj < 8; ++jj) asm volatile("" :: "v"(rwB[jj])); } else PEER_AXPY(rwB, 1);
#undef PEER_AXPY
                    float n8[8], n4[4], n2[2];
                    { const bool b = a & 1;
#pragma unroll
                      for (int q = 0; q < 8; ++q) { const float snd = b ? acc[q] : acc[8 + q], kp = b ? acc[8 + q] : acc[q]; n8[q] = kp + __shfl_xor(snd, 8); } }
                    { const bool b = a & 2;
#pragma unroll
                      for (int q = 0; q < 4; ++q) { const float snd = b ? n8[q] : n8[4 + q], kp = b ? n8[4 + q] : n8[q]; n4[q] = kp + __shfl_xor(snd, 16); } }
                    { const bool b = a & 4;
#pragma unroll
                      for (int q = 0; q < 2; ++q) { const float snd = b ? n4[q] : n4[2 + q], kp = b ? n4[2 + q] : n4[q]; n2[q] = kp + __shfl_xor(snd, 32); } }
                    const unsigned nw = pk2(bflo(xw) + n2[0], bfhi(xw) + n2[1]);
                    if (MODE == 0) { *xp = nw; const float q0 = bflo(nw), q1 = bfhi(nw); const float sq = wave_sum(q0 * q0 + q1 * q1); if (lane == 0) ((float*)(ws + P_SS))[(size_t)tok * 32 + s] = sq; }
                    else asm volatile("" :: "v"(nw));
                }
                e_lo = ne_lo; e_hi = ne_hi;
                if (SIDE == 0) { ta = nta; tb = ntb; } else { w_lo = nw_lo; w_hi = nw_hi; }
            }
        }
    }
}
#undef PEER_ISSUE

DI void phase_peer_combine(const Ctx& C0, const Params& P) {
    const Ctx C = fresh(C0);
    unsigned char* ws = P.ws;
    const float* usc = (const float*)(ws + P_UT + 32 * MiB); const float* vsc = (const float*)(ws + P_VT + 32 * MiB);
    const int* pe = (const int*)(ws + P_PE_E); float* pg = (float*)(ws + P_PE_G); const int* part = (const int*)(ws + P_SC); const float* tsc = (const float*)(ws + P_PE_TSC);
    for (size_t i = (size_t)C.blk * NTHREADS + C.tid; i < (size_t)T * 128; i += (size_t)C.G * NTHREADS) {
        int a = 0;
#pragma unroll
        for (int s = 0; s < 16; ++s) a += part[(size_t)s * T * 128 + i];
        const int e = pe[i];
        pg[i] = pg[i] * gelu_erf((float)a * usc[e] * tsc[i >> 7]) * vsc[e];
    }
}
#endif

constexpr int N_PHASES = 39;
__global__ void __launch_bounds__(NTHREADS, 2) mk_fwd(Params P) {
    extern __shared__ __attribute__((aligned(16))) unsigned char lds_raw[];
    Ctx C; C.lds = (LAS unsigned char*)lds_raw; C.tid = threadIdx.x; C.lane = C.tid & 63; C.wave = __builtin_amdgcn_readfirstlane(C.tid >> 6); C.blk = blockIdx.x; C.G = gridDim.x;
    unsigned char* ws = P.ws;
    for (int u = C.tid; u < (LDS_BYTES - LDSCTL_OFF) / 4; u += NTHREADS) ((LAS unsigned*)(C.lds + LDSCTL_OFF))[u] = 0u;
    __syncthreads();
    XcdBarrier bar; bar.bar = (unsigned*)(ws + WS_CTL) + CW_BAR; bar.x = 0; bar.st = nullptr;
    const bool one = (P.ph_hi - P.ph_lo) > 1;
    if (one) bar = xcd_barrier_post((unsigned*)(ws + WS_CTL) + CW_BAR, (volatile LAS unsigned*)(C.lds + LDSCTL_OFF));
    const int lo = P.ph_lo, hi = P.ph_hi;
#define IN(k) (lo <= (k) && (k) < hi)
#define SEAM(k) do { if (IN(k) && IN((k) + 1)) xcd_barrier(bar); } while (0)
    bf16_t* hbuf = (bf16_t*)(ws + P_H); bf16_t* xb = (bf16_t*)(ws + P_XB); float* ssp = (float*)(ws + P_SS);
    const int* pos = (const int*)P.in[I_POS];
    const f32x2* rtab = (const f32x2*)(ws + WS_ROPE);

    if (IN(0)) { if (EN_PRO) phase_prologue(C, P); rms_rows_2048(C, P.in[I_X], P.in[I_AB_NORM], hbuf, T); } SEAM(0);
    if (IN(1)) {
        {
            g8::Desc g{(const bf16_t*)(ws + P_MEMN), (const bf16_t*)(ws + WS_LW + LW_XKV), DM, DM, DM, MT / 256, DM / 256, 2, 1, (long)MT * DM, 0, (long)(LW_STRIDE / 2), 0};
            EpiBf16 E{(bf16_t*)(ws + WS_KVX), DM, (long)(KVX_STRIDE / 2), 0, 1.0f, nullptr};
            if (PROBE == 1) { EpiNull En; g8::gemm(C.lds, g, En, C.G, C.blk); } if (GSITE < 0 || GSITE == 1) g8::gemm(C.lds, g, E, C.G, C.blk);
        }
        {
            g8::Desc g{(const bf16_t*)(ws + WS_LW + LW_XKV) + (size_t)DM * DM, (const bf16_t*)(ws + P_MEMN), DM, DM, DM, DM / 256, MT / 256, 2, 1, (long)(LW_STRIDE / 2), 0, (long)MT * DM, 0};
            EpiBf16 E{(bf16_t*)(ws + WS_KVX + 16 * MiB), MT, (long)(KVX_STRIDE / 2), 0, 1.0f, nullptr};
            if (PROBE == 1) { EpiNull En; g8::gemm(C.lds, g, En, C.G, C.blk); } if (GSITE < 0 || GSITE == 2) g8::gemm(C.lds, g, E, C.G, C.blk);
        }
        {
            g8::Desc g{(const bf16_t*)(ws + P_SK), (const bf16_t*)(ws + P_WQB), 256, DM, 256, 1, DM / 256, 2, 8, 8L * 65536, 65536, (long)DM * DM, 256};
            EpiBf16 E{(bf16_t*)(ws + WS_LW + LW_PEER), DM, (long)(LW_STRIDE / 2), 256L * DM, 1.0f, nullptr};
            if (PROBE == 1) { EpiNull En; g8::gemm(C.lds, g, En, C.G, C.blk); } if (GSITE < 0 || GSITE == 3) g8::gemm(C.lds, g, E, C.G, C.blk);
        }
        {
        g8::Desc g{hbuf, (const bf16_t*)(ws + WS_ABIN_T), DM, DM, DM, T / 256, AB_IN / 256, 1, 1, 0, 0, 0, 0};
        EpiRope<0> E{(bf16_t*)(ws + P_PROJ), AB_IN, pos, rtab};
        if (PROBE == 1) { EpiNull En; g8::gemm(C.lds, g, En, C.G, C.blk); } if (GSITE < 0 || GSITE == 4) g8::gemm(C.lds, g, E, C.G, C.blk);
        }
    }
    SEAM(1);

    {
        constexpr int l = 0, pb = 2; (void)l;

            if (IN(pb + 3)) { if (EN_DIFF) { if (PROBE == 2) phase_diff_attn(C, P, 2); phase_diff_attn(C, P, 0); } }
            SEAM(pb + 3);
            if (IN(pb + 4)) {
                g8::Desc g{(const bf16_t*)(ws + P_GBUF), (const bf16_t*)(ws + WS_GLU_T), S5_W, S5_W, S5_W, T / 256, S5_W / 256, 1, 1, 0, 0, 0, 0};
                EpiGlu E{(const bf16_t*)(ws + P_GBUF), P.in[I_S5_BGLU], (bf16_t*)(ws + P_CONCAT)};
                if (PROBE == 1) { EpiNull En; g8::gemm(C.lds, g, En, C.G, C.blk); } if (GSITE < 0 || GSITE == 5) g8::gemm(C.lds, g, E, C.G, C.blk);
            }
            SEAM(pb + 4);
            if (IN(pb + 5)) {
                g8::Desc g{(const bf16_t*)(ws + P_CONCAT), (const bf16_t*)(ws + WS_ABOUT_T), DM, DM, DM, T / 256, DM / 256, 1, 1, 0, 0, 0, 0};
                EpiResidB<true> E{P.in[I_X], xb, ssp};
                if (PROBE == 1) { EpiNull En; g8::gemm(C.lds, g, En, C.G, C.blk); } if (GSITE < 0 || GSITE == 6) g8::gemm(C.lds, g, E, C.G, C.blk);
            }
            SEAM(pb + 5);
    }
    {
        constexpr int l = 0, pb = 2; (void)l;
        const unsigned char* lw = ws + WS_LW + (size_t)l * LW_STRIDE;
        if (IN(pb + 7)) {
            g8::Desc g{xb, (const bf16_t*)(lw + LW_XQ), DM, DM, DM, T / 256, DM / 256, 1, 1, 0, 0, 0, 0};
            EpiBf16T<32> E{(bf16_t*)(ws + P_QX), DM, 0, 0, 1.0f, ssp};
            if (PROBE == 1) { EpiNull En; g8::gemm(C.lds, g, En, C.G, C.blk); } if (GSITE < 0 || GSITE == 11) g8::gemm(C.lds, g, E, C.G, C.blk);
        }
        SEAM(pb + 7);
        if (IN(pb + 8)) {
            g8::Desc g{(const bf16_t*)(ws + P_QX), (const bf16_t*)(ws + WS_KVX + (size_t)l * KVX_STRIDE), DM, DM, 512, SEQ / 256, 1, BATCH, 4, (long)SEQ * DM, 512, (long)MEM_LEN * DM, 512};
            EpiF32 E{(float*)(ws + P_S), 1024, (long)SEQ * 1024, 256, 0.04419417382415922f, nullptr};
            if (PROBE == 1) { EpiNull En; g8::gemm(C.lds, g, En, C.G, C.blk); } if (GSITE < 0 || GSITE == 12) g8::gemm(C.lds, g, E, C.G, C.blk);
        }
        SEAM(pb + 8);
        if (IN(pb + 9)) {
            if (PROBE == 5) phase_xa_softmax(C, P);
            phase_xa_softmax(C, P);
            if (l == 1) {
                convert_tables(C, P, 1);
            }
        }
        SEAM(pb + 9);
        if (IN(pb + 10)) {
            g8::Desc g{(const bf16_t*)(ws + P_P), (const bf16_t*)(ws + WS_KVX + (size_t)l * KVX_STRIDE + 16 * MiB), 1024, MT, 256, SEQ / 256, 2, BATCH, 4, (long)SEQ * 1024, 256, 256, 512L * MT};
            EpiBf16 E{(bf16_t*)(ws + P_OX), DM, (long)SEQ * DM, 512, 1.0f, nullptr};
            if (PROBE == 1) { EpiNull En; g8::gemm(C.lds, g, En, C.G, C.blk); } if (GSITE < 0 || GSITE == 13) g8::gemm(C.lds, g, E, C.G, C.blk);
        }
        SEAM(pb + 10);
        if (IN(pb + 11)) {
            g8::Desc g{(const bf16_t*)(ws + P_OX), (const bf16_t*)(lw + LW_XO), DM, DM, DM, T / 256, DM / 256, 1, 1, 0, 0, 0, 0};
            EpiResidB<false> E{nullptr, xb, ssp};
            if (PROBE == 1) { EpiNull En; g8::gemm(C.lds, g, En, C.G, C.blk); } if (GSITE < 0 || GSITE == 14) g8::gemm(C.lds, g, E, C.G, C.blk);
        }
        SEAM(pb + 11);
        if (IN(pb + 13)) {
            g8::Desc g{xb, (const bf16_t*)(lw + LW_PEER), DM, DM, DM, T / 256, DM / 256, 1, 1, 0, 0, 0, 0};
            EpiF32T<32> E{(float*)(ws + P_SC), DM, 0, 0, 1.0f, ssp};
            if (PROBE == 1) { EpiNull En; g8::gemm(C.lds, g, En, C.G, C.blk); } if (GSITE < 0 || GSITE == 15) g8::gemm(C.lds, g, E, C.G, C.blk);
        }
        SEAM(pb + 13);
        if (IN(pb + 14)) { if (EN_PEER && EN_TOPK) phase_peer<true>(C, P); }
        SEAM(pb + 14);
#if PEER_SLICED
        if (IN(pb + 15)) { if (EN_PEER && EN_PU) { if (PROBE >= 7 && PROBE <= 9) { phase_peer_sliced<0, PROBE - 7>(C, P, 8 + 32 * l + 64); __syncthreads(); } phase_peer_sliced<0>(C, P, 8 + 32 * l); } }
        SEAM(pb + 15);
        if (IN(pb + 16)) { if (EN_PEER) phase_peer_combine(C, P); }
        SEAM(pb + 16);
        if (IN(pb + 17)) { if (EN_PEER && EN_PV) { if (PROBE >= 10 && PROBE <= 12) { phase_peer_sliced<1, PROBE == 10 ? 3 : PROBE - 10>(C, P, 8 + 32 * l + 80); __syncthreads(); } phase_peer_sliced<1>(C, P, 8 + 32 * l + 16); } }
        SEAM(pb + 17);
#endif
    }
    {
        constexpr int l = 1, pb = 20; (void)l;

            if (IN(pb + 1)) {
                g8::Desc g{xb, (const bf16_t*)(ws + WS_MLAIN_T), DM, DM, DM, T / 256, MLA_IN_PAD / 256, 1, 1, 0, 0, 0, 0};
                EpiBf16T<16> E{(bf16_t*)(ws + P_MLAPROJ), MLA_IN_PAD, 0, 0, 1.0f, ssp};
                if (PROBE == 1) { EpiNull En; g8::gemm(C.lds, g, En, C.G, C.blk); } if (GSITE < 0 || GSITE == 7) g8::gemm(C.lds, g, E, C.G, C.blk);
            }
            SEAM(pb + 1);
            if (IN(pb + 2)) { if (PROBE == 5) phase_mla_rows(C, P); phase_mla_rows(C, P); }
            SEAM(pb + 2);
            if (IN(pb + 3)) {
                {
                    g8::Desc g{(const bf16_t*)(ws + P_CQN), (const bf16_t*)(ws + WS_UQ_T), MLA_QR, MLA_QR, MLA_QR, T / 256, 3072 / 256, 1, 1, 0, 0, 0, 0};
                    EpiRope<1> E{(bf16_t*)(ws + P_Q), 3072, pos, rtab};
                    if (PROBE == 1) { EpiNull En; g8::gemm(C.lds, g, En, C.G, C.blk); } if (GSITE < 0 || GSITE == 8) g8::gemm(C.lds, g, E, C.G, C.blk);
                }
                {
                    g8::Desc g{(const bf16_t*)(ws + P_CKVN), (const bf16_t*)(ws + WS_UKV_T), MLA_KVR, MLA_KVR, MLA_KVR, T / 256, 4096 / 256, 1, 1, 0, 0, 0, 0};
                    EpiBf16 E{(bf16_t*)(ws + P_KV), 4096, 0, 0, 1.0f, nullptr};
                    if (PROBE == 1) { EpiNull En; g8::gemm(C.lds, g, En, C.G, C.blk); } if (GSITE < 0 || GSITE == 9) g8::gemm(C.lds, g, E, C.G, C.blk);
                }
            }
            SEAM(pb + 3);
            if (IN(pb + 4)) { if (EN_MLA) { if (PROBE == 2) phase_mla_attn(C, P, 3); phase_mla_attn(C, P, 1); } }
            SEAM(pb + 4);
            if (IN(pb + 5)) {
                g8::Desc g{hbuf, (const bf16_t*)(ws + WS_MLAO_T), DM, DM, DM, T / 256, DM / 256, 1, 1, 0, 0, 0, 0};
                EpiResidB<false> E{nullptr, xb, ssp};
                if (PROBE == 1) { EpiNull En; g8::gemm(C.lds, g, En, C.G, C.blk); } if (GSITE < 0 || GSITE == 10) g8::gemm(C.lds, g, E, C.G, C.blk);
            }
            SEAM(pb + 5);
    }
    {
        constexpr int l = 1, pb = 20; (void)l;
        const unsigned char* lw = ws + WS_LW + (size_t)l * LW_STRIDE;
        if (IN(pb + 7)) {
            g8::Desc g{xb, (const bf16_t*)(lw + LW_XQ), DM, DM, DM, T / 256, DM / 256, 1, 1, 0, 0, 0, 0};
            EpiBf16T<32> E{(bf16_t*)(ws + P_QX), DM, 0, 0, 1.0f, ssp};
            if (PROBE == 1) { EpiNull En; g8::gemm(C.lds, g, En, C.G, C.blk); } if (GSITE < 0 || GSITE == 11) g8::gemm(C.lds, g, E, C.G, C.blk);
        }
        SEAM(pb + 7);
        if (IN(pb + 8)) {
            g8::Desc g{(const bf16_t*)(ws + P_QX), (const bf16_t*)(ws + WS_KVX + (size_t)l * KVX_STRIDE), DM, DM, 512, SEQ / 256, 1, BATCH, 4, (long)SEQ * DM, 512, (long)MEM_LEN * DM, 512};
            EpiF32 E{(float*)(ws + P_S), 1024, (long)SEQ * 1024, 256, 0.04419417382415922f, nullptr};
            if (PROBE == 1) { EpiNull En; g8::gemm(C.lds, g, En, C.G, C.blk); } if (GSITE < 0 || GSITE == 12) g8::gemm(C.lds, g, E, C.G, C.blk);
        }
        SEAM(pb + 8);
        if (IN(pb + 9)) {
            if (PROBE == 5) phase_xa_softmax(C, P);
            phase_xa_softmax(C, P);
            if (l == 1) {
                convert_tables(C, P, 1);
            }
        }
        SEAM(pb + 9);
        if (IN(pb + 10)) {
            g8::Desc g{(const bf16_t*)(ws + P_P), (const bf16_t*)(ws + WS_KVX + (size_t)l * KVX_STRIDE + 16 * MiB), 1024, MT, 256, SEQ / 256, 2, BATCH, 4, (long)SEQ * 1024, 256, 256, 512L * MT};
            EpiBf16 E{(bf16_t*)(ws + P_OX), DM, (long)SEQ * DM, 512, 1.0f, nullptr};
            if (PROBE == 1) { EpiNull En; g8::gemm(C.lds, g, En, C.G, C.blk); } if (GSITE < 0 || GSITE == 13) g8::gemm(C.lds, g, E, C.G, C.blk);
        }
        SEAM(pb + 10);
        if (IN(pb + 11)) {
            g8::Desc g{(const bf16_t*)(ws + P_OX), (const bf16_t*)(lw + LW_XO), DM, DM, DM, T / 256, DM / 256, 1, 1, 0, 0, 0, 0};
            EpiResidB<false> E{nullptr, xb, ssp};
            if (PROBE == 1) { EpiNull En; g8::gemm(C.lds, g, En, C.G, C.blk); } if (GSITE < 0 || GSITE == 14) g8::gemm(C.lds, g, E, C.G, C.blk);
        }
        SEAM(pb + 11);
        if (IN(pb + 13)) {
            g8::Desc g{xb, (const bf16_t*)(lw + LW_PEER), DM, DM, DM, T / 256, DM / 256, 1, 1, 0, 0, 0, 0};
            EpiF32T<32> E{(float*)(ws + P_SC), DM, 0, 0, 1.0f, ssp};
            if (PROBE == 1) { EpiNull En; g8::gemm(C.lds, g, En, C.G, C.blk); } if (GSITE < 0 || GSITE == 15) g8::gemm(C.lds, g, E, C.G, C.blk);
        }
        SEAM(pb + 13);
        if (IN(pb + 14)) { if (EN_PEER && EN_TOPK) phase_peer<true>(C, P); }
        SEAM(pb + 14);
#if PEER_SLICED
        if (IN(pb + 15)) { if (EN_PEER && EN_PU) { if (PROBE >= 7 && PROBE <= 9) { phase_peer_sliced<0, PROBE - 7>(C, P, 8 + 32 * l + 64); __syncthreads(); } phase_peer_sliced<0>(C, P, 8 + 32 * l); } }
        SEAM(pb + 15);
        if (IN(pb + 16)) { if (EN_PEER) phase_peer_combine(C, P); }
        SEAM(pb + 16);
        if (IN(pb + 17)) { if (EN_PEER && EN_PV) { if (PROBE >= 10 && PROBE <= 12) { phase_peer_sliced<1, PROBE == 10 ? 3 : PROBE - 10>(C, P, 8 + 32 * l + 80); __syncthreads(); } phase_peer_sliced<1>(C, P, 8 + 32 * l + 16); } }
        SEAM(pb + 17);
#endif
    }
    if (IN(38)) rms_rows_final(C, xb, P.out, P.in[I_FINAL_NORM], T);
#undef IN
#undef SEAM
}

extern "C" void kernel_launch(void* const* d_in, const int* in_sizes, int n_in, void* d_out, int out_size, void* d_ws, size_t ws_size, hipStream_t stream) {
    static int grid = 0;
    if (grid == 0) {
        if (n_in != 39 || in_sizes[0] != T * DM || out_size != T * DM || ws_size < WS_END) {
            fprintf(stderr, "kernel_launch: unexpected shapes (n_in %d in0 %d out %d ws %zu, need ws >= %zu); nothing launched\n", n_in, n_in > 0 ? in_sizes[0] : -1, out_size, ws_size, (size_t)WS_END);
            grid = -1; return; }
        int dev = 0, cus = 0;
        if (hipGetDevice(&dev) != hipSuccess || hipDeviceGetAttribute(&cus, hipDeviceAttributeMultiprocessorCount, dev) != hipSuccess) { grid = -1; return; }
        if (hipFuncSetAttribute((const void*)mk_fwd, hipFuncAttributeMaxDynamicSharedMemorySize, LDS_BYTES) != hipSuccess) { fprintf(stderr, "kernel_launch: hipFuncSetAttribute failed\n"); grid = -1; return; }
        int per_cu = 0;
        if (hipOccupancyMaxActiveBlocksPerMultiprocessor(&per_cu, (const void*)mk_fwd, NTHREADS, LDS_BYTES) != hipSuccess || per_cu < 1)
            fprintf(stderr, "kernel_launch: occupancy query reports %d blocks per CU\n", per_cu);
        (void)hipGetLastError();
        grid = cus;
    }
    if (grid < 0) return;
    (void)hipMemsetAsync((char*)d_ws + WS_CTL, 0, CTL_BYTES, stream);
    Params p{};
    for (int i = 0; i < 39; ++i) p.in[i] = (const float*)d_in[i];
    p.out = (float*)d_out; p.ws = (unsigned char*)d_ws;
#if MK_ONE_LAUNCH
    p.ph_lo = 0; p.ph_hi = N_PHASES;
    hipLaunchKernelGGL(mk_fwd, dim3(grid), dim3(NTHREADS), LDS_BYTES, stream, p);
#else
    for (int ph = 0; ph < N_PHASES; ++ph) { p.ph_lo = ph; p.ph_hi = ph + 1; hipLaunchKernelGGL(mk_fwd, dim3(grid), dim3(NTHREADS), LDS_BYTES, stream, p); }
#endif
    const hipError_t le = hipPeekAtLastError();
    if (le != hipSuccess) fprintf(stderr, "kernel_launch: launch failed: %s\n", hipGetErrorName(le));
}
```

```cpp
#include <hip/hip_runtime.h>
#include <cstdio>
#include <cstdint>

#ifndef MK_ONE_LAUNCH
#define MK_ONE_LAUNCH 1
#endif
#ifndef FAST_GEMM
#define FAST_GEMM 1
#endif
#ifndef FAST_ATTN
#define FAST_ATTN 1
#endif

#ifndef EN_TOPK
#define EN_TOPK 1
#endif
#ifndef EN_PU
#define EN_PU 1
#endif
#ifndef EN_PV
#define EN_PV 1
#endif
#ifndef EN_S5
#define EN_S5 1
#endif
#ifndef EN_DIFF
#define EN_DIFF 1
#endif
#ifndef EN_MLA
#define EN_MLA 1
#endif
#ifndef EN_PEER
#define EN_PEER 1
#endif
#ifndef EN_GEMM
#define EN_GEMM 1
#endif
#ifndef EN_PRO
#define EN_PRO 1
#endif
#ifndef PEER_FP8
#define PEER_FP8 1
#endif
#ifndef PROBE
#define PROBE 0
#endif
#ifndef PEER_SLICED
#define PEER_SLICED 1
#endif
#ifndef PROBE_PEER2
#define PROBE_PEER2 0
#endif
#ifndef GSITE
#define GSITE -1
#endif
#define GAS __attribute__((address_space(1)))
#define LAS __attribute__((address_space(3)))
#define DI __device__ __forceinline__
typedef unsigned short bf16_t;
typedef short bf16x8 __attribute__((ext_vector_type(8)));
typedef short s16x4 __attribute__((ext_vector_type(4)));
typedef float f32x2 __attribute__((ext_vector_type(2)));
typedef float f32x4 __attribute__((ext_vector_type(4)));
typedef float f32x16 __attribute__((ext_vector_type(16)));
typedef unsigned u32x2 __attribute__((ext_vector_type(2)));
typedef unsigned u32x4 __attribute__((ext_vector_type(4)));
typedef __bf16 bf16x2_t __attribute__((ext_vector_type(2)));

constexpr int BATCH = 16, SEQ = 2048, DM = 2048, T = BATCH * SEQ, MEM_LEN = 256, MT = BATCH * MEM_LEN;
constexpr int DIFF_HEADS = 12, DIFF_W = 1536, S5_W = 512, AB_IN = 5120;
constexpr int MLA_HEADS = 16, MLA_QR = 768, MLA_KVR = 256, MLA_IN = 1088, MLA_IN_PAD = 1280;
constexpr int PEER_NE = 16384;
constexpr float NORM_EPS = 1e-6f;
constexpr int ROPE_POS = 3072;
constexpr int NWAVES = 8, NTHREADS = 512;

constexpr size_t MiB = 1u << 20;
constexpr size_t WS_CTL = 0, CTL_BYTES = 1 * MiB;
constexpr size_t WS_ROPE = 1 * MiB;
constexpr size_t WS_ABIN_T = 2 * MiB, WS_ABOUT_T = 22 * MiB, WS_GLU_T = 30 * MiB, WS_MLAIN_T = 31 * MiB, WS_UQ_T = 36 * MiB, WS_UKV_T = 41 * MiB, WS_MLAO_T = 43 * MiB;
constexpr size_t WS_LW = 51 * MiB, LW_STRIDE = 40 * MiB;
constexpr size_t LW_XQ = 0, LW_XKV = 8 * MiB, LW_XO = 24 * MiB, LW_PEER = 32 * MiB;
constexpr size_t WS_KVX = 131 * MiB, KVX_STRIDE = 32 * MiB;
constexpr size_t WS_POOL = 195 * MiB;
constexpr size_t P_H = WS_POOL;
constexpr size_t P_PROJ = WS_POOL + 128 * MiB;
constexpr size_t P_CONCAT = WS_POOL + 448 * MiB;
constexpr size_t P_GBUF = WS_POOL + 576 * MiB;
constexpr size_t P_MLAPROJ = WS_POOL + 0 * MiB;
constexpr size_t P_CQN = WS_POOL + 80 * MiB;
constexpr size_t P_CKVN = WS_POOL + 128 * MiB;
constexpr size_t P_KROPE = WS_POOL + 144 * MiB;
constexpr size_t P_Q = WS_POOL + 152 * MiB;
constexpr size_t P_KV = WS_POOL + 344 * MiB;
constexpr size_t P_QX = WS_POOL + 128 * MiB;
constexpr size_t P_S = WS_POOL + 256 * MiB;
constexpr size_t P_P = WS_POOL + 384 * MiB;
constexpr size_t P_OX = WS_POOL + 448 * MiB;
constexpr size_t P_SC = WS_POOL + 128 * MiB;
constexpr size_t P_UT = WS_POOL + 608 * MiB;
constexpr size_t P_VT = WS_POOL + 642 * MiB;
constexpr size_t P_PE_E = WS_POOL + 384 * MiB;
constexpr size_t P_PE_G = WS_POOL + 400 * MiB;
constexpr size_t P_PE_T8 = WS_POOL + 432 * MiB;
constexpr size_t P_PE_TSC = WS_POOL + 496 * MiB;
constexpr size_t P_MEMN = WS_POOL + 448 * MiB;
constexpr size_t P_WQB = WS_POOL + 480 * MiB;
constexpr size_t P_SK = WS_POOL + 496 * MiB;
constexpr size_t P_SS = WS_POOL + 680 * MiB;
constexpr size_t P_XB = WS_POOL + 704 * MiB;
constexpr size_t WS_END = WS_POOL + 832 * MiB;
constexpr int CW_BAR = 4096, CW_CTR = 16384;

constexpr int RING_BYTES = 131072, LDSCTL_OFF = RING_BYTES, LDS_BYTES = 147456;

DI unsigned pk2(float lo, float hi) { f32x2 v = {lo, hi}; bf16x2_t b = __builtin_convertvector(v, bf16x2_t); return __builtin_bit_cast(unsigned, b); }
DI float bflo(unsigned u) { return __uint_as_float(u << 16); }
DI float bfhi(unsigned u) { return __uint_as_float(u & 0xffff0000u); }
DI float bf2f(bf16_t b) { return __uint_as_float(((unsigned)b) << 16); }
DI bf16_t f2bf(float f) { return (bf16_t)(pk2(f, 0.f) & 0xffffu); }
DI float dot2bf(unsigned a, unsigned b, float c) { return __builtin_amdgcn_fdot2_f32_bf16(__builtin_bit_cast(bf16x2_t, a), __builtin_bit_cast(bf16x2_t, b), c, false); }
DI int opaque_tid() { int t; asm volatile("v_mov_b32 %0, %1" : "=v"(t) : "v"(threadIdx.x)); return t; }
DI float wave_sum(float v) {
#pragma unroll
    for (int o = 1; o < 64; o <<= 1) v += __shfl_xor(v, o);
    return v;
}
DI float gelu_erf(float v) { return 0.5f * v * (1.0f + erff(v * 0.70710678118654752f)); }
DI float swap32_max(float x) { auto rr = __builtin_amdgcn_permlane32_swap(__float_as_uint(x), __float_as_uint(x), false, false); return fmaxf(__uint_as_float(rr[0]), __uint_as_float(rr[1])); }
DI float swap32_sum(float x) { auto rr = __builtin_amdgcn_permlane32_swap(__float_as_uint(x), __float_as_uint(x), false, false); return __uint_as_float(rr[0]) + __uint_as_float(rr[1]); }
#define LDS_WAIT() asm volatile("s_waitcnt lgkmcnt(0)" ::: "memory")
#define VM_WAIT() asm volatile("s_waitcnt vmcnt(0)" ::: "memory")

#define XB_TMO      128
#define XB_XCNT(j)  (256  + 64 * (j))
#define XB_XSUB(j)  (1280 + 64 * (j))
#define XB_XGEN(j)  (2304 + 64 * (j))
#define XB_TOP      3328
#define XB_TOPGEN   3392
#define XCD_BAR_WORDS 3456
#define XB_SPIN_CAP (1u << 20)
DI unsigned xb_ld(unsigned* p)              { return __hip_atomic_load(p, __ATOMIC_RELAXED, __HIP_MEMORY_SCOPE_AGENT); }
DI unsigned xb_add(unsigned* p, unsigned v) { return __hip_atomic_fetch_add(p, v, __ATOMIC_RELAXED, __HIP_MEMORY_SCOPE_AGENT); }
DI unsigned xb_xcc_id() { return (unsigned)__builtin_amdgcn_s_getreg((3 << 11) | 20) & 0xFu; }
#define XB_SPIN(cond, bar) do { unsigned _sp = 0; while (cond) { __builtin_amdgcn_s_sleep(1); \
    if ((++_sp & 255u) == 0u) { if (xb_ld(&(bar)[XB_TMO])) break; if (_sp > XB_SPIN_CAP) { atomicAdd(&(bar)[XB_TMO], 1u); break; } } } } while (0)
struct XcdBarrier { unsigned* bar; unsigned x; volatile LAS unsigned* st; };
DI XcdBarrier xcd_barrier_post(unsigned* bar, volatile LAS unsigned* st) {
    XcdBarrier b; b.bar = bar; b.x = xb_xcc_id(); b.st = st;
    if (threadIdx.x == 0) (void)xb_add(&bar[XB_XCNT(b.x)], 1u);
    return b;
}
DI void xcd_barrier_complete(unsigned* bar, unsigned x, unsigned& nloc, unsigned& nx) {
    const unsigned G = gridDim.x * gridDim.y * gridDim.z;
    unsigned sum, cnt, mine, sp = 0u;
    for (;;) {
        sum = 0u; cnt = 0u; mine = 0u;
#pragma unroll
        for (unsigned j = 0; j < 16; ++j) { const unsigned c = xb_ld(&bar[XB_XCNT(j)]); sum += c; cnt += (c > 0u) ? 1u : 0u; mine = (j == x) ? c : mine; }
        if (sum == G) break;
        __builtin_amdgcn_s_sleep(1);
        if ((++sp & 255u) == 0u) { if (xb_ld(&bar[XB_TMO])) break; if (sp > XB_SPIN_CAP) { atomicAdd(&bar[XB_TMO], 1u); break; } }
    }
    nloc = mine > 0u ? mine : 1u; nx = cnt > 0u ? cnt : 1u;
}
DI void xcd_barrier(const XcdBarrier& b) {
    asm volatile("s_waitcnt vmcnt(0)" ::: "memory");
    __syncthreads();
    if (threadIdx.x == 0) {
        unsigned* bar = b.bar;
        __builtin_amdgcn_s_waitcnt(0);
        unsigned nloc = b.st[0], nx = b.st[1];
        if (nloc == 0u) { xcd_barrier_complete(bar, b.x, nloc, nx); b.st[0] = nloc; b.st[1] = nx; }
        const unsigned old = xb_add(&bar[XB_XSUB(b.x)], 1u);
        const unsigned gen = old / nloc;
        if (old + 1u == (gen + 1u) * nloc) {
            __builtin_amdgcn_fence(__ATOMIC_RELEASE, "agent");
            asm volatile("s_waitcnt vmcnt(0)" ::: "memory");
            const unsigned og = xb_add(&bar[XB_TOP], 1u);
            const unsigned tg = og / nx;
            if (og + 1u == (tg + 1u) * nx) xb_add(&bar[XB_TOPGEN], 1u);
            else XB_SPIN(xb_ld(&bar[XB_TOPGEN]) == tg, bar);
            __builtin_amdgcn_fence(__ATOMIC_ACQUIRE, "agent");
            xb_add(&bar[XB_XGEN(b.x)], 1u);
            asm volatile("s_waitcnt vmcnt(0)" ::: "memory");
        } else {
            XB_SPIN(xb_ld(&bar[XB_XGEN(b.x)]) == gen, bar);
            __builtin_amdgcn_fence(__ATOMIC_ACQUIRE, "agent");
            asm volatile("s_waitcnt vmcnt(0)" ::: "memory");
        }
    }
    __syncthreads();
}

namespace g8 {
constexpr int BM = 256, BK = 64, HALF = 128, HTB = HALF * BK * 2, STAGE_BYTES = 8 * HTB, NXCD = 8, WGM = 8;
DI int lds_byte(int r, int c) { const int st = (r >> 4) * 2 + (c >> 5), rr = r & 15, cc = c & 31, ob = rr * 64 + cc * 2; return st * 1024 + (ob ^ (((ob >> 9) & 1) << 5)); }
DI void stage_rc(int b, int& R, int& C) { const int st = b / 1024, sb = b % 1024, swz = sb ^ (((sb >> 9) & 1) << 5); R = (st >> 1) * 16 + swz / 64; C = (st & 1) * 32 + (swz % 64) / 2; }
DI int perm32(int rho) { const int n = rho >> 4, i = rho & 15; return 8 * (i >> 2) + 4 * n + (i & 3); }

struct Unit { int zo, zi, pm, pn; };
struct Desc { const bf16_t* A; const bf16_t* Bt; int lda, ldb, K, nM, nN, nZo, nZi; long sAo, sAi, sBo, sBi; };
DI bool next_unit(const Desc& g, int i, int G, int c, Unit& u) {
    const int per = g.nM * g.nN, nwg = per * g.nZo * g.nZi;
    const long L = (long)i * G + c; if (L >= nwg) return false;
    int wgid = (int)L; { const int q = nwg / NXCD, r = nwg % NXCD, xcd = wgid % NXCD, off = wgid / NXCD; wgid = (xcd < r ? xcd * (q + 1) : r * (q + 1) + (xcd - r) * q) + off; }
    const int z = wgid / per, w = wgid % per;
    u.zo = z / g.nZi; u.zi = z % g.nZi;
    const int nig = WGM * g.nN, gid = w / nig, fm = gid * WGM, gsz = (g.nM - fm) < WGM ? (g.nM - fm) : WGM;
    u.pm = fm + ((w % nig) % gsz); u.pn = (w % nig) / gsz; return true;
}

template <class Epi>
DI void gemm_phase(LAS unsigned char* lds, const Desc g, const Epi& E, int G, int c) {
    const int tid = opaque_tid(), wid = __builtin_amdgcn_readfirstlane(tid >> 6), lane = tid & 63, wr = wid >> 2, wc = wid & 3, fr = lane & 15, fq = lane >> 4;
    const int K = g.K, nt = K / BK;
    unsigned voffA[2], voffB[2];
#pragma unroll
    for (int i = 0; i < 2; ++i) { int R, C; stage_rc(tid * 16 + i * 8192, R, C); const int Rb = (R & ~31) + perm32(R & 31);
        voffA[i] = (unsigned)(R * g.lda + C) * 2u; voffB[i] = (unsigned)(Rb * g.ldb + C) * 2u; }
    const size_t kstep = (size_t)(BK * 2);
    const size_t hstepA = (size_t)HALF * g.lda * 2, hstepB = (size_t)HALF * g.ldb * 2;
    const unsigned ldsw = (unsigned)wid * 1024u;
    const int aoff = lds_byte(wr * 64 + fr, fq * 8), boff = lds_byte(wc * 32 + fr, fq * 8);
#define PG8_SA(b, h) (((b) * 2 + (h)) * HTB)
#define PG8_SB(b, h) ((4 + (b) * 2 + (h)) * HTB)
#define PG8_STAGE(bufoff, gbase, voff) do { _Pragma("unroll") for (int _i = 0; _i < 2; ++_i) \
        __builtin_amdgcn_global_load_lds((const unsigned*)((const char*)(gbase) + (voff)[_i]), (LAS unsigned*)(lds + (bufoff) + ldsw + _i * 8192), 16, 0, 0); } while (0)
#define PG8_LDA(dst, b, h) do { _Pragma("unroll") for (int m = 0; m < 4; ++m) _Pragma("unroll") for (int k = 0; k < 2; ++k) dst[m][k] = *(const LAS bf16x8*)(lds + PG8_SA(b, h) + aoff + m * 2048 + k * 1024); } while (0)
#define PG8_LDB(dst, b, h) do { _Pragma("unroll") for (int n = 0; n < 2; ++n) _Pragma("unroll") for (int k = 0; k < 2; ++k) dst[n][k] = *(const LAS bf16x8*)(lds + PG8_SB(b, h) + boff + n * 2048 + k * 1024); } while (0)
#define PG8_MMA(ai, bj, At, Bt) do { __builtin_amdgcn_s_setprio(1); _Pragma("unroll") for (int m = 0; m < 4; ++m) _Pragma("unroll") for (int n = 0; n < 2; ++n) _Pragma("unroll") for (int k = 0; k < 2; ++k) \
        acc[ai][bj][m][n] = __builtin_amdgcn_mfma_f32_16x16x32_bf16(Bt[n][k], At[m][k], acc[ai][bj][m][n], 0, 0, 0); __builtin_amdgcn_s_setprio(0); } while (0)
#define PG8_WAIT_V(n) asm volatile("s_waitcnt vmcnt(" #n ")" ::: "memory")
#define PG8_WAIT_L(n) asm volatile("s_waitcnt lgkmcnt(" #n ")" ::: "memory")
#define PG8_BAR __builtin_amdgcn_s_barrier()
#define PG8_SCHED __builtin_amdgcn_sched_barrier(0)
#define PG8_APTR(u) ((const char*)g.A + ((size_t)(u).zo * g.sAo + (size_t)(u).zi * g.sAi + (size_t)(u).pm * BM * g.lda) * 2)
#define PG8_BPTR(u) ((const char*)g.Bt + ((size_t)(u).zo * g.sBo + (size_t)(u).zi * g.sBi + (size_t)(u).pn * BM * g.ldb) * 2)
    Unit cur, nxt; int ui = 0;
    if (!next_unit(g, 0, G, c, cur)) return;
    f32x4 acc[2][2][4][2];
#pragma unroll
    for (int a = 0; a < 2; ++a)
#pragma unroll
        for (int b = 0; b < 2; ++b)
#pragma unroll
            for (int m = 0; m < 4; ++m)
#pragma unroll
                for (int n = 0; n < 2; ++n) acc[a][b][m][n] = (f32x4){0.f, 0.f, 0.f, 0.f};
    bf16x8 At[4][2], B0[2][2], B1[2][2];
    const char* cA = PG8_APTR(cur); const char* cB = PG8_BPTR(cur);
    PG8_STAGE(PG8_SB(0, 0), cB, voffB); PG8_STAGE(PG8_SA(0, 0), cA, voffA); PG8_STAGE(PG8_SB(0, 1), cB + hstepB, voffB); PG8_STAGE(PG8_SA(0, 1), cA + hstepA, voffA);
    if (wr == 1) PG8_BAR;
    PG8_WAIT_V(4); PG8_BAR;
    PG8_STAGE(PG8_SB(1, 0), cB + kstep, voffB); PG8_STAGE(PG8_SA(1, 0), cA + kstep, voffA); PG8_STAGE(PG8_SB(1, 1), cB + hstepB + kstep, voffB);
    PG8_WAIT_V(6); PG8_BAR;
    for (;;) {
        const bool has_next = next_unit(g, ui + 1, G, c, nxt);
        const char* nA = has_next ? PG8_APTR(nxt) : cA; const char* nB = has_next ? PG8_BPTR(nxt) : cB;
        for (int t = 0; t < nt; t += 2) {
            const bool last = (t == nt - 2);
            const char* a1 = cA + (size_t)(t + 1) * kstep;
            const char* a2 = last ? nA : cA + (size_t)(t + 2) * kstep; const char* b2 = last ? nB : cB + (size_t)(t + 2) * kstep;
            const char* a3 = a2 + kstep; const char* b3 = b2 + kstep;
            PG8_LDB(B0, 0, 0); PG8_SCHED; PG8_LDA(At, 0, 0); PG8_STAGE(PG8_SA(1, 1), a1 + hstepA, voffA);
            PG8_WAIT_L(8); PG8_BAR; PG8_WAIT_L(0); PG8_MMA(0, 0, At, B0); PG8_BAR; PG8_SCHED;
            PG8_LDB(B1, 0, 1); PG8_STAGE(PG8_SB(0, 0), b2, voffB);
            PG8_BAR; PG8_WAIT_L(0); PG8_MMA(0, 1, At, B1); PG8_BAR;
            PG8_LDA(At, 0, 1); PG8_STAGE(PG8_SA(0, 0), a2, voffA);
            PG8_BAR; PG8_WAIT_L(0); PG8_MMA(1, 0, At, B0); PG8_BAR; PG8_SCHED;
            PG8_STAGE(PG8_SB(0, 1), b2 + hstepB, voffB);
            PG8_WAIT_V(6); PG8_BAR; PG8_MMA(1, 1, At, B1); PG8_BAR;
            PG8_LDB(B0, 1, 0); PG8_SCHED; PG8_LDA(At, 1, 0); PG8_STAGE(PG8_SA(0, 1), a2 + hstepA, voffA);
            PG8_WAIT_L(8); PG8_BAR; PG8_WAIT_L(0); PG8_MMA(0, 0, At, B0); PG8_BAR; PG8_SCHED;
            PG8_LDB(B1, 1, 1); PG8_STAGE(PG8_SB(1, 0), b3, voffB);
            PG8_BAR; PG8_WAIT_L(0); PG8_MMA(0, 1, At, B1); PG8_BAR;
            PG8_LDA(At, 1, 1); PG8_STAGE(PG8_SA(1, 0), a3, voffA);
            PG8_BAR; PG8_WAIT_L(0); PG8_MMA(1, 0, At, B0); PG8_BAR; PG8_SCHED;
            PG8_STAGE(PG8_SB(1, 1), b3 + hstepB, voffB);
            PG8_WAIT_V(6); PG8_BAR; PG8_MMA(1, 1, At, B1); PG8_BAR;
        }
        {
            const int row0 = cur.pm * BM + wr * 64 + fr, col0 = cur.pn * BM + wc * 32 + 8 * fq;
#pragma unroll
            for (int ai = 0; ai < 2; ++ai)
#pragma unroll
                for (int m = 0; m < 4; ++m) {
                    const int row = row0 + ai * HALF + m * 16;
                    const float ri = E.row_begin(cur.zo, cur.zi, row);
                    float ra = 0.f;
#pragma unroll
                    for (int bj = 0; bj < 2; ++bj) ra += E.oct(cur.zo, cur.zi, row, col0 + bj * HALF, acc[ai][bj][m][0], acc[ai][bj][m][1], ri);
                    E.row_end(row, cur.pn * 4 + wc, ra);
                }
        }
        if (!has_next) break;
#pragma unroll
        for (int a = 0; a < 2; ++a)
#pragma unroll
            for (int b = 0; b < 2; ++b)
#pragma unroll
                for (int m = 0; m < 4; ++m)
#pragma unroll
                    for (int n = 0; n < 2; ++n) acc[a][b][m][n] = (f32x4){0.f, 0.f, 0.f, 0.f};
        cur = nxt; cA = nA; cB = nB; ++ui;
    }
    PG8_WAIT_V(0);
    if (wr == 0) PG8_BAR;
    PG8_BAR;
#undef PG8_SA
#undef PG8_SB
#undef PG8_STAGE
#undef PG8_LDA
#undef PG8_LDB
#undef PG8_MMA
#undef PG8_WAIT_V
#undef PG8_WAIT_L
#undef PG8_BAR
#undef PG8_SCHED
#undef PG8_APTR
#undef PG8_BPTR
}

template <class Epi>
DI void naive_gemm(const Desc g, const Epi& E, int G, int c) {
    const int M = g.nM * BM, N = g.nN * BM, n8 = N / 8, nZ = g.nZo * g.nZi;
    const long total = (long)nZ * M * n8;
    for (long idx = (long)c * NTHREADS + threadIdx.x; idx < total; idx += (long)G * NTHREADS) {
        const int col = (int)(idx % n8) * 8; const int row = (int)((idx / n8) % M); const int z = (int)(idx / ((long)n8 * M));
        const int zo = z / g.nZi, zi = z % g.nZi;
        const bf16_t* a = g.A + (size_t)zo * g.sAo + (size_t)zi * g.sAi + (size_t)row * g.lda;
        const bf16_t* b = g.Bt + (size_t)zo * g.sBo + (size_t)zi * g.sBi + (size_t)col * g.ldb;
        float acc[8];
#pragma unroll
        for (int j = 0; j < 8; ++j) acc[j] = 0.f;
        for (int k = 0; k < g.K; k += 8) {
            const u32x4 av = *(const u32x4*)(a + k);
#pragma unroll
            for (int j = 0; j < 8; ++j) { const u32x4 bv = *(const u32x4*)(b + (size_t)j * g.ldb + k);
                float s = acc[j]; s = dot2bf(av.x, bv.x, s); s = dot2bf(av.y, bv.y, s); s = dot2bf(av.z, bv.z, s); s = dot2bf(av.w, bv.w, s); acc[j] = s; }
        }
        (void)E.oct(zo, zi, row, col, (f32x4){acc[0], acc[1], acc[2], acc[3]}, (f32x4){acc[4], acc[5], acc[6], acc[7]}, E.row_begin(zo, zi, row));
    }
}
template <class Epi>
DI void gemm(LAS unsigned char* lds, const Desc g, const Epi& E, int G, int c) {
#if !EN_GEMM
    return;
#elif FAST_GEMM
    gemm_phase(lds, g, E, G, c);
#else
    naive_gemm(g, E, G, c);
#endif
}
}

template <int NP> DI float row_rstd(const float* ss, int row) {
    const f32x4* p = (const f32x4*)(ss + (size_t)row * 32); float t = 0.f;
#pragma unroll
    for (int i = 0; i < NP / 4; ++i) { const f32x4 v = p[i]; t += (v[0] + v[1]) + (v[2] + v[3]); }
    return rsqrtf(t * (1.0f / DM) + NORM_EPS);
}
#define EPI_NO_ROW_BEGIN DI float row_begin(int, int, int) const { return 0.f; }
#define EPI_NO_ROW_END DI void row_end(int, int, float) const {}
template <int NP  > struct EpiBf16T {
    bf16_t* O; long ldc, sZo, sZi; float scale; const float* ss;
    EPI_NO_ROW_END
    DI float row_begin(int, int, int row) const { return NP ? row_rstd<NP ? NP : 4>(ss, row) * scale : scale; }
    DI float oct(int zo, int zi, int row, int col, f32x4 lo, f32x4 hi, float f) const {
        bf16_t* p = O + (size_t)zo * sZo + (size_t)zi * sZi + (size_t)row * ldc + col;
        u32x4 w; w.x = pk2(lo[0] * f, lo[1] * f); w.y = pk2(lo[2] * f, lo[3] * f); w.z = pk2(hi[0] * f, hi[1] * f); w.w = pk2(hi[2] * f, hi[3] * f);
        *(u32x4*)p = w; return 0.f;
    }
};
typedef EpiBf16T<0> EpiBf16;
template <int NP> struct EpiF32T {
    float* O; long ldc, sZo, sZi; float scale; const float* ss;
    EPI_NO_ROW_END
    DI float row_begin(int, int, int row) const { return NP ? row_rstd<NP ? NP : 4>(ss, row) * scale : scale; }
    DI float oct(int zo, int zi, int row, int col, f32x4 lo, f32x4 hi, float f) const {
        float* p = O + (size_t)zo * sZo + (size_t)zi * sZi + (size_t)row * ldc + col;
        *(f32x4*)p = lo * f; *(f32x4*)(p + 4) = hi * f; return 0.f;
    }
};
typedef EpiF32T<0> EpiF32;
template <bool F32SRC> struct EpiResidB {
    const float* xin; bf16_t* xb; float* ss;
    EPI_NO_ROW_BEGIN
    DI float oct(int, int, int row, int col, f32x4 lo, f32x4 hi, float) const {
        const size_t o = (size_t)row * DM + col;
        float r[8];
        if (F32SRC) { const f32x4 r0 = *(const f32x4*)(xin + o), r1 = *(const f32x4*)(xin + o + 4); r[0] = r0[0]; r[1] = r0[1]; r[2] = r0[2]; r[3] = r0[3]; r[4] = r1[0]; r[5] = r1[1]; r[6] = r1[2]; r[7] = r1[3]; }
        else { const u32x4 w = *(const u32x4*)(xb + o); r[0] = bflo(w.x); r[1] = bfhi(w.x); r[2] = bflo(w.y); r[3] = bfhi(w.y); r[4] = bflo(w.z); r[5] = bfhi(w.z); r[6] = bflo(w.w); r[7] = bfhi(w.w); }
        u32x4 w; w.x = pk2(r[0] + lo[0], r[1] + lo[1]); w.y = pk2(r[2] + lo[2], r[3] + lo[3]); w.z = pk2(r[4] + hi[0], r[5] + hi[1]); w.w = pk2(r[6] + hi[2], r[7] + hi[3]);
        *(u32x4*)(xb + o) = w;
        const float q0 = bflo(w.x), q1 = bfhi(w.x), q2 = bflo(w.y), q3 = bfhi(w.y), q4 = bflo(w.z), q5 = bfhi(w.z), q6 = bflo(w.w), q7 = bfhi(w.w);
        return ((q0 * q0 + q1 * q1) + (q2 * q2 + q3 * q3)) + ((q4 * q4 + q5 * q5) + (q6 * q6 + q7 * q7));
    }
    DI void row_end(int row, int slot, float ra) const {
        ra += __shfl_xor(ra, 16); ra += __shfl_xor(ra, 32);
        if ((threadIdx.x & 63) < 16) ss[(size_t)row * 32 + slot] = ra;
    }
};
template <int MODE> struct EpiRope {
    bf16_t* O; long ldc; const int* pos; const f32x2* tab;
    EPI_NO_ROW_BEGIN EPI_NO_ROW_END
    DI float oct(int, int, int row, int col, f32x4 lo, f32x4 hi, float) const {
        bool rope; int j0;
        if (MODE == 0) { rope = col < 2 * DIFF_W; j0 = col & 63; } else { const int c = col % 192; rope = c >= 128; j0 = c - 128; }
        if (rope) {
            int p = pos[row]; p = p < 0 ? 0 : (p > ROPE_POS - 1 ? ROPE_POS - 1 : p);
            const f32x4* tp = (const f32x4*)(tab + (size_t)p * 32 + (j0 >> 1));
            const f32x4 t0 = tp[0], t1 = tp[1];
            f32x4 a = lo, b = hi;
            lo[0] = a[0] * t0[0] - a[1] * t0[1]; lo[1] = a[1] * t0[0] + a[0] * t0[1];
            lo[2] = a[2] * t0[2] - a[3] * t0[3]; lo[3] = a[3] * t0[2] + a[2] * t0[3];
            hi[0] = b[0] * t1[0] - b[1] * t1[1]; hi[1] = b[1] * t1[0] + b[0] * t1[1];
            hi[2] = b[2] * t1[2] - b[3] * t1[3]; hi[3] = b[3] * t1[2] + b[2] * t1[3];
        }
        u32x4 w; w.x = pk2(lo[0], lo[1]); w.y = pk2(lo[2], lo[3]); w.z = pk2(hi[0], hi[1]); w.w = pk2(hi[2], hi[3]);
        *(u32x4*)(O + (size_t)row * ldc + col) = w; return 0.f;
    }
};
struct EpiGlu {
    const bf16_t* gbuf; const float* bias; bf16_t* out;
    EPI_NO_ROW_BEGIN EPI_NO_ROW_END
    DI float oct(int, int, int row, int col, f32x4 lo, f32x4 hi, float) const {
        const u32x4 gv = *(const u32x4*)(gbuf + (size_t)row * S5_W + col);
        const f32x4 b0 = *(const f32x4*)(bias + col), b1 = *(const f32x4*)(bias + col + 4);
        float g[8] = {bflo(gv.x), bfhi(gv.x), bflo(gv.y), bfhi(gv.y), bflo(gv.z), bfhi(gv.z), bflo(gv.w), bfhi(gv.w)};
        float a[8] = {lo[0] + b0[0], lo[1] + b0[1], lo[2] + b0[2], lo[3] + b0[3], hi[0] + b1[0], hi[1] + b1[1], hi[2] + b1[2], hi[3] + b1[3]};
        float r[8];
#pragma unroll
        for (int j = 0; j < 8; ++j) r[j] = g[j] / (1.0f + __expf(-a[j]));
        u32x4 w; w.x = pk2(r[0], r[1]); w.y = pk2(r[2], r[3]); w.z = pk2(r[4], r[5]); w.w = pk2(r[6], r[7]);
        *(u32x4*)(out + (size_t)row * DM + DIFF_W + col) = w; return 0.f;
    }
};
struct EpiNull { EPI_NO_ROW_BEGIN EPI_NO_ROW_END DI float oct(int, int, int, int, f32x4 lo, f32x4 hi, float) const { asm volatile("" :: "v"(lo), "v"(hi)); return 0.f; } };
struct Params {
    const float* in[39];
    float* out; unsigned char* ws;
    int ph_lo, ph_hi;
};
enum { I_X = 0, I_MEM, I_POS, I_AB_NORM, I_AB_WIN, I_AB_WOUT, I_LQ1, I_LK1, I_LQ2, I_LK2, I_SUBLN, I_S5_ARE, I_S5_AIM, I_S5_LOGSTEP, I_S5_BRE, I_S5_BIM, I_S5_CRE, I_S5_CIM, I_S5_D,
       I_S5_WGLU, I_S5_BGLU, I_MLA_NORM, I_MLA_WIN, I_MLA_QNORM, I_MLA_KVNORM, I_MLA_WUQ, I_MLA_WUKV, I_MLA_WO, I_XA_NORM, I_XA_MEMNORM, I_XA_WQ, I_XA_WKV, I_XA_WO, I_FFN_NORM,
       I_PEER_WQ, I_PEER_SK, I_PEER_U, I_PEER_V, I_FINAL_NORM };

struct Ctx { LAS unsigned char* lds; int tid, lane, wave, blk, G; };
DI Ctx fresh(const Ctx& C0) { Ctx C = C0; C.tid = opaque_tid(); C.lane = C.tid & 63; return C; }

DI void rms_rows_2048(const Ctx& C0, const float* src, const float* gain, bf16_t* dst, int nrows) {
    const Ctx C = fresh(C0);
    for (int r = C.blk * NWAVES + C.wave; r < nrows; r += C.G * NWAVES) {
        const f32x4* xr = (const f32x4*)(src + (size_t)r * DM) + C.lane;
        f32x4 v[8]; float ss = 0.f;
#pragma unroll
        for (int j = 0; j < 8; ++j) { v[j] = xr[64 * j]; ss += (v[j][0] * v[j][0] + v[j][1] * v[j][1]) + (v[j][2] * v[j][2] + v[j][3] * v[j][3]); }
        const float sc = rsqrtf(wave_sum(ss) * (1.0f / DM) + NORM_EPS);
        u32x2* o = (u32x2*)(dst + (size_t)r * DM) + C.lane;
#pragma unroll
        for (int j = 0; j < 8; ++j) { const f32x4 g = *((const f32x4*)gain + C.lane + 64 * j);
            u32x2 w; w.x = pk2(v[j][0] * sc * g[0], v[j][1] * sc * g[1]); w.y = pk2(v[j][2] * sc * g[2], v[j][3] * sc * g[3]); o[64 * j] = w; }
    }
}
DI void rms_rows_final(const Ctx& C0, const bf16_t* xbp, float* out, const float* gain, int nrows) {
    const Ctx C = fresh(C0);
    for (int r = C.blk * NWAVES + C.wave; r < nrows; r += C.G * NWAVES) {
        const u32x2* xr = (const u32x2*)(xbp + (size_t)r * DM) + C.lane;
        f32x4 v[8]; float ss = 0.f;
#pragma unroll
        for (int j = 0; j < 8; ++j) { const u32x2 w = xr[64 * j]; v[j] = (f32x4){bflo(w.x), bfhi(w.x), bflo(w.y), bfhi(w.y)}; ss += (v[j][0] * v[j][0] + v[j][1] * v[j][1]) + (v[j][2] * v[j][2] + v[j][3] * v[j][3]); }
        const float sc = rsqrtf(wave_sum(ss) * (1.0f / DM) + NORM_EPS);
        f32x4* o = (f32x4*)(out + (size_t)r * DM) + C.lane;
#pragma unroll
        for (int j = 0; j < 8; ++j) { const f32x4 g = *((const f32x4*)gain + C.lane + 64 * j); o[64 * j] = v[j] * sc * g; }
    }
}

DI int srccol(int kind, int n) {
    if (kind == 1) { if (n < 2 * DIFF_W) { const int j = n & 63; return (n & ~63) + (j >> 1) + 32 * (j & 1); } return n; }
    if (kind == 2) { if (n >= MLA_IN) return -1; if (n >= 1024) { const int j = n - 1024; return 1024 + (j >> 1) + 32 * (j & 1); } return n; }
    if (kind == 3) { const int c = n % 192; if (c >= 128) { const int j = c - 128; return n - c + 128 + (j >> 1) + 32 * (j & 1); } return n; }
    return n;
}
DI void transpose_item(const float* W, int K, int Nsrc, bf16_t* Wt, int nblk, int kind, const float* kgain, LAS float* scr, int item, int lane) {
    const int kb = item / nblk, nb = item % nblk, k0 = 64 * kb, n0 = 32 * nb;
    const int src = srccol(kind, n0 + (lane & 31));
#pragma unroll 8
    for (int i = 0; i < 32; ++i) { const int kk = 2 * i + (lane >> 5); scr[kk * 33 + (lane & 31)] = (src >= 0) ? W[(size_t)(k0 + kk) * Nsrc + src] * (kgain ? kgain[k0 + kk] : 1.0f) : 0.f; }
    LDS_WAIT(); asm volatile("" ::: "memory");
    const int c = lane & 7;
#pragma unroll
    for (int j = 0; j < 4; ++j) { const int n = (lane >> 3) + 8 * j; const LAS float* s = scr + (8 * c) * 33 + n;
        u32x4 o; o.x = pk2(s[0 * 33], s[1 * 33]); o.y = pk2(s[2 * 33], s[3 * 33]); o.z = pk2(s[4 * 33], s[5 * 33]); o.w = pk2(s[6 * 33], s[7 * 33]);
        *(u32x4*)(Wt + (size_t)(n0 + n) * K + k0 + 8 * c) = o; }
    LDS_WAIT(); asm volatile("" ::: "memory");
}
DI void cvt_bf16(const Ctx& C0, const float* src, bf16_t* dst, size_t n8) {
    const Ctx C = fresh(C0);
    for (size_t i = (size_t)C.blk * NTHREADS + C.tid; i < n8; i += (size_t)C.G * NTHREADS) {
        const f32x4 a = *(const f32x4*)(src + i * 8), b = *(const f32x4*)(src + i * 8 + 4);
        u32x4 w; w.x = pk2(a[0], a[1]); w.y = pk2(a[2], a[3]); w.z = pk2(b[0], b[1]); w.w = pk2(b[2], b[3]);
        *(u32x4*)(dst + i * 8) = w;
    }
}


DI void cvt_fp8_rows(const Ctx& C0, const float* src, unsigned char* dst, float* isc, int nrows) {
    const Ctx C = fresh(C0);
    for (int r = C.blk * NWAVES + C.wave; r < nrows; r += C.G * NWAVES) {
        const f32x4* xr = (const f32x4*)(src + (size_t)r * DM) + C.lane;
        f32x4 v[8]; float am = 0.f;
#pragma unroll
        for (int j = 0; j < 8; ++j) { v[j] = xr[64 * j]; am = fmaxf(am, fmaxf(fmaxf(fabsf(v[j][0]), fabsf(v[j][1])), fmaxf(fabsf(v[j][2]), fabsf(v[j][3])))); }
#pragma unroll
        for (int o = 1; o < 64; o <<= 1) am = fmaxf(am, __shfl_xor(am, o));
        const float e = am > 0.f ? floorf(log2f(448.0f / am)) : 0.f;
        const float scale = exp2f(e);
        if (C.lane == 0) isc[r] = exp2f(-e);
#if PEER_SLICED
        unsigned* o = (unsigned*)(dst + (size_t)(C.lane >> 5) * ((size_t)PEER_NE * 128) + (size_t)r * 128) + (C.lane & 31);
#pragma unroll
        for (int j = 0; j < 8; ++j) { int w = 0; w = __builtin_amdgcn_cvt_pk_fp8_f32(v[j][0] * scale, v[j][1] * scale, w, false); w = __builtin_amdgcn_cvt_pk_fp8_f32(v[j][2] * scale, v[j][3] * scale, w, true); o[(size_t)2 * j * (PEER_NE * 128 / 4)] = (unsigned)w; }
#else
        unsigned* o = (unsigned*)(dst + (size_t)r * DM) + C.lane;
#pragma unroll
        for (int j = 0; j < 8; ++j) { int w = 0; w = __builtin_amdgcn_cvt_pk_fp8_f32(v[j][0] * scale, v[j][1] * scale, w, false); w = __builtin_amdgcn_cvt_pk_fp8_f32(v[j][2] * scale, v[j][3] * scale, w, true); o[64 * j] = (unsigned)w; }
#endif
    }
}


DI void cvt_i8_rows(const Ctx& C0, const float* src, const float* cgain, unsigned char* dst, float* isc, int nrows) {
    const Ctx C = fresh(C0);
    for (int r = C.blk * NWAVES + C.wave; r < nrows; r += C.G * NWAVES) {
        const f32x4* xr = (const f32x4*)(src + (size_t)r * DM) + C.lane;
        f32x4 v[8]; float am = 0.f;
#pragma unroll
        for (int j = 0; j < 8; ++j) { v[j] = xr[64 * j] * *((const f32x4*)cgain + C.lane + 64 * j); am = fmaxf(am, fmaxf(fmaxf(fabsf(v[j][0]), fabsf(v[j][1])), fmaxf(fabsf(v[j][2]), fabsf(v[j][3])))); }
#pragma unroll
        for (int o = 1; o < 64; o <<= 1) am = fmaxf(am, __shfl_xor(am, o));
        const float scale = am > 0.f ? 127.0f / am : 0.f;
        if (C.lane == 0) isc[r] = am * (1.0f / 127.0f);
        unsigned* o = (unsigned*)(dst + (size_t)(C.lane >> 5) * ((size_t)PEER_NE * 128) + (size_t)r * 128) + (C.lane & 31);
#pragma unroll
        for (int j = 0; j < 8; ++j) { const int q0 = (int)rintf(v[j][0] * scale), q1 = (int)rintf(v[j][1] * scale), q2 = (int)rintf(v[j][2] * scale), q3 = (int)rintf(v[j][3] * scale);
            o[(size_t)2 * j * (PEER_NE * 128 / 4)] = (unsigned)(q0 & 255) | ((unsigned)(q1 & 255) << 8) | ((unsigned)(q2 & 255) << 16) | ((unsigned)(q3 & 255) << 24); }
    }
}

DI void convert_tables(const Ctx& C, const Params& P, int l) {
    unsigned char* ws = P.ws;
#if PEER_FP8
#if PEER_SLICED
    cvt_i8_rows(C, P.in[I_PEER_U] + (size_t)l * PEER_NE * DM, P.in[I_FFN_NORM] + l * DM, ws + P_UT, (float*)(ws + P_UT + 32 * MiB), PEER_NE);
#else
    cvt_fp8_rows(C, P.in[I_PEER_U] + (size_t)l * PEER_NE * DM, ws + P_UT, (float*)(ws + P_UT + 32 * MiB), PEER_NE);
#endif
    cvt_fp8_rows(C, P.in[I_PEER_V] + (size_t)l * PEER_NE * DM, ws + P_VT, (float*)(ws + P_VT + 32 * MiB), PEER_NE);
#else
    cvt_bf16(C, P.in[I_PEER_U] + (size_t)l * PEER_NE * DM, (bf16_t*)(ws + P_UT), (size_t)PEER_NE * DM / 8);
    cvt_bf16(C, P.in[I_PEER_V] + (size_t)l * PEER_NE * DM, (bf16_t*)(ws + P_VT), (size_t)PEER_NE * DM / 8);
#endif
}

DI void phase_prologue(const Ctx& C0, const Params& P) {
    const Ctx C = fresh(C0);
    unsigned char* ws = P.ws;
    LAS float* scr = (LAS float*)(C.lds + C.wave * 8448);
    const int gw = C.blk * NWAVES + C.wave, NGW = C.G * NWAVES;
    int base = 0;
#define TJOB(Wp, K_, Nsrc_, Nout_, kind_, dst_, kg_) do { const int nblk_ = (Nout_) / 32, nit_ = ((K_) / 64) * nblk_; \
        int first_ = (gw - base % NGW + NGW) % NGW; \
        for (int it = first_; it < nit_; it += NGW) transpose_item((Wp), (K_), (Nsrc_), (bf16_t*)(dst_), nblk_, (kind_), (kg_), scr, it, C.lane); base += nit_; } while (0)
    TJOB(P.in[I_AB_WIN], DM, AB_IN, AB_IN, 1, ws + WS_ABIN_T, nullptr);
    TJOB(P.in[I_AB_WOUT], DM, DM, DM, 0, ws + WS_ABOUT_T, nullptr);
    TJOB(P.in[I_S5_WGLU], S5_W, S5_W, S5_W, 0, ws + WS_GLU_T, nullptr);
    TJOB(P.in[I_MLA_WIN], DM, MLA_IN, MLA_IN_PAD, 2, ws + WS_MLAIN_T, P.in[I_MLA_NORM]);
    TJOB(P.in[I_MLA_WUQ], MLA_QR, 3072, 3072, 3, ws + WS_UQ_T, nullptr);
    TJOB(P.in[I_MLA_WUKV], MLA_KVR, 4096, 4096, 0, ws + WS_UKV_T, nullptr);
    TJOB(P.in[I_MLA_WO], DM, DM, DM, 0, ws + WS_MLAO_T, nullptr);
    for (int l = 0; l < 2; ++l) {
        TJOB(P.in[I_XA_WQ] + (size_t)l * DM * DM, DM, DM, DM, 0, ws + WS_LW + l * LW_STRIDE + LW_XQ, P.in[I_XA_NORM] + l * DM);
        TJOB(P.in[I_XA_WKV] + (size_t)l * DM * 2 * DM, DM, 2 * DM, 2 * DM, 0, ws + WS_LW + l * LW_STRIDE + LW_XKV, nullptr);
        TJOB(P.in[I_XA_WO] + (size_t)l * DM * DM, DM, DM, DM, 0, ws + WS_LW + l * LW_STRIDE + LW_XO, nullptr);
    }
#undef TJOB
    {
        f32x2* tab = (f32x2*)(ws + WS_ROPE);
        for (int i = C.blk * NTHREADS + C.tid; i < ROPE_POS * 32; i += C.G * NTHREADS) {
            const int p = i >> 5, f = i & 31;
            const float inv = powf(10000.0f, -(float)f * (2.0f / 64.0f));
            const float ang = (float)p * inv;
            tab[i] = (f32x2){(float)cos((double)ang), (float)sin((double)ang)};
        }
    }
    {
        const float* src = P.in[I_PEER_WQ]; bf16_t* dst = (bf16_t*)(ws + P_WQB);
        for (size_t i = (size_t)C.blk * NTHREADS + C.tid; i < (size_t)2 * DM * DM / 8; i += (size_t)C.G * NTHREADS) {
            const float g = P.in[I_FFN_NORM][i / (DM / 8)];
            const f32x4 a = *(const f32x4*)(src + i * 8), b = *(const f32x4*)(src + i * 8 + 4);
            u32x4 w; w.x = pk2(a[0] * g, a[1] * g); w.y = pk2(a[2] * g, a[3] * g); w.z = pk2(b[0] * g, b[1] * g); w.w = pk2(b[2] * g, b[3] * g);
            *(u32x4*)(dst + i * 8) = w;
        }
    }
    {
        bf16_t* sk = (bf16_t*)(ws + P_SK); const float* skin = P.in[I_PEER_SK];
        for (int i = C.blk * NTHREADS + C.tid; i < 2 * 8 * 256 * 256 / 8; i += C.G * NTHREADS) {
            const int q8 = (i & 31) * 8, np = (i >> 5) & 255, lh = i >> 13;
            const int c = np >> 7, n = np & 127, c2 = q8 >> 7, q = q8 & 127;
            u32x4 w = {0u, 0u, 0u, 0u};
            if (c == c2) { const float* s = skin + ((((size_t)lh * 2 + c) * 128 + n) * 128 + q);
                const f32x4 a = *(const f32x4*)s, b = *(const f32x4*)(s + 4);
                w.x = pk2(a[0], a[1]); w.y = pk2(a[2], a[3]); w.z = pk2(b[0], b[1]); w.w = pk2(b[2], b[3]); }
            *(u32x4*)(sk + (size_t)i * 8) = w;
        }
    }
    convert_tables(C, P, 0);
    for (int l = 0; l < 2; ++l) rms_rows_2048(C, P.in[I_MEM], P.in[I_XA_MEMNORM] + l * DM, (bf16_t*)(ws + P_MEMN) + (size_t)l * MT * DM, MT);
}

DI void phase_s5(const Ctx& C0, const Params& P, int first, int last, int stride_w, int stride) {
    const Ctx C = fresh(C0);
    unsigned char* ws = P.ws;
    const bf16_t* proj = (const bf16_t*)(ws + P_PROJ); bf16_t* gbuf = (bf16_t*)(ws + P_GBUF);
    LAS unsigned char* my = C.lds + C.wave * 8192;
    LAS float* U = (LAS float*)my;
    LAS bf16_t* H = (LAS bf16_t*)(my + 1024);
    const int lane = C.lane, n = lane;
    for (int task = first + C.wave * stride_w; task < last; task += stride) {
        const int b = task >> 5, g = task & 31;
        const float a_re = P.in[I_S5_ARE][g * 64 + n], a_im = P.in[I_S5_AIM][g * 64 + n];
        const float step = expf(P.in[I_S5_LOGSTEP][g]);
        const float mag = expf(a_re * step);
        const float ab_re = mag * cosf(a_im * step), ab_im = mag * sinf(a_im * step);
        const float den = a_re * a_re + a_im * a_im, num_re = ab_re - 1.0f;
        const float f_re = (num_re * a_re + ab_im * a_im) / den, f_im = (ab_im * a_re - num_re * a_im) / den;
        float bbr[16], bbi[16];
        {
            const float* br = P.in[I_S5_BRE] + ((size_t)g * 64 + n) * 16; const float* bi = P.in[I_S5_BIM] + ((size_t)g * 64 + n) * 16;
#pragma unroll
            for (int p = 0; p < 16; ++p) { const float x = br[p], y = bi[p]; bbr[p] = f_re * x - f_im * y; bbi[p] = f_re * y + f_im * x; }
        }
        bf16x8 cf[4];
        {
            const int p = lane & 15, kq = lane >> 4;
#pragma unroll
            for (int kk = 0; kk < 4; ++kk) {
                const int k = 32 * kk + 8 * kq; const bool im = k >= 64;
                const float* src = (im ? P.in[I_S5_CIM] : P.in[I_S5_CRE]) + ((size_t)g * 16 + p) * 64 + (k & 63);
                const float sg = im ? -1.f : 1.f;
                const f32x4 a = *(const f32x4*)src, bq = *(const f32x4*)(src + 4);
                u32x4 w; w.x = pk2(sg * a[0], sg * a[1]); w.y = pk2(sg * a[2], sg * a[3]); w.z = pk2(sg * bq[0], sg * bq[1]); w.w = pk2(sg * bq[2], sg * bq[3]);
                cf[kk] = __builtin_bit_cast(bf16x8, w);
            }
        }
        const float dcoef = P.in[I_S5_D][g * 16 + (lane & 15)];
        float h_re = 0.f, h_im = 0.f;
        const bf16_t* ub = proj + (size_t)b * SEQ * AB_IN + 3 * DIFF_W + g * 16;
        for (int s0 = 0; s0 < SEQ; s0 += 16) {
            {
                const int st = lane >> 2, pp = (lane & 3) * 4;
                const u32x2 uv = *(const u32x2*)(ub + (size_t)(s0 + st) * AB_IN + pp);
                *(LAS f32x4*)(U + st * 16 + pp) = (f32x4){bflo(uv.x), bfhi(uv.x), bflo(uv.y), bfhi(uv.y)};
            }
            LDS_WAIT(); asm volatile("" ::: "memory");
#pragma unroll 4
            for (int st = 0; st < 16; ++st) {
                const f32x4 u0 = *(const LAS f32x4*)(U + st * 16), u1 = *(const LAS f32x4*)(U + st * 16 + 4), u2 = *(const LAS f32x4*)(U + st * 16 + 8), u3 = *(const LAS f32x4*)(U + st * 16 + 12);
                const float uu[16] = {u0[0], u0[1], u0[2], u0[3], u1[0], u1[1], u1[2], u1[3], u2[0], u2[1], u2[2], u2[3], u3[0], u3[1], u3[2], u3[3]};
                float br = 0.f, bi = 0.f;
#pragma unroll
                for (int p = 0; p < 16; ++p) { br = fmaf(bbr[p], uu[p], br); bi = fmaf(bbi[p], uu[p], bi); }
                const float nr = ab_re * h_re - ab_im * h_im + br, ni = ab_re * h_im + ab_im * h_re + bi;
                h_re = nr; h_im = ni;
                H[st * 136 + n] = f2bf(h_re); H[st * 136 + 64 + n] = f2bf(h_im);
            }
            LDS_WAIT(); asm volatile("" ::: "memory");
            f32x4 acc = {0.f, 0.f, 0.f, 0.f};
#pragma unroll
            for (int kk = 0; kk < 4; ++kk) {
                const bf16x8 af = *(const LAS bf16x8*)((LAS unsigned char*)H + (lane & 15) * 272 + (32 * kk + 8 * (lane >> 4)) * 2);
                acc = __builtin_amdgcn_mfma_f32_16x16x32_bf16(af, cf[kk], acc, 0, 0, 0);
            }
#pragma unroll
            for (int r = 0; r < 4; ++r) {
                const int st = (lane >> 4) * 4 + r, p = lane & 15;
                const float y = acc[r] + dcoef * U[st * 16 + p];
                gbuf[(size_t)(b * SEQ + s0 + st) * S5_W + g * 16 + p] = f2bf(gelu_erf(y));
            }
            LDS_WAIT(); asm volatile("" ::: "memory");
        }
    }
}

struct AttnArgs { const bf16_t* Qn; const bf16_t* Qr; const bf16_t* Kn; const bf16_t* Kr; const bf16_t* V; int ldq, ldkn, ldkr, ldv; };
DI int crow(int r, int hi) { return (r & 3) + 8 * (r >> 2) + 4 * hi; }
template <int DK> DI int koff(int row, int ch) { return DK == 64 ? row * 128 + 16 * (ch ^ ((row >> 1) & 7)) : row * 256 + 16 * (ch ^ (row & 15)); }
DI int voff(int row, int ch) { return 256 * row + 16 * (ch ^ (((row & 3) << 2) | ((row >> 2) & 3))); }
DI bf16x8 pack8(const f32x16& p, int s) {
    u32x4 w; w.x = pk2(p[8 * s + 0], p[8 * s + 1]); w.y = pk2(p[8 * s + 2], p[8 * s + 3]); w.z = pk2(p[8 * s + 4], p[8 * s + 5]); w.w = pk2(p[8 * s + 6], p[8 * s + 7]);
    return __builtin_bit_cast(bf16x8, w);
}
DI s16x4 vtr(const LAS unsigned char* p) { return __builtin_bit_cast(s16x4, __builtin_amdgcn_ds_read_tr16_b64_v4i16((LAS s16x4*)p)); }

template <int DKN, int DKR>
DI void attn_core(const AttnArgs& a, int q0, LAS unsigned char* lds, float scale, f32x16 (&o)[4]) {
    const int tid = opaque_tid(), wid = __builtin_amdgcn_readfirstlane(tid >> 6), lane = tid & 63, r32 = lane & 31, hi = lane >> 5;
    constexpr int CN = DKN / 8, NLK = CN * 64 / NTHREADS, KNB = 64 * DKN * 2, KRB = 64 * DKR * 2, VOFF = KNB + KRB, BUF = VOFF + 16384;
    static_assert(2 * BUF <= RING_BYTES, "attention LDS");
    bf16x8 qn[DKN / 16]; bf16x8 qr[DKR ? DKR / 16 : 1];
    {
        const bf16_t* qp = a.Qn + (size_t)(q0 + 32 * wid + r32) * a.ldq + hi * 8;
#pragma unroll
        for (int d0 = 0; d0 < DKN / 16; ++d0) qn[d0] = *(const bf16x8*)(qp + d0 * 16);
        if (DKR) { const bf16_t* qp2 = a.Qr + (size_t)(q0 + 32 * wid + r32) * a.ldq + hi * 8;
#pragma unroll
            for (int d0 = 0; d0 < DKR / 16; ++d0) qr[d0] = *(const bf16x8*)(qp2 + d0 * 16); }
    }
    const int NT = (q0 + 256) / 64, NTw = (q0 + 32 * wid + 31) / 64 + 1;
    u32x4 skn[NLK], skr, sv[2];
#define AT_LOAD(t) do { _Pragma("unroll") for (int i_ = 0; i_ < NLK; ++i_) { const int id_ = tid + NTHREADS * i_, row_ = id_ / CN, ch_ = id_ % CN; \
            skn[i_] = *(const u32x4*)(a.Kn + (size_t)((t) * 64 + row_) * a.ldkn + ch_ * 8); } \
        if (DKR) { const int row_ = tid >> 3, ch_ = tid & 7; skr = *(const u32x4*)(a.Kr + (size_t)((t) * 64 + row_) * a.ldkr + ch_ * 8); } \
        _Pragma("unroll") for (int i_ = 0; i_ < 2; ++i_) { const int id_ = tid + NTHREADS * i_, row_ = id_ >> 4, ch_ = id_ & 15; \
            sv[i_] = *(const u32x4*)(a.V + (size_t)((t) * 64 + row_) * a.ldv + ch_ * 8); } } while (0)
#define AT_WRITE(bf) do { LAS unsigned char* bb_ = lds + (bf) * BUF; \
        _Pragma("unroll") for (int i_ = 0; i_ < NLK; ++i_) { const int id_ = tid + NTHREADS * i_, row_ = id_ / CN, ch_ = id_ % CN; *(LAS u32x4*)(bb_ + koff<DKN>(row_, ch_)) = skn[i_]; } \
        if (DKR) { const int row_ = tid >> 3, ch_ = tid & 7; *(LAS u32x4*)(bb_ + KNB + koff<64>(row_, ch_)) = skr; } \
        _Pragma("unroll") for (int i_ = 0; i_ < 2; ++i_) { const int id_ = tid + NTHREADS * i_, row_ = id_ >> 4, ch_ = id_ & 15; *(LAS u32x4*)(bb_ + VOFF + voff(row_, ch_)) = sv[i_]; } } while (0)
    const float Cs = scale * 1.4426950408889634f;
    float m_run = -1e30f, l_run = 0.f;
#pragma unroll
    for (int blk = 0; blk < 4; ++blk)
#pragma unroll
        for (int r = 0; r < 16; ++r) o[blk][r] = 0.f;
    AT_LOAD(0); AT_WRITE(0);
#pragma unroll
    for (int d0 = 0; d0 < DKN / 16; ++d0) asm volatile("" : "+v"(qn[d0]));
    if (DKR) {
#pragma unroll
        for (int d0 = 0; d0 < DKR / 16; ++d0) asm volatile("" : "+v"(qr[d0]));
    }
    if (NT > 1) AT_LOAD(1);
    for (int t = 0; t < NT; ++t) {
        __syncthreads();
        if (t + 1 < NT) AT_WRITE((t + 1) & 1);
        if (t + 2 < NT) AT_LOAD(t + 2);
        if (t < NTw) {
            const LAS unsigned char* base = lds + (t & 1) * BUF;
            int r32v = r32, lanev = lane; asm volatile("" : "+v"(r32v), "+v"(lanev));
            int vb[4][2];
            {
                const int i = lanev & 15, q_ = i >> 2, p_ = i & 3, grp1 = (lanev >> 4) & 1, hv = lanev >> 5, low2 = 2 * grp1 + (p_ >> 1);
#pragma unroll
                for (int blk = 0; blk < 4; ++blk)
#pragma unroll
                    for (int x = 0; x < 2; ++x) vb[blk][x] = VOFF + 256 * (8 * x + 4 * hv + q_) + 16 * (4 * (blk ^ q_) + (low2 ^ (hv + 2 * x))) + 8 * (p_ & 1);
            }
            f32x16 p0, p1;
#pragma unroll
            for (int r = 0; r < 16; ++r) { p0[r] = 0.f; p1[r] = 0.f; }
            {
                constexpr int NDN = DKN / 16, NDT = NDN + DKR / 16;
#pragma unroll
                for (int g0 = 0; g0 < NDT; g0 += 4) {
                    bf16x8 kb0[4], kb1[4];
#pragma unroll
                    for (int i = 0; i < 4; ++i) { const int dd = g0 + i;
                        if (dd < NDN) { kb0[i] = *(const LAS bf16x8*)(base + koff<DKN>(r32v, 2 * dd + hi)); kb1[i] = *(const LAS bf16x8*)(base + koff<DKN>(32 + r32v, 2 * dd + hi)); }
                        else { kb0[i] = *(const LAS bf16x8*)(base + KNB + koff<64>(r32v, 2 * (dd - NDN) + hi)); kb1[i] = *(const LAS bf16x8*)(base + KNB + koff<64>(32 + r32v, 2 * (dd - NDN) + hi)); } }
#pragma unroll
                    for (int i = 0; i < 4; ++i) asm volatile("" : "+v"(kb0[i]), "+v"(kb1[i]));
#pragma unroll
                    for (int i = 0; i < 4; ++i) { const int dd = g0 + i;
                        const bf16x8 qf = dd < NDN ? qn[dd < NDN ? dd : 0] : qr[dd >= NDN ? dd - NDN : 0];
                        p0 = __builtin_amdgcn_mfma_f32_32x32x16_bf16(kb0[i], qf, p0, 0, 0, 0); p1 = __builtin_amdgcn_mfma_f32_32x32x16_bf16(kb1[i], qf, p1, 0, 0, 0); }
                }
            }
            if (t == NTw - 1) {
                const int qrel = q0 + 32 * wid + r32 - 64 * t;
#pragma unroll
                for (int r = 0; r < 16; ++r) { const int kv = crow(r, hi); if (kv > qrel) p0[r] = -INFINITY; if (kv + 32 > qrel) p1[r] = -INFINITY; }
            }
            float pmax = p0[0];
#pragma unroll
            for (int r = 1; r < 16; ++r) pmax = fmaxf(pmax, p0[r]);
#pragma unroll
            for (int r = 0; r < 16; ++r) pmax = fmaxf(pmax, p1[r]);
            pmax = swap32_max(pmax);
            const float mn = fmaxf(m_run, pmax);
            const float alpha = __builtin_amdgcn_exp2f((m_run - mn) * Cs);
            m_run = mn;
            const float mnC = -mn * Cs;
            float ps = 0.f;
#pragma unroll
            for (int r = 0; r < 16; ++r) { p0[r] = __builtin_amdgcn_exp2f(fmaf(p0[r], Cs, mnC)); p1[r] = __builtin_amdgcn_exp2f(fmaf(p1[r], Cs, mnC)); ps += p0[r] + p1[r]; }
            l_run = l_run * alpha + ps;
            if (!__all(alpha == 1.0f)) {
#pragma unroll
                for (int blk = 0; blk < 4; ++blk)
#pragma unroll
                    for (int r = 0; r < 16; ++r) o[blk][r] *= alpha;
            }
            bf16x8 pb[4]; pb[0] = pack8(p0, 0); pb[1] = pack8(p0, 1); pb[2] = pack8(p1, 0); pb[3] = pack8(p1, 1);
            {
                s16x4 lo[2][4], hh[2][4];
#pragma unroll
                for (int ks = 0; ks < 4; ++ks) { lo[0][ks] = vtr(base + vb[0][0] + 4096 * ks); hh[0][ks] = vtr(base + vb[0][1] + 4096 * ks); }
#pragma unroll
                for (int blk = 0; blk < 4; ++blk) {
                    if (blk + 1 < 4) {
#pragma unroll
                        for (int ks = 0; ks < 4; ++ks) { lo[(blk + 1) & 1][ks] = vtr(base + vb[blk + 1][0] + 4096 * ks); hh[(blk + 1) & 1][ks] = vtr(base + vb[blk + 1][1] + 4096 * ks); }
                    }
#pragma unroll
                    for (int ks = 0; ks < 4; ++ks) {
                        const s16x4 l_ = lo[blk & 1][ks], h_ = hh[blk & 1][ks];
                        const bf16x8 af = {l_[0], l_[1], l_[2], l_[3], h_[0], h_[1], h_[2], h_[3]};
                        o[blk] = __builtin_amdgcn_mfma_f32_32x32x16_bf16(af, pb[ks], o[blk], 0, 0, 0);
                    }
                    __builtin_amdgcn_sched_barrier(0);
                }
            }
        }
    }
    __syncthreads();
    const float linv = 1.0f / swap32_sum(l_run);
#pragma unroll
    for (int blk = 0; blk < 4; ++blk)
#pragma unroll
        for (int r = 0; r < 16; ++r) o[blk][r] *= linv;
#undef AT_LOAD
#undef AT_WRITE
}
DI void attn_store(const f32x16 (&o)[4], bf16_t* dst, int ld, int q0) {
    const int tid = opaque_tid(), wid = tid >> 6, lane = tid & 63, r32 = lane & 31, hi = lane >> 5;
    bf16_t* rp = dst + (size_t)(q0 + 32 * wid + r32) * ld;
#pragma unroll
    for (int blk = 0; blk < 4; ++blk)
#pragma unroll
        for (int g = 0; g < 4; ++g) {
            u32x2 w; w.x = pk2(o[blk][4 * g], o[blk][4 * g + 1]); w.y = pk2(o[blk][4 * g + 2], o[blk][4 * g + 3]);
            *(u32x2*)(rp + 32 * blk + 8 * g + 4 * hi) = w;
        }
}
DI int queue_pop(const Ctx& C0, unsigned* ctr, int total) {
    const Ctx C = fresh(C0);
    volatile LAS int* slot = (volatile LAS int*)(C.lds + LDSCTL_OFF + 64);
    __syncthreads();
    if (C.tid == 0) *slot = (int)__hip_atomic_fetch_add(ctr, 1u, __ATOMIC_RELAXED, __HIP_MEMORY_SCOPE_AGENT);
    __syncthreads();
    const int u = *slot;
    return u < total ? u : -1;
}
DI float diff_lambda(const Params& P) {
    float s1 = 0.f, s2 = 0.f;
    for (int i = 0; i < 64; ++i) { s1 += P.in[I_LQ1][i] * P.in[I_LK1][i]; s2 += P.in[I_LQ2][i] * P.in[I_LK2][i]; }
    return expf(s1) - expf(s2) + 0.2f;
}

#if FAST_ATTN
DI void phase_diff_attn(const Ctx& C0, const Params& P, int qi) {
    const Ctx C = fresh(C0);
    unsigned char* ws = P.ws;
    const bf16_t* proj = (const bf16_t*)(ws + P_PROJ); bf16_t* concat = (bf16_t*)(ws + P_CONCAT);
    unsigned* ctr = (unsigned*)(ws + WS_CTL) + CW_CTR + 64 * qi;
    const float lam = diff_lambda(P);
    const int NBH = BATCH * DIFF_HEADS, NS5 = BATCH * 32 / NWAVES, total = NS5 + NBH * 8;
    const int lane = C.lane, r32 = lane & 31, hi = lane >> 5;
    for (;;) {
        int u = queue_pop(C, ctr, total); if (u < 0) break;
        if (u < NS5) { phase_s5(C, P, u * NWAVES, u * NWAVES + NWAVES, 1, NWAVES); continue; }
        u -= NS5;
        const int qb = 7 - u / NBH, bh = u % NBH, b = bh / DIFF_HEADS, h = bh % DIFF_HEADS;
        const bf16_t* base = proj + (size_t)b * SEQ * AB_IN;
        AttnArgs a; a.ldq = AB_IN; a.ldkn = AB_IN; a.ldkr = 0; a.ldv = AB_IN; a.Qr = nullptr; a.Kr = nullptr;
        a.V = base + 2 * DIFF_W + h * 128;
        f32x16 o2[4];
        bf16_t* dst = concat + (size_t)b * SEQ * DM + h * 128;
        a.Qn = base + h * 128; a.Kn = base + DIFF_W + h * 128;
        attn_core<64, 0>(a, qb * 256, C.lds, 0.125f, o2);
        attn_store(o2, dst, DM, qb * 256);
        a.Qn = base + h * 128 + 64; a.Kn = base + DIFF_W + h * 128 + 64;
        attn_core<64, 0>(a, qb * 256, C.lds, 0.125f, o2);
        float ss = 0.f;
        {
            const bf16_t* rp = dst + (size_t)(qb * 256 + 32 * C.wave + r32) * DM;
#pragma unroll
            for (int blk = 0; blk < 4; ++blk)
#pragma unroll
                for (int g = 0; g < 4; ++g) {
                    const u32x2 w = *(const u32x2*)(rp + 32 * blk + 8 * g + 4 * hi);
                    const float o1v[4] = {bflo(w.x), bfhi(w.x), bflo(w.y), bfhi(w.y)};
#pragma unroll
                    for (int j = 0; j < 4; ++j) { const float v = o1v[j] - lam * o2[blk][4 * g + j]; o2[blk][4 * g + j] = v; ss += v * v; }
                }
        }
        ss = swap32_sum(ss);
        const float rs = rsqrtf(ss * (1.0f / 128.0f) + NORM_EPS) * 0.8f;
        const float* sub = P.in[I_SUBLN];
#pragma unroll
        for (int blk = 0; blk < 4; ++blk)
#pragma unroll
            for (int r = 0; r < 16; ++r) o2[blk][r] *= rs * sub[32 * blk + crow(r, hi)];
        attn_store(o2, dst, DM, qb * 256);
    }
}
DI void phase_mla_attn(const Ctx& C0, const Params& P, int qi) {
    const Ctx C = fresh(C0);
    unsigned char* ws = P.ws;
    const bf16_t* q = (const bf16_t*)(ws + P_Q); const bf16_t* kv = (const bf16_t*)(ws + P_KV); const bf16_t* kr = (const bf16_t*)(ws + P_KROPE);
    bf16_t* ob = (bf16_t*)(ws + P_H);
    unsigned* ctr = (unsigned*)(ws + WS_CTL) + CW_CTR + 64 * qi;
    const int NBH = BATCH * MLA_HEADS, total = NBH * 8;
    for (;;) {
        const int u = queue_pop(C, ctr, total); if (u < 0) break;
        const int qb = 7 - u / NBH, bh = u % NBH, b = bh / MLA_HEADS, h = bh % MLA_HEADS;
        AttnArgs a; a.ldq = 3072; a.ldkn = 4096; a.ldkr = 64; a.ldv = 4096;
        a.Qn = q + (size_t)b * SEQ * 3072 + h * 192; a.Qr = a.Qn + 128;
        a.Kn = kv + (size_t)b * SEQ * 4096 + h * 256; a.V = a.Kn + 128; a.Kr = kr + (size_t)b * SEQ * 64;
        f32x16 o[4];
        attn_core<128, 64>(a, qb * 256, C.lds, 0.07216878364870322f, o);
        attn_store(o, ob + (size_t)b * SEQ * DM + h * 128, DM, qb * 256);
    }
}
#else
template <int DK> DI void naive_attn_row(const bf16_t* qrow, const bf16_t* qrow2, const bf16_t* Kn, int ldkn, const bf16_t* Kr, int ldkr, const bf16_t* V, int ldv, int nkeys, float scale, int lane, float& o0, float& o1) {
    float qv[3];
#pragma unroll
    for (int j = 0; j < 3; ++j) { const int d = lane + 64 * j; qv[j] = 0.f; if (d < DK) qv[j] = (DK == 192 && d >= 128) ? bf2f(qrow2[d - 128]) : bf2f(qrow[d]); }
    float m = -1e30f, l = 0.f; o0 = 0.f; o1 = 0.f;
    for (int k = 0; k < nkeys; ++k) {
        float s = 0.f;
#pragma unroll
        for (int j = 0; j < 3; ++j) { const int d = lane + 64 * j; if (d < DK) { const float kvv = (DK == 192 && d >= 128) ? bf2f(Kr[(size_t)k * ldkr + d - 128]) : bf2f(Kn[(size_t)k * ldkn + d]); s += qv[j] * kvv; } }
        s = wave_sum(s) * scale;
        const float mn = fmaxf(m, s), al = expf(m - mn), p = expf(s - mn);
        m = mn; l = l * al + p;
        o0 = o0 * al + p * bf2f(V[(size_t)k * ldv + lane]); o1 = o1 * al + p * bf2f(V[(size_t)k * ldv + 64 + lane]);
    }
    o0 /= l; o1 /= l;
}
DI void phase_diff_attn(const Ctx& C, const Params& P, int) {
    unsigned char* ws = P.ws;
    const bf16_t* proj = (const bf16_t*)(ws + P_PROJ); bf16_t* concat = (bf16_t*)(ws + P_CONCAT);
    const float lam = diff_lambda(P);
    const int lane = C.lane;
    for (int it = C.blk * NWAVES + C.wave; it < BATCH * DIFF_HEADS * SEQ; it += C.G * NWAVES) {
        const int s = it % SEQ, bh = it / SEQ, b = bh / DIFF_HEADS, h = bh % DIFF_HEADS;
        const bf16_t* base = proj + (size_t)b * SEQ * AB_IN;
        const bf16_t* qrow = base + (size_t)s * AB_IN + h * 128;
        float a0, a1, b0, b1;
        naive_attn_row<64>(qrow, nullptr, base + DIFF_W + h * 128, AB_IN, nullptr, 0, base + 2 * DIFF_W + h * 128, AB_IN, s + 1, 0.125f, lane, a0, a1);
        naive_attn_row<64>(qrow + 64, nullptr, base + DIFF_W + h * 128 + 64, AB_IN, nullptr, 0, base + 2 * DIFF_W + h * 128, AB_IN, s + 1, 0.125f, lane, b0, b1);
        const float v0 = a0 - lam * b0, v1 = a1 - lam * b1;
        const float ss = wave_sum(v0 * v0 + v1 * v1);
        const float rs = rsqrtf(ss * (1.0f / 128.0f) + NORM_EPS) * 0.8f;
        bf16_t* orow = concat + (size_t)(b * SEQ + s) * DM + h * 128;
        orow[lane] = f2bf(v0 * rs * P.in[I_SUBLN][lane]); orow[64 + lane] = f2bf(v1 * rs * P.in[I_SUBLN][64 + lane]);
    }
}
DI void phase_mla_attn(const Ctx& C, const Params& P, int) {
    unsigned char* ws = P.ws;
    const bf16_t* q = (const bf16_t*)(ws + P_Q); const bf16_t* kv = (const bf16_t*)(ws + P_KV); const bf16_t* kr = (const bf16_t*)(ws + P_KROPE);
    bf16_t* ob = (bf16_t*)(ws + P_H);
    const int lane = C.lane;
    for (int it = C.blk * NWAVES + C.wave; it < BATCH * MLA_HEADS * SEQ; it += C.G * NWAVES) {
        const int s = it % SEQ, bh = it / SEQ, b = bh / MLA_HEADS, h = bh % MLA_HEADS;
        const bf16_t* qrow = q + (size_t)(b * SEQ + s) * 3072 + h * 192;
        const bf16_t* kn = kv + (size_t)b * SEQ * 4096 + h * 256;
        float a0, a1;
        naive_attn_row<192>(qrow, qrow + 128, kn, 4096, kr + (size_t)b * SEQ * 64, 64, kn + 128, 4096, s + 1, 0.07216878364870322f, lane, a0, a1);
        bf16_t* orow = ob + (size_t)(b * SEQ + s) * DM + h * 128;
        orow[lane] = f2bf(a0); orow[64 + lane] = f2bf(a1);
    }
}
#endif

DI void phase_mla_rows(const Ctx& C0, const Params& P) {
    const Ctx C = fresh(C0);
    unsigned char* ws = P.ws;
    const bf16_t* mp = (const bf16_t*)(ws + P_MLAPROJ); bf16_t* cqn = (bf16_t*)(ws + P_CQN); bf16_t* ckvn = (bf16_t*)(ws + P_CKVN); bf16_t* krp = (bf16_t*)(ws + P_KROPE);
    const f32x2* tab = (const f32x2*)(ws + WS_ROPE);
    const int lane = C.lane;
    for (int r = C.blk * NWAVES + C.wave; r < T; r += C.G * NWAVES) {
        const bf16_t* row = mp + (size_t)r * MLA_IN_PAD;
        float v[12]; float ss = 0.f;
#pragma unroll
        for (int j = 0; j < 3; ++j) { const u32x2 w = *(const u32x2*)(row + 4 * (lane + 64 * j)); v[4 * j] = bflo(w.x); v[4 * j + 1] = bfhi(w.x); v[4 * j + 2] = bflo(w.y); v[4 * j + 3] = bfhi(w.y); }
#pragma unroll
        for (int j = 0; j < 12; ++j) ss += v[j] * v[j];
        float sc = rsqrtf(wave_sum(ss) * (1.0f / MLA_QR) + NORM_EPS);
#pragma unroll
        for (int j = 0; j < 3; ++j) { const f32x4 g = *(const f32x4*)(P.in[I_MLA_QNORM] + 4 * (lane + 64 * j));
            u32x2 w; w.x = pk2(v[4 * j] * sc * g[0], v[4 * j + 1] * sc * g[1]); w.y = pk2(v[4 * j + 2] * sc * g[2], v[4 * j + 3] * sc * g[3]);
            *(u32x2*)(cqn + (size_t)r * MLA_QR + 4 * (lane + 64 * j)) = w; }
        {
            const u32x2 w = *(const u32x2*)(row + MLA_QR + 4 * lane);
            const float a0 = bflo(w.x), a1 = bfhi(w.x), a2 = bflo(w.y), a3 = bfhi(w.y);
            const float s2 = rsqrtf(wave_sum(a0 * a0 + a1 * a1 + a2 * a2 + a3 * a3) * (1.0f / MLA_KVR) + NORM_EPS);
            const f32x4 g = *(const f32x4*)(P.in[I_MLA_KVNORM] + 4 * lane);
            u32x2 o; o.x = pk2(a0 * s2 * g[0], a1 * s2 * g[1]); o.y = pk2(a2 * s2 * g[2], a3 * s2 * g[3]);
            *(u32x2*)(ckvn + (size_t)r * MLA_KVR + 4 * lane) = o;
        }
        if (lane < 32) {
            const unsigned w = *(const unsigned*)(row + 1024 + 2 * lane);
            int p = ((const int*)P.in[I_POS])[r]; p = p < 0 ? 0 : (p > ROPE_POS - 1 ? ROPE_POS - 1 : p);
            const f32x2 cs = tab[(size_t)p * 32 + lane];
            const float x1 = bflo(w), x2 = bfhi(w);
            *(unsigned*)(krp + (size_t)r * 64 + 2 * lane) = pk2(x1 * cs[0] - x2 * cs[1], x2 * cs[0] + x1 * cs[1]);
        }
    }
}

DI void phase_xa_softmax(const Ctx& C0, const Params& P) {
    const Ctx C = fresh(C0);
    unsigned char* ws = P.ws;
    const bf16_t* S = (const bf16_t*)(ws + P_S); bf16_t* Pb = (bf16_t*)(ws + P_P);
    const int lane = C.lane, hd = lane >> 4, li = lane & 15;
    for (int r = C.blk * NWAVES + C.wave; r < T; r += C.G * NWAVES) {
        const bf16_t* row = S + (size_t)r * 1024 + hd * 256;
        f32x4 v[4]; float mx = -1e30f;
#pragma unroll
        for (int j = 0; j < 4; ++j) { const u32x2 w = *(const u32x2*)(row + 4 * (li + 16 * j)); v[j] = (f32x4){bflo(w.x), bfhi(w.x), bflo(w.y), bfhi(w.y)}; mx = fmaxf(mx, fmaxf(fmaxf(v[j][0], v[j][1]), fmaxf(v[j][2], v[j][3]))); }
#pragma unroll
        for (int o = 1; o < 16; o <<= 1) mx = fmaxf(mx, __shfl_xor(mx, o));
        float sm = 0.f;
#pragma unroll
        for (int j = 0; j < 4; ++j) { v[j][0] = __expf(v[j][0] - mx); v[j][1] = __expf(v[j][1] - mx); v[j][2] = __expf(v[j][2] - mx); v[j][3] = __expf(v[j][3] - mx); sm += (v[j][0] + v[j][1]) + (v[j][2] + v[j][3]); }
#pragma unroll
        for (int o = 1; o < 16; o <<= 1) sm += __shfl_xor(sm, o);
        const float inv = 1.0f / sm;
        bf16_t* orow = Pb + (size_t)r * 1024 + hd * 256;
#pragma unroll
        for (int j = 0; j < 4; ++j) { u32x2 w; w.x = pk2(v[j][0] * inv, v[j][1] * inv); w.y = pk2(v[j][2] * inv, v[j][3] * inv); *(u32x2*)(orow + 4 * (li + 16 * j)) = w; }
    }
}

template <bool STORE> DI void phase_peer(const Ctx& C0, const Params& P) {
    const Ctx C = fresh(C0);
    unsigned char* ws = P.ws;
    const bf16_t* sc = (const bf16_t*)(ws + P_SC); const bf16_t* hb = (const bf16_t*)(ws + P_H);
    const bf16_t* ut = (const bf16_t*)(ws + P_UT); const bf16_t* vt = (const bf16_t*)(ws + P_VT);
    float* xo = P.out;
    LAS unsigned char* my = C.lds + C.wave * 4096;
    LAS float* top_s = (LAS float*)my;
    LAS int* top_i = (LAS int*)(my + 1024);
    LAS int* best_e = (LAS int*)(my + 2048);
    LAS float* best_g = (LAS float*)(my + 2560);
    LAS float* best_s = (LAS float*)(my + 3072);
    LAS int* best_p = (LAS int*)(my + 3584);
    const int lane = C.lane;
    for (int tok = C.blk * NWAVES + C.wave; tok < T; tok += C.G * NWAVES) {
        for (int rep = 0; rep < (PROBE == 6 ? 2 : 1); ++rep) {
        {
            const int g = lane >> 2, qd = lane & 3;
            unsigned k[32];
            const u32x4* sp = (const u32x4*)(sc + (size_t)tok * 2048 + g * 128 + qd * 32);
#pragma unroll
            for (int j = 0; j < 8; ++j) { const u32x4 xw = sp[j >> 1]; const unsigned wa = (j & 1) ? xw.z : xw.x, wb = (j & 1) ? xw.w : xw.y; const f32x4 x = {bflo(wa), bfhi(wa), bflo(wb), bfhi(wb)};
#pragma unroll
                for (int e = 0; e < 4; ++e) { unsigned u = __float_as_uint(x[e]); u ^= (unsigned)((int)u >> 31) | 0x80000000u; k[4 * j + e] = (u & ~127u) | (unsigned)(127 - (32 * qd + 4 * j + e)); } }
#pragma unroll
            for (int r = 0; r < 16; ++r) {
                unsigned m = k[0];
#pragma unroll
                for (int j = 1; j < 32; ++j) m = m > k[j] ? m : k[j];
                { const unsigned o1 = (unsigned)__shfl_xor((int)m, 1); m = m > o1 ? m : o1; const unsigned o2 = (unsigned)__shfl_xor((int)m, 2); m = m > o2 ? m : o2; }
                if (qd == 0) top_i[g * 16 + r] = 127 - (int)(m & 127u);
#pragma unroll
                for (int j = 0; j < 32; ++j) k[j] = (k[j] == m) ? 0u : k[j];
            }
        }
        LDS_WAIT(); asm volatile("" ::: "memory");
#pragma unroll
        for (int i = 0; i < 4; ++i) { const int e = lane + 64 * i; top_s[e] = bf2f(sc[(size_t)tok * 2048 + (e >> 4) * 128 + top_i[e]]); }
        LDS_WAIT(); asm volatile("" ::: "memory");
        {
            const int h = lane >> 3, sub = lane & 7;
            unsigned k[32];
            const float s00 = top_s[(2 * h) * 16 + 2 * sub], s01 = top_s[(2 * h) * 16 + 2 * sub + 1];
#pragma unroll
            for (int k2 = 0; k2 < 16; ++k2) { const float s1 = top_s[(2 * h + 1) * 16 + k2];
                unsigned u0 = __float_as_uint(s00 + s1), u1 = __float_as_uint(s01 + s1);
                u0 ^= (unsigned)((int)u0 >> 31) | 0x80000000u; u1 ^= (unsigned)((int)u1 >> 31) | 0x80000000u;
                k[k2] = (u0 & ~255u) | (unsigned)(255 - (32 * sub + k2)); k[16 + k2] = (u1 & ~255u) | (unsigned)(255 - (32 * sub + 16 + k2)); }
#pragma unroll
            for (int r = 0; r < 16; ++r) {
                unsigned m = k[0];
#pragma unroll
                for (int j = 1; j < 32; ++j) m = m > k[j] ? m : k[j];
                { const unsigned o1 = (unsigned)__shfl_xor((int)m, 1); m = m > o1 ? m : o1; const unsigned o2 = (unsigned)__shfl_xor((int)m, 2); m = m > o2 ? m : o2; const unsigned o4 = (unsigned)__shfl_xor((int)m, 4); m = m > o4 ? m : o4; }
                if (sub == 0) best_p[h * 16 + r] = 255 - (int)(m & 255u);
#pragma unroll
                for (int j = 0; j < 32; ++j) k[j] = (k[j] == m) ? 0u : k[j];
            }
        }
        LDS_WAIT(); asm volatile("" ::: "memory");
#pragma unroll
        for (int e2 = 0; e2 < 2; ++e2) { const int idx = lane + 64 * e2, h = idx >> 4, pos = best_p[idx]; best_s[idx] = top_s[(2 * h) * 16 + (pos >> 4)] + top_s[(2 * h + 1) * 16 + (pos & 15)]; }
        LDS_WAIT(); asm volatile("" ::: "memory");
#pragma unroll
        for (int e2 = 0; e2 < 2; ++e2) {
            const int idx = lane + 64 * e2, h = idx >> 4;
            float mx = -1e30f;
            for (int k = 0; k < 16; ++k) mx = fmaxf(mx, best_s[h * 16 + k]);
            float sm = 0.f;
            for (int k = 0; k < 16; ++k) sm += __expf(best_s[h * 16 + k] - mx);
            const float gate = __expf(best_s[idx] - mx) / sm;
            const int pos = best_p[idx], k1 = pos >> 4, k2 = pos & 15;
            best_e[idx] = top_i[(2 * h) * 16 + k1] * 128 + top_i[(2 * h + 1) * 16 + k2];
            best_g[idx] = gate;
        }
        LDS_WAIT(); asm volatile("" ::: "memory");
        }
#if PEER_SLICED
        {
            int* pe = (int*)(ws + P_PE_E) + (size_t)tok * 128; float* pg = (float*)(ws + P_PE_G) + (size_t)tok * 128;
            pe[lane] = best_e[lane]; pe[64 + lane] = best_e[64 + lane]; pg[lane] = best_g[lane]; pg[64 + lane] = best_g[64 + lane];
            const u32x4* tp = (const u32x4*)((const bf16_t*)(ws + P_XB) + (size_t)tok * DM + 32 * lane);
            u32x4 tw[4]; float am = 0.f;
#pragma unroll
            for (int i = 0; i < 4; ++i) { tw[i] = tp[i]; const unsigned w4[4] = {tw[i].x, tw[i].y, tw[i].z, tw[i].w};
#pragma unroll
                for (int q = 0; q < 4; ++q) am = fmaxf(am, fmaxf(fabsf(bflo(w4[q])), fabsf(bfhi(w4[q])))); }
#pragma unroll
            for (int o = 1; o < 64; o <<= 1) am = fmaxf(am, __shfl_xor(am, o));
            const float tscale = am > 0.f ? 127.0f / am : 0.f;
            if (lane == 0) ((float*)(ws + P_PE_TSC))[tok] = am * (1.0f / 127.0f) * row_rstd<32>((const float*)(ws + P_SS), tok);
            unsigned qd[8];
#pragma unroll
            for (int i = 0; i < 4; ++i) { const unsigned w4[4] = {tw[i].x, tw[i].y, tw[i].z, tw[i].w};
#pragma unroll
                for (int h2 = 0; h2 < 2; ++h2) { const int q0 = (int)rintf(bflo(w4[2 * h2]) * tscale), q1 = (int)rintf(bfhi(w4[2 * h2]) * tscale), q2 = (int)rintf(bflo(w4[2 * h2 + 1]) * tscale), q3 = (int)rintf(bfhi(w4[2 * h2 + 1]) * tscale);
                    qd[2 * i + h2] = (unsigned)(q0 & 255) | ((unsigned)(q1 & 255) << 8) | ((unsigned)(q2 & 255) << 16) | ((unsigned)(q3 & 255) << 24); } }
            u32x4* t8p = (u32x4*)(ws + P_PE_T8 + (size_t)tok * DM + 32 * lane);
            t8p[0] = (u32x4){qd[0], qd[1], qd[2], qd[3]}; t8p[1] = (u32x4){qd[4], qd[5], qd[6], qd[7]};
        }
#else
#if PEER_FP8
        float tf[32];
#pragma unroll
        for (int i = 0; i < 2; ++i) { const u32x4* tp = (const u32x4*)(hb + (size_t)tok * DM + 16 * (lane + 64 * i));
            const u32x4 a = tp[0], b = tp[1];
            tf[16 * i + 0] = bflo(a.x); tf[16 * i + 1] = bfhi(a.x); tf[16 * i + 2] = bflo(a.y); tf[16 * i + 3] = bfhi(a.y); tf[16 * i + 4] = bflo(a.z); tf[16 * i + 5] = bfhi(a.z); tf[16 * i + 6] = bflo(a.w); tf[16 * i + 7] = bfhi(a.w);
            tf[16 * i + 8] = bflo(b.x); tf[16 * i + 9] = bfhi(b.x); tf[16 * i + 10] = bflo(b.y); tf[16 * i + 11] = bfhi(b.y); tf[16 * i + 12] = bflo(b.z); tf[16 * i + 13] = bfhi(b.z); tf[16 * i + 14] = bflo(b.w); tf[16 * i + 15] = bfhi(b.w); }
        const unsigned char* ut8 = (const unsigned char*)ut; const unsigned char* vt8 = (const unsigned char*)vt;
        const float* usc = (const float*)(ut8 + 32 * MiB); const float* vsc = (const float*)(vt8 + 32 * MiB);
        for (int k0 = 0; k0 < 128; k0 += 8) {
            u32x4 rw[8][2];
#pragma unroll
            for (int kk = 0; kk < 8; ++kk) { const int e = __builtin_amdgcn_readfirstlane(best_e[k0 + kk]); const unsigned char* rp = ut8 + (size_t)e * DM;
#pragma unroll
                for (int i = 0; i < 2; ++i) rw[kk][i] = *(const u32x4*)(rp + 16 * (lane + 64 * i)); }
            float d[8];
#pragma unroll
            for (int kk = 0; kk < 8; ++kk) { float s0 = 0.f, s1 = 0.f;
#pragma unroll
                for (int i = 0; i < 2; ++i) {
                    const unsigned w4[4] = {rw[kk][i].x, rw[kk][i].y, rw[kk][i].z, rw[kk][i].w};
#pragma unroll
                    for (int q = 0; q < 4; ++q) { const f32x2 lo = __builtin_amdgcn_cvt_pk_f32_fp8((int)w4[q], false), hi2 = __builtin_amdgcn_cvt_pk_f32_fp8((int)w4[q], true);
                        s0 = fmaf(lo[0], tf[16 * i + 4 * q], s0); s1 = fmaf(lo[1], tf[16 * i + 4 * q + 1], s1); s0 = fmaf(hi2[0], tf[16 * i + 4 * q + 2], s0); s1 = fmaf(hi2[1], tf[16 * i + 4 * q + 3], s1); }
                }
                d[kk] = s0 + s1; }
            float n4[4], n2[2], r1;
            { const bool b0 = lane & 1;
#pragma unroll
              for (int j = 0; j < 4; ++j) { const float snd = b0 ? d[j] : d[4 + j], kp = b0 ? d[4 + j] : d[j]; n4[j] = kp + __shfl_xor(snd, 1); } }
            { const bool b1 = lane & 2;
#pragma unroll
              for (int j = 0; j < 2; ++j) { const float snd = b1 ? n4[j] : n4[2 + j], kp = b1 ? n4[2 + j] : n4[j]; n2[j] = kp + __shfl_xor(snd, 2); } }
            { const bool b2 = lane & 4; const float snd = b2 ? n2[0] : n2[1], kp = b2 ? n2[1] : n2[0]; r1 = kp + __shfl_xor(snd, 4); }
            r1 += __shfl_xor(r1, 8); r1 += __shfl_xor(r1, 16); r1 += __shfl_xor(r1, 32);
            if (lane < 8) { const int idx = k0 + 4 * (lane & 1) + 2 * ((lane >> 1) & 1) + ((lane >> 2) & 1); const float act = r1 * usc[best_e[idx]]; best_g[idx] *= gelu_erf(act); }
        }
        LDS_WAIT(); asm volatile("" ::: "memory");
        float acc[32];
#pragma unroll
        for (int j = 0; j < 32; ++j) acc[j] = 0.f;
        for (int k0 = 0; k0 < 128; k0 += 8) {
            u32x4 rw[8][2]; float wk[8];
#pragma unroll
            for (int kk = 0; kk < 8; ++kk) { const int e = __builtin_amdgcn_readfirstlane(best_e[k0 + kk]); wk[kk] = best_g[k0 + kk] * vsc[e]; const unsigned char* rp = vt8 + (size_t)e * DM;
#pragma unroll
                for (int i = 0; i < 2; ++i) rw[kk][i] = *(const u32x4*)(rp + 16 * (lane + 64 * i)); }
#pragma unroll
            for (int kk = 0; kk < 8; ++kk)
#pragma unroll
                for (int i = 0; i < 2; ++i) {
                    const unsigned w4[4] = {rw[kk][i].x, rw[kk][i].y, rw[kk][i].z, rw[kk][i].w};
#pragma unroll
                    for (int q = 0; q < 4; ++q) { const f32x2 lo = __builtin_amdgcn_cvt_pk_f32_fp8((int)w4[q], false), hi2 = __builtin_amdgcn_cvt_pk_f32_fp8((int)w4[q], true);
                        acc[16 * i + 4 * q] = fmaf(wk[kk], lo[0], acc[16 * i + 4 * q]); acc[16 * i + 4 * q + 1] = fmaf(wk[kk], lo[1], acc[16 * i + 4 * q + 1]);
                        acc[16 * i + 4 * q + 2] = fmaf(wk[kk], hi2[0], acc[16 * i + 4 * q + 2]); acc[16 * i + 4 * q + 3] = fmaf(wk[kk], hi2[1], acc[16 * i + 4 * q + 3]); }
                }
        }
#else
        u32x4 tv[4];
#pragma unroll
        for (int i = 0; i < 4; ++i) tv[i] = *(const u32x4*)(hb + (size_t)tok * DM + 8 * (lane + 64 * i));
        for (int k0 = 0; k0 < 128; k0 += 4) {
            u32x4 rw[4][4];
#pragma unroll
            for (int kk = 0; kk < 4; ++kk) { const int e = __builtin_amdgcn_readfirstlane(best_e[k0 + kk]); const bf16_t* rp = ut + (size_t)e * DM;
#pragma unroll
                for (int i = 0; i < 4; ++i) rw[kk][i] = *(const u32x4*)(rp + 8 * (lane + 64 * i)); }
            float d[4];
#pragma unroll
            for (int kk = 0; kk < 4; ++kk) { float s = 0.f;
#pragma unroll
                for (int i = 0; i < 4; ++i) { s = dot2bf(rw[kk][i].x, tv[i].x, s); s = dot2bf(rw[kk][i].y, tv[i].y, s); s = dot2bf(rw[kk][i].z, tv[i].z, s); s = dot2bf(rw[kk][i].w, tv[i].w, s); }
                d[kk] = wave_sum(s); }
            if (lane < 4) { const float act = lane == 0 ? d[0] : lane == 1 ? d[1] : lane == 2 ? d[2] : d[3]; best_g[k0 + lane] *= gelu_erf(act); }
        }
        LDS_WAIT(); asm volatile("" ::: "memory");
        float acc[32];
#pragma unroll
        for (int j = 0; j < 32; ++j) acc[j] = 0.f;
        for (int k0 = 0; k0 < 128; k0 += 4) {
            u32x4 rw[4][4]; float wk[4];
#pragma unroll
            for (int kk = 0; kk < 4; ++kk) { const int e = __builtin_amdgcn_readfirstlane(best_e[k0 + kk]); wk[kk] = best_g[k0 + kk]; const bf16_t* rp = vt + (size_t)e * DM;
#pragma unroll
                for (int i = 0; i < 4; ++i) rw[kk][i] = *(const u32x4*)(rp + 8 * (lane + 64 * i)); }
#pragma unroll
            for (int kk = 0; kk < 4; ++kk)
#pragma unroll
                for (int i = 0; i < 4; ++i) {
                    acc[8 * i + 0] = fmaf(wk[kk], bflo(rw[kk][i].x), acc[8 * i + 0]); acc[8 * i + 1] = fmaf(wk[kk], bfhi(rw[kk][i].x), acc[8 * i + 1]);
                    acc[8 * i + 2] = fmaf(wk[kk], bflo(rw[kk][i].y), acc[8 * i + 2]); acc[8 * i + 3] = fmaf(wk[kk], bfhi(rw[kk][i].y), acc[8 * i + 3]);
                    acc[8 * i + 4] = fmaf(wk[kk], bflo(rw[kk][i].z), acc[8 * i + 4]); acc[8 * i + 5] = fmaf(wk[kk], bfhi(rw[kk][i].z), acc[8 * i + 5]);
                    acc[8 * i + 6] = fmaf(wk[kk], bflo(rw[kk][i].w), acc[8 * i + 6]); acc[8 * i + 7] = fmaf(wk[kk], bfhi(rw[kk][i].w), acc[8 * i + 7]);
                }
        }
#endif
        float* xr = xo + (size_t)tok * DM;
        if (!STORE) {
#pragma unroll
            for (int j = 0; j < 32; ++j) asm volatile("" :: "v"(acc[j]));
        } else {
#if PEER_FP8
#pragma unroll
            for (int i = 0; i < 2; ++i) { f32x4* p = (f32x4*)(xr + 16 * (lane + 64 * i));
#pragma unroll
                for (int q = 0; q < 4; ++q) { f32x4 a = p[q]; a[0] += acc[16 * i + 4 * q]; a[1] += acc[16 * i + 4 * q + 1]; a[2] += acc[16 * i + 4 * q + 2]; a[3] += acc[16 * i + 4 * q + 3]; p[q] = a; } }
#else
#pragma unroll
            for (int i = 0; i < 4; ++i) { f32x4* p = (f32x4*)(xr + 8 * (lane + 64 * i));
                f32x4 a = p[0], b = p[1];
                a[0] += acc[8 * i]; a[1] += acc[8 * i + 1]; a[2] += acc[8 * i + 2]; a[3] += acc[8 * i + 3];
                b[0] += acc[8 * i + 4]; b[1] += acc[8 * i + 5]; b[2] += acc[8 * i + 6]; b[3] += acc[8 * i + 7];
                p[0] = a; p[1] = b; }
#endif
        }
#endif
        LDS_WAIT(); asm volatile("" ::: "memory");
    }
}


#if PEER_SLICED
DI int peer_cj(int j) { return ((j >> 3) & 1) | (((j >> 2) & 1) << 1) | (((j >> 1) & 1) << 2); }
constexpr int PEER_CHUNK = 128, PEER_NCHUNK = T / PEER_CHUNK;
DI int peer_cjh(int half, int jj) { return half | (((jj >> 2) & 1) << 1) | (((jj >> 1) & 1) << 2); }
#define PEER_ISSUE(RW, ELO, EHI, HALF) do { _Pragma("unroll") for (int jj = 0; jj < 8; ++jj) { \
        const int e_ = __shfl((jj & 1) ? (EHI) : (ELO), (lane & ~7) | peer_cjh((HALF), jj)); \
        RW[jj] = *(const u32x4*)(tabs + (size_t)(MODE == 2 ? (e_ & 1) : e_) * 128); } } while (0)
template <int SIDE  , int MODE = 0  >
DI void phase_peer_sliced(const Ctx& C0, const Params& P, int qbase) {
    const Ctx C = fresh(C0);
    unsigned char* ws = P.ws;
    const bf16_t* hb = (const bf16_t*)(ws + P_H);
    const unsigned char* tab8 = ws + (SIDE == 0 ? P_UT : P_VT);
    const int* pe = (const int*)(ws + P_PE_E); const float* pg = (const float*)(ws + P_PE_G);
    const int lane = C.lane, a = lane >> 3, c = lane & 7;
    const int x = (int)(xb_xcc_id() & 7u);
    for (int i = 0; i < 16; ++i) {
        const int s = ((x + (i >> 1)) & 7) + 8 * (i & 1);
        unsigned* ctr = (unsigned*)(ws + WS_CTL) + CW_CTR + 64 * (qbase + s);
        const unsigned char* tabs = tab8 + (size_t)s * ((size_t)PEER_NE * 128) + 16 * c;
        for (;;) {
            const int ch = queue_pop(C, ctr, PEER_NCHUNK); if (ch < 0) break;
            const int tok0 = ch * PEER_CHUNK + C.wave;
            constexpr int NTOK = PEER_CHUNK / NWAVES;
            u32x4 rwA[8], rwB[8];
            int e_lo = pe[(size_t)tok0 * 128 + lane], e_hi = pe[(size_t)tok0 * 128 + 64 + lane];
            u32x4 ta, tb; float w_lo = 0.f, w_hi = 0.f;
            if (SIDE == 0) { ta = *(const u32x4*)(ws + P_PE_T8 + (size_t)tok0 * DM + s * 128 + 16 * c); tb = ta; }
            else { w_lo = pg[(size_t)tok0 * 128 + lane]; w_hi = pg[(size_t)tok0 * 128 + 64 + lane]; }
            PEER_ISSUE(rwA, e_lo, e_hi, 0);
#pragma unroll 1
            for (int it = 0; it < NTOK; ++it) {
                const int tok = tok0 + NWAVES * it, ntok = (it + 1 < NTOK) ? tok + NWAVES : tok;
                unsigned* xp = (unsigned*)((bf16_t*)(ws + P_XB) + (size_t)tok * DM + s * 128 + 16 * c + 8 * (a & 1) + 4 * ((a >> 1) & 1) + 2 * ((a >> 2) & 1));
                unsigned xw = 0u; if (SIDE == 1) xw = *xp;
                const int ne_lo = pe[(size_t)ntok * 128 + lane], ne_hi = pe[(size_t)ntok * 128 + 64 + lane];
                u32x4 nta, ntb; float nw_lo = 0.f, nw_hi = 0.f;
                if (SIDE == 0) { nta = *(const u32x4*)(ws + P_PE_T8 + (size_t)ntok * DM + s * 128 + 16 * c); ntb = nta; }
                else { nw_lo = pg[(size_t)ntok * 128 + lane]; nw_hi = pg[(size_t)ntok * 128 + 64 + lane]; }
                PEER_ISSUE(rwB, e_lo, e_hi, 1);
                if (SIDE == 0) {
                    int d[16];
#define PEER_DOT(RW, HALF) do { _Pragma("unroll") for (int jj = 0; jj < 8; ++jj) { int s0 = __builtin_amdgcn_sdot4((int)RW[jj].x, (int)ta.x, 0, false); s0 = __builtin_amdgcn_sdot4((int)RW[jj].y, (int)ta.y, s0, false); \
                        s0 = __builtin_amdgcn_sdot4((int)RW[jj].z, (int)ta.z, s0, false); s0 = __builtin_amdgcn_sdot4((int)RW[jj].w, (int)ta.w, s0, false); d[8 * (HALF) + jj] = s0; } } while (0)
                    if (MODE == 1) { _Pragma("unroll") for (int jj = 0; jj < 8; ++jj) { asm volatile("" :: "v"(rwA[jj])); d[jj] = 0; d[8 + jj] = 0; } } else PEER_DOT(rwA, 0);
                    PEER_ISSUE(rwA, ne_lo, ne_hi, 0);
                    if (MODE == 1) { _Pragma("unroll") for (int jj = 0; jj < 8; ++jj) asm volatile("" :: "v"(rwB[jj])); } else PEER_DOT(rwB, 1);
#undef PEER_DOT
                    int n8[8], n4[4], n2[2];
                    { const bool b = c & 1;
#pragma unroll
                      for (int j = 0; j < 8; ++j) { const int snd = b ? d[j] : d[8 + j], kp = b ? d[8 + j] : d[j]; n8[j] = kp + __shfl_xor(snd, 1); } }
                    { const bool b = c & 2;
#pragma unroll
                      for (int j = 0; j < 4; ++j) { const int snd = b ? n8[j] : n8[4 + j], kp = b ? n8[4 + j] : n8[j]; n4[j] = kp + __shfl_xor(snd, 2); } }
                    { const bool b = c & 4;
#pragma unroll
                      for (int j = 0; j < 2; ++j) { const int snd = b ? n4[j] : n4[2 + j], kp = b ? n4[2 + j] : n4[j]; n2[j] = kp + __shfl_xor(snd, 4); } }
                    int* pp = (int*)(ws + P_SC) + ((size_t)s * T + tok) * 128;
                    pp[lane] = n2[0]; pp[64 + lane] = n2[1];
                } else {
                    float acc[16];
#pragma unroll
                    for (int q = 0; q < 16; ++q) acc[q] = 0.f;
#define PEER_AXPY(RW, HALF) do { _Pragma("unroll") for (int jj = 0; jj < 8; ++jj) { const float wj = __shfl((jj & 1) ? w_hi : w_lo, (lane & ~7) | peer_cjh((HALF), jj)); \
                        unsigned w4[4] = {RW[jj].x, RW[jj].y, RW[jj].z, RW[jj].w}; \
                        asm volatile("" : "+v"(w4[0]), "+v"(w4[1]), "+v"(w4[2]), "+v"(w4[3]) : "v"(acc[0]), "v"(acc[15]));     \
                        _Pragma("unroll") for (int q = 0; q < 4; ++q) { const f32x2 lo = __builtin_amdgcn_cvt_pk_f32_fp8((int)w4[q], false), hi2 = __builtin_amdgcn_cvt_pk_f32_fp8((int)w4[q], true); \
                            acc[4 * q] = fmaf(wj, lo[0], acc[4 * q]); acc[4 * q + 1] = fmaf(wj, lo[1], acc[4 * q + 1]); acc[4 * q + 2] = fmaf(wj, hi2[0], acc[4 * q + 2]); acc[4 * q + 3] = fmaf(wj, hi2[1], acc[4 * q + 3]); } } } while (0)
                    if (MODE == 1) { _Pragma("unroll") for (int jj = 0; jj < 8; ++jj) asm volatile("" :: "v"(rwA[jj])); } else PEER_AXPY(rwA, 0);
                    PEER_ISSUE(rwA, ne_lo, ne_hi, 0);
                    if (MODE == 1) { _Pragma("unroll") for (int jj = 0; jj < 8; ++jj) asm volatile("" :: "v"(rwB[jj])); } else PEER_AXPY(rwB, 1);
#undef PEER_AXPY
                    float n8[8], n4[4], n2[2];
                    { const bool b = a & 1;
#pragma unroll
                      for (int q = 0; q < 8; ++q) { const float snd = b ? acc[q] : acc[8 + q], kp = b ? acc[8 + q] : acc[q]; n8[q] = kp + __shfl_xor(snd, 8); } }
                    { const bool b = a & 2;
#pragma unroll
                      for (int q = 0; q < 4; ++q) { const float snd = b ? n8[q] : n8[4 + q], kp = b ? n8[4 + q] : n8[q]; n4[q] = kp + __shfl_xor(snd, 16); } }
                    { const bool b = a & 4;
#pragma unroll
                      for (int q = 0; q < 2; ++q) { const float snd = b ? n4[q] : n4[2 + q], kp = b ? n4[2 + q] : n4[q]; n2[q] = kp + __shfl_xor(snd, 32); } }
                    const unsigned nw = pk2(bflo(xw) + n2[0], bfhi(xw) + n2[1]);
                    if (MODE == 0) { *xp = nw; const float q0 = bflo(nw), q1 = bfhi(nw); const float sq = wave_sum(q0 * q0 + q1 * q1); if (lane == 0) ((float*)(ws + P_SS))[(size_t)tok * 32 + s] = sq; }
                    else asm volatile("" :: "v"(nw));
                }
                e_lo = ne_lo; e_hi = ne_hi;
                if (SIDE == 0) { ta = nta; tb = ntb; } else { w_lo = nw_lo; w_hi = nw_hi; }
            }
        }
    }
}
#undef PEER_ISSUE

DI void phase_peer_combine(const Ctx& C0, const Params& P) {
    const Ctx C = fresh(C0);
    unsigned char* ws = P.ws;
    const float* usc = (const float*)(ws + P_UT + 32 * MiB); const float* vsc = (const float*)(ws + P_VT + 32 * MiB);
    const int* pe = (const int*)(ws + P_PE_E); float* pg = (float*)(ws + P_PE_G); const int* part = (const int*)(ws + P_SC); const float* tsc = (const float*)(ws + P_PE_TSC);
    for (size_t i = (size_t)C.blk * NTHREADS + C.tid; i < (size_t)T * 128; i += (size_t)C.G * NTHREADS) {
        int a = 0;
#pragma unroll
        for (int s = 0; s < 16; ++s) a += part[(size_t)s * T * 128 + i];
        const int e = pe[i];
        pg[i] = pg[i] * gelu_erf((float)a * usc[e] * tsc[i >> 7]) * vsc[e];
    }
}
#endif

constexpr int N_PHASES = 39;
__global__ void __launch_bounds__(NTHREADS, 2) mk_fwd(Params P) {
    extern __shared__ __attribute__((aligned(16))) unsigned char lds_raw[];
    Ctx C; C.lds = (LAS unsigned char*)lds_raw; C.tid = threadIdx.x; C.lane = C.tid & 63; C.wave = __builtin_amdgcn_readfirstlane(C.tid >> 6); C.blk = blockIdx.x; C.G = gridDim.x;
    unsigned char* ws = P.ws;
    for (int u = C.tid; u < (LDS_BYTES - LDSCTL_OFF) / 4; u += NTHREADS) ((LAS unsigned*)(C.lds + LDSCTL_OFF))[u] = 0u;
    __syncthreads();
    XcdBarrier bar; bar.bar = (unsigned*)(ws + WS_CTL) + CW_BAR; bar.x = 0; bar.st = nullptr;
    const bool one = (P.ph_hi - P.ph_lo) > 1;
    if (one) bar = xcd_barrier_post((unsigned*)(ws + WS_CTL) + CW_BAR, (volatile LAS unsigned*)(C.lds + LDSCTL_OFF));
    const int lo = P.ph_lo, hi = P.ph_hi;
#define IN(k) (lo <= (k) && (k) < hi)
#define SEAM(k) do { if (IN(k) && IN((k) + 1)) xcd_barrier(bar); } while (0)
    bf16_t* hbuf = (bf16_t*)(ws + P_H); bf16_t* xb = (bf16_t*)(ws + P_XB); float* ssp = (float*)(ws + P_SS);
    const int* pos = (const int*)P.in[I_POS];
    const f32x2* rtab = (const f32x2*)(ws + WS_ROPE);

    if (IN(0)) { if (EN_PRO) phase_prologue(C, P); rms_rows_2048(C, P.in[I_X], P.in[I_AB_NORM], hbuf, T); } SEAM(0);
    if (IN(1)) {
        {
            g8::Desc g{(const bf16_t*)(ws + P_MEMN), (const bf16_t*)(ws + WS_LW + LW_XKV), DM, DM, DM, MT / 256, DM / 256, 2, 1, (long)MT * DM, 0, (long)(LW_STRIDE / 2), 0};
            EpiBf16 E{(bf16_t*)(ws + WS_KVX), DM, (long)(KVX_STRIDE / 2), 0, 1.0f, nullptr};
            if (PROBE == 1) { EpiNull En; g8::gemm(C.lds, g, En, C.G, C.blk); } if (PROBE == 13) g8::gemm(C.lds, g, E, C.G, C.blk); if (GSITE < 0 || GSITE == 1) g8::gemm(C.lds, g, E, C.G, C.blk);
        }
        {
            g8::Desc g{(const bf16_t*)(ws + WS_LW + LW_XKV) + (size_t)DM * DM, (const bf16_t*)(ws + P_MEMN), DM, DM, DM, DM / 256, MT / 256, 2, 1, (long)(LW_STRIDE / 2), 0, (long)MT * DM, 0};
            EpiBf16 E{(bf16_t*)(ws + WS_KVX + 16 * MiB), MT, (long)(KVX_STRIDE / 2), 0, 1.0f, nullptr};
            if (PROBE == 1) { EpiNull En; g8::gemm(C.lds, g, En, C.G, C.blk); } if (PROBE == 13) g8::gemm(C.lds, g, E, C.G, C.blk); if (GSITE < 0 || GSITE == 2) g8::gemm(C.lds, g, E, C.G, C.blk);
        }
        {
            g8::Desc g{(const bf16_t*)(ws + P_SK), (const bf16_t*)(ws + P_WQB), 256, DM, 256, 1, DM / 256, 2, 8, 8L * 65536, 65536, (long)DM * DM, 256};
            EpiBf16 E{(bf16_t*)(ws + WS_LW + LW_PEER), DM, (long)(LW_STRIDE / 2), 256L * DM, 1.0f, nullptr};
            if (PROBE == 1) { EpiNull En; g8::gemm(C.lds, g, En, C.G, C.blk); } if (PROBE == 13) g8::gemm(C.lds, g, E, C.G, C.blk); if (GSITE < 0 || GSITE == 3) g8::gemm(C.lds, g, E, C.G, C.blk);
        }
        {
        g8::Desc g{hbuf, (const bf16_t*)(ws + WS_ABIN_T), DM, DM, DM, T / 256, AB_IN / 256, 1, 1, 0, 0, 0, 0};
        EpiRope<0> E{(bf16_t*)(ws + P_PROJ), AB_IN, pos, rtab};
        if (PROBE == 1) { EpiNull En; g8::gemm(C.lds, g, En, C.G, C.blk); } if (PROBE == 13) g8::gemm(C.lds, g, E, C.G, C.blk); if (GSITE < 0 || GSITE == 4) g8::gemm(C.lds, g, E, C.G, C.blk);
        }
    }
    SEAM(1);

    {
        constexpr int l = 0, pb = 2; (void)l;

            if (IN(pb + 3)) { if (EN_DIFF) { if (PROBE == 2) phase_diff_attn(C, P, 2); phase_diff_attn(C, P, 0); } }
            SEAM(pb + 3);
            if (IN(pb + 4)) {
                g8::Desc g{(const bf16_t*)(ws + P_GBUF), (const bf16_t*)(ws + WS_GLU_T), S5_W, S5_W, S5_W, T / 256, S5_W / 256, 1, 1, 0, 0, 0, 0};
                EpiGlu E{(const bf16_t*)(ws + P_GBUF), P.in[I_S5_BGLU], (bf16_t*)(ws + P_CONCAT)};
                if (PROBE == 1) { EpiNull En; g8::gemm(C.lds, g, En, C.G, C.blk); } if (PROBE == 13) g8::gemm(C.lds, g, E, C.G, C.blk); if (GSITE < 0 || GSITE == 5) g8::gemm(C.lds, g, E, C.G, C.blk);
            }
            SEAM(pb + 4);
            if (IN(pb + 5)) {
                g8::Desc g{(const bf16_t*)(ws + P_CONCAT), (const bf16_t*)(ws + WS_ABOUT_T), DM, DM, DM, T / 256, DM / 256, 1, 1, 0, 0, 0, 0};
                EpiResidB<true> E{P.in[I_X], xb, ssp};
                if (PROBE == 1 || PROBE == 13) { EpiNull En; g8::gemm(C.lds, g, En, C.G, C.blk); } if (GSITE < 0 || GSITE == 6) g8::gemm(C.lds, g, E, C.G, C.blk);
            }
            SEAM(pb + 5);
    }
    {
        constexpr int l = 0, pb = 2; (void)l;
        const unsigned char* lw = ws + WS_LW + (size_t)l * LW_STRIDE;
        if (IN(pb + 7)) {
            g8::Desc g{xb, (const bf16_t*)(lw + LW_XQ), DM, DM, DM, T / 256, DM / 256, 1, 1, 0, 0, 0, 0};
            EpiBf16T<32> E{(bf16_t*)(ws + P_QX), DM, 0, 0, 1.0f, ssp};
            if (PROBE == 1) { EpiNull En; g8::gemm(C.lds, g, En, C.G, C.blk); } if (PROBE == 13) g8::gemm(C.lds, g, E, C.G, C.blk); if (GSITE < 0 || GSITE == 11) g8::gemm(C.lds, g, E, C.G, C.blk);
        }
        SEAM(pb + 7);
        if (IN(pb + 8)) {
            g8::Desc g{(const bf16_t*)(ws + P_QX), (const bf16_t*)(ws + WS_KVX + (size_t)l * KVX_STRIDE), DM, DM, 512, SEQ / 256, 1, BATCH, 4, (long)SEQ * DM, 512, (long)MEM_LEN * DM, 512};
            EpiBf16 E{(bf16_t*)(ws + P_S), 1024, (long)SEQ * 1024, 256, 0.04419417382415922f, nullptr};
            if (PROBE == 1) { EpiNull En; g8::gemm(C.lds, g, En, C.G, C.blk); } if (PROBE == 13) g8::gemm(C.lds, g, E, C.G, C.blk); if (GSITE < 0 || GSITE == 12) g8::gemm(C.lds, g, E, C.G, C.blk);
        }
        SEAM(pb + 8);
        if (IN(pb + 9)) {
            if (PROBE == 5) phase_xa_softmax(C, P);
            phase_xa_softmax(C, P);
            if (l == 1) {
                convert_tables(C, P, 1);
            }
        }
        SEAM(pb + 9);
        if (IN(pb + 10)) {
            g8::Desc g{(const bf16_t*)(ws + P_P), (const bf16_t*)(ws + WS_KVX + (size_t)l * KVX_STRIDE + 16 * MiB), 1024, MT, 256, SEQ / 256, 2, BATCH, 4, (long)SEQ * 1024, 256, 256, 512L * MT};
            EpiBf16 E{(bf16_t*)(ws + P_OX), DM, (long)SEQ * DM, 512, 1.0f, nullptr};
            if (PROBE == 1) { EpiNull En; g8::gemm(C.lds, g, En, C.G, C.blk); } if (PROBE == 13) g8::gemm(C.lds, g, E, C.G, C.blk); if (GSITE < 0 || GSITE == 13) g8::gemm(C.lds, g, E, C.G, C.blk);
        }
        SEAM(pb + 10);
        if (IN(pb + 11)) {
            g8::Desc g{(const bf16_t*)(ws + P_OX), (const bf16_t*)(lw + LW_XO), DM, DM, DM, T / 256, DM / 256, 1, 1, 0, 0, 0, 0};
            EpiResidB<false> E{nullptr, xb, ssp};
            if (PROBE == 1 || PROBE == 13) { EpiNull En; g8::gemm(C.lds, g, En, C.G, C.blk); } if (GSITE < 0 || GSITE == 14) g8::gemm(C.lds, g, E, C.G, C.blk);
        }
        SEAM(pb + 11);
        if (IN(pb + 13)) {
            g8::Desc g{xb, (const bf16_t*)(lw + LW_PEER), DM, DM, DM, T / 256, DM / 256, 1, 1, 0, 0, 0, 0};
            EpiBf16T<32> E{(bf16_t*)(ws + P_SC), DM, 0, 0, 1.0f, ssp};
            if (PROBE == 1) { EpiNull En; g8::gemm(C.lds, g, En, C.G, C.blk); } if (PROBE == 13) g8::gemm(C.lds, g, E, C.G, C.blk); if (GSITE < 0 || GSITE == 15) g8::gemm(C.lds, g, E, C.G, C.blk);
        }
        SEAM(pb + 13);
        if (IN(pb + 14)) { if (EN_PEER && EN_TOPK) phase_peer<true>(C, P); }
        SEAM(pb + 14);
#if PEER_SLICED
        if (IN(pb + 15)) { if (EN_PEER && EN_PU) { if (PROBE >= 7 && PROBE <= 9) { phase_peer_sliced<0, PROBE - 7>(C, P, 8 + 32 * l + 64); __syncthreads(); } phase_peer_sliced<0>(C, P, 8 + 32 * l); } }
        SEAM(pb + 15);
        if (IN(pb + 16)) { if (EN_PEER) phase_peer_combine(C, P); }
        SEAM(pb + 16);
        if (IN(pb + 17)) { if (EN_PEER && EN_PV) { if (PROBE >= 10 && PROBE <= 12) { phase_peer_sliced<1, PROBE == 10 ? 3 : PROBE - 10>(C, P, 8 + 32 * l + 80); __syncthreads(); } phase_peer_sliced<1>(C, P, 8 + 32 * l + 16); } }
        SEAM(pb + 17);
#endif
    }
    {
        constexpr int l = 1, pb = 20; (void)l;

            if (IN(pb + 1)) {
                g8::Desc g{xb, (const bf16_t*)(ws + WS_MLAIN_T), DM, DM, DM, T / 256, MLA_IN_PAD / 256, 1, 1, 0, 0, 0, 0};
                EpiBf16T<16> E{(bf16_t*)(ws + P_MLAPROJ), MLA_IN_PAD, 0, 0, 1.0f, ssp};
                if (PROBE == 1) { EpiNull En; g8::gemm(C.lds, g, En, C.G, C.blk); } if (PROBE == 13) g8::gemm(C.lds, g, E, C.G, C.blk); if (GSITE < 0 || GSITE == 7) g8::gemm(C.lds, g, E, C.G, C.blk);
            }
            SEAM(pb + 1);
            if (IN(pb + 2)) { if (PROBE == 5) phase_mla_rows(C, P); phase_mla_rows(C, P); }
            SEAM(pb + 2);
            if (IN(pb + 3)) {
                {
                    g8::Desc g{(const bf16_t*)(ws + P_CQN), (const bf16_t*)(ws + WS_UQ_T), MLA_QR, MLA_QR, MLA_QR, T / 256, 3072 / 256, 1, 1, 0, 0, 0, 0};
                    EpiRope<1> E{(bf16_t*)(ws + P_Q), 3072, pos, rtab};
                    if (PROBE == 1) { EpiNull En; g8::gemm(C.lds, g, En, C.G, C.blk); } if (PROBE == 13) g8::gemm(C.lds, g, E, C.G, C.blk); if (GSITE < 0 || GSITE == 8) g8::gemm(C.lds, g, E, C.G, C.blk);
                }
                {
                    g8::Desc g{(const bf16_t*)(ws + P_CKVN), (const bf16_t*)(ws + WS_UKV_T), MLA_KVR, MLA_KVR, MLA_KVR, T / 256, 4096 / 256, 1, 1, 0, 0, 0, 0};
                    EpiBf16 E{(bf16_t*)(ws + P_KV), 4096, 0, 0, 1.0f, nullptr};
                    if (PROBE == 1) { EpiNull En; g8::gemm(C.lds, g, En, C.G, C.blk); } if (PROBE == 13) g8::gemm(C.lds, g, E, C.G, C.blk); if (GSITE < 0 || GSITE == 9) g8::gemm(C.lds, g, E, C.G, C.blk);
                }
            }
            SEAM(pb + 3);
            if (IN(pb + 4)) { if (EN_MLA) { if (PROBE == 2) phase_mla_attn(C, P, 3); phase_mla_attn(C, P, 1); } }
            SEAM(pb + 4);
            if (IN(pb + 5)) {
                g8::Desc g{hbuf, (const bf16_t*)(ws + WS_MLAO_T), DM, DM, DM, T / 256, DM / 256, 1, 1, 0, 0, 0, 0};
                EpiResidB<false> E{nullptr, xb, ssp};
                if (PROBE == 1 || PROBE == 13) { EpiNull En; g8::gemm(C.lds, g, En, C.G, C.blk); } if (GSITE < 0 || GSITE == 10) g8::gemm(C.lds, g, E, C.G, C.blk);
            }
            SEAM(pb + 5);
    }
    {
        constexpr int l = 1, pb = 20; (void)l;
        const unsigned char* lw = ws + WS_LW + (size_t)l * LW_STRIDE;
        if (IN(pb + 7)) {
            g8::Desc g{xb, (const bf16_t*)(lw + LW_XQ), DM, DM, DM, T / 256, DM / 256, 1, 1, 0, 0, 0, 0};
            EpiBf16T<32> E{(bf16_t*)(ws + P_QX), DM, 0, 0, 1.0f, ssp};
            if (PROBE == 1) { EpiNull En; g8::gemm(C.lds, g, En, C.G, C.blk); } if (PROBE == 13) g8::gemm(C.lds, g, E, C.G, C.blk); if (GSITE < 0 || GSITE == 11) g8::gemm(C.lds, g, E, C.G, C.blk);
        }
        SEAM(pb + 7);
        if (IN(pb + 8)) {
            g8::Desc g{(const bf16_t*)(ws + P_QX), (const bf16_t*)(ws + WS_KVX + (size_t)l * KVX_STRIDE), DM, DM, 512, SEQ / 256, 1, BATCH, 4, (long)SEQ * DM, 512, (long)MEM_LEN * DM, 512};
            EpiBf16 E{(bf16_t*)(ws + P_S), 1024, (long)SEQ * 1024, 256, 0.04419417382415922f, nullptr};
            if (PROBE == 1) { EpiNull En; g8::gemm(C.lds, g, En, C.G, C.blk); } if (PROBE == 13) g8::gemm(C.lds, g, E, C.G, C.blk); if (GSITE < 0 || GSITE == 12) g8::gemm(C.lds, g, E, C.G, C.blk);
        }
        SEAM(pb + 8);
        if (IN(pb + 9)) {
            if (PROBE == 5) phase_xa_softmax(C, P);
            phase_xa_softmax(C, P);
            if (l == 1) {
                convert_tables(C, P, 1);
            }
        }
        SEAM(pb + 9);
        if (IN(pb + 10)) {
            g8::Desc g{(const bf16_t*)(ws + P_P), (const bf16_t*)(ws + WS_KVX + (size_t)l * KVX_STRIDE + 16 * MiB), 1024, MT, 256, SEQ / 256, 2, BATCH, 4, (long)SEQ * 1024, 256, 256, 512L * MT};
            EpiBf16 E{(bf16_t*)(ws + P_OX), DM, (long)SEQ * DM, 512, 1.0f, nullptr};
            if (PROBE == 1) { EpiNull En; g8::gemm(C.lds, g, En, C.G, C.blk); } if (PROBE == 13) g8::gemm(C.lds, g, E, C.G, C.blk); if (GSITE < 0 || GSITE == 13) g8::gemm(C.lds, g, E, C.G, C.blk);
        }
        SEAM(pb + 10);
        if (IN(pb + 11)) {
            g8::Desc g{(const bf16_t*)(ws + P_OX), (const bf16_t*)(lw + LW_XO), DM, DM, DM, T / 256, DM / 256, 1, 1, 0, 0, 0, 0};
            EpiResidB<false> E{nullptr, xb, ssp};
            if (PROBE == 1 || PROBE == 13) { EpiNull En; g8::gemm(C.lds, g, En, C.G, C.blk); } if (GSITE < 0 || GSITE == 14) g8::gemm(C.lds, g, E, C.G, C.blk);
        }
        SEAM(pb + 11);
        if (IN(pb + 13)) {
            g8::Desc g{xb, (const bf16_t*)(lw + LW_PEER), DM, DM, DM, T / 256, DM / 256, 1, 1, 0, 0, 0, 0};
            EpiBf16T<32> E{(bf16_t*)(ws + P_SC), DM, 0, 0, 1.0f, ssp};
            if (PROBE == 1) { EpiNull En; g8::gemm(C.lds, g, En, C.G, C.blk); } if (PROBE == 13) g8::gemm(C.lds, g, E, C.G, C.blk); if (GSITE < 0 || GSITE == 15) g8::gemm(C.lds, g, E, C.G, C.blk);
        }
        SEAM(pb + 13);
        if (IN(pb + 14)) { if (EN_PEER && EN_TOPK) phase_peer<true>(C, P); }
        SEAM(pb + 14);
#if PEER_SLICED
        if (IN(pb + 15)) { if (EN_PEER && EN_PU) { if (PROBE >= 7 && PROBE <= 9) { phase_peer_sliced<0, PROBE - 7>(C, P, 8 + 32 * l + 64); __syncthreads(); } phase_peer_sliced<0>(C, P, 8 + 32 * l); } }
        SEAM(pb + 15);
        if (IN(pb + 16)) { if (EN_PEER) phase_peer_combine(C, P); }
        SEAM(pb + 16);
        if (IN(pb + 17)) { if (EN_PEER && EN_PV) { if (PROBE >= 10 && PROBE <= 12) { phase_peer_sliced<1, PROBE == 10 ? 3 : PROBE - 10>(C, P, 8 + 32 * l + 80); __syncthreads(); } phase_peer_sliced<1>(C, P, 8 + 32 * l + 16); } }
        SEAM(pb + 17);
#endif
    }
    if (IN(38)) rms_rows_final(C, xb, P.out, P.in[I_FINAL_NORM], T);
#undef IN
#undef SEAM
}

extern "C" void kernel_launch(void* const* d_in, const int* in_sizes, int n_in, void* d_out, int out_size, void* d_ws, size_t ws_size, hipStream_t stream) {
    static int grid = 0;
    if (grid == 0) {
        if (n_in != 39 || in_sizes[0] != T * DM || out_size != T * DM || ws_size < WS_END) {
            fprintf(stderr, "kernel_launch: unexpected shapes (n_in %d in0 %d out %d ws %zu, need ws >= %zu); nothing launched\n", n_in, n_in > 0 ? in_sizes[0] : -1, out_size, ws_size, (size_t)WS_END);
            grid = -1; return; }
        int dev = 0, cus = 0;
        if (hipGetDevice(&dev) != hipSuccess || hipDeviceGetAttribute(&cus, hipDeviceAttributeMultiprocessorCount, dev) != hipSuccess) { grid = -1; return; }
        if (hipFuncSetAttribute((const void*)mk_fwd, hipFuncAttributeMaxDynamicSharedMemorySize, LDS_BYTES) != hipSuccess) { fprintf(stderr, "kernel_launch: hipFuncSetAttribute failed\n"); grid = -1; return; }
        int per_cu = 0;
        if (hipOccupancyMaxActiveBlocksPerMultiprocessor(&per_cu, (const void*)mk_fwd, NTHREADS, LDS_BYTES) != hipSuccess || per_cu < 1)
            fprintf(stderr, "kernel_launch: occupancy query reports %d blocks per CU\n", per_cu);
        (void)hipGetLastError();
        grid = cus;
    }
    if (grid < 0) return;
    (void)hipMemsetAsync((char*)d_ws + WS_CTL, 0, CTL_BYTES, stream);
    Params p{};
    for (int i = 0; i < 39; ++i) p.in[i] = (const float*)d_in[i];
    p.out = (float*)d_out; p.ws = (unsigned char*)d_ws;
#if MK_ONE_LAUNCH
    p.ph_lo = 0; p.ph_hi = N_PHASES;
    hipLaunchKernelGGL(mk_fwd, dim3(grid), dim3(NTHREADS), LDS_BYTES, stream, p);
#else
    for (int ph = 0; ph < N_PHASES; ++ph) { p.ph_lo = ph; p.ph_hi = ph + 1; hipLaunchKernelGGL(mk_fwd, dim3(grid), dim3(NTHREADS), LDS_BYTES, stream, p); }
#endif
    const hipError_t le = hipPeekAtLastError();
    if (le != hipSuccess) fprintf(stderr, "kernel_launch: launch failed: %s\n", hipGetErrorName(le));
}
```

```cpp
#include <hip/hip_runtime.h>
#include <cstdio>
#include <cstdint>

#ifndef MK_ONE_LAUNCH
#define MK_ONE_LAUNCH 1
#endif
#ifndef FAST_GEMM
#define FAST_GEMM 1
#endif
#ifndef FAST_ATTN
#define FAST_ATTN 1
#endif

#ifndef EN_TOPK
#define EN_TOPK 1
#endif
#ifndef EN_PU
#define EN_PU 1
#endif
#ifndef EN_PV
#define EN_PV 1
#endif
#ifndef EN_S5
#define EN_S5 1
#endif
#ifndef EN_DIFF
#define EN_DIFF 1
#endif
#ifndef EN_MLA
#define EN_MLA 1
#endif
#ifndef EN_PEER
#define EN_PEER 1
#endif
#ifndef EN_GEMM
#define EN_GEMM 1
#endif
#ifndef EN_PRO
#define EN_PRO 1
#endif
#ifndef PEER_FP8
#define PEER_FP8 1
#endif
#ifndef PROBE
#define PROBE 0
#endif
#ifndef PEER_SLICED
#define PEER_SLICED 1
#endif
#ifndef PROBE_ATTN_MODE
#define PROBE_ATTN_MODE 0
#endif
#ifndef PROBE_PEER2
#define PROBE_PEER2 0
#endif
#ifndef GSITE
#define GSITE -1
#endif
#define GAS __attribute__((address_space(1)))
#define LAS __attribute__((address_space(3)))
#define DI __device__ __forceinline__
typedef unsigned short bf16_t;
typedef short bf16x8 __attribute__((ext_vector_type(8)));
typedef short s16x4 __attribute__((ext_vector_type(4)));
typedef float f32x2 __attribute__((ext_vector_type(2)));
typedef float f32x4 __attribute__((ext_vector_type(4)));
typedef float f32x16 __attribute__((ext_vector_type(16)));
typedef unsigned u32x2 __attribute__((ext_vector_type(2)));
typedef unsigned u32x4 __attribute__((ext_vector_type(4)));
typedef __bf16 bf16x2_t __attribute__((ext_vector_type(2)));

constexpr int BATCH = 16, SEQ = 2048, DM = 2048, T = BATCH * SEQ, MEM_LEN = 256, MT = BATCH * MEM_LEN;
constexpr int DIFF_HEADS = 12, DIFF_W = 1536, S5_W = 512, AB_IN = 5120;
constexpr int MLA_HEADS = 16, MLA_QR = 768, MLA_KVR = 256, MLA_IN = 1088, MLA_IN_PAD = 1280;
constexpr int PEER_NE = 16384;
constexpr float NORM_EPS = 1e-6f;
constexpr int ROPE_POS = 3072;
constexpr int NWAVES = 8, NTHREADS = 512;

constexpr size_t MiB = 1u << 20;
constexpr size_t WS_CTL = 0, CTL_BYTES = 1 * MiB;
constexpr size_t WS_ROPE = 1 * MiB;
constexpr size_t WS_ABIN_T = 2 * MiB, WS_ABOUT_T = 22 * MiB, WS_GLU_T = 30 * MiB, WS_MLAIN_T = 31 * MiB, WS_UQ_T = 36 * MiB, WS_UKV_T = 41 * MiB, WS_MLAO_T = 43 * MiB;
constexpr size_t WS_LW = 51 * MiB, LW_STRIDE = 40 * MiB;
constexpr size_t LW_XQ = 0, LW_XKV = 8 * MiB, LW_XO = 24 * MiB, LW_PEER = 32 * MiB;
constexpr size_t WS_KVX = 131 * MiB, KVX_STRIDE = 32 * MiB;
constexpr size_t WS_POOL = 195 * MiB;
constexpr size_t P_H = WS_POOL;
constexpr size_t P_PROJ = WS_POOL + 128 * MiB;
constexpr size_t P_CONCAT = WS_POOL + 448 * MiB;
constexpr size_t P_GBUF = WS_POOL + 576 * MiB;
constexpr size_t P_MLAPROJ = WS_POOL + 0 * MiB;
constexpr size_t P_CQN = WS_POOL + 80 * MiB;
constexpr size_t P_CKVN = WS_POOL + 128 * MiB;
constexpr size_t P_KROPE = WS_POOL + 144 * MiB;
constexpr size_t P_Q = WS_POOL + 152 * MiB;
constexpr size_t P_KV = WS_POOL + 344 * MiB;
constexpr size_t P_WABS = WS_POOL + 128 * MiB;
constexpr size_t P_VW = WS_POOL + 192 * MiB;
constexpr size_t P_S = WS_POOL + 256 * MiB;
constexpr size_t P_P = WS_POOL + 320 * MiB;
constexpr size_t P_SC = WS_POOL + 128 * MiB;
constexpr size_t P_UT = WS_POOL + 608 * MiB;
constexpr size_t P_VT = WS_POOL + 642 * MiB;
constexpr size_t P_PE_E = WS_POOL + 384 * MiB;
constexpr size_t P_PE_G = WS_POOL + 400 * MiB;
constexpr size_t P_PE_T8 = WS_POOL + 432 * MiB;
constexpr size_t P_PE_TSC = WS_POOL + 496 * MiB;
constexpr size_t P_MEMN = WS_POOL + 448 * MiB;
constexpr size_t P_WQB = WS_POOL + 480 * MiB;
constexpr size_t P_SK = WS_POOL + 496 * MiB;
constexpr size_t P_SS = WS_POOL + 680 * MiB;
constexpr size_t P_XB = WS_POOL + 704 * MiB;
constexpr size_t WS_END = WS_POOL + 832 * MiB;
constexpr int CW_BAR = 4096, CW_CTR = 16384;

constexpr int RING_BYTES = 131072, LDSCTL_OFF = RING_BYTES, LDS_BYTES = 147456;

DI unsigned pk2(float lo, float hi) { f32x2 v = {lo, hi}; bf16x2_t b = __builtin_convertvector(v, bf16x2_t); return __builtin_bit_cast(unsigned, b); }
DI float bflo(unsigned u) { return __uint_as_float(u << 16); }
DI float bfhi(unsigned u) { return __uint_as_float(u & 0xffff0000u); }
DI float bf2f(bf16_t b) { return __uint_as_float(((unsigned)b) << 16); }
DI bf16_t f2bf(float f) { return (bf16_t)(pk2(f, 0.f) & 0xffffu); }
DI float dot2bf(unsigned a, unsigned b, float c) { return __builtin_amdgcn_fdot2_f32_bf16(__builtin_bit_cast(bf16x2_t, a), __builtin_bit_cast(bf16x2_t, b), c, false); }
DI int opaque_tid() { int t; asm volatile("v_mov_b32 %0, %1" : "=v"(t) : "v"(threadIdx.x)); return t; }
DI float wave_sum(float v) {
#pragma unroll
    for (int o = 1; o < 64; o <<= 1) v += __shfl_xor(v, o);
    return v;
}
DI float gelu_erf(float v) { return 0.5f * v * (1.0f + erff(v * 0.70710678118654752f)); }
DI float swap32_max(float x) { auto rr = __builtin_amdgcn_permlane32_swap(__float_as_uint(x), __float_as_uint(x), false, false); return fmaxf(__uint_as_float(rr[0]), __uint_as_float(rr[1])); }
DI float swap32_sum(float x) { auto rr = __builtin_amdgcn_permlane32_swap(__float_as_uint(x), __float_as_uint(x), false, false); return __uint_as_float(rr[0]) + __uint_as_float(rr[1]); }
#define LDS_WAIT() asm volatile("s_waitcnt lgkmcnt(0)" ::: "memory")
#define VM_WAIT() asm volatile("s_waitcnt vmcnt(0)" ::: "memory")

#define XB_TMO      128
#define XB_XCNT(j)  (256  + 64 * (j))
#define XB_XSUB(j)  (1280 + 64 * (j))
#define XB_XGEN(j)  (2304 + 64 * (j))
#define XB_TOP      3328
#define XB_TOPGEN   3392
#define XCD_BAR_WORDS 3456
#define XB_SPIN_CAP (1u << 20)
DI unsigned xb_ld(unsigned* p)              { return __hip_atomic_load(p, __ATOMIC_RELAXED, __HIP_MEMORY_SCOPE_AGENT); }
DI unsigned xb_add(unsigned* p, unsigned v) { return __hip_atomic_fetch_add(p, v, __ATOMIC_RELAXED, __HIP_MEMORY_SCOPE_AGENT); }
DI unsigned xb_xcc_id() { return (unsigned)__builtin_amdgcn_s_getreg((3 << 11) | 20) & 0xFu; }
#define XB_SPIN(cond, bar) do { unsigned _sp = 0; while (cond) { __builtin_amdgcn_s_sleep(1); \
    if ((++_sp & 255u) == 0u) { if (xb_ld(&(bar)[XB_TMO])) break; if (_sp > XB_SPIN_CAP) { atomicAdd(&(bar)[XB_TMO], 1u); break; } } } } while (0)
struct XcdBarrier { unsigned* bar; unsigned x; volatile LAS unsigned* st; };
DI XcdBarrier xcd_barrier_post(unsigned* bar, volatile LAS unsigned* st) {
    XcdBarrier b; b.bar = bar; b.x = xb_xcc_id(); b.st = st;
    if (threadIdx.x == 0) (void)xb_add(&bar[XB_XCNT(b.x)], 1u);
    return b;
}
DI void xcd_barrier_complete(unsigned* bar, unsigned x, unsigned& nloc, unsigned& nx) {
    const unsigned G = gridDim.x * gridDim.y * gridDim.z;
    unsigned sum, cnt, mine, sp = 0u;
    for (;;) {
        sum = 0u; cnt = 0u; mine = 0u;
#pragma unroll
        for (unsigned j = 0; j < 16; ++j) { const unsigned c = xb_ld(&bar[XB_XCNT(j)]); sum += c; cnt += (c > 0u) ? 1u : 0u; mine = (j == x) ? c : mine; }
        if (sum == G) break;
        __builtin_amdgcn_s_sleep(1);
        if ((++sp & 255u) == 0u) { if (xb_ld(&bar[XB_TMO])) break; if (sp > XB_SPIN_CAP) { atomicAdd(&bar[XB_TMO], 1u); break; } }
    }
    nloc = mine > 0u ? mine : 1u; nx = cnt > 0u ? cnt : 1u;
}
DI void xcd_barrier(const XcdBarrier& b) {
    asm volatile("s_waitcnt vmcnt(0)" ::: "memory");
    __syncthreads();
    if (threadIdx.x == 0) {
        unsigned* bar = b.bar;
        __builtin_amdgcn_s_waitcnt(0);
        unsigned nloc = b.st[0], nx = b.st[1];
        if (nloc == 0u) { xcd_barrier_complete(bar, b.x, nloc, nx); b.st[0] = nloc; b.st[1] = nx; }
        const unsigned old = xb_add(&bar[XB_XSUB(b.x)], 1u);
        const unsigned gen = old / nloc;
        if (old + 1u == (gen + 1u) * nloc) {
            __builtin_amdgcn_fence(__ATOMIC_RELEASE, "agent");
            asm volatile("s_waitcnt vmcnt(0)" ::: "memory");
            const unsigned og = xb_add(&bar[XB_TOP], 1u);
            const unsigned tg = og / nx;
            if (og + 1u == (tg + 1u) * nx) xb_add(&bar[XB_TOPGEN], 1u);
            else XB_SPIN(xb_ld(&bar[XB_TOPGEN]) == tg, bar);
            __builtin_amdgcn_fence(__ATOMIC_ACQUIRE, "agent");
            xb_add(&bar[XB_XGEN(b.x)], 1u);
            asm volatile("s_waitcnt vmcnt(0)" ::: "memory");
        } else {
            XB_SPIN(xb_ld(&bar[XB_XGEN(b.x)]) == gen, bar);
            __builtin_amdgcn_fence(__ATOMIC_ACQUIRE, "agent");
            asm volatile("s_waitcnt vmcnt(0)" ::: "memory");
        }
    }
    __syncthreads();
}

namespace g8 {
constexpr int BM = 256, BK = 64, HALF = 128, HTB = HALF * BK * 2, STAGE_BYTES = 8 * HTB, NXCD = 8, WGM = 8;
DI int lds_byte(int r, int c) { const int st = (r >> 4) * 2 + (c >> 5), rr = r & 15, cc = c & 31, ob = rr * 64 + cc * 2; return st * 1024 + (ob ^ (((ob >> 9) & 1) << 5)); }
DI void stage_rc(int b, int& R, int& C) { const int st = b / 1024, sb = b % 1024, swz = sb ^ (((sb >> 9) & 1) << 5); R = (st >> 1) * 16 + swz / 64; C = (st & 1) * 32 + (swz % 64) / 2; }
DI int perm32(int rho) { const int n = rho >> 4, i = rho & 15; return 8 * (i >> 2) + 4 * n + (i & 3); }

struct Unit { int zo, zi, pm, pn; };
struct Desc { const bf16_t* A; const bf16_t* Bt; int lda, ldb, K, nM, nN, nZo, nZi; long sAo, sAi, sBo, sBi; };
DI bool next_unit(const Desc& g, int i, int G, int c, Unit& u) {
    const int per = g.nM * g.nN, nwg = per * g.nZo * g.nZi;
    const long L = (long)i * G + c; if (L >= nwg) return false;
    int wgid = (int)L; { const int q = nwg / NXCD, r = nwg % NXCD, xcd = wgid % NXCD, off = wgid / NXCD; wgid = (xcd < r ? xcd * (q + 1) : r * (q + 1) + (xcd - r) * q) + off; }
    const int z = wgid / per, w = wgid % per;
    u.zo = z / g.nZi; u.zi = z % g.nZi;
    const int nig = WGM * g.nN, gid = w / nig, fm = gid * WGM, gsz = (g.nM - fm) < WGM ? (g.nM - fm) : WGM;
    u.pm = fm + ((w % nig) % gsz); u.pn = (w % nig) / gsz; return true;
}

template <class Epi>
DI void gemm_phase(LAS unsigned char* lds, const Desc g, const Epi& E, int G, int c) {
    const int tid = opaque_tid(), wid = __builtin_amdgcn_readfirstlane(tid >> 6), lane = tid & 63, wr = wid >> 2, wc = wid & 3, fr = lane & 15, fq = lane >> 4;
    const int K = g.K, nt = K / BK;
    unsigned voffA[2], voffB[2];
#pragma unroll
    for (int i = 0; i < 2; ++i) { int R, C; stage_rc(tid * 16 + i * 8192, R, C); const int Rb = (R & ~31) + perm32(R & 31);
        voffA[i] = (unsigned)(R * g.lda + C) * 2u; voffB[i] = (unsigned)(Rb * g.ldb + C) * 2u; }
    const size_t kstep = (size_t)(BK * 2);
    const size_t hstepA = (size_t)HALF * g.lda * 2, hstepB = (size_t)HALF * g.ldb * 2;
    const unsigned ldsw = (unsigned)wid * 1024u;
    const int aoff = lds_byte(wr * 64 + fr, fq * 8), boff = lds_byte(wc * 32 + fr, fq * 8);
#define PG8_SA(b, h) (((b) * 2 + (h)) * HTB)
#define PG8_SB(b, h) ((4 + (b) * 2 + (h)) * HTB)
#define PG8_STAGE(bufoff, gbase, voff) do { _Pragma("unroll") for (int _i = 0; _i < 2; ++_i) \
        __builtin_amdgcn_global_load_lds((const unsigned*)((const char*)(gbase) + (voff)[_i]), (LAS unsigned*)(lds + (bufoff) + ldsw + _i * 8192), 16, 0, 0); } while (0)
#define PG8_LDA(dst, b, h) do { _Pragma("unroll") for (int m = 0; m < 4; ++m) _Pragma("unroll") for (int k = 0; k < 2; ++k) dst[m][k] = *(const LAS bf16x8*)(lds + PG8_SA(b, h) + aoff + m * 2048 + k * 1024); } while (0)
#define PG8_LDB(dst, b, h) do { _Pragma("unroll") for (int n = 0; n < 2; ++n) _Pragma("unroll") for (int k = 0; k < 2; ++k) dst[n][k] = *(const LAS bf16x8*)(lds + PG8_SB(b, h) + boff + n * 2048 + k * 1024); } while (0)
#define PG8_MMA(ai, bj, At, Bt) do { __builtin_amdgcn_s_setprio(1); _Pragma("unroll") for (int m = 0; m < 4; ++m) _Pragma("unroll") for (int n = 0; n < 2; ++n) _Pragma("unroll") for (int k = 0; k < 2; ++k) \
        acc[ai][bj][m][n] = __builtin_amdgcn_mfma_f32_16x16x32_bf16(Bt[n][k], At[m][k], acc[ai][bj][m][n], 0, 0, 0); __builtin_amdgcn_s_setprio(0); } while (0)
#define PG8_WAIT_V(n) asm volatile("s_waitcnt vmcnt(" #n ")" ::: "memory")
#define PG8_WAIT_L(n) asm volatile("s_waitcnt lgkmcnt(" #n ")" ::: "memory")
#define PG8_BAR __builtin_amdgcn_s_barrier()
#define PG8_SCHED __builtin_amdgcn_sched_barrier(0)
#define PG8_APTR(u) ((const char*)g.A + ((size_t)(u).zo * g.sAo + (size_t)(u).zi * g.sAi + (size_t)(u).pm * BM * g.lda) * 2)
#define PG8_BPTR(u) ((const char*)g.Bt + ((size_t)(u).zo * g.sBo + (size_t)(u).zi * g.sBi + (size_t)(u).pn * BM * g.ldb) * 2)
    Unit cur, nxt; int ui = 0;
    if (!next_unit(g, 0, G, c, cur)) return;
    f32x4 acc[2][2][4][2];
#pragma unroll
    for (int a = 0; a < 2; ++a)
#pragma unroll
        for (int b = 0; b < 2; ++b)
#pragma unroll
            for (int m = 0; m < 4; ++m)
#pragma unroll
                for (int n = 0; n < 2; ++n) acc[a][b][m][n] = (f32x4){0.f, 0.f, 0.f, 0.f};
    bf16x8 At[4][2], B0[2][2], B1[2][2];
    const char* cA = PG8_APTR(cur); const char* cB = PG8_BPTR(cur);
    PG8_STAGE(PG8_SB(0, 0), cB, voffB); PG8_STAGE(PG8_SA(0, 0), cA, voffA); PG8_STAGE(PG8_SB(0, 1), cB + hstepB, voffB); PG8_STAGE(PG8_SA(0, 1), cA + hstepA, voffA);
    if (wr == 1) PG8_BAR;
    PG8_WAIT_V(4); PG8_BAR;
    PG8_STAGE(PG8_SB(1, 0), cB + kstep, voffB); PG8_STAGE(PG8_SA(1, 0), cA + kstep, voffA); PG8_STAGE(PG8_SB(1, 1), cB + hstepB + kstep, voffB);
    PG8_WAIT_V(6); PG8_BAR;
    for (;;) {
        const bool has_next = next_unit(g, ui + 1, G, c, nxt);
        const char* nA = has_next ? PG8_APTR(nxt) : cA; const char* nB = has_next ? PG8_BPTR(nxt) : cB;
        for (int t = 0; t < nt; t += 2) {
            const bool last = (t == nt - 2);
            const char* a1 = cA + (size_t)(t + 1) * kstep;
            const char* a2 = last ? nA : cA + (size_t)(t + 2) * kstep; const char* b2 = last ? nB : cB + (size_t)(t + 2) * kstep;
            const char* a3 = a2 + kstep; const char* b3 = b2 + kstep;
            PG8_LDB(B0, 0, 0); PG8_SCHED; PG8_LDA(At, 0, 0); PG8_STAGE(PG8_SA(1, 1), a1 + hstepA, voffA);
            PG8_WAIT_L(8); PG8_BAR; PG8_WAIT_L(0); PG8_MMA(0, 0, At, B0); PG8_BAR; PG8_SCHED;
            PG8_LDB(B1, 0, 1); PG8_STAGE(PG8_SB(0, 0), b2, voffB);
            PG8_BAR; PG8_WAIT_L(0); PG8_MMA(0, 1, At, B1); PG8_BAR;
            PG8_LDA(At, 0, 1); PG8_STAGE(PG8_SA(0, 0), a2, voffA);
            PG8_BAR; PG8_WAIT_L(0); PG8_MMA(1, 0, At, B0); PG8_BAR; PG8_SCHED;
            PG8_STAGE(PG8_SB(0, 1), b2 + hstepB, voffB);
            PG8_WAIT_V(6); PG8_BAR; PG8_MMA(1, 1, At, B1); PG8_BAR;
            PG8_LDB(B0, 1, 0); PG8_SCHED; PG8_LDA(At, 1, 0); PG8_STAGE(PG8_SA(0, 1), a2 + hstepA, voffA);
            PG8_WAIT_L(8); PG8_BAR; PG8_WAIT_L(0); PG8_MMA(0, 0, At, B0); PG8_BAR; PG8_SCHED;
            PG8_LDB(B1, 1, 1); PG8_STAGE(PG8_SB(1, 0), b3, voffB);
            PG8_BAR; PG8_WAIT_L(0); PG8_MMA(0, 1, At, B1); PG8_BAR;
            PG8_LDA(At, 1, 1); PG8_STAGE(PG8_SA(1, 0), a3, voffA);
            PG8_BAR; PG8_WAIT_L(0); PG8_MMA(1, 0, At, B0); PG8_BAR; PG8_SCHED;
            PG8_STAGE(PG8_SB(1, 1), b3 + hstepB, voffB);
            PG8_WAIT_V(6); PG8_BAR; PG8_MMA(1, 1, At, B1); PG8_BAR;
        }
        {
            const int row0 = cur.pm * BM + wr * 64 + fr, col0 = cur.pn * BM + wc * 32 + 8 * fq;
#pragma unroll
            for (int ai = 0; ai < 2; ++ai)
#pragma unroll
                for (int m = 0; m < 4; ++m) {
                    const int row = row0 + ai * HALF + m * 16;
                    const float ri = E.row_begin(cur.zo, cur.zi, row);
                    float ra = 0.f;
#pragma unroll
                    for (int bj = 0; bj < 2; ++bj) ra += E.oct(cur.zo, cur.zi, row, col0 + bj * HALF, acc[ai][bj][m][0], acc[ai][bj][m][1], ri);
                    E.row_end(cur.zo, row, cur.pn * 4 + wc, ra);
                }
        }
        if (!has_next) break;
#pragma unroll
        for (int a = 0; a < 2; ++a)
#pragma unroll
            for (int b = 0; b < 2; ++b)
#pragma unroll
                for (int m = 0; m < 4; ++m)
#pragma unroll
                    for (int n = 0; n < 2; ++n) acc[a][b][m][n] = (f32x4){0.f, 0.f, 0.f, 0.f};
        cur = nxt; cA = nA; cB = nB; ++ui;
    }
    PG8_WAIT_V(0);
    if (wr == 0) PG8_BAR;
    PG8_BAR;
#undef PG8_SA
#undef PG8_SB
#undef PG8_STAGE
#undef PG8_LDA
#undef PG8_LDB
#undef PG8_MMA
#undef PG8_WAIT_V
#undef PG8_WAIT_L
#undef PG8_BAR
#undef PG8_SCHED
#undef PG8_APTR
#undef PG8_BPTR
}

template <class Epi>
DI void naive_gemm(const Desc g, const Epi& E, int G, int c) {
    const int M = g.nM * BM, N = g.nN * BM, n8 = N / 8, nZ = g.nZo * g.nZi;
    const long total = (long)nZ * M * n8;
    for (long idx = (long)c * NTHREADS + threadIdx.x; idx < total; idx += (long)G * NTHREADS) {
        const int col = (int)(idx % n8) * 8; const int row = (int)((idx / n8) % M); const int z = (int)(idx / ((long)n8 * M));
        const int zo = z / g.nZi, zi = z % g.nZi;
        const bf16_t* a = g.A + (size_t)zo * g.sAo + (size_t)zi * g.sAi + (size_t)row * g.lda;
        const bf16_t* b = g.Bt + (size_t)zo * g.sBo + (size_t)zi * g.sBi + (size_t)col * g.ldb;
        float acc[8];
#pragma unroll
        for (int j = 0; j < 8; ++j) acc[j] = 0.f;
        for (int k = 0; k < g.K; k += 8) {
            const u32x4 av = *(const u32x4*)(a + k);
#pragma unroll
            for (int j = 0; j < 8; ++j) { const u32x4 bv = *(const u32x4*)(b + (size_t)j * g.ldb + k);
                float s = acc[j]; s = dot2bf(av.x, bv.x, s); s = dot2bf(av.y, bv.y, s); s = dot2bf(av.z, bv.z, s); s = dot2bf(av.w, bv.w, s); acc[j] = s; }
        }
        (void)E.oct(zo, zi, row, col, (f32x4){acc[0], acc[1], acc[2], acc[3]}, (f32x4){acc[4], acc[5], acc[6], acc[7]}, E.row_begin(zo, zi, row));
    }
}
template <class Epi>
DI void gemm(LAS unsigned char* lds, const Desc g, const Epi& E, int G, int c) {
#if !EN_GEMM
    return;
#elif FAST_GEMM
    gemm_phase(lds, g, E, G, c);
#else
    naive_gemm(g, E, G, c);
#endif
}
}

template <int NP> DI float row_rstd(const float* ss, int row) {
    const f32x4* p = (const f32x4*)(ss + (size_t)row * 32); float t = 0.f;
#pragma unroll
    for (int i = 0; i < NP / 4; ++i) { const f32x4 v = p[i]; t += (v[0] + v[1]) + (v[2] + v[3]); }
    return rsqrtf(t * (1.0f / DM) + NORM_EPS);
}
#define EPI_NO_ROW_BEGIN DI float row_begin(int, int, int) const { return 0.f; }
#define EPI_NO_ROW_END DI void row_end(int, int, int, float) const {}
template <int NP  > struct EpiBf16T {
    bf16_t* O; long ldc, sZo, sZi; float scale; const float* ss; int rzo;
    EPI_NO_ROW_END
    DI float row_begin(int zo, int, int row) const { return NP ? row_rstd<NP ? NP : 4>(ss, zo * rzo + row) * scale : scale; }
    DI float oct(int zo, int zi, int row, int col, f32x4 lo, f32x4 hi, float f) const {
        bf16_t* p = O + (size_t)zo * sZo + (size_t)zi * sZi + (size_t)row * ldc + col;
        u32x4 w; w.x = pk2(lo[0] * f, lo[1] * f); w.y = pk2(lo[2] * f, lo[3] * f); w.z = pk2(hi[0] * f, hi[1] * f); w.w = pk2(hi[2] * f, hi[3] * f);
        *(u32x4*)p = w; return 0.f;
    }
};
typedef EpiBf16T<0> EpiBf16;
template <int NP> struct EpiF32T {
    float* O; long ldc, sZo, sZi; float scale; const float* ss; int rzo;
    EPI_NO_ROW_END
    DI float row_begin(int zo, int, int row) const { return NP ? row_rstd<NP ? NP : 4>(ss, zo * rzo + row) * scale : scale; }
    DI float oct(int zo, int zi, int row, int col, f32x4 lo, f32x4 hi, float f) const {
        float* p = O + (size_t)zo * sZo + (size_t)zi * sZi + (size_t)row * ldc + col;
        *(f32x4*)p = lo * f; *(f32x4*)(p + 4) = hi * f; return 0.f;
    }
};
typedef EpiF32T<0> EpiF32;
template <bool F32SRC> struct EpiResidB {
    const float* xin; bf16_t* xb; float* ss; int rzo;
    EPI_NO_ROW_BEGIN
    DI float oct(int zo, int, int row, int col, f32x4 lo, f32x4 hi, float) const {
        const size_t o = (size_t)(zo * rzo + row) * DM + col;
        float r[8];
        if (F32SRC) { const f32x4 r0 = *(const f32x4*)(xin + o), r1 = *(const f32x4*)(xin + o + 4); r[0] = r0[0]; r[1] = r0[1]; r[2] = r0[2]; r[3] = r0[3]; r[4] = r1[0]; r[5] = r1[1]; r[6] = r1[2]; r[7] = r1[3]; }
        else { const u32x4 w = *(const u32x4*)(xb + o); r[0] = bflo(w.x); r[1] = bfhi(w.x); r[2] = bflo(w.y); r[3] = bfhi(w.y); r[4] = bflo(w.z); r[5] = bfhi(w.z); r[6] = bflo(w.w); r[7] = bfhi(w.w); }
        u32x4 w; w.x = pk2(r[0] + lo[0], r[1] + lo[1]); w.y = pk2(r[2] + lo[2], r[3] + lo[3]); w.z = pk2(r[4] + hi[0], r[5] + hi[1]); w.w = pk2(r[6] + hi[2], r[7] + hi[3]);
        *(u32x4*)(xb + o) = w;
        const float q0 = bflo(w.x), q1 = bfhi(w.x), q2 = bflo(w.y), q3 = bfhi(w.y), q4 = bflo(w.z), q5 = bfhi(w.z), q6 = bflo(w.w), q7 = bfhi(w.w);
        return ((q0 * q0 + q1 * q1) + (q2 * q2 + q3 * q3)) + ((q4 * q4 + q5 * q5) + (q6 * q6 + q7 * q7));
    }
    DI void row_end(int zo, int row, int slot, float ra) const {
        ra += __shfl_xor(ra, 16); ra += __shfl_xor(ra, 32);
        if ((threadIdx.x & 63) < 16) ss[(size_t)(zo * rzo + row) * 32 + slot] = ra;
    }
};
template <int MODE> struct EpiRope {
    bf16_t* O; long ldc; const int* pos; const f32x2* tab;
    EPI_NO_ROW_BEGIN EPI_NO_ROW_END
    DI float oct(int, int, int row, int col, f32x4 lo, f32x4 hi, float) const {
        bool rope; int j0;
        if (MODE == 0) { rope = col < 2 * DIFF_W; j0 = col & 63; } else { const int c = col % 192; rope = c >= 128; j0 = c - 128; }
        if (rope) {
            int p = pos[row]; p = p < 0 ? 0 : (p > ROPE_POS - 1 ? ROPE_POS - 1 : p);
            const f32x4* tp = (const f32x4*)(tab + (size_t)p * 32 + (j0 >> 1));
            const f32x4 t0 = tp[0], t1 = tp[1];
            f32x4 a = lo, b = hi;
            lo[0] = a[0] * t0[0] - a[1] * t0[1]; lo[1] = a[1] * t0[0] + a[0] * t0[1];
            lo[2] = a[2] * t0[2] - a[3] * t0[3]; lo[3] = a[3] * t0[2] + a[2] * t0[3];
            hi[0] = b[0] * t1[0] - b[1] * t1[1]; hi[1] = b[1] * t1[0] + b[0] * t1[1];
            hi[2] = b[2] * t1[2] - b[3] * t1[3]; hi[3] = b[3] * t1[2] + b[2] * t1[3];
        }
        u32x4 w; w.x = pk2(lo[0], lo[1]); w.y = pk2(lo[2], lo[3]); w.z = pk2(hi[0], hi[1]); w.w = pk2(hi[2], hi[3]);
        *(u32x4*)(O + (size_t)row * ldc + col) = w; return 0.f;
    }
};
struct EpiGlu {
    const bf16_t* gbuf; const float* bias; bf16_t* out;
    EPI_NO_ROW_BEGIN EPI_NO_ROW_END
    DI float oct(int, int, int row, int col, f32x4 lo, f32x4 hi, float) const {
        const u32x4 gv = *(const u32x4*)(gbuf + (size_t)row * S5_W + col);
        const f32x4 b0 = *(const f32x4*)(bias + col), b1 = *(const f32x4*)(bias + col + 4);
        float g[8] = {bflo(gv.x), bfhi(gv.x), bflo(gv.y), bfhi(gv.y), bflo(gv.z), bfhi(gv.z), bflo(gv.w), bfhi(gv.w)};
        float a[8] = {lo[0] + b0[0], lo[1] + b0[1], lo[2] + b0[2], lo[3] + b0[3], hi[0] + b1[0], hi[1] + b1[1], hi[2] + b1[2], hi[3] + b1[3]};
        float r[8];
#pragma unroll
        for (int j = 0; j < 8; ++j) r[j] = g[j] / (1.0f + __expf(-a[j]));
        u32x4 w; w.x = pk2(r[0], r[1]); w.y = pk2(r[2], r[3]); w.z = pk2(r[4], r[5]); w.w = pk2(r[6], r[7]);
        *(u32x4*)(out + (size_t)row * DM + DIFF_W + col) = w; return 0.f;
    }
};
struct EpiNull { EPI_NO_ROW_BEGIN EPI_NO_ROW_END DI float oct(int, int, int, int, f32x4 lo, f32x4 hi, float) const { asm volatile("" :: "v"(lo), "v"(hi)); return 0.f; } };
struct Params {
    const float* in[39];
    float* out; unsigned char* ws;
    int ph_lo, ph_hi;
};
enum { I_X = 0, I_MEM, I_POS, I_AB_NORM, I_AB_WIN, I_AB_WOUT, I_LQ1, I_LK1, I_LQ2, I_LK2, I_SUBLN, I_S5_ARE, I_S5_AIM, I_S5_LOGSTEP, I_S5_BRE, I_S5_BIM, I_S5_CRE, I_S5_CIM, I_S5_D,
       I_S5_WGLU, I_S5_BGLU, I_MLA_NORM, I_MLA_WIN, I_MLA_QNORM, I_MLA_KVNORM, I_MLA_WUQ, I_MLA_WUKV, I_MLA_WO, I_XA_NORM, I_XA_MEMNORM, I_XA_WQ, I_XA_WKV, I_XA_WO, I_FFN_NORM,
       I_PEER_WQ, I_PEER_SK, I_PEER_U, I_PEER_V, I_FINAL_NORM };

struct Ctx { LAS unsigned char* lds; int tid, lane, wave, blk, G; };
DI Ctx fresh(const Ctx& C0) { Ctx C = C0; C.tid = opaque_tid(); C.lane = C.tid & 63; return C; }

DI void rms_rows_2048(const Ctx& C0, const float* src, const float* gain, bf16_t* dst, int nrows) {
    const Ctx C = fresh(C0);
    for (int r = C.blk * NWAVES + C.wave; r < nrows; r += C.G * NWAVES) {
        const f32x4* xr = (const f32x4*)(src + (size_t)r * DM) + C.lane;
        f32x4 v[8]; float ss = 0.f;
#pragma unroll
        for (int j = 0; j < 8; ++j) { v[j] = xr[64 * j]; ss += (v[j][0] * v[j][0] + v[j][1] * v[j][1]) + (v[j][2] * v[j][2] + v[j][3] * v[j][3]); }
        const float sc = rsqrtf(wave_sum(ss) * (1.0f / DM) + NORM_EPS);
        u32x2* o = (u32x2*)(dst + (size_t)r * DM) + C.lane;
#pragma unroll
        for (int j = 0; j < 8; ++j) { const f32x4 g = *((const f32x4*)gain + C.lane + 64 * j);
            u32x2 w; w.x = pk2(v[j][0] * sc * g[0], v[j][1] * sc * g[1]); w.y = pk2(v[j][2] * sc * g[2], v[j][3] * sc * g[3]); o[64 * j] = w; }
    }
}
DI void rms_rows_final(const Ctx& C0, const bf16_t* xbp, float* out, const float* gain, int nrows) {
    const Ctx C = fresh(C0);
    for (int r = C.blk * NWAVES + C.wave; r < nrows; r += C.G * NWAVES) {
        const u32x2* xr = (const u32x2*)(xbp + (size_t)r * DM) + C.lane;
        f32x4 v[8]; float ss = 0.f;
#pragma unroll
        for (int j = 0; j < 8; ++j) { const u32x2 w = xr[64 * j]; v[j] = (f32x4){bflo(w.x), bfhi(w.x), bflo(w.y), bfhi(w.y)}; ss += (v[j][0] * v[j][0] + v[j][1] * v[j][1]) + (v[j][2] * v[j][2] + v[j][3] * v[j][3]); }
        const float sc = rsqrtf(wave_sum(ss) * (1.0f / DM) + NORM_EPS);
        f32x4* o = (f32x4*)(out + (size_t)r * DM) + C.lane;
#pragma unroll
        for (int j = 0; j < 8; ++j) { const f32x4 g = *((const f32x4*)gain + C.lane + 64 * j); o[64 * j] = v[j] * sc * g; }
    }
}

DI int srccol(int kind, int n) {
    if (kind == 1) { if (n < 2 * DIFF_W) { const int j = n & 63; return (n & ~63) + (j >> 1) + 32 * (j & 1); } return n; }
    if (kind == 2) { if (n >= MLA_IN) return -1; if (n >= 1024) { const int j = n - 1024; return 1024 + (j >> 1) + 32 * (j & 1); } return n; }
    if (kind == 3) { const int c = n % 192; if (c >= 128) { const int j = c - 128; return n - c + 128 + (j >> 1) + 32 * (j & 1); } return n; }
    return n;
}
DI void transpose_item(const float* W, int K, int Nsrc, bf16_t* Wt, int nblk, int kind, const float* kgain, LAS float* scr, int item, int lane) {
    const int kb = item / nblk, nb = item % nblk, k0 = 64 * kb, n0 = 32 * nb;
    const int src = srccol(kind, n0 + (lane & 31));
#pragma unroll 8
    for (int i = 0; i < 32; ++i) { const int kk = 2 * i + (lane >> 5); scr[kk * 33 + (lane & 31)] = (src >= 0) ? W[(size_t)(k0 + kk) * Nsrc + src] * (kgain ? kgain[k0 + kk] : 1.0f) : 0.f; }
    LDS_WAIT(); asm volatile("" ::: "memory");
    const int c = lane & 7;
#pragma unroll
    for (int j = 0; j < 4; ++j) { const int n = (lane >> 3) + 8 * j; const LAS float* s = scr + (8 * c) * 33 + n;
        u32x4 o; o.x = pk2(s[0 * 33], s[1 * 33]); o.y = pk2(s[2 * 33], s[3 * 33]); o.z = pk2(s[4 * 33], s[5 * 33]); o.w = pk2(s[6 * 33], s[7 * 33]);
        *(u32x4*)(Wt + (size_t)(n0 + n) * K + k0 + 8 * c) = o; }
    LDS_WAIT(); asm volatile("" ::: "memory");
}
DI void cvt_bf16(const Ctx& C0, const float* src, bf16_t* dst, size_t n8) {
    const Ctx C = fresh(C0);
    for (size_t i = (size_t)C.blk * NTHREADS + C.tid; i < n8; i += (size_t)C.G * NTHREADS) {
        const f32x4 a = *(const f32x4*)(src + i * 8), b = *(const f32x4*)(src + i * 8 + 4);
        u32x4 w; w.x = pk2(a[0], a[1]); w.y = pk2(a[2], a[3]); w.z = pk2(b[0], b[1]); w.w = pk2(b[2], b[3]);
        *(u32x4*)(dst + i * 8) = w;
    }
}


DI void cvt_fp8_rows(const Ctx& C0, const float* src, unsigned char* dst, float* isc, int nrows) {
    const Ctx C = fresh(C0);
    for (int r = C.blk * NWAVES + C.wave; r < nrows; r += C.G * NWAVES) {
        const f32x4* xr = (const f32x4*)(src + (size_t)r * DM) + C.lane;
        f32x4 v[8]; float am = 0.f;
#pragma unroll
        for (int j = 0; j < 8; ++j) { v[j] = xr[64 * j]; am = fmaxf(am, fmaxf(fmaxf(fabsf(v[j][0]), fabsf(v[j][1])), fmaxf(fabsf(v[j][2]), fabsf(v[j][3])))); }
#pragma unroll
        for (int o = 1; o < 64; o <<= 1) am = fmaxf(am, __shfl_xor(am, o));
        const float e = am > 0.f ? floorf(log2f(448.0f / am)) : 0.f;
        const float scale = exp2f(e);
        if (C.lane == 0) isc[r] = exp2f(-e);
#if PEER_SLICED
        unsigned* o = (unsigned*)(dst + (size_t)(C.lane >> 5) * ((size_t)PEER_NE * 128) + (size_t)r * 128) + (C.lane & 31);
#pragma unroll
        for (int j = 0; j < 8; ++j) { int w = 0; w = __builtin_amdgcn_cvt_pk_fp8_f32(v[j][0] * scale, v[j][1] * scale, w, false); w = __builtin_amdgcn_cvt_pk_fp8_f32(v[j][2] * scale, v[j][3] * scale, w, true); o[(size_t)2 * j * (PEER_NE * 128 / 4)] = (unsigned)w; }
#else
        unsigned* o = (unsigned*)(dst + (size_t)r * DM) + C.lane;
#pragma unroll
        for (int j = 0; j < 8; ++j) { int w = 0; w = __builtin_amdgcn_cvt_pk_fp8_f32(v[j][0] * scale, v[j][1] * scale, w, false); w = __builtin_amdgcn_cvt_pk_fp8_f32(v[j][2] * scale, v[j][3] * scale, w, true); o[64 * j] = (unsigned)w; }
#endif
    }
}


DI void cvt_i8_rows(const Ctx& C0, const float* src, const float* cgain, unsigned char* dst, float* isc, int nrows) {
    const Ctx C = fresh(C0);
    for (int r = C.blk * NWAVES + C.wave; r < nrows; r += C.G * NWAVES) {
        const f32x4* xr = (const f32x4*)(src + (size_t)r * DM) + C.lane;
        f32x4 v[8]; float am = 0.f;
#pragma unroll
        for (int j = 0; j < 8; ++j) { v[j] = xr[64 * j] * *((const f32x4*)cgain + C.lane + 64 * j); am = fmaxf(am, fmaxf(fmaxf(fabsf(v[j][0]), fabsf(v[j][1])), fmaxf(fabsf(v[j][2]), fabsf(v[j][3])))); }
#pragma unroll
        for (int o = 1; o < 64; o <<= 1) am = fmaxf(am, __shfl_xor(am, o));
        const float scale = am > 0.f ? 127.0f / am : 0.f;
        if (C.lane == 0) isc[r] = am * (1.0f / 127.0f);
        unsigned* o = (unsigned*)(dst + (size_t)(C.lane >> 5) * ((size_t)PEER_NE * 128) + (size_t)r * 128) + (C.lane & 31);
#pragma unroll
        for (int j = 0; j < 8; ++j) { const int q0 = (int)rintf(v[j][0] * scale), q1 = (int)rintf(v[j][1] * scale), q2 = (int)rintf(v[j][2] * scale), q3 = (int)rintf(v[j][3] * scale);
            o[(size_t)2 * j * (PEER_NE * 128 / 4)] = (unsigned)(q0 & 255) | ((unsigned)(q1 & 255) << 8) | ((unsigned)(q2 & 255) << 16) | ((unsigned)(q3 & 255) << 24); }
    }
}

DI void convert_tables(const Ctx& C, const Params& P, int l) {
    unsigned char* ws = P.ws;
#if PEER_FP8
#if PEER_SLICED
    cvt_i8_rows(C, P.in[I_PEER_U] + (size_t)l * PEER_NE * DM, P.in[I_FFN_NORM] + l * DM, ws + P_UT, (float*)(ws + P_UT + 32 * MiB), PEER_NE);
#else
    cvt_fp8_rows(C, P.in[I_PEER_U] + (size_t)l * PEER_NE * DM, ws + P_UT, (float*)(ws + P_UT + 32 * MiB), PEER_NE);
#endif
    cvt_fp8_rows(C, P.in[I_PEER_V] + (size_t)l * PEER_NE * DM, ws + P_VT, (float*)(ws + P_VT + 32 * MiB), PEER_NE);
#else
    cvt_bf16(C, P.in[I_PEER_U] + (size_t)l * PEER_NE * DM, (bf16_t*)(ws + P_UT), (size_t)PEER_NE * DM / 8);
    cvt_bf16(C, P.in[I_PEER_V] + (size_t)l * PEER_NE * DM, (bf16_t*)(ws + P_VT), (size_t)PEER_NE * DM / 8);
#endif
}

DI void phase_prologue(const Ctx& C0, const Params& P) {
    const Ctx C = fresh(C0);
    unsigned char* ws = P.ws;
    LAS float* scr = (LAS float*)(C.lds + C.wave * 8448);
    const int gw = C.blk * NWAVES + C.wave, NGW = C.G * NWAVES;
    int base = 0;
#define TJOB(Wp, K_, Nsrc_, Nout_, kind_, dst_, kg_) do { const int nblk_ = (Nout_) / 32, nit_ = ((K_) / 64) * nblk_; \
        int first_ = (gw - base % NGW + NGW) % NGW; \
        for (int it = first_; it < nit_; it += NGW) transpose_item((Wp), (K_), (Nsrc_), (bf16_t*)(dst_), nblk_, (kind_), (kg_), scr, it, C.lane); base += nit_; } while (0)
    TJOB(P.in[I_AB_WIN], DM, AB_IN, AB_IN, 1, ws + WS_ABIN_T, nullptr);
    TJOB(P.in[I_AB_WOUT], DM, DM, DM, 0, ws + WS_ABOUT_T, nullptr);
    TJOB(P.in[I_S5_WGLU], S5_W, S5_W, S5_W, 0, ws + WS_GLU_T, nullptr);
    TJOB(P.in[I_MLA_WIN], DM, MLA_IN, MLA_IN_PAD, 2, ws + WS_MLAIN_T, P.in[I_MLA_NORM]);
    TJOB(P.in[I_MLA_WUQ], MLA_QR, 3072, 3072, 3, ws + WS_UQ_T, nullptr);
    TJOB(P.in[I_MLA_WUKV], MLA_KVR, 4096, 4096, 0, ws + WS_UKV_T, nullptr);
    TJOB(P.in[I_MLA_WO], DM, DM, DM, 0, ws + WS_MLAO_T, nullptr);
    for (int l = 0; l < 2; ++l) {
        TJOB(P.in[I_XA_WKV] + (size_t)l * DM * 2 * DM, DM, 2 * DM, 2 * DM, 0, ws + WS_LW + l * LW_STRIDE + LW_XKV, nullptr);
        TJOB(P.in[I_XA_WO] + (size_t)l * DM * DM, DM, DM, DM, 0, ws + WS_LW + l * LW_STRIDE + LW_XO, nullptr);
    }
#undef TJOB
    {
        f32x2* tab = (f32x2*)(ws + WS_ROPE);
        for (int i = C.blk * NTHREADS + C.tid; i < ROPE_POS * 32; i += C.G * NTHREADS) {
            const int p = i >> 5, f = i & 31;
            const float inv = powf(10000.0f, -(float)f * (2.0f / 64.0f));
            const float ang = (float)p * inv;
            tab[i] = (f32x2){(float)cos((double)ang), (float)sin((double)ang)};
        }
    }
    for (int l = 0; l < 2; ++l) {
        const float* src = P.in[I_XA_WQ] + (size_t)l * DM * DM; bf16_t* dst = (bf16_t*)(ws + WS_LW + l * LW_STRIDE + LW_XQ);
        for (size_t i = (size_t)C.blk * NTHREADS + C.tid; i < (size_t)DM * DM / 8; i += (size_t)C.G * NTHREADS) {
            const float g = P.in[I_XA_NORM][l * DM + i / (DM / 8)];
            const f32x4 a = *(const f32x4*)(src + i * 8), b = *(const f32x4*)(src + i * 8 + 4);
            u32x4 w; w.x = pk2(a[0] * g, a[1] * g); w.y = pk2(a[2] * g, a[3] * g); w.z = pk2(b[0] * g, b[1] * g); w.w = pk2(b[2] * g, b[3] * g);
            *(u32x4*)(dst + i * 8) = w;
        }
    }
    {
        const float* src = P.in[I_PEER_WQ]; bf16_t* dst = (bf16_t*)(ws + P_WQB);
        for (size_t i = (size_t)C.blk * NTHREADS + C.tid; i < (size_t)2 * DM * DM / 8; i += (size_t)C.G * NTHREADS) {
            const float g = P.in[I_FFN_NORM][i / (DM / 8)];
            const f32x4 a = *(const f32x4*)(src + i * 8), b = *(const f32x4*)(src + i * 8 + 4);
            u32x4 w; w.x = pk2(a[0] * g, a[1] * g); w.y = pk2(a[2] * g, a[3] * g); w.z = pk2(b[0] * g, b[1] * g); w.w = pk2(b[2] * g, b[3] * g);
            *(u32x4*)(dst + i * 8) = w;
        }
    }
    {
        bf16_t* sk = (bf16_t*)(ws + P_SK); const float* skin = P.in[I_PEER_SK];
        for (int i = C.blk * NTHREADS + C.tid; i < 2 * 8 * 256 * 256 / 8; i += C.G * NTHREADS) {
            const int q8 = (i & 31) * 8, np = (i >> 5) & 255, lh = i >> 13;
            const int c = np >> 7, n = np & 127, c2 = q8 >> 7, q = q8 & 127;
            u32x4 w = {0u, 0u, 0u, 0u};
            if (c == c2) { const float* s = skin + ((((size_t)lh * 2 + c) * 128 + n) * 128 + q);
                const f32x4 a = *(const f32x4*)s, b = *(const f32x4*)(s + 4);
                w.x = pk2(a[0], a[1]); w.y = pk2(a[2], a[3]); w.z = pk2(b[0], b[1]); w.w = pk2(b[2], b[3]); }
            *(u32x4*)(sk + (size_t)i * 8) = w;
        }
    }
    convert_tables(C, P, 0);
    for (int l = 0; l < 2; ++l) rms_rows_2048(C, P.in[I_MEM], P.in[I_XA_MEMNORM] + l * DM, (bf16_t*)(ws + P_MEMN) + (size_t)l * MT * DM, MT);
}

DI void phase_s5(const Ctx& C0, const Params& P, int first, int last, int stride_w, int stride) {
    const Ctx C = fresh(C0);
    unsigned char* ws = P.ws;
    const bf16_t* proj = (const bf16_t*)(ws + P_PROJ); bf16_t* gbuf = (bf16_t*)(ws + P_GBUF);
    LAS unsigned char* my = C.lds + C.wave * 8192;
    LAS float* U = (LAS float*)my;
    LAS bf16_t* H = (LAS bf16_t*)(my + 1024);
    const int lane = C.lane, n = lane;
    for (int task = first + C.wave * stride_w; task < last; task += stride) {
        const int b = task >> 5, g = task & 31;
        const float a_re = P.in[I_S5_ARE][g * 64 + n], a_im = P.in[I_S5_AIM][g * 64 + n];
        const float step = expf(P.in[I_S5_LOGSTEP][g]);
        const float mag = expf(a_re * step);
        const float ab_re = mag * cosf(a_im * step), ab_im = mag * sinf(a_im * step);
        const float den = a_re * a_re + a_im * a_im, num_re = ab_re - 1.0f;
        const float f_re = (num_re * a_re + ab_im * a_im) / den, f_im = (ab_im * a_re - num_re * a_im) / den;
        float bbr[16], bbi[16];
        {
            const float* br = P.in[I_S5_BRE] + ((size_t)g * 64 + n) * 16; const float* bi = P.in[I_S5_BIM] + ((size_t)g * 64 + n) * 16;
#pragma unroll
            for (int p = 0; p < 16; ++p) { const float x = br[p], y = bi[p]; bbr[p] = f_re * x - f_im * y; bbi[p] = f_re * y + f_im * x; }
        }
        bf16x8 cf[4];
        {
            const int p = lane & 15, kq = lane >> 4;
#pragma unroll
            for (int kk = 0; kk < 4; ++kk) {
                const int k = 32 * kk + 8 * kq; const bool im = k >= 64;
                const float* src = (im ? P.in[I_S5_CIM] : P.in[I_S5_CRE]) + ((size_t)g * 16 + p) * 64 + (k & 63);
                const float sg = im ? -1.f : 1.f;
                const f32x4 a = *(const f32x4*)src, bq = *(const f32x4*)(src + 4);
                u32x4 w; w.x = pk2(sg * a[0], sg * a[1]); w.y = pk2(sg * a[2], sg * a[3]); w.z = pk2(sg * bq[0], sg * bq[1]); w.w = pk2(sg * bq[2], sg * bq[3]);
                cf[kk] = __builtin_bit_cast(bf16x8, w);
            }
        }
        const float dcoef = P.in[I_S5_D][g * 16 + (lane & 15)];
        float h_re = 0.f, h_im = 0.f;
        const bf16_t* ub = proj + (size_t)b * SEQ * AB_IN + 3 * DIFF_W + g * 16;
        for (int s0 = 0; s0 < SEQ; s0 += 16) {
            {
                const int st = lane >> 2, pp = (lane & 3) * 4;
                const u32x2 uv = *(const u32x2*)(ub + (size_t)(s0 + st) * AB_IN + pp);
                *(LAS f32x4*)(U + st * 16 + pp) = (f32x4){bflo(uv.x), bfhi(uv.x), bflo(uv.y), bfhi(uv.y)};
            }
            LDS_WAIT(); asm volatile("" ::: "memory");
#pragma unroll 4
            for (int st = 0; st < 16; ++st) {
                const f32x4 u0 = *(const LAS f32x4*)(U + st * 16), u1 = *(const LAS f32x4*)(U + st * 16 + 4), u2 = *(const LAS f32x4*)(U + st * 16 + 8), u3 = *(const LAS f32x4*)(U + st * 16 + 12);
                const float uu[16] = {u0[0], u0[1], u0[2], u0[3], u1[0], u1[1], u1[2], u1[3], u2[0], u2[1], u2[2], u2[3], u3[0], u3[1], u3[2], u3[3]};
                float br = 0.f, bi = 0.f;
#pragma unroll
                for (int p = 0; p < 16; ++p) { br = fmaf(bbr[p], uu[p], br); bi = fmaf(bbi[p], uu[p], bi); }
                const float nr = ab_re * h_re - ab_im * h_im + br, ni = ab_re * h_im + ab_im * h_re + bi;
                h_re = nr; h_im = ni;
                H[st * 136 + n] = f2bf(h_re); H[st * 136 + 64 + n] = f2bf(h_im);
            }
            LDS_WAIT(); asm volatile("" ::: "memory");
            f32x4 acc = {0.f, 0.f, 0.f, 0.f};
#pragma unroll
            for (int kk = 0; kk < 4; ++kk) {
                const bf16x8 af = *(const LAS bf16x8*)((LAS unsigned char*)H + (lane & 15) * 272 + (32 * kk + 8 * (lane >> 4)) * 2);
                acc = __builtin_amdgcn_mfma_f32_16x16x32_bf16(af, cf[kk], acc, 0, 0, 0);
            }
#pragma unroll
            for (int r = 0; r < 4; ++r) {
                const int st = (lane >> 4) * 4 + r, p = lane & 15;
                const float y = acc[r] + dcoef * U[st * 16 + p];
                gbuf[(size_t)(b * SEQ + s0 + st) * S5_W + g * 16 + p] = f2bf(gelu_erf(y));
            }
            LDS_WAIT(); asm volatile("" ::: "memory");
        }
    }
}

struct AttnArgs { const bf16_t* Qn; const bf16_t* Qr; const bf16_t* Kn; const bf16_t* Kr; const bf16_t* V; int ldq, ldkn, ldkr, ldv; };
DI int crow(int r, int hi) { return (r & 3) + 8 * (r >> 2) + 4 * hi; }
template <int DK> DI int koff(int row, int ch) { return DK == 64 ? row * 128 + 16 * (ch ^ ((row >> 1) & 7)) : row * 256 + 16 * (ch ^ (row & 15)); }
DI int voff(int row, int ch) { return 256 * row + 16 * (ch ^ (((row & 3) << 2) | ((row >> 2) & 3))); }
DI bf16x8 pack8(const f32x16& p, int s) {
    u32x4 w; w.x = pk2(p[8 * s + 0], p[8 * s + 1]); w.y = pk2(p[8 * s + 2], p[8 * s + 3]); w.z = pk2(p[8 * s + 4], p[8 * s + 5]); w.w = pk2(p[8 * s + 6], p[8 * s + 7]);
    return __builtin_bit_cast(bf16x8, w);
}
DI s16x4 vtr(const LAS unsigned char* p) { return __builtin_bit_cast(s16x4, __builtin_amdgcn_ds_read_tr16_b64_v4i16((LAS s16x4*)p)); }

template <int DKN, int DKR>
DI void attn_core(const AttnArgs& a, int q0, LAS unsigned char* lds, float scale, f32x16 (&o)[4], int mode = 0) {
    const int tid = opaque_tid(), wid = __builtin_amdgcn_readfirstlane(tid >> 6), lane = tid & 63, r32 = lane & 31, hi = lane >> 5;
    constexpr int CN = DKN / 8, NLK = CN * 64 / NTHREADS, KNB = 64 * DKN * 2, KRB = 64 * DKR * 2, KSZ = KNB + KRB, VBASE = 2 * KSZ, VSZ = 16384;
    constexpr int KG = DKR ? 2 : 4;
    static_assert(VBASE + 3 * VSZ <= RING_BYTES, "attention LDS");
    const bool late = wid >= 4;
    bf16x8 qn[DKN / 16]; bf16x8 qr[DKR ? DKR / 16 : 1];
    {
        const bf16_t* qp = a.Qn + (size_t)(q0 + 32 * wid + r32) * a.ldq + hi * 8;
#pragma unroll
        for (int d0 = 0; d0 < DKN / 16; ++d0) qn[d0] = *(const bf16x8*)(qp + d0 * 16);
        if (DKR) { const bf16_t* qp2 = a.Qr + (size_t)(q0 + 32 * wid + r32) * a.ldq + hi * 8;
#pragma unroll
            for (int d0 = 0; d0 < DKR / 16; ++d0) qr[d0] = *(const bf16x8*)(qp2 + d0 * 16); }
    }
    const int NT = (q0 + 256) / 64, NTw = (q0 + 32 * wid + 31) / 64 + 1;
    u32x4 skn[NLK], skr, sv[2];
#define AT_LOAD(t) do { _Pragma("unroll") for (int i_ = 0; i_ < NLK; ++i_) { const int id_ = tid + NTHREADS * i_, row_ = id_ / CN, ch_ = id_ % CN; \
            skn[i_] = *(const u32x4*)(a.Kn + (size_t)((t) * 64 + row_) * a.ldkn + ch_ * 8); } \
        if (DKR) { const int row_ = tid >> 3, ch_ = tid & 7; skr = *(const u32x4*)(a.Kr + (size_t)((t) * 64 + row_) * a.ldkr + ch_ * 8); } \
        _Pragma("unroll") for (int i_ = 0; i_ < 2; ++i_) { const int id_ = tid + NTHREADS * i_, row_ = id_ >> 4, ch_ = id_ & 15; \
            sv[i_] = *(const u32x4*)(a.V + (size_t)((t) * 64 + row_) * a.ldv + ch_ * 8); } } while (0)
#define AT_WRITE(kbuf, vbuf) do { LAS unsigned char* kb_ = lds + (kbuf) * KSZ; LAS unsigned char* vb_ = lds + VBASE + (vbuf) * VSZ; \
        _Pragma("unroll") for (int i_ = 0; i_ < NLK; ++i_) { const int id_ = tid + NTHREADS * i_, row_ = id_ / CN, ch_ = id_ % CN; *(LAS u32x4*)(kb_ + koff<DKN>(row_, ch_)) = skn[i_]; } \
        if (DKR) { const int row_ = tid >> 3, ch_ = tid & 7; *(LAS u32x4*)(kb_ + KNB + koff<64>(row_, ch_)) = skr; } \
        _Pragma("unroll") for (int i_ = 0; i_ < 2; ++i_) { const int id_ = tid + NTHREADS * i_, row_ = id_ >> 4, ch_ = id_ & 15; *(LAS u32x4*)(vb_ + voff(row_, ch_)) = sv[i_]; } } while (0)
    const float Cs = scale * 1.4426950408889634f;
    float m_run = -1e30f, l_run = 0.f;
#pragma unroll
    for (int blk = 0; blk < 4; ++blk)
#pragma unroll
        for (int r = 0; r < 16; ++r) o[blk][r] = 0.f;
    bf16x8 pb[4];
#pragma unroll
    for (int i = 0; i < 4; ++i) pb[i] = (bf16x8){0, 0, 0, 0, 0, 0, 0, 0};
#define AT_PV(vbuf) do { const LAS unsigned char* vbase_ = lds + VBASE + (vbuf) * VSZ; \
        int lanev_ = lane; asm volatile("" : "+v"(lanev_));       \
        int vb_[4][2]; { const int i_ = lanev_ & 15, q_ = i_ >> 2, p_ = i_ & 3, grp1_ = (lanev_ >> 4) & 1, hv_ = lanev_ >> 5, low2_ = 2 * grp1_ + (p_ >> 1); \
            _Pragma("unroll") for (int blk = 0; blk < 4; ++blk) _Pragma("unroll") for (int x = 0; x < 2; ++x) vb_[blk][x] = 256 * (8 * x + 4 * hv_ + q_) + 16 * (4 * (blk ^ q_) + (low2_ ^ (hv_ + 2 * x))) + 8 * (p_ & 1); } \
        s16x4 lo_[2][4], hh_[2][4]; \
        _Pragma("unroll") for (int ks = 0; ks < 4; ++ks) { lo_[0][ks] = vtr(vbase_ + vb_[0][0] + 4096 * ks); hh_[0][ks] = vtr(vbase_ + vb_[0][1] + 4096 * ks); } \
        _Pragma("unroll") for (int blk = 0; blk < 4; ++blk) { \
            if (blk + 1 < 4) { _Pragma("unroll") for (int ks = 0; ks < 4; ++ks) { lo_[(blk + 1) & 1][ks] = vtr(vbase_ + vb_[blk + 1][0] + 4096 * ks); hh_[(blk + 1) & 1][ks] = vtr(vbase_ + vb_[blk + 1][1] + 4096 * ks); } } \
            _Pragma("unroll") for (int ks = 0; ks < 4; ++ks) { const s16x4 l_ = lo_[blk & 1][ks], h_ = hh_[blk & 1][ks]; \
                const bf16x8 af_ = {l_[0], l_[1], l_[2], l_[3], h_[0], h_[1], h_[2], h_[3]}; \
                o[blk] = __builtin_amdgcn_mfma_f32_32x32x16_bf16(af_, pb[ks], o[blk], 0, 0, 0); } \
            __builtin_amdgcn_sched_barrier(0); } } while (0)
    AT_LOAD(0); AT_WRITE(0, 0);
#pragma unroll
    for (int d0 = 0; d0 < DKN / 16; ++d0) asm volatile("" : "+v"(qn[d0]));
    if (DKR) {
#pragma unroll
        for (int d0 = 0; d0 < DKR / 16; ++d0) asm volatile("" : "+v"(qr[d0]));
    }
    if (NT > 1) AT_LOAD(1);
    int vcur = 0, vprev = 2, vnext = 1;
    for (int t = 0; t < NT; ++t) {
        if (mode != 5) __syncthreads();
        if (t + 1 < NT && mode != 2) AT_WRITE((t + 1) & 1, vnext);
        if (t + 2 < NT && mode != 1) AT_LOAD(t + 2);
        if (late && t >= 1 && t - 1 < NTw && mode != 3) AT_PV(vprev);
        if (t < NTw) {
            const LAS unsigned char* base = lds + (t & 1) * KSZ;
            int r32v = r32; asm volatile("" : "+v"(r32v));
            f32x16 p0, p1;
#pragma unroll
            for (int r = 0; r < 16; ++r) { p0[r] = 0.f; p1[r] = 0.f; }
            {
                constexpr int NDN = DKN / 16, NDT = NDN + DKR / 16;
#pragma unroll
                for (int g0 = 0; g0 < NDT; g0 += KG) {
                    bf16x8 kb0[KG], kb1[KG];
#pragma unroll
                    for (int i = 0; i < KG; ++i) { const int dd = g0 + i;
                        if (dd < NDN) { kb0[i] = *(const LAS bf16x8*)(base + koff<DKN>(r32v, 2 * dd + hi)); kb1[i] = *(const LAS bf16x8*)(base + koff<DKN>(32 + r32v, 2 * dd + hi)); }
                        else { kb0[i] = *(const LAS bf16x8*)(base + KNB + koff<64>(r32v, 2 * (dd - NDN) + hi)); kb1[i] = *(const LAS bf16x8*)(base + KNB + koff<64>(32 + r32v, 2 * (dd - NDN) + hi)); } }
#pragma unroll
                    for (int i = 0; i < KG; ++i) asm volatile("" : "+v"(kb0[i]), "+v"(kb1[i]));
#pragma unroll
                    for (int i = 0; i < KG; ++i) { const int dd = g0 + i;
                        const bf16x8 qf = dd < NDN ? qn[dd < NDN ? dd : 0] : qr[dd >= NDN ? dd - NDN : 0];
                        p0 = __builtin_amdgcn_mfma_f32_32x32x16_bf16(kb0[i], qf, p0, 0, 0, 0); p1 = __builtin_amdgcn_mfma_f32_32x32x16_bf16(kb1[i], qf, p1, 0, 0, 0); }
                }
            }
            if (t == NTw - 1) {
                const int qrel = q0 + 32 * wid + r32 - 64 * t;
#pragma unroll
                for (int r = 0; r < 16; ++r) { const int kv = crow(r, hi); if (kv > qrel) p0[r] = -INFINITY; if (kv + 32 > qrel) p1[r] = -INFINITY; }
            }
            float pmax = p0[0];
#pragma unroll
            for (int r = 1; r < 16; ++r) pmax = fmaxf(pmax, p0[r]);
#pragma unroll
            for (int r = 0; r < 16; ++r) pmax = fmaxf(pmax, p1[r]);
            pmax = swap32_max(pmax);
            const float mn = fmaxf(m_run, pmax);
            const float alpha = __builtin_amdgcn_exp2f((m_run - mn) * Cs);
            m_run = mn;
            const float mnC = -mn * Cs;
            float ps = 0.f;
#pragma unroll
            for (int r = 0; r < 16; ++r) { if (mode != 4) { p0[r] = __builtin_amdgcn_exp2f(fmaf(p0[r], Cs, mnC)); p1[r] = __builtin_amdgcn_exp2f(fmaf(p1[r], Cs, mnC)); } ps += p0[r] + p1[r]; }
            l_run = l_run * alpha + ps;
            if (!__all(alpha == 1.0f)) {
#pragma unroll
                for (int blk = 0; blk < 4; ++blk)
#pragma unroll
                    for (int r = 0; r < 16; ++r) o[blk][r] *= alpha;
            }
            pb[0] = pack8(p0, 0); pb[1] = pack8(p0, 1); pb[2] = pack8(p1, 0); pb[3] = pack8(p1, 1);
            if (!late && mode != 3) AT_PV(vcur);
        }
        { const int tmp = vprev; vprev = vcur; vcur = vnext; vnext = tmp; }
    }
    if (late && NTw == NT && mode != 3) AT_PV(vprev);
    __syncthreads();
    const float linv = 1.0f / swap32_sum(l_run);
#pragma unroll
    for (int blk = 0; blk < 4; ++blk)
#pragma unroll
        for (int r = 0; r < 16; ++r) o[blk][r] *= linv;
#undef AT_LOAD
#undef AT_WRITE
#undef AT_PV
}
DI void attn_store(const f32x16 (&o)[4], bf16_t* dst, int ld, int q0) {
    const int tid = opaque_tid(), wid = tid >> 6, lane = tid & 63, r32 = lane & 31, hi = lane >> 5;
    bf16_t* rp = dst + (size_t)(q0 + 32 * wid + r32) * ld;
#pragma unroll
    for (int blk = 0; blk < 4; ++blk)
#pragma unroll
        for (int g = 0; g < 4; ++g) {
            u32x2 w; w.x = pk2(o[blk][4 * g], o[blk][4 * g + 1]); w.y = pk2(o[blk][4 * g + 2], o[blk][4 * g + 3]);
            *(u32x2*)(rp + 32 * blk + 8 * g + 4 * hi) = w;
        }
}
DI int queue_pop(const Ctx& C0, unsigned* ctr, int total) {
    const Ctx C = fresh(C0);
    volatile LAS int* slot = (volatile LAS int*)(C.lds + LDSCTL_OFF + 64);
    __syncthreads();
    if (C.tid == 0) *slot = (int)__hip_atomic_fetch_add(ctr, 1u, __ATOMIC_RELAXED, __HIP_MEMORY_SCOPE_AGENT);
    __syncthreads();
    const int u = *slot;
    return u < total ? u : -1;
}
DI float diff_lambda(const Params& P) {
    float s1 = 0.f, s2 = 0.f;
    for (int i = 0; i < 64; ++i) { s1 += P.in[I_LQ1][i] * P.in[I_LK1][i]; s2 += P.in[I_LQ2][i] * P.in[I_LK2][i]; }
    return expf(s1) - expf(s2) + 0.2f;
}

#if FAST_ATTN
DI void phase_diff_attn(const Ctx& C0, const Params& P, int qi) {
    const Ctx C = fresh(C0);
    unsigned char* ws = P.ws;
    const bf16_t* proj = (const bf16_t*)(ws + P_PROJ); bf16_t* concat = (bf16_t*)(ws + P_CONCAT);
    unsigned* ctr = (unsigned*)(ws + WS_CTL) + CW_CTR + 64 * qi;
    const float lam = diff_lambda(P);
    const int NBH = BATCH * DIFF_HEADS, NS5 = BATCH * 32 / NWAVES, total = NS5 + NBH * 8;
    const int lane = C.lane, r32 = lane & 31, hi = lane >> 5;
    for (;;) {
        int u = queue_pop(C, ctr, total); if (u < 0) break;
        if (u < NS5) { phase_s5(C, P, u * NWAVES, u * NWAVES + NWAVES, 1, NWAVES); continue; }
        u -= NS5;
        const int qb = 7 - u / NBH, bh = u % NBH, b = bh / DIFF_HEADS, h = bh % DIFF_HEADS;
        const bf16_t* base = proj + (size_t)b * SEQ * AB_IN;
        AttnArgs a; a.ldq = AB_IN; a.ldkn = AB_IN; a.ldkr = 0; a.ldv = AB_IN; a.Qr = nullptr; a.Kr = nullptr;
        a.V = base + 2 * DIFF_W + h * 128;
        f32x16 o2[4];
        bf16_t* dst = concat + (size_t)b * SEQ * DM + h * 128;
        a.Qn = base + h * 128; a.Kn = base + DIFF_W + h * 128;
        attn_core<64, 0>(a, qb * 256, C.lds, 0.125f, o2, qi >= 2 ? PROBE_ATTN_MODE : 0);
        attn_store(o2, dst, DM, qb * 256);
        a.Qn = base + h * 128 + 64; a.Kn = base + DIFF_W + h * 128 + 64;
        attn_core<64, 0>(a, qb * 256, C.lds, 0.125f, o2, qi >= 2 ? PROBE_ATTN_MODE : 0);
        float ss = 0.f;
        {
            const bf16_t* rp = dst + (size_t)(qb * 256 + 32 * C.wave + r32) * DM;
#pragma unroll
            for (int blk = 0; blk < 4; ++blk)
#pragma unroll
                for (int g = 0; g < 4; ++g) {
                    const u32x2 w = *(const u32x2*)(rp + 32 * blk + 8 * g + 4 * hi);
                    const float o1v[4] = {bflo(w.x), bfhi(w.x), bflo(w.y), bfhi(w.y)};
#pragma unroll
                    for (int j = 0; j < 4; ++j) { const float v = o1v[j] - lam * o2[blk][4 * g + j]; o2[blk][4 * g + j] = v; ss += v * v; }
                }
        }
        ss = swap32_sum(ss);
        const float rs = rsqrtf(ss * (1.0f / 128.0f) + NORM_EPS) * 0.8f;
        const float* sub = P.in[I_SUBLN];
#pragma unroll
        for (int blk = 0; blk < 4; ++blk)
#pragma unroll
            for (int r = 0; r < 16; ++r) o2[blk][r] *= rs * sub[32 * blk + crow(r, hi)];
        attn_store(o2, dst, DM, qb * 256);
    }
}
DI void phase_mla_attn(const Ctx& C0, const Params& P, int qi) {
    const Ctx C = fresh(C0);
    unsigned char* ws = P.ws;
    const bf16_t* q = (const bf16_t*)(ws + P_Q); const bf16_t* kv = (const bf16_t*)(ws + P_KV); const bf16_t* kr = (const bf16_t*)(ws + P_KROPE);
    bf16_t* ob = (bf16_t*)(ws + P_H);
    unsigned* ctr = (unsigned*)(ws + WS_CTL) + CW_CTR + 64 * qi;
    const int NBH = BATCH * MLA_HEADS, total = NBH * 8;
    for (;;) {
        const int u = queue_pop(C, ctr, total); if (u < 0) break;
        const int qb = 7 - u / NBH, bh = u % NBH, b = bh / MLA_HEADS, h = bh % MLA_HEADS;
        AttnArgs a; a.ldq = 3072; a.ldkn = 4096; a.ldkr = 64; a.ldv = 4096;
        a.Qn = q + (size_t)b * SEQ * 3072 + h * 192; a.Qr = a.Qn + 128;
        a.Kn = kv + (size_t)b * SEQ * 4096 + h * 256; a.V = a.Kn + 128; a.Kr = kr + (size_t)b * SEQ * 64;
        f32x16 o[4];
        attn_core<128, 64>(a, qb * 256, C.lds, 0.07216878364870322f, o, qi >= 2 ? PROBE_ATTN_MODE : 0);
        attn_store(o, ob + (size_t)b * SEQ * DM + h * 128, DM, qb * 256);
    }
}
#else
template <int DK> DI void naive_attn_row(const bf16_t* qrow, const bf16_t* qrow2, const bf16_t* Kn, int ldkn, const bf16_t* Kr, int ldkr, const bf16_t* V, int ldv, int nkeys, float scale, int lane, float& o0, float& o1) {
    float qv[3];
#pragma unroll
    for (int j = 0; j < 3; ++j) { const int d = lane + 64 * j; qv[j] = 0.f; if (d < DK) qv[j] = (DK == 192 && d >= 128) ? bf2f(qrow2[d - 128]) : bf2f(qrow[d]); }
    float m = -1e30f, l = 0.f; o0 = 0.f; o1 = 0.f;
    for (int k = 0; k < nkeys; ++k) {
        float s = 0.f;
#pragma unroll
        for (int j = 0; j < 3; ++j) { const int d = lane + 64 * j; if (d < DK) { const float kvv = (DK == 192 && d >= 128) ? bf2f(Kr[(size_t)k * ldkr + d - 128]) : bf2f(Kn[(size_t)k * ldkn + d]); s += qv[j] * kvv; } }
        s = wave_sum(s) * scale;
        const float mn = fmaxf(m, s), al = expf(m - mn), p = expf(s - mn);
        m = mn; l = l * al + p;
        o0 = o0 * al + p * bf2f(V[(size_t)k * ldv + lane]); o1 = o1 * al + p * bf2f(V[(size_t)k * ldv + 64 + lane]);
    }
    o0 /= l; o1 /= l;
}
DI void phase_diff_attn(const Ctx& C, const Params& P, int) {
    unsigned char* ws = P.ws;
    const bf16_t* proj = (const bf16_t*)(ws + P_PROJ); bf16_t* concat = (bf16_t*)(ws + P_CONCAT);
    const float lam = diff_lambda(P);
    const int lane = C.lane;
    for (int it = C.blk * NWAVES + C.wave; it < BATCH * DIFF_HEADS * SEQ; it += C.G * NWAVES) {
        const int s = it % SEQ, bh = it / SEQ, b = bh / DIFF_HEADS, h = bh % DIFF_HEADS;
        const bf16_t* base = proj + (size_t)b * SEQ * AB_IN;
        const bf16_t* qrow = base + (size_t)s * AB_IN + h * 128;
        float a0, a1, b0, b1;
        naive_attn_row<64>(qrow, nullptr, base + DIFF_W + h * 128, AB_IN, nullptr, 0, base + 2 * DIFF_W + h * 128, AB_IN, s + 1, 0.125f, lane, a0, a1);
        naive_attn_row<64>(qrow + 64, nullptr, base + DIFF_W + h * 128 + 64, AB_IN, nullptr, 0, base + 2 * DIFF_W + h * 128, AB_IN, s + 1, 0.125f, lane, b0, b1);
        const float v0 = a0 - lam * b0, v1 = a1 - lam * b1;
        const float ss = wave_sum(v0 * v0 + v1 * v1);
        const float rs = rsqrtf(ss * (1.0f / 128.0f) + NORM_EPS) * 0.8f;
        bf16_t* orow = concat + (size_t)(b * SEQ + s) * DM + h * 128;
        orow[lane] = f2bf(v0 * rs * P.in[I_SUBLN][lane]); orow[64 + lane] = f2bf(v1 * rs * P.in[I_SUBLN][64 + lane]);
    }
}
DI void phase_mla_attn(const Ctx& C, const Params& P, int) {
    unsigned char* ws = P.ws;
    const bf16_t* q = (const bf16_t*)(ws + P_Q); const bf16_t* kv = (const bf16_t*)(ws + P_KV); const bf16_t* kr = (const bf16_t*)(ws + P_KROPE);
    bf16_t* ob = (bf16_t*)(ws + P_H);
    const int lane = C.lane;
    for (int it = C.blk * NWAVES + C.wave; it < BATCH * MLA_HEADS * SEQ; it += C.G * NWAVES) {
        const int s = it % SEQ, bh = it / SEQ, b = bh / MLA_HEADS, h = bh % MLA_HEADS;
        const bf16_t* qrow = q + (size_t)(b * SEQ + s) * 3072 + h * 192;
        const bf16_t* kn = kv + (size_t)b * SEQ * 4096 + h * 256;
        float a0, a1;
        naive_attn_row<192>(qrow, qrow + 128, kn, 4096, kr + (size_t)b * SEQ * 64, 64, kn + 128, 4096, s + 1, 0.07216878364870322f, lane, a0, a1);
        bf16_t* orow = ob + (size_t)(b * SEQ + s) * DM + h * 128;
        orow[lane] = f2bf(a0); orow[64 + lane] = f2bf(a1);
    }
}
#endif

DI void phase_mla_rows(const Ctx& C0, const Params& P) {
    const Ctx C = fresh(C0);
    unsigned char* ws = P.ws;
    const bf16_t* mp = (const bf16_t*)(ws + P_MLAPROJ); bf16_t* cqn = (bf16_t*)(ws + P_CQN); bf16_t* ckvn = (bf16_t*)(ws + P_CKVN); bf16_t* krp = (bf16_t*)(ws + P_KROPE);
    const f32x2* tab = (const f32x2*)(ws + WS_ROPE);
    const int lane = C.lane;
    for (int r = C.blk * NWAVES + C.wave; r < T; r += C.G * NWAVES) {
        const bf16_t* row = mp + (size_t)r * MLA_IN_PAD;
        float v[12]; float ss = 0.f;
#pragma unroll
        for (int j = 0; j < 3; ++j) { const u32x2 w = *(const u32x2*)(row + 4 * (lane + 64 * j)); v[4 * j] = bflo(w.x); v[4 * j + 1] = bfhi(w.x); v[4 * j + 2] = bflo(w.y); v[4 * j + 3] = bfhi(w.y); }
#pragma unroll
        for (int j = 0; j < 12; ++j) ss += v[j] * v[j];
        float sc = rsqrtf(wave_sum(ss) * (1.0f / MLA_QR) + NORM_EPS);
#pragma unroll
        for (int j = 0; j < 3; ++j) { const f32x4 g = *(const f32x4*)(P.in[I_MLA_QNORM] + 4 * (lane + 64 * j));
            u32x2 w; w.x = pk2(v[4 * j] * sc * g[0], v[4 * j + 1] * sc * g[1]); w.y = pk2(v[4 * j + 2] * sc * g[2], v[4 * j + 3] * sc * g[3]);
            *(u32x2*)(cqn + (size_t)r * MLA_QR + 4 * (lane + 64 * j)) = w; }
        {
            const u32x2 w = *(const u32x2*)(row + MLA_QR + 4 * lane);
            const float a0 = bflo(w.x), a1 = bfhi(w.x), a2 = bflo(w.y), a3 = bfhi(w.y);
            const float s2 = rsqrtf(wave_sum(a0 * a0 + a1 * a1 + a2 * a2 + a3 * a3) * (1.0f / MLA_KVR) + NORM_EPS);
            const f32x4 g = *(const f32x4*)(P.in[I_MLA_KVNORM] + 4 * lane);
            u32x2 o; o.x = pk2(a0 * s2 * g[0], a1 * s2 * g[1]); o.y = pk2(a2 * s2 * g[2], a3 * s2 * g[3]);
            *(u32x2*)(ckvn + (size_t)r * MLA_KVR + 4 * lane) = o;
        }
        if (lane < 32) {
            const unsigned w = *(const unsigned*)(row + 1024 + 2 * lane);
            int p = ((const int*)P.in[I_POS])[r]; p = p < 0 ? 0 : (p > ROPE_POS - 1 ? ROPE_POS - 1 : p);
            const f32x2 cs = tab[(size_t)p * 32 + lane];
            const float x1 = bflo(w), x2 = bfhi(w);
            *(unsigned*)(krp + (size_t)r * 64 + 2 * lane) = pk2(x1 * cs[0] - x2 * cs[1], x2 * cs[0] + x1 * cs[1]);
        }
    }
}

DI void phase_xa_softmax(const Ctx& C0, const Params& P) {
    const Ctx C = fresh(C0);
    unsigned char* ws = P.ws;
    const bf16_t* S = (const bf16_t*)(ws + P_S); bf16_t* Pb = (bf16_t*)(ws + P_P);
    const int lane = C.lane, hd = lane >> 4, li = lane & 15;
    for (int r = C.blk * NWAVES + C.wave; r < T; r += C.G * NWAVES) {
        const bf16_t* row = S + (size_t)r * 1024 + hd * 256;
        f32x4 v[4]; float mx = -1e30f;
#pragma unroll
        for (int j = 0; j < 4; ++j) { const u32x2 w = *(const u32x2*)(row + 4 * (li + 16 * j)); v[j] = (f32x4){bflo(w.x), bfhi(w.x), bflo(w.y), bfhi(w.y)}; mx = fmaxf(mx, fmaxf(fmaxf(v[j][0], v[j][1]), fmaxf(v[j][2], v[j][3]))); }
#pragma unroll
        for (int o = 1; o < 16; o <<= 1) mx = fmaxf(mx, __shfl_xor(mx, o));
        float sm = 0.f;
#pragma unroll
        for (int j = 0; j < 4; ++j) { v[j][0] = __expf(v[j][0] - mx); v[j][1] = __expf(v[j][1] - mx); v[j][2] = __expf(v[j][2] - mx); v[j][3] = __expf(v[j][3] - mx); sm += (v[j][0] + v[j][1]) + (v[j][2] + v[j][3]); }
#pragma unroll
        for (int o = 1; o < 16; o <<= 1) sm += __shfl_xor(sm, o);
        const float inv = 1.0f / sm;
        bf16_t* orow = Pb + (size_t)r * 1024 + hd * 256;
#pragma unroll
        for (int j = 0; j < 4; ++j) { u32x2 w; w.x = pk2(v[j][0] * inv, v[j][1] * inv); w.y = pk2(v[j][2] * inv, v[j][3] * inv); *(u32x2*)(orow + 4 * (li + 16 * j)) = w; }
    }
}

template <bool STORE> DI void phase_peer(const Ctx& C0, const Params& P) {
    const Ctx C = fresh(C0);
    unsigned char* ws = P.ws;
    const bf16_t* sc = (const bf16_t*)(ws + P_SC); const bf16_t* hb = (const bf16_t*)(ws + P_H);
    const bf16_t* ut = (const bf16_t*)(ws + P_UT); const bf16_t* vt = (const bf16_t*)(ws + P_VT);
    float* xo = P.out;
    LAS unsigned char* my = C.lds + C.wave * 4096;
    LAS float* top_s = (LAS float*)my;
    LAS int* top_i = (LAS int*)(my + 1024);
    LAS int* best_e = (LAS int*)(my + 2048);
    LAS float* best_g = (LAS float*)(my + 2560);
    LAS float* best_s = (LAS float*)(my + 3072);
    LAS int* best_p = (LAS int*)(my + 3584);
    const int lane = C.lane;
    for (int tok = C.blk * NWAVES + C.wave; tok < T; tok += C.G * NWAVES) {
        for (int rep = 0; rep < (PROBE == 6 ? 2 : 1); ++rep) {
        {
            const int g = lane >> 2, qd = lane & 3;
            unsigned k[32];
            const u32x4* sp = (const u32x4*)(sc + (size_t)tok * 2048 + g * 128 + qd * 32);
#pragma unroll
            for (int j = 0; j < 8; ++j) { const u32x4 xw = sp[j >> 1]; const unsigned wa = (j & 1) ? xw.z : xw.x, wb = (j & 1) ? xw.w : xw.y; const f32x4 x = {bflo(wa), bfhi(wa), bflo(wb), bfhi(wb)};
#pragma unroll
                for (int e = 0; e < 4; ++e) { unsigned u = __float_as_uint(x[e]); u ^= (unsigned)((int)u >> 31) | 0x80000000u; k[4 * j + e] = (u & ~127u) | (unsigned)(127 - (32 * qd + 4 * j + e)); } }
#pragma unroll
            for (int r = 0; r < 16; ++r) {
                unsigned m = k[0];
#pragma unroll
                for (int j = 1; j < 32; ++j) m = m > k[j] ? m : k[j];
                { const unsigned o1 = (unsigned)__shfl_xor((int)m, 1); m = m > o1 ? m : o1; const unsigned o2 = (unsigned)__shfl_xor((int)m, 2); m = m > o2 ? m : o2; }
                if (qd == 0) top_i[g * 16 + r] = 127 - (int)(m & 127u);
#pragma unroll
                for (int j = 0; j < 32; ++j) k[j] = (k[j] == m) ? 0u : k[j];
            }
        }
        LDS_WAIT(); asm volatile("" ::: "memory");
#pragma unroll
        for (int i = 0; i < 4; ++i) { const int e = lane + 64 * i; top_s[e] = bf2f(sc[(size_t)tok * 2048 + (e >> 4) * 128 + top_i[e]]); }
        LDS_WAIT(); asm volatile("" ::: "memory");
        {
            const int h = lane >> 3, sub = lane & 7;
            unsigned k[32];
            const float s00 = top_s[(2 * h) * 16 + 2 * sub], s01 = top_s[(2 * h) * 16 + 2 * sub + 1];
#pragma unroll
            for (int k2 = 0; k2 < 16; ++k2) { const float s1 = top_s[(2 * h + 1) * 16 + k2];
                unsigned u0 = __float_as_uint(s00 + s1), u1 = __float_as_uint(s01 + s1);
                u0 ^= (unsigned)((int)u0 >> 31) | 0x80000000u; u1 ^= (unsigned)((int)u1 >> 31) | 0x80000000u;
                k[k2] = (u0 & ~255u) | (unsigned)(255 - (32 * sub + k2)); k[16 + k2] = (u1 & ~255u) | (unsigned)(255 - (32 * sub + 16 + k2)); }
#pragma unroll
            for (int r = 0; r < 16; ++r) {
                unsigned m = k[0];
#pragma unroll
                for (int j = 1; j < 32; ++j) m = m > k[j] ? m : k[j];
                { const unsigned o1 = (unsigned)__shfl_xor((int)m, 1); m = m > o1 ? m : o1; const unsigned o2 = (unsigned)__shfl_xor((int)m, 2); m = m > o2 ? m : o2; const unsigned o4 = (unsigned)__shfl_xor((int)m, 4); m = m > o4 ? m : o4; }
                if (sub == 0) best_p[h * 16 + r] = 255 - (int)(m & 255u);
#pragma unroll
                for (int j = 0; j < 32; ++j) k[j] = (k[j] == m) ? 0u : k[j];
            }
        }
        LDS_WAIT(); asm volatile("" ::: "memory");
#pragma unroll
        for (int e2 = 0; e2 < 2; ++e2) { const int idx = lane + 64 * e2, h = idx >> 4, pos = best_p[idx]; best_s[idx] = top_s[(2 * h) * 16 + (pos >> 4)] + top_s[(2 * h + 1) * 16 + (pos & 15)]; }
        LDS_WAIT(); asm volatile("" ::: "memory");
#pragma unroll
        for (int e2 = 0; e2 < 2; ++e2) {
            const int idx = lane + 64 * e2, h = idx >> 4;
            float mx = -1e30f;
            for (int k = 0; k < 16; ++k) mx = fmaxf(mx, best_s[h * 16 + k]);
            float sm = 0.f;
            for (int k = 0; k < 16; ++k) sm += __expf(best_s[h * 16 + k] - mx);
            const float gate = __expf(best_s[idx] - mx) / sm;
            const int pos = best_p[idx], k1 = pos >> 4, k2 = pos & 15;
            best_e[idx] = top_i[(2 * h) * 16 + k1] * 128 + top_i[(2 * h + 1) * 16 + k2];
            best_g[idx] = gate;
        }
        LDS_WAIT(); asm volatile("" ::: "memory");
        }
#if PEER_SLICED
        {
            int* pe = (int*)(ws + P_PE_E) + (size_t)tok * 128; float* pg = (float*)(ws + P_PE_G) + (size_t)tok * 128;
            pe[lane] = best_e[lane]; pe[64 + lane] = best_e[64 + lane]; pg[lane] = best_g[lane]; pg[64 + lane] = best_g[64 + lane];
            const u32x4* tp = (const u32x4*)((const bf16_t*)(ws + P_XB) + (size_t)tok * DM + 32 * lane);
            u32x4 tw[4]; float am = 0.f;
#pragma unroll
            for (int i = 0; i < 4; ++i) { tw[i] = tp[i]; const unsigned w4[4] = {tw[i].x, tw[i].y, tw[i].z, tw[i].w};
#pragma unroll
                for (int q = 0; q < 4; ++q) am = fmaxf(am, fmaxf(fabsf(bflo(w4[q])), fabsf(bfhi(w4[q])))); }
#pragma unroll
            for (int o = 1; o < 64; o <<= 1) am = fmaxf(am, __shfl_xor(am, o));
            const float tscale = am > 0.f ? 127.0f / am : 0.f;
            if (lane == 0) ((float*)(ws + P_PE_TSC))[tok] = am * (1.0f / 127.0f) * row_rstd<32>((const float*)(ws + P_SS), tok);
            unsigned qd[8];
#pragma unroll
            for (int i = 0; i < 4; ++i) { const unsigned w4[4] = {tw[i].x, tw[i].y, tw[i].z, tw[i].w};
#pragma unroll
                for (int h2 = 0; h2 < 2; ++h2) { const int q0 = (int)rintf(bflo(w4[2 * h2]) * tscale), q1 = (int)rintf(bfhi(w4[2 * h2]) * tscale), q2 = (int)rintf(bflo(w4[2 * h2 + 1]) * tscale), q3 = (int)rintf(bfhi(w4[2 * h2 + 1]) * tscale);
                    qd[2 * i + h2] = (unsigned)(q0 & 255) | ((unsigned)(q1 & 255) << 8) | ((unsigned)(q2 & 255) << 16) | ((unsigned)(q3 & 255) << 24); } }
            u32x4* t8p = (u32x4*)(ws + P_PE_T8 + (size_t)tok * DM + 32 * lane);
            t8p[0] = (u32x4){qd[0], qd[1], qd[2], qd[3]}; t8p[1] = (u32x4){qd[4], qd[5], qd[6], qd[7]};
        }
#else
#if PEER_FP8
        float tf[32];
#pragma unroll
        for (int i = 0; i < 2; ++i) { const u32x4* tp = (const u32x4*)(hb + (size_t)tok * DM + 16 * (lane + 64 * i));
            const u32x4 a = tp[0], b = tp[1];
            tf[16 * i + 0] = bflo(a.x); tf[16 * i + 1] = bfhi(a.x); tf[16 * i + 2] = bflo(a.y); tf[16 * i + 3] = bfhi(a.y); tf[16 * i + 4] = bflo(a.z); tf[16 * i + 5] = bfhi(a.z); tf[16 * i + 6] = bflo(a.w); tf[16 * i + 7] = bfhi(a.w);
            tf[16 * i + 8] = bflo(b.x); tf[16 * i + 9] = bfhi(b.x); tf[16 * i + 10] = bflo(b.y); tf[16 * i + 11] = bfhi(b.y); tf[16 * i + 12] = bflo(b.z); tf[16 * i + 13] = bfhi(b.z); tf[16 * i + 14] = bflo(b.w); tf[16 * i + 15] = bfhi(b.w); }
        const unsigned char* ut8 = (const unsigned char*)ut; const unsigned char* vt8 = (const unsigned char*)vt;
        const float* usc = (const float*)(ut8 + 32 * MiB); const float* vsc = (const float*)(vt8 + 32 * MiB);
        for (int k0 = 0; k0 < 128; k0 += 8) {
            u32x4 rw[8][2];
#pragma unroll
            for (int kk = 0; kk < 8; ++kk) { const int e = __builtin_amdgcn_readfirstlane(best_e[k0 + kk]); const unsigned char* rp = ut8 + (size_t)e * DM;
#pragma unroll
                for (int i = 0; i < 2; ++i) rw[kk][i] = *(const u32x4*)(rp + 16 * (lane + 64 * i)); }
            float d[8];
#pragma unroll
            for (int kk = 0; kk < 8; ++kk) { float s0 = 0.f, s1 = 0.f;
#pragma unroll
                for (int i = 0; i < 2; ++i) {
                    const unsigned w4[4] = {rw[kk][i].x, rw[kk][i].y, rw[kk][i].z, rw[kk][i].w};
#pragma unroll
                    for (int q = 0; q < 4; ++q) { const f32x2 lo = __builtin_amdgcn_cvt_pk_f32_fp8((int)w4[q], false), hi2 = __builtin_amdgcn_cvt_pk_f32_fp8((int)w4[q], true);
                        s0 = fmaf(lo[0], tf[16 * i + 4 * q], s0); s1 = fmaf(lo[1], tf[16 * i + 4 * q + 1], s1); s0 = fmaf(hi2[0], tf[16 * i + 4 * q + 2], s0); s1 = fmaf(hi2[1], tf[16 * i + 4 * q + 3], s1); }
                }
                d[kk] = s0 + s1; }
            float n4[4], n2[2], r1;
            { const bool b0 = lane & 1;
#pragma unroll
              for (int j = 0; j < 4; ++j) { const float snd = b0 ? d[j] : d[4 + j], kp = b0 ? d[4 + j] : d[j]; n4[j] = kp + __shfl_xor(snd, 1); } }
            { const bool b1 = lane & 2;
#pragma unroll
              for (int j = 0; j < 2; ++j) { const float snd = b1 ? n4[j] : n4[2 + j], kp = b1 ? n4[2 + j] : n4[j]; n2[j] = kp + __shfl_xor(snd, 2); } }
            { const bool b2 = lane & 4; const float snd = b2 ? n2[0] : n2[1], kp = b2 ? n2[1] : n2[0]; r1 = kp + __shfl_xor(snd, 4); }
            r1 += __shfl_xor(r1, 8); r1 += __shfl_xor(r1, 16); r1 += __shfl_xor(r1, 32);
            if (lane < 8) { const int idx = k0 + 4 * (lane & 1) + 2 * ((lane >> 1) & 1) + ((lane >> 2) & 1); const float act = r1 * usc[best_e[idx]]; best_g[idx] *= gelu_erf(act); }
        }
        LDS_WAIT(); asm volatile("" ::: "memory");
        float acc[32];
#pragma unroll
        for (int j = 0; j < 32; ++j) acc[j] = 0.f;
        for (int k0 = 0; k0 < 128; k0 += 8) {
            u32x4 rw[8][2]; float wk[8];
#pragma unroll
            for (int kk = 0; kk < 8; ++kk) { const int e = __builtin_amdgcn_readfirstlane(best_e[k0 + kk]); wk[kk] = best_g[k0 + kk] * vsc[e]; const unsigned char* rp = vt8 + (size_t)e * DM;
#pragma unroll
                for (int i = 0; i < 2; ++i) rw[kk][i] = *(const u32x4*)(rp + 16 * (lane + 64 * i)); }
#pragma unroll
            for (int kk = 0; kk < 8; ++kk)
#pragma unroll
                for (int i = 0; i < 2; ++i) {
                    const unsigned w4[4] = {rw[kk][i].x, rw[kk][i].y, rw[kk][i].z, rw[kk][i].w};
#pragma unroll
                    for (int q = 0; q < 4; ++q) { const f32x2 lo = __builtin_amdgcn_cvt_pk_f32_fp8((int)w4[q], false), hi2 = __builtin_amdgcn_cvt_pk_f32_fp8((int)w4[q], true);
                        acc[16 * i + 4 * q] = fmaf(wk[kk], lo[0], acc[16 * i + 4 * q]); acc[16 * i + 4 * q + 1] = fmaf(wk[kk], lo[1], acc[16 * i + 4 * q + 1]);
                        acc[16 * i + 4 * q + 2] = fmaf(wk[kk], hi2[0], acc[16 * i + 4 * q + 2]); acc[16 * i + 4 * q + 3] = fmaf(wk[kk], hi2[1], acc[16 * i + 4 * q + 3]); }
                }
        }
#else
        u32x4 tv[4];
#pragma unroll
        for (int i = 0; i < 4; ++i) tv[i] = *(const u32x4*)(hb + (size_t)tok * DM + 8 * (lane + 64 * i));
        for (int k0 = 0; k0 < 128; k0 += 4) {
            u32x4 rw[4][4];
#pragma unroll
            for (int kk = 0; kk < 4; ++kk) { const int e = __builtin_amdgcn_readfirstlane(best_e[k0 + kk]); const bf16_t* rp = ut + (size_t)e * DM;
#pragma unroll
                for (int i = 0; i < 4; ++i) rw[kk][i] = *(const u32x4*)(rp + 8 * (lane + 64 * i)); }
            float d[4];
#pragma unroll
            for (int kk = 0; kk < 4; ++kk) { float s = 0.f;
#pragma unroll
                for (int i = 0; i < 4; ++i) { s = dot2bf(rw[kk][i].x, tv[i].x, s); s = dot2bf(rw[kk][i].y, tv[i].y, s); s = dot2bf(rw[kk][i].z, tv[i].z, s); s = dot2bf(rw[kk][i].w, tv[i].w, s); }
                d[kk] = wave_sum(s); }
            if (lane < 4) { const float act = lane == 0 ? d[0] : lane == 1 ? d[1] : lane == 2 ? d[2] : d[3]; best_g[k0 + lane] *= gelu_erf(act); }
        }
        LDS_WAIT(); asm volatile("" ::: "memory");
        float acc[32];
#pragma unroll
        for (int j = 0; j < 32; ++j) acc[j] = 0.f;
        for (int k0 = 0; k0 < 128; k0 += 4) {
            u32x4 rw[4][4]; float wk[4];
#pragma unroll
            for (int kk = 0; kk < 4; ++kk) { const int e = __builtin_amdgcn_readfirstlane(best_e[k0 + kk]); wk[kk] = best_g[k0 + kk]; const bf16_t* rp = vt + (size_t)e * DM;
#pragma unroll
                for (int i = 0; i < 4; ++i) rw[kk][i] = *(const u32x4*)(rp + 8 * (lane + 64 * i)); }
#pragma unroll
            for (int kk = 0; kk < 4; ++kk)
#pragma unroll
                for (int i = 0; i < 4; ++i) {
                    acc[8 * i + 0] = fmaf(wk[kk], bflo(rw[kk][i].x), acc[8 * i + 0]); acc[8 * i + 1] = fmaf(wk[kk], bfhi(rw[kk][i].x), acc[8 * i + 1]);
                    acc[8 * i + 2] = fmaf(wk[kk], bflo(rw[kk][i].y), acc[8 * i + 2]); acc[8 * i + 3] = fmaf(wk[kk], bfhi(rw[kk][i].y), acc[8 * i + 3]);
                    acc[8 * i + 4] = fmaf(wk[kk], bflo(rw[kk][i].z), acc[8 * i + 4]); acc[8 * i + 5] = fmaf(wk[kk], bfhi(rw[kk][i].z), acc[8 * i + 5]);
                    acc[8 * i + 6] = fmaf(wk[kk], bflo(rw[kk][i].w), acc[8 * i + 6]); acc[8 * i + 7] = fmaf(wk[kk], bfhi(rw[kk][i].w), acc[8 * i + 7]);
                }
        }
#endif
        float* xr = xo + (size_t)tok * DM;
        if (!STORE) {
#pragma unroll
            for (int j = 0; j < 32; ++j) asm volatile("" :: "v"(acc[j]));
        } else {
#if PEER_FP8
#pragma unroll
            for (int i = 0; i < 2; ++i) { f32x4* p = (f32x4*)(xr + 16 * (lane + 64 * i));
#pragma unroll
                for (int q = 0; q < 4; ++q) { f32x4 a = p[q]; a[0] += acc[16 * i + 4 * q]; a[1] += acc[16 * i + 4 * q + 1]; a[2] += acc[16 * i + 4 * q + 2]; a[3] += acc[16 * i + 4 * q + 3]; p[q] = a; } }
#else
#pragma unroll
            for (int i = 0; i < 4; ++i) { f32x4* p = (f32x4*)(xr + 8 * (lane + 64 * i));
                f32x4 a = p[0], b = p[1];
                a[0] += acc[8 * i]; a[1] += acc[8 * i + 1]; a[2] += acc[8 * i + 2]; a[3] += acc[8 * i + 3];
                b[0] += acc[8 * i + 4]; b[1] += acc[8 * i + 5]; b[2] += acc[8 * i + 6]; b[3] += acc[8 * i + 7];
                p[0] = a; p[1] = b; }
#endif
        }
#endif
        LDS_WAIT(); asm volatile("" ::: "memory");
    }
}


#if PEER_SLICED
DI int peer_cj(int j) { return ((j >> 3) & 1) | (((j >> 2) & 1) << 1) | (((j >> 1) & 1) << 2); }
constexpr int PEER_CHUNK = 128, PEER_NCHUNK = T / PEER_CHUNK;
DI int peer_cjh(int half, int jj) { return half | (((jj >> 2) & 1) << 1) | (((jj >> 1) & 1) << 2); }
#define PEER_ISSUE(RW, ELO, EHI, HALF) do { _Pragma("unroll") for (int jj = 0; jj < 8; ++jj) { \
        const int e_ = __shfl((jj & 1) ? (EHI) : (ELO), (lane & ~7) | peer_cjh((HALF), jj)); \
        RW[jj] = *(const u32x4*)(tabs + (size_t)(MODE == 2 ? (e_ & 1) : e_) * 128); } } while (0)
template <int SIDE  , int MODE = 0  >
DI void phase_peer_sliced(const Ctx& C0, const Params& P, int qbase) {
    const Ctx C = fresh(C0);
    unsigned char* ws = P.ws;
    const bf16_t* hb = (const bf16_t*)(ws + P_H);
    const unsigned char* tab8 = ws + (SIDE == 0 ? P_UT : P_VT);
    const int* pe = (const int*)(ws + P_PE_E); const float* pg = (const float*)(ws + P_PE_G);
    const int lane = C.lane, a = lane >> 3, c = lane & 7;
    const int x = (int)(xb_xcc_id() & 7u);
    for (int i = 0; i < 16; ++i) {
        const int s = ((x + (i >> 1)) & 7) + 8 * (i & 1);
        unsigned* ctr = (unsigned*)(ws + WS_CTL) + CW_CTR + 64 * (qbase + s);
        const unsigned char* tabs = tab8 + (size_t)s * ((size_t)PEER_NE * 128) + 16 * c;
        for (;;) {
            const int ch = queue_pop(C, ctr, PEER_NCHUNK); if (ch < 0) break;
            const int tok0 = ch * PEER_CHUNK + C.wave;
            constexpr int NTOK = PEER_CHUNK / NWAVES;
            u32x4 rwA[8], rwB[8];
            int e_lo = pe[(size_t)tok0 * 128 + lane], e_hi = pe[(size_t)tok0 * 128 + 64 + lane];
            u32x4 ta, tb; float w_lo = 0.f, w_hi = 0.f;
            if (SIDE == 0) { ta = *(const u32x4*)(ws + P_PE_T8 + (size_t)tok0 * DM + s * 128 + 16 * c); tb = ta; }
            else { w_lo = pg[(size_t)tok0 * 128 + lane]; w_hi = pg[(size_t)tok0 * 128 + 64 + lane]; }
            PEER_ISSUE(rwA, e_lo, e_hi, 0);
#pragma unroll 1
            for (int it = 0; it < NTOK; ++it) {
                const int tok = tok0 + NWAVES * it, ntok = (it + 1 < NTOK) ? tok + NWAVES : tok;
                unsigned* xp = (unsigned*)((bf16_t*)(ws + P_XB) + (size_t)tok * DM + s * 128 + 16 * c + 8 * (a & 1) + 4 * ((a >> 1) & 1) + 2 * ((a >> 2) & 1));
                unsigned xw = 0u; if (SIDE == 1) xw = *xp;
                const int ne_lo = pe[(size_t)ntok * 128 + lane], ne_hi = pe[(size_t)ntok * 128 + 64 + lane];
                u32x4 nta, ntb; float nw_lo = 0.f, nw_hi = 0.f;
                if (SIDE == 0) { nta = *(const u32x4*)(ws + P_PE_T8 + (size_t)ntok * DM + s * 128 + 16 * c); ntb = nta; }
                else { nw_lo = pg[(size_t)ntok * 128 + lane]; nw_hi = pg[(size_t)ntok * 128 + 64 + lane]; }
                PEER_ISSUE(rwB, e_lo, e_hi, 1);
                if (SIDE == 0) {
                    int d[16];
#define PEER_DOT(RW, HALF) do { _Pragma("unroll") for (int jj = 0; jj < 8; ++jj) { int s0 = __builtin_amdgcn_sdot4((int)RW[jj].x, (int)ta.x, 0, false); s0 = __builtin_amdgcn_sdot4((int)RW[jj].y, (int)ta.y, s0, false); \
                        s0 = __builtin_amdgcn_sdot4((int)RW[jj].z, (int)ta.z, s0, false); s0 = __builtin_amdgcn_sdot4((int)RW[jj].w, (int)ta.w, s0, false); d[8 * (HALF) + jj] = s0; } } while (0)
                    if (MODE == 1) { _Pragma("unroll") for (int jj = 0; jj < 8; ++jj) { asm volatile("" :: "v"(rwA[jj])); d[jj] = 0; d[8 + jj] = 0; } } else PEER_DOT(rwA, 0);
                    PEER_ISSUE(rwA, ne_lo, ne_hi, 0);
                    if (MODE == 1) { _Pragma("unroll") for (int jj = 0; jj < 8; ++jj) asm volatile("" :: "v"(rwB[jj])); } else PEER_DOT(rwB, 1);
#undef PEER_DOT
                    int n8[8], n4[4], n2[2];
                    { const bool b = c & 1;
#pragma unroll
                      for (int j = 0; j < 8; ++j) { const int snd = b ? d[j] : d[8 + j], kp = b ? d[8 + j] : d[j]; n8[j] = kp + __shfl_xor(snd, 1); } }
                    { const bool b = c & 2;
#pragma unroll
                      for (int j = 0; j < 4; ++j) { const int snd = b ? n8[j] : n8[4 + j], kp = b ? n8[4 + j] : n8[j]; n4[j] = kp + __shfl_xor(snd, 2); } }
                    { const bool b = c & 4;
#pragma unroll
                      for (int j = 0; j < 2; ++j) { const int snd = b ? n4[j] : n4[2 + j], kp = b ? n4[2 + j] : n4[j]; n2[j] = kp + __shfl_xor(snd, 4); } }
                    int* pp = (int*)(ws + P_SC) + ((size_t)s * T + tok) * 128;
                    pp[lane] = n2[0]; pp[64 + lane] = n2[1];
                } else {
                    float acc[16];
#pragma unroll
                    for (int q = 0; q < 16; ++q) acc[q] = 0.f;
#define PEER_AXPY(RW, HALF) do { _Pragma("unroll") for (int jj = 0; jj < 8; ++jj) { const float wj = __shfl((jj & 1) ? w_hi : w_lo, (lane & ~7) | peer_cjh((HALF), jj)); \
                        unsigned w4[4] = {RW[jj].x, RW[jj].y, RW[jj].z, RW[jj].w}; \
                        asm volatile("" : "+v"(w4[0]), "+v"(w4[1]), "+v"(w4[2]), "+v"(w4[3]) : "v"(acc[0]), "v"(acc[15]));     \
                        _Pragma("unroll") for (int q = 0; q < 4; ++q) { const f32x2 lo = __builtin_amdgcn_cvt_pk_f32_fp8((int)w4[q], false), hi2 = __builtin_amdgcn_cvt_pk_f32_fp8((int)w4[q], true); \
                            acc[4 * q] = fmaf(wj, lo[0], acc[4 * q]); acc[4 * q + 1] = fmaf(wj, lo[1], acc[4 * q + 1]); acc[4 * q + 2] = fmaf(wj, hi2[0], acc[4 * q + 2]); acc[4 * q + 3] = fmaf(wj, hi2[1], acc[4 * q + 3]); } } } while (0)
                    if (MODE == 1) { _Pragma("unroll") for (int jj = 0; jj < 8; ++jj) asm volatile("" :: "v"(rwA[jj])); } else PEER_AXPY(rwA, 0);
                    PEER_ISSUE(rwA, ne_lo, ne_hi, 0);
                    if (MODE == 1) { _Pragma("unroll") for (int jj = 0; jj < 8; ++jj) asm volatile("" :: "v"(rwB[jj])); } else PEER_AXPY(rwB, 1);
#undef PEER_AXPY
                    float n8[8], n4[4], n2[2];
                    { const bool b = a & 1;
#pragma unroll
                      for (int q = 0; q < 8; ++q) { const float snd = b ? acc[q] : acc[8 + q], kp = b ? acc[8 + q] : acc[q]; n8[q] = kp + __shfl_xor(snd, 8); } }
                    { const bool b = a & 2;
#pragma unroll
                      for (int q = 0; q < 4; ++q) { const float snd = b ? n8[q] : n8[4 + q], kp = b ? n8[4 + q] : n8[q]; n4[q] = kp + __shfl_xor(snd, 16); } }
                    { const bool b = a & 4;
#pragma unroll
                      for (int q = 0; q < 2; ++q) { const float snd = b ? n4[q] : n4[2 + q], kp = b ? n4[2 + q] : n4[q]; n2[q] = kp + __shfl_xor(snd, 32); } }
                    const unsigned nw = pk2(bflo(xw) + n2[0], bfhi(xw) + n2[1]);
                    if (MODE == 0) { *xp = nw; const float q0 = bflo(nw), q1 = bfhi(nw); const float sq = wave_sum(q0 * q0 + q1 * q1); if (lane == 0) ((float*)(ws + P_SS))[(size_t)tok * 32 + s] = sq; }
                    else asm volatile("" :: "v"(nw));
                }
                e_lo = ne_lo; e_hi = ne_hi;
                if (SIDE == 0) { ta = nta; tb = ntb; } else { w_lo = nw_lo; w_hi = nw_hi; }
            }
        }
    }
}
#undef PEER_ISSUE

DI void phase_peer_combine(const Ctx& C0, const Params& P) {
    const Ctx C = fresh(C0);
    unsigned char* ws = P.ws;
    const float* usc = (const float*)(ws + P_UT + 32 * MiB); const float* vsc = (const float*)(ws + P_VT + 32 * MiB);
    const int* pe = (const int*)(ws + P_PE_E); float* pg = (float*)(ws + P_PE_G); const int* part = (const int*)(ws + P_SC); const float* tsc = (const float*)(ws + P_PE_TSC);
    for (size_t i = (size_t)C.blk * NTHREADS + C.tid; i < (size_t)T * 128; i += (size_t)C.G * NTHREADS) {
        int a = 0;
#pragma unroll
        for (int s = 0; s < 16; ++s) a += part[(size_t)s * T * 128 + i];
        const int e = pe[i];
        pg[i] = pg[i] * gelu_erf((float)a * usc[e] * tsc[i >> 7]) * vsc[e];
    }
}
#endif

constexpr int N_PHASES = 39;
__global__ void __launch_bounds__(NTHREADS, 2) mk_fwd(Params P) {
    extern __shared__ __attribute__((aligned(16))) unsigned char lds_raw[];
    Ctx C; C.lds = (LAS unsigned char*)lds_raw; C.tid = threadIdx.x; C.lane = C.tid & 63; C.wave = __builtin_amdgcn_readfirstlane(C.tid >> 6); C.blk = blockIdx.x; C.G = gridDim.x;
    unsigned char* ws = P.ws;
    for (int u = C.tid; u < (LDS_BYTES - LDSCTL_OFF) / 4; u += NTHREADS) ((LAS unsigned*)(C.lds + LDSCTL_OFF))[u] = 0u;
    __syncthreads();
    XcdBarrier bar; bar.bar = (unsigned*)(ws + WS_CTL) + CW_BAR; bar.x = 0; bar.st = nullptr;
    const bool one = (P.ph_hi - P.ph_lo) > 1;
    if (one) bar = xcd_barrier_post((unsigned*)(ws + WS_CTL) + CW_BAR, (volatile LAS unsigned*)(C.lds + LDSCTL_OFF));
    const int lo = P.ph_lo, hi = P.ph_hi;
#define IN(k) (lo <= (k) && (k) < hi)
#define SEAM(k) do { if (IN(k) && IN((k) + 1)) xcd_barrier(bar); } while (0)
    bf16_t* hbuf = (bf16_t*)(ws + P_H); bf16_t* xb = (bf16_t*)(ws + P_XB); float* ssp = (float*)(ws + P_SS);
    const int* pos = (const int*)P.in[I_POS];
    const f32x2* rtab = (const f32x2*)(ws + WS_ROPE);

    if (IN(0)) { if (EN_PRO) phase_prologue(C, P); rms_rows_2048(C, P.in[I_X], P.in[I_AB_NORM], hbuf, T); } SEAM(0);
    if (IN(1)) {
        {
            g8::Desc g{(const bf16_t*)(ws + P_MEMN), (const bf16_t*)(ws + WS_LW + LW_XKV), DM, DM, DM, MT / 256, 2 * DM / 256, 2, 1, (long)MT * DM, 0, (long)(LW_STRIDE / 2), 0};
            EpiBf16 E{(bf16_t*)(ws + WS_KVX), 2 * DM, (long)(KVX_STRIDE / 2), 0, 1.0f, nullptr, 0};
            g8::gemm(C.lds, g, E, C.G, C.blk);
        }
        {
            g8::Desc g{(const bf16_t*)(ws + P_SK), (const bf16_t*)(ws + P_WQB), 256, DM, 256, 1, DM / 256, 2, 8, 8L * 65536, 65536, (long)DM * DM, 256};
            EpiBf16 E{(bf16_t*)(ws + WS_LW + LW_PEER), DM, (long)(LW_STRIDE / 2), 256L * DM, 1.0f, nullptr, 0};
            if (PROBE == 1) { EpiNull En; g8::gemm(C.lds, g, En, C.G, C.blk); } if (PROBE == 13) g8::gemm(C.lds, g, E, C.G, C.blk); if (GSITE < 0 || GSITE == 3) g8::gemm(C.lds, g, E, C.G, C.blk);
        }
        {
        g8::Desc g{hbuf, (const bf16_t*)(ws + WS_ABIN_T), DM, DM, DM, T / 256, AB_IN / 256, 1, 1, 0, 0, 0, 0};
        EpiRope<0> E{(bf16_t*)(ws + P_PROJ), AB_IN, pos, rtab};
        if (PROBE == 1) { EpiNull En; g8::gemm(C.lds, g, En, C.G, C.blk); } if (PROBE == 13) g8::gemm(C.lds, g, E, C.G, C.blk); if (GSITE < 0 || GSITE == 4) g8::gemm(C.lds, g, E, C.G, C.blk);
        }
    }
    SEAM(1);

    {
        constexpr int l = 0, pb = 2; (void)l;

            if (IN(pb + 3)) { if (EN_DIFF) { if (PROBE == 2) phase_diff_attn(C, P, 2); phase_diff_attn(C, P, 0); } }
            SEAM(pb + 3);
            if (IN(pb + 4)) {
                g8::Desc g{(const bf16_t*)(ws + P_GBUF), (const bf16_t*)(ws + WS_GLU_T), S5_W, S5_W, S5_W, T / 256, S5_W / 256, 1, 1, 0, 0, 0, 0};
                EpiGlu E{(const bf16_t*)(ws + P_GBUF), P.in[I_S5_BGLU], (bf16_t*)(ws + P_CONCAT)};
                if (PROBE == 1) { EpiNull En; g8::gemm(C.lds, g, En, C.G, C.blk); } if (PROBE == 13) g8::gemm(C.lds, g, E, C.G, C.blk); if (GSITE < 0 || GSITE == 5) g8::gemm(C.lds, g, E, C.G, C.blk);
            }
            SEAM(pb + 4);
            if (IN(pb + 5)) {
                g8::Desc g{(const bf16_t*)(ws + P_CONCAT), (const bf16_t*)(ws + WS_ABOUT_T), DM, DM, DM, T / 256, DM / 256, 1, 1, 0, 0, 0, 0};
                EpiResidB<true> E{P.in[I_X], xb, ssp, 0};
                if (PROBE == 1 || PROBE == 13) { EpiNull En; g8::gemm(C.lds, g, En, C.G, C.blk); } if (GSITE < 0 || GSITE == 6) g8::gemm(C.lds, g, E, C.G, C.blk);
            {
                const unsigned char* lwa = ws + WS_LW + (size_t)l * LW_STRIDE; const bf16_t* kvx = (const bf16_t*)(ws + WS_KVX + (size_t)l * KVX_STRIDE);
                {
                    g8::Desc g{kvx, (const bf16_t*)(lwa + LW_XQ), 2 * DM, DM, 512, 1, DM / 256, BATCH, 4, (long)MEM_LEN * 2 * DM, 512, 0, 512};
                    EpiBf16 E{(bf16_t*)(ws + P_WABS), DM, 1024L * DM, 256L * DM, 1.0f, nullptr, 0};
                    g8::gemm(C.lds, g, E, C.G, C.blk);
                }
                {
                    g8::Desc g{(const bf16_t*)(lwa + LW_XO), kvx + DM, DM, 2 * DM, 512, DM / 256, 1, BATCH, 4, 0, 512, (long)MEM_LEN * 2 * DM, 512};
                    EpiBf16 E{(bf16_t*)(ws + P_VW), 1024, (long)DM * 1024, 256, 1.0f, nullptr, 0};
                    g8::gemm(C.lds, g, E, C.G, C.blk);
                }
            }
            }
            SEAM(pb + 5);
    }
    {
        constexpr int l = 0, pb = 2; (void)l;
        const unsigned char* lw = ws + WS_LW + (size_t)l * LW_STRIDE;
        if (IN(pb + 7)) {
            g8::Desc g{xb, (const bf16_t*)(ws + P_WABS), DM, DM, DM, SEQ / 256, 1024 / 256, BATCH, 1, (long)SEQ * DM, 0, 1024L * DM, 0};
            EpiBf16T<32> E{(bf16_t*)(ws + P_S), 1024, (long)SEQ * 1024, 0, 0.04419417382415922f, ssp, SEQ};
            if (PROBE == 1) { EpiNull En; g8::gemm(C.lds, g, En, C.G, C.blk); } if (PROBE == 13) g8::gemm(C.lds, g, E, C.G, C.blk); if (GSITE < 0 || GSITE == 11) g8::gemm(C.lds, g, E, C.G, C.blk);
        }
        SEAM(pb + 7);
        if (IN(pb + 9)) {
            phase_xa_softmax(C, P);
            if (l == 1) {
                convert_tables(C, P, 1);
            }
        }
        SEAM(pb + 9);
        if (IN(pb + 10)) {
            g8::Desc g{(const bf16_t*)(ws + P_P), (const bf16_t*)(ws + P_VW), 1024, 1024, 1024, SEQ / 256, DM / 256, BATCH, 1, (long)SEQ * 1024, 0, (long)DM * 1024, 0};
            EpiResidB<false> E{nullptr, xb, ssp, SEQ};
            if (PROBE == 1 || PROBE == 13) { EpiNull En; g8::gemm(C.lds, g, En, C.G, C.blk); } if (GSITE < 0 || GSITE == 14) g8::gemm(C.lds, g, E, C.G, C.blk);
        }
        SEAM(pb + 10);
        if (IN(pb + 13)) {
            g8::Desc g{xb, (const bf16_t*)(lw + LW_PEER), DM, DM, DM, T / 256, DM / 256, 1, 1, 0, 0, 0, 0};
            EpiBf16T<32> E{(bf16_t*)(ws + P_SC), DM, 0, 0, 1.0f, ssp, 0};
            if (PROBE == 1) { EpiNull En; g8::gemm(C.lds, g, En, C.G, C.blk); } if (PROBE == 13) g8::gemm(C.lds, g, E, C.G, C.blk); if (GSITE < 0 || GSITE == 15) g8::gemm(C.lds, g, E, C.G, C.blk);
        }
        SEAM(pb + 13);
        if (IN(pb + 14)) { if (EN_PEER && EN_TOPK) phase_peer<true>(C, P); }
        SEAM(pb + 14);
#if PEER_SLICED
        if (IN(pb + 15)) { if (EN_PEER && EN_PU) { if (PROBE >= 7 && PROBE <= 9) { phase_peer_sliced<0, PROBE - 7>(C, P, 8 + 32 * l + 64); __syncthreads(); } phase_peer_sliced<0>(C, P, 8 + 32 * l); } }
        SEAM(pb + 15);
        if (IN(pb + 16)) { if (EN_PEER) phase_peer_combine(C, P); }
        SEAM(pb + 16);
        if (IN(pb + 17)) { if (EN_PEER && EN_PV) { if (PROBE >= 10 && PROBE <= 12) { phase_peer_sliced<1, PROBE == 10 ? 3 : PROBE - 10>(C, P, 8 + 32 * l + 80); __syncthreads(); } phase_peer_sliced<1>(C, P, 8 + 32 * l + 16); } }
        SEAM(pb + 17);
#endif
    }
    {
        constexpr int l = 1, pb = 20; (void)l;

            if (IN(pb + 1)) {
                g8::Desc g{xb, (const bf16_t*)(ws + WS_MLAIN_T), DM, DM, DM, T / 256, MLA_IN_PAD / 256, 1, 1, 0, 0, 0, 0};
                EpiBf16T<16> E{(bf16_t*)(ws + P_MLAPROJ), MLA_IN_PAD, 0, 0, 1.0f, ssp, 0};
                if (PROBE == 1) { EpiNull En; g8::gemm(C.lds, g, En, C.G, C.blk); } if (PROBE == 13) g8::gemm(C.lds, g, E, C.G, C.blk); if (GSITE < 0 || GSITE == 7) g8::gemm(C.lds, g, E, C.G, C.blk);
            }
            SEAM(pb + 1);
            if (IN(pb + 2)) { if (PROBE == 5) phase_mla_rows(C, P); phase_mla_rows(C, P); }
            SEAM(pb + 2);
            if (IN(pb + 3)) {
                {
                    g8::Desc g{(const bf16_t*)(ws + P_CQN), (const bf16_t*)(ws + WS_UQ_T), MLA_QR, MLA_QR, MLA_QR, T / 256, 3072 / 256, 1, 1, 0, 0, 0, 0};
                    EpiRope<1> E{(bf16_t*)(ws + P_Q), 3072, pos, rtab};
                    if (PROBE == 1) { EpiNull En; g8::gemm(C.lds, g, En, C.G, C.blk); } if (PROBE == 13) g8::gemm(C.lds, g, E, C.G, C.blk); if (GSITE < 0 || GSITE == 8) g8::gemm(C.lds, g, E, C.G, C.blk);
                }
                {
                    g8::Desc g{(const bf16_t*)(ws + P_CKVN), (const bf16_t*)(ws + WS_UKV_T), MLA_KVR, MLA_KVR, MLA_KVR, T / 256, 4096 / 256, 1, 1, 0, 0, 0, 0};
                    EpiBf16 E{(bf16_t*)(ws + P_KV), 4096, 0, 0, 1.0f, nullptr, 0};
                    if (PROBE == 1) { EpiNull En; g8::gemm(C.lds, g, En, C.G, C.blk); } if (PROBE == 13) g8::gemm(C.lds, g, E, C.G, C.blk); if (GSITE < 0 || GSITE == 9) g8::gemm(C.lds, g, E, C.G, C.blk);
                }
            }
            SEAM(pb + 3);
            if (IN(pb + 4)) { if (EN_MLA) { if (PROBE == 2) phase_mla_attn(C, P, 3); phase_mla_attn(C, P, 1); } }
            SEAM(pb + 4);
            if (IN(pb + 5)) {
                g8::Desc g{hbuf, (const bf16_t*)(ws + WS_MLAO_T), DM, DM, DM, T / 256, DM / 256, 1, 1, 0, 0, 0, 0};
                EpiResidB<false> E{nullptr, xb, ssp, 0};
                if (PROBE == 1 || PROBE == 13) { EpiNull En; g8::gemm(C.lds, g, En, C.G, C.blk); } if (GSITE < 0 || GSITE == 10) g8::gemm(C.lds, g, E, C.G, C.blk);
            {
                const unsigned char* lwa = ws + WS_LW + (size_t)l * LW_STRIDE; const bf16_t* kvx = (const bf16_t*)(ws + WS_KVX + (size_t)l * KVX_STRIDE);
                {
                    g8::Desc g{kvx, (const bf16_t*)(lwa + LW_XQ), 2 * DM, DM, 512, 1, DM / 256, BATCH, 4, (long)MEM_LEN * 2 * DM, 512, 0, 512};
                    EpiBf16 E{(bf16_t*)(ws + P_WABS), DM, 1024L * DM, 256L * DM, 1.0f, nullptr, 0};
                    g8::gemm(C.lds, g, E, C.G, C.blk);
                }
                {
                    g8::Desc g{(const bf16_t*)(lwa + LW_XO), kvx + DM, DM, 2 * DM, 512, DM / 256, 1, BATCH, 4, 0, 512, (long)MEM_LEN * 2 * DM, 512};
                    EpiBf16 E{(bf16_t*)(ws + P_VW), 1024, (long)DM * 1024, 256, 1.0f, nullptr, 0};
                    g8::gemm(C.lds, g, E, C.G, C.blk);
                }
            }
            }
            SEAM(pb + 5);
    }
    {
        constexpr int l = 1, pb = 20; (void)l;
        const unsigned char* lw = ws + WS_LW + (size_t)l * LW_STRIDE;
        if (IN(pb + 7)) {
            g8::Desc g{xb, (const bf16_t*)(ws + P_WABS), DM, DM, DM, SEQ / 256, 1024 / 256, BATCH, 1, (long)SEQ * DM, 0, 1024L * DM, 0};
            EpiBf16T<32> E{(bf16_t*)(ws + P_S), 1024, (long)SEQ * 1024, 0, 0.04419417382415922f, ssp, SEQ};
            if (PROBE == 1) { EpiNull En; g8::gemm(C.lds, g, En, C.G, C.blk); } if (PROBE == 13) g8::gemm(C.lds, g, E, C.G, C.blk); if (GSITE < 0 || GSITE == 11) g8::gemm(C.lds, g, E, C.G, C.blk);
        }
        SEAM(pb + 7);
        if (IN(pb + 9)) {
            phase_xa_softmax(C, P);
            if (l == 1) {
                convert_tables(C, P, 1);
            }
        }
        SEAM(pb + 9);
        if (IN(pb + 10)) {
            g8::Desc g{(const bf16_t*)(ws + P_P), (const bf16_t*)(ws + P_VW), 1024, 1024, 1024, SEQ / 256, DM / 256, BATCH, 1, (long)SEQ * 1024, 0, (long)DM * 1024, 0};
            EpiResidB<false> E{nullptr, xb, ssp, SEQ};
            if (PROBE == 1 || PROBE == 13) { EpiNull En; g8::gemm(C.lds, g, En, C.G, C.blk); } if (GSITE < 0 || GSITE == 14) g8::gemm(C.lds, g, E, C.G, C.blk);
        }
        SEAM(pb + 10);
        if (IN(pb + 13)) {
            g8::Desc g{xb, (const bf16_t*)(lw + LW_PEER), DM, DM, DM, T / 256, DM / 256, 1, 1, 0, 0, 0, 0};
            EpiBf16T<32> E{(bf16_t*)(ws + P_SC), DM, 0, 0, 1.0f, ssp, 0};
            if (PROBE == 1) { EpiNull En; g8::gemm(C.lds, g, En, C.G, C.blk); } if (PROBE == 13) g8::gemm(C.lds, g, E, C.G, C.blk); if (GSITE < 0 || GSITE == 15) g8::gemm(C.lds, g, E, C.G, C.blk);
        }
        SEAM(pb + 13);
        if (IN(pb + 14)) { if (EN_PEER && EN_TOPK) phase_peer<true>(C, P); }
        SEAM(pb + 14);
#if PEER_SLICED
        if (IN(pb + 15)) { if (EN_PEER && EN_PU) { if (PROBE >= 7 && PROBE <= 9) { phase_peer_sliced<0, PROBE - 7>(C, P, 8 + 32 * l + 64); __syncthreads(); } phase_peer_sliced<0>(C, P, 8 + 32 * l); } }
        SEAM(pb + 15);
        if (IN(pb + 16)) { if (EN_PEER) phase_peer_combine(C, P); }
        SEAM(pb + 16);
        if (IN(pb + 17)) { if (EN_PEER && EN_PV) { if (PROBE >= 10 && PROBE <= 12) { phase_peer_sliced<1, PROBE == 10 ? 3 : PROBE - 10>(C, P, 8 + 32 * l + 80); __syncthreads(); } phase_peer_sliced<1>(C, P, 8 + 32 * l + 16); } }
        SEAM(pb + 17);
#endif
    }
    if (IN(38)) rms_rows_final(C, xb, P.out, P.in[I_FINAL_NORM], T);
    if (PROBE == 14 && one) { for (int i = 0; i < 30; ++i) xcd_barrier(bar); }
#undef IN
#undef SEAM
}

extern "C" void kernel_launch(void* const* d_in, const int* in_sizes, int n_in, void* d_out, int out_size, void* d_ws, size_t ws_size, hipStream_t stream) {
    static int grid = 0;
    if (grid == 0) {
        if (n_in != 39 || in_sizes[0] != T * DM || out_size != T * DM || ws_size < WS_END) {
            fprintf(stderr, "kernel_launch: unexpected shapes (n_in %d in0 %d out %d ws %zu, need ws >= %zu); nothing launched\n", n_in, n_in > 0 ? in_sizes[0] : -1, out_size, ws_size, (size_t)WS_END);
            grid = -1; return; }
        int dev = 0, cus = 0;
        if (hipGetDevice(&dev) != hipSuccess || hipDeviceGetAttribute(&cus, hipDeviceAttributeMultiprocessorCount, dev) != hipSuccess) { grid = -1; return; }
        if (hipFuncSetAttribute((const void*)mk_fwd, hipFuncAttributeMaxDynamicSharedMemorySize, LDS_BYTES) != hipSuccess) { fprintf(stderr, "kernel_launch: hipFuncSetAttribute failed\n"); grid = -1; return; }
        int per_cu = 0;
        if (hipOccupancyMaxActiveBlocksPerMultiprocessor(&per_cu, (const void*)mk_fwd, NTHREADS, LDS_BYTES) != hipSuccess || per_cu < 1)
            fprintf(stderr, "kernel_launch: occupancy query reports %d blocks per CU\n", per_cu);
        (void)hipGetLastError();
        grid = cus;
    }
    if (grid < 0) return;
    (void)hipMemsetAsync((char*)d_ws + WS_CTL, 0, CTL_BYTES, stream);
    Params p{};
    for (int i = 0; i < 39; ++i) p.in[i] = (const float*)d_in[i];
    p.out = (float*)d_out; p.ws = (unsigned char*)d_ws;
#if MK_ONE_LAUNCH
    p.ph_lo = 0; p.ph_hi = N_PHASES;
    hipLaunchKernelGGL(mk_fwd, dim3(grid), dim3(NTHREADS), LDS_BYTES, stream, p);
#else
    for (int ph = 0; ph < N_PHASES; ++ph) { p.ph_lo = ph; p.ph_hi = ph + 1; hipLaunchKernelGGL(mk_fwd, dim3(grid), dim3(NTHREADS), LDS_BYTES, stream, p); }
#endif
    const hipError_t le = hipPeekAtLastError();
    if (le != hipSuccess) fprintf(stderr, "kernel_launch: launch failed: %s\n", hipGetErrorName(le));
}
```

```cpp
#include <hip/hip_runtime.h>
#include <cstdio>
#include <cstdint>

#ifndef MK_ONE_LAUNCH
#define MK_ONE_LAUNCH 1
#endif
#ifndef FAST_GEMM
#define FAST_GEMM 1
#endif
#ifndef FAST_ATTN
#define FAST_ATTN 1
#endif

#ifndef EN_TOPK
#define EN_TOPK 1
#endif
#ifndef EN_PU
#define EN_PU 1
#endif
#ifndef EN_PV
#define EN_PV 1
#endif
#ifndef EN_S5
#define EN_S5 1
#endif
#ifndef EN_DIFF
#define EN_DIFF 1
#endif
#ifndef EN_MLA
#define EN_MLA 1
#endif
#ifndef EN_PEER
#define EN_PEER 1
#endif
#ifndef EN_GEMM
#define EN_GEMM 1
#endif
#ifndef EN_PRO
#define EN_PRO 1
#endif
#ifndef PEER_FP8
#define PEER_FP8 1
#endif
#ifndef PROBE
#define PROBE 0
#endif
#ifndef PEER_SLICED
#define PEER_SLICED 1
#endif
#ifndef PROBE_ATTN_MODE
#define PROBE_ATTN_MODE 0
#endif
#ifndef PROBE_PEER2
#define PROBE_PEER2 0
#endif
#ifndef GSITE
#define GSITE -1
#endif
#define GAS __attribute__((address_space(1)))
#define LAS __attribute__((address_space(3)))
#define DI __device__ __forceinline__
typedef unsigned short bf16_t;
typedef short bf16x8 __attribute__((ext_vector_type(8)));
typedef short s16x4 __attribute__((ext_vector_type(4)));
typedef float f32x2 __attribute__((ext_vector_type(2)));
typedef float f32x4 __attribute__((ext_vector_type(4)));
typedef float f32x16 __attribute__((ext_vector_type(16)));
typedef unsigned u32x2 __attribute__((ext_vector_type(2)));
typedef unsigned u32x4 __attribute__((ext_vector_type(4)));
typedef __bf16 bf16x2_t __attribute__((ext_vector_type(2)));

constexpr int BATCH = 16, SEQ = 2048, DM = 2048, T = BATCH * SEQ, MEM_LEN = 256, MT = BATCH * MEM_LEN;
constexpr int DIFF_HEADS = 12, DIFF_W = 1536, S5_W = 512, AB_IN = 5120;
constexpr int MLA_HEADS = 16, MLA_QR = 768, MLA_KVR = 256, MLA_IN = 1088, MLA_IN_PAD = 1280;
constexpr int PEER_NE = 16384;
constexpr float NORM_EPS = 1e-6f;
constexpr int ROPE_POS = 3072;
constexpr int NWAVES = 8, NTHREADS = 512;

constexpr size_t MiB = 1u << 20;
constexpr size_t WS_CTL = 0, CTL_BYTES = 1 * MiB;
constexpr size_t WS_ROPE = 1 * MiB;
constexpr size_t WS_ABIN_T = 2 * MiB, WS_ABOUT_T = 22 * MiB, WS_GLU_T = 30 * MiB, WS_MLAIN_T = 31 * MiB, WS_UQ_T = 36 * MiB, WS_UKV_T = 41 * MiB, WS_MLAO_T = 43 * MiB;
constexpr size_t WS_LW = 51 * MiB, LW_STRIDE = 40 * MiB;
constexpr size_t LW_XQ = 0, LW_XKV = 8 * MiB, LW_XO = 24 * MiB, LW_PEER = 32 * MiB;
constexpr size_t WS_KVX = 131 * MiB, KVX_STRIDE = 32 * MiB;
constexpr size_t WS_POOL = 195 * MiB;
constexpr size_t P_H = WS_POOL;
constexpr size_t P_PROJ = WS_POOL + 128 * MiB;
constexpr size_t P_CONCAT = WS_POOL + 448 * MiB;
constexpr size_t P_GBUF = WS_POOL + 576 * MiB;
constexpr size_t P_MLAPROJ = WS_POOL + 0 * MiB;
constexpr size_t P_CQN = WS_POOL + 80 * MiB;
constexpr size_t P_CKVN = WS_POOL + 128 * MiB;
constexpr size_t P_KROPE = WS_POOL + 144 * MiB;
constexpr size_t P_Q = WS_POOL + 152 * MiB;
constexpr size_t P_KV = WS_POOL + 344 * MiB;
constexpr size_t P_WABS = WS_POOL + 128 * MiB;
constexpr size_t P_VW = WS_POOL + 192 * MiB;
constexpr size_t P_S = WS_POOL + 256 * MiB;
constexpr size_t P_P = WS_POOL + 320 * MiB;
constexpr size_t P_SC = WS_POOL + 128 * MiB;
constexpr size_t P_UT = WS_POOL + 608 * MiB;
constexpr size_t P_VT = WS_POOL + 642 * MiB;
constexpr size_t P_PE_E = WS_POOL + 384 * MiB;
constexpr size_t P_PE_G = WS_POOL + 400 * MiB;
constexpr size_t P_PE_T8 = WS_POOL + 432 * MiB;
constexpr size_t P_PE_TSC = WS_POOL + 496 * MiB;
constexpr size_t P_MEMN = WS_POOL + 448 * MiB;
constexpr size_t P_WQB = WS_POOL + 480 * MiB;
constexpr size_t P_SK = WS_POOL + 496 * MiB;
constexpr size_t P_SS = WS_POOL + 680 * MiB;
constexpr size_t P_XB = WS_POOL + 704 * MiB;
constexpr size_t WS_END = WS_POOL + 832 * MiB;
constexpr int CW_BAR = 4096, CW_CTR = 16384;

constexpr int RING_BYTES = 131072, LDSCTL_OFF = RING_BYTES, LDS_BYTES = 147456;

DI unsigned pk2(float lo, float hi) { f32x2 v = {lo, hi}; bf16x2_t b = __builtin_convertvector(v, bf16x2_t); return __builtin_bit_cast(unsigned, b); }
DI float bflo(unsigned u) { return __uint_as_float(u << 16); }
DI float bfhi(unsigned u) { return __uint_as_float(u & 0xffff0000u); }
DI float bf2f(bf16_t b) { return __uint_as_float(((unsigned)b) << 16); }
DI bf16_t f2bf(float f) { return (bf16_t)(pk2(f, 0.f) & 0xffffu); }
DI float dot2bf(unsigned a, unsigned b, float c) { return __builtin_amdgcn_fdot2_f32_bf16(__builtin_bit_cast(bf16x2_t, a), __builtin_bit_cast(bf16x2_t, b), c, false); }
DI int opaque_tid() { int t; asm volatile("v_mov_b32 %0, %1" : "=v"(t) : "v"(threadIdx.x)); return t; }
DI float wave_sum(float v) {
#pragma unroll
    for (int o = 1; o < 64; o <<= 1) v += __shfl_xor(v, o);
    return v;
}
DI float gelu_erf(float v) { return 0.5f * v * (1.0f + erff(v * 0.70710678118654752f)); }
DI float swap32_max(float x) { auto rr = __builtin_amdgcn_permlane32_swap(__float_as_uint(x), __float_as_uint(x), false, false); return fmaxf(__uint_as_float(rr[0]), __uint_as_float(rr[1])); }
DI float swap32_sum(float x) { auto rr = __builtin_amdgcn_permlane32_swap(__float_as_uint(x), __float_as_uint(x), false, false); return __uint_as_float(rr[0]) + __uint_as_float(rr[1]); }
#define LDS_WAIT() asm volatile("s_waitcnt lgkmcnt(0)" ::: "memory")
#define VM_WAIT() asm volatile("s_waitcnt vmcnt(0)" ::: "memory")

#define XB_TMO      128
#define XB_XCNT(j)  (256  + 64 * (j))
#define XB_XSUB(j)  (1280 + 64 * (j))
#define XB_XGEN(j)  (2304 + 64 * (j))
#define XB_TOP      3328
#define XB_TOPGEN   3392
#define XCD_BAR_WORDS 3456
#define XB_SPIN_CAP (1u << 20)
DI unsigned xb_ld(unsigned* p)              { return __hip_atomic_load(p, __ATOMIC_RELAXED, __HIP_MEMORY_SCOPE_AGENT); }
DI unsigned xb_add(unsigned* p, unsigned v) { return __hip_atomic_fetch_add(p, v, __ATOMIC_RELAXED, __HIP_MEMORY_SCOPE_AGENT); }
DI unsigned xb_xcc_id() { return (unsigned)__builtin_amdgcn_s_getreg((3 << 11) | 20) & 0xFu; }
#define XB_SPIN(cond, bar) do { unsigned _sp = 0; while (cond) { __builtin_amdgcn_s_sleep(1); \
    if ((++_sp & 255u) == 0u) { if (xb_ld(&(bar)[XB_TMO])) break; if (_sp > XB_SPIN_CAP) { atomicAdd(&(bar)[XB_TMO], 1u); break; } } } } while (0)
struct XcdBarrier { unsigned* bar; unsigned x; volatile LAS unsigned* st; };
DI XcdBarrier xcd_barrier_post(unsigned* bar, volatile LAS unsigned* st) {
    XcdBarrier b; b.bar = bar; b.x = xb_xcc_id(); b.st = st;
    if (threadIdx.x == 0) (void)xb_add(&bar[XB_XCNT(b.x)], 1u);
    return b;
}
DI void xcd_barrier_complete(unsigned* bar, unsigned x, unsigned& nloc, unsigned& nx) {
    const unsigned G = gridDim.x * gridDim.y * gridDim.z;
    unsigned sum, cnt, mine, sp = 0u;
    for (;;) {
        sum = 0u; cnt = 0u; mine = 0u;
#pragma unroll
        for (unsigned j = 0; j < 16; ++j) { const unsigned c = xb_ld(&bar[XB_XCNT(j)]); sum += c; cnt += (c > 0u) ? 1u : 0u; mine = (j == x) ? c : mine; }
        if (sum == G) break;
        __builtin_amdgcn_s_sleep(1);
        if ((++sp & 255u) == 0u) { if (xb_ld(&bar[XB_TMO])) break; if (sp > XB_SPIN_CAP) { atomicAdd(&bar[XB_TMO], 1u); break; } }
    }
    nloc = mine > 0u ? mine : 1u; nx = cnt > 0u ? cnt : 1u;
}
DI void xcd_barrier(const XcdBarrier& b) {
    asm volatile("s_waitcnt vmcnt(0)" ::: "memory");
    __syncthreads();
    if (threadIdx.x == 0) {
        unsigned* bar = b.bar;
        __builtin_amdgcn_s_waitcnt(0);
        unsigned nloc = b.st[0], nx = b.st[1];
        if (nloc == 0u) { xcd_barrier_complete(bar, b.x, nloc, nx); b.st[0] = nloc; b.st[1] = nx; }
        const unsigned old = xb_add(&bar[XB_XSUB(b.x)], 1u);
        const unsigned gen = old / nloc;
        if (old + 1u == (gen + 1u) * nloc) {
            __builtin_amdgcn_fence(__ATOMIC_RELEASE, "agent");
            asm volatile("s_waitcnt vmcnt(0)" ::: "memory");
            const unsigned og = xb_add(&bar[XB_TOP], 1u);
            const unsigned tg = og / nx;
            if (og + 1u == (tg + 1u) * nx) xb_add(&bar[XB_TOPGEN], 1u);
            else XB_SPIN(xb_ld(&bar[XB_TOPGEN]) == tg, bar);
            __builtin_amdgcn_fence(__ATOMIC_ACQUIRE, "agent");
            xb_add(&bar[XB_XGEN(b.x)], 1u);
            asm volatile("s_waitcnt vmcnt(0)" ::: "memory");
        } else {
            XB_SPIN(xb_ld(&bar[XB_XGEN(b.x)]) == gen, bar);
            __builtin_amdgcn_fence(__ATOMIC_ACQUIRE, "agent");
            asm volatile("s_waitcnt vmcnt(0)" ::: "memory");
        }
    }
    __syncthreads();
}

namespace g8 {
constexpr int BM = 256, BK = 64, HALF = 128, HTB = HALF * BK * 2, STAGE_BYTES = 8 * HTB, NXCD = 8, WGM = 8;
DI int lds_byte(int r, int c) { const int st = (r >> 4) * 2 + (c >> 5), rr = r & 15, cc = c & 31, ob = rr * 64 + cc * 2; return st * 1024 + (ob ^ (((ob >> 9) & 1) << 5)); }
DI void stage_rc(int b, int& R, int& C) { const int st = b / 1024, sb = b % 1024, swz = sb ^ (((sb >> 9) & 1) << 5); R = (st >> 1) * 16 + swz / 64; C = (st & 1) * 32 + (swz % 64) / 2; }
DI int perm32(int rho) { const int n = rho >> 4, i = rho & 15; return 8 * (i >> 2) + 4 * n + (i & 3); }

struct Unit { int zo, zi, pm, pn; };
struct Desc { const bf16_t* A; const bf16_t* Bt; int lda, ldb, K, nM, nN, nZo, nZi; long sAo, sAi, sBo, sBi; };
DI bool next_unit(const Desc& g, int i, int G, int c, Unit& u) {
    const int per = g.nM * g.nN, nwg = per * g.nZo * g.nZi;
    const long L = (long)i * G + c; if (L >= nwg) return false;
    int wgid = (int)L; { const int q = nwg / NXCD, r = nwg % NXCD, xcd = wgid % NXCD, off = wgid / NXCD; wgid = (xcd < r ? xcd * (q + 1) : r * (q + 1) + (xcd - r) * q) + off; }
    const int z = wgid / per, w = wgid % per;
    u.zo = z / g.nZi; u.zi = z % g.nZi;
    const int nig = WGM * g.nN, gid = w / nig, fm = gid * WGM, gsz = (g.nM - fm) < WGM ? (g.nM - fm) : WGM;
    u.pm = fm + ((w % nig) % gsz); u.pn = (w % nig) / gsz; return true;
}

template <class Epi>
DI void gemm_phase(LAS unsigned char* lds, const Desc g, const Epi& E, int G, int c) {
    const int tid = opaque_tid(), wid = __builtin_amdgcn_readfirstlane(tid >> 6), lane = tid & 63, wr = wid >> 2, wc = wid & 3, fr = lane & 15, fq = lane >> 4;
    const int K = g.K, nt = K / BK;
    unsigned voffA[2], voffB[2];
#pragma unroll
    for (int i = 0; i < 2; ++i) { int R, C; stage_rc(tid * 16 + i * 8192, R, C); const int Rb = (R & ~31) + perm32(R & 31);
        voffA[i] = (unsigned)(R * g.lda + C) * 2u; voffB[i] = (unsigned)(Rb * g.ldb + C) * 2u; }
    const size_t kstep = (size_t)(BK * 2);
    const size_t hstepA = (size_t)HALF * g.lda * 2, hstepB = (size_t)HALF * g.ldb * 2;
    const unsigned ldsw = (unsigned)wid * 1024u;
    const int aoff = lds_byte(wr * 64 + fr, fq * 8), boff = lds_byte(wc * 32 + fr, fq * 8);
#define PG8_SA(b, h) (((b) * 2 + (h)) * HTB)
#define PG8_SB(b, h) ((4 + (b) * 2 + (h)) * HTB)
#define PG8_STAGE(bufoff, gbase, voff) do { _Pragma("unroll") for (int _i = 0; _i < 2; ++_i) \
        __builtin_amdgcn_global_load_lds((const unsigned*)((const char*)(gbase) + (voff)[_i]), (LAS unsigned*)(lds + (bufoff) + ldsw + _i * 8192), 16, 0, 0); } while (0)
#define PG8_LDA(dst, b, h) do { _Pragma("unroll") for (int m = 0; m < 4; ++m) _Pragma("unroll") for (int k = 0; k < 2; ++k) dst[m][k] = *(const LAS bf16x8*)(lds + PG8_SA(b, h) + aoff + m * 2048 + k * 1024); } while (0)
#define PG8_LDB(dst, b, h) do { _Pragma("unroll") for (int n = 0; n < 2; ++n) _Pragma("unroll") for (int k = 0; k < 2; ++k) dst[n][k] = *(const LAS bf16x8*)(lds + PG8_SB(b, h) + boff + n * 2048 + k * 1024); } while (0)
#define PG8_MMA(ai, bj, At, Bt) do { __builtin_amdgcn_s_setprio(1); _Pragma("unroll") for (int m = 0; m < 4; ++m) _Pragma("unroll") for (int n = 0; n < 2; ++n) _Pragma("unroll") for (int k = 0; k < 2; ++k) \
        acc[ai][bj][m][n] = __builtin_amdgcn_mfma_f32_16x16x32_bf16(Bt[n][k], At[m][k], acc[ai][bj][m][n], 0, 0, 0); __builtin_amdgcn_s_setprio(0); } while (0)
#define PG8_WAIT_V(n) asm volatile("s_waitcnt vmcnt(" #n ")" ::: "memory")
#define PG8_WAIT_L(n) asm volatile("s_waitcnt lgkmcnt(" #n ")" ::: "memory")
#define PG8_BAR __builtin_amdgcn_s_barrier()
#define PG8_SCHED __builtin_amdgcn_sched_barrier(0)
#define PG8_APTR(u) ((const char*)g.A + ((size_t)(u).zo * g.sAo + (size_t)(u).zi * g.sAi + (size_t)(u).pm * BM * g.lda) * 2)
#define PG8_BPTR(u) ((const char*)g.Bt + ((size_t)(u).zo * g.sBo + (size_t)(u).zi * g.sBi + (size_t)(u).pn * BM * g.ldb) * 2)
    Unit cur, nxt; int ui = 0;
    if (!next_unit(g, 0, G, c, cur)) return;
    f32x4 acc[2][2][4][2];
#pragma unroll
    for (int a = 0; a < 2; ++a)
#pragma unroll
        for (int b = 0; b < 2; ++b)
#pragma unroll
            for (int m = 0; m < 4; ++m)
#pragma unroll
                for (int n = 0; n < 2; ++n) acc[a][b][m][n] = (f32x4){0.f, 0.f, 0.f, 0.f};
    bf16x8 At[4][2], B0[2][2], B1[2][2];
    const char* cA = PG8_APTR(cur); const char* cB = PG8_BPTR(cur);
    PG8_STAGE(PG8_SB(0, 0), cB, voffB); PG8_STAGE(PG8_SA(0, 0), cA, voffA); PG8_STAGE(PG8_SB(0, 1), cB + hstepB, voffB); PG8_STAGE(PG8_SA(0, 1), cA + hstepA, voffA);
    if (wr == 1) PG8_BAR;
    PG8_WAIT_V(4); PG8_BAR;
    PG8_STAGE(PG8_SB(1, 0), cB + kstep, voffB); PG8_STAGE(PG8_SA(1, 0), cA + kstep, voffA); PG8_STAGE(PG8_SB(1, 1), cB + hstepB + kstep, voffB);
    PG8_WAIT_V(6); PG8_BAR;
    for (;;) {
        const bool has_next = next_unit(g, ui + 1, G, c, nxt);
        const char* nA = has_next ? PG8_APTR(nxt) : cA; const char* nB = has_next ? PG8_BPTR(nxt) : cB;
        for (int t = 0; t < nt; t += 2) {
            const bool last = (t == nt - 2);
            const char* a1 = cA + (size_t)(t + 1) * kstep;
            const char* a2 = last ? nA : cA + (size_t)(t + 2) * kstep; const char* b2 = last ? nB : cB + (size_t)(t + 2) * kstep;
            const char* a3 = a2 + kstep; const char* b3 = b2 + kstep;
            PG8_LDB(B0, 0, 0); PG8_SCHED; PG8_LDA(At, 0, 0); PG8_STAGE(PG8_SA(1, 1), a1 + hstepA, voffA);
            PG8_WAIT_L(8); PG8_BAR; PG8_WAIT_L(0); PG8_MMA(0, 0, At, B0); PG8_BAR; PG8_SCHED;
            PG8_LDB(B1, 0, 1); PG8_STAGE(PG8_SB(0, 0), b2, voffB);
            PG8_BAR; PG8_WAIT_L(0); PG8_MMA(0, 1, At, B1); PG8_BAR;
            PG8_LDA(At, 0, 1); PG8_STAGE(PG8_SA(0, 0), a2, voffA);
            PG8_BAR; PG8_WAIT_L(0); PG8_MMA(1, 0, At, B0); PG8_BAR; PG8_SCHED;
            PG8_STAGE(PG8_SB(0, 1), b2 + hstepB, voffB);
            PG8_WAIT_V(6); PG8_BAR; PG8_MMA(1, 1, At, B1); PG8_BAR;
            PG8_LDB(B0, 1, 0); PG8_SCHED; PG8_LDA(At, 1, 0); PG8_STAGE(PG8_SA(0, 1), a2 + hstepA, voffA);
            PG8_WAIT_L(8); PG8_BAR; PG8_WAIT_L(0); PG8_MMA(0, 0, At, B0); PG8_BAR; PG8_SCHED;
            PG8_LDB(B1, 1, 1); PG8_STAGE(PG8_SB(1, 0), b3, voffB);
            PG8_BAR; PG8_WAIT_L(0); PG8_MMA(0, 1, At, B1); PG8_BAR;
            PG8_LDA(At, 1, 1); PG8_STAGE(PG8_SA(1, 0), a3, voffA);
            PG8_BAR; PG8_WAIT_L(0); PG8_MMA(1, 0, At, B0); PG8_BAR; PG8_SCHED;
            PG8_STAGE(PG8_SB(1, 1), b3 + hstepB, voffB);
            PG8_WAIT_V(6); PG8_BAR; PG8_MMA(1, 1, At, B1); PG8_BAR;
        }
        {
            const int row0 = cur.pm * BM + wr * 64 + fr, col0 = cur.pn * BM + wc * 32 + 8 * fq;
#pragma unroll
            for (int ai = 0; ai < 2; ++ai)
#pragma unroll
                for (int m = 0; m < 4; ++m) {
                    const int row = row0 + ai * HALF + m * 16;
                    const float ri = E.row_begin(cur.zo, cur.zi, row);
                    float ra = 0.f;
#pragma unroll
                    for (int bj = 0; bj < 2; ++bj) ra += E.oct(cur.zo, cur.zi, row, col0 + bj * HALF, acc[ai][bj][m][0], acc[ai][bj][m][1], ri);
                    E.row_end(cur.zo, row, cur.pn * 4 + wc, ra);
                }
        }
        if (!has_next) break;
#pragma unroll
        for (int a = 0; a < 2; ++a)
#pragma unroll
            for (int b = 0; b < 2; ++b)
#pragma unroll
                for (int m = 0; m < 4; ++m)
#pragma unroll
                    for (int n = 0; n < 2; ++n) acc[a][b][m][n] = (f32x4){0.f, 0.f, 0.f, 0.f};
        cur = nxt; cA = nA; cB = nB; ++ui;
    }
    PG8_WAIT_V(0);
    if (wr == 0) PG8_BAR;
    PG8_BAR;
#undef PG8_SA
#undef PG8_SB
#undef PG8_STAGE
#undef PG8_LDA
#undef PG8_LDB
#undef PG8_MMA
#undef PG8_WAIT_V
#undef PG8_WAIT_L
#undef PG8_BAR
#undef PG8_SCHED
#undef PG8_APTR
#undef PG8_BPTR
}

template <class Epi>
DI void naive_gemm(const Desc g, const Epi& E, int G, int c) {
    const int M = g.nM * BM, N = g.nN * BM, n8 = N / 8, nZ = g.nZo * g.nZi;
    const long total = (long)nZ * M * n8;
    for (long idx = (long)c * NTHREADS + threadIdx.x; idx < total; idx += (long)G * NTHREADS) {
        const int col = (int)(idx % n8) * 8; const int row = (int)((idx / n8) % M); const int z = (int)(idx / ((long)n8 * M));
        const int zo = z / g.nZi, zi = z % g.nZi;
        const bf16_t* a = g.A + (size_t)zo * g.sAo + (size_t)zi * g.sAi + (size_t)row * g.lda;
        const bf16_t* b = g.Bt + (size_t)zo * g.sBo + (size_t)zi * g.sBi + (size_t)col * g.ldb;
        float acc[8];
#pragma unroll
        for (int j = 0; j < 8; ++j) acc[j] = 0.f;
        for (int k = 0; k < g.K; k += 8) {
            const u32x4 av = *(const u32x4*)(a + k);
#pragma unroll
            for (int j = 0; j < 8; ++j) { const u32x4 bv = *(const u32x4*)(b + (size_t)j * g.ldb + k);
                float s = acc[j]; s = dot2bf(av.x, bv.x, s); s = dot2bf(av.y, bv.y, s); s = dot2bf(av.z, bv.z, s); s = dot2bf(av.w, bv.w, s); acc[j] = s; }
        }
        (void)E.oct(zo, zi, row, col, (f32x4){acc[0], acc[1], acc[2], acc[3]}, (f32x4){acc[4], acc[5], acc[6], acc[7]}, E.row_begin(zo, zi, row));
    }
}
template <class Epi>
DI void gemm(LAS unsigned char* lds, const Desc g, const Epi& E, int G, int c) {
#if !EN_GEMM
    return;
#elif FAST_GEMM
    gemm_phase(lds, g, E, G, c);
#else
    naive_gemm(g, E, G, c);
#endif
}
}

template <int NP> DI float row_rstd(const float* ss, int row) {
    const f32x4* p = (const f32x4*)(ss + (size_t)row * 32); float t = 0.f;
#pragma unroll
    for (int i = 0; i < NP / 4; ++i) { const f32x4 v = p[i]; t += (v[0] + v[1]) + (v[2] + v[3]); }
    return rsqrtf(t * (1.0f / DM) + NORM_EPS);
}
#define EPI_NO_ROW_BEGIN DI float row_begin(int, int, int) const { return 0.f; }
#define EPI_NO_ROW_END DI void row_end(int, int, int, float) const {}
template <int NP  > struct EpiBf16T {
    bf16_t* O; long ldc, sZo, sZi; float scale; const float* ss; int rzo;
    EPI_NO_ROW_END
    DI float row_begin(int zo, int, int row) const { return NP ? row_rstd<NP ? NP : 4>(ss, zo * rzo + row) * scale : scale; }
    DI float oct(int zo, int zi, int row, int col, f32x4 lo, f32x4 hi, float f) const {
        bf16_t* p = O + (size_t)zo * sZo + (size_t)zi * sZi + (size_t)row * ldc + col;
        u32x4 w; w.x = pk2(lo[0] * f, lo[1] * f); w.y = pk2(lo[2] * f, lo[3] * f); w.z = pk2(hi[0] * f, hi[1] * f); w.w = pk2(hi[2] * f, hi[3] * f);
        *(u32x4*)p = w; return 0.f;
    }
};
typedef EpiBf16T<0> EpiBf16;
template <int NP> struct EpiF32T {
    float* O; long ldc, sZo, sZi; float scale; const float* ss; int rzo;
    EPI_NO_ROW_END
    DI float row_begin(int zo, int, int row) const { return NP ? row_rstd<NP ? NP : 4>(ss, zo * rzo + row) * scale : scale; }
    DI float oct(int zo, int zi, int row, int col, f32x4 lo, f32x4 hi, float f) const {
        float* p = O + (size_t)zo * sZo + (size_t)zi * sZi + (size_t)row * ldc + col;
        *(f32x4*)p = lo * f; *(f32x4*)(p + 4) = hi * f; return 0.f;
    }
};
typedef EpiF32T<0> EpiF32;
template <bool F32SRC> struct EpiResidB {
    const float* xin; bf16_t* xb; float* ss; int rzo;
    EPI_NO_ROW_BEGIN
    DI float oct(int zo, int, int row, int col, f32x4 lo, f32x4 hi, float) const {
        const size_t o = (size_t)(zo * rzo + row) * DM + col;
        float r[8];
        if (F32SRC) { const f32x4 r0 = *(const f32x4*)(xin + o), r1 = *(const f32x4*)(xin + o + 4); r[0] = r0[0]; r[1] = r0[1]; r[2] = r0[2]; r[3] = r0[3]; r[4] = r1[0]; r[5] = r1[1]; r[6] = r1[2]; r[7] = r1[3]; }
        else { const u32x4 w = *(const u32x4*)(xb + o); r[0] = bflo(w.x); r[1] = bfhi(w.x); r[2] = bflo(w.y); r[3] = bfhi(w.y); r[4] = bflo(w.z); r[5] = bfhi(w.z); r[6] = bflo(w.w); r[7] = bfhi(w.w); }
        u32x4 w; w.x = pk2(r[0] + lo[0], r[1] + lo[1]); w.y = pk2(r[2] + lo[2], r[3] + lo[3]); w.z = pk2(r[4] + hi[0], r[5] + hi[1]); w.w = pk2(r[6] + hi[2], r[7] + hi[3]);
        *(u32x4*)(xb + o) = w;
        const float q0 = bflo(w.x), q1 = bfhi(w.x), q2 = bflo(w.y), q3 = bfhi(w.y), q4 = bflo(w.z), q5 = bfhi(w.z), q6 = bflo(w.w), q7 = bfhi(w.w);
        return ((q0 * q0 + q1 * q1) + (q2 * q2 + q3 * q3)) + ((q4 * q4 + q5 * q5) + (q6 * q6 + q7 * q7));
    }
    DI void row_end(int zo, int row, int slot, float ra) const {
        ra += __shfl_xor(ra, 16); ra += __shfl_xor(ra, 32);
        if ((threadIdx.x & 63) < 16) ss[(size_t)(zo * rzo + row) * 32 + slot] = ra;
    }
};
template <int MODE> struct EpiRope {
    bf16_t* O; long ldc; const int* pos; const f32x2* tab;
    EPI_NO_ROW_BEGIN EPI_NO_ROW_END
    DI float oct(int, int, int row, int col, f32x4 lo, f32x4 hi, float) const {
        bool rope; int j0;
        if (MODE == 0) { rope = col < 2 * DIFF_W; j0 = col & 63; } else { const int c = col % 192; rope = c >= 128; j0 = c - 128; }
        if (rope) {
            int p = pos[row]; p = p < 0 ? 0 : (p > ROPE_POS - 1 ? ROPE_POS - 1 : p);
            const f32x4* tp = (const f32x4*)(tab + (size_t)p * 32 + (j0 >> 1));
            const f32x4 t0 = tp[0], t1 = tp[1];
            f32x4 a = lo, b = hi;
            lo[0] = a[0] * t0[0] - a[1] * t0[1]; lo[1] = a[1] * t0[0] + a[0] * t0[1];
            lo[2] = a[2] * t0[2] - a[3] * t0[3]; lo[3] = a[3] * t0[2] + a[2] * t0[3];
            hi[0] = b[0] * t1[0] - b[1] * t1[1]; hi[1] = b[1] * t1[0] + b[0] * t1[1];
            hi[2] = b[2] * t1[2] - b[3] * t1[3]; hi[3] = b[3] * t1[2] + b[2] * t1[3];
        }
        u32x4 w; w.x = pk2(lo[0], lo[1]); w.y = pk2(lo[2], lo[3]); w.z = pk2(hi[0], hi[1]); w.w = pk2(hi[2], hi[3]);
        *(u32x4*)(O + (size_t)row * ldc + col) = w; return 0.f;
    }
};
struct EpiGlu {
    const bf16_t* gbuf; const float* bias; bf16_t* out;
    EPI_NO_ROW_BEGIN EPI_NO_ROW_END
    DI float oct(int, int, int row, int col, f32x4 lo, f32x4 hi, float) const {
        const u32x4 gv = *(const u32x4*)(gbuf + (size_t)row * S5_W + col);
        const f32x4 b0 = *(const f32x4*)(bias + col), b1 = *(const f32x4*)(bias + col + 4);
        float g[8] = {bflo(gv.x), bfhi(gv.x), bflo(gv.y), bfhi(gv.y), bflo(gv.z), bfhi(gv.z), bflo(gv.w), bfhi(gv.w)};
        float a[8] = {lo[0] + b0[0], lo[1] + b0[1], lo[2] + b0[2], lo[3] + b0[3], hi[0] + b1[0], hi[1] + b1[1], hi[2] + b1[2], hi[3] + b1[3]};
        float r[8];
#pragma unroll
        for (int j = 0; j < 8; ++j) r[j] = g[j] / (1.0f + __expf(-a[j]));
        u32x4 w; w.x = pk2(r[0], r[1]); w.y = pk2(r[2], r[3]); w.z = pk2(r[4], r[5]); w.w = pk2(r[6], r[7]);
        *(u32x4*)(out + (size_t)row * DM + DIFF_W + col) = w; return 0.f;
    }
};
struct EpiNull { EPI_NO_ROW_BEGIN EPI_NO_ROW_END DI float oct(int, int, int, int, f32x4 lo, f32x4 hi, float) const { asm volatile("" :: "v"(lo), "v"(hi)); return 0.f; } };
struct Params {
    const float* in[39];
    float* out; unsigned char* ws;
    int ph_lo, ph_hi;
};
enum { I_X = 0, I_MEM, I_POS, I_AB_NORM, I_AB_WIN, I_AB_WOUT, I_LQ1, I_LK1, I_LQ2, I_LK2, I_SUBLN, I_S5_ARE, I_S5_AIM, I_S5_LOGSTEP, I_S5_BRE, I_S5_BIM, I_S5_CRE, I_S5_CIM, I_S5_D,
       I_S5_WGLU, I_S5_BGLU, I_MLA_NORM, I_MLA_WIN, I_MLA_QNORM, I_MLA_KVNORM, I_MLA_WUQ, I_MLA_WUKV, I_MLA_WO, I_XA_NORM, I_XA_MEMNORM, I_XA_WQ, I_XA_WKV, I_XA_WO, I_FFN_NORM,
       I_PEER_WQ, I_PEER_SK, I_PEER_U, I_PEER_V, I_FINAL_NORM };

struct Ctx { LAS unsigned char* lds; int tid, lane, wave, blk, G; };
DI Ctx fresh(const Ctx& C0) { Ctx C = C0; C.tid = opaque_tid(); C.lane = C.tid & 63; return C; }

DI void rms_rows_2048(const Ctx& C0, const float* src, const float* gain, bf16_t* dst, int nrows) {
    const Ctx C = fresh(C0);
    for (int r = C.blk * NWAVES + C.wave; r < nrows; r += C.G * NWAVES) {
        const f32x4* xr = (const f32x4*)(src + (size_t)r * DM) + C.lane;
        f32x4 v[8]; float ss = 0.f;
#pragma unroll
        for (int j = 0; j < 8; ++j) { v[j] = xr[64 * j]; ss += (v[j][0] * v[j][0] + v[j][1] * v[j][1]) + (v[j][2] * v[j][2] + v[j][3] * v[j][3]); }
        const float sc = rsqrtf(wave_sum(ss) * (1.0f / DM) + NORM_EPS);
        u32x2* o = (u32x2*)(dst + (size_t)r * DM) + C.lane;
#pragma unroll
        for (int j = 0; j < 8; ++j) { const f32x4 g = *((const f32x4*)gain + C.lane + 64 * j);
            u32x2 w; w.x = pk2(v[j][0] * sc * g[0], v[j][1] * sc * g[1]); w.y = pk2(v[j][2] * sc * g[2], v[j][3] * sc * g[3]); o[64 * j] = w; }
    }
}
DI void rms_rows_final(const Ctx& C0, const bf16_t* xbp, float* out, const float* gain, int nrows) {
    const Ctx C = fresh(C0);
    for (int r = C.blk * NWAVES + C.wave; r < nrows; r += C.G * NWAVES) {
        const u32x2* xr = (const u32x2*)(xbp + (size_t)r * DM) + C.lane;
        f32x4 v[8]; float ss = 0.f;
#pragma unroll
        for (int j = 0; j < 8; ++j) { const u32x2 w = xr[64 * j]; v[j] = (f32x4){bflo(w.x), bfhi(w.x), bflo(w.y), bfhi(w.y)}; ss += (v[j][0] * v[j][0] + v[j][1] * v[j][1]) + (v[j][2] * v[j][2] + v[j][3] * v[j][3]); }
        const float sc = rsqrtf(wave_sum(ss) * (1.0f / DM) + NORM_EPS);
        f32x4* o = (f32x4*)(out + (size_t)r * DM) + C.lane;
#pragma unroll
        for (int j = 0; j < 8; ++j) { const f32x4 g = *((const f32x4*)gain + C.lane + 64 * j); o[64 * j] = v[j] * sc * g; }
    }
}

DI int srccol(int kind, int n) {
    if (kind == 1) { if (n < 2 * DIFF_W) { const int j = n & 63; return (n & ~63) + (j >> 1) + 32 * (j & 1); } return n; }
    if (kind == 2) { if (n >= MLA_IN) return -1; if (n >= 1024) { const int j = n - 1024; return 1024 + (j >> 1) + 32 * (j & 1); } return n; }
    if (kind == 3) { const int c = n % 192; if (c >= 128) { const int j = c - 128; return n - c + 128 + (j >> 1) + 32 * (j & 1); } return n; }
    return n;
}
DI void transpose_item(const float* W, int K, int Nsrc, bf16_t* Wt, int nblk, int kind, const float* kgain, LAS float* scr, int item, int lane) {
    const int kb = item / nblk, nb = item % nblk, k0 = 64 * kb, n0 = 32 * nb;
    const int src = srccol(kind, n0 + (lane & 31));
#pragma unroll 8
    for (int i = 0; i < 32; ++i) { const int kk = 2 * i + (lane >> 5); scr[kk * 33 + (lane & 31)] = (src >= 0) ? W[(size_t)(k0 + kk) * Nsrc + src] * (kgain ? kgain[k0 + kk] : 1.0f) : 0.f; }
    LDS_WAIT(); asm volatile("" ::: "memory");
    const int c = lane & 7;
#pragma unroll
    for (int j = 0; j < 4; ++j) { const int n = (lane >> 3) + 8 * j; const LAS float* s = scr + (8 * c) * 33 + n;
        u32x4 o; o.x = pk2(s[0 * 33], s[1 * 33]); o.y = pk2(s[2 * 33], s[3 * 33]); o.z = pk2(s[4 * 33], s[5 * 33]); o.w = pk2(s[6 * 33], s[7 * 33]);
        *(u32x4*)(Wt + (size_t)(n0 + n) * K + k0 + 8 * c) = o; }
    LDS_WAIT(); asm volatile("" ::: "memory");
}
DI void cvt_bf16(const Ctx& C0, const float* src, bf16_t* dst, size_t n8) {
    const Ctx C = fresh(C0);
    for (size_t i = (size_t)C.blk * NTHREADS + C.tid; i < n8; i += (size_t)C.G * NTHREADS) {
        const f32x4 a = *(const f32x4*)(src + i * 8), b = *(const f32x4*)(src + i * 8 + 4);
        u32x4 w; w.x = pk2(a[0], a[1]); w.y = pk2(a[2], a[3]); w.z = pk2(b[0], b[1]); w.w = pk2(b[2], b[3]);
        *(u32x4*)(dst + i * 8) = w;
    }
}


DI void cvt_fp8_rows(const Ctx& C0, const float* src, unsigned char* dst, float* isc, int nrows) {
    const Ctx C = fresh(C0);
    for (int r = C.blk * NWAVES + C.wave; r < nrows; r += C.G * NWAVES) {
        const f32x4* xr = (const f32x4*)(src + (size_t)r * DM) + C.lane;
        f32x4 v[8]; float am = 0.f;
#pragma unroll
        for (int j = 0; j < 8; ++j) { v[j] = xr[64 * j]; am = fmaxf(am, fmaxf(fmaxf(fabsf(v[j][0]), fabsf(v[j][1])), fmaxf(fabsf(v[j][2]), fabsf(v[j][3])))); }
#pragma unroll
        for (int o = 1; o < 64; o <<= 1) am = fmaxf(am, __shfl_xor(am, o));
        const float e = am > 0.f ? floorf(log2f(448.0f / am)) : 0.f;
        const float scale = exp2f(e);
        if (C.lane == 0) isc[r] = exp2f(-e);
#if PEER_SLICED
        unsigned* o = (unsigned*)(dst + (size_t)(C.lane >> 5) * ((size_t)PEER_NE * 128) + (size_t)r * 128) + (C.lane & 31);
#pragma unroll
        for (int j = 0; j < 8; ++j) { int w = 0; w = __builtin_amdgcn_cvt_pk_fp8_f32(v[j][0] * scale, v[j][1] * scale, w, false); w = __builtin_amdgcn_cvt_pk_fp8_f32(v[j][2] * scale, v[j][3] * scale, w, true); o[(size_t)2 * j * (PEER_NE * 128 / 4)] = (unsigned)w; }
#else
        unsigned* o = (unsigned*)(dst + (size_t)r * DM) + C.lane;
#pragma unroll
        for (int j = 0; j < 8; ++j) { int w = 0; w = __builtin_amdgcn_cvt_pk_fp8_f32(v[j][0] * scale, v[j][1] * scale, w, false); w = __builtin_amdgcn_cvt_pk_fp8_f32(v[j][2] * scale, v[j][3] * scale, w, true); o[64 * j] = (unsigned)w; }
#endif
    }
}


DI void cvt_i8_rows(const Ctx& C0, const float* src, const float* cgain, unsigned char* dst, float* isc, int nrows) {
    const Ctx C = fresh(C0);
    for (int r = C.blk * NWAVES + C.wave; r < nrows; r += C.G * NWAVES) {
        const f32x4* xr = (const f32x4*)(src + (size_t)r * DM) + C.lane;
        f32x4 v[8]; float am = 0.f;
#pragma unroll
        for (int j = 0; j < 8; ++j) { v[j] = xr[64 * j] * *((const f32x4*)cgain + C.lane + 64 * j); am = fmaxf(am, fmaxf(fmaxf(fabsf(v[j][0]), fabsf(v[j][1])), fmaxf(fabsf(v[j][2]), fabsf(v[j][3])))); }
#pragma unroll
        for (int o = 1; o < 64; o <<= 1) am = fmaxf(am, __shfl_xor(am, o));
        const float scale = am > 0.f ? 127.0f / am : 0.f;
        if (C.lane == 0) isc[r] = am * (1.0f / 127.0f);
        unsigned* o = (unsigned*)(dst + (size_t)(C.lane >> 5) * ((size_t)PEER_NE * 128) + (size_t)r * 128) + (C.lane & 31);
#pragma unroll
        for (int j = 0; j < 8; ++j) { const int q0 = (int)rintf(v[j][0] * scale), q1 = (int)rintf(v[j][1] * scale), q2 = (int)rintf(v[j][2] * scale), q3 = (int)rintf(v[j][3] * scale);
            o[(size_t)2 * j * (PEER_NE * 128 / 4)] = (unsigned)(q0 & 255) | ((unsigned)(q1 & 255) << 8) | ((unsigned)(q2 & 255) << 16) | ((unsigned)(q3 & 255) << 24); }
    }
}

DI void convert_tables(const Ctx& C, const Params& P, int l) {
    unsigned char* ws = P.ws;
#if PEER_FP8
#if PEER_SLICED
    cvt_i8_rows(C, P.in[I_PEER_U] + (size_t)l * PEER_NE * DM, P.in[I_FFN_NORM] + l * DM, ws + P_UT, (float*)(ws + P_UT + 32 * MiB), PEER_NE);
#else
    cvt_fp8_rows(C, P.in[I_PEER_U] + (size_t)l * PEER_NE * DM, ws + P_UT, (float*)(ws + P_UT + 32 * MiB), PEER_NE);
#endif
    cvt_fp8_rows(C, P.in[I_PEER_V] + (size_t)l * PEER_NE * DM, ws + P_VT, (float*)(ws + P_VT + 32 * MiB), PEER_NE);
#else
    cvt_bf16(C, P.in[I_PEER_U] + (size_t)l * PEER_NE * DM, (bf16_t*)(ws + P_UT), (size_t)PEER_NE * DM / 8);
    cvt_bf16(C, P.in[I_PEER_V] + (size_t)l * PEER_NE * DM, (bf16_t*)(ws + P_VT), (size_t)PEER_NE * DM / 8);
#endif
}

DI void phase_prologue(const Ctx& C0, const Params& P) {
    const Ctx C = fresh(C0);
    unsigned char* ws = P.ws;
    LAS float* scr = (LAS float*)(C.lds + C.wave * 8448);
    const int gw = C.blk * NWAVES + C.wave, NGW = C.G * NWAVES;
    int base = 0;
#define TJOB(Wp, K_, Nsrc_, Nout_, kind_, dst_, kg_) do { const int nblk_ = (Nout_) / 32, nit_ = ((K_) / 64) * nblk_; \
        int first_ = (gw - base % NGW + NGW) % NGW; \
        for (int it = first_; it < nit_; it += NGW) transpose_item((Wp), (K_), (Nsrc_), (bf16_t*)(dst_), nblk_, (kind_), (kg_), scr, it, C.lane); base += nit_; } while (0)
    TJOB(P.in[I_AB_WIN], DM, AB_IN, AB_IN, 1, ws + WS_ABIN_T, nullptr);
    TJOB(P.in[I_AB_WOUT], DM, DM, DM, 0, ws + WS_ABOUT_T, nullptr);
    TJOB(P.in[I_S5_WGLU], S5_W, S5_W, S5_W, 0, ws + WS_GLU_T, nullptr);
    TJOB(P.in[I_MLA_WIN], DM, MLA_IN, MLA_IN_PAD, 2, ws + WS_MLAIN_T, P.in[I_MLA_NORM]);
    TJOB(P.in[I_MLA_WUQ], MLA_QR, 3072, 3072, 3, ws + WS_UQ_T, nullptr);
    TJOB(P.in[I_MLA_WUKV], MLA_KVR, 4096, 4096, 0, ws + WS_UKV_T, nullptr);
    TJOB(P.in[I_MLA_WO], DM, DM, DM, 0, ws + WS_MLAO_T, nullptr);
    for (int l = 0; l < 2; ++l) {
        TJOB(P.in[I_XA_WKV] + (size_t)l * DM * 2 * DM, DM, 2 * DM, 2 * DM, 0, ws + WS_LW + l * LW_STRIDE + LW_XKV, nullptr);
        TJOB(P.in[I_XA_WO] + (size_t)l * DM * DM, DM, DM, DM, 0, ws + WS_LW + l * LW_STRIDE + LW_XO, nullptr);
    }
#undef TJOB
    {
        f32x2* tab = (f32x2*)(ws + WS_ROPE);
        for (int i = C.blk * NTHREADS + C.tid; i < ROPE_POS * 32; i += C.G * NTHREADS) {
            const int p = i >> 5, f = i & 31;
            const float inv = powf(10000.0f, -(float)f * (2.0f / 64.0f));
            const float ang = (float)p * inv;
            tab[i] = (f32x2){(float)cos((double)ang), (float)sin((double)ang)};
        }
    }
    for (int l = 0; l < 2; ++l) {
        const float* src = P.in[I_XA_WQ] + (size_t)l * DM * DM; bf16_t* dst = (bf16_t*)(ws + WS_LW + l * LW_STRIDE + LW_XQ);
        for (size_t i = (size_t)C.blk * NTHREADS + C.tid; i < (size_t)DM * DM / 8; i += (size_t)C.G * NTHREADS) {
            const float g = P.in[I_XA_NORM][l * DM + i / (DM / 8)];
            const f32x4 a = *(const f32x4*)(src + i * 8), b = *(const f32x4*)(src + i * 8 + 4);
            u32x4 w; w.x = pk2(a[0] * g, a[1] * g); w.y = pk2(a[2] * g, a[3] * g); w.z = pk2(b[0] * g, b[1] * g); w.w = pk2(b[2] * g, b[3] * g);
            *(u32x4*)(dst + i * 8) = w;
        }
    }
    {
        const float* src = P.in[I_PEER_WQ]; bf16_t* dst = (bf16_t*)(ws + P_WQB);
        for (size_t i = (size_t)C.blk * NTHREADS + C.tid; i < (size_t)2 * DM * DM / 8; i += (size_t)C.G * NTHREADS) {
            const float g = P.in[I_FFN_NORM][i / (DM / 8)];
            const f32x4 a = *(const f32x4*)(src + i * 8), b = *(const f32x4*)(src + i * 8 + 4);
            u32x4 w; w.x = pk2(a[0] * g, a[1] * g); w.y = pk2(a[2] * g, a[3] * g); w.z = pk2(b[0] * g, b[1] * g); w.w = pk2(b[2] * g, b[3] * g);
            *(u32x4*)(dst + i * 8) = w;
        }
    }
    {
        bf16_t* sk = (bf16_t*)(ws + P_SK); const float* skin = P.in[I_PEER_SK];
        for (int i = C.blk * NTHREADS + C.tid; i < 2 * 8 * 256 * 256 / 8; i += C.G * NTHREADS) {
            const int q8 = (i & 31) * 8, np = (i >> 5) & 255, lh = i >> 13;
            const int c = np >> 7, n = np & 127, c2 = q8 >> 7, q = q8 & 127;
            u32x4 w = {0u, 0u, 0u, 0u};
            if (c == c2) { const float* s = skin + ((((size_t)lh * 2 + c) * 128 + n) * 128 + q);
                const f32x4 a = *(const f32x4*)s, b = *(const f32x4*)(s + 4);
                w.x = pk2(a[0], a[1]); w.y = pk2(a[2], a[3]); w.z = pk2(b[0], b[1]); w.w = pk2(b[2], b[3]); }
            *(u32x4*)(sk + (size_t)i * 8) = w;
        }
    }
    convert_tables(C, P, 0);
    for (int l = 0; l < 2; ++l) rms_rows_2048(C, P.in[I_MEM], P.in[I_XA_MEMNORM] + l * DM, (bf16_t*)(ws + P_MEMN) + (size_t)l * MT * DM, MT);
}

DI void phase_s5(const Ctx& C0, const Params& P, int first, int last, int stride_w, int stride) {
    const Ctx C = fresh(C0);
    unsigned char* ws = P.ws;
    const bf16_t* proj = (const bf16_t*)(ws + P_PROJ); bf16_t* gbuf = (bf16_t*)(ws + P_GBUF);
    LAS unsigned char* my = C.lds + C.wave * 8192;
    LAS float* U = (LAS float*)my;
    LAS bf16_t* H = (LAS bf16_t*)(my + 1024);
    const int lane = C.lane, n = lane;
    for (int task = first + C.wave * stride_w; task < last; task += stride) {
        const int b = task >> 5, g = task & 31;
        const float a_re = P.in[I_S5_ARE][g * 64 + n], a_im = P.in[I_S5_AIM][g * 64 + n];
        const float step = expf(P.in[I_S5_LOGSTEP][g]);
        const float mag = expf(a_re * step);
        const float ab_re = mag * cosf(a_im * step), ab_im = mag * sinf(a_im * step);
        const float den = a_re * a_re + a_im * a_im, num_re = ab_re - 1.0f;
        const float f_re = (num_re * a_re + ab_im * a_im) / den, f_im = (ab_im * a_re - num_re * a_im) / den;
        float bbr[16], bbi[16];
        {
            const float* br = P.in[I_S5_BRE] + ((size_t)g * 64 + n) * 16; const float* bi = P.in[I_S5_BIM] + ((size_t)g * 64 + n) * 16;
#pragma unroll
            for (int p = 0; p < 16; ++p) { const float x = br[p], y = bi[p]; bbr[p] = f_re * x - f_im * y; bbi[p] = f_re * y + f_im * x; }
        }
        bf16x8 cf[4];
        {
            const int p = lane & 15, kq = lane >> 4;
#pragma unroll
            for (int kk = 0; kk < 4; ++kk) {
                const int k = 32 * kk + 8 * kq; const bool im = k >= 64;
                const float* src = (im ? P.in[I_S5_CIM] : P.in[I_S5_CRE]) + ((size_t)g * 16 + p) * 64 + (k & 63);
                const float sg = im ? -1.f : 1.f;
                const f32x4 a = *(const f32x4*)src, bq = *(const f32x4*)(src + 4);
                u32x4 w; w.x = pk2(sg * a[0], sg * a[1]); w.y = pk2(sg * a[2], sg * a[3]); w.z = pk2(sg * bq[0], sg * bq[1]); w.w = pk2(sg * bq[2], sg * bq[3]);
                cf[kk] = __builtin_bit_cast(bf16x8, w);
            }
        }
        const float dcoef = P.in[I_S5_D][g * 16 + (lane & 15)];
        float h_re = 0.f, h_im = 0.f;
        const bf16_t* ub = proj + (size_t)b * SEQ * AB_IN + 3 * DIFF_W + g * 16;
        for (int s0 = 0; s0 < SEQ; s0 += 16) {
            {
                const int st = lane >> 2, pp = (lane & 3) * 4;
                const u32x2 uv = *(const u32x2*)(ub + (size_t)(s0 + st) * AB_IN + pp);
                *(LAS f32x4*)(U + st * 16 + pp) = (f32x4){bflo(uv.x), bfhi(uv.x), bflo(uv.y), bfhi(uv.y)};
            }
            LDS_WAIT(); asm volatile("" ::: "memory");
#pragma unroll 4
            for (int st = 0; st < 16; ++st) {
                const f32x4 u0 = *(const LAS f32x4*)(U + st * 16), u1 = *(const LAS f32x4*)(U + st * 16 + 4), u2 = *(const LAS f32x4*)(U + st * 16 + 8), u3 = *(const LAS f32x4*)(U + st * 16 + 12);
                const float uu[16] = {u0[0], u0[1], u0[2], u0[3], u1[0], u1[1], u1[2], u1[3], u2[0], u2[1], u2[2], u2[3], u3[0], u3[1], u3[2], u3[3]};
                float br = 0.f, bi = 0.f;
#pragma unroll
                for (int p = 0; p < 16; ++p) { br = fmaf(bbr[p], uu[p], br); bi = fmaf(bbi[p], uu[p], bi); }
                const float nr = ab_re * h_re - ab_im * h_im + br, ni = ab_re * h_im + ab_im * h_re + bi;
                h_re = nr; h_im = ni;
                H[st * 136 + n] = f2bf(h_re); H[st * 136 + 64 + n] = f2bf(h_im);
            }
            LDS_WAIT(); asm volatile("" ::: "memory");
            f32x4 acc = {0.f, 0.f, 0.f, 0.f};
#pragma unroll
            for (int kk = 0; kk < 4; ++kk) {
                const bf16x8 af = *(const LAS bf16x8*)((LAS unsigned char*)H + (lane & 15) * 272 + (32 * kk + 8 * (lane >> 4)) * 2);
                acc = __builtin_amdgcn_mfma_f32_16x16x32_bf16(af, cf[kk], acc, 0, 0, 0);
            }
#pragma unroll
            for (int r = 0; r < 4; ++r) {
                const int st = (lane >> 4) * 4 + r, p = lane & 15;
                const float y = acc[r] + dcoef * U[st * 16 + p];
                gbuf[(size_t)(b * SEQ + s0 + st) * S5_W + g * 16 + p] = f2bf(gelu_erf(y));
            }
            LDS_WAIT(); asm volatile("" ::: "memory");
        }
    }
}

struct AttnArgs { const bf16_t* Qn; const bf16_t* Qr; const bf16_t* Kn; const bf16_t* Kr; const bf16_t* V; int ldq, ldkn, ldkr, ldv; };
DI int crow(int r, int hi) { return (r & 3) + 8 * (r >> 2) + 4 * hi; }
template <int DK> DI int koff(int row, int ch) { return DK == 64 ? row * 128 + 16 * (ch ^ ((row >> 1) & 7)) : row * 256 + 16 * (ch ^ (row & 15)); }
DI int voff(int row, int ch) { return 256 * row + 16 * (ch ^ (((row & 3) << 2) | ((row >> 2) & 3))); }
DI bf16x8 pack8(const f32x16& p, int s) {
    u32x4 w; w.x = pk2(p[8 * s + 0], p[8 * s + 1]); w.y = pk2(p[8 * s + 2], p[8 * s + 3]); w.z = pk2(p[8 * s + 4], p[8 * s + 5]); w.w = pk2(p[8 * s + 6], p[8 * s + 7]);
    return __builtin_bit_cast(bf16x8, w);
}
DI s16x4 vtr(const LAS unsigned char* p) { return __builtin_bit_cast(s16x4, __builtin_amdgcn_ds_read_tr16_b64_v4i16((LAS s16x4*)p)); }

template <int DKN, int DKR>
DI void attn_core(const AttnArgs& a, int q0, LAS unsigned char* lds, float scale, f32x16 (&o)[4], int mode = 0) {
    const int tid = opaque_tid(), wid = __builtin_amdgcn_readfirstlane(tid >> 6), lane = tid & 63, r32 = lane & 31, hi = lane >> 5;
    constexpr int CN = DKN / 8, NLK = CN * 64 / NTHREADS, KNB = 64 * DKN * 2, KRB = 64 * DKR * 2, KSZ = KNB + KRB, VBASE = 2 * KSZ, VSZ = 16384;
    constexpr int KG = DKR ? 2 : 4;
    static_assert(VBASE + 3 * VSZ <= RING_BYTES, "attention LDS");
    const bool late = wid >= 4;
    bf16x8 qn[DKN / 16]; bf16x8 qr[DKR ? DKR / 16 : 1];
    {
        const bf16_t* qp = a.Qn + (size_t)(q0 + 32 * wid + r32) * a.ldq + hi * 8;
#pragma unroll
        for (int d0 = 0; d0 < DKN / 16; ++d0) qn[d0] = *(const bf16x8*)(qp + d0 * 16);
        if (DKR) { const bf16_t* qp2 = a.Qr + (size_t)(q0 + 32 * wid + r32) * a.ldq + hi * 8;
#pragma unroll
            for (int d0 = 0; d0 < DKR / 16; ++d0) qr[d0] = *(const bf16x8*)(qp2 + d0 * 16); }
    }
    const int NT = (q0 + 256) / 64, NTw = (q0 + 32 * wid + 31) / 64 + 1;
    u32x4 skn[NLK], skr, sv[2];
#define AT_LOAD(t) do { _Pragma("unroll") for (int i_ = 0; i_ < NLK; ++i_) { const int id_ = tid + NTHREADS * i_, row_ = id_ / CN, ch_ = id_ % CN; \
            skn[i_] = *(const u32x4*)(a.Kn + (size_t)((t) * 64 + row_) * a.ldkn + ch_ * 8); } \
        if (DKR) { const int row_ = tid >> 3, ch_ = tid & 7; skr = *(const u32x4*)(a.Kr + (size_t)((t) * 64 + row_) * a.ldkr + ch_ * 8); } \
        _Pragma("unroll") for (int i_ = 0; i_ < 2; ++i_) { const int id_ = tid + NTHREADS * i_, row_ = id_ >> 4, ch_ = id_ & 15; \
            sv[i_] = *(const u32x4*)(a.V + (size_t)((t) * 64 + row_) * a.ldv + ch_ * 8); } } while (0)
#define AT_WRITE(kbuf, vbuf) do { LAS unsigned char* kb_ = lds + (kbuf) * KSZ; LAS unsigned char* vb_ = lds + VBASE + (vbuf) * VSZ; \
        _Pragma("unroll") for (int i_ = 0; i_ < NLK; ++i_) { const int id_ = tid + NTHREADS * i_, row_ = id_ / CN, ch_ = id_ % CN; *(LAS u32x4*)(kb_ + koff<DKN>(row_, ch_)) = skn[i_]; } \
        if (DKR) { const int row_ = tid >> 3, ch_ = tid & 7; *(LAS u32x4*)(kb_ + KNB + koff<64>(row_, ch_)) = skr; } \
        _Pragma("unroll") for (int i_ = 0; i_ < 2; ++i_) { const int id_ = tid + NTHREADS * i_, row_ = id_ >> 4, ch_ = id_ & 15; *(LAS u32x4*)(vb_ + voff(row_, ch_)) = sv[i_]; } } while (0)
    const float Cs = scale * 1.4426950408889634f;
    float m_run = -1e30f, l_run = 0.f;
#pragma unroll
    for (int blk = 0; blk < 4; ++blk)
#pragma unroll
        for (int r = 0; r < 16; ++r) o[blk][r] = 0.f;
    bf16x8 pb[4];
#pragma unroll
    for (int i = 0; i < 4; ++i) pb[i] = (bf16x8){0, 0, 0, 0, 0, 0, 0, 0};
#define AT_PV(vbuf) do { const LAS unsigned char* vbase_ = lds + VBASE + (vbuf) * VSZ; \
        int lanev_ = lane; asm volatile("" : "+v"(lanev_));       \
        int vb_[4][2]; { const int i_ = lanev_ & 15, q_ = i_ >> 2, p_ = i_ & 3, grp1_ = (lanev_ >> 4) & 1, hv_ = lanev_ >> 5, low2_ = 2 * grp1_ + (p_ >> 1); \
            _Pragma("unroll") for (int blk = 0; blk < 4; ++blk) _Pragma("unroll") for (int x = 0; x < 2; ++x) vb_[blk][x] = 256 * (8 * x + 4 * hv_ + q_) + 16 * (4 * (blk ^ q_) + (low2_ ^ (hv_ + 2 * x))) + 8 * (p_ & 1); } \
        s16x4 lo_[2][4], hh_[2][4]; \
        _Pragma("unroll") for (int ks = 0; ks < 4; ++ks) { lo_[0][ks] = vtr(vbase_ + vb_[0][0] + 4096 * ks); hh_[0][ks] = vtr(vbase_ + vb_[0][1] + 4096 * ks); } \
        _Pragma("unroll") for (int blk = 0; blk < 4; ++blk) { \
            if (blk + 1 < 4) { _Pragma("unroll") for (int ks = 0; ks < 4; ++ks) { lo_[(blk + 1) & 1][ks] = vtr(vbase_ + vb_[blk + 1][0] + 4096 * ks); hh_[(blk + 1) & 1][ks] = vtr(vbase_ + vb_[blk + 1][1] + 4096 * ks); } } \
            _Pragma("unroll") for (int ks = 0; ks < 4; ++ks) { const s16x4 l_ = lo_[blk & 1][ks], h_ = hh_[blk & 1][ks]; \
                const bf16x8 af_ = {l_[0], l_[1], l_[2], l_[3], h_[0], h_[1], h_[2], h_[3]}; \
                o[blk] = __builtin_amdgcn_mfma_f32_32x32x16_bf16(af_, pb[ks], o[blk], 0, 0, 0); } \
            __builtin_amdgcn_sched_barrier(0); } } while (0)
    AT_LOAD(0); AT_WRITE(0, 0);
#pragma unroll
    for (int d0 = 0; d0 < DKN / 16; ++d0) asm volatile("" : "+v"(qn[d0]));
    if (DKR) {
#pragma unroll
        for (int d0 = 0; d0 < DKR / 16; ++d0) asm volatile("" : "+v"(qr[d0]));
    }
    if (NT > 1) AT_LOAD(1);
    int vcur = 0, vprev = 2, vnext = 1;
    for (int t = 0; t < NT; ++t) {
        if (mode != 5) __syncthreads();
        if (t + 1 < NT && mode != 2) AT_WRITE((t + 1) & 1, vnext);
        if (t + 2 < NT && mode != 1) AT_LOAD(t + 2);
        if (late && t >= 1 && t - 1 < NTw && mode != 3) AT_PV(vprev);
        if (t < NTw) {
            const LAS unsigned char* base = lds + (t & 1) * KSZ;
            int r32v = r32; asm volatile("" : "+v"(r32v));
            f32x16 p0, p1;
#pragma unroll
            for (int r = 0; r < 16; ++r) { p0[r] = 0.f; p1[r] = 0.f; }
            {
                constexpr int NDN = DKN / 16, NDT = NDN + DKR / 16;
#pragma unroll
                for (int g0 = 0; g0 < NDT; g0 += KG) {
                    bf16x8 kb0[KG], kb1[KG];
#pragma unroll
                    for (int i = 0; i < KG; ++i) { const int dd = g0 + i;
                        if (dd < NDN) { kb0[i] = *(const LAS bf16x8*)(base + koff<DKN>(r32v, 2 * dd + hi)); kb1[i] = *(const LAS bf16x8*)(base + koff<DKN>(32 + r32v, 2 * dd + hi)); }
                        else { kb0[i] = *(const LAS bf16x8*)(base + KNB + koff<64>(r32v, 2 * (dd - NDN) + hi)); kb1[i] = *(const LAS bf16x8*)(base + KNB + koff<64>(32 + r32v, 2 * (dd - NDN) + hi)); } }
#pragma unroll
                    for (int i = 0; i < KG; ++i) asm volatile("" : "+v"(kb0[i]), "+v"(kb1[i]));
#pragma unroll
                    for (int i = 0; i < KG; ++i) { const int dd = g0 + i;
                        const bf16x8 qf = dd < NDN ? qn[dd < NDN ? dd : 0] : qr[dd >= NDN ? dd - NDN : 0];
                        p0 = __builtin_amdgcn_mfma_f32_32x32x16_bf16(kb0[i], qf, p0, 0, 0, 0); p1 = __builtin_amdgcn_mfma_f32_32x32x16_bf16(kb1[i], qf, p1, 0, 0, 0); }
                }
            }
            if (t == NTw - 1) {
                const int qrel = q0 + 32 * wid + r32 - 64 * t;
#pragma unroll
                for (int r = 0; r < 16; ++r) { const int kv = crow(r, hi); if (kv > qrel) p0[r] = -INFINITY; if (kv + 32 > qrel) p1[r] = -INFINITY; }
            }
            float pmax = p0[0];
#pragma unroll
            for (int r = 1; r < 16; ++r) pmax = fmaxf(pmax, p0[r]);
#pragma unroll
            for (int r = 0; r < 16; ++r) pmax = fmaxf(pmax, p1[r]);
            pmax = swap32_max(pmax);
            const float mn = fmaxf(m_run, pmax);
            const float alpha = __builtin_amdgcn_exp2f((m_run - mn) * Cs);
            m_run = mn;
            const float mnC = -mn * Cs;
            float ps = 0.f;
#pragma unroll
            for (int r = 0; r < 16; ++r) { if (mode != 4) { p0[r] = __builtin_amdgcn_exp2f(fmaf(p0[r], Cs, mnC)); p1[r] = __builtin_amdgcn_exp2f(fmaf(p1[r], Cs, mnC)); } ps += p0[r] + p1[r]; }
            l_run = l_run * alpha + ps;
            if (!__all(alpha == 1.0f)) {
#pragma unroll
                for (int blk = 0; blk < 4; ++blk)
#pragma unroll
                    for (int r = 0; r < 16; ++r) o[blk][r] *= alpha;
            }
            pb[0] = pack8(p0, 0); pb[1] = pack8(p0, 1); pb[2] = pack8(p1, 0); pb[3] = pack8(p1, 1);
            if (!late && mode != 3) AT_PV(vcur);
        }
        { const int tmp = vprev; vprev = vcur; vcur = vnext; vnext = tmp; }
    }
    if (late && NTw == NT && mode != 3) AT_PV(vprev);
    __syncthreads();
    const float linv = 1.0f / swap32_sum(l_run);
#pragma unroll
    for (int blk = 0; blk < 4; ++blk)
#pragma unroll
        for (int r = 0; r < 16; ++r) o[blk][r] *= linv;
#undef AT_LOAD
#undef AT_WRITE
#undef AT_PV
}
DI void attn_store(const f32x16 (&o)[4], bf16_t* dst, int ld, int q0) {
    const int tid = opaque_tid(), wid = tid >> 6, lane = tid & 63, r32 = lane & 31, hi = lane >> 5;
    bf16_t* rp = dst + (size_t)(q0 + 32 * wid + r32) * ld;
#pragma unroll
    for (int blk = 0; blk < 4; ++blk)
#pragma unroll
        for (int g = 0; g < 4; ++g) {
            u32x2 w; w.x = pk2(o[blk][4 * g], o[blk][4 * g + 1]); w.y = pk2(o[blk][4 * g + 2], o[blk][4 * g + 3]);
            *(u32x2*)(rp + 32 * blk + 8 * g + 4 * hi) = w;
        }
}
DI int queue_pop(const Ctx& C0, unsigned* ctr, int total) {
    const Ctx C = fresh(C0);
    volatile LAS int* slot = (volatile LAS int*)(C.lds + LDSCTL_OFF + 64);
    __syncthreads();
    if (C.tid == 0) *slot = (int)__hip_atomic_fetch_add(ctr, 1u, __ATOMIC_RELAXED, __HIP_MEMORY_SCOPE_AGENT);
    __syncthreads();
    const int u = *slot;
    return u < total ? u : -1;
}
DI float diff_lambda(const Params& P) {
    float s1 = 0.f, s2 = 0.f;
    for (int i = 0; i < 64; ++i) { s1 += P.in[I_LQ1][i] * P.in[I_LK1][i]; s2 += P.in[I_LQ2][i] * P.in[I_LK2][i]; }
    return expf(s1) - expf(s2) + 0.2f;
}

#if FAST_ATTN
DI void phase_diff_attn(const Ctx& C0, const Params& P, int qi) {
    const Ctx C = fresh(C0);
    unsigned char* ws = P.ws;
    const bf16_t* proj = (const bf16_t*)(ws + P_PROJ); bf16_t* concat = (bf16_t*)(ws + P_CONCAT);
    unsigned* ctr = (unsigned*)(ws + WS_CTL) + CW_CTR + 64 * qi;
    const float lam = diff_lambda(P);
    const int NBH = BATCH * DIFF_HEADS, NS5 = BATCH * 32 / NWAVES, total = NS5 + NBH * 8;
    const int lane = C.lane, r32 = lane & 31, hi = lane >> 5;
    for (;;) {
        int u = queue_pop(C, ctr, total); if (u < 0) break;
        if (u < NS5) { phase_s5(C, P, u * NWAVES, u * NWAVES + NWAVES, 1, NWAVES); continue; }
        u -= NS5;
        const int qb = 7 - u / NBH, bh = u % NBH, b = bh / DIFF_HEADS, h = bh % DIFF_HEADS;
        const bf16_t* base = proj + (size_t)b * SEQ * AB_IN;
        AttnArgs a; a.ldq = AB_IN; a.ldkn = AB_IN; a.ldkr = 0; a.ldv = AB_IN; a.Qr = nullptr; a.Kr = nullptr;
        a.V = base + 2 * DIFF_W + h * 128;
        f32x16 o2[4];
        bf16_t* dst = concat + (size_t)b * SEQ * DM + h * 128;
        a.Qn = base + h * 128; a.Kn = base + DIFF_W + h * 128;
        attn_core<64, 0>(a, qb * 256, C.lds, 0.125f, o2, qi >= 2 ? PROBE_ATTN_MODE : 0);
        attn_store(o2, dst, DM, qb * 256);
        a.Qn = base + h * 128 + 64; a.Kn = base + DIFF_W + h * 128 + 64;
        attn_core<64, 0>(a, qb * 256, C.lds, 0.125f, o2, qi >= 2 ? PROBE_ATTN_MODE : 0);
        float ss = 0.f;
        {
            const bf16_t* rp = dst + (size_t)(qb * 256 + 32 * C.wave + r32) * DM;
#pragma unroll
            for (int blk = 0; blk < 4; ++blk)
#pragma unroll
                for (int g = 0; g < 4; ++g) {
                    const u32x2 w = *(const u32x2*)(rp + 32 * blk + 8 * g + 4 * hi);
                    const float o1v[4] = {bflo(w.x), bfhi(w.x), bflo(w.y), bfhi(w.y)};
#pragma unroll
                    for (int j = 0; j < 4; ++j) { const float v = o1v[j] - lam * o2[blk][4 * g + j]; o2[blk][4 * g + j] = v; ss += v * v; }
                }
        }
        ss = swap32_sum(ss);
        const float rs = rsqrtf(ss * (1.0f / 128.0f) + NORM_EPS) * 0.8f;
        const float* sub = P.in[I_SUBLN];
#pragma unroll
        for (int blk = 0; blk < 4; ++blk)
#pragma unroll
            for (int r = 0; r < 16; ++r) o2[blk][r] *= rs * sub[32 * blk + crow(r, hi)];
        attn_store(o2, dst, DM, qb * 256);
    }
}
DI void phase_mla_attn(const Ctx& C0, const Params& P, int qi) {
    const Ctx C = fresh(C0);
    unsigned char* ws = P.ws;
    const bf16_t* q = (const bf16_t*)(ws + P_Q); const bf16_t* kv = (const bf16_t*)(ws + P_KV); const bf16_t* kr = (const bf16_t*)(ws + P_KROPE);
    bf16_t* ob = (bf16_t*)(ws + P_H);
    unsigned* ctr = (unsigned*)(ws + WS_CTL) + CW_CTR + 64 * qi;
    const int NBH = BATCH * MLA_HEADS, total = NBH * 8;
    for (;;) {
        const int u = queue_pop(C, ctr, total); if (u < 0) break;
        const int qb = 7 - u / NBH, bh = u % NBH, b = bh / MLA_HEADS, h = bh % MLA_HEADS;
        AttnArgs a; a.ldq = 3072; a.ldkn = 4096; a.ldkr = 64; a.ldv = 4096;
        a.Qn = q + (size_t)b * SEQ * 3072 + h * 192; a.Qr = a.Qn + 128;
        a.Kn = kv + (size_t)b * SEQ * 4096 + h * 256; a.V = a.Kn + 128; a.Kr = kr + (size_t)b * SEQ * 64;
        f32x16 o[4];
        attn_core<128, 64>(a, qb * 256, C.lds, 0.07216878364870322f, o, qi >= 2 ? PROBE_ATTN_MODE : 0);
        attn_store(o, ob + (size_t)b * SEQ * DM + h * 128, DM, qb * 256);
    }
}
#else
template <int DK> DI void naive_attn_row(const bf16_t* qrow, const bf16_t* qrow2, const bf16_t* Kn, int ldkn, const bf16_t* Kr, int ldkr, const bf16_t* V, int ldv, int nkeys, float scale, int lane, float& o0, float& o1) {
    float qv[3];
#pragma unroll
    for (int j = 0; j < 3; ++j) { const int d = lane + 64 * j; qv[j] = 0.f; if (d < DK) qv[j] = (DK == 192 && d >= 128) ? bf2f(qrow2[d - 128]) : bf2f(qrow[d]); }
    float m = -1e30f, l = 0.f; o0 = 0.f; o1 = 0.f;
    for (int k = 0; k < nkeys; ++k) {
        float s = 0.f;
#pragma unroll
        for (int j = 0; j < 3; ++j) { const int d = lane + 64 * j; if (d < DK) { const float kvv = (DK == 192 && d >= 128) ? bf2f(Kr[(size_t)k * ldkr + d - 128]) : bf2f(Kn[(size_t)k * ldkn + d]); s += qv[j] * kvv; } }
        s = wave_sum(s) * scale;
        const float mn = fmaxf(m, s), al = expf(m - mn), p = expf(s - mn);
        m = mn; l = l * al + p;
        o0 = o0 * al + p * bf2f(V[(size_t)k * ldv + lane]); o1 = o1 * al + p * bf2f(V[(size_t)k * ldv + 64 + lane]);
    }
    o0 /= l; o1 /= l;
}
DI void phase_diff_attn(const Ctx& C, const Params& P, int) {
    unsigned char* ws = P.ws;
    const bf16_t* proj = (const bf16_t*)(ws + P_PROJ); bf16_t* concat = (bf16_t*)(ws + P_CONCAT);
    const float lam = diff_lambda(P);
    const int lane = C.lane;
    for (int it = C.blk * NWAVES + C.wave; it < BATCH * DIFF_HEADS * SEQ; it += C.G * NWAVES) {
        const int s = it % SEQ, bh = it / SEQ, b = bh / DIFF_HEADS, h = bh % DIFF_HEADS;
        const bf16_t* base = proj + (size_t)b * SEQ * AB_IN;
        const bf16_t* qrow = base + (size_t)s * AB_IN + h * 128;
        float a0, a1, b0, b1;
        naive_attn_row<64>(qrow, nullptr, base + DIFF_W + h * 128, AB_IN, nullptr, 0, base + 2 * DIFF_W + h * 128, AB_IN, s + 1, 0.125f, lane, a0, a1);
        naive_attn_row<64>(qrow + 64, nullptr, base + DIFF_W + h * 128 + 64, AB_IN, nullptr, 0, base + 2 * DIFF_W + h * 128, AB_IN, s + 1, 0.125f, lane, b0, b1);
        const float v0 = a0 - lam * b0, v1 = a1 - lam * b1;
        const float ss = wave_sum(v0 * v0 + v1 * v1);
        const float rs = rsqrtf(ss * (1.0f / 128.0f) + NORM_EPS) * 0.8f;
        bf16_t* orow = concat + (size_t)(b * SEQ + s) * DM + h * 128;
        orow[lane] = f2bf(v0 * rs * P.in[I_SUBLN][lane]); orow[64 + lane] = f2bf(v1 * rs * P.in[I_SUBLN][64 + lane]);
    }
}
DI void phase_mla_attn(const Ctx& C, const Params& P, int) {
    unsigned char* ws = P.ws;
    const bf16_t* q = (const bf16_t*)(ws + P_Q); const bf16_t* kv = (const bf16_t*)(ws + P_KV); const bf16_t* kr = (const bf16_t*)(ws + P_KROPE);
    bf16_t* ob = (bf16_t*)(ws + P_H);
    const int lane = C.lane;
    for (int it = C.blk * NWAVES + C.wave; it < BATCH * MLA_HEADS * SEQ; it += C.G * NWAVES) {
        const int s = it % SEQ, bh = it / SEQ, b = bh / MLA_HEADS, h = bh % MLA_HEADS;
        const bf16_t* qrow = q + (size_t)(b * SEQ + s) * 3072 + h * 192;
        const bf16_t* kn = kv + (size_t)b * SEQ * 4096 + h * 256;
        float a0, a1;
        naive_attn_row<192>(qrow, qrow + 128, kn, 4096, kr + (size_t)b * SEQ * 64, 64, kn + 128, 4096, s + 1, 0.07216878364870322f, lane, a0, a1);
        bf16_t* orow = ob + (size_t)(b * SEQ + s) * DM + h * 128;
        orow[lane] = f2bf(a0); orow[64 + lane] = f2bf(a1);
    }
}
#endif

DI void phase_mla_rows(const Ctx& C0, const Params& P) {
    const Ctx C = fresh(C0);
    unsigned char* ws = P.ws;
    const bf16_t* mp = (const bf16_t*)(ws + P_MLAPROJ); bf16_t* cqn = (bf16_t*)(ws + P_CQN); bf16_t* ckvn = (bf16_t*)(ws + P_CKVN); bf16_t* krp = (bf16_t*)(ws + P_KROPE);
    const f32x2* tab = (const f32x2*)(ws + WS_ROPE);
    const int lane = C.lane;
    for (int r = C.blk * NWAVES + C.wave; r < T; r += C.G * NWAVES) {
        const bf16_t* row = mp + (size_t)r * MLA_IN_PAD;
        float v[12]; float ss = 0.f;
#pragma unroll
        for (int j = 0; j < 3; ++j) { const u32x2 w = *(const u32x2*)(row + 4 * (lane + 64 * j)); v[4 * j] = bflo(w.x); v[4 * j + 1] = bfhi(w.x); v[4 * j + 2] = bflo(w.y); v[4 * j + 3] = bfhi(w.y); }
#pragma unroll
        for (int j = 0; j < 12; ++j) ss += v[j] * v[j];
        float sc = rsqrtf(wave_sum(ss) * (1.0f / MLA_QR) + NORM_EPS);
#pragma unroll
        for (int j = 0; j < 3; ++j) { const f32x4 g = *(const f32x4*)(P.in[I_MLA_QNORM] + 4 * (lane + 64 * j));
            u32x2 w; w.x = pk2(v[4 * j] * sc * g[0], v[4 * j + 1] * sc * g[1]); w.y = pk2(v[4 * j + 2] * sc * g[2], v[4 * j + 3] * sc * g[3]);
            *(u32x2*)(cqn + (size_t)r * MLA_QR + 4 * (lane + 64 * j)) = w; }
        {
            const u32x2 w = *(const u32x2*)(row + MLA_QR + 4 * lane);
            const float a0 = bflo(w.x), a1 = bfhi(w.x), a2 = bflo(w.y), a3 = bfhi(w.y);
            const float s2 = rsqrtf(wave_sum(a0 * a0 + a1 * a1 + a2 * a2 + a3 * a3) * (1.0f / MLA_KVR) + NORM_EPS);
            const f32x4 g = *(const f32x4*)(P.in[I_MLA_KVNORM] + 4 * lane);
            u32x2 o; o.x = pk2(a0 * s2 * g[0], a1 * s2 * g[1]); o.y = pk2(a2 * s2 * g[2], a3 * s2 * g[3]);
            *(u32x2*)(ckvn + (size_t)r * MLA_KVR + 4 * lane) = o;
        }
        if (lane < 32) {
            const unsigned w = *(const unsigned*)(row + 1024 + 2 * lane);
            int p = ((const int*)P.in[I_POS])[r]; p = p < 0 ? 0 : (p > ROPE_POS - 1 ? ROPE_POS - 1 : p);
            const f32x2 cs = tab[(size_t)p * 32 + lane];
            const float x1 = bflo(w), x2 = bfhi(w);
            *(unsigned*)(krp + (size_t)r * 64 + 2 * lane) = pk2(x1 * cs[0] - x2 * cs[1], x2 * cs[0] + x1 * cs[1]);
        }
    }
}

DI void phase_xa_softmax(const Ctx& C0, const Params& P) {
    const Ctx C = fresh(C0);
    unsigned char* ws = P.ws;
    const bf16_t* S = (const bf16_t*)(ws + P_S); bf16_t* Pb = (bf16_t*)(ws + P_P);
    const int lane = C.lane, hd = lane >> 4, li = lane & 15;
    for (int r = C.blk * NWAVES + C.wave; r < T; r += C.G * NWAVES) {
        const bf16_t* row = S + (size_t)r * 1024 + hd * 256;
        f32x4 v[4]; float mx = -1e30f;
#pragma unroll
        for (int j = 0; j < 4; ++j) { const u32x2 w = *(const u32x2*)(row + 4 * (li + 16 * j)); v[j] = (f32x4){bflo(w.x), bfhi(w.x), bflo(w.y), bfhi(w.y)}; mx = fmaxf(mx, fmaxf(fmaxf(v[j][0], v[j][1]), fmaxf(v[j][2], v[j][3]))); }
#pragma unroll
        for (int o = 1; o < 16; o <<= 1) mx = fmaxf(mx, __shfl_xor(mx, o));
        float sm = 0.f;
#pragma unroll
        for (int j = 0; j < 4; ++j) { v[j][0] = __expf(v[j][0] - mx); v[j][1] = __expf(v[j][1] - mx); v[j][2] = __expf(v[j][2] - mx); v[j][3] = __expf(v[j][3] - mx); sm += (v[j][0] + v[j][1]) + (v[j][2] + v[j][3]); }
#pragma unroll
        for (int o = 1; o < 16; o <<= 1) sm += __shfl_xor(sm, o);
        const float inv = 1.0f / sm;
        bf16_t* orow = Pb + (size_t)r * 1024 + hd * 256;
#pragma unroll
        for (int j = 0; j < 4; ++j) { u32x2 w; w.x = pk2(v[j][0] * inv, v[j][1] * inv); w.y = pk2(v[j][2] * inv, v[j][3] * inv); *(u32x2*)(orow + 4 * (li + 16 * j)) = w; }
    }
}

template <bool STORE> DI void phase_peer(const Ctx& C0, const Params& P) {
    const Ctx C = fresh(C0);
    unsigned char* ws = P.ws;
    const bf16_t* sc = (const bf16_t*)(ws + P_SC); const bf16_t* hb = (const bf16_t*)(ws + P_H);
    const bf16_t* ut = (const bf16_t*)(ws + P_UT); const bf16_t* vt = (const bf16_t*)(ws + P_VT);
    float* xo = P.out;
    LAS unsigned char* my = C.lds + C.wave * 4096;
    LAS float* top_s = (LAS float*)my;
    LAS int* top_i = (LAS int*)(my + 1024);
    LAS int* best_e = (LAS int*)(my + 2048);
    LAS float* best_g = (LAS float*)(my + 2560);
    LAS float* best_s = (LAS float*)(my + 3072);
    LAS int* best_p = (LAS int*)(my + 3584);
    const int lane = C.lane;
    for (int tok = C.blk * NWAVES + C.wave; tok < T; tok += C.G * NWAVES) {
        for (int rep = 0; rep < (PROBE == 6 ? 2 : 1); ++rep) {
        {
            const int g = lane >> 2, qd = lane & 3;
            unsigned k[32];
            const u32x4* sp = (const u32x4*)(sc + (size_t)tok * 2048 + g * 128 + qd * 32);
#pragma unroll
            for (int j = 0; j < 8; ++j) { const u32x4 xw = sp[j >> 1]; const unsigned wa = (j & 1) ? xw.z : xw.x, wb = (j & 1) ? xw.w : xw.y; const f32x4 x = {bflo(wa), bfhi(wa), bflo(wb), bfhi(wb)};
#pragma unroll
                for (int e = 0; e < 4; ++e) { unsigned u = __float_as_uint(x[e]); u ^= (unsigned)((int)u >> 31) | 0x80000000u; k[4 * j + e] = (u & ~127u) | (unsigned)(127 - (32 * qd + 4 * j + e)); } }
#pragma unroll
            for (int r = 0; r < 16; ++r) {
                unsigned m = k[0];
#pragma unroll
                for (int j = 1; j < 32; ++j) m = m > k[j] ? m : k[j];
                { const unsigned o1 = (unsigned)__shfl_xor((int)m, 1); m = m > o1 ? m : o1; const unsigned o2 = (unsigned)__shfl_xor((int)m, 2); m = m > o2 ? m : o2; }
                if (qd == 0) top_i[g * 16 + r] = 127 - (int)(m & 127u);
#pragma unroll
                for (int j = 0; j < 32; ++j) k[j] = (k[j] == m) ? 0u : k[j];
            }
        }
        LDS_WAIT(); asm volatile("" ::: "memory");
#pragma unroll
        for (int i = 0; i < 4; ++i) { const int e = lane + 64 * i; top_s[e] = bf2f(sc[(size_t)tok * 2048 + (e >> 4) * 128 + top_i[e]]); }
        LDS_WAIT(); asm volatile("" ::: "memory");
        {
            const int h = lane >> 3, sub = lane & 7;
            unsigned k[32];
            const float s00 = top_s[(2 * h) * 16 + 2 * sub], s01 = top_s[(2 * h) * 16 + 2 * sub + 1];
#pragma unroll
            for (int k2 = 0; k2 < 16; ++k2) { const float s1 = top_s[(2 * h + 1) * 16 + k2];
                unsigned u0 = __float_as_uint(s00 + s1), u1 = __float_as_uint(s01 + s1);
                u0 ^= (unsigned)((int)u0 >> 31) | 0x80000000u; u1 ^= (unsigned)((int)u1 >> 31) | 0x80000000u;
                k[k2] = (u0 & ~255u) | (unsigned)(255 - (32 * sub + k2)); k[16 + k2] = (u1 & ~255u) | (unsigned)(255 - (32 * sub + 16 + k2)); }
#pragma unroll
            for (int r = 0; r < 16; ++r) {
                unsigned m = k[0];
#pragma unroll
                for (int j = 1; j < 32; ++j) m = m > k[j] ? m : k[j];
                { const unsigned o1 = (unsigned)__shfl_xor((int)m, 1); m = m > o1 ? m : o1; const unsigned o2 = (unsigned)__shfl_xor((int)m, 2); m = m > o2 ? m : o2; const unsigned o4 = (unsigned)__shfl_xor((int)m, 4); m = m > o4 ? m : o4; }
                if (sub == 0) best_p[h * 16 + r] = 255 - (int)(m & 255u);
#pragma unroll
                for (int j = 0; j < 32; ++j) k[j] = (k[j] == m) ? 0u : k[j];
            }
        }
        LDS_WAIT(); asm volatile("" ::: "memory");
#pragma unroll
        for (int e2 = 0; e2 < 2; ++e2) { const int idx = lane + 64 * e2, h = idx >> 4, pos = best_p[idx]; best_s[idx] = top_s[(2 * h) * 16 + (pos >> 4)] + top_s[(2 * h + 1) * 16 + (pos & 15)]; }
        LDS_WAIT(); asm volatile("" ::: "memory");
#pragma unroll
        for (int e2 = 0; e2 < 2; ++e2) {
            const int idx = lane + 64 * e2, h = idx >> 4;
            float mx = -1e30f;
            for (int k = 0; k < 16; ++k) mx = fmaxf(mx, best_s[h * 16 + k]);
            float sm = 0.f;
            for (int k = 0; k < 16; ++k) sm += __expf(best_s[h * 16 + k] - mx);
            const float gate = __expf(best_s[idx] - mx) / sm;
            const int pos = best_p[idx], k1 = pos >> 4, k2 = pos & 15;
            best_e[idx] = top_i[(2 * h) * 16 + k1] * 128 + top_i[(2 * h + 1) * 16 + k2];
            best_g[idx] = gate;
        }
        LDS_WAIT(); asm volatile("" ::: "memory");
        }
#if PEER_SLICED
        {
            int* pe = (int*)(ws + P_PE_E) + (size_t)tok * 128; float* pg = (float*)(ws + P_PE_G) + (size_t)tok * 128;
            pe[lane] = best_e[lane]; pe[64 + lane] = best_e[64 + lane]; pg[lane] = best_g[lane]; pg[64 + lane] = best_g[64 + lane];
            const u32x4* tp = (const u32x4*)((const bf16_t*)(ws + P_XB) + (size_t)tok * DM + 32 * lane);
            u32x4 tw[4]; float am = 0.f;
#pragma unroll
            for (int i = 0; i < 4; ++i) { tw[i] = tp[i]; const unsigned w4[4] = {tw[i].x, tw[i].y, tw[i].z, tw[i].w};
#pragma unroll
                for (int q = 0; q < 4; ++q) am = fmaxf(am, fmaxf(fabsf(bflo(w4[q])), fabsf(bfhi(w4[q])))); }
#pragma unroll
            for (int o = 1; o < 64; o <<= 1) am = fmaxf(am, __shfl_xor(am, o));
            const float tscale = am > 0.f ? 127.0f / am : 0.f;
            if (lane == 0) ((float*)(ws + P_PE_TSC))[tok] = am * (1.0f / 127.0f) * row_rstd<32>((const float*)(ws + P_SS), tok);
            unsigned qd[8];
#pragma unroll
            for (int i = 0; i < 4; ++i) { const unsigned w4[4] = {tw[i].x, tw[i].y, tw[i].z, tw[i].w};
#pragma unroll
                for (int h2 = 0; h2 < 2; ++h2) { const int q0 = (int)rintf(bflo(w4[2 * h2]) * tscale), q1 = (int)rintf(bfhi(w4[2 * h2]) * tscale), q2 = (int)rintf(bflo(w4[2 * h2 + 1]) * tscale), q3 = (int)rintf(bfhi(w4[2 * h2 + 1]) * tscale);
                    qd[2 * i + h2] = (unsigned)(q0 & 255) | ((unsigned)(q1 & 255) << 8) | ((unsigned)(q2 & 255) << 16) | ((unsigned)(q3 & 255) << 24); } }
            u32x4* t8p = (u32x4*)(ws + P_PE_T8 + (size_t)tok * DM + 32 * lane);
            t8p[0] = (u32x4){qd[0], qd[1], qd[2], qd[3]}; t8p[1] = (u32x4){qd[4], qd[5], qd[6], qd[7]};
        }
#else
#if PEER_FP8
        float tf[32];
#pragma unroll
        for (int i = 0; i < 2; ++i) { const u32x4* tp = (const u32x4*)(hb + (size_t)tok * DM + 16 * (lane + 64 * i));
            const u32x4 a = tp[0], b = tp[1];
            tf[16 * i + 0] = bflo(a.x); tf[16 * i + 1] = bfhi(a.x); tf[16 * i + 2] = bflo(a.y); tf[16 * i + 3] = bfhi(a.y); tf[16 * i + 4] = bflo(a.z); tf[16 * i + 5] = bfhi(a.z); tf[16 * i + 6] = bflo(a.w); tf[16 * i + 7] = bfhi(a.w);
            tf[16 * i + 8] = bflo(b.x); tf[16 * i + 9] = bfhi(b.x); tf[16 * i + 10] = bflo(b.y); tf[16 * i + 11] = bfhi(b.y); tf[16 * i + 12] = bflo(b.z); tf[16 * i + 13] = bfhi(b.z); tf[16 * i + 14] = bflo(b.w); tf[16 * i + 15] = bfhi(b.w); }
        const unsigned char* ut8 = (const unsigned char*)ut; const unsigned char* vt8 = (const unsigned char*)vt;
        const float* usc = (const float*)(ut8 + 32 * MiB); const float* vsc = (const float*)(vt8 + 32 * MiB);
        for (int k0 = 0; k0 < 128; k0 += 8) {
            u32x4 rw[8][2];
#pragma unroll
            for (int kk = 0; kk < 8; ++kk) { const int e = __builtin_amdgcn_readfirstlane(best_e[k0 + kk]); const unsigned char* rp = ut8 + (size_t)e * DM;
#pragma unroll
                for (int i = 0; i < 2; ++i) rw[kk][i] = *(const u32x4*)(rp + 16 * (lane + 64 * i)); }
            float d[8];
#pragma unroll
            for (int kk = 0; kk < 8; ++kk) { float s0 = 0.f, s1 = 0.f;
#pragma unroll
                for (int i = 0; i < 2; ++i) {
                    const unsigned w4[4] = {rw[kk][i].x, rw[kk][i].y, rw[kk][i].z, rw[kk][i].w};
#pragma unroll
                    for (int q = 0; q < 4; ++q) { const f32x2 lo = __builtin_amdgcn_cvt_pk_f32_fp8((int)w4[q], false), hi2 = __builtin_amdgcn_cvt_pk_f32_fp8((int)w4[q], true);
                        s0 = fmaf(lo[0], tf[16 * i + 4 * q], s0); s1 = fmaf(lo[1], tf[16 * i + 4 * q + 1], s1); s0 = fmaf(hi2[0], tf[16 * i + 4 * q + 2], s0); s1 = fmaf(hi2[1], tf[16 * i + 4 * q + 3], s1); }
                }
                d[kk] = s0 + s1; }
            float n4[4], n2[2], r1;
            { const bool b0 = lane & 1;
#pragma unroll
              for (int j = 0; j < 4; ++j) { const float snd = b0 ? d[j] : d[4 + j], kp = b0 ? d[4 + j] : d[j]; n4[j] = kp + __shfl_xor(snd, 1); } }
            { const bool b1 = lane & 2;
#pragma unroll
              for (int j = 0; j < 2; ++j) { const float snd = b1 ? n4[j] : n4[2 + j], kp = b1 ? n4[2 + j] : n4[j]; n2[j] = kp + __shfl_xor(snd, 2); } }
            { const bool b2 = lane & 4; const float snd = b2 ? n2[0] : n2[1], kp = b2 ? n2[1] : n2[0]; r1 = kp + __shfl_xor(snd, 4); }
            r1 += __shfl_xor(r1, 8); r1 += __shfl_xor(r1, 16); r1 += __shfl_xor(r1, 32);
            if (lane < 8) { const int idx = k0 + 4 * (lane & 1) + 2 * ((lane >> 1) & 1) + ((lane >> 2) & 1); const float act = r1 * usc[best_e[idx]]; best_g[idx] *= gelu_erf(act); }
        }
        LDS_WAIT(); asm volatile("" ::: "memory");
        float acc[32];
#pragma unroll
        for (int j = 0; j < 32; ++j) acc[j] = 0.f;
        for (int k0 = 0; k0 < 128; k0 += 8) {
            u32x4 rw[8][2]; float wk[8];
#pragma unroll
            for (int kk = 0; kk < 8; ++kk) { const int e = __builtin_amdgcn_readfirstlane(best_e[k0 + kk]); wk[kk] = best_g[k0 + kk] * vsc[e]; const unsigned char* rp = vt8 + (size_t)e * DM;
#pragma unroll
                for (int i = 0; i < 2; ++i) rw[kk][i] = *(const u32x4*)(rp + 16 * (lane + 64 * i)); }
#pragma unroll
            for (int kk = 0; kk < 8; ++kk)
#pragma unroll
                for (int i = 0; i < 2; ++i) {
                    const unsigned w4[4] = {rw[kk][i].x, rw[kk][i].y, rw[kk][i].z, rw[kk][i].w};
#pragma unroll
                    for (int q = 0; q < 4; ++q) { const f32x2 lo = __builtin_amdgcn_cvt_pk_f32_fp8((int)w4[q], false), hi2 = __builtin_amdgcn_cvt_pk_f32_fp8((int)w4[q], true);
                        acc[16 * i + 4 * q] = fmaf(wk[kk], lo[0], acc[16 * i + 4 * q]); acc[16 * i + 4 * q + 1] = fmaf(wk[kk], lo[1], acc[16 * i + 4 * q + 1]);
                        acc[16 * i + 4 * q + 2] = fmaf(wk[kk], hi2[0], acc[16 * i + 4 * q + 2]); acc[16 * i + 4 * q + 3] = fmaf(wk[kk], hi2[1], acc[16 * i + 4 * q + 3]); }
                }
        }
#else
        u32x4 tv[4];
#pragma unroll
        for (int i = 0; i < 4; ++i) tv[i] = *(const u32x4*)(hb + (size_t)tok * DM + 8 * (lane + 64 * i));
        for (int k0 = 0; k0 < 128; k0 += 4) {
            u32x4 rw[4][4];
#pragma unroll
            for (int kk = 0; kk < 4; ++kk) { const int e = __builtin_amdgcn_readfirstlane(best_e[k0 + kk]); const bf16_t* rp = ut + (size_t)e * DM;
#pragma unroll
                for (int i = 0; i < 4; ++i) rw[kk][i] = *(const u32x4*)(rp + 8 * (lane + 64 * i)); }
            float d[4];
#pragma unroll
            for (int kk = 0; kk < 4; ++kk) { float s = 0.f;
#pragma unroll
                for (int i = 0; i < 4; ++i) { s = dot2bf(rw[kk][i].x, tv[i].x, s); s = dot2bf(rw[kk][i].y, tv[i].y, s); s = dot2bf(rw[kk][i].z, tv[i].z, s); s = dot2bf(rw[kk][i].w, tv[i].w, s); }
                d[kk] = wave_sum(s); }
            if (lane < 4) { const float act = lane == 0 ? d[0] : lane == 1 ? d[1] : lane == 2 ? d[2] : d[3]; best_g[k0 + lane] *= gelu_erf(act); }
        }
        LDS_WAIT(); asm volatile("" ::: "memory");
        float acc[32];
#pragma unroll
        for (int j = 0; j < 32; ++j) acc[j] = 0.f;
        for (int k0 = 0; k0 < 128; k0 += 4) {
            u32x4 rw[4][4]; float wk[4];
#pragma unroll
            for (int kk = 0; kk < 4; ++kk) { const int e = __builtin_amdgcn_readfirstlane(best_e[k0 + kk]); wk[kk] = best_g[k0 + kk]; const bf16_t* rp = vt + (size_t)e * DM;
#pragma unroll
                for (int i = 0; i < 4; ++i) rw[kk][i] = *(const u32x4*)(rp + 8 * (lane + 64 * i)); }
#pragma unroll
            for (int kk = 0; kk < 4; ++kk)
#pragma unroll
                for (int i = 0; i < 4; ++i) {
                    acc[8 * i + 0] = fmaf(wk[kk], bflo(rw[kk][i].x), acc[8 * i + 0]); acc[8 * i + 1] = fmaf(wk[kk], bfhi(rw[kk][i].x), acc[8 * i + 1]);
                    acc[8 * i + 2] = fmaf(wk[kk], bflo(rw[kk][i].y), acc[8 * i + 2]); acc[8 * i + 3] = fmaf(wk[kk], bfhi(rw[kk][i].y), acc[8 * i + 3]);
                    acc[8 * i + 4] = fmaf(wk[kk], bflo(rw[kk][i].z), acc[8 * i + 4]); acc[8 * i + 5] = fmaf(wk[kk], bfhi(rw[kk][i].z), acc[8 * i + 5]);
                    acc[8 * i + 6] = fmaf(wk[kk], bflo(rw[kk][i].w), acc[8 * i + 6]); acc[8 * i + 7] = fmaf(wk[kk], bfhi(rw[kk][i].w), acc[8 * i + 7]);
                }
        }
#endif
        float* xr = xo + (size_t)tok * DM;
        if (!STORE) {
#pragma unroll
            for (int j = 0; j < 32; ++j) asm volatile("" :: "v"(acc[j]));
        } else {
#if PEER_FP8
#pragma unroll
            for (int i = 0; i < 2; ++i) { f32x4* p = (f32x4*)(xr + 16 * (lane + 64 * i));
#pragma unroll
                for (int q = 0; q < 4; ++q) { f32x4 a = p[q]; a[0] += acc[16 * i + 4 * q]; a[1] += acc[16 * i + 4 * q + 1]; a[2] += acc[16 * i + 4 * q + 2]; a[3] += acc[16 * i + 4 * q + 3]; p[q] = a; } }
#else
#pragma unroll
            for (int i = 0; i < 4; ++i) { f32x4* p = (f32x4*)(xr + 8 * (lane + 64 * i));
                f32x4 a = p[0], b = p[1];
                a[0] += acc[8 * i]; a[1] += acc[8 * i + 1]; a[2] += acc[8 * i + 2]; a[3] += acc[8 * i + 3];
                b[0] += acc[8 * i + 4]; b[1] += acc[8 * i + 5]; b[2] += acc[8 * i + 6]; b[3] += acc[8 * i + 7];
                p[0] = a; p[1] = b; }
#endif
        }
#endif
        LDS_WAIT(); asm volatile("" ::: "memory");
    }
}


#if PEER_SLICED
DI int peer_cj(int j) { return ((j >> 3) & 1) | (((j >> 2) & 1) << 1) | (((j >> 1) & 1) << 2); }
constexpr int PEER_CHUNK = 512, PEER_NCHUNK = T / PEER_CHUNK;
DI int peer_cjh(int half, int jj) { return half | (((jj >> 2) & 1) << 1) | (((jj >> 1) & 1) << 2); }
#define PEER_ISSUE(RW, ELO, EHI, HALF) do { _Pragma("unroll") for (int jj = 0; jj < 8; ++jj) { \
        const int e_ = __shfl((jj & 1) ? (EHI) : (ELO), (lane & ~7) | peer_cjh((HALF), jj)); \
        RW[jj] = *(const u32x4*)(tabs + (size_t)(MODE == 2 ? (e_ & 1) : e_) * 128); } } while (0)
template <int SIDE  , int MODE = 0  >
DI void phase_peer_sliced(const Ctx& C0, const Params& P, int qbase) {
    const Ctx C = fresh(C0);
    unsigned char* ws = P.ws;
    const bf16_t* hb = (const bf16_t*)(ws + P_H);
    const unsigned char* tab8 = ws + (SIDE == 0 ? P_UT : P_VT);
    const int* pe = (const int*)(ws + P_PE_E); const float* pg = (const float*)(ws + P_PE_G);
    const int lane = C.lane, a = lane >> 3, c = lane & 7;
    const int x = (int)(xb_xcc_id() & 7u);
    for (int i = 0; i < 16; ++i) {
        const int s = ((x + (i >> 1)) & 7) + 8 * (i & 1);
        unsigned* ctr = (unsigned*)(ws + WS_CTL) + CW_CTR + 64 * (qbase + s);
        const unsigned char* tabs = tab8 + (size_t)s * ((size_t)PEER_NE * 128) + 16 * c;
        for (;;) {
            const int ch = queue_pop(C, ctr, PEER_NCHUNK); if (ch < 0) break;
            const int tok0 = ch * PEER_CHUNK + C.wave;
            constexpr int NTOK = PEER_CHUNK / NWAVES;
            u32x4 rwA[8], rwB[8];
            int e_lo = pe[(size_t)tok0 * 128 + lane], e_hi = pe[(size_t)tok0 * 128 + 64 + lane];
            u32x4 ta, tb; float w_lo = 0.f, w_hi = 0.f;
            if (SIDE == 0) { ta = *(const u32x4*)(ws + P_PE_T8 + (size_t)tok0 * DM + s * 128 + 16 * c); tb = ta; }
            else { w_lo = pg[(size_t)tok0 * 128 + lane]; w_hi = pg[(size_t)tok0 * 128 + 64 + lane]; }
            PEER_ISSUE(rwA, e_lo, e_hi, 0);
#pragma unroll 1
            for (int it = 0; it < NTOK; ++it) {
                const int tok = tok0 + NWAVES * it, ntok = (it + 1 < NTOK) ? tok + NWAVES : tok;
                unsigned* xp = (unsigned*)((bf16_t*)(ws + P_XB) + (size_t)tok * DM + s * 128 + 16 * c + 8 * (a & 1) + 4 * ((a >> 1) & 1) + 2 * ((a >> 2) & 1));
                unsigned xw = 0u; if (SIDE == 1) xw = *xp;
                const int ne_lo = pe[(size_t)ntok * 128 + lane], ne_hi = pe[(size_t)ntok * 128 + 64 + lane];
                u32x4 nta, ntb; float nw_lo = 0.f, nw_hi = 0.f;
                if (SIDE == 0) { nta = *(const u32x4*)(ws + P_PE_T8 + (size_t)ntok * DM + s * 128 + 16 * c); ntb = nta; }
                else { nw_lo = pg[(size_t)ntok * 128 + lane]; nw_hi = pg[(size_t)ntok * 128 + 64 + lane]; }
                PEER_ISSUE(rwB, e_lo, e_hi, 1);
                if (SIDE == 0) {
                    int d[16];
#define PEER_DOT(RW, HALF) do { _Pragma("unroll") for (int jj = 0; jj < 8; ++jj) { int s0 = __builtin_amdgcn_sdot4((int)RW[jj].x, (int)ta.x, 0, false); s0 = __builtin_amdgcn_sdot4((int)RW[jj].y, (int)ta.y, s0, false); \
                        s0 = __builtin_amdgcn_sdot4((int)RW[jj].z, (int)ta.z, s0, false); s0 = __builtin_amdgcn_sdot4((int)RW[jj].w, (int)ta.w, s0, false); d[8 * (HALF) + jj] = s0; } } while (0)
                    if (MODE == 1) { _Pragma("unroll") for (int jj = 0; jj < 8; ++jj) { asm volatile("" :: "v"(rwA[jj])); d[jj] = 0; d[8 + jj] = 0; } } else PEER_DOT(rwA, 0);
                    PEER_ISSUE(rwA, ne_lo, ne_hi, 0);
                    if (MODE == 1) { _Pragma("unroll") for (int jj = 0; jj < 8; ++jj) asm volatile("" :: "v"(rwB[jj])); } else PEER_DOT(rwB, 1);
#undef PEER_DOT
                    int n8[8], n4[4], n2[2];
                    { const bool b = c & 1;
#pragma unroll
                      for (int j = 0; j < 8; ++j) { const int snd = b ? d[j] : d[8 + j], kp = b ? d[8 + j] : d[j]; n8[j] = kp + __shfl_xor(snd, 1); } }
                    { const bool b = c & 2;
#pragma unroll
                      for (int j = 0; j < 4; ++j) { const int snd = b ? n8[j] : n8[4 + j], kp = b ? n8[4 + j] : n8[j]; n4[j] = kp + __shfl_xor(snd, 2); } }
                    { const bool b = c & 4;
#pragma unroll
                      for (int j = 0; j < 2; ++j) { const int snd = b ? n4[j] : n4[2 + j], kp = b ? n4[2 + j] : n4[j]; n2[j] = kp + __shfl_xor(snd, 4); } }
                    int* pp = (int*)(ws + P_SC) + ((size_t)s * T + tok) * 128;
                    pp[lane] = n2[0]; pp[64 + lane] = n2[1];
                } else {
                    float acc[16];
#pragma unroll
                    for (int q = 0; q < 16; ++q) acc[q] = 0.f;
#define PEER_AXPY(RW, HALF) do { _Pragma("unroll") for (int jj = 0; jj < 8; ++jj) { const float wj = __shfl((jj & 1) ? w_hi : w_lo, (lane & ~7) | peer_cjh((HALF), jj)); \
                        unsigned w4[4] = {RW[jj].x, RW[jj].y, RW[jj].z, RW[jj].w}; \
                        asm volatile("" : "+v"(w4[0]), "+v"(w4[1]), "+v"(w4[2]), "+v"(w4[3]) : "v"(acc[0]), "v"(acc[15]));     \
                        _Pragma("unroll") for (int q = 0; q < 4; ++q) { const f32x2 lo = __builtin_amdgcn_cvt_pk_f32_fp8((int)w4[q], false), hi2 = __builtin_amdgcn_cvt_pk_f32_fp8((int)w4[q], true); \
                            acc[4 * q] = fmaf(wj, lo[0], acc[4 * q]); acc[4 * q + 1] = fmaf(wj, lo[1], acc[4 * q + 1]); acc[4 * q + 2] = fmaf(wj, hi2[0], acc[4 * q + 2]); acc[4 * q + 3] = fmaf(wj, hi2[1], acc[4 * q + 3]); } } } while (0)
                    if (MODE == 1) { _Pragma("unroll") for (int jj = 0; jj < 8; ++jj) asm volatile("" :: "v"(rwA[jj])); } else PEER_AXPY(rwA, 0);
                    PEER_ISSUE(rwA, ne_lo, ne_hi, 0);
                    if (MODE == 1) { _Pragma("unroll") for (int jj = 0; jj < 8; ++jj) asm volatile("" :: "v"(rwB[jj])); } else PEER_AXPY(rwB, 1);
#undef PEER_AXPY
                    float n8[8], n4[4], n2[2];
                    { const bool b = a & 1;
#pragma unroll
                      for (int q = 0; q < 8; ++q) { const float snd = b ? acc[q] : acc[8 + q], kp = b ? acc[8 + q] : acc[q]; n8[q] = kp + __shfl_xor(snd, 8); } }
                    { const bool b = a & 2;
#pragma unroll
                      for (int q = 0; q < 4; ++q) { const float snd = b ? n8[q] : n8[4 + q], kp = b ? n8[4 + q] : n8[q]; n4[q] = kp + __shfl_xor(snd, 16); } }
                    { const bool b = a & 4;
#pragma unroll
                      for (int q = 0; q < 2; ++q) { const float snd = b ? n4[q] : n4[2 + q], kp = b ? n4[2 + q] : n4[q]; n2[q] = kp + __shfl_xor(snd, 32); } }
                    const unsigned nw = pk2(bflo(xw) + n2[0], bfhi(xw) + n2[1]);
                    if (MODE == 0) { *xp = nw; const float q0 = bflo(nw), q1 = bfhi(nw); const float sq = wave_sum(q0 * q0 + q1 * q1); if (lane == 0) ((float*)(ws + P_SS))[(size_t)tok * 32 + s] = sq; }
                    else asm volatile("" :: "v"(nw));
                }
                e_lo = ne_lo; e_hi = ne_hi;
                if (SIDE == 0) { ta = nta; tb = ntb; } else { w_lo = nw_lo; w_hi = nw_hi; }
            }
        }
    }
}
#undef PEER_ISSUE

DI void phase_peer_combine(const Ctx& C0, const Params& P) {
    const Ctx C = fresh(C0);
    unsigned char* ws = P.ws;
    const float* usc = (const float*)(ws + P_UT + 32 * MiB); const float* vsc = (const float*)(ws + P_VT + 32 * MiB);
    const int* pe = (const int*)(ws + P_PE_E); float* pg = (float*)(ws + P_PE_G); const int* part = (const int*)(ws + P_SC); const float* tsc = (const float*)(ws + P_PE_TSC);
    for (size_t i = (size_t)C.blk * NTHREADS + C.tid; i < (size_t)T * 128; i += (size_t)C.G * NTHREADS) {
        int a = 0;
#pragma unroll
        for (int s = 0; s < 16; ++s) a += part[(size_t)s * T * 128 + i];
        const int e = pe[i];
        pg[i] = pg[i] * gelu_erf((float)a * usc[e] * tsc[i >> 7]) * vsc[e];
    }
}
#endif

constexpr int N_PHASES = 39;
__global__ void __launch_bounds__(NTHREADS, 2) mk_fwd(Params P) {
    extern __shared__ __attribute__((aligned(16))) unsigned char lds_raw[];
    Ctx C; C.lds = (LAS unsigned char*)lds_raw; C.tid = threadIdx.x; C.lane = C.tid & 63; C.wave = __builtin_amdgcn_readfirstlane(C.tid >> 6); C.blk = blockIdx.x; C.G = gridDim.x;
    unsigned char* ws = P.ws;
    for (int u = C.tid; u < (LDS_BYTES - LDSCTL_OFF) / 4; u += NTHREADS) ((LAS unsigned*)(C.lds + LDSCTL_OFF))[u] = 0u;
    __syncthreads();
    XcdBarrier bar; bar.bar = (unsigned*)(ws + WS_CTL) + CW_BAR; bar.x = 0; bar.st = nullptr;
    const bool one = (P.ph_hi - P.ph_lo) > 1;
    if (one) bar = xcd_barrier_post((unsigned*)(ws + WS_CTL) + CW_BAR, (volatile LAS unsigned*)(C.lds + LDSCTL_OFF));
    const int lo = P.ph_lo, hi = P.ph_hi;
#define IN(k) (lo <= (k) && (k) < hi)
#define SEAM(k) do { if (IN(k) && IN((k) + 1)) xcd_barrier(bar); } while (0)
    bf16_t* hbuf = (bf16_t*)(ws + P_H); bf16_t* xb = (bf16_t*)(ws + P_XB); float* ssp = (float*)(ws + P_SS);
    const int* pos = (const int*)P.in[I_POS];
    const f32x2* rtab = (const f32x2*)(ws + WS_ROPE);

    if (IN(0)) { if (EN_PRO) phase_prologue(C, P); rms_rows_2048(C, P.in[I_X], P.in[I_AB_NORM], hbuf, T); } SEAM(0);
    if (IN(1)) {
        {
            g8::Desc g{(const bf16_t*)(ws + P_MEMN), (const bf16_t*)(ws + WS_LW + LW_XKV), DM, DM, DM, MT / 256, 2 * DM / 256, 2, 1, (long)MT * DM, 0, (long)(LW_STRIDE / 2), 0};
            EpiBf16 E{(bf16_t*)(ws + WS_KVX), 2 * DM, (long)(KVX_STRIDE / 2), 0, 1.0f, nullptr, 0};
            g8::gemm(C.lds, g, E, C.G, C.blk);
        }
        {
            g8::Desc g{(const bf16_t*)(ws + P_SK), (const bf16_t*)(ws + P_WQB), 256, DM, 256, 1, DM / 256, 2, 8, 8L * 65536, 65536, (long)DM * DM, 256};
            EpiBf16 E{(bf16_t*)(ws + WS_LW + LW_PEER), DM, (long)(LW_STRIDE / 2), 256L * DM, 1.0f, nullptr, 0};
            if (PROBE == 1) { EpiNull En; g8::gemm(C.lds, g, En, C.G, C.blk); } if (PROBE == 13) g8::gemm(C.lds, g, E, C.G, C.blk); if (GSITE < 0 || GSITE == 3) g8::gemm(C.lds, g, E, C.G, C.blk);
        }
        {
        g8::Desc g{hbuf, (const bf16_t*)(ws + WS_ABIN_T), DM, DM, DM, T / 256, AB_IN / 256, 1, 1, 0, 0, 0, 0};
        EpiRope<0> E{(bf16_t*)(ws + P_PROJ), AB_IN, pos, rtab};
        if (PROBE == 1) { EpiNull En; g8::gemm(C.lds, g, En, C.G, C.blk); } if (PROBE == 13) g8::gemm(C.lds, g, E, C.G, C.blk); if (GSITE < 0 || GSITE == 4) g8::gemm(C.lds, g, E, C.G, C.blk);
        }
    }
    SEAM(1);

    {
        constexpr int l = 0, pb = 2; (void)l;

            if (IN(pb + 3)) { if (EN_DIFF) { if (PROBE == 2) phase_diff_attn(C, P, 2); phase_diff_attn(C, P, 0); } }
            SEAM(pb + 3);
            if (IN(pb + 4)) {
                g8::Desc g{(const bf16_t*)(ws + P_GBUF), (const bf16_t*)(ws + WS_GLU_T), S5_W, S5_W, S5_W, T / 256, S5_W / 256, 1, 1, 0, 0, 0, 0};
                EpiGlu E{(const bf16_t*)(ws + P_GBUF), P.in[I_S5_BGLU], (bf16_t*)(ws + P_CONCAT)};
                if (PROBE == 1) { EpiNull En; g8::gemm(C.lds, g, En, C.G, C.blk); } if (PROBE == 13) g8::gemm(C.lds, g, E, C.G, C.blk); if (GSITE < 0 || GSITE == 5) g8::gemm(C.lds, g, E, C.G, C.blk);
            }
            SEAM(pb + 4);
            if (IN(pb + 5)) {
                g8::Desc g{(const bf16_t*)(ws + P_CONCAT), (const bf16_t*)(ws + WS_ABOUT_T), DM, DM, DM, T / 256, DM / 256, 1, 1, 0, 0, 0, 0};
                EpiResidB<true> E{P.in[I_X], xb, ssp, 0};
                if (PROBE == 1 || PROBE == 13) { EpiNull En; g8::gemm(C.lds, g, En, C.G, C.blk); } if (GSITE < 0 || GSITE == 6) g8::gemm(C.lds, g, E, C.G, C.blk);
            {
                const unsigned char* lwa = ws + WS_LW + (size_t)l * LW_STRIDE; const bf16_t* kvx = (const bf16_t*)(ws + WS_KVX + (size_t)l * KVX_STRIDE);
                {
                    g8::Desc g{kvx, (const bf16_t*)(lwa + LW_XQ), 2 * DM, DM, 512, 1, DM / 256, BATCH, 4, (long)MEM_LEN * 2 * DM, 512, 0, 512};
                    EpiBf16 E{(bf16_t*)(ws + P_WABS), DM, 1024L * DM, 256L * DM, 1.0f, nullptr, 0};
                    g8::gemm(C.lds, g, E, C.G, C.blk);
                }
                {
                    g8::Desc g{(const bf16_t*)(lwa + LW_XO), kvx + DM, DM, 2 * DM, 512, DM / 256, 1, BATCH, 4, 0, 512, (long)MEM_LEN * 2 * DM, 512};
                    EpiBf16 E{(bf16_t*)(ws + P_VW), 1024, (long)DM * 1024, 256, 1.0f, nullptr, 0};
                    g8::gemm(C.lds, g, E, C.G, C.blk);
                }
            }
            }
            SEAM(pb + 5);
    }
    {
        constexpr int l = 0, pb = 2; (void)l;
        const unsigned char* lw = ws + WS_LW + (size_t)l * LW_STRIDE;
        if (IN(pb + 7)) {
            g8::Desc g{xb, (const bf16_t*)(ws + P_WABS), DM, DM, DM, SEQ / 256, 1024 / 256, BATCH, 1, (long)SEQ * DM, 0, 1024L * DM, 0};
            EpiBf16T<32> E{(bf16_t*)(ws + P_S), 1024, (long)SEQ * 1024, 0, 0.04419417382415922f, ssp, SEQ};
            if (PROBE == 1) { EpiNull En; g8::gemm(C.lds, g, En, C.G, C.blk); } if (PROBE == 13) g8::gemm(C.lds, g, E, C.G, C.blk); if (GSITE < 0 || GSITE == 11) g8::gemm(C.lds, g, E, C.G, C.blk);
        }
        SEAM(pb + 7);
        if (IN(pb + 9)) {
            phase_xa_softmax(C, P);
            if (l == 1) {
                convert_tables(C, P, 1);
            }
        }
        SEAM(pb + 9);
        if (IN(pb + 10)) {
            g8::Desc g{(const bf16_t*)(ws + P_P), (const bf16_t*)(ws + P_VW), 1024, 1024, 1024, SEQ / 256, DM / 256, BATCH, 1, (long)SEQ * 1024, 0, (long)DM * 1024, 0};
            EpiResidB<false> E{nullptr, xb, ssp, SEQ};
            if (PROBE == 1 || PROBE == 13) { EpiNull En; g8::gemm(C.lds, g, En, C.G, C.blk); } if (GSITE < 0 || GSITE == 14) g8::gemm(C.lds, g, E, C.G, C.blk);
        }
        SEAM(pb + 10);
        if (IN(pb + 13)) {
            g8::Desc g{xb, (const bf16_t*)(lw + LW_PEER), DM, DM, DM, T / 256, DM / 256, 1, 1, 0, 0, 0, 0};
            EpiBf16T<32> E{(bf16_t*)(ws + P_SC), DM, 0, 0, 1.0f, ssp, 0};
            if (PROBE == 1) { EpiNull En; g8::gemm(C.lds, g, En, C.G, C.blk); } if (PROBE == 13) g8::gemm(C.lds, g, E, C.G, C.blk); if (GSITE < 0 || GSITE == 15) g8::gemm(C.lds, g, E, C.G, C.blk);
        }
        SEAM(pb + 13);
        if (IN(pb + 14)) { if (EN_PEER && EN_TOPK) phase_peer<true>(C, P); }
        SEAM(pb + 14);
#if PEER_SLICED
        if (IN(pb + 15)) { if (EN_PEER && EN_PU) { if (PROBE >= 7 && PROBE <= 9) { phase_peer_sliced<0, PROBE - 7>(C, P, 8 + 32 * l + 64); __syncthreads(); } phase_peer_sliced<0>(C, P, 8 + 32 * l); } }
        SEAM(pb + 15);
        if (IN(pb + 16)) { if (EN_PEER) phase_peer_combine(C, P); }
        SEAM(pb + 16);
        if (IN(pb + 17)) { if (EN_PEER && EN_PV) { if (PROBE >= 10 && PROBE <= 12) { phase_peer_sliced<1, PROBE == 10 ? 3 : PROBE - 10>(C, P, 8 + 32 * l + 80); __syncthreads(); } phase_peer_sliced<1>(C, P, 8 + 32 * l + 16); } }
        SEAM(pb + 17);
#endif
    }
    {
        constexpr int l = 1, pb = 20; (void)l;

            if (IN(pb + 1)) {
                g8::Desc g{xb, (const bf16_t*)(ws + WS_MLAIN_T), DM, DM, DM, T / 256, MLA_IN_PAD / 256, 1, 1, 0, 0, 0, 0};
                EpiBf16T<16> E{(bf16_t*)(ws + P_MLAPROJ), MLA_IN_PAD, 0, 0, 1.0f, ssp, 0};
                if (PROBE == 1) { EpiNull En; g8::gemm(C.lds, g, En, C.G, C.blk); } if (PROBE == 13) g8::gemm(C.lds, g, E, C.G, C.blk); if (GSITE < 0 || GSITE == 7) g8::gemm(C.lds, g, E, C.G, C.blk);
            }
            SEAM(pb + 1);
            if (IN(pb + 2)) { if (PROBE == 5) phase_mla_rows(C, P); phase_mla_rows(C, P); }
            SEAM(pb + 2);
            if (IN(pb + 3)) {
                {
                    g8::Desc g{(const bf16_t*)(ws + P_CQN), (const bf16_t*)(ws + WS_UQ_T), MLA_QR, MLA_QR, MLA_QR, T / 256, 3072 / 256, 1, 1, 0, 0, 0, 0};
                    EpiRope<1> E{(bf16_t*)(ws + P_Q), 3072, pos, rtab};
                    if (PROBE == 1) { EpiNull En; g8::gemm(C.lds, g, En, C.G, C.blk); } if (PROBE == 13) g8::gemm(C.lds, g, E, C.G, C.blk); if (GSITE < 0 || GSITE == 8) g8::gemm(C.lds, g, E, C.G, C.blk);
                }
                {
                    g8::Desc g{(const bf16_t*)(ws + P_CKVN), (const bf16_t*)(ws + WS_UKV_T), MLA_KVR, MLA_KVR, MLA_KVR, T / 256, 4096 / 256, 1, 1, 0, 0, 0, 0};
                    EpiBf16 E{(bf16_t*)(ws + P_KV), 4096, 0, 0, 1.0f, nullptr, 0};
                    if (PROBE == 1) { EpiNull En; g8::gemm(C.lds, g, En, C.G, C.blk); } if (PROBE == 13) g8::gemm(C.lds, g, E, C.G, C.blk); if (GSITE < 0 || GSITE == 9) g8::gemm(C.lds, g, E, C.G, C.blk);
                }
            }
            SEAM(pb + 3);
            if (IN(pb + 4)) { if (EN_MLA) { if (PROBE == 2) phase_mla_attn(C, P, 3); phase_mla_attn(C, P, 1); } }
            SEAM(pb + 4);
            if (IN(pb + 5)) {
                g8::Desc g{hbuf, (const bf16_t*)(ws + WS_MLAO_T), DM, DM, DM, T / 256, DM / 256, 1, 1, 0, 0, 0, 0};
                EpiResidB<false> E{nullptr, xb, ssp, 0};
                if (PROBE == 1 || PROBE == 13) { EpiNull En; g8::gemm(C.lds, g, En, C.G, C.blk); } if (GSITE < 0 || GSITE == 10) g8::gemm(C.lds, g, E, C.G, C.blk);
            {
                const unsigned char* lwa = ws + WS_LW + (size_t)l * LW_STRIDE; const bf16_t* kvx = (const bf16_t*)(ws + WS_KVX + (size_t)l * KVX_STRIDE);
                {
                    g8::Desc g{kvx, (const bf16_t*)(lwa + LW_XQ), 2 * DM, DM, 512, 1, DM / 256, BATCH, 4, (long)MEM_LEN * 2 * DM, 512, 0, 512};
                    EpiBf16 E{(bf16_t*)(ws + P_WABS), DM, 1024L * DM, 256L * DM, 1.0f, nullptr, 0};
                    g8::gemm(C.lds, g, E, C.G, C.blk);
                }
                {
                    g8::Desc g{(const bf16_t*)(lwa + LW_XO), kvx + DM, DM, 2 * DM, 512, DM / 256, 1, BATCH, 4, 0, 512, (long)MEM_LEN * 2 * DM, 512};
                    EpiBf16 E{(bf16_t*)(ws + P_VW), 1024, (long)DM * 1024, 256, 1.0f, nullptr, 0};
                    g8::gemm(C.lds, g, E, C.G, C.blk);
                }
            }
            }
            SEAM(pb + 5);
    }
    {
        constexpr int l = 1, pb = 20; (void)l;
        const unsigned char* lw = ws + WS_LW + (size_t)l * LW_STRIDE;
        if (IN(pb + 7)) {
            g8::Desc g{xb, (const bf16_t*)(ws + P_WABS), DM, DM, DM, SEQ / 256, 1024 / 256, BATCH, 1, (long)SEQ * DM, 0, 1024L * DM, 0};
            EpiBf16T<32> E{(bf16_t*)(ws + P_S), 1024, (long)SEQ * 1024, 0, 0.04419417382415922f, ssp, SEQ};
            if (PROBE == 1) { EpiNull En; g8::gemm(C.lds, g, En, C.G, C.blk); } if (PROBE == 13) g8::gemm(C.lds, g, E, C.G, C.blk); if (GSITE < 0 || GSITE == 11) g8::gemm(C.lds, g, E, C.G, C.blk);
        }
        SEAM(pb + 7);
        if (IN(pb + 9)) {
            phase_xa_softmax(C, P);
            if (l == 1) {
                convert_tables(C, P, 1);
            }
        }
        SEAM(pb + 9);
        if (IN(pb + 10)) {
            g8::Desc g{(const bf16_t*)(ws + P_P), (const bf16_t*)(ws + P_VW), 1024, 1024, 1024, SEQ / 256, DM / 256, BATCH, 1, (long)SEQ * 1024, 0, (long)DM * 1024, 0};
            EpiResidB<false> E{nullptr, xb, ssp, SEQ};
            if (PROBE == 1 || PROBE == 13) { EpiNull En; g8::gemm(C.lds, g, En, C.G, C.blk); } if (GSITE < 0 || GSITE == 14) g8::gemm(C.lds, g, E, C.G, C.blk);
        }
        SEAM(pb + 10);
        if (IN(pb + 13)) {
            g8::Desc g{xb, (const bf16_t*)(lw + LW_PEER), DM, DM, DM, T / 256, DM / 256, 1, 1, 0, 0, 0, 0};
            EpiBf16T<32> E{(bf16_t*)(ws + P_SC), DM, 0, 0, 1.0f, ssp, 0};
            if (PROBE == 1) { EpiNull En; g8::gemm(C.lds, g, En, C.G, C.blk); } if (PROBE == 13) g8::gemm(C.lds, g, E, C.G, C.blk); if (GSITE < 0 || GSITE == 15) g8::gemm(C.lds, g, E, C.G, C.blk);
        }
        SEAM(pb + 13);
        if (IN(pb + 14)) { if (EN_PEER && EN_TOPK) phase_peer<true>(C, P); }
        SEAM(pb + 14);
#if PEER_SLICED
        if (IN(pb + 15)) { if (EN_PEER && EN_PU) { if (PROBE >= 7 && PROBE <= 9) { phase_peer_sliced<0, PROBE - 7>(C, P, 8 + 32 * l + 64); __syncthreads(); } phase_peer_sliced<0>(C, P, 8 + 32 * l); } }
        SEAM(pb + 15);
        if (IN(pb + 16)) { if (EN_PEER) phase_peer_combine(C, P); }
        SEAM(pb + 16);
        if (IN(pb + 17)) { if (EN_PEER && EN_PV) { if (PROBE >= 10 && PROBE <= 12) { phase_peer_sliced<1, PROBE == 10 ? 3 : PROBE - 10>(C, P, 8 + 32 * l + 80); __syncthreads(); } phase_peer_sliced<1>(C, P, 8 + 32 * l + 16); } }
        SEAM(pb + 17);
#endif
    }
    if (IN(38)) rms_rows_final(C, xb, P.out, P.in[I_FINAL_NORM], T);
    if (PROBE == 14 && one) { for (int i = 0; i < 30; ++i) xcd_barrier(bar); }
#undef IN
#undef SEAM
}

extern "C" void kernel_launch(void* const* d_in, const int* in_sizes, int n_in, void* d_out, int out_size, void* d_ws, size_t ws_size, hipStream_t stream) {
    static int grid = 0;
    if (grid == 0) {
        if (n_in != 39 || in_sizes[0] != T * DM || out_size != T * DM || ws_size < WS_END) {
            fprintf(stderr, "kernel_launch: unexpected shapes (n_in %d in0 %d out %d ws %zu, need ws >= %zu); nothing launched\n", n_in, n_in > 0 ? in_sizes[0] : -1, out_size, ws_size, (size_t)WS_END);
            grid = -1; return; }
        int dev = 0, cus = 0;
        if (hipGetDevice(&dev) != hipSuccess || hipDeviceGetAttribute(&cus, hipDeviceAttributeMultiprocessorCount, dev) != hipSuccess) { grid = -1; return; }
        if (hipFuncSetAttribute((const void*)mk_fwd, hipFuncAttributeMaxDynamicSharedMemorySize, LDS_BYTES) != hipSuccess) { fprintf(stderr, "kernel_launch: hipFuncSetAttribute failed\n"); grid = -1; return; }
        int per_cu = 0;
        if (hipOccupancyMaxActiveBlocksPerMultiprocessor(&per_cu, (const void*)mk_fwd, NTHREADS, LDS_BYTES) != hipSuccess || per_cu < 1)
            fprintf(stderr, "kernel_launch: occupancy query reports %d blocks per CU\n", per_cu);
        (void)hipGetLastError();
        grid = cus;
    }
    if (grid < 0) return;
    (void)hipMemsetAsync((char*)d_ws + WS_CTL, 0, CTL_BYTES, stream);
    Params p{};
    for (int i = 0; i < 39; ++i) p.in[i] = (const float*)d_in[i];
    p.out = (float*)d_out; p.ws = (unsigned char*)d_ws;
#if MK_ONE_LAUNCH
    p.ph_lo = 0; p.ph_hi = N_PHASES;
    hipLaunchKernelGGL(mk_fwd, dim3(grid), dim3(NTHREADS), LDS_BYTES, stream, p);
#else
    for (int ph = 0; ph < N_PHASES; ++ph) { p.ph_lo = ph; p.ph_hi = ph + 1; hipLaunchKernelGGL(mk_fwd, dim3(grid), dim3(NTHREADS), LDS_BYTES, stream, p); }
#endif
    const hipError_t le = hipPeekAtLastError();
    if (le != hipSuccess) fprintf(stderr, "kernel_launch: launch failed: %s\n", hipGetErrorName(le));
}
```

```cpp
#include <hip/hip_runtime.h>
#include <cstdio>
#include <cstdint>

#ifndef MK_ONE_LAUNCH
#define MK_ONE_LAUNCH 1
#endif
#ifndef FAST_GEMM
#define FAST_GEMM 1
#endif
#ifndef FAST_ATTN
#define FAST_ATTN 1
#endif

#ifndef EN_TOPK
#define EN_TOPK 1
#endif
#ifndef EN_PU
#define EN_PU 1
#endif
#ifndef EN_PV
#define EN_PV 1
#endif
#ifndef EN_S5
#define EN_S5 1
#endif
#ifndef EN_DIFF
#define EN_DIFF 1
#endif
#ifndef EN_MLA
#define EN_MLA 1
#endif
#ifndef EN_PEER
#define EN_PEER 1
#endif
#ifndef EN_GEMM
#define EN_GEMM 1
#endif
#ifndef EN_PRO
#define EN_PRO 1
#endif
#ifndef PEER_FP8
#define PEER_FP8 1
#endif
#ifndef PROBE
#define PROBE 0
#endif
#ifndef PEER_SLICED
#define PEER_SLICED 1
#endif
#ifndef PROBE_ATTN_MODE
#define PROBE_ATTN_MODE 0
#endif
#ifndef PROBE_T
#define PROBE_T -1
#endif
#ifndef PROBE_PEER2
#define PROBE_PEER2 0
#endif
#ifndef GSITE
#define GSITE -1
#endif
#define GAS __attribute__((address_space(1)))
#define LAS __attribute__((address_space(3)))
#define DI __device__ __forceinline__
typedef unsigned short bf16_t;
typedef short bf16x8 __attribute__((ext_vector_type(8)));
typedef short s16x4 __attribute__((ext_vector_type(4)));
typedef float f32x2 __attribute__((ext_vector_type(2)));
typedef float f32x4 __attribute__((ext_vector_type(4)));
typedef float f32x16 __attribute__((ext_vector_type(16)));
typedef unsigned u32x2 __attribute__((ext_vector_type(2)));
typedef unsigned u32x4 __attribute__((ext_vector_type(4)));
typedef __bf16 bf16x2_t __attribute__((ext_vector_type(2)));

constexpr int BATCH = 16, SEQ = 2048, DM = 2048, T = BATCH * SEQ, MEM_LEN = 256, MT = BATCH * MEM_LEN;
constexpr int DIFF_HEADS = 12, DIFF_W = 1536, S5_W = 512, AB_IN = 5120;
constexpr int MLA_HEADS = 16, MLA_QR = 768, MLA_KVR = 256, MLA_IN = 1088, MLA_IN_PAD = 1280;
constexpr int PEER_NE = 16384;
constexpr float NORM_EPS = 1e-6f;
constexpr int ROPE_POS = 3072;
constexpr int NWAVES = 8, NTHREADS = 512;

constexpr size_t MiB = 1u << 20;
constexpr size_t WS_CTL = 0, CTL_BYTES = 1 * MiB;
constexpr size_t WS_ROPE = 1 * MiB;
constexpr size_t WS_ABIN_T = 2 * MiB, WS_ABOUT_T = 22 * MiB, WS_GLU_T = 30 * MiB, WS_MLAIN_T = 31 * MiB, WS_UQ_T = 36 * MiB, WS_UKV_T = 41 * MiB, WS_MLAO_T = 43 * MiB;
constexpr size_t WS_LW = 51 * MiB, LW_STRIDE = 40 * MiB;
constexpr size_t LW_XQ = 0, LW_XKV = 8 * MiB, LW_XO = 24 * MiB, LW_PEER = 32 * MiB;
constexpr size_t WS_KVX = 131 * MiB, KVX_STRIDE = 32 * MiB;
constexpr size_t WS_POOL = 195 * MiB;
constexpr size_t P_H = WS_POOL;
constexpr size_t P_PROJ = WS_POOL + 128 * MiB;
constexpr size_t P_CONCAT = WS_POOL + 448 * MiB;
constexpr size_t P_GBUF = WS_POOL + 576 * MiB;
constexpr size_t P_MLAPROJ = WS_POOL + 0 * MiB;
constexpr size_t P_CQN = WS_POOL + 80 * MiB;
constexpr size_t P_CKVN = WS_POOL + 128 * MiB;
constexpr size_t P_KROPE = WS_POOL + 144 * MiB;
constexpr size_t P_Q = WS_POOL + 152 * MiB;
constexpr size_t P_KV = WS_POOL + 344 * MiB;
constexpr size_t P_WABS = WS_POOL + 128 * MiB;
constexpr size_t P_VW = WS_POOL + 192 * MiB;
constexpr size_t P_S = WS_POOL + 256 * MiB;
constexpr size_t P_P = WS_POOL + 320 * MiB;
constexpr size_t P_SC = WS_POOL + 128 * MiB;
constexpr size_t P_UT = WS_POOL + 608 * MiB;
constexpr size_t P_VT = WS_POOL + 642 * MiB;
constexpr size_t P_PE_E = WS_POOL + 384 * MiB;
constexpr size_t P_PE_G = WS_POOL + 400 * MiB;
constexpr size_t P_PE_E16 = WS_POOL + 416 * MiB;
constexpr size_t P_PE_W8 = WS_POOL + 424 * MiB;
constexpr size_t P_PE_WSC = WS_POOL + 428 * MiB;
constexpr size_t P_PE_T8 = WS_POOL + 432 * MiB;
constexpr size_t P_PE_TSC = WS_POOL + 496 * MiB;
constexpr size_t P_MEMN = WS_POOL + 448 * MiB;
constexpr size_t P_WQB = WS_POOL + 480 * MiB;
constexpr size_t P_SK = WS_POOL + 496 * MiB;
constexpr size_t P_SS = WS_POOL + 680 * MiB;
constexpr size_t P_XB = WS_POOL + 704 * MiB;
constexpr size_t WS_END = WS_POOL + 832 * MiB;
constexpr int CW_BAR = 4096, CW_CTR = 16384;

constexpr int RING_BYTES = 131072, LDSCTL_OFF = RING_BYTES, LDS_BYTES = 147456;

DI unsigned pk2(float lo, float hi) { f32x2 v = {lo, hi}; bf16x2_t b = __builtin_convertvector(v, bf16x2_t); return __builtin_bit_cast(unsigned, b); }
DI float bflo(unsigned u) { return __uint_as_float(u << 16); }
DI float bfhi(unsigned u) { return __uint_as_float(u & 0xffff0000u); }
DI float bf2f(bf16_t b) { return __uint_as_float(((unsigned)b) << 16); }
DI bf16_t f2bf(float f) { return (bf16_t)(pk2(f, 0.f) & 0xffffu); }
DI float dot2bf(unsigned a, unsigned b, float c) { return __builtin_amdgcn_fdot2_f32_bf16(__builtin_bit_cast(bf16x2_t, a), __builtin_bit_cast(bf16x2_t, b), c, false); }
DI int opaque_tid() { int t; asm volatile("v_mov_b32 %0, %1" : "=v"(t) : "v"(threadIdx.x)); return t; }
DI float dpp_f(float v, int ctrl_is) {
    const int x = __float_as_int(v);
    const int r = ctrl_is == 0 ? __builtin_amdgcn_update_dpp(0, x, 0xB1, 0xF, 0xF, true) : ctrl_is == 1 ? __builtin_amdgcn_update_dpp(0, x, 0x4E, 0xF, 0xF, true)
                : ctrl_is == 2 ? __builtin_amdgcn_update_dpp(0, x, 0x141, 0xF, 0xF, true) : __builtin_amdgcn_update_dpp(0, x, 0x140, 0xF, 0xF, true);
    return __int_as_float(r);
}
DI float wave_sum(float v) {
    v += dpp_f(v, 0); v += dpp_f(v, 1); v += dpp_f(v, 2); v += dpp_f(v, 3);
    { auto rr = __builtin_amdgcn_permlane16_swap(__float_as_uint(v), __float_as_uint(v), false, false); v = __uint_as_float(rr[0]) + __uint_as_float(rr[1]); }
    { auto rr = __builtin_amdgcn_permlane32_swap(__float_as_uint(v), __float_as_uint(v), false, false); v = __uint_as_float(rr[0]) + __uint_as_float(rr[1]); }
    return v;
}
DI float rows_sum(float v) {
    { auto rr = __builtin_amdgcn_permlane16_swap(__float_as_uint(v), __float_as_uint(v), false, false); v = __uint_as_float(rr[0]) + __uint_as_float(rr[1]); }
    { auto rr = __builtin_amdgcn_permlane32_swap(__float_as_uint(v), __float_as_uint(v), false, false); v = __uint_as_float(rr[0]) + __uint_as_float(rr[1]); }
    return v;
}
DI float rows_max(float v) {
    { auto rr = __builtin_amdgcn_permlane16_swap(__float_as_uint(v), __float_as_uint(v), false, false); v = fmaxf(__uint_as_float(rr[0]), __uint_as_float(rr[1])); }
    { auto rr = __builtin_amdgcn_permlane32_swap(__float_as_uint(v), __float_as_uint(v), false, false); v = fmaxf(__uint_as_float(rr[0]), __uint_as_float(rr[1])); }
    return v;
}
DI float row16_sum(float v) { v += dpp_f(v, 0); v += dpp_f(v, 1); v += dpp_f(v, 2); v += dpp_f(v, 3); return v; }
DI float row16_max(float v) { v = fmaxf(v, dpp_f(v, 0)); v = fmaxf(v, dpp_f(v, 1)); v = fmaxf(v, dpp_f(v, 2)); v = fmaxf(v, dpp_f(v, 3)); return v; }
DI float wave_max(float v) {
    v = fmaxf(v, dpp_f(v, 0)); v = fmaxf(v, dpp_f(v, 1)); v = fmaxf(v, dpp_f(v, 2)); v = fmaxf(v, dpp_f(v, 3));
    { auto rr = __builtin_amdgcn_permlane16_swap(__float_as_uint(v), __float_as_uint(v), false, false); v = fmaxf(__uint_as_float(rr[0]), __uint_as_float(rr[1])); }
    { auto rr = __builtin_amdgcn_permlane32_swap(__float_as_uint(v), __float_as_uint(v), false, false); v = fmaxf(__uint_as_float(rr[0]), __uint_as_float(rr[1])); }
    return v;
}
DI float erf_as(float x) {
    const float ax = fabsf(x), t = __builtin_amdgcn_rcpf(fmaf(0.3275911f, ax, 1.0f));
    const float poly = t * fmaf(t, fmaf(t, fmaf(t, fmaf(t, 1.061405429f, -1.453152027f), 1.421413741f), -0.284496736f), 0.254829592f);
    const float r = fmaf(-poly, __builtin_amdgcn_exp2f(-1.4426950408889634f * ax * ax), 1.0f);
    return copysignf(r, x);
}
DI float gelu_erf(float v) { return 0.5f * v * (1.0f + erf_as(v * 0.70710678118654752f)); }
DI float swap32_max(float x) { auto rr = __builtin_amdgcn_permlane32_swap(__float_as_uint(x), __float_as_uint(x), false, false); return fmaxf(__uint_as_float(rr[0]), __uint_as_float(rr[1])); }
DI float swap32_sum(float x) { auto rr = __builtin_amdgcn_permlane32_swap(__float_as_uint(x), __float_as_uint(x), false, false); return __uint_as_float(rr[0]) + __uint_as_float(rr[1]); }
DI unsigned q8x4(float a, float b, float c, float d, float scale) {
    const float M = 12582912.0f;
    const unsigned y0 = __float_as_uint(fmaf(a, scale, M)), y1 = __float_as_uint(fmaf(b, scale, M)), y2 = __float_as_uint(fmaf(c, scale, M)), y3 = __float_as_uint(fmaf(d, scale, M));
    const unsigned lo = __builtin_amdgcn_perm(y1, y0, 0x0c0c0400u), hi = __builtin_amdgcn_perm(y3, y2, 0x0c0c0400u);
    return lo | (hi << 16);
}
#define LDS_WAIT() asm volatile("s_waitcnt lgkmcnt(0)" ::: "memory")
#define VM_WAIT() asm volatile("s_waitcnt vmcnt(0)" ::: "memory")

#define XB_TMO      128
#define XB_XCNT(j)  (256  + 64 * (j))
#define XB_XSUB(j)  (1280 + 64 * (j))
#define XB_XGEN(j)  (2304 + 64 * (j))
#define XB_TOP      3328
#define XB_TOPGEN   3392
#define XCD_BAR_WORDS 3456
#define XB_SPIN_CAP (1u << 20)
DI unsigned xb_ld(unsigned* p)              { return __hip_atomic_load(p, __ATOMIC_RELAXED, __HIP_MEMORY_SCOPE_AGENT); }
DI unsigned xb_add(unsigned* p, unsigned v) { return __hip_atomic_fetch_add(p, v, __ATOMIC_RELAXED, __HIP_MEMORY_SCOPE_AGENT); }
DI unsigned xb_xcc_id() { return (unsigned)__builtin_amdgcn_s_getreg((3 << 11) | 20) & 0xFu; }
#define XB_SPIN(cond, bar) do { unsigned _sp = 0; while (cond) { __builtin_amdgcn_s_sleep(1); \
    if ((++_sp & 255u) == 0u) { if (xb_ld(&(bar)[XB_TMO])) break; if (_sp > XB_SPIN_CAP) { atomicAdd(&(bar)[XB_TMO], 1u); break; } } } } while (0)
struct XcdBarrier { unsigned* bar; unsigned x; volatile LAS unsigned* st; };
DI XcdBarrier xcd_barrier_post(unsigned* bar, volatile LAS unsigned* st) {
    XcdBarrier b; b.bar = bar; b.x = xb_xcc_id(); b.st = st;
    if (threadIdx.x == 0) (void)xb_add(&bar[XB_XCNT(b.x)], 1u);
    return b;
}
DI void xcd_barrier_complete(unsigned* bar, unsigned x, unsigned& nloc, unsigned& nx) {
    const unsigned G = gridDim.x * gridDim.y * gridDim.z;
    unsigned sum, cnt, mine, sp = 0u;
    for (;;) {
        sum = 0u; cnt = 0u; mine = 0u;
#pragma unroll
        for (unsigned j = 0; j < 16; ++j) { const unsigned c = xb_ld(&bar[XB_XCNT(j)]); sum += c; cnt += (c > 0u) ? 1u : 0u; mine = (j == x) ? c : mine; }
        if (sum == G) break;
        __builtin_amdgcn_s_sleep(1);
        if ((++sp & 255u) == 0u) { if (xb_ld(&bar[XB_TMO])) break; if (sp > XB_SPIN_CAP) { atomicAdd(&bar[XB_TMO], 1u); break; } }
    }
    nloc = mine > 0u ? mine : 1u; nx = cnt > 0u ? cnt : 1u;
}
DI void xcd_barrier(const XcdBarrier& b) {
    asm volatile("s_waitcnt vmcnt(0)" ::: "memory");
    __syncthreads();
    if (threadIdx.x == 0) {
        unsigned* bar = b.bar;
        __builtin_amdgcn_s_waitcnt(0);
        unsigned nloc = b.st[0], nx = b.st[1];
        if (nloc == 0u) { xcd_barrier_complete(bar, b.x, nloc, nx); b.st[0] = nloc; b.st[1] = nx; }
        const unsigned old = xb_add(&bar[XB_XSUB(b.x)], 1u);
        const unsigned gen = old / nloc;
        if (old + 1u == (gen + 1u) * nloc) {
            __builtin_amdgcn_fence(__ATOMIC_RELEASE, "agent");
            asm volatile("s_waitcnt vmcnt(0)" ::: "memory");
            const unsigned og = xb_add(&bar[XB_TOP], 1u);
            const unsigned tg = og / nx;
            if (og + 1u == (tg + 1u) * nx) xb_add(&bar[XB_TOPGEN], 1u);
            else XB_SPIN(xb_ld(&bar[XB_TOPGEN]) == tg, bar);
            __builtin_amdgcn_fence(__ATOMIC_ACQUIRE, "agent");
            xb_add(&bar[XB_XGEN(b.x)], 1u);
            asm volatile("s_waitcnt vmcnt(0)" ::: "memory");
        } else {
            XB_SPIN(xb_ld(&bar[XB_XGEN(b.x)]) == gen, bar);
            __builtin_amdgcn_fence(__ATOMIC_ACQUIRE, "agent");
            asm volatile("s_waitcnt vmcnt(0)" ::: "memory");
        }
    }
    __syncthreads();
}

template <class E, class = void> struct IsSoftmaxEpi { static constexpr bool value = false; };
template <class E> struct IsSoftmaxEpi<E, decltype((void)E::kSoftmax)> { static constexpr bool value = true; };
namespace g8 {
constexpr int BM = 256, BK = 64, HALF = 128, HTB = HALF * BK * 2, STAGE_BYTES = 8 * HTB, NXCD = 8, WGM = 8;
DI int lds_byte(int r, int c) { const int st = (r >> 4) * 2 + (c >> 5), rr = r & 15, cc = c & 31, ob = rr * 64 + cc * 2; return st * 1024 + (ob ^ (((ob >> 9) & 1) << 5)); }
DI void stage_rc(int b, int& R, int& C) { const int st = b / 1024, sb = b % 1024, swz = sb ^ (((sb >> 9) & 1) << 5); R = (st >> 1) * 16 + swz / 64; C = (st & 1) * 32 + (swz % 64) / 2; }
DI int perm32(int rho) { const int n = rho >> 4, i = rho & 15; return 8 * (i >> 2) + 4 * n + (i & 3); }

struct Unit { int zo, zi, pm, pn; };
struct Desc { const bf16_t* A; const bf16_t* Bt; int lda, ldb, K, nM, nN, nZo, nZi; long sAo, sAi, sBo, sBi; };
DI bool next_unit(const Desc& g, int i, int G, int c, Unit& u) {
    const int per = g.nM * g.nN, nwg = per * g.nZo * g.nZi;
    const long L = (long)i * G + c; if (L >= nwg) return false;
    int wgid = (int)L; { const int q = nwg / NXCD, r = nwg % NXCD, xcd = wgid % NXCD, off = wgid / NXCD; wgid = (xcd < r ? xcd * (q + 1) : r * (q + 1) + (xcd - r) * q) + off; }
    const int z = wgid / per, w = wgid % per;
    u.zo = z / g.nZi; u.zi = z % g.nZi;
    const int nig = WGM * g.nN, gid = w / nig, fm = gid * WGM, gsz = (g.nM - fm) < WGM ? (g.nM - fm) : WGM;
    u.pm = fm + ((w % nig) % gsz); u.pn = (w % nig) / gsz; return true;
}

template <class Epi>
DI void gemm_phase(LAS unsigned char* lds, const Desc g, const Epi& E, int G, int c) {
    const int tid = opaque_tid(), wid = __builtin_amdgcn_readfirstlane(tid >> 6), lane = tid & 63, wr = wid >> 2, wc = wid & 3, fr = lane & 15, fq = lane >> 4;
    const int K = g.K, nt = K / BK;
    unsigned voffA[2], voffB[2];
#pragma unroll
    for (int i = 0; i < 2; ++i) { int R, C; stage_rc(tid * 16 + i * 8192, R, C); const int Rb = (R & ~31) + perm32(R & 31);
        voffA[i] = (unsigned)(R * g.lda + C) * 2u; voffB[i] = (unsigned)(Rb * g.ldb + C) * 2u; }
    const size_t kstep = (size_t)(BK * 2);
    const size_t hstepA = (size_t)HALF * g.lda * 2, hstepB = (size_t)HALF * g.ldb * 2;
    const unsigned ldsw = (unsigned)wid * 1024u;
    const int aoff = lds_byte(wr * 64 + fr, fq * 8), boff = lds_byte(wc * 32 + fr, fq * 8);
#define PG8_SA(b, h) (((b) * 2 + (h)) * HTB)
#define PG8_SB(b, h) ((4 + (b) * 2 + (h)) * HTB)
#define PG8_STAGE(bufoff, gbase, voff) do { _Pragma("unroll") for (int _i = 0; _i < 2; ++_i) \
        __builtin_amdgcn_global_load_lds((const unsigned*)((const char*)(gbase) + (voff)[_i]), (LAS unsigned*)(lds + (bufoff) + ldsw + _i * 8192), 16, 0, 0); } while (0)
#define PG8_LDA(dst, b, h) do { _Pragma("unroll") for (int m = 0; m < 4; ++m) _Pragma("unroll") for (int k = 0; k < 2; ++k) dst[m][k] = *(const LAS bf16x8*)(lds + PG8_SA(b, h) + aoff + m * 2048 + k * 1024); } while (0)
#define PG8_LDB(dst, b, h) do { _Pragma("unroll") for (int n = 0; n < 2; ++n) _Pragma("unroll") for (int k = 0; k < 2; ++k) dst[n][k] = *(const LAS bf16x8*)(lds + PG8_SB(b, h) + boff + n * 2048 + k * 1024); } while (0)
#define PG8_MMA(ai, bj, At, Bt) do { __builtin_amdgcn_s_setprio(1); _Pragma("unroll") for (int m = 0; m < 4; ++m) _Pragma("unroll") for (int n = 0; n < 2; ++n) _Pragma("unroll") for (int k = 0; k < 2; ++k) \
        acc[ai][bj][m][n] = __builtin_amdgcn_mfma_f32_16x16x32_bf16(Bt[n][k], At[m][k], acc[ai][bj][m][n], 0, 0, 0); __builtin_amdgcn_s_setprio(0); } while (0)
#define PG8_WAIT_V(n) asm volatile("s_waitcnt vmcnt(" #n ")" ::: "memory")
#define PG8_WAIT_L(n) asm volatile("s_waitcnt lgkmcnt(" #n ")" ::: "memory")
#define PG8_BAR __builtin_amdgcn_s_barrier()
#define PG8_SCHED __builtin_amdgcn_sched_barrier(0)
#define PG8_APTR(u) ((const char*)g.A + ((size_t)(u).zo * g.sAo + (size_t)(u).zi * g.sAi + (size_t)(u).pm * BM * g.lda) * 2)
#define PG8_BPTR(u) ((const char*)g.Bt + ((size_t)(u).zo * g.sBo + (size_t)(u).zi * g.sBi + (size_t)(u).pn * BM * g.ldb) * 2)
    Unit cur, nxt; int ui = 0;
    if (!next_unit(g, 0, G, c, cur)) return;
    f32x4 acc[2][2][4][2];
#define PG8_ACC_INIT(u) do { const int row0_ = (u).pm * BM + wr * 64 + fr, col0_ = (u).pn * BM + wc * 32 + 8 * fq; \
        _Pragma("unroll") for (int a = 0; a < 2; ++a) _Pragma("unroll") for (int b = 0; b < 2; ++b) _Pragma("unroll") for (int m = 0; m < 4; ++m) \
            E.acc_init((u).zo, row0_ + a * HALF + m * 16, col0_ + b * HALF, acc[a][b][m][0], acc[a][b][m][1]); } while (0)
    PG8_ACC_INIT(cur);
    bf16x8 At[4][2], B0[2][2], B1[2][2];
    const char* cA = PG8_APTR(cur); const char* cB = PG8_BPTR(cur);
    PG8_STAGE(PG8_SB(0, 0), cB, voffB); PG8_STAGE(PG8_SA(0, 0), cA, voffA); PG8_STAGE(PG8_SB(0, 1), cB + hstepB, voffB); PG8_STAGE(PG8_SA(0, 1), cA + hstepA, voffA);
    if (wr == 1) PG8_BAR;
    PG8_WAIT_V(4); PG8_BAR;
    PG8_STAGE(PG8_SB(1, 0), cB + kstep, voffB); PG8_STAGE(PG8_SA(1, 0), cA + kstep, voffA); PG8_STAGE(PG8_SB(1, 1), cB + hstepB + kstep, voffB);
    PG8_WAIT_V(6); PG8_BAR;
    for (;;) {
        const bool has_next = next_unit(g, ui + 1, G, c, nxt);
        const char* nA = has_next ? PG8_APTR(nxt) : cA; const char* nB = has_next ? PG8_BPTR(nxt) : cB;
        for (int t = 0; t < nt; t += 2) {
            const bool last = (t == nt - 2);
            const char* a1 = cA + (size_t)(t + 1) * kstep;
            const char* a2 = last ? nA : cA + (size_t)(t + 2) * kstep; const char* b2 = last ? nB : cB + (size_t)(t + 2) * kstep;
            const char* a3 = a2 + kstep; const char* b3 = b2 + kstep;
            PG8_LDB(B0, 0, 0); PG8_SCHED; PG8_LDA(At, 0, 0); PG8_STAGE(PG8_SA(1, 1), a1 + hstepA, voffA);
            PG8_WAIT_L(8); PG8_BAR; PG8_WAIT_L(0); PG8_MMA(0, 0, At, B0); PG8_BAR; PG8_SCHED;
            PG8_LDB(B1, 0, 1); PG8_STAGE(PG8_SB(0, 0), b2, voffB);
            PG8_BAR; PG8_WAIT_L(0); PG8_MMA(0, 1, At, B1); PG8_BAR;
            PG8_LDA(At, 0, 1); PG8_STAGE(PG8_SA(0, 0), a2, voffA);
            PG8_BAR; PG8_WAIT_L(0); PG8_MMA(1, 0, At, B0); PG8_BAR; PG8_SCHED;
            PG8_STAGE(PG8_SB(0, 1), b2 + hstepB, voffB);
            PG8_WAIT_V(6); PG8_BAR; PG8_MMA(1, 1, At, B1); PG8_BAR;
            PG8_LDB(B0, 1, 0); PG8_SCHED; PG8_LDA(At, 1, 0); PG8_STAGE(PG8_SA(0, 1), a2 + hstepA, voffA);
            PG8_WAIT_L(8); PG8_BAR; PG8_WAIT_L(0); PG8_MMA(0, 0, At, B0); PG8_BAR; PG8_SCHED;
            PG8_LDB(B1, 1, 1); PG8_STAGE(PG8_SB(1, 0), b3, voffB);
            PG8_BAR; PG8_WAIT_L(0); PG8_MMA(0, 1, At, B1); PG8_BAR;
            PG8_LDA(At, 1, 1); PG8_STAGE(PG8_SA(1, 0), a3, voffA);
            PG8_BAR; PG8_WAIT_L(0); PG8_MMA(1, 0, At, B0); PG8_BAR; PG8_SCHED;
            PG8_STAGE(PG8_SB(1, 1), b3 + hstepB, voffB);
            PG8_WAIT_V(6); PG8_BAR; PG8_MMA(1, 1, At, B1); PG8_BAR;
        }
        if constexpr (IsSoftmaxEpi<Epi>::value) { E.tile_epilogue(lds, cur.zo, cur.pm, cur.pn, acc, wr, wc, fr, fq); } else
        {
            const int row0 = cur.pm * BM + wr * 64 + fr, col0 = cur.pn * BM + wc * 32 + 8 * fq;
#pragma unroll
            for (int ai = 0; ai < 2; ++ai) {
                typename Epi::RowPre rp[4]; typename Epi::OctPre op[4][2];
#pragma unroll
                for (int m = 0; m < 4; ++m) { const int row = row0 + ai * HALF + m * 16; rp[m] = E.row_pre(cur.zo, row, fq);
#pragma unroll
                    for (int bj = 0; bj < 2; ++bj) op[m][bj] = E.oct_pre(cur.zo, row, col0 + bj * HALF); }
#pragma unroll
                for (int m = 0; m < 4; ++m) {
                    const int row = row0 + ai * HALF + m * 16;
                    const float ri = E.row_begin(rp[m]);
                    float ra = 0.f;
#pragma unroll
                    for (int bj = 0; bj < 2; ++bj) ra += E.oct(cur.zo, cur.zi, row, col0 + bj * HALF, acc[ai][bj][m][0], acc[ai][bj][m][1], ri, op[m][bj]);
                    E.row_end(cur.zo, row, cur.pn * 4 + wc, ra);
                }
            }
        }
        if (!has_next) break;
        PG8_ACC_INIT(nxt);
        cur = nxt; cA = nA; cB = nB; ++ui;
    }
    PG8_WAIT_V(0);
    if (wr == 0) PG8_BAR;
    PG8_BAR;
#undef PG8_SA
#undef PG8_SB
#undef PG8_STAGE
#undef PG8_LDA
#undef PG8_LDB
#undef PG8_MMA
#undef PG8_WAIT_V
#undef PG8_WAIT_L
#undef PG8_BAR
#undef PG8_SCHED
#undef PG8_ACC_INIT
#undef PG8_APTR
#undef PG8_BPTR
}

template <class Epi>
DI void naive_gemm(const Desc g, const Epi& E, int G, int c) {
    const int M = g.nM * BM, N = g.nN * BM, n8 = N / 8, nZ = g.nZo * g.nZi;
    const long total = (long)nZ * M * n8;
    for (long idx = (long)c * NTHREADS + threadIdx.x; idx < total; idx += (long)G * NTHREADS) {
        const int col = (int)(idx % n8) * 8; const int row = (int)((idx / n8) % M); const int z = (int)(idx / ((long)n8 * M));
        const int zo = z / g.nZi, zi = z % g.nZi;
        const bf16_t* a = g.A + (size_t)zo * g.sAo + (size_t)zi * g.sAi + (size_t)row * g.lda;
        const bf16_t* b = g.Bt + (size_t)zo * g.sBo + (size_t)zi * g.sBi + (size_t)col * g.ldb;
        float acc[8];
#pragma unroll
        for (int j = 0; j < 8; ++j) acc[j] = 0.f;
        for (int k = 0; k < g.K; k += 8) {
            const u32x4 av = *(const u32x4*)(a + k);
#pragma unroll
            for (int j = 0; j < 8; ++j) { const u32x4 bv = *(const u32x4*)(b + (size_t)j * g.ldb + k);
                float s = acc[j]; s = dot2bf(av.x, bv.x, s); s = dot2bf(av.y, bv.y, s); s = dot2bf(av.z, bv.z, s); s = dot2bf(av.w, bv.w, s); acc[j] = s; }
        }
        (void)E.oct(zo, zi, row, col, (f32x4){acc[0], acc[1], acc[2], acc[3]}, (f32x4){acc[4], acc[5], acc[6], acc[7]}, E.row_begin(E.row_pre(zo, row, 0)), E.oct_pre(zo, row, col));
    }
}
template <class Epi>
DI void gemm(LAS unsigned char* lds, const Desc g, const Epi& E, int G, int c) {
#if !EN_GEMM
    return;
#elif FAST_GEMM
    gemm_phase(lds, g, E, G, c);
#else
    naive_gemm(g, E, G, c);
#endif
}
}

template <int NP> DI float row_rstd(const float* ss, int row) {
    const f32x4* p = (const f32x4*)(ss + (size_t)row * 32); float t = 0.f;
#pragma unroll
    for (int i = 0; i < NP / 4; ++i) { const f32x4 v = p[i]; t += (v[0] + v[1]) + (v[2] + v[3]); }
    return rsqrtf(t * (1.0f / DM) + NORM_EPS);
}
template <int NP> struct RowStat { f32x4 v[NP / 16 ? NP / 16 : 1]; };
template <int NP> DI RowStat<NP> row_stat_pre(const float* ss, int row, int fq) {
    RowStat<NP> r; const f32x4* p = (const f32x4*)(ss + (size_t)row * 32) + fq * (NP / 16);
#pragma unroll
    for (int i = 0; i < NP / 16; ++i) r.v[i] = p[i];
    return r;
}
template <int NP> DI float row_stat_fin(const RowStat<NP>& r) {
    float t = 0.f;
#pragma unroll
    for (int i = 0; i < NP / 16; ++i) t += (r.v[i][0] + r.v[i][1]) + (r.v[i][2] + r.v[i][3]);
    t = rows_sum(t);
    return rsqrtf(t * (1.0f / DM) + NORM_EPS);
}
struct EpiNone {};
#define EPI_NO_ROW_BEGIN typedef EpiNone RowPre; DI RowPre row_pre(int, int, int) const { return RowPre{}; } DI float row_begin(const RowPre&) const { return 0.f; }
#define EPI_NO_OCT_PRE typedef EpiNone OctPre; DI OctPre oct_pre(int, int, int) const { return OctPre{}; }
#define EPI_NO_ROW_END DI void row_end(int, int, int, float) const {}
#define EPI_ZERO_ACC DI void acc_init(int, int, int, f32x4& lo, f32x4& hi) const { lo = (f32x4){0.f, 0.f, 0.f, 0.f}; hi = lo; }
template <int NP  > struct EpiBf16T {
    bf16_t* O; long ldc, sZo, sZi; float scale; const float* ss; int rzo;
    EPI_NO_ROW_END EPI_NO_OCT_PRE EPI_ZERO_ACC
    typedef RowStat<NP ? NP : 16> RowPre;
    DI RowPre row_pre(int zo, int row, int fq) const { if (NP) return row_stat_pre<NP ? NP : 16>(ss, zo * rzo + row, fq); return RowPre{}; }
    DI float row_begin(const RowPre& r) const { return NP ? row_stat_fin<NP ? NP : 16>(r) * scale : scale; }
    DI float oct(int zo, int zi, int row, int col, f32x4 lo, f32x4 hi, float f, const OctPre&) const {
        bf16_t* p = O + (size_t)zo * sZo + (size_t)zi * sZi + (size_t)row * ldc + col;
        u32x4 w; w.x = pk2(lo[0] * f, lo[1] * f); w.y = pk2(lo[2] * f, lo[3] * f); w.z = pk2(hi[0] * f, hi[1] * f); w.w = pk2(hi[2] * f, hi[3] * f);
        *(u32x4*)p = w; return 0.f;
    }
};
typedef EpiBf16T<0> EpiBf16;
struct EpiSoftmax256 {
    static constexpr bool kSoftmax = true;
    bf16_t* O; long ldc, sZo; float scale; const float* ss; int rzo;
    EPI_NO_ROW_BEGIN EPI_NO_OCT_PRE EPI_NO_ROW_END EPI_ZERO_ACC
    DI float oct(int, int, int, int, f32x4, f32x4, float, const OctPre&) const { return 0.f; }
    DI void tile_epilogue(LAS unsigned char* lds, int zo, int pm, int pn, f32x4 (&acc)[2][2][4][2], int wr, int wc, int fr, int fq) const {
        LAS float* xm = (LAS float*)(lds + LDSCTL_OFF + 1024);
        LAS float* xs = xm + 1024;
        const int row0 = pm * 256 + wr * 64 + fr, col0 = pn * 256 + wc * 32 + 8 * fq;
        float mloc[2][4];
#pragma unroll
        for (int ai = 0; ai < 2; ++ai) {
            RowStat<32> rp[4];
#pragma unroll
            for (int m = 0; m < 4; ++m) rp[m] = row_stat_pre<32>(ss, zo * rzo + row0 + ai * 128 + m * 16, fq);
#pragma unroll
            for (int m = 0; m < 4; ++m) {
                const float f = row_stat_fin<32>(rp[m]) * scale * 1.4426950408889634f;
                float mx = -INFINITY;
#pragma unroll
                for (int bj = 0; bj < 2; ++bj)
#pragma unroll
                    for (int h = 0; h < 2; ++h)
#pragma unroll
                        for (int j = 0; j < 4; ++j) { const float v = acc[ai][bj][m][h][j] * f; acc[ai][bj][m][h][j] = v; mx = fmaxf(mx, v); }
                mx = rows_max(mx);
                float sm = 0.f;
#pragma unroll
                for (int bj = 0; bj < 2; ++bj)
#pragma unroll
                    for (int h = 0; h < 2; ++h)
#pragma unroll
                        for (int j = 0; j < 4; ++j) { const float p = __builtin_amdgcn_exp2f(acc[ai][bj][m][h][j] - mx); acc[ai][bj][m][h][j] = p; sm += p; }
                sm = rows_sum(sm);
                mloc[ai][m] = mx;
                const int rl = ai * 128 + wr * 64 + m * 16 + fr;
                if (fq == 0) { xm[rl * 4 + wc] = mx; xs[rl * 4 + wc] = sm; }
            }
        }
        asm volatile("s_waitcnt lgkmcnt(0)" ::: "memory");
        __builtin_amdgcn_s_barrier();
        asm volatile("" ::: "memory");
#pragma unroll
        for (int ai = 0; ai < 2; ++ai)
#pragma unroll
            for (int m = 0; m < 4; ++m) {
                const int rl = ai * 128 + wr * 64 + m * 16 + fr;
                const f32x4 m4 = *(const LAS f32x4*)(xm + rl * 4), s4 = *(const LAS f32x4*)(xs + rl * 4);
                const float M = fmaxf(fmaxf(m4[0], m4[1]), fmaxf(m4[2], m4[3]));
                const float S = s4[0] * __builtin_amdgcn_exp2f(m4[0] - M) + s4[1] * __builtin_amdgcn_exp2f(m4[1] - M) + s4[2] * __builtin_amdgcn_exp2f(m4[2] - M) + s4[3] * __builtin_amdgcn_exp2f(m4[3] - M);
                const float f = __builtin_amdgcn_exp2f(mloc[ai][m] - M) / S;
                bf16_t* p = O + (size_t)zo * sZo + (size_t)(row0 + ai * 128 + m * 16) * ldc + col0;
#pragma unroll
                for (int bj = 0; bj < 2; ++bj) {
                    const f32x4 lo = acc[ai][bj][m][0], hi = acc[ai][bj][m][1];
                    u32x4 w; w.x = pk2(lo[0] * f, lo[1] * f); w.y = pk2(lo[2] * f, lo[3] * f); w.z = pk2(hi[0] * f, hi[1] * f); w.w = pk2(hi[2] * f, hi[3] * f);
                    *(u32x4*)(p + bj * 128) = w;
                }
            }
    }
};
template <int NP> struct EpiF32T {
    float* O; long ldc, sZo, sZi; float scale; const float* ss; int rzo;
    EPI_NO_ROW_END EPI_NO_OCT_PRE EPI_ZERO_ACC
    typedef RowStat<NP ? NP : 16> RowPre;
    DI RowPre row_pre(int zo, int row, int fq) const { if (NP) return row_stat_pre<NP ? NP : 16>(ss, zo * rzo + row, fq); return RowPre{}; }
    DI float row_begin(const RowPre& r) const { return NP ? row_stat_fin<NP ? NP : 16>(r) * scale : scale; }
    DI float oct(int zo, int zi, int row, int col, f32x4 lo, f32x4 hi, float f, const OctPre&) const {
        float* p = O + (size_t)zo * sZo + (size_t)zi * sZi + (size_t)row * ldc + col;
        *(f32x4*)p = lo * f; *(f32x4*)(p + 4) = hi * f; return 0.f;
    }
};
typedef EpiF32T<0> EpiF32;
template <bool F32SRC> struct EpiResidB {
    const float* xin; bf16_t* xb; float* ss; int rzo;
    EPI_NO_ROW_BEGIN EPI_NO_OCT_PRE
    DI void acc_init(int zo, int row, int col, f32x4& lo, f32x4& hi) const {
        const size_t o = (size_t)(zo * rzo + row) * DM + col;
        if (F32SRC) { lo = *(const f32x4*)(xin + o); hi = *(const f32x4*)(xin + o + 4); }
        else { const u32x4 w = *(const u32x4*)(xb + o); lo = (f32x4){bflo(w.x), bfhi(w.x), bflo(w.y), bfhi(w.y)}; hi = (f32x4){bflo(w.z), bfhi(w.z), bflo(w.w), bfhi(w.w)}; }
    }
    DI float oct(int zo, int, int row, int col, f32x4 lo, f32x4 hi, float, const OctPre&) const {
        const size_t o = (size_t)(zo * rzo + row) * DM + col;
        const float r[8] = {0.f, 0.f, 0.f, 0.f, 0.f, 0.f, 0.f, 0.f};
        u32x4 w; w.x = pk2(r[0] + lo[0], r[1] + lo[1]); w.y = pk2(r[2] + lo[2], r[3] + lo[3]); w.z = pk2(r[4] + hi[0], r[5] + hi[1]); w.w = pk2(r[6] + hi[2], r[7] + hi[3]);
        *(u32x4*)(xb + o) = w;
        const float q0 = bflo(w.x), q1 = bfhi(w.x), q2 = bflo(w.y), q3 = bfhi(w.y), q4 = bflo(w.z), q5 = bfhi(w.z), q6 = bflo(w.w), q7 = bfhi(w.w);
        return ((q0 * q0 + q1 * q1) + (q2 * q2 + q3 * q3)) + ((q4 * q4 + q5 * q5) + (q6 * q6 + q7 * q7));
    }
    DI void row_end(int zo, int row, int slot, float ra) const {
        ra = rows_sum(ra);
        if ((threadIdx.x & 63) < 16) ss[(size_t)(zo * rzo + row) * 32 + slot] = ra;
    }
};
template <int MODE> struct EpiRope {
    bf16_t* O; long ldc; const int* pos; const f32x2* tab;
    EPI_NO_ROW_BEGIN EPI_NO_ROW_END EPI_NO_OCT_PRE EPI_ZERO_ACC
    DI float oct(int, int, int row, int col, f32x4 lo, f32x4 hi, float, const OctPre&) const {
        bool rope; int j0;
        if (MODE == 0) { rope = col < 2 * DIFF_W; j0 = col & 63; } else { const int c = col % 192; rope = c >= 128; j0 = c - 128; }
        if (rope) {
            int p = pos[row]; p = p < 0 ? 0 : (p > ROPE_POS - 1 ? ROPE_POS - 1 : p);
            const f32x4* tp = (const f32x4*)(tab + (size_t)p * 32 + (j0 >> 1));
            const f32x4 t0 = tp[0], t1 = tp[1];
            f32x4 a = lo, b = hi;
            lo[0] = a[0] * t0[0] - a[1] * t0[1]; lo[1] = a[1] * t0[0] + a[0] * t0[1];
            lo[2] = a[2] * t0[2] - a[3] * t0[3]; lo[3] = a[3] * t0[2] + a[2] * t0[3];
            hi[0] = b[0] * t1[0] - b[1] * t1[1]; hi[1] = b[1] * t1[0] + b[0] * t1[1];
            hi[2] = b[2] * t1[2] - b[3] * t1[3]; hi[3] = b[3] * t1[2] + b[2] * t1[3];
        }
        u32x4 w; w.x = pk2(lo[0], lo[1]); w.y = pk2(lo[2], lo[3]); w.z = pk2(hi[0], hi[1]); w.w = pk2(hi[2], hi[3]);
        *(u32x4*)(O + (size_t)row * ldc + col) = w; return 0.f;
    }
};
struct EpiGlu {
    const bf16_t* gbuf; const float* bias; bf16_t* out;
    EPI_NO_ROW_BEGIN EPI_NO_ROW_END EPI_NO_OCT_PRE EPI_ZERO_ACC
    DI float oct(int, int, int row, int col, f32x4 lo, f32x4 hi, float, const OctPre&) const {
        const u32x4 gv = *(const u32x4*)(gbuf + (size_t)row * S5_W + col);
        const f32x4 b0 = *(const f32x4*)(bias + col), b1 = *(const f32x4*)(bias + col + 4);
        float g[8] = {bflo(gv.x), bfhi(gv.x), bflo(gv.y), bfhi(gv.y), bflo(gv.z), bfhi(gv.z), bflo(gv.w), bfhi(gv.w)};
        float a[8] = {lo[0] + b0[0], lo[1] + b0[1], lo[2] + b0[2], lo[3] + b0[3], hi[0] + b1[0], hi[1] + b1[1], hi[2] + b1[2], hi[3] + b1[3]};
        float r[8];
#pragma unroll
        for (int j = 0; j < 8; ++j) r[j] = g[j] / (1.0f + __expf(-a[j]));
        u32x4 w; w.x = pk2(r[0], r[1]); w.y = pk2(r[2], r[3]); w.z = pk2(r[4], r[5]); w.w = pk2(r[6], r[7]);
        *(u32x4*)(out + (size_t)row * DM + DIFF_W + col) = w; return 0.f;
    }
};
struct EpiNull { EPI_NO_ROW_BEGIN EPI_NO_ROW_END EPI_NO_OCT_PRE EPI_ZERO_ACC DI float oct(int, int, int, int, f32x4 lo, f32x4 hi, float, const OctPre&) const { asm volatile("" :: "v"(lo), "v"(hi)); return 0.f; } };
struct Params {
    const float* in[39];
    float* out; unsigned char* ws;
    int ph_lo, ph_hi;
};
enum { I_X = 0, I_MEM, I_POS, I_AB_NORM, I_AB_WIN, I_AB_WOUT, I_LQ1, I_LK1, I_LQ2, I_LK2, I_SUBLN, I_S5_ARE, I_S5_AIM, I_S5_LOGSTEP, I_S5_BRE, I_S5_BIM, I_S5_CRE, I_S5_CIM, I_S5_D,
       I_S5_WGLU, I_S5_BGLU, I_MLA_NORM, I_MLA_WIN, I_MLA_QNORM, I_MLA_KVNORM, I_MLA_WUQ, I_MLA_WUKV, I_MLA_WO, I_XA_NORM, I_XA_MEMNORM, I_XA_WQ, I_XA_WKV, I_XA_WO, I_FFN_NORM,
       I_PEER_WQ, I_PEER_SK, I_PEER_U, I_PEER_V, I_FINAL_NORM };

struct Ctx { LAS unsigned char* lds; int tid, lane, wave, blk, G; };
DI Ctx fresh(const Ctx& C0) { Ctx C = C0; C.tid = opaque_tid(); C.lane = C.tid & 63; return C; }

DI void rms_rows_2048(const Ctx& C0, const float* src, const float* gain, bf16_t* dst, int nrows) {
    const Ctx C = fresh(C0);
    const int r0 = C.blk * NWAVES + C.wave, rstep = C.G * NWAVES;
    f32x4 nv[8];
    if (r0 < nrows) { const f32x4* xr = (const f32x4*)(src + (size_t)r0 * DM) + C.lane;
#pragma unroll
        for (int j = 0; j < 8; ++j) nv[j] = xr[64 * j]; }
    for (int r = r0; r < nrows; r += rstep) {
        f32x4 v[8]; float ss = 0.f;
#pragma unroll
        for (int j = 0; j < 8; ++j) v[j] = nv[j];
        { const int rn = (r + rstep < nrows) ? r + rstep : r; const f32x4* xr = (const f32x4*)(src + (size_t)rn * DM) + C.lane;
#pragma unroll
            for (int j = 0; j < 8; ++j) nv[j] = xr[64 * j]; }
#pragma unroll
        for (int j = 0; j < 8; ++j) ss += (v[j][0] * v[j][0] + v[j][1] * v[j][1]) + (v[j][2] * v[j][2] + v[j][3] * v[j][3]);
        const float sc = rsqrtf(wave_sum(ss) * (1.0f / DM) + NORM_EPS);
        u32x2* o = (u32x2*)(dst + (size_t)r * DM) + C.lane;
#pragma unroll
        for (int j = 0; j < 8; ++j) { const f32x4 g = *((const f32x4*)gain + C.lane + 64 * j);
            u32x2 w; w.x = pk2(v[j][0] * sc * g[0], v[j][1] * sc * g[1]); w.y = pk2(v[j][2] * sc * g[2], v[j][3] * sc * g[3]); o[64 * j] = w; }
    }
}
DI void rms_rows_final(const Ctx& C0, const bf16_t* xbp, float* out, const float* gain, int nrows) {
    const Ctx C = fresh(C0);
    const int r0 = C.blk * NWAVES + C.wave, rstep = C.G * NWAVES;
    u32x2 nw[8];
    if (r0 < nrows) { const u32x2* xr = (const u32x2*)(xbp + (size_t)r0 * DM) + C.lane;
#pragma unroll
        for (int j = 0; j < 8; ++j) nw[j] = xr[64 * j]; }
    for (int r = r0; r < nrows; r += rstep) {
        f32x4 v[8]; float ss = 0.f;
#pragma unroll
        for (int j = 0; j < 8; ++j) { const u32x2 w = nw[j]; v[j] = (f32x4){bflo(w.x), bfhi(w.x), bflo(w.y), bfhi(w.y)}; }
        { const int rn = (r + rstep < nrows) ? r + rstep : r; const u32x2* xr = (const u32x2*)(xbp + (size_t)rn * DM) + C.lane;
#pragma unroll
            for (int j = 0; j < 8; ++j) nw[j] = xr[64 * j]; }
#pragma unroll
        for (int j = 0; j < 8; ++j) ss += (v[j][0] * v[j][0] + v[j][1] * v[j][1]) + (v[j][2] * v[j][2] + v[j][3] * v[j][3]);
        const float sc = rsqrtf(wave_sum(ss) * (1.0f / DM) + NORM_EPS);
        f32x4* o = (f32x4*)(out + (size_t)r * DM) + C.lane;
#pragma unroll
        for (int j = 0; j < 8; ++j) { const f32x4 g = *((const f32x4*)gain + C.lane + 64 * j); o[64 * j] = v[j] * sc * g; }
    }
}

DI int srccol(int kind, int n) {
    if (kind == 1) { if (n < 2 * DIFF_W) { const int j = n & 63; return (n & ~63) + (j >> 1) + 32 * (j & 1); } return n; }
    if (kind == 2) { if (n >= MLA_IN) return -1; if (n >= 1024) { const int j = n - 1024; return 1024 + (j >> 1) + 32 * (j & 1); } return n; }
    if (kind == 3) { const int c = n % 192; if (c >= 128) { const int j = c - 128; return n - c + 128 + (j >> 1) + 32 * (j & 1); } return n; }
    return n;
}
DI void transpose_item(const float* W, int K, int Nsrc, bf16_t* Wt, int nblk, int kind, const float* kgain, LAS float* scr, int item, int lane) {
    const int kb = item / nblk, nb = item % nblk, k0 = 64 * kb, n0 = 32 * nb;
    const int src = srccol(kind, n0 + (lane & 31));
    float wv[32];
#pragma unroll
    for (int i = 0; i < 32; ++i) { const int kk = 2 * i + (lane >> 5); wv[i] = (src >= 0) ? W[(size_t)(k0 + kk) * Nsrc + src] : 0.f; }
#pragma unroll
    for (int i = 0; i < 32; ++i) { const int kk = 2 * i + (lane >> 5); scr[kk * 33 + (lane & 31)] = kgain ? wv[i] * kgain[k0 + kk] : wv[i]; }
    LDS_WAIT(); asm volatile("" ::: "memory");
    const int c = lane & 7;
#pragma unroll
    for (int j = 0; j < 4; ++j) { const int n = (lane >> 3) + 8 * j; const LAS float* s = scr + (8 * c) * 33 + n;
        u32x4 o; o.x = pk2(s[0 * 33], s[1 * 33]); o.y = pk2(s[2 * 33], s[3 * 33]); o.z = pk2(s[4 * 33], s[5 * 33]); o.w = pk2(s[6 * 33], s[7 * 33]);
        *(u32x4*)(Wt + (size_t)(n0 + n) * K + k0 + 8 * c) = o; }
    LDS_WAIT(); asm volatile("" ::: "memory");
}
DI void cvt_bf16(const Ctx& C0, const float* src, bf16_t* dst, size_t n8) {
    const Ctx C = fresh(C0);
    for (size_t i = (size_t)C.blk * NTHREADS + C.tid; i < n8; i += (size_t)C.G * NTHREADS) {
        const f32x4 a = *(const f32x4*)(src + i * 8), b = *(const f32x4*)(src + i * 8 + 4);
        u32x4 w; w.x = pk2(a[0], a[1]); w.y = pk2(a[2], a[3]); w.z = pk2(b[0], b[1]); w.w = pk2(b[2], b[3]);
        *(u32x4*)(dst + i * 8) = w;
    }
}


DI void cvt_rows_gain(const Ctx& C, const float* src, bf16_t* dst, const float* gain, size_t n8) {
    const size_t stride = (size_t)C.G * NTHREADS;
    for (size_t i0 = (size_t)C.blk * NTHREADS + C.tid; i0 < n8; i0 += 4 * stride) {
        f32x4 a[4], b[4]; float g[4];
#pragma unroll
        for (int j = 0; j < 4; ++j) { const size_t i = i0 + j * stride; if (i < n8) { a[j] = *(const f32x4*)(src + i * 8); b[j] = *(const f32x4*)(src + i * 8 + 4); g[j] = gain[i / (DM / 8)]; } }
#pragma unroll
        for (int j = 0; j < 4; ++j) { const size_t i = i0 + j * stride; if (i < n8) {
            u32x4 w; w.x = pk2(a[j][0] * g[j], a[j][1] * g[j]); w.y = pk2(a[j][2] * g[j], a[j][3] * g[j]); w.z = pk2(b[j][0] * g[j], b[j][1] * g[j]); w.w = pk2(b[j][2] * g[j], b[j][3] * g[j]);
            *(u32x4*)(dst + i * 8) = w; } }
    }
}

DI void cvt_fp8_rows(const Ctx& C0, const float* src, unsigned char* dst, float* isc, int nrows) {
    const Ctx C = fresh(C0);
    for (int r = C.blk * NWAVES + C.wave; r < nrows; r += C.G * NWAVES) {
        const f32x4* xr = (const f32x4*)(src + (size_t)r * DM) + C.lane;
        f32x4 v[8]; float am = 0.f;
#pragma unroll
        for (int j = 0; j < 8; ++j) { v[j] = xr[64 * j]; am = fmaxf(am, fmaxf(fmaxf(fabsf(v[j][0]), fabsf(v[j][1])), fmaxf(fabsf(v[j][2]), fabsf(v[j][3])))); }
        am = wave_max(am);
        const float e = am > 0.f ? floorf(log2f(448.0f / am)) : 0.f;
        const float scale = exp2f(e);
        if (C.lane == 0) isc[r] = exp2f(-e);
#if PEER_SLICED
        unsigned* o = (unsigned*)(dst + (size_t)(C.lane >> 5) * ((size_t)PEER_NE * 128) + (size_t)r * 128) + (C.lane & 31);
#pragma unroll
        for (int j = 0; j < 8; ++j) { int w = 0; w = __builtin_amdgcn_cvt_pk_fp8_f32(v[j][0] * scale, v[j][1] * scale, w, false); w = __builtin_amdgcn_cvt_pk_fp8_f32(v[j][2] * scale, v[j][3] * scale, w, true); o[(size_t)2 * j * (PEER_NE * 128 / 4)] = (unsigned)w; }
#else
        unsigned* o = (unsigned*)(dst + (size_t)r * DM) + C.lane;
#pragma unroll
        for (int j = 0; j < 8; ++j) { int w = 0; w = __builtin_amdgcn_cvt_pk_fp8_f32(v[j][0] * scale, v[j][1] * scale, w, false); w = __builtin_amdgcn_cvt_pk_fp8_f32(v[j][2] * scale, v[j][3] * scale, w, true); o[64 * j] = (unsigned)w; }
#endif
    }
}


DI void cvt_i8_rows(const Ctx& C0, const float* src, const float* cgain, unsigned char* dst, float* isc, int nrows) {
    const Ctx C = fresh(C0);
    const int r0 = C.blk * NWAVES + C.wave, rstep = C.G * NWAVES;
    f32x4 nv[8];
    if (r0 < nrows) { const f32x4* xr = (const f32x4*)(src + (size_t)r0 * DM) + C.lane;
#pragma unroll
        for (int j = 0; j < 8; ++j) nv[j] = xr[64 * j]; }
    for (int r = r0; r < nrows; r += rstep) {
        f32x4 v[8]; float am = 0.f;
#pragma unroll
        for (int j = 0; j < 8; ++j) v[j] = nv[j];
        { const int rn = (r + rstep < nrows) ? r + rstep : r; const f32x4* xr = (const f32x4*)(src + (size_t)rn * DM) + C.lane;
#pragma unroll
            for (int j = 0; j < 8; ++j) nv[j] = xr[64 * j]; }
#pragma unroll
        for (int j = 0; j < 8; ++j) { if (cgain) v[j] = v[j] * *((const f32x4*)cgain + C.lane + 64 * j); am = fmaxf(am, fmaxf(fmaxf(fabsf(v[j][0]), fabsf(v[j][1])), fmaxf(fabsf(v[j][2]), fabsf(v[j][3])))); }
        am = wave_max(am);
        const float scale = am > 0.f ? 127.0f / am : 0.f;
        if (C.lane == 0) isc[r] = am * (1.0f / 127.0f);
        unsigned* o = (unsigned*)(dst + (size_t)(C.lane >> 5) * ((size_t)PEER_NE * 128) + (size_t)r * 128) + (C.lane & 31);
#pragma unroll
        for (int j = 0; j < 8; ++j) o[(size_t)2 * j * (PEER_NE * 128 / 4)] = q8x4(v[j][0], v[j][1], v[j][2], v[j][3], scale);
    }
}

template <bool HI_SIGNED  , bool LO_SIGNED  >
DI void cvt_i4_rows(const Ctx& C0, const float* src, const float* cgain, unsigned char* dst, float* isc, int nrows) {
    const Ctx C = fresh(C0);
    const int r0 = C.blk * NWAVES + C.wave, rstep = C.G * NWAVES;
    f32x4 nv[8];
    if (r0 < nrows) { const f32x4* xr = (const f32x4*)(src + (size_t)r0 * DM) + 2 * C.lane;
#pragma unroll
        for (int j = 0; j < 4; ++j) { nv[2 * j] = xr[128 * j]; nv[2 * j + 1] = xr[128 * j + 1]; } }
    for (int r = r0; r < nrows; r += rstep) {
        f32x4 v[8]; float am = 0.f;
#pragma unroll
        for (int j = 0; j < 8; ++j) v[j] = nv[j];
        { const int rn = (r + rstep < nrows) ? r + rstep : r; const f32x4* xr = (const f32x4*)(src + (size_t)rn * DM) + 2 * C.lane;
#pragma unroll
            for (int j = 0; j < 4; ++j) { nv[2 * j] = xr[128 * j]; nv[2 * j + 1] = xr[128 * j + 1]; } }
#pragma unroll
        for (int j = 0; j < 4; ++j) { if (cgain) { const f32x4* gp = (const f32x4*)cgain + 2 * C.lane + 128 * j; v[2 * j] = v[2 * j] * gp[0]; v[2 * j + 1] = v[2 * j + 1] * gp[1]; } }
#pragma unroll
        for (int j = 0; j < 8; ++j) am = fmaxf(am, fmaxf(fmaxf(fabsf(v[j][0]), fabsf(v[j][1])), fmaxf(fabsf(v[j][2]), fabsf(v[j][3]))));
        am = wave_max(am);
        const float amc = 0.78f * am;
        const float scale = am > 0.f ? 7.0f / amc : 0.f;
        if (C.lane == 0) isc[r] = amc * (1.0f / 7.0f);
        unsigned* o = (unsigned*)(dst + (size_t)(C.lane >> 5) * ((size_t)PEER_NE * 128) + (size_t)r * 128) + (C.lane & 31);
#pragma unroll
        for (int j = 0; j < 4; ++j) {
            const float M8 = 12582912.0f + 8.0f;
            f32x4 a = v[2 * j] * scale, b = v[2 * j + 1] * scale;
#pragma unroll
            for (int k = 0; k < 4; ++k) { a[k] = __builtin_amdgcn_fmed3f(a[k], -7.0f, 7.0f); b[k] = __builtin_amdgcn_fmed3f(b[k], -7.0f, 7.0f); }
            const float ML = LO_SIGNED ? 12582912.0f : M8;
            const unsigned y0 = __float_as_uint(a[0] + ML), y1 = __float_as_uint(a[1] + ML), y2 = __float_as_uint(a[2] + ML), y3 = __float_as_uint(a[3] + ML);
            const float MH = HI_SIGNED ? 12582912.0f : M8;
            const unsigned z0 = __float_as_uint(b[0] + MH), z1 = __float_as_uint(b[1] + MH), z2 = __float_as_uint(b[2] + MH), z3 = __float_as_uint(b[3] + MH);
            unsigned lo = __builtin_amdgcn_perm(y1, y0, 0x0c0c0400u) | (__builtin_amdgcn_perm(y3, y2, 0x0c0c0400u) << 16);
            if (LO_SIGNED) lo &= 0x0f0f0f0fu;
            unsigned hi = __builtin_amdgcn_perm(z1, z0, 0x0c0c0400u) | (__builtin_amdgcn_perm(z3, z2, 0x0c0c0400u) << 16);
            if (HI_SIGNED) hi &= 0x0f0f0f0fu;
            o[(size_t)2 * j * (PEER_NE * 128 / 4)] = lo | (hi << 4);
        }
    }
}

DI void convert_tables(const Ctx& C, const Params& P, int l) {
    unsigned char* ws = P.ws;
#if PEER_FP8
#if PEER_SLICED
    cvt_i4_rows<true, true>(C, P.in[I_PEER_U] + (size_t)l * PEER_NE * DM, P.in[I_FFN_NORM] + l * DM, ws + P_UT, (float*)(ws + P_UT + 32 * MiB), PEER_NE);
#else
    cvt_fp8_rows(C, P.in[I_PEER_U] + (size_t)l * PEER_NE * DM, ws + P_UT, (float*)(ws + P_UT + 32 * MiB), PEER_NE);
#endif
    cvt_i4_rows<true, false>(C, P.in[I_PEER_V] + (size_t)l * PEER_NE * DM, nullptr, ws + P_VT, (float*)(ws + P_VT + 32 * MiB), PEER_NE);
#else
    cvt_bf16(C, P.in[I_PEER_U] + (size_t)l * PEER_NE * DM, (bf16_t*)(ws + P_UT), (size_t)PEER_NE * DM / 8);
    cvt_bf16(C, P.in[I_PEER_V] + (size_t)l * PEER_NE * DM, (bf16_t*)(ws + P_VT), (size_t)PEER_NE * DM / 8);
#endif
}

DI void phase_prologue(const Ctx& C0, const Params& P) {
    const Ctx C = fresh(C0);
    unsigned char* ws = P.ws;
    LAS float* scr = (LAS float*)(C.lds + C.wave * 8448);
    const int gw = C.blk * NWAVES + C.wave, NGW = C.G * NWAVES;
    int base = 0;
#define TJOB(Wp, K_, Nsrc_, Nout_, kind_, dst_, kg_) do { const int nblk_ = (Nout_) / 32, nit_ = ((K_) / 64) * nblk_; \
        int first_ = (gw - base % NGW + NGW) % NGW; \
        for (int it = first_; it < nit_; it += NGW) transpose_item((Wp), (K_), (Nsrc_), (bf16_t*)(dst_), nblk_, (kind_), (kg_), scr, it, C.lane); base += nit_; } while (0)
    TJOB(P.in[I_AB_WIN], DM, AB_IN, AB_IN, 1, ws + WS_ABIN_T, nullptr);
    TJOB(P.in[I_AB_WOUT], DM, DM, DM, 0, ws + WS_ABOUT_T, nullptr);
    TJOB(P.in[I_S5_WGLU], S5_W, S5_W, S5_W, 0, ws + WS_GLU_T, nullptr);
    TJOB(P.in[I_MLA_WIN], DM, MLA_IN, MLA_IN_PAD, 2, ws + WS_MLAIN_T, P.in[I_MLA_NORM]);
    TJOB(P.in[I_MLA_WUQ], MLA_QR, 3072, 3072, 3, ws + WS_UQ_T, nullptr);
    TJOB(P.in[I_MLA_WUKV], MLA_KVR, 4096, 4096, 0, ws + WS_UKV_T, nullptr);
    TJOB(P.in[I_MLA_WO], DM, DM, DM, 0, ws + WS_MLAO_T, nullptr);
    for (int l = 0; l < 2; ++l) {
        TJOB(P.in[I_XA_WKV] + (size_t)l * DM * 2 * DM, DM, 2 * DM, 2 * DM, 0, ws + WS_LW + l * LW_STRIDE + LW_XKV, nullptr);
        TJOB(P.in[I_XA_WO] + (size_t)l * DM * DM, DM, DM, DM, 0, ws + WS_LW + l * LW_STRIDE + LW_XO, nullptr);
    }
#undef TJOB
    {
        f32x2* tab = (f32x2*)(ws + WS_ROPE);
        for (int i = C.blk * NTHREADS + C.tid; i < ROPE_POS * 32; i += C.G * NTHREADS) {
            const int p = i >> 5, f = i & 31;
            const float inv = powf(10000.0f, -(float)f * (2.0f / 64.0f));
            const float ang = (float)p * inv;
            tab[i] = (f32x2){(float)cos((double)ang), (float)sin((double)ang)};
        }
    }
    for (int l = 0; l < 2; ++l) {
        const float* src = P.in[I_XA_WQ] + (size_t)l * DM * DM; bf16_t* dst = (bf16_t*)(ws + WS_LW + l * LW_STRIDE + LW_XQ);
        cvt_rows_gain(C, src, dst, P.in[I_XA_NORM] + l * DM, (size_t)DM * DM / 8);
    }
    {
        const float* src = P.in[I_PEER_WQ]; bf16_t* dst = (bf16_t*)(ws + P_WQB);
        cvt_rows_gain(C, src, dst, P.in[I_FFN_NORM], (size_t)2 * DM * DM / 8);
    }
    {
        bf16_t* sk = (bf16_t*)(ws + P_SK); const float* skin = P.in[I_PEER_SK];
        for (int i = C.blk * NTHREADS + C.tid; i < 2 * 8 * 256 * 256 / 8; i += C.G * NTHREADS) {
            const int q8 = (i & 31) * 8, np = (i >> 5) & 255, lh = i >> 13;
            const int c = np >> 7, n = np & 127, c2 = q8 >> 7, q = q8 & 127;
            u32x4 w = {0u, 0u, 0u, 0u};
            if (c == c2) { const float* s = skin + ((((size_t)lh * 2 + c) * 128 + n) * 128 + q);
                const f32x4 a = *(const f32x4*)s, b = *(const f32x4*)(s + 4);
                w.x = pk2(a[0], a[1]); w.y = pk2(a[2], a[3]); w.z = pk2(b[0], b[1]); w.w = pk2(b[2], b[3]); }
            *(u32x4*)(sk + (size_t)i * 8) = w;
        }
    }
    for (int l = 0; l < 2; ++l) rms_rows_2048(C, P.in[I_MEM], P.in[I_XA_MEMNORM] + l * DM, (bf16_t*)(ws + P_MEMN) + (size_t)l * MT * DM, MT);
}

DI void phase_s5(const Ctx& C0, const Params& P, int first, int last, int stride_w, int stride) {
    const Ctx C = fresh(C0);
    unsigned char* ws = P.ws;
    const bf16_t* proj = (const bf16_t*)(ws + P_PROJ); bf16_t* gbuf = (bf16_t*)(ws + P_GBUF);
    LAS unsigned char* my = C.lds + C.wave * 16384;
    LAS float* U = (LAS float*)my;
    LAS bf16_t* H = (LAS bf16_t*)(my + 1024);
    LAS float* BU = (LAS float*)(my + 5632);
    const int lane = C.lane, n = lane;
    for (int task = first + C.wave * stride_w; task < last; task += stride) {
        const int b = task >> 5, g = task & 31;
        const float a_re = P.in[I_S5_ARE][g * 64 + n], a_im = P.in[I_S5_AIM][g * 64 + n];
        const float step = expf(P.in[I_S5_LOGSTEP][g]);
        const float mag = expf(a_re * step);
        const float ab_re = mag * cosf(a_im * step), ab_im = mag * sinf(a_im * step);
        const float den = a_re * a_re + a_im * a_im, num_re = ab_re - 1.0f;
        const float f_re = (num_re * a_re + ab_im * a_im) / den, f_im = (ab_im * a_re - num_re * a_im) / den;
        bf16x8 bfr[8];
        {
            const float* br = P.in[I_S5_BRE] + ((size_t)g * 64 + n) * 16; const float* bi = P.in[I_S5_BIM] + ((size_t)g * 64 + n) * 16;
            unsigned wre[8], wim[8];
#pragma unroll
            for (int p = 0; p < 16; p += 2) { const float x0 = br[p], y0 = bi[p], x1 = br[p + 1], y1 = bi[p + 1];
                wre[p >> 1] = pk2(f_re * x0 - f_im * y0, f_re * x1 - f_im * y1); wim[p >> 1] = pk2(f_re * y0 + f_im * x0, f_re * y1 + f_im * x1); }
            LAS unsigned char* bbt = (LAS unsigned char*)BU;
            *(LAS u32x4*)(bbt + n * 32) = (u32x4){wre[0], wre[1], wre[2], wre[3]}; *(LAS u32x4*)(bbt + n * 32 + 16) = (u32x4){wre[4], wre[5], wre[6], wre[7]};
            *(LAS u32x4*)(bbt + (64 + n) * 32) = (u32x4){wim[0], wim[1], wim[2], wim[3]}; *(LAS u32x4*)(bbt + (64 + n) * 32 + 16) = (u32x4){wim[4], wim[5], wim[6], wim[7]};
            LDS_WAIT(); asm volatile("" ::: "memory");
#pragma unroll
            for (int j = 0; j < 8; ++j) { const u32x4 w = *(const LAS u32x4*)(bbt + (16 * j + (lane & 15)) * 32 + 16 * ((lane >> 4) & 1));
                bfr[j] = __builtin_bit_cast(bf16x8, (lane >> 5) ? (u32x4){0u, 0u, 0u, 0u} : w); }
            LDS_WAIT(); asm volatile("" ::: "memory");
        }
        bf16x8 cf[4];
        {
            const int p = lane & 15, kq = lane >> 4;
#pragma unroll
            for (int kk = 0; kk < 4; ++kk) {
                const int k = 32 * kk + 8 * kq; const bool im = k >= 64;
                const float* src = (im ? P.in[I_S5_CIM] : P.in[I_S5_CRE]) + ((size_t)g * 16 + p) * 64 + (k & 63);
                const float sg = im ? -1.f : 1.f;
                const f32x4 a = *(const f32x4*)src, bq = *(const f32x4*)(src + 4);
                u32x4 w; w.x = pk2(sg * a[0], sg * a[1]); w.y = pk2(sg * a[2], sg * a[3]); w.z = pk2(sg * bq[0], sg * bq[1]); w.w = pk2(sg * bq[2], sg * bq[3]);
                cf[kk] = __builtin_bit_cast(bf16x8, w);
            }
        }
        const float dcoef = P.in[I_S5_D][g * 16 + (lane & 15)];
        float h_re = 0.f, h_im = 0.f;
        const bf16_t* ub = proj + (size_t)b * SEQ * AB_IN + 3 * DIFF_W + g * 16;
        u32x4 uan = *(const u32x4*)(ub + (size_t)(lane & 15) * AB_IN + 8 * ((lane >> 4) & 1));
        u32x2 uvn = *(const u32x2*)(ub + (size_t)(lane >> 2) * AB_IN + (lane & 3) * 4);
        for (int s0 = 0; s0 < SEQ; s0 += 16) {
            const bf16x8 ua = __builtin_bit_cast(bf16x8, (lane >> 5) ? (u32x4){0u, 0u, 0u, 0u} : uan);
            {
                const int st = lane >> 2, pp = (lane & 3) * 4;
                const u32x2 uv = uvn;
                const int sn = (s0 + 16 < SEQ) ? s0 + 16 : s0;
                uan = *(const u32x4*)(ub + (size_t)(sn + (lane & 15)) * AB_IN + 8 * ((lane >> 4) & 1));
                uvn = *(const u32x2*)(ub + (size_t)(sn + st) * AB_IN + pp);
                *(LAS f32x4*)(U + st * 16 + pp) = (f32x4){bflo(uv.x), bfhi(uv.x), bflo(uv.y), bfhi(uv.y)};
            }
            __builtin_amdgcn_sched_barrier(0);
            f32x4 dj[8];
#pragma unroll
            for (int j = 0; j < 8; ++j) dj[j] = __builtin_amdgcn_mfma_f32_16x16x32_bf16(ua, bfr[j], (f32x4){0.f, 0.f, 0.f, 0.f}, 0, 0, 0);
            __builtin_amdgcn_sched_barrier(0);
            asm volatile("s_nop 7\n\ts_nop 7\n\ts_nop 7" ::: "memory");
            __builtin_amdgcn_sched_barrier(0);
#pragma unroll
            for (int j = 0; j < 8; ++j) *(LAS f32x4*)(BU + (16 * j + (lane & 15)) * 20 + 4 * (lane >> 4)) = dj[j];
            LDS_WAIT(); asm volatile("" ::: "memory");
            float bre[16], bim[16];
#pragma unroll
            for (int q = 0; q < 4; ++q) { const f32x4 x = *(const LAS f32x4*)(BU + n * 20 + 4 * q), y = *(const LAS f32x4*)(BU + (64 + n) * 20 + 4 * q);
#pragma unroll
                for (int i = 0; i < 4; ++i) { bre[4 * q + i] = x[i]; bim[4 * q + i] = y[i]; } }
#pragma unroll
            for (int st = 0; st < 16; ++st) {
                const float nr = fmaf(ab_re, h_re, fmaf(-ab_im, h_im, bre[st])), ni = fmaf(ab_re, h_im, fmaf(ab_im, h_re, bim[st]));
                h_re = nr; h_im = ni;
                H[st * 136 + n] = f2bf(h_re); H[st * 136 + 64 + n] = f2bf(h_im);
            }
            LDS_WAIT(); asm volatile("" ::: "memory");
            f32x4 acc = {0.f, 0.f, 0.f, 0.f};
#pragma unroll
            for (int kk = 0; kk < 4; ++kk) {
                const bf16x8 af = *(const LAS bf16x8*)((LAS unsigned char*)H + (lane & 15) * 272 + (32 * kk + 8 * (lane >> 4)) * 2);
                acc = __builtin_amdgcn_mfma_f32_16x16x32_bf16(af, cf[kk], acc, 0, 0, 0);
            }
            __builtin_amdgcn_sched_barrier(0);
            asm volatile("s_nop 7\n\ts_nop 7\n\ts_nop 7" : "+v"(acc) :: "memory");
            __builtin_amdgcn_sched_barrier(0);
#pragma unroll
            for (int r = 0; r < 4; ++r) {
                const int st = (lane >> 4) * 4 + r, p = lane & 15;
                const float y = acc[r] + dcoef * U[st * 16 + p];
                gbuf[(size_t)(b * SEQ + s0 + st) * S5_W + g * 16 + p] = f2bf(gelu_erf(y));
            }
            LDS_WAIT(); asm volatile("" ::: "memory");
        }
    }
}

struct AttnArgs { const bf16_t* Qn; const bf16_t* Qr; const bf16_t* Kn; const bf16_t* Kr; const bf16_t* V; int ldq, ldkn, ldkr, ldv; };
DI int crow(int r, int hi) { return (r & 3) + 8 * (r >> 2) + 4 * hi; }
template <int DK> DI int koff(int row, int ch) { return DK == 64 ? row * 128 + 16 * (ch ^ ((row >> 1) & 7)) : row * 256 + 16 * (ch ^ (row & 15)); }
DI int voff(int row, int ch) { return 256 * row + 16 * (ch ^ (((row & 3) << 2) | ((row >> 2) & 3))); }
DI bf16x8 pack8(const f32x16& p, int s) {
    u32x4 w; w.x = pk2(p[8 * s + 0], p[8 * s + 1]); w.y = pk2(p[8 * s + 2], p[8 * s + 3]); w.z = pk2(p[8 * s + 4], p[8 * s + 5]); w.w = pk2(p[8 * s + 6], p[8 * s + 7]);
    return __builtin_bit_cast(bf16x8, w);
}
DI s16x4 vtr(const LAS unsigned char* p) { return __builtin_bit_cast(s16x4, __builtin_amdgcn_ds_read_tr16_b64_v4i16((LAS s16x4*)p)); }

template <int DKN, int DKR>
DI void attn_core(const AttnArgs& a, int q0, LAS unsigned char* lds, float scale, f32x16 (&o)[4], int mode = 0) {
    const int tid = opaque_tid(), wid = __builtin_amdgcn_readfirstlane(tid >> 6), lane = tid & 63, r32 = lane & 31, hi = lane >> 5;
    constexpr int CN = DKN / 8, NLK = CN * 64 / NTHREADS, KNB = 64 * DKN * 2, KRB = 64 * DKR * 2, KSZ = KNB + KRB, VBASE = 2 * KSZ, VSZ = 16384;
    constexpr int KG = DKR ? 2 : 4;
    static_assert(VBASE + 3 * VSZ <= RING_BYTES, "attention LDS");
    const bool late = wid >= 4;
    bf16x8 qn[DKN / 16]; bf16x8 qr[DKR ? DKR / 16 : 1];
    {
        const bf16_t* qp = a.Qn + (size_t)(q0 + 32 * wid + r32) * a.ldq + hi * 8;
#pragma unroll
        for (int d0 = 0; d0 < DKN / 16; ++d0) qn[d0] = *(const bf16x8*)(qp + d0 * 16);
        if (DKR) { const bf16_t* qp2 = a.Qr + (size_t)(q0 + 32 * wid + r32) * a.ldq + hi * 8;
#pragma unroll
            for (int d0 = 0; d0 < DKR / 16; ++d0) qr[d0] = *(const bf16x8*)(qp2 + d0 * 16); }
    }
    const int NT = (q0 + 256) / 64, NTw = (q0 + 32 * wid + 31) / 64 + 1;
    u32x4 skn[NLK], skr, sv[2];
#define AT_LOAD(t) do { _Pragma("unroll") for (int i_ = 0; i_ < NLK; ++i_) { const int id_ = tid + NTHREADS * i_, row_ = id_ / CN, ch_ = id_ % CN; \
            skn[i_] = *(const u32x4*)(a.Kn + (size_t)((t) * 64 + row_) * a.ldkn + ch_ * 8); } \
        if (DKR) { const int row_ = tid >> 3, ch_ = tid & 7; skr = *(const u32x4*)(a.Kr + (size_t)((t) * 64 + row_) * a.ldkr + ch_ * 8); } \
        _Pragma("unroll") for (int i_ = 0; i_ < 2; ++i_) { const int id_ = tid + NTHREADS * i_, row_ = id_ >> 4, ch_ = id_ & 15; \
            sv[i_] = *(const u32x4*)(a.V + (size_t)((t) * 64 + row_) * a.ldv + ch_ * 8); } } while (0)
#define AT_WRITE(kbuf, vbuf) do { LAS unsigned char* kb_ = lds + (kbuf) * KSZ; LAS unsigned char* vb_ = lds + VBASE + (vbuf) * VSZ; \
        _Pragma("unroll") for (int i_ = 0; i_ < NLK; ++i_) { const int id_ = tid + NTHREADS * i_, row_ = id_ / CN, ch_ = id_ % CN; *(LAS u32x4*)(kb_ + koff<DKN>(row_, ch_)) = skn[i_]; } \
        if (DKR) { const int row_ = tid >> 3, ch_ = tid & 7; *(LAS u32x4*)(kb_ + KNB + koff<64>(row_, ch_)) = skr; } \
        _Pragma("unroll") for (int i_ = 0; i_ < 2; ++i_) { const int id_ = tid + NTHREADS * i_, row_ = id_ >> 4, ch_ = id_ & 15; *(LAS u32x4*)(vb_ + voff(row_, ch_)) = sv[i_]; } } while (0)
    const float Cs = scale * 1.4426950408889634f, thr = 8.0f / Cs;
    float m_run = -1e30f, l_run = 0.f;
#pragma unroll
    for (int blk = 0; blk < 4; ++blk)
#pragma unroll
        for (int r = 0; r < 16; ++r) o[blk][r] = 0.f;
    bf16x8 pb[4];
#pragma unroll
    for (int i = 0; i < 4; ++i) pb[i] = (bf16x8){0, 0, 0, 0, 0, 0, 0, 0};
#define AT_PV(vbuf) do { const LAS unsigned char* vbase_ = lds + VBASE + (vbuf) * VSZ; \
        int lanev_ = lane; if (DKR) asm volatile("" : "+v"(lanev_));       \
        int vb_[4][2]; { const int i_ = lanev_ & 15, q_ = i_ >> 2, p_ = i_ & 3, grp1_ = (lanev_ >> 4) & 1, hv_ = lanev_ >> 5, low2_ = 2 * grp1_ + (p_ >> 1); \
            _Pragma("unroll") for (int blk = 0; blk < 4; ++blk) _Pragma("unroll") for (int x = 0; x < 2; ++x) vb_[blk][x] = 256 * (8 * x + 4 * hv_ + q_) + 16 * (4 * (blk ^ q_) + (low2_ ^ (hv_ + 2 * x))) + 8 * (p_ & 1); } \
        s16x4 lo_[2][4], hh_[2][4]; \
        _Pragma("unroll") for (int ks = 0; ks < 4; ++ks) { lo_[0][ks] = vtr(vbase_ + vb_[0][0] + 4096 * ks); hh_[0][ks] = vtr(vbase_ + vb_[0][1] + 4096 * ks); } \
        _Pragma("unroll") for (int blk = 0; blk < 4; ++blk) { \
            if (blk + 1 < 4) { _Pragma("unroll") for (int ks = 0; ks < 4; ++ks) { lo_[(blk + 1) & 1][ks] = vtr(vbase_ + vb_[blk + 1][0] + 4096 * ks); hh_[(blk + 1) & 1][ks] = vtr(vbase_ + vb_[blk + 1][1] + 4096 * ks); } } \
            _Pragma("unroll") for (int ks = 0; ks < 4; ++ks) { const s16x4 l_ = lo_[blk & 1][ks], h_ = hh_[blk & 1][ks]; \
                const bf16x8 af_ = {l_[0], l_[1], l_[2], l_[3], h_[0], h_[1], h_[2], h_[3]}; \
                o[blk] = __builtin_amdgcn_mfma_f32_32x32x16_bf16(af_, pb[ks], o[blk], 0, 0, 0); } \
            __builtin_amdgcn_sched_barrier(0); } } while (0)
    AT_LOAD(0); AT_WRITE(0, 0);
#pragma unroll
    for (int d0 = 0; d0 < DKN / 16; ++d0) asm volatile("" : "+v"(qn[d0]));
    if (DKR) {
#pragma unroll
        for (int d0 = 0; d0 < DKR / 16; ++d0) asm volatile("" : "+v"(qr[d0]));
    }
    if (NT > 1) AT_LOAD(1);
    int vcur = 0, vprev = 2, vnext = 1;
    for (int t = 0; t < NT; ++t) {
        if (mode != 5) __syncthreads();
        if (t + 1 < NT && mode != 2) AT_WRITE((t + 1) & 1, vnext);
        if (t + 2 < NT && mode != 1) AT_LOAD(t + 2);
        if (late && t >= 1 && t - 1 < NTw && mode != 3) AT_PV(vprev);
        if (t < NTw) {
            const LAS unsigned char* base = lds + (t & 1) * KSZ;
            int r32v = r32; if (DKR) asm volatile("" : "+v"(r32v));
            f32x16 p0, p1;
#pragma unroll
            for (int r = 0; r < 16; ++r) { p0[r] = 0.f; p1[r] = 0.f; }
            {
                constexpr int NDN = DKN / 16, NDT = NDN + DKR / 16;
#pragma unroll
                for (int g0 = 0; g0 < NDT; g0 += KG) {
                    bf16x8 kb0[KG], kb1[KG];
#pragma unroll
                    for (int i = 0; i < KG; ++i) { const int dd = g0 + i;
                        if (dd < NDN) { kb0[i] = *(const LAS bf16x8*)(base + koff<DKN>(r32v, 2 * dd + hi)); kb1[i] = *(const LAS bf16x8*)(base + koff<DKN>(32 + r32v, 2 * dd + hi)); }
                        else { kb0[i] = *(const LAS bf16x8*)(base + KNB + koff<64>(r32v, 2 * (dd - NDN) + hi)); kb1[i] = *(const LAS bf16x8*)(base + KNB + koff<64>(32 + r32v, 2 * (dd - NDN) + hi)); } }
#pragma unroll
                    for (int i = 0; i < KG; ++i) asm volatile("" : "+v"(kb0[i]), "+v"(kb1[i]));
#pragma unroll
                    for (int i = 0; i < KG; ++i) { const int dd = g0 + i;
                        const bf16x8 qf = dd < NDN ? qn[dd < NDN ? dd : 0] : qr[dd >= NDN ? dd - NDN : 0];
                        p0 = __builtin_amdgcn_mfma_f32_32x32x16_bf16(kb0[i], qf, p0, 0, 0, 0); p1 = __builtin_amdgcn_mfma_f32_32x32x16_bf16(kb1[i], qf, p1, 0, 0, 0); }
                }
            }
            if (t == NTw - 1) {
                const int qrel = q0 + 32 * wid + r32 - 64 * t;
#pragma unroll
                for (int r = 0; r < 16; ++r) { const int kv = crow(r, hi); if (kv > qrel) p0[r] = -INFINITY; if (kv + 32 > qrel) p1[r] = -INFINITY; }
            }
            float pmax = p0[0];
#pragma unroll
            for (int r = 1; r < 16; ++r) pmax = fmaxf(pmax, p0[r]);
#pragma unroll
            for (int r = 0; r < 16; ++r) pmax = fmaxf(pmax, p1[r]);
            pmax = swap32_max(pmax);
            if (__any(pmax > m_run + thr)) {
                const float mn = fmaxf(m_run, pmax);
                const float alpha = __builtin_amdgcn_exp2f((m_run - mn) * Cs);
                m_run = mn; l_run *= alpha;
#pragma unroll
                for (int blk = 0; blk < 4; ++blk)
#pragma unroll
                    for (int r = 0; r < 16; ++r) o[blk][r] *= alpha;
            }
            const float mnC = -m_run * Cs;
            float ps = 0.f;
#pragma unroll
            for (int r = 0; r < 16; ++r) { if (mode != 4) { p0[r] = __builtin_amdgcn_exp2f(fmaf(p0[r], Cs, mnC)); p1[r] = __builtin_amdgcn_exp2f(fmaf(p1[r], Cs, mnC)); } ps += p0[r] + p1[r]; }
            l_run += ps;
            pb[0] = pack8(p0, 0); pb[1] = pack8(p0, 1); pb[2] = pack8(p1, 0); pb[3] = pack8(p1, 1);
            if (!late && mode != 3) AT_PV(vcur);
        }
        { const int tmp = vprev; vprev = vcur; vcur = vnext; vnext = tmp; }
    }
    if (late && NTw == NT && mode != 3) AT_PV(vprev);
    __syncthreads();
    const float linv = 1.0f / swap32_sum(l_run);
#pragma unroll
    for (int blk = 0; blk < 4; ++blk)
#pragma unroll
        for (int r = 0; r < 16; ++r) o[blk][r] *= linv;
#undef AT_LOAD
#undef AT_WRITE
#undef AT_PV
}
DI void attn_store(const f32x16 (&o)[4], bf16_t* dst, int ld, int q0) {
    const int tid = opaque_tid(), wid = tid >> 6, lane = tid & 63, r32 = lane & 31, hi = lane >> 5;
    bf16_t* rp = dst + (size_t)(q0 + 32 * wid + r32) * ld;
#pragma unroll
    for (int blk = 0; blk < 4; ++blk)
#pragma unroll
        for (int g = 0; g < 4; ++g) {
            u32x2 w; w.x = pk2(o[blk][4 * g], o[blk][4 * g + 1]); w.y = pk2(o[blk][4 * g + 2], o[blk][4 * g + 3]);
            *(u32x2*)(rp + 32 * blk + 8 * g + 4 * hi) = w;
        }
}
DI int queue_pop(const Ctx& C0, unsigned* ctr, int total) {
    const Ctx C = fresh(C0);
    volatile LAS int* slot = (volatile LAS int*)(C.lds + LDSCTL_OFF + 64);
    __syncthreads();
    if (C.tid == 0) *slot = (int)__hip_atomic_fetch_add(ctr, 1u, __ATOMIC_RELAXED, __HIP_MEMORY_SCOPE_AGENT);
    __syncthreads();
    const int u = *slot;
    return u < total ? u : -1;
}
DI float diff_lambda(const Params& P) {
    float s1 = 0.f, s2 = 0.f;
    for (int i = 0; i < 64; ++i) { s1 += P.in[I_LQ1][i] * P.in[I_LK1][i]; s2 += P.in[I_LQ2][i] * P.in[I_LK2][i]; }
    return expf(s1) - expf(s2) + 0.2f;
}

#if FAST_ATTN
DI void phase_diff_attn(const Ctx& C0, const Params& P, int qi) {
    const Ctx C = fresh(C0);
    unsigned char* ws = P.ws;
    const bf16_t* proj = (const bf16_t*)(ws + P_PROJ); bf16_t* concat = (bf16_t*)(ws + P_CONCAT);
    unsigned* ctr = (unsigned*)(ws + WS_CTL) + CW_CTR + 64 * qi;
    const float lam = diff_lambda(P);
    const int NBH = BATCH * DIFF_HEADS, NS5 = BATCH * 32 / NWAVES, total = NS5 + NBH * 8;
    const int lane = C.lane, r32 = lane & 31, hi = lane >> 5;
    for (;;) {
        int u = queue_pop(C, ctr, total); if (u < 0) break;
        if (u < NS5) { phase_s5(C, P, u * NWAVES, u * NWAVES + NWAVES, 1, NWAVES); continue; }
        u -= NS5;
        const int qb = 7 - u / NBH, bh = u % NBH, b = bh / DIFF_HEADS, h = bh % DIFF_HEADS;
        const bf16_t* base = proj + (size_t)b * SEQ * AB_IN;
        AttnArgs a; a.ldq = AB_IN; a.ldkn = AB_IN; a.ldkr = 0; a.ldv = AB_IN; a.Qr = nullptr; a.Kr = nullptr;
        a.V = base + 2 * DIFF_W + h * 128;
        f32x16 o2[4];
        bf16_t* dst = concat + (size_t)b * SEQ * DM + h * 128;
        a.Qn = base + h * 128; a.Kn = base + DIFF_W + h * 128;
        attn_core<64, 0>(a, qb * 256, C.lds, 0.125f, o2, qi >= 2 ? PROBE_ATTN_MODE : 0);
        attn_store(o2, dst, DM, qb * 256);
        a.Qn = base + h * 128 + 64; a.Kn = base + DIFF_W + h * 128 + 64;
        attn_core<64, 0>(a, qb * 256, C.lds, 0.125f, o2, qi >= 2 ? PROBE_ATTN_MODE : 0);
        float ss = 0.f;
        {
            const bf16_t* rp = dst + (size_t)(qb * 256 + 32 * C.wave + r32) * DM;
#pragma unroll
            for (int blk = 0; blk < 4; ++blk)
#pragma unroll
                for (int g = 0; g < 4; ++g) {
                    const u32x2 w = *(const u32x2*)(rp + 32 * blk + 8 * g + 4 * hi);
                    const float o1v[4] = {bflo(w.x), bfhi(w.x), bflo(w.y), bfhi(w.y)};
#pragma unroll
                    for (int j = 0; j < 4; ++j) { const float v = o1v[j] - lam * o2[blk][4 * g + j]; o2[blk][4 * g + j] = v; ss += v * v; }
                }
        }
        ss = swap32_sum(ss);
        const float rs = rsqrtf(ss * (1.0f / 128.0f) + NORM_EPS) * 0.8f;
        const float* sub = P.in[I_SUBLN];
#pragma unroll
        for (int blk = 0; blk < 4; ++blk)
#pragma unroll
            for (int r = 0; r < 16; ++r) o2[blk][r] *= rs * sub[32 * blk + crow(r, hi)];
        attn_store(o2, dst, DM, qb * 256);
    }
}
DI void phase_mla_attn(const Ctx& C0, const Params& P, int qi) {
    const Ctx C = fresh(C0);
    unsigned char* ws = P.ws;
    const bf16_t* q = (const bf16_t*)(ws + P_Q); const bf16_t* kv = (const bf16_t*)(ws + P_KV); const bf16_t* kr = (const bf16_t*)(ws + P_KROPE);
    bf16_t* ob = (bf16_t*)(ws + P_H);
    unsigned* ctr = (unsigned*)(ws + WS_CTL) + CW_CTR + 64 * qi;
    const int NBH = BATCH * MLA_HEADS, total = NBH * 8;
    for (;;) {
        const int u = queue_pop(C, ctr, total); if (u < 0) break;
        const int qb = 7 - u / NBH, bh = u % NBH, b = bh / MLA_HEADS, h = bh % MLA_HEADS;
        AttnArgs a; a.ldq = 3072; a.ldkn = 4096; a.ldkr = 64; a.ldv = 4096;
        a.Qn = q + (size_t)b * SEQ * 3072 + h * 192; a.Qr = a.Qn + 128;
        a.Kn = kv + (size_t)b * SEQ * 4096 + h * 256; a.V = a.Kn + 128; a.Kr = kr + (size_t)b * SEQ * 64;
        f32x16 o[4];
        attn_core<128, 64>(a, qb * 256, C.lds, 0.07216878364870322f, o, qi >= 2 ? PROBE_ATTN_MODE : 0);
        attn_store(o, ob + (size_t)b * SEQ * DM + h * 128, DM, qb * 256);
    }
}
#else
template <int DK> DI void naive_attn_row(const bf16_t* qrow, const bf16_t* qrow2, const bf16_t* Kn, int ldkn, const bf16_t* Kr, int ldkr, const bf16_t* V, int ldv, int nkeys, float scale, int lane, float& o0, float& o1) {
    float qv[3];
#pragma unroll
    for (int j = 0; j < 3; ++j) { const int d = lane + 64 * j; qv[j] = 0.f; if (d < DK) qv[j] = (DK == 192 && d >= 128) ? bf2f(qrow2[d - 128]) : bf2f(qrow[d]); }
    float m = -1e30f, l = 0.f; o0 = 0.f; o1 = 0.f;
    for (int k = 0; k < nkeys; ++k) {
        float s = 0.f;
#pragma unroll
        for (int j = 0; j < 3; ++j) { const int d = lane + 64 * j; if (d < DK) { const float kvv = (DK == 192 && d >= 128) ? bf2f(Kr[(size_t)k * ldkr + d - 128]) : bf2f(Kn[(size_t)k * ldkn + d]); s += qv[j] * kvv; } }
        s = wave_sum(s) * scale;
        const float mn = fmaxf(m, s), al = expf(m - mn), p = expf(s - mn);
        m = mn; l = l * al + p;
        o0 = o0 * al + p * bf2f(V[(size_t)k * ldv + lane]); o1 = o1 * al + p * bf2f(V[(size_t)k * ldv + 64 + lane]);
    }
    o0 /= l; o1 /= l;
}
DI void phase_diff_attn(const Ctx& C, const Params& P, int) {
    unsigned char* ws = P.ws;
    const bf16_t* proj = (const bf16_t*)(ws + P_PROJ); bf16_t* concat = (bf16_t*)(ws + P_CONCAT);
    const float lam = diff_lambda(P);
    const int lane = C.lane;
    for (int it = C.blk * NWAVES + C.wave; it < BATCH * DIFF_HEADS * SEQ; it += C.G * NWAVES) {
        const int s = it % SEQ, bh = it / SEQ, b = bh / DIFF_HEADS, h = bh % DIFF_HEADS;
        const bf16_t* base = proj + (size_t)b * SEQ * AB_IN;
        const bf16_t* qrow = base + (size_t)s * AB_IN + h * 128;
        float a0, a1, b0, b1;
        naive_attn_row<64>(qrow, nullptr, base + DIFF_W + h * 128, AB_IN, nullptr, 0, base + 2 * DIFF_W + h * 128, AB_IN, s + 1, 0.125f, lane, a0, a1);
        naive_attn_row<64>(qrow + 64, nullptr, base + DIFF_W + h * 128 + 64, AB_IN, nullptr, 0, base + 2 * DIFF_W + h * 128, AB_IN, s + 1, 0.125f, lane, b0, b1);
        const float v0 = a0 - lam * b0, v1 = a1 - lam * b1;
        const float ss = wave_sum(v0 * v0 + v1 * v1);
        const float rs = rsqrtf(ss * (1.0f / 128.0f) + NORM_EPS) * 0.8f;
        bf16_t* orow = concat + (size_t)(b * SEQ + s) * DM + h * 128;
        orow[lane] = f2bf(v0 * rs * P.in[I_SUBLN][lane]); orow[64 + lane] = f2bf(v1 * rs * P.in[I_SUBLN][64 + lane]);
    }
}
DI void phase_mla_attn(const Ctx& C, const Params& P, int) {
    unsigned char* ws = P.ws;
    const bf16_t* q = (const bf16_t*)(ws + P_Q); const bf16_t* kv = (const bf16_t*)(ws + P_KV); const bf16_t* kr = (const bf16_t*)(ws + P_KROPE);
    bf16_t* ob = (bf16_t*)(ws + P_H);
    const int lane = C.lane;
    for (int it = C.blk * NWAVES + C.wave; it < BATCH * MLA_HEADS * SEQ; it += C.G * NWAVES) {
        const int s = it % SEQ, bh = it / SEQ, b = bh / MLA_HEADS, h = bh % MLA_HEADS;
        const bf16_t* qrow = q + (size_t)(b * SEQ + s) * 3072 + h * 192;
        const bf16_t* kn = kv + (size_t)b * SEQ * 4096 + h * 256;
        float a0, a1;
        naive_attn_row<192>(qrow, qrow + 128, kn, 4096, kr + (size_t)b * SEQ * 64, 64, kn + 128, 4096, s + 1, 0.07216878364870322f, lane, a0, a1);
        bf16_t* orow = ob + (size_t)(b * SEQ + s) * DM + h * 128;
        orow[lane] = f2bf(a0); orow[64 + lane] = f2bf(a1);
    }
}
#endif

DI void phase_mla_rows(const Ctx& C0, const Params& P) {
    const Ctx C = fresh(C0);
    unsigned char* ws = P.ws;
    const bf16_t* mp = (const bf16_t*)(ws + P_MLAPROJ); bf16_t* cqn = (bf16_t*)(ws + P_CQN); bf16_t* ckvn = (bf16_t*)(ws + P_CKVN); bf16_t* krp = (bf16_t*)(ws + P_KROPE);
    const f32x2* tab = (const f32x2*)(ws + WS_ROPE);
    const int lane = C.lane;
    const int r0 = C.blk * NWAVES + C.wave, rstep = C.G * NWAVES;
    if (r0 >= T) return;
    const int* posp = (const int*)P.in[I_POS];
    u32x2 nw[3], nwkv; unsigned nwr; float nssv; f32x2 ncs; int npos;
#define MR_LOAD(R) do { const bf16_t* row_ = mp + (size_t)(R) * MLA_IN_PAD; \
        _Pragma("unroll") for (int j = 0; j < 3; ++j) nw[j] = *(const u32x2*)(row_ + 4 * (lane + 64 * j)); \
        nwkv = *(const u32x2*)(row_ + MLA_QR + 4 * lane); nwr = *(const unsigned*)(row_ + 1024 + 2 * (lane & 31)); nssv = ((const float*)(ws + P_SS))[(size_t)(R) * 32 + (lane & 7)]; } while (0)
#define MR_CLAMP(p_) ((p_) < 0 ? 0 : ((p_) > ROPE_POS - 1 ? ROPE_POS - 1 : (p_)))
    MR_LOAD(r0);
    { const int p0 = posp[r0]; ncs = tab[(size_t)MR_CLAMP(p0) * 32 + (lane & 31)]; }
    npos = posp[(r0 + rstep < T) ? r0 + rstep : r0];
    for (int r = r0; r < T; r += rstep) {
        u32x2 cw[3], cwkv; unsigned cwr; float cssv; f32x2 cs;
#pragma unroll
        for (int j = 0; j < 3; ++j) cw[j] = nw[j];
        cwkv = nwkv; cwr = nwr; cssv = nssv; cs = ncs;
        {
            const int rn = (r + rstep < T) ? r + rstep : r, rnn = (rn + rstep < T) ? rn + rstep : rn;
            MR_LOAD(rn);
            ncs = tab[(size_t)MR_CLAMP(npos) * 32 + (lane & 31)];
            npos = posp[rnn];
        }
        const float rs = rsqrtf(wave_sum((lane < 8) ? cssv : 0.f) * (1.0f / DM) + NORM_EPS);
        const float eps_raw = NORM_EPS / (rs * rs);
        float v[12]; float ss = 0.f;
#pragma unroll
        for (int j = 0; j < 3; ++j) { const u32x2 w = cw[j]; v[4 * j] = bflo(w.x); v[4 * j + 1] = bfhi(w.x); v[4 * j + 2] = bflo(w.y); v[4 * j + 3] = bfhi(w.y); }
#pragma unroll
        for (int j = 0; j < 12; ++j) ss += v[j] * v[j];
        float sc = rsqrtf(wave_sum(ss) * (1.0f / MLA_QR) + eps_raw);
#pragma unroll
        for (int j = 0; j < 3; ++j) { const f32x4 g = *(const f32x4*)(P.in[I_MLA_QNORM] + 4 * (lane + 64 * j));
            u32x2 w; w.x = pk2(v[4 * j] * sc * g[0], v[4 * j + 1] * sc * g[1]); w.y = pk2(v[4 * j + 2] * sc * g[2], v[4 * j + 3] * sc * g[3]);
            *(u32x2*)(cqn + (size_t)r * MLA_QR + 4 * (lane + 64 * j)) = w; }
        {
            const u32x2 w = cwkv;
            const float a0 = bflo(w.x), a1 = bfhi(w.x), a2 = bflo(w.y), a3 = bfhi(w.y);
            const float s2 = rsqrtf(wave_sum(a0 * a0 + a1 * a1 + a2 * a2 + a3 * a3) * (1.0f / MLA_KVR) + eps_raw);
            const f32x4 g = *(const f32x4*)(P.in[I_MLA_KVNORM] + 4 * lane);
            u32x2 o; o.x = pk2(a0 * s2 * g[0], a1 * s2 * g[1]); o.y = pk2(a2 * s2 * g[2], a3 * s2 * g[3]);
            *(u32x2*)(ckvn + (size_t)r * MLA_KVR + 4 * lane) = o;
        }
        if (lane < 32) {
            const float x1 = bflo(cwr) * rs, x2 = bfhi(cwr) * rs;
            *(unsigned*)(krp + (size_t)r * 64 + 2 * lane) = pk2(x1 * cs[0] - x2 * cs[1], x2 * cs[0] + x1 * cs[1]);
        }
    }
#undef MR_LOAD
#undef MR_CLAMP
}

DI void phase_xa_softmax(const Ctx& C0, const Params& P) {
    const Ctx C = fresh(C0);
    unsigned char* ws = P.ws;
    const bf16_t* S = (const bf16_t*)(ws + P_S); bf16_t* Pb = (bf16_t*)(ws + P_P);
    const int lane = C.lane, hd = lane >> 4, li = lane & 15;
    const int r0 = C.blk * NWAVES + C.wave, rstep = C.G * NWAVES;
    if (r0 >= T) return;
    u32x2 nw[4]; float nssv;
#define XS_LOAD(R) do { const bf16_t* row_ = S + (size_t)(R) * 1024 + hd * 256; _Pragma("unroll") for (int j = 0; j < 4; ++j) nw[j] = *(const u32x2*)(row_ + 4 * (li + 16 * j)); \
        nssv = ((const float*)(ws + P_SS))[(size_t)(R) * 32 + (lane & 31)]; } while (0)
    XS_LOAD(r0);
    for (int r = r0; r < T; r += rstep) {
        u32x2 cw[4];
#pragma unroll
        for (int j = 0; j < 4; ++j) cw[j] = nw[j];
        const float cssv = nssv;
        { const int rn = (r + rstep < T) ? r + rstep : r; XS_LOAD(rn); }
        const float rs = rsqrtf(wave_sum((lane < 32) ? cssv : 0.f) * (1.0f / DM) + NORM_EPS);
        f32x4 v[4]; float mx = -1e30f;
#pragma unroll
        for (int j = 0; j < 4; ++j) { const u32x2 w = cw[j]; v[j] = (f32x4){bflo(w.x), bfhi(w.x), bflo(w.y), bfhi(w.y)} * rs; mx = fmaxf(mx, fmaxf(fmaxf(v[j][0], v[j][1]), fmaxf(v[j][2], v[j][3]))); }
        mx = row16_max(mx);
        float sm = 0.f;
#pragma unroll
        for (int j = 0; j < 4; ++j) { v[j][0] = __expf(v[j][0] - mx); v[j][1] = __expf(v[j][1] - mx); v[j][2] = __expf(v[j][2] - mx); v[j][3] = __expf(v[j][3] - mx); sm += (v[j][0] + v[j][1]) + (v[j][2] + v[j][3]); }
        sm = row16_sum(sm);
        const float inv = 1.0f / sm;
        bf16_t* orow = Pb + (size_t)r * 1024 + hd * 256;
#pragma unroll
        for (int j = 0; j < 4; ++j) { u32x2 w; w.x = pk2(v[j][0] * inv, v[j][1] * inv); w.y = pk2(v[j][2] * inv, v[j][3] * inv); *(u32x2*)(orow + 4 * (li + 16 * j)) = w; }
    }
#undef XS_LOAD
}

template <int N> DI void bitonic_sort_desc(unsigned (&v)[N]) {
#pragma unroll
    for (int k = 2; k <= N; k <<= 1)
#pragma unroll
        for (int j = k >> 1; j > 0; j >>= 1)
#pragma unroll
            for (int i = 0; i < N; ++i) { const int l = i ^ j;
                if (l > i) { const bool desc = ((i & k) == 0); const unsigned a = v[i], b = v[l], mx = a > b ? a : b, mn = a > b ? b : a; v[i] = desc ? mx : mn; v[l] = desc ? mn : mx; } }
}
template <int N> DI void oem_sort_desc(unsigned (&v)[N]) {
#pragma unroll
    for (int p = 1; p < N; p <<= 1)
#pragma unroll
        for (int k = p; k >= 1; k >>= 1)
#pragma unroll
            for (int j = k % p; j <= N - 1 - k; j += 2 * k)
#pragma unroll
                for (int i = 0; i < k; ++i)
                    if (i + j + k < N && (i + j) / (2 * p) == (i + j + k) / (2 * p)) { const unsigned a = v[i + j], b = v[i + j + k]; v[i + j] = a > b ? a : b; v[i + j + k] = a > b ? b : a; }
}
DI void top16_of_32(const unsigned (&k)[32], unsigned (&t)[16]) {
    unsigned a[16], b[16];
#pragma unroll
    for (int i = 0; i < 16; ++i) { a[i] = k[i]; b[i] = k[16 + i]; }
    oem_sort_desc<16>(a); oem_sort_desc<16>(b);
#pragma unroll
    for (int i = 0; i < 16; ++i) t[i] = a[i] > b[15 - i] ? a[i] : b[15 - i];
#pragma unroll
    for (int j = 8; j > 0; j >>= 1)
#pragma unroll
        for (int i = 0; i < 16; ++i) { const int l = i ^ j; if (l > i) { const unsigned x = t[i], y = t[l]; t[i] = x > y ? x : y; t[l] = x > y ? y : x; } }
}
template <int D> DI void merge_top16(unsigned (&t)[16]) {
    static_assert(D == 1 || D == 2, "quad-local exchange");
    unsigned c[16];
#pragma unroll
    for (int i = 0; i < 16; ++i) { const unsigned o = (unsigned)__builtin_amdgcn_update_dpp(0, (int)t[15 - i], D == 1 ? 0xB1 : 0x4E, 0xF, 0xF, true);
        c[i] = t[i] > o ? t[i] : o; }
#pragma unroll
    for (int j = 8; j > 0; j >>= 1)
#pragma unroll
        for (int i = 0; i < 16; ++i) { const int l = i ^ j; if (l > i) { const unsigned a = c[i], b = c[l]; c[i] = a > b ? a : b; c[l] = a > b ? b : a; } }
#pragma unroll
    for (int i = 0; i < 16; ++i) t[i] = c[i];
}
DI void phase_peer_topk(const Ctx& C0, const Params& P) {
    const Ctx C = fresh(C0);
    unsigned char* ws = P.ws;
    const bf16_t* sc = (const bf16_t*)(ws + P_SC); const bf16_t* xbp = (const bf16_t*)(ws + P_XB); const float* ssp = (const float*)(ws + P_SS);
    LAS unsigned char* my = C.lds + C.wave * 4096;
    LAS float* top_s = (LAS float*)my;
    LAS int* top_i = (LAS int*)(my + 1024);
    LAS float* best_s = (LAS float*)(my + 2048);
    LAS int* best_p = (LAS int*)(my + 2560);
    const int lane = C.lane, g = lane >> 2, qd = lane & 3;
    const int stride = C.G * NWAVES;
    int tok = C.blk * NWAVES + C.wave;
    if (tok >= T) return;
    u32x4 scw[4], xw[4]; float ssv;
#define TK_LOAD(TOK) do { const u32x4* sp_ = (const u32x4*)(sc + (size_t)(TOK) * 2048 + g * 128 + qd * 32); const u32x4* xp_ = (const u32x4*)(xbp + (size_t)(TOK) * DM + 32 * lane); \
        _Pragma("unroll") for (int i = 0; i < 4; ++i) { scw[i] = sp_[i]; xw[i] = xp_[i]; } ssv = ssp[(size_t)(TOK) * 32 + (lane & 31)]; } while (0)
    TK_LOAD(tok);
    int s2a[16], s2b[16]; unsigned s2k[16];
    {
        const int h = (lane >> 2) & 7, sub = lane & 3;
#pragma unroll
        for (int c2 = 0; c2 < 16; ++c2) {
            int ci, cj;
            if (sub == 0) { ci = 0; cj = c2; }
            else if (sub == 1) { ci = c2 < 8 ? 1 : c2 < 13 ? 2 : 4; cj = c2 < 8 ? c2 : c2 < 13 ? c2 - 8 : c2 - 13; }
            else if (sub == 2) { ci = c2 < 4 ? 3 : c2 < 10 ? 5 + ((c2 - 4) >> 1) : 8 + (c2 - 10); cj = c2 < 4 ? c2 : c2 < 10 ? ((c2 - 4) & 1) : 0; }
            else { ci = c2 < 2 ? 14 + c2 : -1; cj = 0; }
            s2a[c2] = ci < 0 ? 3072 : 4 * ((2 * h) * 16 + ci); s2b[c2] = ci < 0 ? 3072 : 4 * ((2 * h + 1) * 16 + cj); s2k[c2] = ci < 0 ? 0u : (unsigned)(255 - (16 * ci + cj));
        }
        if (lane == 0) *(LAS float*)(my + 3072) = -INFINITY;
        LDS_WAIT(); asm volatile("" ::: "memory");
    }
    for (; tok < T; tok += stride) {
        unsigned k[32];
#pragma unroll
        for (int j = 0; j < 8; ++j) { const u32x4 w4 = scw[j >> 1]; const unsigned wa = (j & 1) ? w4.z : w4.x, wb = (j & 1) ? w4.w : w4.y; const unsigned bits[4] = {wa << 16, wa & 0xffff0000u, wb << 16, wb & 0xffff0000u};
#pragma unroll
            for (int e = 0; e < 4; ++e) { unsigned u = bits[e]; u ^= (unsigned)((int)u >> 31) | 0x80000000u; k[4 * j + e] = (u & ~127u) | (unsigned)(127 - (32 * qd + 4 * j + e)); } }
        const float rstd = rsqrtf(wave_sum((lane < 32) ? ssv : 0.f) * (1.0f / DM) + NORM_EPS);
        {
            float am = 0.f;
#pragma unroll
            for (int i = 0; i < 4; ++i) { const unsigned w4[4] = {xw[i].x, xw[i].y, xw[i].z, xw[i].w};
#pragma unroll
                for (int q = 0; q < 4; ++q) am = fmaxf(am, fmaxf(fabsf(bflo(w4[q])), fabsf(bfhi(w4[q])))); }
            am = wave_max(am);
            const float tscale = am > 0.f ? 119.0f / am : 0.f;
            if (lane == 0) ((float*)(ws + P_PE_TSC))[tok] = am * (1.0f / 119.0f) * rstd;
            unsigned qd8[8];
#pragma unroll
            for (int i = 0; i < 4; ++i) { const unsigned w4[4] = {xw[i].x, xw[i].y, xw[i].z, xw[i].w};
#pragma unroll
                for (int h2 = 0; h2 < 2; ++h2) qd8[2 * i + h2] = q8x4(bflo(w4[2 * h2]), bfhi(w4[2 * h2]), bflo(w4[2 * h2 + 1]), bfhi(w4[2 * h2 + 1]), tscale); }
            unsigned th4[4], tl4[4];
#pragma unroll
            for (int d = 0; d < 4; ++d) {
                const unsigned A = qd8[2 * d], B = qd8[2 * d + 1];
                const unsigned sa = ((A & 0x7f7f7f7fu) + 0x08080808u) ^ (A & 0x80808080u), sb = ((B & 0x7f7f7f7fu) + 0x08080808u) ^ (B & 0x80808080u);
                tl4[d] = (A & 0x0f0f0f0fu) | ((B & 0x0f0f0f0fu) << 4);
                th4[d] = ((sa >> 4) & 0x0f0f0f0fu) | (sb & 0xf0f0f0f0u);
            }
            u32x4* t8p = (u32x4*)(ws + P_PE_T8 + (size_t)tok * DM + 32 * lane);
            t8p[0] = (u32x4){th4[0], th4[1], th4[2], th4[3]}; t8p[1] = (u32x4){tl4[0], tl4[1], tl4[2], tl4[3]};
        }
        { const int ntok = (tok + stride < T) ? tok + stride : tok; TK_LOAD(ntok); }
        unsigned t16[16];
        top16_of_32(k, t16);
        merge_top16<1>(t16); merge_top16<2>(t16);
#pragma unroll
        for (int i = 0; i < 4; ++i) { const int r = 4 * qd + i;
            unsigned m = t16[0];
#pragma unroll
            for (int rr = 1; rr < 16; ++rr) m = (rr == r) ? t16[rr] : m;
            top_i[g * 16 + r] = 127 - (int)(m & 127u); top_s[g * 16 + r] = __uint_as_float((m & 0x80000000u) ? (m & 0x7fffff80u) : ~(m | 127u)); }
        LDS_WAIT(); asm volatile("" ::: "memory");
        {
            const int h = (lane >> 2) & 7, sub = lane & 3;
            unsigned kk[16];
#pragma unroll
            for (int c2 = 0; c2 < 16; ++c2) {
                unsigned u0 = __float_as_uint(*(const LAS float*)(my + s2a[c2]) + *(const LAS float*)(my + s2b[c2]));
                u0 ^= (unsigned)((int)u0 >> 31) | 0x80000000u;
                kk[c2] = (u0 & ~255u) | s2k[c2]; }
            oem_sort_desc<16>(kk);
            merge_top16<1>(kk); merge_top16<2>(kk);
#pragma unroll
            for (int i = 0; i < 4; ++i) { const int r = 4 * sub + i;
                unsigned m = kk[0];
#pragma unroll
                for (int rr = 1; rr < 16; ++rr) m = (rr == r) ? kk[rr] : m;
                best_p[h * 16 + r] = 255 - (int)(m & 255u); }
        }
        LDS_WAIT(); asm volatile("" ::: "memory");
        int pos2[2];
#pragma unroll
        for (int e2 = 0; e2 < 2; ++e2) { const int idx = lane + 64 * e2, h = idx >> 4; pos2[e2] = best_p[idx]; best_s[idx] = (top_s[(2 * h) * 16 + (pos2[e2] >> 4)] + top_s[(2 * h + 1) * 16 + (pos2[e2] & 15)]) * rstd; }
        LDS_WAIT(); asm volatile("" ::: "memory");
        int* pe = (int*)(ws + P_PE_E) + (size_t)tok * 128; float* pg = (float*)(ws + P_PE_G) + (size_t)tok * 128;
#pragma unroll
        for (int e2 = 0; e2 < 2; ++e2) {
            const int idx = lane + 64 * e2, h = idx >> 4;
            float mx = -1e30f;
#pragma unroll
            for (int kk = 0; kk < 16; ++kk) mx = fmaxf(mx, best_s[h * 16 + kk]);
            float sm = 0.f;
#pragma unroll
            for (int kk = 0; kk < 16; ++kk) sm += __expf(best_s[h * 16 + kk] - mx);
            pg[idx] = __expf(best_s[idx] - mx) / sm;
            const int eid = top_i[(2 * h) * 16 + (pos2[e2] >> 4)] * 128 + top_i[(2 * h + 1) * 16 + (pos2[e2] & 15)];
            pe[idx] = eid; ((unsigned short*)(ws + P_PE_E16))[(size_t)tok * 128 + idx] = (unsigned short)eid;
        }
        LDS_WAIT(); asm volatile("" ::: "memory");
    }
#undef TK_LOAD
}

#if PEER_SLICED
DI int peer_cj(int j) { return ((j >> 3) & 1) | (((j >> 2) & 1) << 1) | (((j >> 1) & 1) << 2); }
constexpr int PEER_CHUNK = 1024, PEER_NCHUNK = T / PEER_CHUNK;
DI int peer_cjh(int half, int jj) { return half | (((jj >> 2) & 1) << 1) | (((jj >> 1) & 1) << 2); }
#define PEER_ISSUE(RW, ELO, EHI, HALF) do { _Pragma("unroll") for (int jj = 0; jj < 8; ++jj) { \
        const int e_ = __shfl((jj & 1) ? (EHI) : (ELO), (lane & ~7) | peer_cjh((HALF), jj)); \
        RW[jj] = *(const u32x4*)(tabs + (size_t)(MODE == 2 ? (e_ & 1) : e_) * 128 + 16 * (lane & 7)); } } while (0)
template <int SIDE  , int MODE = 0  >
DI void phase_peer_sliced(const Ctx& C0, const Params& P, int qbase) {
    const Ctx C = fresh(C0);
    unsigned char* ws = P.ws;
    const bf16_t* hb = (const bf16_t*)(ws + P_H);
    const unsigned char* tab8 = ws + (SIDE == 0 ? P_UT : P_VT);
    const int* pe = (const int*)(ws + P_PE_E); const float* pg = (const float*)(ws + P_PE_G);
    const int lane = C.lane, a = lane >> 3, c = lane & 7;
    const int x = (int)(xb_xcc_id() & 7u);
    for (int i = 0; i < 8; ++i) {
        const int s = (x + i) & 7;
        unsigned* ctr = (unsigned*)(ws + WS_CTL) + CW_CTR + 64 * (qbase + s);
        const unsigned char* tabs = tab8 + (size_t)s * ((size_t)PEER_NE * 128);
        const unsigned coff = 16u * (unsigned)c;
        for (;;) {
            const int ch = queue_pop(C, ctr, PEER_NCHUNK); if (ch < 0) break;
            const int tok0 = ch * PEER_CHUNK + C.wave;
            constexpr int NTOK = PEER_CHUNK / NWAVES;
            if constexpr (SIDE == 0) {
            const unsigned short* e16 = (const unsigned short*)(ws + P_PE_E16);
#define PU_CQ(H, JJ) (((H) << 2) | (((JJ) >> 2) & 1) | ((((JJ) >> 1) & 1) << 1))
#define PU_IDS(I0, I1, TOK) do { I0 = *(const u32x4*)(e16 + (size_t)(TOK) * 128 + 8 * a); I1 = *(const u32x4*)(e16 + (size_t)(TOK) * 128 + 64 + 8 * a); } while (0)
#define PU_DW(I, K) ((K) == 0 ? I.x : (K) == 1 ? I.y : (K) == 2 ? I.z : I.w)
#define PU_EID(I0, I1, H, JJ) ((PU_CQ(H, JJ) & 1) ? (((JJ) & 1) ? PU_DW(I1, PU_CQ(H, JJ) >> 1) : PU_DW(I0, PU_CQ(H, JJ) >> 1)) >> 16 : ((((JJ) & 1) ? PU_DW(I1, PU_CQ(H, JJ) >> 1) : PU_DW(I0, PU_CQ(H, JJ) >> 1)) & 0xffffu))
#define PU_ISSUE(RW, I0, I1, H) do { _Pragma("unroll") for (int jj = 0; jj < 8; ++jj) { const unsigned e_ = PU_EID(I0, I1, H, jj); RW[jj] = *(const u32x4*)(tabs + (size_t)(e_ * 128u + coff)); } } while (0)
#define PU_DOT(RW, H) do { _Pragma("unroll") for (int jj = 0; jj < 8; ++jj) { int sh = 0, sl = 0; \
                        sh = __builtin_amdgcn_sdot8((int)RW[jj].x, (int)ta.x, sh, false); sl = __builtin_amdgcn_sdot8((int)RW[jj].x, (int)tb.x, sl, false); \
                        sh = __builtin_amdgcn_sdot8((int)RW[jj].y, (int)ta.y, sh, false); sl = __builtin_amdgcn_sdot8((int)RW[jj].y, (int)tb.y, sl, false); \
                        sh = __builtin_amdgcn_sdot8((int)RW[jj].z, (int)ta.z, sh, false); sl = __builtin_amdgcn_sdot8((int)RW[jj].z, (int)tb.z, sl, false); \
                        sh = __builtin_amdgcn_sdot8((int)RW[jj].w, (int)ta.w, sh, false); sl = __builtin_amdgcn_sdot8((int)RW[jj].w, (int)tb.w, sl, false); \
                        d[8 * (H) + jj] = (sh << 4) + sl; } } while (0)
#define PU_TLOAD(TA, TB, TOK) do { const u32x4* tp_ = (const u32x4*)(ws + P_PE_T8 + (size_t)(TOK) * DM + s * 256 + 32 * c); TA = tp_[0]; TB = tp_[1]; } while (0)
#define PU_ISSUE4(RW, I0, I1, ST) do { _Pragma("unroll") for (int j4 = 0; j4 < 4; ++j4) { const unsigned e_ = PU_EID(I0, I1, (ST) >> 1, 4 * ((ST) & 1) + j4); RW[j4] = *(const u32x4*)(tabs + (size_t)(e_ * 128u + coff)); } } while (0)
#define PU_DOT4(RW, ST) do { _Pragma("unroll") for (int j4 = 0; j4 < 4; ++j4) { int sh = 0, sl = 0; \
                        sh = __builtin_amdgcn_sdot8((int)RW[j4].x, (int)ta.x, sh, false); sl = __builtin_amdgcn_sdot8((int)RW[j4].x, (int)tb.x, sl, false); \
                        sh = __builtin_amdgcn_sdot8((int)RW[j4].y, (int)ta.y, sh, false); sl = __builtin_amdgcn_sdot8((int)RW[j4].y, (int)tb.y, sl, false); \
                        sh = __builtin_amdgcn_sdot8((int)RW[j4].z, (int)ta.z, sh, false); sl = __builtin_amdgcn_sdot8((int)RW[j4].z, (int)tb.z, sl, false); \
                        sh = __builtin_amdgcn_sdot8((int)RW[j4].w, (int)ta.w, sh, false); sl = __builtin_amdgcn_sdot8((int)RW[j4].w, (int)tb.w, sl, false); \
                        d[4 * (ST) + j4] = (sh << 4) + sl; } } while (0)
            u32x4 q0[4], q1[4], q2[4], q3[4];
            u32x4 i0, i1; PU_IDS(i0, i1, tok0);
            u32x4 ni0, ni1; PU_IDS(ni0, ni1, tok0 + NWAVES);
            u32x4 ta, tb; PU_TLOAD(ta, tb, tok0);
            asm volatile("" :: "v"(i0), "v"(i1), "v"(ni0), "v"(ni1), "v"(ta), "v"(tb));
            PU_ISSUE4(q0, i0, i1, 0); PU_ISSUE4(q1, i0, i1, 1); PU_ISSUE4(q2, i0, i1, 2);
#pragma unroll 1
            for (int it = 0; it < NTOK; ++it) {
                const int tok = tok0 + NWAVES * it, ntok = (it + 1 < NTOK) ? tok + NWAVES : tok, nntok = (it + 2 < NTOK) ? tok + 2 * NWAVES : tok;
                u32x4 nni0, nni1; PU_IDS(nni0, nni1, nntok);
                u32x4 nta, ntb; PU_TLOAD(nta, ntb, ntok);
                PU_ISSUE4(q3, i0, i1, 3);
                int d[16];
                __builtin_amdgcn_sched_barrier(0);
                PU_DOT4(q0, 0); __builtin_amdgcn_sched_barrier(0); PU_ISSUE4(q0, ni0, ni1, 0); __builtin_amdgcn_sched_barrier(0);
                PU_DOT4(q1, 1); __builtin_amdgcn_sched_barrier(0); PU_ISSUE4(q1, ni0, ni1, 1); __builtin_amdgcn_sched_barrier(0);
                PU_DOT4(q2, 2); __builtin_amdgcn_sched_barrier(0); PU_ISSUE4(q2, ni0, ni1, 2); __builtin_amdgcn_sched_barrier(0);
                PU_DOT4(q3, 3);
                int n8[8], n4[4], n2[2];
                { const bool b = c & 4;
#pragma unroll
                  for (int j = 0; j < 8; ++j) { const int snd = b ? d[j] : d[8 + j], kp = b ? d[8 + j] : d[j]; n8[j] = kp + __builtin_amdgcn_update_dpp(0, snd, 0x141, 0xF, 0xF, true); } }
                { const bool b = c & 1;
#pragma unroll
                  for (int j = 0; j < 4; ++j) { const int snd = b ? n8[j] : n8[4 + j], kp = b ? n8[4 + j] : n8[j]; n4[j] = kp + __builtin_amdgcn_update_dpp(0, snd, 0xB1, 0xF, 0xF, true); } }
                { const bool b = c & 2;
#pragma unroll
                  for (int j = 0; j < 2; ++j) { const int snd = b ? n4[j] : n4[2 + j], kp = b ? n4[2 + j] : n4[j]; n2[j] = kp + __builtin_amdgcn_update_dpp(0, snd, 0x4E, 0xF, 0xF, true); } }
                unsigned* pp = (unsigned*)(ws + P_SC) + ((size_t)s * T + tok) * 64;
                pp[lane] = (unsigned)(((n2[0] + 4) >> 3) & 0xffff) | ((unsigned)((n2[1] + 4) >> 3) << 16);
                i0 = ni0; i1 = ni1; ni0 = nni0; ni1 = nni1; ta = nta; tb = ntb;
            }
#undef PU_CQ
#undef PU_IDS
#undef PU_DW
#undef PU_EID
#undef PU_ISSUE
#undef PU_DOT
#undef PU_ISSUE4
#undef PU_DOT4
#undef PU_TLOAD
            } else
            {
                const unsigned short* e16 = (const unsigned short*)(ws + P_PE_E16); const unsigned char* w8 = ws + P_PE_W8; const float* wsc = (const float*)(ws + P_PE_WSC);
#define PV_TOKLOAD(I0, I1, WQ, WS_, TOK) do { const u32x4* ip_ = (const u32x4*)(e16 + (size_t)(TOK) * 128 + 16 * a); I0 = ip_[0]; I1 = ip_[1]; WQ = *(const u32x4*)(w8 + (size_t)(TOK) * 128 + 16 * a); WS_ = wsc[TOK]; } while (0)
#define PV_EID(I0, I1, J) ((((J) & 1) ? ((J) < 8 ? ((J) >> 1 == 0 ? I0.x : (J) >> 1 == 1 ? I0.y : (J) >> 1 == 2 ? I0.z : I0.w) : ((J) >> 1 == 4 ? I1.x : (J) >> 1 == 5 ? I1.y : (J) >> 1 == 6 ? I1.z : I1.w)) >> 16 \
                                      : ((J) < 8 ? ((J) >> 1 == 0 ? I0.x : (J) >> 1 == 1 ? I0.y : (J) >> 1 == 2 ? I0.z : I0.w) : ((J) >> 1 == 4 ? I1.x : (J) >> 1 == 5 ? I1.y : (J) >> 1 == 6 ? I1.z : I1.w)) & 0xffffu))
#define PV_ISSUE(RW, I0, I1, HALF) do { _Pragma("unroll") for (int jj = 0; jj < 8; ++jj) { const unsigned e_ = PV_EID(I0, I1, 8 * (HALF) + jj); RW[jj] = *(const u32x4*)(tabs + (size_t)(e_ * 128u + coff)); } } while (0)
#define PV_DOT4(RW, G, WD) do { _Pragma("unroll") for (int q = 0; q < 4; ++q) { \
                    const unsigned r0 = (q == 0) ? RW[4 * (G)].x : (q == 1) ? RW[4 * (G)].y : (q == 2) ? RW[4 * (G)].z : RW[4 * (G)].w; \
                    const unsigned r1 = (q == 0) ? RW[4 * (G) + 1].x : (q == 1) ? RW[4 * (G) + 1].y : (q == 2) ? RW[4 * (G) + 1].z : RW[4 * (G) + 1].w; \
                    const unsigned r2 = (q == 0) ? RW[4 * (G) + 2].x : (q == 1) ? RW[4 * (G) + 2].y : (q == 2) ? RW[4 * (G) + 2].z : RW[4 * (G) + 2].w; \
                    const unsigned r3 = (q == 0) ? RW[4 * (G) + 3].x : (q == 1) ? RW[4 * (G) + 3].y : (q == 2) ? RW[4 * (G) + 3].z : RW[4 * (G) + 3].w; \
                    const unsigned lo01 = __builtin_amdgcn_perm(r1, r0, 0x05010400u), hi01 = __builtin_amdgcn_perm(r1, r0, 0x07030602u); \
                    const unsigned lo23 = __builtin_amdgcn_perm(r3, r2, 0x05010400u), hi23 = __builtin_amdgcn_perm(r3, r2, 0x07030602u); \
                    const unsigned c0 = __builtin_amdgcn_perm(lo23, lo01, 0x05040100u), c1 = __builtin_amdgcn_perm(lo23, lo01, 0x07060302u); \
                    const unsigned c2 = __builtin_amdgcn_perm(hi23, hi01, 0x05040100u), c3 = __builtin_amdgcn_perm(hi23, hi01, 0x07060302u); \
                    acc[8 * q + 0] = __builtin_amdgcn_sdot4((int)(c0 & 0x0f0f0f0fu), (int)(WD), acc[8 * q + 0], false); acc[8 * q + 4] = __builtin_amdgcn_sdot4((int)(c0 & 0xf0f0f0f0u), (int)(WD), acc[8 * q + 4], false); \
                    acc[8 * q + 1] = __builtin_amdgcn_sdot4((int)(c1 & 0x0f0f0f0fu), (int)(WD), acc[8 * q + 1], false); acc[8 * q + 5] = __builtin_amdgcn_sdot4((int)(c1 & 0xf0f0f0f0u), (int)(WD), acc[8 * q + 5], false); \
                    acc[8 * q + 2] = __builtin_amdgcn_sdot4((int)(c2 & 0x0f0f0f0fu), (int)(WD), acc[8 * q + 2], false); acc[8 * q + 6] = __builtin_amdgcn_sdot4((int)(c2 & 0xf0f0f0f0u), (int)(WD), acc[8 * q + 6], false); \
                    acc[8 * q + 3] = __builtin_amdgcn_sdot4((int)(c3 & 0x0f0f0f0fu), (int)(WD), acc[8 * q + 3], false); acc[8 * q + 7] = __builtin_amdgcn_sdot4((int)(c3 & 0xf0f0f0f0u), (int)(WD), acc[8 * q + 7], false); } } while (0)
#define PV_ISSUE4(RW, I0, I1, ST) do { _Pragma("unroll") for (int jj = 0; jj < 4; ++jj) { const unsigned e_ = PV_EID(I0, I1, 4 * (ST) + jj); RW[jj] = *(const u32x4*)(tabs + (size_t)(e_ * 128u + coff)); } } while (0)
                u32x4 i0, i1, wq; float wsv;
                PV_TOKLOAD(i0, i1, wq, wsv, tok0);
                u32x4 ni0, ni1, nwq; float nwsv;
                PV_TOKLOAD(ni0, ni1, nwq, nwsv, tok0 + NWAVES);
                asm volatile("" :: "v"(i0), "v"(i1), "v"(wq), "v"(wsv), "v"(ni0), "v"(ni1), "v"(nwq), "v"(nwsv));
                u32x4 q0[4], q1[4], q2[4], q3[4];
                PV_ISSUE4(q0, i0, i1, 0); PV_ISSUE4(q1, i0, i1, 1); PV_ISSUE4(q2, i0, i1, 2);
#pragma unroll 1
                for (int it = 0; it < NTOK; ++it) {
                    const int tok = tok0 + NWAVES * it, ntok = (it + 1 < NTOK) ? tok + NWAVES : tok;
                    u32x2* xp = (u32x2*)((bf16_t*)(ws + P_XB) + (size_t)tok * DM + s * 256 + 32 * c + 16 * (a & 1) + 8 * ((a >> 1) & 1) + 4 * ((a >> 2) & 1));
                    const u32x2 xw = *xp;
                    const int nntok = (it + 2 < NTOK) ? tok + 2 * NWAVES : tok; (void)ntok;
                    u32x4 nni0, nni1, nnwq; float nnwsv;
                    PV_TOKLOAD(nni0, nni1, nnwq, nnwsv, nntok);
                    PV_ISSUE4(q3, i0, i1, 3);
                    int acc[32];
                    {
                        const int wb = -8 * __builtin_amdgcn_sdot4((int)wq.x, 0x01010101, __builtin_amdgcn_sdot4((int)wq.y, 0x01010101, __builtin_amdgcn_sdot4((int)wq.z, 0x01010101, __builtin_amdgcn_sdot4((int)wq.w, 0x01010101, 0, false), false), false), false);
#pragma unroll
                        for (int q = 0; q < 32; ++q) acc[q] = (q & 4) ? 0 : wb; }
                    __builtin_amdgcn_sched_barrier(0);
                    PV_DOT4(q0, 0, wq.x); __builtin_amdgcn_sched_barrier(0); PV_ISSUE4(q0, ni0, ni1, 0); __builtin_amdgcn_sched_barrier(0);
                    PV_DOT4(q1, 0, wq.y); __builtin_amdgcn_sched_barrier(0); PV_ISSUE4(q1, ni0, ni1, 1); __builtin_amdgcn_sched_barrier(0);
                    PV_DOT4(q2, 0, wq.z); __builtin_amdgcn_sched_barrier(0); PV_ISSUE4(q2, ni0, ni1, 2); __builtin_amdgcn_sched_barrier(0);
                    PV_DOT4(q3, 0, wq.w);
                    int n16[16], n8[8], n4[4];
                    { const bool b_ = a & 1;
#pragma unroll
                      for (int q = 0; q < 16; ++q) { const int snd = b_ ? acc[q] : acc[16 + q], kp = b_ ? acc[16 + q] : acc[q]; n16[q] = kp + __builtin_amdgcn_update_dpp(0, snd, 0x128, 0xF, 0xF, true); } }
#pragma unroll
                    for (int q = 0; q < 8; ++q) { auto rr = __builtin_amdgcn_permlane16_swap((unsigned)n16[q], (unsigned)n16[8 + q], false, false); n8[q] = (int)rr[0] + (int)rr[1]; }
#pragma unroll
                    for (int q = 0; q < 4; ++q) { auto rr = __builtin_amdgcn_permlane32_swap((unsigned)n8[q], (unsigned)n8[4 + q], false, false); n4[q] = (int)rr[0] + (int)rr[1]; }
                    const float wse = (a & 4) ? wsv * 0.0625f : wsv;
                    u32x2 nw; nw.x = pk2(bflo(xw.x) + (float)n4[0] * wse, bfhi(xw.x) + (float)n4[1] * wse); nw.y = pk2(bflo(xw.y) + (float)n4[2] * wse, bfhi(xw.y) + (float)n4[3] * wse);
                    { *xp = nw; const float q0f = bflo(nw.x), q1f = bfhi(nw.x), q2f = bflo(nw.y), q3f = bfhi(nw.y); const float sq = wave_sum((q0f * q0f + q1f * q1f) + (q2f * q2f + q3f * q3f)); if (lane == 0) ((float*)(ws + P_SS))[(size_t)tok * 32 + s] = sq; }
                    i0 = ni0; i1 = ni1; wq = nwq; wsv = nwsv; ni0 = nni0; ni1 = nni1; nwq = nnwq; nwsv = nnwsv;
                }
#undef PV_ISSUE4
#undef PV_TOKLOAD
#undef PV_EID
#undef PV_ISSUE
#undef PV_DOT4
            }
        }
    }
}
#undef PEER_ISSUE

DI void phase_peer_combine(const Ctx& C0, const Params& P) {
    const Ctx C = fresh(C0);
    unsigned char* ws = P.ws;
    const float* usc = (const float*)(ws + P_UT + 32 * MiB); const float* vsc = (const float*)(ws + P_VT + 32 * MiB);
    const int* pe = (const int*)(ws + P_PE_E); const float* pg = (const float*)(ws + P_PE_G); const unsigned* part = (const unsigned*)(ws + P_SC); const float* tsc = (const float*)(ws + P_PE_TSC);
    const int lane = C.lane;
    const int t0 = C.blk * NWAVES + C.wave, tstep = C.G * NWAVES;
    if (t0 >= T) return;
    unsigned np[16]; f32x2 ng, nus, nvs; float ntsc; int ne[2];
#define CB_LOAD(TOK) do { _Pragma("unroll") for (int s_ = 0; s_ < 8; ++s_) np[s_] = part[((size_t)s_ * T + (TOK)) * 64 + lane]; \
        ng[0] = pg[(size_t)(TOK) * 128 + lane]; ng[1] = pg[(size_t)(TOK) * 128 + 64 + lane]; ntsc = tsc[TOK]; } while (0)
    CB_LOAD(t0);
    { const int e0 = pe[(size_t)t0 * 128 + lane], e1 = pe[(size_t)t0 * 128 + 64 + lane]; nus[0] = usc[e0]; nus[1] = usc[e1]; nvs[0] = vsc[e0]; nvs[1] = vsc[e1]; }
    { const int t1 = (t0 + tstep < T) ? t0 + tstep : t0; ne[0] = pe[(size_t)t1 * 128 + lane]; ne[1] = pe[(size_t)t1 * 128 + 64 + lane]; }
    for (int tok = t0; tok < T; tok += tstep) {
        unsigned cp[16];
#pragma unroll
        for (int s = 0; s < 8; ++s) cp[s] = np[s];
        const f32x2 cg = ng, cus = nus, cvs = nvs; const float ctsc = ntsc;
        {
            const int tn = (tok + tstep < T) ? tok + tstep : tok, tnn = (tn + tstep < T) ? tn + tstep : tn;
            CB_LOAD(tn);
            nus[0] = usc[ne[0]]; nus[1] = usc[ne[1]]; nvs[0] = vsc[ne[0]]; nvs[1] = vsc[ne[1]];
            ne[0] = pe[(size_t)tnn * 128 + lane]; ne[1] = pe[(size_t)tnn * 128 + 64 + lane];
        }
        float w[2]; int asum[2] = {0, 0};
#pragma unroll
        for (int s = 0; s < 8; ++s) { const int v = (int)cp[s]; asum[0] += (v << 16) >> 16; asum[1] += v >> 16; }
#pragma unroll
        for (int e2 = 0; e2 < 2; ++e2) { const float pv = (float)asum[e2] * 8.0f * cus[e2] * ctsc; w[e2] = cg[e2] * (0.5f * pv * (1.0f + erff(pv * 0.70710678118654752f))) * cvs[e2]; }
        float am = fmaxf(fabsf(w[0]), fabsf(w[1]));
        am = wave_max(am);
        const float sc = am > 0.f ? 127.0f / am : 0.f;
        if (lane == 0) ((float*)(ws + P_PE_WSC))[tok] = am * (1.0f / 127.0f);
        signed char* w8 = (signed char*)(ws + P_PE_W8) + (size_t)tok * 128;
        w8[lane] = (signed char)(int)rintf(w[0] * sc); w8[64 + lane] = (signed char)(int)rintf(w[1] * sc);
    }
#undef CB_LOAD
}
#endif

constexpr int N_PHASES = 39;
__global__ void __launch_bounds__(NTHREADS, 2) mk_fwd(Params P) {
    extern __shared__ __attribute__((aligned(16))) unsigned char lds_raw[];
    Ctx C; C.lds = (LAS unsigned char*)lds_raw; C.tid = threadIdx.x; C.lane = C.tid & 63; C.wave = __builtin_amdgcn_readfirstlane(C.tid >> 6); C.blk = blockIdx.x; C.G = gridDim.x;
    unsigned char* ws = P.ws;
    for (int u = C.tid; u < (LDS_BYTES - LDSCTL_OFF) / 4; u += NTHREADS) ((LAS unsigned*)(C.lds + LDSCTL_OFF))[u] = 0u;
    __syncthreads();
    XcdBarrier bar; bar.bar = (unsigned*)(ws + WS_CTL) + CW_BAR; bar.x = 0; bar.st = nullptr;
    const bool one = (P.ph_hi - P.ph_lo) > 1;
    if (one) bar = xcd_barrier_post((unsigned*)(ws + WS_CTL) + CW_BAR, (volatile LAS unsigned*)(C.lds + LDSCTL_OFF));
    const int lo = P.ph_lo, hi = P.ph_hi;
#define IN(k) (lo <= (k) && (k) < hi)
    int seam_no = 0; unsigned long long* stamps = (unsigned long long*)(ws + WS_CTL + 512 * 1024);
    if (PROBE_T >= 0 && C.blk == 0 && C.tid == 0) stamps[0] = __builtin_amdgcn_s_memrealtime();
#define SEAM(k) do { if (IN(k) && IN((k) + 1)) { xcd_barrier(bar); if (PROBE_T >= 0) { ++seam_no; if (C.blk == 0 && C.tid == 0) stamps[seam_no] = __builtin_amdgcn_s_memrealtime(); } } } while (0)
    bf16_t* hbuf = (bf16_t*)(ws + P_H); bf16_t* xb = (bf16_t*)(ws + P_XB); float* ssp = (float*)(ws + P_SS);
    const int* pos = (const int*)P.in[I_POS];
    const f32x2* rtab = (const f32x2*)(ws + WS_ROPE);

    if (IN(0)) { if (EN_PRO) phase_prologue(C, P); rms_rows_2048(C, P.in[I_X], P.in[I_AB_NORM], hbuf, T); } SEAM(0);
    if (IN(1)) {
        {
            g8::Desc g{(const bf16_t*)(ws + P_MEMN), (const bf16_t*)(ws + WS_LW + LW_XKV), DM, DM, DM, MT / 256, 2 * DM / 256, 2, 1, (long)MT * DM, 0, (long)(LW_STRIDE / 2), 0};
            EpiBf16 E{(bf16_t*)(ws + WS_KVX), 2 * DM, (long)(KVX_STRIDE / 2), 0, 1.0f, nullptr, 0};
            g8::gemm(C.lds, g, E, C.G, C.blk);
        }
        {
            g8::Desc g{(const bf16_t*)(ws + P_SK), (const bf16_t*)(ws + P_WQB), 256, DM, 256, 1, DM / 256, 2, 8, 8L * 65536, 65536, (long)DM * DM, 256};
            EpiBf16 E{(bf16_t*)(ws + WS_LW + LW_PEER), DM, (long)(LW_STRIDE / 2), 256L * DM, 1.0f, nullptr, 0};
            if (PROBE == 1) { EpiNull En; g8::gemm(C.lds, g, En, C.G, C.blk); } if (PROBE == 13) g8::gemm(C.lds, g, E, C.G, C.blk); if (GSITE < 0 || GSITE == 3) g8::gemm(C.lds, g, E, C.G, C.blk);
        }
        {
        g8::Desc g{hbuf, (const bf16_t*)(ws + WS_ABIN_T), DM, DM, DM, T / 256, AB_IN / 256, 1, 1, 0, 0, 0, 0};
        EpiRope<0> E{(bf16_t*)(ws + P_PROJ), AB_IN, pos, rtab};
        if (PROBE == 1) { EpiNull En; g8::gemm(C.lds, g, En, C.G, C.blk); } if (PROBE == 13) g8::gemm(C.lds, g, E, C.G, C.blk); if (GSITE < 0 || GSITE == 4) g8::gemm(C.lds, g, E, C.G, C.blk);
        }
    }
    SEAM(1);

    {
        constexpr int l = 0, pb = 2; (void)l;

            if (IN(pb + 3)) { if (EN_DIFF) { if (PROBE == 2) phase_diff_attn(C, P, 2); phase_diff_attn(C, P, 0); } }
            SEAM(pb + 3);
            if (IN(pb + 4)) {
                g8::Desc g{(const bf16_t*)(ws + P_GBUF), (const bf16_t*)(ws + WS_GLU_T), S5_W, S5_W, S5_W, T / 256, S5_W / 256, 1, 1, 0, 0, 0, 0};
                EpiGlu E{(const bf16_t*)(ws + P_GBUF), P.in[I_S5_BGLU], (bf16_t*)(ws + P_CONCAT)};
                if (PROBE == 1) { EpiNull En; g8::gemm(C.lds, g, En, C.G, C.blk); } if (PROBE == 13) g8::gemm(C.lds, g, E, C.G, C.blk); if (GSITE < 0 || GSITE == 5) g8::gemm(C.lds, g, E, C.G, C.blk);
            }
            SEAM(pb + 4);
            if (IN(pb + 5)) {
                g8::Desc g{(const bf16_t*)(ws + P_CONCAT), (const bf16_t*)(ws + WS_ABOUT_T), DM, DM, DM, T / 256, DM / 256, 1, 1, 0, 0, 0, 0};
                EpiResidB<true> E{P.in[I_X], xb, ssp, 0};
                if (PROBE == 1 || PROBE == 13) { EpiNull En; g8::gemm(C.lds, g, En, C.G, C.blk); } if (GSITE < 0 || GSITE == 6) g8::gemm(C.lds, g, E, C.G, C.blk);
            {
                const unsigned char* lwa = ws + WS_LW + (size_t)l * LW_STRIDE; const bf16_t* kvx = (const bf16_t*)(ws + WS_KVX + (size_t)l * KVX_STRIDE);
                {
                    g8::Desc g{kvx, (const bf16_t*)(lwa + LW_XQ), 2 * DM, DM, 512, 1, DM / 256, BATCH, 4, (long)MEM_LEN * 2 * DM, 512, 0, 512};
                    EpiBf16 E{(bf16_t*)(ws + P_WABS), DM, 1024L * DM, 256L * DM, 1.0f, nullptr, 0};
                    g8::gemm(C.lds, g, E, C.G, C.blk);
                }
                {
                    g8::Desc g{(const bf16_t*)(lwa + LW_XO), kvx + DM, DM, 2 * DM, 512, DM / 256, 1, BATCH, 4, 0, 512, (long)MEM_LEN * 2 * DM, 512};
                    EpiBf16 E{(bf16_t*)(ws + P_VW), 1024, (long)DM * 1024, 256, 1.0f, nullptr, 0};
                    g8::gemm(C.lds, g, E, C.G, C.blk);
                }
            }
            }
            SEAM(pb + 5);
    }
    {
        constexpr int l = 0, pb = 2; (void)l;
        const unsigned char* lw = ws + WS_LW + (size_t)l * LW_STRIDE;
        if (IN(pb + 7)) {
            g8::Desc g{xb, (const bf16_t*)(ws + P_WABS), DM, DM, DM, SEQ / 256, 1024 / 256, BATCH, 1, (long)SEQ * DM, 0, 1024L * DM, 0};
            EpiSoftmax256 E{(bf16_t*)(ws + P_P), 1024, (long)SEQ * 1024, 0.04419417382415922f, ssp, SEQ};
            if (PROBE == 1) { EpiNull En; g8::gemm(C.lds, g, En, C.G, C.blk); } if (PROBE == 13) g8::gemm(C.lds, g, E, C.G, C.blk); if (GSITE < 0 || GSITE == 11) g8::gemm(C.lds, g, E, C.G, C.blk);
        }
        SEAM(pb + 7);
        if (IN(pb + 10)) {
            g8::Desc g{(const bf16_t*)(ws + P_P), (const bf16_t*)(ws + P_VW), 1024, 1024, 1024, SEQ / 256, DM / 256, BATCH, 1, (long)SEQ * 1024, 0, (long)DM * 1024, 0};
            EpiResidB<false> E{nullptr, xb, ssp, SEQ};
            if (PROBE == 1 || PROBE == 13) { EpiNull En; g8::gemm(C.lds, g, En, C.G, C.blk); } if (GSITE < 0 || GSITE == 14) g8::gemm(C.lds, g, E, C.G, C.blk);
        }
        SEAM(pb + 10);
        if (IN(pb + 13)) {
            g8::Desc g{xb, (const bf16_t*)(lw + LW_PEER), DM, DM, DM, T / 256, DM / 256, 1, 1, 0, 0, 0, 0};
            EpiBf16 E{(bf16_t*)(ws + P_SC), DM, 0, 0, 1.0f, nullptr, 0};
            if (PROBE == 1) { EpiNull En; g8::gemm(C.lds, g, En, C.G, C.blk); } if (PROBE == 13) g8::gemm(C.lds, g, E, C.G, C.blk); if (GSITE < 0 || GSITE == 15) g8::gemm(C.lds, g, E, C.G, C.blk);
        }
        SEAM(pb + 13);
        if (IN(pb + 14)) { if (EN_PEER && EN_TOPK) {
            const bool conv_first = C.wave >= 4;
            if (conv_first) convert_tables(C, P, l);
            phase_peer_topk(C, P);
            if (!conv_first) convert_tables(C, P, l);
        } }
        SEAM(pb + 14);
#if PEER_SLICED
        if (IN(pb + 15)) { if (EN_PEER && EN_PU) { if (PROBE >= 7 && PROBE <= 9) { phase_peer_sliced<0, PROBE - 7>(C, P, 8 + 32 * l + 64); __syncthreads(); } phase_peer_sliced<0>(C, P, 8 + 32 * l); } }
        SEAM(pb + 15);
        if (IN(pb + 16)) { if (EN_PEER) phase_peer_combine(C, P); }
        SEAM(pb + 16);
        if (IN(pb + 17)) { if (EN_PEER && EN_PV) { if (PROBE >= 10 && PROBE <= 12) { phase_peer_sliced<1, PROBE == 10 ? 3 : PROBE - 10>(C, P, 8 + 32 * l + 80); __syncthreads(); } phase_peer_sliced<1>(C, P, 8 + 32 * l + 16); } }
        SEAM(pb + 17);
#endif
    }
    {
        constexpr int l = 1, pb = 20; (void)l;

            if (IN(pb + 1)) {
                g8::Desc g{xb, (const bf16_t*)(ws + WS_MLAIN_T), DM, DM, DM, T / 256, MLA_IN_PAD / 256, 1, 1, 0, 0, 0, 0};
                EpiBf16 E{(bf16_t*)(ws + P_MLAPROJ), MLA_IN_PAD, 0, 0, 1.0f, nullptr, 0};
                if (PROBE == 1) { EpiNull En; g8::gemm(C.lds, g, En, C.G, C.blk); } if (PROBE == 13) g8::gemm(C.lds, g, E, C.G, C.blk); if (GSITE < 0 || GSITE == 7) g8::gemm(C.lds, g, E, C.G, C.blk);
            }
            SEAM(pb + 1);
            if (IN(pb + 2)) { if (PROBE == 5) phase_mla_rows(C, P); phase_mla_rows(C, P); }
            SEAM(pb + 2);
            if (IN(pb + 3)) {
                {
                    g8::Desc g{(const bf16_t*)(ws + P_CQN), (const bf16_t*)(ws + WS_UQ_T), MLA_QR, MLA_QR, MLA_QR, T / 256, 3072 / 256, 1, 1, 0, 0, 0, 0};
                    EpiRope<1> E{(bf16_t*)(ws + P_Q), 3072, pos, rtab};
                    if (PROBE == 1) { EpiNull En; g8::gemm(C.lds, g, En, C.G, C.blk); } if (PROBE == 13) g8::gemm(C.lds, g, E, C.G, C.blk); if (GSITE < 0 || GSITE == 8) g8::gemm(C.lds, g, E, C.G, C.blk);
                }
                {
                    g8::Desc g{(const bf16_t*)(ws + P_CKVN), (const bf16_t*)(ws + WS_UKV_T), MLA_KVR, MLA_KVR, MLA_KVR, T / 256, 4096 / 256, 1, 1, 0, 0, 0, 0};
                    EpiBf16 E{(bf16_t*)(ws + P_KV), 4096, 0, 0, 1.0f, nullptr, 0};
                    if (PROBE == 1) { EpiNull En; g8::gemm(C.lds, g, En, C.G, C.blk); } if (PROBE == 13) g8::gemm(C.lds, g, E, C.G, C.blk); if (GSITE < 0 || GSITE == 9) g8::gemm(C.lds, g, E, C.G, C.blk);
                }
            }
            SEAM(pb + 3);
            if (IN(pb + 4)) { if (EN_MLA) { if (PROBE == 2) phase_mla_attn(C, P, 3); phase_mla_attn(C, P, 1); } }
            SEAM(pb + 4);
            if (IN(pb + 5)) {
                g8::Desc g{hbuf, (const bf16_t*)(ws + WS_MLAO_T), DM, DM, DM, T / 256, DM / 256, 1, 1, 0, 0, 0, 0};
                EpiResidB<false> E{nullptr, xb, ssp, 0};
                if (PROBE == 1 || PROBE == 13) { EpiNull En; g8::gemm(C.lds, g, En, C.G, C.blk); } if (GSITE < 0 || GSITE == 10) g8::gemm(C.lds, g, E, C.G, C.blk);
            {
                const unsigned char* lwa = ws + WS_LW + (size_t)l * LW_STRIDE; const bf16_t* kvx = (const bf16_t*)(ws + WS_KVX + (size_t)l * KVX_STRIDE);
                {
                    g8::Desc g{kvx, (const bf16_t*)(lwa + LW_XQ), 2 * DM, DM, 512, 1, DM / 256, BATCH, 4, (long)MEM_LEN * 2 * DM, 512, 0, 512};
                    EpiBf16 E{(bf16_t*)(ws + P_WABS), DM, 1024L * DM, 256L * DM, 1.0f, nullptr, 0};
                    g8::gemm(C.lds, g, E, C.G, C.blk);
                }
                {
                    g8::Desc g{(const bf16_t*)(lwa + LW_XO), kvx + DM, DM, 2 * DM, 512, DM / 256, 1, BATCH, 4, 0, 512, (long)MEM_LEN * 2 * DM, 512};
                    EpiBf16 E{(bf16_t*)(ws + P_VW), 1024, (long)DM * 1024, 256, 1.0f, nullptr, 0};
                    g8::gemm(C.lds, g, E, C.G, C.blk);
                }
            }
            }
            SEAM(pb + 5);
    }
    {
        constexpr int l = 1, pb = 20; (void)l;
        const unsigned char* lw = ws + WS_LW + (size_t)l * LW_STRIDE;
        if (IN(pb + 7)) {
            g8::Desc g{xb, (const bf16_t*)(ws + P_WABS), DM, DM, DM, SEQ / 256, 1024 / 256, BATCH, 1, (long)SEQ * DM, 0, 1024L * DM, 0};
            EpiSoftmax256 E{(bf16_t*)(ws + P_P), 1024, (long)SEQ * 1024, 0.04419417382415922f, ssp, SEQ};
            if (PROBE == 1) { EpiNull En; g8::gemm(C.lds, g, En, C.G, C.blk); } if (PROBE == 13) g8::gemm(C.lds, g, E, C.G, C.blk); if (GSITE < 0 || GSITE == 11) g8::gemm(C.lds, g, E, C.G, C.blk);
        }
        SEAM(pb + 7);
        if (IN(pb + 10)) {
            g8::Desc g{(const bf16_t*)(ws + P_P), (const bf16_t*)(ws + P_VW), 1024, 1024, 1024, SEQ / 256, DM / 256, BATCH, 1, (long)SEQ * 1024, 0, (long)DM * 1024, 0};
            EpiResidB<false> E{nullptr, xb, ssp, SEQ};
            if (PROBE == 1 || PROBE == 13) { EpiNull En; g8::gemm(C.lds, g, En, C.G, C.blk); } if (GSITE < 0 || GSITE == 14) g8::gemm(C.lds, g, E, C.G, C.blk);
        }
        SEAM(pb + 10);
        if (IN(pb + 13)) {
            g8::Desc g{xb, (const bf16_t*)(lw + LW_PEER), DM, DM, DM, T / 256, DM / 256, 1, 1, 0, 0, 0, 0};
            EpiBf16 E{(bf16_t*)(ws + P_SC), DM, 0, 0, 1.0f, nullptr, 0};
            if (PROBE == 1) { EpiNull En; g8::gemm(C.lds, g, En, C.G, C.blk); } if (PROBE == 13) g8::gemm(C.lds, g, E, C.G, C.blk); if (GSITE < 0 || GSITE == 15) g8::gemm(C.lds, g, E, C.G, C.blk);
        }
        SEAM(pb + 13);
        if (IN(pb + 14)) { if (EN_PEER && EN_TOPK) {
            const bool conv_first = C.wave >= 4;
            if (conv_first) convert_tables(C, P, l);
            phase_peer_topk(C, P);
            if (!conv_first) convert_tables(C, P, l);
        } }
        SEAM(pb + 14);
#if PEER_SLICED
        if (IN(pb + 15)) { if (EN_PEER && EN_PU) { if (PROBE >= 7 && PROBE <= 9) { phase_peer_sliced<0, PROBE - 7>(C, P, 8 + 32 * l + 64); __syncthreads(); } phase_peer_sliced<0>(C, P, 8 + 32 * l); } }
        SEAM(pb + 15);
        if (IN(pb + 16)) { if (EN_PEER) phase_peer_combine(C, P); }
        SEAM(pb + 16);
        if (IN(pb + 17)) { if (EN_PEER && EN_PV) { if (PROBE >= 10 && PROBE <= 12) { phase_peer_sliced<1, PROBE == 10 ? 3 : PROBE - 10>(C, P, 8 + 32 * l + 80); __syncthreads(); } phase_peer_sliced<1>(C, P, 8 + 32 * l + 16); } }
        SEAM(pb + 17);
#endif
    }
    if (IN(38)) rms_rows_final(C, xb, P.out, P.in[I_FINAL_NORM], T);
    if (PROBE == 14 && one) { for (int i = 0; i < 30; ++i) xcd_barrier(bar); }
    if (PROBE_T >= 0 && one) {
        xcd_barrier(bar);
        if (C.blk == 0 && C.tid == 0) stamps[seam_no + 1] = __builtin_amdgcn_s_memrealtime();
        xcd_barrier(bar);
        const unsigned long long d = __hip_atomic_load(&stamps[PROBE_T + 1], __ATOMIC_RELAXED, __HIP_MEMORY_SCOPE_AGENT) - __hip_atomic_load(&stamps[PROBE_T], __ATOMIC_RELAXED, __HIP_MEMORY_SCOPE_AGENT);
        const unsigned long long t0 = __builtin_amdgcn_s_memrealtime();
        while (__builtin_amdgcn_s_memrealtime() - t0 < 8ull * d) __builtin_amdgcn_s_sleep(8);
    }
#undef IN
#undef SEAM
}

extern "C" void kernel_launch(void* const* d_in, const int* in_sizes, int n_in, void* d_out, int out_size, void* d_ws, size_t ws_size, hipStream_t stream) {
    static int grid = 0;
    if (grid == 0) {
        if (n_in != 39 || in_sizes[0] != T * DM || out_size != T * DM || ws_size < WS_END) {
            fprintf(stderr, "kernel_launch: unexpected shapes (n_in %d in0 %d out %d ws %zu, need ws >= %zu); nothing launched\n", n_in, n_in > 0 ? in_sizes[0] : -1, out_size, ws_size, (size_t)WS_END);
            grid = -1; return; }
        int dev = 0, cus = 0;
        if (hipGetDevice(&dev) != hipSuccess || hipDeviceGetAttribute(&cus, hipDeviceAttributeMultiprocessorCount, dev) != hipSuccess) { grid = -1; return; }
        if (hipFuncSetAttribute((const void*)mk_fwd, hipFuncAttributeMaxDynamicSharedMemorySize, LDS_BYTES) != hipSuccess) { fprintf(stderr, "kernel_launch: hipFuncSetAttribute failed\n"); grid = -1; return; }
        int per_cu = 0;
        if (hipOccupancyMaxActiveBlocksPerMultiprocessor(&per_cu, (const void*)mk_fwd, NTHREADS, LDS_BYTES) != hipSuccess || per_cu < 1)
            fprintf(stderr, "kernel_launch: occupancy query reports %d blocks per CU\n", per_cu);
        (void)hipGetLastError();
        grid = cus;
    }
    if (grid < 0) return;
    (void)hipMemsetAsync((char*)d_ws + WS_CTL, 0, CTL_BYTES, stream);
    Params p{};
    for (int i = 0; i < 39; ++i) p.in[i] = (const float*)d_in[i];
    p.out = (float*)d_out; p.ws = (unsigned char*)d_ws;
#if MK_ONE_LAUNCH
    p.ph_lo = 0; p.ph_hi = N_PHASES;
    hipLaunchKernelGGL(mk_fwd, dim3(grid), dim3(NTHREADS), LDS_BYTES, stream, p);
#else
    for (int ph = 0; ph < N_PHASES; ++ph) { p.ph_lo = ph; p.ph_hi = ph + 1; hipLaunchKernelGGL(mk_fwd, dim3(grid), dim3(NTHREADS), LDS_BYTES, stream, p); }
#endif
    const hipError_t le = hipPeekAtLastError();
    if (le != hipSuccess) fprintf(stderr, "kernel_launch: launch failed: %s\n", hipGetErrorName(le));
}
```

```cpp
#include <hip/hip_runtime.h>
#include <cstdio>
#include <cstdint>

#ifndef MK_ONE_LAUNCH
#define MK_ONE_LAUNCH 1
#endif
#ifndef FAST_GEMM
#define FAST_GEMM 1
#endif
#ifndef FAST_ATTN
#define FAST_ATTN 1
#endif

#ifndef EN_TOPK
#define EN_TOPK 1
#endif
#ifndef EN_PU
#define EN_PU 1
#endif
#ifndef EN_PV
#define EN_PV 1
#endif
#ifndef EN_S5
#define EN_S5 1
#endif
#ifndef EN_DIFF
#define EN_DIFF 1
#endif
#ifndef EN_MLA
#define EN_MLA 1
#endif
#ifndef EN_PEER
#define EN_PEER 1
#endif
#ifndef EN_GEMM
#define EN_GEMM 1
#endif
#ifndef EN_PRO
#define EN_PRO 1
#endif
#ifndef PEER_FP8
#define PEER_FP8 1
#endif
#ifndef PROBE
#define PROBE 0
#endif
#ifndef PEER_SLICED
#define PEER_SLICED 1
#endif
#ifndef PROBE_ATTN_MODE
#define PROBE_ATTN_MODE 0
#endif
#ifndef PROBE_T
#define PROBE_T -1
#endif
#ifndef PROBE_PEER2
#define PROBE_PEER2 0
#endif
#ifndef GSITE
#define GSITE -1
#endif
#define GAS __attribute__((address_space(1)))
#define LAS __attribute__((address_space(3)))
#define DI __device__ __forceinline__
typedef unsigned short bf16_t;
typedef short bf16x8 __attribute__((ext_vector_type(8)));
typedef short s16x4 __attribute__((ext_vector_type(4)));
typedef float f32x2 __attribute__((ext_vector_type(2)));
typedef float f32x4 __attribute__((ext_vector_type(4)));
typedef float f32x16 __attribute__((ext_vector_type(16)));
typedef unsigned u32x2 __attribute__((ext_vector_type(2)));
typedef unsigned u32x4 __attribute__((ext_vector_type(4)));
typedef __bf16 bf16x2_t __attribute__((ext_vector_type(2)));

constexpr int BATCH = 16, SEQ = 2048, DM = 2048, T = BATCH * SEQ, MEM_LEN = 256, MT = BATCH * MEM_LEN;
constexpr int DIFF_HEADS = 12, DIFF_W = 1536, S5_W = 512, AB_IN = 5120;
constexpr int MLA_HEADS = 16, MLA_QR = 768, MLA_KVR = 256, MLA_IN = 1088, MLA_IN_PAD = 1280;
constexpr int PEER_NE = 16384;
constexpr float NORM_EPS = 1e-6f;
constexpr int ROPE_POS = 3072;
constexpr int NWAVES = 8, NTHREADS = 512;

constexpr size_t MiB = 1u << 20;
constexpr size_t WS_CTL = 0, CTL_BYTES = 1 * MiB;
constexpr size_t WS_ROPE = 1 * MiB;
constexpr size_t WS_ABIN_T = 2 * MiB, WS_ABOUT_T = 22 * MiB, WS_GLU_T = 30 * MiB, WS_MLAIN_T = 31 * MiB, WS_UQ_T = 36 * MiB, WS_UKV_T = 41 * MiB, WS_MLAO_T = 43 * MiB;
constexpr size_t WS_LW = 51 * MiB, LW_STRIDE = 40 * MiB;
constexpr size_t LW_XQ = 0, LW_XKV = 8 * MiB, LW_XO = 24 * MiB, LW_PEER = 32 * MiB;
constexpr size_t WS_KVX = 131 * MiB, KVX_STRIDE = 32 * MiB;
constexpr size_t WS_POOL = 195 * MiB;
constexpr size_t P_H = WS_POOL;
constexpr size_t P_PROJ = WS_POOL + 128 * MiB;
constexpr size_t P_CONCAT = WS_POOL + 448 * MiB;
constexpr size_t P_GBUF = WS_POOL + 576 * MiB;
constexpr size_t P_MLAPROJ = WS_POOL + 0 * MiB;
constexpr size_t P_CQN = WS_POOL + 80 * MiB;
constexpr size_t P_CKVN = WS_POOL + 128 * MiB;
constexpr size_t P_KROPE = WS_POOL + 144 * MiB;
constexpr size_t P_Q = WS_POOL + 152 * MiB;
constexpr size_t P_KV = WS_POOL + 344 * MiB;
constexpr size_t P_WABS = WS_POOL + 128 * MiB;
constexpr size_t P_VW = WS_POOL + 192 * MiB;
constexpr size_t P_S = WS_POOL + 256 * MiB;
constexpr size_t P_P = WS_POOL + 320 * MiB;
constexpr size_t P_SC = WS_POOL + 128 * MiB;
constexpr size_t P_UT = WS_POOL + 608 * MiB;
constexpr size_t P_VT = WS_POOL + 642 * MiB;
constexpr size_t P_PE_E = WS_POOL + 384 * MiB;
constexpr size_t P_PE_G = WS_POOL + 400 * MiB;
constexpr size_t P_PE_E16 = WS_POOL + 416 * MiB;
constexpr size_t P_PE_W8 = WS_POOL + 424 * MiB;
constexpr size_t P_PE_WSC = WS_POOL + 428 * MiB;
constexpr size_t P_PE_T8 = WS_POOL + 432 * MiB;
constexpr size_t P_PE_TSC = WS_POOL + 496 * MiB;
constexpr size_t P_MEMN = WS_POOL + 448 * MiB;
constexpr size_t P_WQB = WS_POOL + 480 * MiB;
constexpr size_t P_SK = WS_POOL + 496 * MiB;
constexpr size_t P_SS = WS_POOL + 680 * MiB;
constexpr size_t P_XB = WS_POOL + 704 * MiB;
constexpr size_t WS_END = WS_POOL + 832 * MiB;
constexpr int CW_BAR = 4096, CW_CTR = 16384;

constexpr int RING_BYTES = 131072, LDSCTL_OFF = RING_BYTES, LDS_BYTES = 147456;

DI unsigned pk2(float lo, float hi) { f32x2 v = {lo, hi}; bf16x2_t b = __builtin_convertvector(v, bf16x2_t); return __builtin_bit_cast(unsigned, b); }
DI float bflo(unsigned u) { return __uint_as_float(u << 16); }
DI float bfhi(unsigned u) { return __uint_as_float(u & 0xffff0000u); }
DI float bf2f(bf16_t b) { return __uint_as_float(((unsigned)b) << 16); }
DI bf16_t f2bf(float f) { return (bf16_t)(pk2(f, 0.f) & 0xffffu); }
DI float dot2bf(unsigned a, unsigned b, float c) { return __builtin_amdgcn_fdot2_f32_bf16(__builtin_bit_cast(bf16x2_t, a), __builtin_bit_cast(bf16x2_t, b), c, false); }
DI int opaque_tid() { int t; asm volatile("v_mov_b32 %0, %1" : "=v"(t) : "v"(threadIdx.x)); return t; }
DI float dpp_f(float v, int ctrl_is) {
    const int x = __float_as_int(v);
    const int r = ctrl_is == 0 ? __builtin_amdgcn_update_dpp(0, x, 0xB1, 0xF, 0xF, true) : ctrl_is == 1 ? __builtin_amdgcn_update_dpp(0, x, 0x4E, 0xF, 0xF, true)
                : ctrl_is == 2 ? __builtin_amdgcn_update_dpp(0, x, 0x141, 0xF, 0xF, true) : __builtin_amdgcn_update_dpp(0, x, 0x140, 0xF, 0xF, true);
    return __int_as_float(r);
}
DI float wave_sum(float v) {
    v += dpp_f(v, 0); v += dpp_f(v, 1); v += dpp_f(v, 2); v += dpp_f(v, 3);
    { auto rr = __builtin_amdgcn_permlane16_swap(__float_as_uint(v), __float_as_uint(v), false, false); v = __uint_as_float(rr[0]) + __uint_as_float(rr[1]); }
    { auto rr = __builtin_amdgcn_permlane32_swap(__float_as_uint(v), __float_as_uint(v), false, false); v = __uint_as_float(rr[0]) + __uint_as_float(rr[1]); }
    return v;
}
DI float rows_sum(float v) {
    { auto rr = __builtin_amdgcn_permlane16_swap(__float_as_uint(v), __float_as_uint(v), false, false); v = __uint_as_float(rr[0]) + __uint_as_float(rr[1]); }
    { auto rr = __builtin_amdgcn_permlane32_swap(__float_as_uint(v), __float_as_uint(v), false, false); v = __uint_as_float(rr[0]) + __uint_as_float(rr[1]); }
    return v;
}
DI float rows_max(float v) {
    { auto rr = __builtin_amdgcn_permlane16_swap(__float_as_uint(v), __float_as_uint(v), false, false); v = fmaxf(__uint_as_float(rr[0]), __uint_as_float(rr[1])); }
    { auto rr = __builtin_amdgcn_permlane32_swap(__float_as_uint(v), __float_as_uint(v), false, false); v = fmaxf(__uint_as_float(rr[0]), __uint_as_float(rr[1])); }
    return v;
}
DI float row16_sum(float v) { v += dpp_f(v, 0); v += dpp_f(v, 1); v += dpp_f(v, 2); v += dpp_f(v, 3); return v; }
DI float row16_max(float v) { v = fmaxf(v, dpp_f(v, 0)); v = fmaxf(v, dpp_f(v, 1)); v = fmaxf(v, dpp_f(v, 2)); v = fmaxf(v, dpp_f(v, 3)); return v; }
DI float wave_max(float v) {
    v = fmaxf(v, dpp_f(v, 0)); v = fmaxf(v, dpp_f(v, 1)); v = fmaxf(v, dpp_f(v, 2)); v = fmaxf(v, dpp_f(v, 3));
    { auto rr = __builtin_amdgcn_permlane16_swap(__float_as_uint(v), __float_as_uint(v), false, false); v = fmaxf(__uint_as_float(rr[0]), __uint_as_float(rr[1])); }
    { auto rr = __builtin_amdgcn_permlane32_swap(__float_as_uint(v), __float_as_uint(v), false, false); v = fmaxf(__uint_as_float(rr[0]), __uint_as_float(rr[1])); }
    return v;
}
DI float erf_as(float x) {
    const float ax = fabsf(x), t = __builtin_amdgcn_rcpf(fmaf(0.3275911f, ax, 1.0f));
    const float poly = t * fmaf(t, fmaf(t, fmaf(t, fmaf(t, 1.061405429f, -1.453152027f), 1.421413741f), -0.284496736f), 0.254829592f);
    const float r = fmaf(-poly, __builtin_amdgcn_exp2f(-1.4426950408889634f * ax * ax), 1.0f);
    return copysignf(r, x);
}
DI float gelu_erf(float v) { return 0.5f * v * (1.0f + erf_as(v * 0.70710678118654752f)); }
DI float swap32_max(float x) { auto rr = __builtin_amdgcn_permlane32_swap(__float_as_uint(x), __float_as_uint(x), false, false); return fmaxf(__uint_as_float(rr[0]), __uint_as_float(rr[1])); }
DI float swap32_sum(float x) { auto rr = __builtin_amdgcn_permlane32_swap(__float_as_uint(x), __float_as_uint(x), false, false); return __uint_as_float(rr[0]) + __uint_as_float(rr[1]); }
DI unsigned q8x4(float a, float b, float c, float d, float scale) {
    const float M = 12582912.0f;
    const unsigned y0 = __float_as_uint(fmaf(a, scale, M)), y1 = __float_as_uint(fmaf(b, scale, M)), y2 = __float_as_uint(fmaf(c, scale, M)), y3 = __float_as_uint(fmaf(d, scale, M));
    const unsigned lo = __builtin_amdgcn_perm(y1, y0, 0x0c0c0400u), hi = __builtin_amdgcn_perm(y3, y2, 0x0c0c0400u);
    return lo | (hi << 16);
}
DI int dot4_from(unsigned a, unsigned b, int c) { int d; asm("v_dot4_i32_i8 %0, %1, %2, %3" : "=v"(d) : "v"(a), "v"(b), "v"(c)); return d; }
DI int dot4_from0(unsigned a, unsigned b) { int d; asm("v_dot4_i32_i8 %0, %1, %2, 0" : "=v"(d) : "v"(a), "v"(b)); return d; }
#define LDS_WAIT() asm volatile("s_waitcnt lgkmcnt(0)" ::: "memory")
#define VM_WAIT() asm volatile("s_waitcnt vmcnt(0)" ::: "memory")

#define XB_TMO      128
#define XB_XCNT(j)  (256  + 64 * (j))
#define XB_XSUB(j)  (1280 + 64 * (j))
#define XB_XGEN(j)  (2304 + 64 * (j))
#define XB_TOP      3328
#define XB_TOPGEN   3392
#define XCD_BAR_WORDS 3456
#define XB_SPIN_CAP (1u << 20)
DI unsigned xb_ld(unsigned* p)              { return __hip_atomic_load(p, __ATOMIC_RELAXED, __HIP_MEMORY_SCOPE_AGENT); }
DI unsigned xb_add(unsigned* p, unsigned v) { return __hip_atomic_fetch_add(p, v, __ATOMIC_RELAXED, __HIP_MEMORY_SCOPE_AGENT); }
DI unsigned xb_xcc_id() { return (unsigned)__builtin_amdgcn_s_getreg((3 << 11) | 20) & 0xFu; }
#define XB_SPIN(cond, bar) do { unsigned _sp = 0; while (cond) { __builtin_amdgcn_s_sleep(1); \
    if ((++_sp & 255u) == 0u) { if (xb_ld(&(bar)[XB_TMO])) break; if (_sp > XB_SPIN_CAP) { atomicAdd(&(bar)[XB_TMO], 1u); break; } } } } while (0)
struct XcdBarrier { unsigned* bar; unsigned x; volatile LAS unsigned* st; };
DI XcdBarrier xcd_barrier_post(unsigned* bar, volatile LAS unsigned* st) {
    XcdBarrier b; b.bar = bar; b.x = xb_xcc_id(); b.st = st;
    if (threadIdx.x == 0) (void)xb_add(&bar[XB_XCNT(b.x)], 1u);
    return b;
}
DI void xcd_barrier_complete(unsigned* bar, unsigned x, unsigned& nloc, unsigned& nx) {
    const unsigned G = gridDim.x * gridDim.y * gridDim.z;
    unsigned sum, cnt, mine, sp = 0u;
    for (;;) {
        sum = 0u; cnt = 0u; mine = 0u;
#pragma unroll
        for (unsigned j = 0; j < 16; ++j) { const unsigned c = xb_ld(&bar[XB_XCNT(j)]); sum += c; cnt += (c > 0u) ? 1u : 0u; mine = (j == x) ? c : mine; }
        if (sum == G) break;
        __builtin_amdgcn_s_sleep(1);
        if ((++sp & 255u) == 0u) { if (xb_ld(&bar[XB_TMO])) break; if (sp > XB_SPIN_CAP) { atomicAdd(&bar[XB_TMO], 1u); break; } }
    }
    nloc = mine > 0u ? mine : 1u; nx = cnt > 0u ? cnt : 1u;
}
DI void xcd_barrier(const XcdBarrier& b) {
    asm volatile("s_waitcnt vmcnt(0)" ::: "memory");
    __syncthreads();
    if (threadIdx.x == 0) {
        unsigned* bar = b.bar;
        __builtin_amdgcn_s_waitcnt(0);
        unsigned nloc = b.st[0], nx = b.st[1];
        if (nloc == 0u) { xcd_barrier_complete(bar, b.x, nloc, nx); b.st[0] = nloc; b.st[1] = nx; }
        const unsigned old = xb_add(&bar[XB_XSUB(b.x)], 1u);
        const unsigned gen = old / nloc;
        if (old + 1u == (gen + 1u) * nloc) {
            __builtin_amdgcn_fence(__ATOMIC_RELEASE, "agent");
            asm volatile("s_waitcnt vmcnt(0)" ::: "memory");
            const unsigned og = xb_add(&bar[XB_TOP], 1u);
            const unsigned tg = og / nx;
            if (og + 1u == (tg + 1u) * nx) xb_add(&bar[XB_TOPGEN], 1u);
            else XB_SPIN(xb_ld(&bar[XB_TOPGEN]) == tg, bar);
            __builtin_amdgcn_fence(__ATOMIC_ACQUIRE, "agent");
            xb_add(&bar[XB_XGEN(b.x)], 1u);
            asm volatile("s_waitcnt vmcnt(0)" ::: "memory");
        } else {
            XB_SPIN(xb_ld(&bar[XB_XGEN(b.x)]) == gen, bar);
            __builtin_amdgcn_fence(__ATOMIC_ACQUIRE, "agent");
            asm volatile("s_waitcnt vmcnt(0)" ::: "memory");
        }
    }
    __syncthreads();
}

template <class E, class = void> struct IsSoftmaxEpi { static constexpr bool value = false; };
template <class E> struct IsSoftmaxEpi<E, decltype((void)E::kSoftmax)> { static constexpr bool value = true; };
namespace g8 {
constexpr int BM = 256, BK = 64, HALF = 128, HTB = HALF * BK * 2, STAGE_BYTES = 8 * HTB, NXCD = 8, WGM = 8;
DI int lds_byte(int r, int c) { const int st = (r >> 4) * 2 + (c >> 5), rr = r & 15, cc = c & 31, ob = rr * 64 + cc * 2; return st * 1024 + (ob ^ (((ob >> 9) & 1) << 5)); }
DI void stage_rc(int b, int& R, int& C) { const int st = b / 1024, sb = b % 1024, swz = sb ^ (((sb >> 9) & 1) << 5); R = (st >> 1) * 16 + swz / 64; C = (st & 1) * 32 + (swz % 64) / 2; }
DI int perm32(int rho) { const int n = rho >> 4, i = rho & 15; return 8 * (i >> 2) + 4 * n + (i & 3); }

struct Unit { int zo, zi, pm, pn; };
struct Desc { const bf16_t* A; const bf16_t* Bt; int lda, ldb, K, nM, nN, nZo, nZi; long sAo, sAi, sBo, sBi; };
DI bool next_unit(const Desc& g, int i, int G, int c, Unit& u) {
    const int per = g.nM * g.nN, nwg = per * g.nZo * g.nZi;
    const long L = (long)i * G + c; if (L >= nwg) return false;
    int wgid = (int)L; { const int q = nwg / NXCD, r = nwg % NXCD, xcd = wgid % NXCD, off = wgid / NXCD; wgid = (xcd < r ? xcd * (q + 1) : r * (q + 1) + (xcd - r) * q) + off; }
    const int z = wgid / per, w = wgid % per;
    u.zo = z / g.nZi; u.zi = z % g.nZi;
    const int nig = WGM * g.nN, gid = w / nig, fm = gid * WGM, gsz = (g.nM - fm) < WGM ? (g.nM - fm) : WGM;
    u.pm = fm + ((w % nig) % gsz); u.pn = (w % nig) / gsz; return true;
}

template <class Epi>
DI void gemm_phase(LAS unsigned char* lds, const Desc g, const Epi& E, int G, int c) {
    const int tid = opaque_tid(), wid = __builtin_amdgcn_readfirstlane(tid >> 6), lane = tid & 63, wr = wid >> 2, wc = wid & 3, fr = lane & 15, fq = lane >> 4;
    const int K = g.K, nt = K / BK;
    unsigned voffA[2], voffB[2];
#pragma unroll
    for (int i = 0; i < 2; ++i) { int R, C; stage_rc(tid * 16 + i * 8192, R, C); const int Rb = (R & ~31) + perm32(R & 31);
        voffA[i] = (unsigned)(R * g.lda + C) * 2u; voffB[i] = (unsigned)(Rb * g.ldb + C) * 2u; }
    const size_t kstep = (size_t)(BK * 2);
    const size_t hstepA = (size_t)HALF * g.lda * 2, hstepB = (size_t)HALF * g.ldb * 2;
    const unsigned ldsw = (unsigned)wid * 1024u;
    const int aoff = lds_byte(wr * 64 + fr, fq * 8), boff = lds_byte(wc * 32 + fr, fq * 8);
#define PG8_SA(b, h) (((b) * 2 + (h)) * HTB)
#define PG8_SB(b, h) ((4 + (b) * 2 + (h)) * HTB)
#define PG8_STAGE(bufoff, gbase, voff) do { _Pragma("unroll") for (int _i = 0; _i < 2; ++_i) \
        __builtin_amdgcn_global_load_lds((const unsigned*)((const char*)(gbase) + (voff)[_i]), (LAS unsigned*)(lds + (bufoff) + ldsw + _i * 8192), 16, 0, 0); } while (0)
#define PG8_LDA(dst, b, h) do { _Pragma("unroll") for (int m = 0; m < 4; ++m) _Pragma("unroll") for (int k = 0; k < 2; ++k) dst[m][k] = *(const LAS bf16x8*)(lds + PG8_SA(b, h) + aoff + m * 2048 + k * 1024); } while (0)
#define PG8_LDB(dst, b, h) do { _Pragma("unroll") for (int n = 0; n < 2; ++n) _Pragma("unroll") for (int k = 0; k < 2; ++k) dst[n][k] = *(const LAS bf16x8*)(lds + PG8_SB(b, h) + boff + n * 2048 + k * 1024); } while (0)
#define PG8_MMA(ai, bj, At, Bt) do { __builtin_amdgcn_s_setprio(1); _Pragma("unroll") for (int m = 0; m < 4; ++m) _Pragma("unroll") for (int n = 0; n < 2; ++n) _Pragma("unroll") for (int k = 0; k < 2; ++k) \
        acc[ai][bj][m][n] = __builtin_amdgcn_mfma_f32_16x16x32_bf16(Bt[n][k], At[m][k], acc[ai][bj][m][n], 0, 0, 0); __builtin_amdgcn_s_setprio(0); } while (0)
#define PG8_WAIT_V(n) asm volatile("s_waitcnt vmcnt(" #n ")" ::: "memory")
#define PG8_WAIT_L(n) asm volatile("s_waitcnt lgkmcnt(" #n ")" ::: "memory")
#define PG8_BAR __builtin_amdgcn_s_barrier()
#define PG8_SCHED __builtin_amdgcn_sched_barrier(0)
#define PG8_APTR(u) ((const char*)g.A + ((size_t)(u).zo * g.sAo + (size_t)(u).zi * g.sAi + (size_t)(u).pm * BM * g.lda) * 2)
#define PG8_BPTR(u) ((const char*)g.Bt + ((size_t)(u).zo * g.sBo + (size_t)(u).zi * g.sBi + (size_t)(u).pn * BM * g.ldb) * 2)
    Unit cur, nxt; int ui = 0;
    if (!next_unit(g, 0, G, c, cur)) return;
    f32x4 acc[2][2][4][2];
#define PG8_ACC_INIT(u) do { const int row0_ = (u).pm * BM + wr * 64 + fr, col0_ = (u).pn * BM + wc * 32 + 8 * fq; \
        _Pragma("unroll") for (int a = 0; a < 2; ++a) _Pragma("unroll") for (int b = 0; b < 2; ++b) _Pragma("unroll") for (int m = 0; m < 4; ++m) \
            E.acc_init((u).zo, row0_ + a * HALF + m * 16, col0_ + b * HALF, acc[a][b][m][0], acc[a][b][m][1]); } while (0)
    PG8_ACC_INIT(cur);
    bf16x8 At[4][2], B0[2][2], B1[2][2];
    const char* cA = PG8_APTR(cur); const char* cB = PG8_BPTR(cur);
    PG8_STAGE(PG8_SB(0, 0), cB, voffB); PG8_STAGE(PG8_SA(0, 0), cA, voffA); PG8_STAGE(PG8_SB(0, 1), cB + hstepB, voffB); PG8_STAGE(PG8_SA(0, 1), cA + hstepA, voffA);
    if (wr == 1) PG8_BAR;
    PG8_WAIT_V(4); PG8_BAR;
    PG8_STAGE(PG8_SB(1, 0), cB + kstep, voffB); PG8_STAGE(PG8_SA(1, 0), cA + kstep, voffA); PG8_STAGE(PG8_SB(1, 1), cB + hstepB + kstep, voffB);
    PG8_WAIT_V(6); PG8_BAR;
    for (;;) {
        const bool has_next = next_unit(g, ui + 1, G, c, nxt);
        const char* nA = has_next ? PG8_APTR(nxt) : cA; const char* nB = has_next ? PG8_BPTR(nxt) : cB;
        for (int t = 0; t < nt; t += 2) {
            const bool last = (t == nt - 2);
            const char* a1 = cA + (size_t)(t + 1) * kstep;
            const char* a2 = last ? nA : cA + (size_t)(t + 2) * kstep; const char* b2 = last ? nB : cB + (size_t)(t + 2) * kstep;
            const char* a3 = a2 + kstep; const char* b3 = b2 + kstep;
            PG8_LDB(B0, 0, 0); PG8_SCHED; PG8_LDA(At, 0, 0); PG8_STAGE(PG8_SA(1, 1), a1 + hstepA, voffA);
            PG8_WAIT_L(8); PG8_BAR; PG8_WAIT_L(0); PG8_MMA(0, 0, At, B0); PG8_BAR; PG8_SCHED;
            PG8_LDB(B1, 0, 1); PG8_STAGE(PG8_SB(0, 0), b2, voffB);
            PG8_BAR; PG8_WAIT_L(0); PG8_MMA(0, 1, At, B1); PG8_BAR;
            PG8_LDA(At, 0, 1); PG8_STAGE(PG8_SA(0, 0), a2, voffA);
            PG8_BAR; PG8_WAIT_L(0); PG8_MMA(1, 0, At, B0); PG8_BAR; PG8_SCHED;
            PG8_STAGE(PG8_SB(0, 1), b2 + hstepB, voffB);
            PG8_WAIT_V(6); PG8_BAR; PG8_MMA(1, 1, At, B1); PG8_BAR;
            PG8_LDB(B0, 1, 0); PG8_SCHED; PG8_LDA(At, 1, 0); PG8_STAGE(PG8_SA(0, 1), a2 + hstepA, voffA);
            PG8_WAIT_L(8); PG8_BAR; PG8_WAIT_L(0); PG8_MMA(0, 0, At, B0); PG8_BAR; PG8_SCHED;
            PG8_LDB(B1, 1, 1); PG8_STAGE(PG8_SB(1, 0), b3, voffB);
            PG8_BAR; PG8_WAIT_L(0); PG8_MMA(0, 1, At, B1); PG8_BAR;
            PG8_LDA(At, 1, 1); PG8_STAGE(PG8_SA(1, 0), a3, voffA);
            PG8_BAR; PG8_WAIT_L(0); PG8_MMA(1, 0, At, B0); PG8_BAR; PG8_SCHED;
            PG8_STAGE(PG8_SB(1, 1), b3 + hstepB, voffB);
            PG8_WAIT_V(6); PG8_BAR; PG8_MMA(1, 1, At, B1); PG8_BAR;
        }
        if constexpr (IsSoftmaxEpi<Epi>::value) { E.tile_epilogue(lds, cur.zo, cur.pm, cur.pn, acc, wr, wc, fr, fq); } else
        {
            const int row0 = cur.pm * BM + wr * 64 + fr, col0 = cur.pn * BM + wc * 32 + 8 * fq;
#pragma unroll
            for (int ai = 0; ai < 2; ++ai) {
                typename Epi::RowPre rp[4]; typename Epi::OctPre op[4][2];
#pragma unroll
                for (int m = 0; m < 4; ++m) { const int row = row0 + ai * HALF + m * 16; rp[m] = E.row_pre(cur.zo, row, fq);
#pragma unroll
                    for (int bj = 0; bj < 2; ++bj) op[m][bj] = E.oct_pre(cur.zo, row, col0 + bj * HALF); }
#pragma unroll
                for (int m = 0; m < 4; ++m) {
                    const int row = row0 + ai * HALF + m * 16;
                    const float ri = E.row_begin(rp[m]);
                    float ra = 0.f;
#pragma unroll
                    for (int bj = 0; bj < 2; ++bj) ra += E.oct(cur.zo, cur.zi, row, col0 + bj * HALF, acc[ai][bj][m][0], acc[ai][bj][m][1], ri, op[m][bj]);
                    E.row_end(cur.zo, row, cur.pn * 4 + wc, ra);
                }
            }
        }
        if (!has_next) break;
        PG8_ACC_INIT(nxt);
        cur = nxt; cA = nA; cB = nB; ++ui;
    }
    PG8_WAIT_V(0);
    if (wr == 0) PG8_BAR;
    PG8_BAR;
#undef PG8_SA
#undef PG8_SB
#undef PG8_STAGE
#undef PG8_LDA
#undef PG8_LDB
#undef PG8_MMA
#undef PG8_WAIT_V
#undef PG8_WAIT_L
#undef PG8_BAR
#undef PG8_SCHED
#undef PG8_ACC_INIT
#undef PG8_APTR
#undef PG8_BPTR
}

template <class Epi>
DI void naive_gemm(const Desc g, const Epi& E, int G, int c) {
    const int M = g.nM * BM, N = g.nN * BM, n8 = N / 8, nZ = g.nZo * g.nZi;
    const long total = (long)nZ * M * n8;
    for (long idx = (long)c * NTHREADS + threadIdx.x; idx < total; idx += (long)G * NTHREADS) {
        const int col = (int)(idx % n8) * 8; const int row = (int)((idx / n8) % M); const int z = (int)(idx / ((long)n8 * M));
        const int zo = z / g.nZi, zi = z % g.nZi;
        const bf16_t* a = g.A + (size_t)zo * g.sAo + (size_t)zi * g.sAi + (size_t)row * g.lda;
        const bf16_t* b = g.Bt + (size_t)zo * g.sBo + (size_t)zi * g.sBi + (size_t)col * g.ldb;
        float acc[8];
#pragma unroll
        for (int j = 0; j < 8; ++j) acc[j] = 0.f;
        for (int k = 0; k < g.K; k += 8) {
            const u32x4 av = *(const u32x4*)(a + k);
#pragma unroll
            for (int j = 0; j < 8; ++j) { const u32x4 bv = *(const u32x4*)(b + (size_t)j * g.ldb + k);
                float s = acc[j]; s = dot2bf(av.x, bv.x, s); s = dot2bf(av.y, bv.y, s); s = dot2bf(av.z, bv.z, s); s = dot2bf(av.w, bv.w, s); acc[j] = s; }
        }
        (void)E.oct(zo, zi, row, col, (f32x4){acc[0], acc[1], acc[2], acc[3]}, (f32x4){acc[4], acc[5], acc[6], acc[7]}, E.row_begin(E.row_pre(zo, row, 0)), E.oct_pre(zo, row, col));
    }
}
template <class Epi>
DI void gemm(LAS unsigned char* lds, const Desc g, const Epi& E, int G, int c) {
#if !EN_GEMM
    return;
#elif FAST_GEMM
    gemm_phase(lds, g, E, G, c);
#else
    naive_gemm(g, E, G, c);
#endif
}
}

template <int NP> DI float row_rstd(const float* ss, int row) {
    const f32x4* p = (const f32x4*)(ss + (size_t)row * 32); float t = 0.f;
#pragma unroll
    for (int i = 0; i < NP / 4; ++i) { const f32x4 v = p[i]; t += (v[0] + v[1]) + (v[2] + v[3]); }
    return rsqrtf(t * (1.0f / DM) + NORM_EPS);
}
template <int NP> struct RowStat { f32x4 v[NP / 16 ? NP / 16 : 1]; };
template <int NP> DI RowStat<NP> row_stat_pre(const float* ss, int row, int fq) {
    RowStat<NP> r; const f32x4* p = (const f32x4*)(ss + (size_t)row * 32) + fq * (NP / 16);
#pragma unroll
    for (int i = 0; i < NP / 16; ++i) r.v[i] = p[i];
    return r;
}
template <int NP> DI float row_stat_fin(const RowStat<NP>& r) {
    float t = 0.f;
#pragma unroll
    for (int i = 0; i < NP / 16; ++i) t += (r.v[i][0] + r.v[i][1]) + (r.v[i][2] + r.v[i][3]);
    t = rows_sum(t);
    return rsqrtf(t * (1.0f / DM) + NORM_EPS);
}
struct EpiNone {};
#define EPI_NO_ROW_BEGIN typedef EpiNone RowPre; DI RowPre row_pre(int, int, int) const { return RowPre{}; } DI float row_begin(const RowPre&) const { return 0.f; }
#define EPI_NO_OCT_PRE typedef EpiNone OctPre; DI OctPre oct_pre(int, int, int) const { return OctPre{}; }
#define EPI_NO_ROW_END DI void row_end(int, int, int, float) const {}
#define EPI_ZERO_ACC DI void acc_init(int, int, int, f32x4& lo, f32x4& hi) const { lo = (f32x4){0.f, 0.f, 0.f, 0.f}; hi = lo; }
template <int NP  > struct EpiBf16T {
    bf16_t* O; long ldc, sZo, sZi; float scale; const float* ss; int rzo;
    EPI_NO_ROW_END EPI_NO_OCT_PRE EPI_ZERO_ACC
    typedef RowStat<NP ? NP : 16> RowPre;
    DI RowPre row_pre(int zo, int row, int fq) const { if (NP) return row_stat_pre<NP ? NP : 16>(ss, zo * rzo + row, fq); return RowPre{}; }
    DI float row_begin(const RowPre& r) const { return NP ? row_stat_fin<NP ? NP : 16>(r) * scale : scale; }
    DI float oct(int zo, int zi, int row, int col, f32x4 lo, f32x4 hi, float f, const OctPre&) const {
        bf16_t* p = O + (size_t)zo * sZo + (size_t)zi * sZi + (size_t)row * ldc + col;
        u32x4 w; w.x = pk2(lo[0] * f, lo[1] * f); w.y = pk2(lo[2] * f, lo[3] * f); w.z = pk2(hi[0] * f, hi[1] * f); w.w = pk2(hi[2] * f, hi[3] * f);
        *(u32x4*)p = w; return 0.f;
    }
};
typedef EpiBf16T<0> EpiBf16;
struct EpiSoftmax256 {
    static constexpr bool kSoftmax = true;
    bf16_t* O; long ldc, sZo; float scale; const float* ss; int rzo;
    EPI_NO_ROW_BEGIN EPI_NO_OCT_PRE EPI_NO_ROW_END EPI_ZERO_ACC
    DI float oct(int, int, int, int, f32x4, f32x4, float, const OctPre&) const { return 0.f; }
    DI void tile_epilogue(LAS unsigned char* lds, int zo, int pm, int pn, f32x4 (&acc)[2][2][4][2], int wr, int wc, int fr, int fq) const {
        LAS float* xm = (LAS float*)(lds + LDSCTL_OFF + 1024);
        LAS float* xs = xm + 1024;
        const int row0 = pm * 256 + wr * 64 + fr, col0 = pn * 256 + wc * 32 + 8 * fq;
        float mloc[2][4];
#pragma unroll
        for (int ai = 0; ai < 2; ++ai) {
            RowStat<32> rp[4];
#pragma unroll
            for (int m = 0; m < 4; ++m) rp[m] = row_stat_pre<32>(ss, zo * rzo + row0 + ai * 128 + m * 16, fq);
#pragma unroll
            for (int m = 0; m < 4; ++m) {
                const float f = row_stat_fin<32>(rp[m]) * scale * 1.4426950408889634f;
                float mx = -INFINITY;
#pragma unroll
                for (int bj = 0; bj < 2; ++bj)
#pragma unroll
                    for (int h = 0; h < 2; ++h)
#pragma unroll
                        for (int j = 0; j < 4; ++j) { const float v = acc[ai][bj][m][h][j] * f; acc[ai][bj][m][h][j] = v; mx = fmaxf(mx, v); }
                mx = rows_max(mx);
                float sm = 0.f;
#pragma unroll
                for (int bj = 0; bj < 2; ++bj)
#pragma unroll
                    for (int h = 0; h < 2; ++h)
#pragma unroll
                        for (int j = 0; j < 4; ++j) { const float p = __builtin_amdgcn_exp2f(acc[ai][bj][m][h][j] - mx); acc[ai][bj][m][h][j] = p; sm += p; }
                sm = rows_sum(sm);
                mloc[ai][m] = mx;
                const int rl = ai * 128 + wr * 64 + m * 16 + fr;
                if (fq == 0) { xm[rl * 4 + wc] = mx; xs[rl * 4 + wc] = sm; }
            }
        }
        asm volatile("s_waitcnt lgkmcnt(0)" ::: "memory");
        __builtin_amdgcn_s_barrier();
        asm volatile("" ::: "memory");
#pragma unroll
        for (int ai = 0; ai < 2; ++ai)
#pragma unroll
            for (int m = 0; m < 4; ++m) {
                const int rl = ai * 128 + wr * 64 + m * 16 + fr;
                const f32x4 m4 = *(const LAS f32x4*)(xm + rl * 4), s4 = *(const LAS f32x4*)(xs + rl * 4);
                const float M = fmaxf(fmaxf(m4[0], m4[1]), fmaxf(m4[2], m4[3]));
                const float S = s4[0] * __builtin_amdgcn_exp2f(m4[0] - M) + s4[1] * __builtin_amdgcn_exp2f(m4[1] - M) + s4[2] * __builtin_amdgcn_exp2f(m4[2] - M) + s4[3] * __builtin_amdgcn_exp2f(m4[3] - M);
                const float f = __builtin_amdgcn_exp2f(mloc[ai][m] - M) / S;
                bf16_t* p = O + (size_t)zo * sZo + (size_t)(row0 + ai * 128 + m * 16) * ldc + col0;
#pragma unroll
                for (int bj = 0; bj < 2; ++bj) {
                    const f32x4 lo = acc[ai][bj][m][0], hi = acc[ai][bj][m][1];
                    u32x4 w; w.x = pk2(lo[0] * f, lo[1] * f); w.y = pk2(lo[2] * f, lo[3] * f); w.z = pk2(hi[0] * f, hi[1] * f); w.w = pk2(hi[2] * f, hi[3] * f);
                    *(u32x4*)(p + bj * 128) = w;
                }
            }
    }
};
template <int NP> struct EpiF32T {
    float* O; long ldc, sZo, sZi; float scale; const float* ss; int rzo;
    EPI_NO_ROW_END EPI_NO_OCT_PRE EPI_ZERO_ACC
    typedef RowStat<NP ? NP : 16> RowPre;
    DI RowPre row_pre(int zo, int row, int fq) const { if (NP) return row_stat_pre<NP ? NP : 16>(ss, zo * rzo + row, fq); return RowPre{}; }
    DI float row_begin(const RowPre& r) const { return NP ? row_stat_fin<NP ? NP : 16>(r) * scale : scale; }
    DI float oct(int zo, int zi, int row, int col, f32x4 lo, f32x4 hi, float f, const OctPre&) const {
        float* p = O + (size_t)zo * sZo + (size_t)zi * sZi + (size_t)row * ldc + col;
        *(f32x4*)p = lo * f; *(f32x4*)(p + 4) = hi * f; return 0.f;
    }
};
typedef EpiF32T<0> EpiF32;
template <bool F32SRC> struct EpiResidB {
    const float* xin; bf16_t* xb; float* ss; int rzo;
    EPI_NO_ROW_BEGIN EPI_NO_OCT_PRE
    DI void acc_init(int zo, int row, int col, f32x4& lo, f32x4& hi) const {
        const size_t o = (size_t)(zo * rzo + row) * DM + col;
        if (F32SRC) { lo = *(const f32x4*)(xin + o); hi = *(const f32x4*)(xin + o + 4); }
        else { const u32x4 w = *(const u32x4*)(xb + o); lo = (f32x4){bflo(w.x), bfhi(w.x), bflo(w.y), bfhi(w.y)}; hi = (f32x4){bflo(w.z), bfhi(w.z), bflo(w.w), bfhi(w.w)}; }
    }
    DI float oct(int zo, int, int row, int col, f32x4 lo, f32x4 hi, float, const OctPre&) const {
        const size_t o = (size_t)(zo * rzo + row) * DM + col;
        const float r[8] = {0.f, 0.f, 0.f, 0.f, 0.f, 0.f, 0.f, 0.f};
        u32x4 w; w.x = pk2(r[0] + lo[0], r[1] + lo[1]); w.y = pk2(r[2] + lo[2], r[3] + lo[3]); w.z = pk2(r[4] + hi[0], r[5] + hi[1]); w.w = pk2(r[6] + hi[2], r[7] + hi[3]);
        *(u32x4*)(xb + o) = w;
        const float q0 = bflo(w.x), q1 = bfhi(w.x), q2 = bflo(w.y), q3 = bfhi(w.y), q4 = bflo(w.z), q5 = bfhi(w.z), q6 = bflo(w.w), q7 = bfhi(w.w);
        return ((q0 * q0 + q1 * q1) + (q2 * q2 + q3 * q3)) + ((q4 * q4 + q5 * q5) + (q6 * q6 + q7 * q7));
    }
    DI void row_end(int zo, int row, int slot, float ra) const {
        ra = rows_sum(ra);
        if ((threadIdx.x & 63) < 16) ss[(size_t)(zo * rzo + row) * 32 + slot] = ra;
    }
};
template <int MODE> struct EpiRope {
    bf16_t* O; long ldc; const int* pos; const f32x2* tab;
    EPI_NO_ROW_BEGIN EPI_NO_ROW_END EPI_NO_OCT_PRE EPI_ZERO_ACC
    DI float oct(int, int, int row, int col, f32x4 lo, f32x4 hi, float, const OctPre&) const {
        bool rope; int j0;
        if (MODE == 0) { rope = col < 2 * DIFF_W; j0 = col & 63; } else { const int c = col % 192; rope = c >= 128; j0 = c - 128; }
        if (rope) {
            int p = pos[row]; p = p < 0 ? 0 : (p > ROPE_POS - 1 ? ROPE_POS - 1 : p);
            const f32x4* tp = (const f32x4*)(tab + (size_t)p * 32 + (j0 >> 1));
            const f32x4 t0 = tp[0], t1 = tp[1];
            f32x4 a = lo, b = hi;
            lo[0] = a[0] * t0[0] - a[1] * t0[1]; lo[1] = a[1] * t0[0] + a[0] * t0[1];
            lo[2] = a[2] * t0[2] - a[3] * t0[3]; lo[3] = a[3] * t0[2] + a[2] * t0[3];
            hi[0] = b[0] * t1[0] - b[1] * t1[1]; hi[1] = b[1] * t1[0] + b[0] * t1[1];
            hi[2] = b[2] * t1[2] - b[3] * t1[3]; hi[3] = b[3] * t1[2] + b[2] * t1[3];
        }
        u32x4 w; w.x = pk2(lo[0], lo[1]); w.y = pk2(lo[2], lo[3]); w.z = pk2(hi[0], hi[1]); w.w = pk2(hi[2], hi[3]);
        *(u32x4*)(O + (size_t)row * ldc + col) = w; return 0.f;
    }
};
struct EpiGlu {
    const bf16_t* gbuf; const float* bias; bf16_t* out;
    EPI_NO_ROW_BEGIN EPI_NO_ROW_END EPI_NO_OCT_PRE EPI_ZERO_ACC
    DI float oct(int, int, int row, int col, f32x4 lo, f32x4 hi, float, const OctPre&) const {
        const u32x4 gv = *(const u32x4*)(gbuf + (size_t)row * S5_W + col);
        const f32x4 b0 = *(const f32x4*)(bias + col), b1 = *(const f32x4*)(bias + col + 4);
        float g[8] = {bflo(gv.x), bfhi(gv.x), bflo(gv.y), bfhi(gv.y), bflo(gv.z), bfhi(gv.z), bflo(gv.w), bfhi(gv.w)};
        float a[8] = {lo[0] + b0[0], lo[1] + b0[1], lo[2] + b0[2], lo[3] + b0[3], hi[0] + b1[0], hi[1] + b1[1], hi[2] + b1[2], hi[3] + b1[3]};
        float r[8];
#pragma unroll
        for (int j = 0; j < 8; ++j) r[j] = g[j] / (1.0f + __expf(-a[j]));
        u32x4 w; w.x = pk2(r[0], r[1]); w.y = pk2(r[2], r[3]); w.z = pk2(r[4], r[5]); w.w = pk2(r[6], r[7]);
        *(u32x4*)(out + (size_t)row * DM + DIFF_W + col) = w; return 0.f;
    }
};
struct EpiNull { EPI_NO_ROW_BEGIN EPI_NO_ROW_END EPI_NO_OCT_PRE EPI_ZERO_ACC DI float oct(int, int, int, int, f32x4 lo, f32x4 hi, float, const OctPre&) const { asm volatile("" :: "v"(lo), "v"(hi)); return 0.f; } };
struct Params {
    const float* in[39];
    float* out; unsigned char* ws;
    int ph_lo, ph_hi;
};
enum { I_X = 0, I_MEM, I_POS, I_AB_NORM, I_AB_WIN, I_AB_WOUT, I_LQ1, I_LK1, I_LQ2, I_LK2, I_SUBLN, I_S5_ARE, I_S5_AIM, I_S5_LOGSTEP, I_S5_BRE, I_S5_BIM, I_S5_CRE, I_S5_CIM, I_S5_D,
       I_S5_WGLU, I_S5_BGLU, I_MLA_NORM, I_MLA_WIN, I_MLA_QNORM, I_MLA_KVNORM, I_MLA_WUQ, I_MLA_WUKV, I_MLA_WO, I_XA_NORM, I_XA_MEMNORM, I_XA_WQ, I_XA_WKV, I_XA_WO, I_FFN_NORM,
       I_PEER_WQ, I_PEER_SK, I_PEER_U, I_PEER_V, I_FINAL_NORM };

struct Ctx { LAS unsigned char* lds; int tid, lane, wave, blk, G; };
DI Ctx fresh(const Ctx& C0) { Ctx C = C0; C.tid = opaque_tid(); C.lane = C.tid & 63; return C; }

DI void rms_rows_2048(const Ctx& C0, const float* src, const float* gain, bf16_t* dst, int nrows) {
    const Ctx C = fresh(C0);
    const int r0 = C.blk * NWAVES + C.wave, rstep = C.G * NWAVES;
    f32x4 nv[8];
    if (r0 < nrows) { const f32x4* xr = (const f32x4*)(src + (size_t)r0 * DM) + C.lane;
#pragma unroll
        for (int j = 0; j < 8; ++j) nv[j] = xr[64 * j]; }
    for (int r = r0; r < nrows; r += rstep) {
        f32x4 v[8]; float ss = 0.f;
#pragma unroll
        for (int j = 0; j < 8; ++j) v[j] = nv[j];
        { const int rn = (r + rstep < nrows) ? r + rstep : r; const f32x4* xr = (const f32x4*)(src + (size_t)rn * DM) + C.lane;
#pragma unroll
            for (int j = 0; j < 8; ++j) nv[j] = xr[64 * j]; }
#pragma unroll
        for (int j = 0; j < 8; ++j) ss += (v[j][0] * v[j][0] + v[j][1] * v[j][1]) + (v[j][2] * v[j][2] + v[j][3] * v[j][3]);
        const float sc = rsqrtf(wave_sum(ss) * (1.0f / DM) + NORM_EPS);
        u32x2* o = (u32x2*)(dst + (size_t)r * DM) + C.lane;
#pragma unroll
        for (int j = 0; j < 8; ++j) { const f32x4 g = *((const f32x4*)gain + C.lane + 64 * j);
            u32x2 w; w.x = pk2(v[j][0] * sc * g[0], v[j][1] * sc * g[1]); w.y = pk2(v[j][2] * sc * g[2], v[j][3] * sc * g[3]); o[64 * j] = w; }
    }
}
DI void rms_rows_final(const Ctx& C0, const bf16_t* xbp, float* out, const float* gain, int nrows) {
    const Ctx C = fresh(C0);
    const int r0 = C.blk * NWAVES + C.wave, rstep = C.G * NWAVES;
    u32x2 nw[8];
    if (r0 < nrows) { const u32x2* xr = (const u32x2*)(xbp + (size_t)r0 * DM) + C.lane;
#pragma unroll
        for (int j = 0; j < 8; ++j) nw[j] = xr[64 * j]; }
    for (int r = r0; r < nrows; r += rstep) {
        f32x4 v[8]; float ss = 0.f;
#pragma unroll
        for (int j = 0; j < 8; ++j) { const u32x2 w = nw[j]; v[j] = (f32x4){bflo(w.x), bfhi(w.x), bflo(w.y), bfhi(w.y)}; }
        { const int rn = (r + rstep < nrows) ? r + rstep : r; const u32x2* xr = (const u32x2*)(xbp + (size_t)rn * DM) + C.lane;
#pragma unroll
            for (int j = 0; j < 8; ++j) nw[j] = xr[64 * j]; }
#pragma unroll
        for (int j = 0; j < 8; ++j) ss += (v[j][0] * v[j][0] + v[j][1] * v[j][1]) + (v[j][2] * v[j][2] + v[j][3] * v[j][3]);
        const float sc = rsqrtf(wave_sum(ss) * (1.0f / DM) + NORM_EPS);
        f32x4* o = (f32x4*)(out + (size_t)r * DM) + C.lane;
#pragma unroll
        for (int j = 0; j < 8; ++j) { const f32x4 g = *((const f32x4*)gain + C.lane + 64 * j); o[64 * j] = v[j] * sc * g; }
    }
}

DI int srccol(int kind, int n) {
    if (kind == 1) { if (n < 2 * DIFF_W) { const int j = n & 63; return (n & ~63) + (j >> 1) + 32 * (j & 1); } return n; }
    if (kind == 2) { if (n >= MLA_IN) return -1; if (n >= 1024) { const int j = n - 1024; return 1024 + (j >> 1) + 32 * (j & 1); } return n; }
    if (kind == 3) { const int c = n % 192; if (c >= 128) { const int j = c - 128; return n - c + 128 + (j >> 1) + 32 * (j & 1); } return n; }
    return n;
}
DI void transpose_item(const float* W, int K, int Nsrc, bf16_t* Wt, int nblk, int kind, const float* kgain, LAS float* scr, int item, int lane) {
    const int kb = item / nblk, nb = item % nblk, k0 = 64 * kb, n0 = 32 * nb;
    const int src = srccol(kind, n0 + (lane & 31));
    float wv[32];
#pragma unroll
    for (int i = 0; i < 32; ++i) { const int kk = 2 * i + (lane >> 5); wv[i] = (src >= 0) ? W[(size_t)(k0 + kk) * Nsrc + src] : 0.f; }
#pragma unroll
    for (int i = 0; i < 32; ++i) { const int kk = 2 * i + (lane >> 5); scr[kk * 33 + (lane & 31)] = kgain ? wv[i] * kgain[k0 + kk] : wv[i]; }
    LDS_WAIT(); asm volatile("" ::: "memory");
    const int c = lane & 7;
#pragma unroll
    for (int j = 0; j < 4; ++j) { const int n = (lane >> 3) + 8 * j; const LAS float* s = scr + (8 * c) * 33 + n;
        u32x4 o; o.x = pk2(s[0 * 33], s[1 * 33]); o.y = pk2(s[2 * 33], s[3 * 33]); o.z = pk2(s[4 * 33], s[5 * 33]); o.w = pk2(s[6 * 33], s[7 * 33]);
        *(u32x4*)(Wt + (size_t)(n0 + n) * K + k0 + 8 * c) = o; }
    LDS_WAIT(); asm volatile("" ::: "memory");
}
DI void cvt_bf16(const Ctx& C0, const float* src, bf16_t* dst, size_t n8) {
    const Ctx C = fresh(C0);
    for (size_t i = (size_t)C.blk * NTHREADS + C.tid; i < n8; i += (size_t)C.G * NTHREADS) {
        const f32x4 a = *(const f32x4*)(src + i * 8), b = *(const f32x4*)(src + i * 8 + 4);
        u32x4 w; w.x = pk2(a[0], a[1]); w.y = pk2(a[2], a[3]); w.z = pk2(b[0], b[1]); w.w = pk2(b[2], b[3]);
        *(u32x4*)(dst + i * 8) = w;
    }
}


DI void cvt_rows_gain(const Ctx& C, const float* src, bf16_t* dst, const float* gain, size_t n8) {
    const size_t stride = (size_t)C.G * NTHREADS;
    for (size_t i0 = (size_t)C.blk * NTHREADS + C.tid; i0 < n8; i0 += 4 * stride) {
        f32x4 a[4], b[4]; float g[4];
#pragma unroll
        for (int j = 0; j < 4; ++j) { const size_t i = i0 + j * stride; if (i < n8) { a[j] = *(const f32x4*)(src + i * 8); b[j] = *(const f32x4*)(src + i * 8 + 4); g[j] = gain[i / (DM / 8)]; } }
#pragma unroll
        for (int j = 0; j < 4; ++j) { const size_t i = i0 + j * stride; if (i < n8) {
            u32x4 w; w.x = pk2(a[j][0] * g[j], a[j][1] * g[j]); w.y = pk2(a[j][2] * g[j], a[j][3] * g[j]); w.z = pk2(b[j][0] * g[j], b[j][1] * g[j]); w.w = pk2(b[j][2] * g[j], b[j][3] * g[j]);
            *(u32x4*)(dst + i * 8) = w; } }
    }
}

DI void cvt_fp8_rows(const Ctx& C0, const float* src, unsigned char* dst, float* isc, int nrows) {
    const Ctx C = fresh(C0);
    for (int r = C.blk * NWAVES + C.wave; r < nrows; r += C.G * NWAVES) {
        const f32x4* xr = (const f32x4*)(src + (size_t)r * DM) + C.lane;
        f32x4 v[8]; float am = 0.f;
#pragma unroll
        for (int j = 0; j < 8; ++j) { v[j] = xr[64 * j]; am = fmaxf(am, fmaxf(fmaxf(fabsf(v[j][0]), fabsf(v[j][1])), fmaxf(fabsf(v[j][2]), fabsf(v[j][3])))); }
        am = wave_max(am);
        const float e = am > 0.f ? floorf(log2f(448.0f / am)) : 0.f;
        const float scale = exp2f(e);
        if (C.lane == 0) isc[r] = exp2f(-e);
#if PEER_SLICED
        unsigned* o = (unsigned*)(dst + (size_t)(C.lane >> 5) * ((size_t)PEER_NE * 128) + (size_t)r * 128) + (C.lane & 31);
#pragma unroll
        for (int j = 0; j < 8; ++j) { int w = 0; w = __builtin_amdgcn_cvt_pk_fp8_f32(v[j][0] * scale, v[j][1] * scale, w, false); w = __builtin_amdgcn_cvt_pk_fp8_f32(v[j][2] * scale, v[j][3] * scale, w, true); o[(size_t)2 * j * (PEER_NE * 128 / 4)] = (unsigned)w; }
#else
        unsigned* o = (unsigned*)(dst + (size_t)r * DM) + C.lane;
#pragma unroll
        for (int j = 0; j < 8; ++j) { int w = 0; w = __builtin_amdgcn_cvt_pk_fp8_f32(v[j][0] * scale, v[j][1] * scale, w, false); w = __builtin_amdgcn_cvt_pk_fp8_f32(v[j][2] * scale, v[j][3] * scale, w, true); o[64 * j] = (unsigned)w; }
#endif
    }
}


DI void cvt_i8_rows(const Ctx& C0, const float* src, const float* cgain, unsigned char* dst, float* isc, int nrows) {
    const Ctx C = fresh(C0);
    const int r0 = C.blk * NWAVES + C.wave, rstep = C.G * NWAVES;
    f32x4 nv[8];
    if (r0 < nrows) { const f32x4* xr = (const f32x4*)(src + (size_t)r0 * DM) + C.lane;
#pragma unroll
        for (int j = 0; j < 8; ++j) nv[j] = xr[64 * j]; }
    for (int r = r0; r < nrows; r += rstep) {
        f32x4 v[8]; float am = 0.f;
#pragma unroll
        for (int j = 0; j < 8; ++j) v[j] = nv[j];
        { const int rn = (r + rstep < nrows) ? r + rstep : r; const f32x4* xr = (const f32x4*)(src + (size_t)rn * DM) + C.lane;
#pragma unroll
            for (int j = 0; j < 8; ++j) nv[j] = xr[64 * j]; }
#pragma unroll
        for (int j = 0; j < 8; ++j) { if (cgain) v[j] = v[j] * *((const f32x4*)cgain + C.lane + 64 * j); am = fmaxf(am, fmaxf(fmaxf(fabsf(v[j][0]), fabsf(v[j][1])), fmaxf(fabsf(v[j][2]), fabsf(v[j][3])))); }
        am = wave_max(am);
        const float scale = am > 0.f ? 127.0f / am : 0.f;
        if (C.lane == 0) isc[r] = am * (1.0f / 127.0f);
        unsigned* o = (unsigned*)(dst + (size_t)(C.lane >> 5) * ((size_t)PEER_NE * 128) + (size_t)r * 128) + (C.lane & 31);
#pragma unroll
        for (int j = 0; j < 8; ++j) o[(size_t)2 * j * (PEER_NE * 128 / 4)] = q8x4(v[j][0], v[j][1], v[j][2], v[j][3], scale);
    }
}

template <bool HI_SIGNED  , bool LO_SIGNED  >
DI void cvt_i4_rows(const Ctx& C0, const float* src, const float* cgain, unsigned char* dst, float* isc, int nrows) {
    const Ctx C = fresh(C0);
    const int r0 = C.blk * NWAVES + C.wave, rstep = C.G * NWAVES;
    f32x4 nv[8];
    if (r0 < nrows) { const f32x4* xr = (const f32x4*)(src + (size_t)r0 * DM) + 2 * C.lane;
#pragma unroll
        for (int j = 0; j < 4; ++j) { nv[2 * j] = xr[128 * j]; nv[2 * j + 1] = xr[128 * j + 1]; } }
    for (int r = r0; r < nrows; r += rstep) {
        f32x4 v[8]; float am = 0.f;
#pragma unroll
        for (int j = 0; j < 8; ++j) v[j] = nv[j];
        { const int rn = (r + rstep < nrows) ? r + rstep : r; const f32x4* xr = (const f32x4*)(src + (size_t)rn * DM) + 2 * C.lane;
#pragma unroll
            for (int j = 0; j < 4; ++j) { nv[2 * j] = xr[128 * j]; nv[2 * j + 1] = xr[128 * j + 1]; } }
#pragma unroll
        for (int j = 0; j < 4; ++j) { if (cgain) { const f32x4* gp = (const f32x4*)cgain + 2 * C.lane + 128 * j; v[2 * j] = v[2 * j] * gp[0]; v[2 * j + 1] = v[2 * j + 1] * gp[1]; } }
#pragma unroll
        for (int j = 0; j < 8; ++j) am = fmaxf(am, fmaxf(fmaxf(fabsf(v[j][0]), fabsf(v[j][1])), fmaxf(fabsf(v[j][2]), fabsf(v[j][3]))));
        am = wave_max(am);
        const float amc = 0.70f * am;
        const float scale = am > 0.f ? 7.0f / amc : 0.f;
        if (C.lane == 0) isc[r] = amc * (1.0f / 7.0f);
        unsigned* o = (unsigned*)(dst + (size_t)(C.lane >> 5) * ((size_t)PEER_NE * 128) + (size_t)r * 128) + (C.lane & 31);
#pragma unroll
        for (int j = 0; j < 4; ++j) {
            const float M8 = 12582912.0f + 8.0f;
            f32x4 a = v[2 * j] * scale, b = v[2 * j + 1] * scale;
#pragma unroll
            for (int k = 0; k < 4; ++k) { a[k] = __builtin_amdgcn_fmed3f(a[k], -7.0f, 7.0f); b[k] = __builtin_amdgcn_fmed3f(b[k], -7.0f, 7.0f); }
            const float ML = LO_SIGNED ? 12582912.0f : M8;
            const unsigned y0 = __float_as_uint(a[0] + ML), y1 = __float_as_uint(a[1] + ML), y2 = __float_as_uint(a[2] + ML), y3 = __float_as_uint(a[3] + ML);
            const float MH = HI_SIGNED ? 12582912.0f : M8;
            const unsigned z0 = __float_as_uint(b[0] + MH), z1 = __float_as_uint(b[1] + MH), z2 = __float_as_uint(b[2] + MH), z3 = __float_as_uint(b[3] + MH);
            unsigned lo = __builtin_amdgcn_perm(y1, y0, 0x0c0c0400u) | (__builtin_amdgcn_perm(y3, y2, 0x0c0c0400u) << 16);
            if (LO_SIGNED) lo &= 0x0f0f0f0fu;
            unsigned hi = __builtin_amdgcn_perm(z1, z0, 0x0c0c0400u) | (__builtin_amdgcn_perm(z3, z2, 0x0c0c0400u) << 16);
            if (HI_SIGNED) hi &= 0x0f0f0f0fu;
            o[(size_t)2 * j * (PEER_NE * 128 / 4)] = lo | (hi << 4);
        }
    }
}

DI void convert_tables(const Ctx& C, const Params& P, int l) {
    unsigned char* ws = P.ws;
#if PEER_FP8
#if PEER_SLICED
    cvt_i4_rows<true, true>(C, P.in[I_PEER_U] + (size_t)l * PEER_NE * DM, P.in[I_FFN_NORM] + l * DM, ws + P_UT, (float*)(ws + P_UT + 32 * MiB), PEER_NE);
#else
    cvt_fp8_rows(C, P.in[I_PEER_U] + (size_t)l * PEER_NE * DM, ws + P_UT, (float*)(ws + P_UT + 32 * MiB), PEER_NE);
#endif
    cvt_i4_rows<true, false>(C, P.in[I_PEER_V] + (size_t)l * PEER_NE * DM, nullptr, ws + P_VT, (float*)(ws + P_VT + 32 * MiB), PEER_NE);
#else
    cvt_bf16(C, P.in[I_PEER_U] + (size_t)l * PEER_NE * DM, (bf16_t*)(ws + P_UT), (size_t)PEER_NE * DM / 8);
    cvt_bf16(C, P.in[I_PEER_V] + (size_t)l * PEER_NE * DM, (bf16_t*)(ws + P_VT), (size_t)PEER_NE * DM / 8);
#endif
}

DI void phase_prologue(const Ctx& C0, const Params& P) {
    const Ctx C = fresh(C0);
    unsigned char* ws = P.ws;
    LAS float* scr = (LAS float*)(C.lds + C.wave * 8448);
    const int gw = C.blk * NWAVES + C.wave, NGW = C.G * NWAVES;
    int base = 0;
#define TJOB(Wp, K_, Nsrc_, Nout_, kind_, dst_, kg_) do { const int nblk_ = (Nout_) / 32, nit_ = ((K_) / 64) * nblk_; \
        int first_ = (gw - base % NGW + NGW) % NGW; \
        for (int it = first_; it < nit_; it += NGW) transpose_item((Wp), (K_), (Nsrc_), (bf16_t*)(dst_), nblk_, (kind_), (kg_), scr, it, C.lane); base += nit_; } while (0)
    TJOB(P.in[I_AB_WIN], DM, AB_IN, AB_IN, 1, ws + WS_ABIN_T, nullptr);
    TJOB(P.in[I_AB_WOUT], DM, DM, DM, 0, ws + WS_ABOUT_T, nullptr);
    TJOB(P.in[I_S5_WGLU], S5_W, S5_W, S5_W, 0, ws + WS_GLU_T, nullptr);
    TJOB(P.in[I_MLA_WIN], DM, MLA_IN, MLA_IN_PAD, 2, ws + WS_MLAIN_T, P.in[I_MLA_NORM]);
    TJOB(P.in[I_MLA_WUQ], MLA_QR, 3072, 3072, 3, ws + WS_UQ_T, nullptr);
    TJOB(P.in[I_MLA_WUKV], MLA_KVR, 4096, 4096, 0, ws + WS_UKV_T, nullptr);
    TJOB(P.in[I_MLA_WO], DM, DM, DM, 0, ws + WS_MLAO_T, nullptr);
    for (int l = 0; l < 2; ++l) {
        TJOB(P.in[I_XA_WKV] + (size_t)l * DM * 2 * DM, DM, 2 * DM, 2 * DM, 0, ws + WS_LW + l * LW_STRIDE + LW_XKV, nullptr);
        TJOB(P.in[I_XA_WO] + (size_t)l * DM * DM, DM, DM, DM, 0, ws + WS_LW + l * LW_STRIDE + LW_XO, nullptr);
    }
#undef TJOB
    {
        f32x2* tab = (f32x2*)(ws + WS_ROPE);
        for (int i = C.blk * NTHREADS + C.tid; i < ROPE_POS * 32; i += C.G * NTHREADS) {
            const int p = i >> 5, f = i & 31;
            const float inv = powf(10000.0f, -(float)f * (2.0f / 64.0f));
            const float ang = (float)p * inv;
            tab[i] = (f32x2){(float)cos((double)ang), (float)sin((double)ang)};
        }
    }
    for (int l = 0; l < 2; ++l) {
        const float* src = P.in[I_XA_WQ] + (size_t)l * DM * DM; bf16_t* dst = (bf16_t*)(ws + WS_LW + l * LW_STRIDE + LW_XQ);
        cvt_rows_gain(C, src, dst, P.in[I_XA_NORM] + l * DM, (size_t)DM * DM / 8);
    }
    {
        const float* src = P.in[I_PEER_WQ]; bf16_t* dst = (bf16_t*)(ws + P_WQB);
        cvt_rows_gain(C, src, dst, P.in[I_FFN_NORM], (size_t)2 * DM * DM / 8);
    }
    {
        bf16_t* sk = (bf16_t*)(ws + P_SK); const float* skin = P.in[I_PEER_SK];
        for (int i = C.blk * NTHREADS + C.tid; i < 2 * 8 * 256 * 256 / 8; i += C.G * NTHREADS) {
            const int q8 = (i & 31) * 8, np = (i >> 5) & 255, lh = i >> 13;
            const int c = np >> 7, n = np & 127, c2 = q8 >> 7, q = q8 & 127;
            u32x4 w = {0u, 0u, 0u, 0u};
            if (c == c2) { const float* s = skin + ((((size_t)lh * 2 + c) * 128 + n) * 128 + q);
                const f32x4 a = *(const f32x4*)s, b = *(const f32x4*)(s + 4);
                w.x = pk2(a[0], a[1]); w.y = pk2(a[2], a[3]); w.z = pk2(b[0], b[1]); w.w = pk2(b[2], b[3]); }
            *(u32x4*)(sk + (size_t)i * 8) = w;
        }
    }
    for (int l = 0; l < 2; ++l) rms_rows_2048(C, P.in[I_MEM], P.in[I_XA_MEMNORM] + l * DM, (bf16_t*)(ws + P_MEMN) + (size_t)l * MT * DM, MT);
}

DI void phase_s5(const Ctx& C0, const Params& P, int first, int last, int stride_w, int stride) {
    const Ctx C = fresh(C0);
    unsigned char* ws = P.ws;
    const bf16_t* proj = (const bf16_t*)(ws + P_PROJ); bf16_t* gbuf = (bf16_t*)(ws + P_GBUF);
    LAS unsigned char* my = C.lds + C.wave * 16384;
    LAS float* U = (LAS float*)my;
    LAS bf16_t* H = (LAS bf16_t*)(my + 1024);
    LAS float* BU = (LAS float*)(my + 5632);
    const int lane = C.lane, n = lane;
    for (int task = first + C.wave * stride_w; task < last; task += stride) {
        const int b = task >> 5, g = task & 31;
        const float a_re = P.in[I_S5_ARE][g * 64 + n], a_im = P.in[I_S5_AIM][g * 64 + n];
        const float step = expf(P.in[I_S5_LOGSTEP][g]);
        const float mag = expf(a_re * step);
        const float ab_re = mag * cosf(a_im * step), ab_im = mag * sinf(a_im * step);
        const float den = a_re * a_re + a_im * a_im, num_re = ab_re - 1.0f;
        const float f_re = (num_re * a_re + ab_im * a_im) / den, f_im = (ab_im * a_re - num_re * a_im) / den;
        bf16x8 bfr[8];
        {
            const float* br = P.in[I_S5_BRE] + ((size_t)g * 64 + n) * 16; const float* bi = P.in[I_S5_BIM] + ((size_t)g * 64 + n) * 16;
            unsigned wre[8], wim[8];
#pragma unroll
            for (int p = 0; p < 16; p += 2) { const float x0 = br[p], y0 = bi[p], x1 = br[p + 1], y1 = bi[p + 1];
                wre[p >> 1] = pk2(f_re * x0 - f_im * y0, f_re * x1 - f_im * y1); wim[p >> 1] = pk2(f_re * y0 + f_im * x0, f_re * y1 + f_im * x1); }
            LAS unsigned char* bbt = (LAS unsigned char*)BU;
            *(LAS u32x4*)(bbt + n * 32) = (u32x4){wre[0], wre[1], wre[2], wre[3]}; *(LAS u32x4*)(bbt + n * 32 + 16) = (u32x4){wre[4], wre[5], wre[6], wre[7]};
            *(LAS u32x4*)(bbt + (64 + n) * 32) = (u32x4){wim[0], wim[1], wim[2], wim[3]}; *(LAS u32x4*)(bbt + (64 + n) * 32 + 16) = (u32x4){wim[4], wim[5], wim[6], wim[7]};
            LDS_WAIT(); asm volatile("" ::: "memory");
#pragma unroll
            for (int j = 0; j < 8; ++j) { const u32x4 w = *(const LAS u32x4*)(bbt + (16 * j + (lane & 15)) * 32 + 16 * ((lane >> 4) & 1));
                bfr[j] = __builtin_bit_cast(bf16x8, (lane >> 5) ? (u32x4){0u, 0u, 0u, 0u} : w); }
            LDS_WAIT(); asm volatile("" ::: "memory");
        }
        bf16x8 cf[4];
        {
            const int p = lane & 15, kq = lane >> 4;
#pragma unroll
            for (int kk = 0; kk < 4; ++kk) {
                const int k = 32 * kk + 8 * kq; const bool im = k >= 64;
                const float* src = (im ? P.in[I_S5_CIM] : P.in[I_S5_CRE]) + ((size_t)g * 16 + p) * 64 + (k & 63);
                const float sg = im ? -1.f : 1.f;
                const f32x4 a = *(const f32x4*)src, bq = *(const f32x4*)(src + 4);
                u32x4 w; w.x = pk2(sg * a[0], sg * a[1]); w.y = pk2(sg * a[2], sg * a[3]); w.z = pk2(sg * bq[0], sg * bq[1]); w.w = pk2(sg * bq[2], sg * bq[3]);
                cf[kk] = __builtin_bit_cast(bf16x8, w);
            }
        }
        const float dcoef = P.in[I_S5_D][g * 16 + (lane & 15)];
        float h_re = 0.f, h_im = 0.f;
        const bf16_t* ub = proj + (size_t)b * SEQ * AB_IN + 3 * DIFF_W + g * 16;
        u32x4 uan = *(const u32x4*)(ub + (size_t)(lane & 15) * AB_IN + 8 * ((lane >> 4) & 1));
        u32x2 uvn = *(const u32x2*)(ub + (size_t)(lane >> 2) * AB_IN + (lane & 3) * 4);
        for (int s0 = 0; s0 < SEQ; s0 += 16) {
            const bf16x8 ua = __builtin_bit_cast(bf16x8, (lane >> 5) ? (u32x4){0u, 0u, 0u, 0u} : uan);
            {
                const int st = lane >> 2, pp = (lane & 3) * 4;
                const u32x2 uv = uvn;
                const int sn = (s0 + 16 < SEQ) ? s0 + 16 : s0;
                uan = *(const u32x4*)(ub + (size_t)(sn + (lane & 15)) * AB_IN + 8 * ((lane >> 4) & 1));
                uvn = *(const u32x2*)(ub + (size_t)(sn + st) * AB_IN + pp);
                *(LAS f32x4*)(U + st * 16 + pp) = (f32x4){bflo(uv.x), bfhi(uv.x), bflo(uv.y), bfhi(uv.y)};
            }
            __builtin_amdgcn_sched_barrier(0);
            f32x4 dj[8];
#pragma unroll
            for (int j = 0; j < 8; ++j) dj[j] = __builtin_amdgcn_mfma_f32_16x16x32_bf16(ua, bfr[j], (f32x4){0.f, 0.f, 0.f, 0.f}, 0, 0, 0);
            __builtin_amdgcn_sched_barrier(0);
            asm volatile("s_nop 7\n\ts_nop 7\n\ts_nop 7" ::: "memory");
            __builtin_amdgcn_sched_barrier(0);
#pragma unroll
            for (int j = 0; j < 8; ++j) *(LAS f32x4*)(BU + (16 * j + (lane & 15)) * 20 + 4 * (lane >> 4)) = dj[j];
            LDS_WAIT(); asm volatile("" ::: "memory");
            float bre[16], bim[16];
#pragma unroll
            for (int q = 0; q < 4; ++q) { const f32x4 x = *(const LAS f32x4*)(BU + n * 20 + 4 * q), y = *(const LAS f32x4*)(BU + (64 + n) * 20 + 4 * q);
#pragma unroll
                for (int i = 0; i < 4; ++i) { bre[4 * q + i] = x[i]; bim[4 * q + i] = y[i]; } }
#pragma unroll
            for (int st = 0; st < 16; ++st) {
                const float nr = fmaf(ab_re, h_re, fmaf(-ab_im, h_im, bre[st])), ni = fmaf(ab_re, h_im, fmaf(ab_im, h_re, bim[st]));
                h_re = nr; h_im = ni;
                H[st * 136 + n] = f2bf(h_re); H[st * 136 + 64 + n] = f2bf(h_im);
            }
            LDS_WAIT(); asm volatile("" ::: "memory");
            f32x4 acc = {0.f, 0.f, 0.f, 0.f};
#pragma unroll
            for (int kk = 0; kk < 4; ++kk) {
                const bf16x8 af = *(const LAS bf16x8*)((LAS unsigned char*)H + (lane & 15) * 272 + (32 * kk + 8 * (lane >> 4)) * 2);
                acc = __builtin_amdgcn_mfma_f32_16x16x32_bf16(af, cf[kk], acc, 0, 0, 0);
            }
            __builtin_amdgcn_sched_barrier(0);
            asm volatile("s_nop 7\n\ts_nop 7\n\ts_nop 7" : "+v"(acc) :: "memory");
            __builtin_amdgcn_sched_barrier(0);
#pragma unroll
            for (int r = 0; r < 4; ++r) {
                const int st = (lane >> 4) * 4 + r, p = lane & 15;
                const float y = acc[r] + dcoef * U[st * 16 + p];
                gbuf[(size_t)(b * SEQ + s0 + st) * S5_W + g * 16 + p] = f2bf(gelu_erf(y));
            }
            LDS_WAIT(); asm volatile("" ::: "memory");
        }
    }
}

struct AttnArgs { const bf16_t* Qn; const bf16_t* Qr; const bf16_t* Kn; const bf16_t* Kr; const bf16_t* V; int ldq, ldkn, ldkr, ldv; };
DI int crow(int r, int hi) { return (r & 3) + 8 * (r >> 2) + 4 * hi; }
template <int DK> DI int koff(int row, int ch) { return DK == 64 ? row * 128 + 16 * (ch ^ ((row >> 1) & 7)) : row * 256 + 16 * (ch ^ (row & 15)); }
DI int voff(int row, int ch) { return 256 * row + 16 * (ch ^ (((row & 3) << 2) | ((row >> 2) & 3))); }
DI bf16x8 pack8(const f32x16& p, int s) {
    u32x4 w; w.x = pk2(p[8 * s + 0], p[8 * s + 1]); w.y = pk2(p[8 * s + 2], p[8 * s + 3]); w.z = pk2(p[8 * s + 4], p[8 * s + 5]); w.w = pk2(p[8 * s + 6], p[8 * s + 7]);
    return __builtin_bit_cast(bf16x8, w);
}
DI s16x4 vtr(const LAS unsigned char* p) { return __builtin_bit_cast(s16x4, __builtin_amdgcn_ds_read_tr16_b64_v4i16((LAS s16x4*)p)); }

template <int DKN, int DKR>
DI void attn_core(const AttnArgs& a, int q0, LAS unsigned char* lds, float scale, f32x16 (&o)[4], int mode = 0) {
    const int tid = opaque_tid(), wid = __builtin_amdgcn_readfirstlane(tid >> 6), lane = tid & 63, r32 = lane & 31, hi = lane >> 5;
    constexpr int CN = DKN / 8, NLK = CN * 64 / NTHREADS, KNB = 64 * DKN * 2, KRB = 64 * DKR * 2, KSZ = KNB + KRB, VBASE = 2 * KSZ, VSZ = 16384;
    constexpr int KG = DKR ? 2 : 4;
    static_assert(VBASE + 3 * VSZ <= RING_BYTES, "attention LDS");
    const bool late = wid >= 4;
    bf16x8 qn[DKN / 16]; bf16x8 qr[DKR ? DKR / 16 : 1];
    {
        const bf16_t* qp = a.Qn + (size_t)(q0 + 32 * wid + r32) * a.ldq + hi * 8;
#pragma unroll
        for (int d0 = 0; d0 < DKN / 16; ++d0) qn[d0] = *(const bf16x8*)(qp + d0 * 16);
        if (DKR) { const bf16_t* qp2 = a.Qr + (size_t)(q0 + 32 * wid + r32) * a.ldq + hi * 8;
#pragma unroll
            for (int d0 = 0; d0 < DKR / 16; ++d0) qr[d0] = *(const bf16x8*)(qp2 + d0 * 16); }
    }
    const int NT = (q0 + 256) / 64, NTw = (q0 + 32 * wid + 31) / 64 + 1;
    u32x4 skn[NLK], skr, sv[2];
#define AT_LOAD(t) do { _Pragma("unroll") for (int i_ = 0; i_ < NLK; ++i_) { const int id_ = tid + NTHREADS * i_, row_ = id_ / CN, ch_ = id_ % CN; \
            skn[i_] = *(const u32x4*)(a.Kn + (size_t)((t) * 64 + row_) * a.ldkn + ch_ * 8); } \
        if (DKR) { const int row_ = tid >> 3, ch_ = tid & 7; skr = *(const u32x4*)(a.Kr + (size_t)((t) * 64 + row_) * a.ldkr + ch_ * 8); } \
        _Pragma("unroll") for (int i_ = 0; i_ < 2; ++i_) { const int id_ = tid + NTHREADS * i_, row_ = id_ >> 4, ch_ = id_ & 15; \
            sv[i_] = *(const u32x4*)(a.V + (size_t)((t) * 64 + row_) * a.ldv + ch_ * 8); } } while (0)
#define AT_WRITE(kbuf, vbuf) do { LAS unsigned char* kb_ = lds + (kbuf) * KSZ; LAS unsigned char* vb_ = lds + VBASE + (vbuf) * VSZ; \
        _Pragma("unroll") for (int i_ = 0; i_ < NLK; ++i_) { const int id_ = tid + NTHREADS * i_, row_ = id_ / CN, ch_ = id_ % CN; *(LAS u32x4*)(kb_ + koff<DKN>(row_, ch_)) = skn[i_]; } \
        if (DKR) { const int row_ = tid >> 3, ch_ = tid & 7; *(LAS u32x4*)(kb_ + KNB + koff<64>(row_, ch_)) = skr; } \
        _Pragma("unroll") for (int i_ = 0; i_ < 2; ++i_) { const int id_ = tid + NTHREADS * i_, row_ = id_ >> 4, ch_ = id_ & 15; *(LAS u32x4*)(vb_ + voff(row_, ch_)) = sv[i_]; } } while (0)
    const float Cs = scale * 1.4426950408889634f, thr = 8.0f / Cs;
    float m_run = -1e30f, l_run = 0.f;
#pragma unroll
    for (int blk = 0; blk < 4; ++blk)
#pragma unroll
        for (int r = 0; r < 16; ++r) o[blk][r] = 0.f;
    bf16x8 pb[4];
#pragma unroll
    for (int i = 0; i < 4; ++i) pb[i] = (bf16x8){0, 0, 0, 0, 0, 0, 0, 0};
#define AT_PV(vbuf) do { const LAS unsigned char* vbase_ = lds + VBASE + (vbuf) * VSZ; \
        int lanev_ = lane; if (DKR) asm volatile("" : "+v"(lanev_));       \
        int vb_[4][2]; { const int i_ = lanev_ & 15, q_ = i_ >> 2, p_ = i_ & 3, grp1_ = (lanev_ >> 4) & 1, hv_ = lanev_ >> 5, low2_ = 2 * grp1_ + (p_ >> 1); \
            _Pragma("unroll") for (int blk = 0; blk < 4; ++blk) _Pragma("unroll") for (int x = 0; x < 2; ++x) vb_[blk][x] = 256 * (8 * x + 4 * hv_ + q_) + 16 * (4 * (blk ^ q_) + (low2_ ^ (hv_ + 2 * x))) + 8 * (p_ & 1); } \
        s16x4 lo_[2][4], hh_[2][4]; \
        _Pragma("unroll") for (int ks = 0; ks < 4; ++ks) { lo_[0][ks] = vtr(vbase_ + vb_[0][0] + 4096 * ks); hh_[0][ks] = vtr(vbase_ + vb_[0][1] + 4096 * ks); } \
        _Pragma("unroll") for (int blk = 0; blk < 4; ++blk) { \
            if (blk + 1 < 4) { _Pragma("unroll") for (int ks = 0; ks < 4; ++ks) { lo_[(blk + 1) & 1][ks] = vtr(vbase_ + vb_[blk + 1][0] + 4096 * ks); hh_[(blk + 1) & 1][ks] = vtr(vbase_ + vb_[blk + 1][1] + 4096 * ks); } } \
            _Pragma("unroll") for (int ks = 0; ks < 4; ++ks) { const s16x4 l_ = lo_[blk & 1][ks], h_ = hh_[blk & 1][ks]; \
                const bf16x8 af_ = {l_[0], l_[1], l_[2], l_[3], h_[0], h_[1], h_[2], h_[3]}; \
                o[blk] = __builtin_amdgcn_mfma_f32_32x32x16_bf16(af_, pb[ks], o[blk], 0, 0, 0); } \
            __builtin_amdgcn_sched_barrier(0); } } while (0)
    AT_LOAD(0); AT_WRITE(0, 0);
#pragma unroll
    for (int d0 = 0; d0 < DKN / 16; ++d0) asm volatile("" : "+v"(qn[d0]));
    if (DKR) {
#pragma unroll
        for (int d0 = 0; d0 < DKR / 16; ++d0) asm volatile("" : "+v"(qr[d0]));
    }
    if (NT > 1) AT_LOAD(1);
    int vcur = 0, vprev = 2, vnext = 1;
    for (int t = 0; t < NT; ++t) {
        if (mode != 5) __syncthreads();
        if (t + 1 < NT && mode != 2) AT_WRITE((t + 1) & 1, vnext);
        if (t + 2 < NT && mode != 1) AT_LOAD(t + 2);
        if (late && t >= 1 && t - 1 < NTw && mode != 3) AT_PV(vprev);
        if (t < NTw) {
            const LAS unsigned char* base = lds + (t & 1) * KSZ;
            int r32v = r32; if (DKR) asm volatile("" : "+v"(r32v));
            f32x16 p0, p1;
#pragma unroll
            for (int r = 0; r < 16; ++r) { p0[r] = 0.f; p1[r] = 0.f; }
            {
                constexpr int NDN = DKN / 16, NDT = NDN + DKR / 16;
#pragma unroll
                for (int g0 = 0; g0 < NDT; g0 += KG) {
                    bf16x8 kb0[KG], kb1[KG];
#pragma unroll
                    for (int i = 0; i < KG; ++i) { const int dd = g0 + i;
                        if (dd < NDN) { kb0[i] = *(const LAS bf16x8*)(base + koff<DKN>(r32v, 2 * dd + hi)); kb1[i] = *(const LAS bf16x8*)(base + koff<DKN>(32 + r32v, 2 * dd + hi)); }
                        else { kb0[i] = *(const LAS bf16x8*)(base + KNB + koff<64>(r32v, 2 * (dd - NDN) + hi)); kb1[i] = *(const LAS bf16x8*)(base + KNB + koff<64>(32 + r32v, 2 * (dd - NDN) + hi)); } }
#pragma unroll
                    for (int i = 0; i < KG; ++i) asm volatile("" : "+v"(kb0[i]), "+v"(kb1[i]));
#pragma unroll
                    for (int i = 0; i < KG; ++i) { const int dd = g0 + i;
                        const bf16x8 qf = dd < NDN ? qn[dd < NDN ? dd : 0] : qr[dd >= NDN ? dd - NDN : 0];
                        p0 = __builtin_amdgcn_mfma_f32_32x32x16_bf16(kb0[i], qf, p0, 0, 0, 0); p1 = __builtin_amdgcn_mfma_f32_32x32x16_bf16(kb1[i], qf, p1, 0, 0, 0); }
                }
            }
            if (t == NTw - 1) {
                const int qrel = q0 + 32 * wid + r32 - 64 * t;
#pragma unroll
                for (int r = 0; r < 16; ++r) { const int kv = crow(r, hi); if (kv > qrel) p0[r] = -INFINITY; if (kv + 32 > qrel) p1[r] = -INFINITY; }
            }
            float pmax = p0[0];
#pragma unroll
            for (int r = 1; r < 16; ++r) pmax = fmaxf(pmax, p0[r]);
#pragma unroll
            for (int r = 0; r < 16; ++r) pmax = fmaxf(pmax, p1[r]);
            pmax = swap32_max(pmax);
            if (__any(pmax > m_run + thr)) {
                const float mn = fmaxf(m_run, pmax);
                const float alpha = __builtin_amdgcn_exp2f((m_run - mn) * Cs);
                m_run = mn; l_run *= alpha;
#pragma unroll
                for (int blk = 0; blk < 4; ++blk)
#pragma unroll
                    for (int r = 0; r < 16; ++r) o[blk][r] *= alpha;
            }
            const float mnC = -m_run * Cs;
            float ps = 0.f;
#pragma unroll
            for (int r = 0; r < 16; ++r) { if (mode != 4) { p0[r] = __builtin_amdgcn_exp2f(fmaf(p0[r], Cs, mnC)); p1[r] = __builtin_amdgcn_exp2f(fmaf(p1[r], Cs, mnC)); } ps += p0[r] + p1[r]; }
            l_run += ps;
            pb[0] = pack8(p0, 0); pb[1] = pack8(p0, 1); pb[2] = pack8(p1, 0); pb[3] = pack8(p1, 1);
            if (!late && mode != 3) AT_PV(vcur);
        }
        { const int tmp = vprev; vprev = vcur; vcur = vnext; vnext = tmp; }
    }
    if (late && NTw == NT && mode != 3) AT_PV(vprev);
    __syncthreads();
    const float linv = 1.0f / swap32_sum(l_run);
#pragma unroll
    for (int blk = 0; blk < 4; ++blk)
#pragma unroll
        for (int r = 0; r < 16; ++r) o[blk][r] *= linv;
#undef AT_LOAD
#undef AT_WRITE
#undef AT_PV
}
DI void attn_store(const f32x16 (&o)[4], bf16_t* dst, int ld, int q0) {
    const int tid = opaque_tid(), wid = tid >> 6, lane = tid & 63, r32 = lane & 31, hi = lane >> 5;
    bf16_t* rp = dst + (size_t)(q0 + 32 * wid + r32) * ld;
#pragma unroll
    for (int blk = 0; blk < 4; ++blk)
#pragma unroll
        for (int g = 0; g < 4; ++g) {
            u32x2 w; w.x = pk2(o[blk][4 * g], o[blk][4 * g + 1]); w.y = pk2(o[blk][4 * g + 2], o[blk][4 * g + 3]);
            *(u32x2*)(rp + 32 * blk + 8 * g + 4 * hi) = w;
        }
}
DI int queue_pop(const Ctx& C0, unsigned* ctr, int total) {
    const Ctx C = fresh(C0);
    volatile LAS int* slot = (volatile LAS int*)(C.lds + LDSCTL_OFF + 64);
    __syncthreads();
    if (C.tid == 0) *slot = (int)__hip_atomic_fetch_add(ctr, 1u, __ATOMIC_RELAXED, __HIP_MEMORY_SCOPE_AGENT);
    __syncthreads();
    const int u = *slot;
    return u < total ? u : -1;
}
DI float diff_lambda(const Params& P) {
    float s1 = 0.f, s2 = 0.f;
    for (int i = 0; i < 64; ++i) { s1 += P.in[I_LQ1][i] * P.in[I_LK1][i]; s2 += P.in[I_LQ2][i] * P.in[I_LK2][i]; }
    return expf(s1) - expf(s2) + 0.2f;
}

#if FAST_ATTN
DI void phase_diff_attn(const Ctx& C0, const Params& P, int qi) {
    const Ctx C = fresh(C0);
    unsigned char* ws = P.ws;
    const bf16_t* proj = (const bf16_t*)(ws + P_PROJ); bf16_t* concat = (bf16_t*)(ws + P_CONCAT);
    unsigned* ctr = (unsigned*)(ws + WS_CTL) + CW_CTR + 64 * qi;
    const float lam = diff_lambda(P);
    const int NBH = BATCH * DIFF_HEADS, NS5 = BATCH * 32 / NWAVES, total = NS5 + NBH * 8;
    const int lane = C.lane, r32 = lane & 31, hi = lane >> 5;
    for (;;) {
        int u = queue_pop(C, ctr, total); if (u < 0) break;
        if (u < NS5) { phase_s5(C, P, u * NWAVES, u * NWAVES + NWAVES, 1, NWAVES); continue; }
        u -= NS5;
        const int qb = 7 - u / NBH, bh = u % NBH, b = bh / DIFF_HEADS, h = bh % DIFF_HEADS;
        const bf16_t* base = proj + (size_t)b * SEQ * AB_IN;
        AttnArgs a; a.ldq = AB_IN; a.ldkn = AB_IN; a.ldkr = 0; a.ldv = AB_IN; a.Qr = nullptr; a.Kr = nullptr;
        a.V = base + 2 * DIFF_W + h * 128;
        f32x16 o2[4];
        bf16_t* dst = concat + (size_t)b * SEQ * DM + h * 128;
        a.Qn = base + h * 128; a.Kn = base + DIFF_W + h * 128;
        attn_core<64, 0>(a, qb * 256, C.lds, 0.125f, o2, qi >= 2 ? PROBE_ATTN_MODE : 0);
        attn_store(o2, dst, DM, qb * 256);
        a.Qn = base + h * 128 + 64; a.Kn = base + DIFF_W + h * 128 + 64;
        attn_core<64, 0>(a, qb * 256, C.lds, 0.125f, o2, qi >= 2 ? PROBE_ATTN_MODE : 0);
        float ss = 0.f;
        {
            const bf16_t* rp = dst + (size_t)(qb * 256 + 32 * C.wave + r32) * DM;
#pragma unroll
            for (int blk = 0; blk < 4; ++blk)
#pragma unroll
                for (int g = 0; g < 4; ++g) {
                    const u32x2 w = *(const u32x2*)(rp + 32 * blk + 8 * g + 4 * hi);
                    const float o1v[4] = {bflo(w.x), bfhi(w.x), bflo(w.y), bfhi(w.y)};
#pragma unroll
                    for (int j = 0; j < 4; ++j) { const float v = o1v[j] - lam * o2[blk][4 * g + j]; o2[blk][4 * g + j] = v; ss += v * v; }
                }
        }
        ss = swap32_sum(ss);
        const float rs = rsqrtf(ss * (1.0f / 128.0f) + NORM_EPS) * 0.8f;
        const float* sub = P.in[I_SUBLN];
#pragma unroll
        for (int blk = 0; blk < 4; ++blk)
#pragma unroll
            for (int r = 0; r < 16; ++r) o2[blk][r] *= rs * sub[32 * blk + crow(r, hi)];
        attn_store(o2, dst, DM, qb * 256);
    }
}
DI void phase_mla_attn(const Ctx& C0, const Params& P, int qi) {
    const Ctx C = fresh(C0);
    unsigned char* ws = P.ws;
    const bf16_t* q = (const bf16_t*)(ws + P_Q); const bf16_t* kv = (const bf16_t*)(ws + P_KV); const bf16_t* kr = (const bf16_t*)(ws + P_KROPE);
    bf16_t* ob = (bf16_t*)(ws + P_H);
    unsigned* ctr = (unsigned*)(ws + WS_CTL) + CW_CTR + 64 * qi;
    const int NBH = BATCH * MLA_HEADS, total = NBH * 8;
    for (;;) {
        const int u = queue_pop(C, ctr, total); if (u < 0) break;
        const int qb = 7 - u / NBH, bh = u % NBH, b = bh / MLA_HEADS, h = bh % MLA_HEADS;
        AttnArgs a; a.ldq = 3072; a.ldkn = 4096; a.ldkr = 64; a.ldv = 4096;
        a.Qn = q + (size_t)b * SEQ * 3072 + h * 192; a.Qr = a.Qn + 128;
        a.Kn = kv + (size_t)b * SEQ * 4096 + h * 256; a.V = a.Kn + 128; a.Kr = kr + (size_t)b * SEQ * 64;
        f32x16 o[4];
        attn_core<128, 64>(a, qb * 256, C.lds, 0.07216878364870322f, o, qi >= 2 ? PROBE_ATTN_MODE : 0);
        attn_store(o, ob + (size_t)b * SEQ * DM + h * 128, DM, qb * 256);
    }
}
#else
template <int DK> DI void naive_attn_row(const bf16_t* qrow, const bf16_t* qrow2, const bf16_t* Kn, int ldkn, const bf16_t* Kr, int ldkr, const bf16_t* V, int ldv, int nkeys, float scale, int lane, float& o0, float& o1) {
    float qv[3];
#pragma unroll
    for (int j = 0; j < 3; ++j) { const int d = lane + 64 * j; qv[j] = 0.f; if (d < DK) qv[j] = (DK == 192 && d >= 128) ? bf2f(qrow2[d - 128]) : bf2f(qrow[d]); }
    float m = -1e30f, l = 0.f; o0 = 0.f; o1 = 0.f;
    for (int k = 0; k < nkeys; ++k) {
        float s = 0.f;
#pragma unroll
        for (int j = 0; j < 3; ++j) { const int d = lane + 64 * j; if (d < DK) { const float kvv = (DK == 192 && d >= 128) ? bf2f(Kr[(size_t)k * ldkr + d - 128]) : bf2f(Kn[(size_t)k * ldkn + d]); s += qv[j] * kvv; } }
        s = wave_sum(s) * scale;
        const float mn = fmaxf(m, s), al = expf(m - mn), p = expf(s - mn);
        m = mn; l = l * al + p;
        o0 = o0 * al + p * bf2f(V[(size_t)k * ldv + lane]); o1 = o1 * al + p * bf2f(V[(size_t)k * ldv + 64 + lane]);
    }
    o0 /= l; o1 /= l;
}
DI void phase_diff_attn(const Ctx& C, const Params& P, int) {
    unsigned char* ws = P.ws;
    const bf16_t* proj = (const bf16_t*)(ws + P_PROJ); bf16_t* concat = (bf16_t*)(ws + P_CONCAT);
    const float lam = diff_lambda(P);
    const int lane = C.lane;
    for (int it = C.blk * NWAVES + C.wave; it < BATCH * DIFF_HEADS * SEQ; it += C.G * NWAVES) {
        const int s = it % SEQ, bh = it / SEQ, b = bh / DIFF_HEADS, h = bh % DIFF_HEADS;
        const bf16_t* base = proj + (size_t)b * SEQ * AB_IN;
        const bf16_t* qrow = base + (size_t)s * AB_IN + h * 128;
        float a0, a1, b0, b1;
        naive_attn_row<64>(qrow, nullptr, base + DIFF_W + h * 128, AB_IN, nullptr, 0, base + 2 * DIFF_W + h * 128, AB_IN, s + 1, 0.125f, lane, a0, a1);
        naive_attn_row<64>(qrow + 64, nullptr, base + DIFF_W + h * 128 + 64, AB_IN, nullptr, 0, base + 2 * DIFF_W + h * 128, AB_IN, s + 1, 0.125f, lane, b0, b1);
        const float v0 = a0 - lam * b0, v1 = a1 - lam * b1;
        const float ss = wave_sum(v0 * v0 + v1 * v1);
        const float rs = rsqrtf(ss * (1.0f / 128.0f) + NORM_EPS) * 0.8f;
        bf16_t* orow = concat + (size_t)(b * SEQ + s) * DM + h * 128;
        orow[lane] = f2bf(v0 * rs * P.in[I_SUBLN][lane]); orow[64 + lane] = f2bf(v1 * rs * P.in[I_SUBLN][64 + lane]);
    }
}
DI void phase_mla_attn(const Ctx& C, const Params& P, int) {
    unsigned char* ws = P.ws;
    const bf16_t* q = (const bf16_t*)(ws + P_Q); const bf16_t* kv = (const bf16_t*)(ws + P_KV); const bf16_t* kr = (const bf16_t*)(ws + P_KROPE);
    bf16_t* ob = (bf16_t*)(ws + P_H);
    const int lane = C.lane;
    for (int it = C.blk * NWAVES + C.wave; it < BATCH * MLA_HEADS * SEQ; it += C.G * NWAVES) {
        const int s = it % SEQ, bh = it / SEQ, b = bh / MLA_HEADS, h = bh % MLA_HEADS;
        const bf16_t* qrow = q + (size_t)(b * SEQ + s) * 3072 + h * 192;
        const bf16_t* kn = kv + (size_t)b * SEQ * 4096 + h * 256;
        float a0, a1;
        naive_attn_row<192>(qrow, qrow + 128, kn, 4096, kr + (size_t)b * SEQ * 64, 64, kn + 128, 4096, s + 1, 0.07216878364870322f, lane, a0, a1);
        bf16_t* orow = ob + (size_t)(b * SEQ + s) * DM + h * 128;
        orow[lane] = f2bf(a0); orow[64 + lane] = f2bf(a1);
    }
}
#endif

DI void phase_mla_rows(const Ctx& C0, const Params& P) {
    const Ctx C = fresh(C0);
    unsigned char* ws = P.ws;
    const bf16_t* mp = (const bf16_t*)(ws + P_MLAPROJ); bf16_t* cqn = (bf16_t*)(ws + P_CQN); bf16_t* ckvn = (bf16_t*)(ws + P_CKVN); bf16_t* krp = (bf16_t*)(ws + P_KROPE);
    const f32x2* tab = (const f32x2*)(ws + WS_ROPE);
    const int lane = C.lane;
    const int r0 = C.blk * NWAVES + C.wave, rstep = C.G * NWAVES;
    if (r0 >= T) return;
    const int* posp = (const int*)P.in[I_POS];
    u32x2 nw[3], nwkv; unsigned nwr; float nssv; f32x2 ncs; int npos;
#define MR_LOAD(R) do { const bf16_t* row_ = mp + (size_t)(R) * MLA_IN_PAD; \
        _Pragma("unroll") for (int j = 0; j < 3; ++j) nw[j] = *(const u32x2*)(row_ + 4 * (lane + 64 * j)); \
        nwkv = *(const u32x2*)(row_ + MLA_QR + 4 * lane); nwr = *(const unsigned*)(row_ + 1024 + 2 * (lane & 31)); nssv = ((const float*)(ws + P_SS))[(size_t)(R) * 32 + (lane & 7)]; } while (0)
#define MR_CLAMP(p_) ((p_) < 0 ? 0 : ((p_) > ROPE_POS - 1 ? ROPE_POS - 1 : (p_)))
    MR_LOAD(r0);
    { const int p0 = posp[r0]; ncs = tab[(size_t)MR_CLAMP(p0) * 32 + (lane & 31)]; }
    npos = posp[(r0 + rstep < T) ? r0 + rstep : r0];
    for (int r = r0; r < T; r += rstep) {
        u32x2 cw[3], cwkv; unsigned cwr; float cssv; f32x2 cs;
#pragma unroll
        for (int j = 0; j < 3; ++j) cw[j] = nw[j];
        cwkv = nwkv; cwr = nwr; cssv = nssv; cs = ncs;
        {
            const int rn = (r + rstep < T) ? r + rstep : r, rnn = (rn + rstep < T) ? rn + rstep : rn;
            MR_LOAD(rn);
            ncs = tab[(size_t)MR_CLAMP(npos) * 32 + (lane & 31)];
            npos = posp[rnn];
        }
        const float rs = rsqrtf(wave_sum((lane < 8) ? cssv : 0.f) * (1.0f / DM) + NORM_EPS);
        const float eps_raw = NORM_EPS / (rs * rs);
        float v[12]; float ss = 0.f;
#pragma unroll
        for (int j = 0; j < 3; ++j) { const u32x2 w = cw[j]; v[4 * j] = bflo(w.x); v[4 * j + 1] = bfhi(w.x); v[4 * j + 2] = bflo(w.y); v[4 * j + 3] = bfhi(w.y); }
#pragma unroll
        for (int j = 0; j < 12; ++j) ss += v[j] * v[j];
        float sc = rsqrtf(wave_sum(ss) * (1.0f / MLA_QR) + eps_raw);
#pragma unroll
        for (int j = 0; j < 3; ++j) { const f32x4 g = *(const f32x4*)(P.in[I_MLA_QNORM] + 4 * (lane + 64 * j));
            u32x2 w; w.x = pk2(v[4 * j] * sc * g[0], v[4 * j + 1] * sc * g[1]); w.y = pk2(v[4 * j + 2] * sc * g[2], v[4 * j + 3] * sc * g[3]);
            *(u32x2*)(cqn + (size_t)r * MLA_QR + 4 * (lane + 64 * j)) = w; }
        {
            const u32x2 w = cwkv;
            const float a0 = bflo(w.x), a1 = bfhi(w.x), a2 = bflo(w.y), a3 = bfhi(w.y);
            const float s2 = rsqrtf(wave_sum(a0 * a0 + a1 * a1 + a2 * a2 + a3 * a3) * (1.0f / MLA_KVR) + eps_raw);
            const f32x4 g = *(const f32x4*)(P.in[I_MLA_KVNORM] + 4 * lane);
            u32x2 o; o.x = pk2(a0 * s2 * g[0], a1 * s2 * g[1]); o.y = pk2(a2 * s2 * g[2], a3 * s2 * g[3]);
            *(u32x2*)(ckvn + (size_t)r * MLA_KVR + 4 * lane) = o;
        }
        if (lane < 32) {
            const float x1 = bflo(cwr) * rs, x2 = bfhi(cwr) * rs;
            *(unsigned*)(krp + (size_t)r * 64 + 2 * lane) = pk2(x1 * cs[0] - x2 * cs[1], x2 * cs[0] + x1 * cs[1]);
        }
    }
#undef MR_LOAD
#undef MR_CLAMP
}

DI void phase_xa_softmax(const Ctx& C0, const Params& P) {
    const Ctx C = fresh(C0);
    unsigned char* ws = P.ws;
    const bf16_t* S = (const bf16_t*)(ws + P_S); bf16_t* Pb = (bf16_t*)(ws + P_P);
    const int lane = C.lane, hd = lane >> 4, li = lane & 15;
    const int r0 = C.blk * NWAVES + C.wave, rstep = C.G * NWAVES;
    if (r0 >= T) return;
    u32x2 nw[4]; float nssv;
#define XS_LOAD(R) do { const bf16_t* row_ = S + (size_t)(R) * 1024 + hd * 256; _Pragma("unroll") for (int j = 0; j < 4; ++j) nw[j] = *(const u32x2*)(row_ + 4 * (li + 16 * j)); \
        nssv = ((const float*)(ws + P_SS))[(size_t)(R) * 32 + (lane & 31)]; } while (0)
    XS_LOAD(r0);
    for (int r = r0; r < T; r += rstep) {
        u32x2 cw[4];
#pragma unroll
        for (int j = 0; j < 4; ++j) cw[j] = nw[j];
        const float cssv = nssv;
        { const int rn = (r + rstep < T) ? r + rstep : r; XS_LOAD(rn); }
        const float rs = rsqrtf(wave_sum((lane < 32) ? cssv : 0.f) * (1.0f / DM) + NORM_EPS);
        f32x4 v[4]; float mx = -1e30f;
#pragma unroll
        for (int j = 0; j < 4; ++j) { const u32x2 w = cw[j]; v[j] = (f32x4){bflo(w.x), bfhi(w.x), bflo(w.y), bfhi(w.y)} * rs; mx = fmaxf(mx, fmaxf(fmaxf(v[j][0], v[j][1]), fmaxf(v[j][2], v[j][3]))); }
        mx = row16_max(mx);
        float sm = 0.f;
#pragma unroll
        for (int j = 0; j < 4; ++j) { v[j][0] = __expf(v[j][0] - mx); v[j][1] = __expf(v[j][1] - mx); v[j][2] = __expf(v[j][2] - mx); v[j][3] = __expf(v[j][3] - mx); sm += (v[j][0] + v[j][1]) + (v[j][2] + v[j][3]); }
        sm = row16_sum(sm);
        const float inv = 1.0f / sm;
        bf16_t* orow = Pb + (size_t)r * 1024 + hd * 256;
#pragma unroll
        for (int j = 0; j < 4; ++j) { u32x2 w; w.x = pk2(v[j][0] * inv, v[j][1] * inv); w.y = pk2(v[j][2] * inv, v[j][3] * inv); *(u32x2*)(orow + 4 * (li + 16 * j)) = w; }
    }
#undef XS_LOAD
}

template <int N> DI void bitonic_sort_desc(unsigned (&v)[N]) {
#pragma unroll
    for (int k = 2; k <= N; k <<= 1)
#pragma unroll
        for (int j = k >> 1; j > 0; j >>= 1)
#pragma unroll
            for (int i = 0; i < N; ++i) { const int l = i ^ j;
                if (l > i) { const bool desc = ((i & k) == 0); const unsigned a = v[i], b = v[l], mx = a > b ? a : b, mn = a > b ? b : a; v[i] = desc ? mx : mn; v[l] = desc ? mn : mx; } }
}
template <int N> DI void oem_sort_desc(unsigned (&v)[N]) {
#pragma unroll
    for (int p = 1; p < N; p <<= 1)
#pragma unroll
        for (int k = p; k >= 1; k >>= 1)
#pragma unroll
            for (int j = k % p; j <= N - 1 - k; j += 2 * k)
#pragma unroll
                for (int i = 0; i < k; ++i)
                    if (i + j + k < N && (i + j) / (2 * p) == (i + j + k) / (2 * p)) { const unsigned a = v[i + j], b = v[i + j + k]; v[i + j] = a > b ? a : b; v[i + j + k] = a > b ? b : a; }
}
DI void top16_of_32(const unsigned (&k)[32], unsigned (&t)[16]) {
    unsigned a[16], b[16];
#pragma unroll
    for (int i = 0; i < 16; ++i) { a[i] = k[i]; b[i] = k[16 + i]; }
    oem_sort_desc<16>(a); oem_sort_desc<16>(b);
#pragma unroll
    for (int i = 0; i < 16; ++i) t[i] = a[i] > b[15 - i] ? a[i] : b[15 - i];
#pragma unroll
    for (int j = 8; j > 0; j >>= 1)
#pragma unroll
        for (int i = 0; i < 16; ++i) { const int l = i ^ j; if (l > i) { const unsigned x = t[i], y = t[l]; t[i] = x > y ? x : y; t[l] = x > y ? y : x; } }
}
template <int D> DI void merge_top16(unsigned (&t)[16]) {
    static_assert(D == 1 || D == 2, "quad-local exchange");
    unsigned c[16];
#pragma unroll
    for (int i = 0; i < 16; ++i) { const unsigned o = (unsigned)__builtin_amdgcn_update_dpp(0, (int)t[15 - i], D == 1 ? 0xB1 : 0x4E, 0xF, 0xF, true);
        c[i] = t[i] > o ? t[i] : o; }
#pragma unroll
    for (int j = 8; j > 0; j >>= 1)
#pragma unroll
        for (int i = 0; i < 16; ++i) { const int l = i ^ j; if (l > i) { const unsigned a = c[i], b = c[l]; c[i] = a > b ? a : b; c[l] = a > b ? b : a; } }
#pragma unroll
    for (int i = 0; i < 16; ++i) t[i] = c[i];
}
DI void phase_peer_topk(const Ctx& C0, const Params& P) {
    const Ctx C = fresh(C0);
    unsigned char* ws = P.ws;
    const bf16_t* sc = (const bf16_t*)(ws + P_SC); const bf16_t* xbp = (const bf16_t*)(ws + P_XB); const float* ssp = (const float*)(ws + P_SS);
    LAS unsigned char* my = C.lds + C.wave * 4096;
    LAS float* top_s = (LAS float*)my;
    LAS int* top_i = (LAS int*)(my + 1024);
    LAS float* best_s = (LAS float*)(my + 2048);
    LAS int* best_p = (LAS int*)(my + 2560);
    const int lane = C.lane, g = lane >> 2, qd = lane & 3;
    const int stride = C.G * NWAVES;
    int tok = C.blk * NWAVES + C.wave;
    if (tok >= T) return;
    u32x4 scw[4], xw[4]; float ssv;
#define TK_LOAD(TOK) do { const u32x4* sp_ = (const u32x4*)(sc + (size_t)(TOK) * 2048 + g * 128 + qd * 32); const u32x4* xp_ = (const u32x4*)(xbp + (size_t)(TOK) * DM + 32 * lane); \
        _Pragma("unroll") for (int i = 0; i < 4; ++i) { scw[i] = sp_[i]; xw[i] = xp_[i]; } ssv = ssp[(size_t)(TOK) * 32 + (lane & 31)]; } while (0)
    TK_LOAD(tok);
    int s2a[16], s2b[16]; unsigned s2k[16];
    {
        const int h = (lane >> 2) & 7, sub = lane & 3;
#pragma unroll
        for (int c2 = 0; c2 < 16; ++c2) {
            int ci, cj;
            if (sub == 0) { ci = 0; cj = c2; }
            else if (sub == 1) { ci = c2 < 8 ? 1 : c2 < 13 ? 2 : 4; cj = c2 < 8 ? c2 : c2 < 13 ? c2 - 8 : c2 - 13; }
            else if (sub == 2) { ci = c2 < 4 ? 3 : c2 < 10 ? 5 + ((c2 - 4) >> 1) : 8 + (c2 - 10); cj = c2 < 4 ? c2 : c2 < 10 ? ((c2 - 4) & 1) : 0; }
            else { ci = c2 < 2 ? 14 + c2 : -1; cj = 0; }
            s2a[c2] = ci < 0 ? 3072 : 4 * ((2 * h) * 16 + ci); s2b[c2] = ci < 0 ? 3072 : 4 * ((2 * h + 1) * 16 + cj); s2k[c2] = ci < 0 ? 0u : (unsigned)(255 - (16 * ci + cj));
        }
        if (lane == 0) *(LAS float*)(my + 3072) = -INFINITY;
        LDS_WAIT(); asm volatile("" ::: "memory");
    }
    for (; tok < T; tok += stride) {
        unsigned k[32];
#pragma unroll
        for (int j = 0; j < 8; ++j) { const u32x4 w4 = scw[j >> 1]; const unsigned wa = (j & 1) ? w4.z : w4.x, wb = (j & 1) ? w4.w : w4.y; const unsigned bits[4] = {wa << 16, wa & 0xffff0000u, wb << 16, wb & 0xffff0000u};
#pragma unroll
            for (int e = 0; e < 4; ++e) { unsigned u = bits[e]; u ^= (unsigned)((int)u >> 31) | 0x80000000u; k[4 * j + e] = (u & ~127u) | (unsigned)(127 - (32 * qd + 4 * j + e)); } }
        const float rstd = rsqrtf(wave_sum((lane < 32) ? ssv : 0.f) * (1.0f / DM) + NORM_EPS);
        {
            float am = 0.f;
#pragma unroll
            for (int i = 0; i < 4; ++i) { const unsigned w4[4] = {xw[i].x, xw[i].y, xw[i].z, xw[i].w};
#pragma unroll
                for (int q = 0; q < 4; ++q) am = fmaxf(am, fmaxf(fabsf(bflo(w4[q])), fabsf(bfhi(w4[q])))); }
            am = wave_max(am);
            const float tscale = am > 0.f ? 119.0f / am : 0.f;
            if (lane == 0) ((float*)(ws + P_PE_TSC))[tok] = am * (1.0f / 119.0f) * rstd;
            unsigned qd8[8];
#pragma unroll
            for (int i = 0; i < 4; ++i) { const unsigned w4[4] = {xw[i].x, xw[i].y, xw[i].z, xw[i].w};
#pragma unroll
                for (int h2 = 0; h2 < 2; ++h2) qd8[2 * i + h2] = q8x4(bflo(w4[2 * h2]), bfhi(w4[2 * h2]), bflo(w4[2 * h2 + 1]), bfhi(w4[2 * h2 + 1]), tscale); }
            unsigned th4[4], tl4[4];
#pragma unroll
            for (int d = 0; d < 4; ++d) {
                const unsigned A = qd8[2 * d], B = qd8[2 * d + 1];
                const unsigned sa = ((A & 0x7f7f7f7fu) + 0x08080808u) ^ (A & 0x80808080u), sb = ((B & 0x7f7f7f7fu) + 0x08080808u) ^ (B & 0x80808080u);
                tl4[d] = (A & 0x0f0f0f0fu) | ((B & 0x0f0f0f0fu) << 4);
                th4[d] = ((sa >> 4) & 0x0f0f0f0fu) | (sb & 0xf0f0f0f0u);
            }
            u32x4* t8p = (u32x4*)(ws + P_PE_T8 + (size_t)tok * DM + 32 * lane);
            t8p[0] = (u32x4){th4[0], th4[1], th4[2], th4[3]}; t8p[1] = (u32x4){tl4[0], tl4[1], tl4[2], tl4[3]};
        }
        { const int ntok = (tok + stride < T) ? tok + stride : tok; TK_LOAD(ntok); }
        unsigned t16[16];
        top16_of_32(k, t16);
        merge_top16<1>(t16); merge_top16<2>(t16);
#pragma unroll
        for (int i = 0; i < 4; ++i) { const int r = 4 * qd + i;
            unsigned m = t16[0];
#pragma unroll
            for (int rr = 1; rr < 16; ++rr) m = (rr == r) ? t16[rr] : m;
            top_i[g * 16 + r] = 127 - (int)(m & 127u); top_s[g * 16 + r] = __uint_as_float((m & 0x80000000u) ? (m & 0x7fffff80u) : ~(m | 127u)); }
        LDS_WAIT(); asm volatile("" ::: "memory");
        {
            const int h = (lane >> 2) & 7, sub = lane & 3;
            unsigned kk[16];
#pragma unroll
            for (int c2 = 0; c2 < 16; ++c2) {
                unsigned u0 = __float_as_uint(*(const LAS float*)(my + s2a[c2]) + *(const LAS float*)(my + s2b[c2]));
                u0 ^= (unsigned)((int)u0 >> 31) | 0x80000000u;
                kk[c2] = (u0 & ~255u) | s2k[c2]; }
            oem_sort_desc<16>(kk);
            merge_top16<1>(kk); merge_top16<2>(kk);
#pragma unroll
            for (int i = 0; i < 4; ++i) { const int r = 4 * sub + i;
                unsigned m = kk[0];
#pragma unroll
                for (int rr = 1; rr < 16; ++rr) m = (rr == r) ? kk[rr] : m;
                best_p[h * 16 + r] = 255 - (int)(m & 255u); }
        }
        LDS_WAIT(); asm volatile("" ::: "memory");
        int pos2[2];
#pragma unroll
        for (int e2 = 0; e2 < 2; ++e2) { const int idx = lane + 64 * e2, h = idx >> 4; pos2[e2] = best_p[idx]; best_s[idx] = (top_s[(2 * h) * 16 + (pos2[e2] >> 4)] + top_s[(2 * h + 1) * 16 + (pos2[e2] & 15)]) * rstd; }
        LDS_WAIT(); asm volatile("" ::: "memory");
        int* pe = (int*)(ws + P_PE_E) + (size_t)tok * 128; float* pg = (float*)(ws + P_PE_G) + (size_t)tok * 128;
#pragma unroll
        for (int e2 = 0; e2 < 2; ++e2) {
            const int idx = lane + 64 * e2, h = idx >> 4;
            float mx = -1e30f;
#pragma unroll
            for (int kk = 0; kk < 16; ++kk) mx = fmaxf(mx, best_s[h * 16 + kk]);
            float sm = 0.f;
#pragma unroll
            for (int kk = 0; kk < 16; ++kk) sm += __expf(best_s[h * 16 + kk] - mx);
            pg[idx] = __expf(best_s[idx] - mx) / sm;
            const int eid = top_i[(2 * h) * 16 + (pos2[e2] >> 4)] * 128 + top_i[(2 * h + 1) * 16 + (pos2[e2] & 15)];
            pe[idx] = eid; ((unsigned short*)(ws + P_PE_E16))[(size_t)tok * 128 + idx] = (unsigned short)eid;
        }
        LDS_WAIT(); asm volatile("" ::: "memory");
    }
#undef TK_LOAD
}

#if PEER_SLICED
DI int peer_cj(int j) { return ((j >> 3) & 1) | (((j >> 2) & 1) << 1) | (((j >> 1) & 1) << 2); }
constexpr int PEER_CHUNK = 1024, PEER_NCHUNK = T / PEER_CHUNK;
DI int peer_cjh(int half, int jj) { return half | (((jj >> 2) & 1) << 1) | (((jj >> 1) & 1) << 2); }
#define PEER_ISSUE(RW, ELO, EHI, HALF) do { _Pragma("unroll") for (int jj = 0; jj < 8; ++jj) { \
        const int e_ = __shfl((jj & 1) ? (EHI) : (ELO), (lane & ~7) | peer_cjh((HALF), jj)); \
        RW[jj] = *(const u32x4*)(tabs + (size_t)(MODE == 2 ? (e_ & 1) : e_) * 128 + 16 * (lane & 7)); } } while (0)
template <int SIDE  , int MODE = 0  >
DI void phase_peer_sliced(const Ctx& C0, const Params& P, int qbase, bool stats = true  ) {
    const Ctx C = fresh(C0);
    unsigned char* ws = P.ws;
    const bf16_t* hb = (const bf16_t*)(ws + P_H);
    const unsigned char* tab8 = ws + (SIDE == 0 ? P_UT : P_VT);
    const int* pe = (const int*)(ws + P_PE_E); const float* pg = (const float*)(ws + P_PE_G);
    const int lane = C.lane, a = lane >> 3, c = lane & 7;
    const int x = (int)(xb_xcc_id() & 7u);
    for (int i = 0; i < 8; ++i) {
        const int s = (x + i) & 7;
        unsigned* ctr = (unsigned*)(ws + WS_CTL) + CW_CTR + 64 * (qbase + s);
        const unsigned char* tabs = tab8 + (size_t)s * ((size_t)PEER_NE * 128);
        const unsigned coff = 16u * (unsigned)c;
        for (;;) {
            const int ch = queue_pop(C, ctr, PEER_NCHUNK); if (ch < 0) break;
            const int tok0 = ch * PEER_CHUNK + C.wave;
            constexpr int NTOK = PEER_CHUNK / NWAVES;
            if constexpr (SIDE == 0) {
            const unsigned short* e16 = (const unsigned short*)(ws + P_PE_E16);
#define PU_CQ(H, JJ) (((H) << 2) | (((JJ) >> 2) & 1) | ((((JJ) >> 1) & 1) << 1))
#define PU_IDS(I0, I1, TOK) do { I0 = *(const u32x4*)(e16 + (size_t)(TOK) * 128 + 8 * a); I1 = *(const u32x4*)(e16 + (size_t)(TOK) * 128 + 64 + 8 * a); } while (0)
#define PU_DW(I, K) ((K) == 0 ? I.x : (K) == 1 ? I.y : (K) == 2 ? I.z : I.w)
#define PU_EID(I0, I1, H, JJ) ((PU_CQ(H, JJ) & 1) ? (((JJ) & 1) ? PU_DW(I1, PU_CQ(H, JJ) >> 1) : PU_DW(I0, PU_CQ(H, JJ) >> 1)) >> 16 : ((((JJ) & 1) ? PU_DW(I1, PU_CQ(H, JJ) >> 1) : PU_DW(I0, PU_CQ(H, JJ) >> 1)) & 0xffffu))
#define PU_ISSUE(RW, I0, I1, H) do { _Pragma("unroll") for (int jj = 0; jj < 8; ++jj) { const unsigned e_ = PU_EID(I0, I1, H, jj); RW[jj] = *(const u32x4*)(tabs + (size_t)(e_ * 128u + coff)); } } while (0)
#define PU_DOT(RW, H) do { _Pragma("unroll") for (int jj = 0; jj < 8; ++jj) { int sh = 0, sl = 0; \
                        sh = __builtin_amdgcn_sdot8((int)RW[jj].x, (int)ta.x, sh, false); sl = __builtin_amdgcn_sdot8((int)RW[jj].x, (int)tb.x, sl, false); \
                        sh = __builtin_amdgcn_sdot8((int)RW[jj].y, (int)ta.y, sh, false); sl = __builtin_amdgcn_sdot8((int)RW[jj].y, (int)tb.y, sl, false); \
                        sh = __builtin_amdgcn_sdot8((int)RW[jj].z, (int)ta.z, sh, false); sl = __builtin_amdgcn_sdot8((int)RW[jj].z, (int)tb.z, sl, false); \
                        sh = __builtin_amdgcn_sdot8((int)RW[jj].w, (int)ta.w, sh, false); sl = __builtin_amdgcn_sdot8((int)RW[jj].w, (int)tb.w, sl, false); \
                        d[8 * (H) + jj] = (sh << 4) + sl; } } while (0)
#define PU_TLOAD(TA, TB, TOK) do { const u32x4* tp_ = (const u32x4*)(ws + P_PE_T8 + (size_t)(TOK) * DM + s * 256 + 32 * c); TA = tp_[0]; TB = tp_[1]; } while (0)
            u32x4 rwA[8], rwB[8];
            u32x4 i0, i1; PU_IDS(i0, i1, tok0);
            u32x4 ta, tb; PU_TLOAD(ta, tb, tok0);
            PU_ISSUE(rwA, i0, i1, 0);
#pragma unroll 1
            for (int it = 0; it < NTOK; ++it) {
                const int tok = tok0 + NWAVES * it, ntok = (it + 1 < NTOK) ? tok + NWAVES : tok;
                u32x4 ni0, ni1; PU_IDS(ni0, ni1, ntok);
                u32x4 nta, ntb; PU_TLOAD(nta, ntb, ntok);
                PU_ISSUE(rwB, i0, i1, 1);
                int d[16];
                __builtin_amdgcn_sched_barrier(0);
                PU_DOT(rwA, 0);
                __builtin_amdgcn_sched_barrier(0);
                PU_ISSUE(rwA, ni0, ni1, 0);
                __builtin_amdgcn_sched_barrier(0);
                PU_DOT(rwB, 1);
                int n8[8], n4[4], n2[2];
                { const bool b = c & 4;
#pragma unroll
                  for (int j = 0; j < 8; ++j) { const int snd = b ? d[j] : d[8 + j], kp = b ? d[8 + j] : d[j]; n8[j] = kp + __builtin_amdgcn_update_dpp(0, snd, 0x141, 0xF, 0xF, true); } }
                { const bool b = c & 1;
#pragma unroll
                  for (int j = 0; j < 4; ++j) { const int snd = b ? n8[j] : n8[4 + j], kp = b ? n8[4 + j] : n8[j]; n4[j] = kp + __builtin_amdgcn_update_dpp(0, snd, 0xB1, 0xF, 0xF, true); } }
                { const bool b = c & 2;
#pragma unroll
                  for (int j = 0; j < 2; ++j) { const int snd = b ? n4[j] : n4[2 + j], kp = b ? n4[2 + j] : n4[j]; n2[j] = kp + __builtin_amdgcn_update_dpp(0, snd, 0x4E, 0xF, 0xF, true); } }
                unsigned* pp = (unsigned*)(ws + P_SC) + ((size_t)s * T + tok) * 64;
                pp[lane] = (unsigned)(((n2[0] + 4) >> 3) & 0xffff) | ((unsigned)((n2[1] + 4) >> 3) << 16);
                i0 = ni0; i1 = ni1; ta = nta; tb = ntb;
            }
#undef PU_CQ
#undef PU_IDS
#undef PU_DW
#undef PU_EID
#undef PU_ISSUE
#undef PU_DOT
#undef PU_TLOAD
            } else
            {
                const unsigned short* e16 = (const unsigned short*)(ws + P_PE_E16); const unsigned char* w8 = ws + P_PE_W8; const float* wsc = (const float*)(ws + P_PE_WSC);
#define PV_TOKLOAD(I0, I1, WQ, WS_, TOK) do { const u32x4* ip_ = (const u32x4*)(e16 + (size_t)(TOK) * 128 + 16 * a); I0 = ip_[0]; I1 = ip_[1]; WQ = *(const u32x4*)(w8 + (size_t)(TOK) * 128 + 16 * a); WS_ = wsc[TOK]; } while (0)
#define PV_EID(I0, I1, J) ((((J) & 1) ? ((J) < 8 ? ((J) >> 1 == 0 ? I0.x : (J) >> 1 == 1 ? I0.y : (J) >> 1 == 2 ? I0.z : I0.w) : ((J) >> 1 == 4 ? I1.x : (J) >> 1 == 5 ? I1.y : (J) >> 1 == 6 ? I1.z : I1.w)) >> 16 \
                                      : ((J) < 8 ? ((J) >> 1 == 0 ? I0.x : (J) >> 1 == 1 ? I0.y : (J) >> 1 == 2 ? I0.z : I0.w) : ((J) >> 1 == 4 ? I1.x : (J) >> 1 == 5 ? I1.y : (J) >> 1 == 6 ? I1.z : I1.w)) & 0xffffu))
#define PV_ISSUE(RW, I0, I1, HALF) do { _Pragma("unroll") for (int jj = 0; jj < 8; ++jj) { const unsigned e_ = PV_EID(I0, I1, 8 * (HALF) + jj); RW[jj] = *(const u32x4*)(tabs + (size_t)(e_ * 128u + coff)); } } while (0)
#define PV_DOT4X(RW, G, WD, FIRST) do { _Pragma("unroll") for (int q = 0; q < 4; ++q) { \
                    const unsigned r0 = (q == 0) ? RW[4 * (G)].x : (q == 1) ? RW[4 * (G)].y : (q == 2) ? RW[4 * (G)].z : RW[4 * (G)].w; \
                    const unsigned r1 = (q == 0) ? RW[4 * (G) + 1].x : (q == 1) ? RW[4 * (G) + 1].y : (q == 2) ? RW[4 * (G) + 1].z : RW[4 * (G) + 1].w; \
                    const unsigned r2 = (q == 0) ? RW[4 * (G) + 2].x : (q == 1) ? RW[4 * (G) + 2].y : (q == 2) ? RW[4 * (G) + 2].z : RW[4 * (G) + 2].w; \
                    const unsigned r3 = (q == 0) ? RW[4 * (G) + 3].x : (q == 1) ? RW[4 * (G) + 3].y : (q == 2) ? RW[4 * (G) + 3].z : RW[4 * (G) + 3].w; \
                    const unsigned lo01 = __builtin_amdgcn_perm(r1, r0, 0x05010400u), hi01 = __builtin_amdgcn_perm(r1, r0, 0x07030602u); \
                    const unsigned lo23 = __builtin_amdgcn_perm(r3, r2, 0x05010400u), hi23 = __builtin_amdgcn_perm(r3, r2, 0x07030602u); \
                    const unsigned c0 = __builtin_amdgcn_perm(lo23, lo01, 0x05040100u), c1 = __builtin_amdgcn_perm(lo23, lo01, 0x07060302u); \
                    const unsigned c2 = __builtin_amdgcn_perm(hi23, hi01, 0x05040100u), c3 = __builtin_amdgcn_perm(hi23, hi01, 0x07060302u); \
                    if (FIRST) { acc[8 * q + 0] = dot4_from(c0, (WD), wb); acc[8 * q + 4] = dot4_from0(c0 & 0xf0f0f0f0u, (WD)); } else { acc[8 * q + 0] = __builtin_amdgcn_sdot4((int)c0, (int)(WD), acc[8 * q + 0], false); acc[8 * q + 4] = __builtin_amdgcn_sdot4((int)(c0 & 0xf0f0f0f0u), (int)(WD), acc[8 * q + 4], false); } \
                    if (FIRST) { acc[8 * q + 1] = dot4_from(c1, (WD), wb); acc[8 * q + 5] = dot4_from0(c1 & 0xf0f0f0f0u, (WD)); } else { acc[8 * q + 1] = __builtin_amdgcn_sdot4((int)c1, (int)(WD), acc[8 * q + 1], false); acc[8 * q + 5] = __builtin_amdgcn_sdot4((int)(c1 & 0xf0f0f0f0u), (int)(WD), acc[8 * q + 5], false); } \
                    if (FIRST) { acc[8 * q + 2] = dot4_from(c2, (WD), wb); acc[8 * q + 6] = dot4_from0(c2 & 0xf0f0f0f0u, (WD)); } else { acc[8 * q + 2] = __builtin_amdgcn_sdot4((int)c2, (int)(WD), acc[8 * q + 2], false); acc[8 * q + 6] = __builtin_amdgcn_sdot4((int)(c2 & 0xf0f0f0f0u), (int)(WD), acc[8 * q + 6], false); } \
                    if (FIRST) { acc[8 * q + 3] = dot4_from(c3, (WD), wb); acc[8 * q + 7] = dot4_from0(c3 & 0xf0f0f0f0u, (WD)); } else { acc[8 * q + 3] = __builtin_amdgcn_sdot4((int)c3, (int)(WD), acc[8 * q + 3], false); acc[8 * q + 7] = __builtin_amdgcn_sdot4((int)(c3 & 0xf0f0f0f0u), (int)(WD), acc[8 * q + 7], false); } } } while (0)
#define PV_DOT4(RW, G, WD) PV_DOT4X(RW, G, WD, false)
#define PV_ISSUE4(RW, I0, I1, ST) do { _Pragma("unroll") for (int jj = 0; jj < 4; ++jj) { const unsigned e_ = PV_EID(I0, I1, 4 * (ST) + jj); RW[jj] = *(const u32x4*)(tabs + (size_t)(e_ * 128u + coff)); } } while (0)
                u32x4 iA0, iA1, wA; float sA; u32x4 iB0, iB1, wB; float sB; u32x4 iC0, iC1, wC; float sC;
                PV_TOKLOAD(iA0, iA1, wA, sA, tok0);
                PV_TOKLOAD(iB0, iB1, wB, sB, tok0 + NWAVES);
                asm volatile("" :: "v"(iA0), "v"(iA1), "v"(wA), "v"(sA), "v"(iB0), "v"(iB1), "v"(wB), "v"(sB));
                u32x4 q0[4], q1[4], q2[4], q3[4];
                PV_ISSUE4(q0, iA0, iA1, 0); PV_ISSUE4(q1, iA0, iA1, 1); PV_ISSUE4(q2, iA0, iA1, 2);
#define PV_BODY(IT, I0, I1, WQ, WSV, NI0, NI1, NNI0, NNI1, NNWQ, NNWSV) do { \
                    const int tok = tok0 + NWAVES * (IT); \
                    u32x2* xp = (u32x2*)((bf16_t*)(ws + P_XB) + (size_t)tok * DM + s * 256 + 32 * c + 16 * ((a >> 2) & 1) + 8 * ((a >> 1) & 1) + 4 * (a & 1)); \
                    const u32x2 xw = *xp; \
                    const int nntok = ((IT) + 2 < NTOK) ? tok + 2 * NWAVES : tok; \
                    PV_TOKLOAD(NNI0, NNI1, NNWQ, NNWSV, nntok); \
                    PV_ISSUE4(q3, I0, I1, 3); \
                    int acc[32]; \
                    const int wb = -8 * __builtin_amdgcn_sdot4((int)WQ.x, 0x01010101, __builtin_amdgcn_sdot4((int)WQ.y, 0x01010101, __builtin_amdgcn_sdot4((int)WQ.z, 0x01010101, __builtin_amdgcn_sdot4((int)WQ.w, 0x01010101, 0, false), false), false), false); \
                    __builtin_amdgcn_sched_barrier(0); \
                    PV_DOT4X(q0, 0, WQ.x, true); __builtin_amdgcn_sched_barrier(0); PV_ISSUE4(q0, NI0, NI1, 0); __builtin_amdgcn_sched_barrier(0); \
                    PV_DOT4(q1, 0, WQ.y); __builtin_amdgcn_sched_barrier(0); PV_ISSUE4(q1, NI0, NI1, 1); __builtin_amdgcn_sched_barrier(0); \
                    PV_DOT4(q2, 0, WQ.z); __builtin_amdgcn_sched_barrier(0); PV_ISSUE4(q2, NI0, NI1, 2); __builtin_amdgcn_sched_barrier(0); \
                    PV_DOT4(q3, 0, WQ.w); \
                    int n16[16], n8[8], n4[4]; \
                    _Pragma("unroll") \
                    for (int q = 0; q < 16; ++q) { auto rr = __builtin_amdgcn_permlane32_swap((unsigned)acc[q], (unsigned)acc[16 + q], false, false); n16[q] = (int)rr[0] + (int)rr[1]; } \
                    _Pragma("unroll") \
                    for (int q = 0; q < 8; ++q) { auto rr = __builtin_amdgcn_permlane16_swap((unsigned)n16[q], (unsigned)n16[8 + q], false, false); n8[q] = (int)rr[0] + (int)rr[1]; } \
                      \
                    _Pragma("unroll") \
                    for (int q = 0; q < 4; ++q) n8[q] -= n8[4 + q]; \
                    { const bool b_ = a & 1; \
                    _Pragma("unroll") \
                      for (int q = 0; q < 4; ++q) { const int snd = b_ ? n8[q] : n8[4 + q], kp = b_ ? n8[4 + q] : n8[q]; n4[q] = kp + __builtin_amdgcn_update_dpp(0, snd, 0x128, 0xF, 0xF, true); } } \
                    const float wse = (a & 1) ? (WSV) * 0.0625f : (WSV); \
                    u32x2 nw; nw.x = pk2(bflo(xw.x) + (float)n4[0] * wse, bfhi(xw.x) + (float)n4[1] * wse); nw.y = pk2(bflo(xw.y) + (float)n4[2] * wse, bfhi(xw.y) + (float)n4[3] * wse); \
                    { *xp = nw; if (stats) { const float q0f = bflo(nw.x), q1f = bfhi(nw.x), q2f = bflo(nw.y), q3f = bfhi(nw.y); const float sq = wave_sum((q0f * q0f + q1f * q1f) + (q2f * q2f + q3f * q3f)); if (lane == 0) ((float*)(ws + P_SS))[(size_t)tok * 32 + s] = sq; } } \
                } while (0)
                static_assert(NTOK % 3 == 2, "token loop: groups of three plus two tail steps");
#pragma unroll 1
                for (int it = 0; it + 2 < NTOK; it += 3) {
                    PV_BODY(it,     iA0, iA1, wA, sA, iB0, iB1, iC0, iC1, wC, sC);
                    PV_BODY(it + 1, iB0, iB1, wB, sB, iC0, iC1, iA0, iA1, wA, sA);
                    PV_BODY(it + 2, iC0, iC1, wC, sC, iA0, iA1, iB0, iB1, wB, sB);
                }
                PV_BODY(NTOK - 2, iA0, iA1, wA, sA, iB0, iB1, iC0, iC1, wC, sC);
                PV_BODY(NTOK - 1, iB0, iB1, wB, sB, iC0, iC1, iA0, iA1, wA, sA);
#undef PV_BODY
#undef PV_ISSUE4
#undef PV_TOKLOAD
#undef PV_EID
#undef PV_ISSUE
#undef PV_DOT4
#undef PV_DOT4X
            }
        }
    }
}
#undef PEER_ISSUE

DI void phase_peer_combine(const Ctx& C0, const Params& P) {
    const Ctx C = fresh(C0);
    unsigned char* ws = P.ws;
    const float* usc = (const float*)(ws + P_UT + 32 * MiB); const float* vsc = (const float*)(ws + P_VT + 32 * MiB);
    const int* pe = (const int*)(ws + P_PE_E); const float* pg = (const float*)(ws + P_PE_G); const unsigned* part = (const unsigned*)(ws + P_SC); const float* tsc = (const float*)(ws + P_PE_TSC);
    const int lane = C.lane;
    const int t0 = C.blk * NWAVES + C.wave, tstep = C.G * NWAVES;
    if (t0 >= T) return;
    unsigned np[16]; f32x2 ng, nus, nvs; float ntsc; int ne[2];
#define CB_LOAD(TOK) do { _Pragma("unroll") for (int s_ = 0; s_ < 8; ++s_) np[s_] = part[((size_t)s_ * T + (TOK)) * 64 + lane]; \
        ng[0] = pg[(size_t)(TOK) * 128 + lane]; ng[1] = pg[(size_t)(TOK) * 128 + 64 + lane]; ntsc = tsc[TOK]; } while (0)
    CB_LOAD(t0);
    { const int e0 = pe[(size_t)t0 * 128 + lane], e1 = pe[(size_t)t0 * 128 + 64 + lane]; nus[0] = usc[e0]; nus[1] = usc[e1]; nvs[0] = vsc[e0]; nvs[1] = vsc[e1]; }
    { const int t1 = (t0 + tstep < T) ? t0 + tstep : t0; ne[0] = pe[(size_t)t1 * 128 + lane]; ne[1] = pe[(size_t)t1 * 128 + 64 + lane]; }
    for (int tok = t0; tok < T; tok += tstep) {
        unsigned cp[16];
#pragma unroll
        for (int s = 0; s < 8; ++s) cp[s] = np[s];
        const f32x2 cg = ng, cus = nus, cvs = nvs; const float ctsc = ntsc;
        {
            const int tn = (tok + tstep < T) ? tok + tstep : tok, tnn = (tn + tstep < T) ? tn + tstep : tn;
            CB_LOAD(tn);
            nus[0] = usc[ne[0]]; nus[1] = usc[ne[1]]; nvs[0] = vsc[ne[0]]; nvs[1] = vsc[ne[1]];
            ne[0] = pe[(size_t)tnn * 128 + lane]; ne[1] = pe[(size_t)tnn * 128 + 64 + lane];
        }
        float w[2]; int asum[2] = {0, 0};
#pragma unroll
        for (int s = 0; s < 8; ++s) { const int v = (int)cp[s]; asum[0] += (v << 16) >> 16; asum[1] += v >> 16; }
#pragma unroll
        for (int e2 = 0; e2 < 2; ++e2) { const float pv = (float)asum[e2] * 8.0f * cus[e2] * ctsc; w[e2] = cg[e2] * (0.5f * pv * (1.0f + erff(pv * 0.70710678118654752f))) * cvs[e2]; }
        float am = fmaxf(fabsf(w[0]), fabsf(w[1]));
        am = wave_max(am);
        const float sc = am > 0.f ? 127.0f / am : 0.f;
        if (lane == 0) ((float*)(ws + P_PE_WSC))[tok] = am * (1.0f / 127.0f);
        signed char* w8 = (signed char*)(ws + P_PE_W8) + (size_t)tok * 128;
        w8[lane] = (signed char)(int)rintf(w[0] * sc); w8[64 + lane] = (signed char)(int)rintf(w[1] * sc);
    }
#undef CB_LOAD
}
#endif

constexpr int N_PHASES = 39;
__global__ void __launch_bounds__(NTHREADS, 2) mk_fwd(Params P) {
    extern __shared__ __attribute__((aligned(16))) unsigned char lds_raw[];
    Ctx C; C.lds = (LAS unsigned char*)lds_raw; C.tid = threadIdx.x; C.lane = C.tid & 63; C.wave = __builtin_amdgcn_readfirstlane(C.tid >> 6); C.blk = blockIdx.x; C.G = gridDim.x;
    unsigned char* ws = P.ws;
    for (int u = C.tid; u < (LDS_BYTES - LDSCTL_OFF) / 4; u += NTHREADS) ((LAS unsigned*)(C.lds + LDSCTL_OFF))[u] = 0u;
    __syncthreads();
    XcdBarrier bar; bar.bar = (unsigned*)(ws + WS_CTL) + CW_BAR; bar.x = 0; bar.st = nullptr;
    const bool one = (P.ph_hi - P.ph_lo) > 1;
    if (one) bar = xcd_barrier_post((unsigned*)(ws + WS_CTL) + CW_BAR, (volatile LAS unsigned*)(C.lds + LDSCTL_OFF));
    const int lo = P.ph_lo, hi = P.ph_hi;
#define IN(k) (lo <= (k) && (k) < hi)
    int seam_no = 0; unsigned long long* stamps = (unsigned long long*)(ws + WS_CTL + 512 * 1024);
    if (PROBE_T >= 0 && C.blk == 0 && C.tid == 0) stamps[0] = __builtin_amdgcn_s_memrealtime();
#define SEAM(k) do { if (IN(k) && IN((k) + 1)) { xcd_barrier(bar); if (PROBE_T >= 0) { ++seam_no; if (C.blk == 0 && C.tid == 0) stamps[seam_no] = __builtin_amdgcn_s_memrealtime(); } } } while (0)
    bf16_t* hbuf = (bf16_t*)(ws + P_H); bf16_t* xb = (bf16_t*)(ws + P_XB); float* ssp = (float*)(ws + P_SS);
    const int* pos = (const int*)P.in[I_POS];
    const f32x2* rtab = (const f32x2*)(ws + WS_ROPE);

    if (IN(0)) { if (EN_PRO) phase_prologue(C, P); rms_rows_2048(C, P.in[I_X], P.in[I_AB_NORM], hbuf, T); } SEAM(0);
    if (IN(1)) {
        {
            g8::Desc g{(const bf16_t*)(ws + P_MEMN), (const bf16_t*)(ws + WS_LW + LW_XKV), DM, DM, DM, MT / 256, 2 * DM / 256, 2, 1, (long)MT * DM, 0, (long)(LW_STRIDE / 2), 0};
            EpiBf16 E{(bf16_t*)(ws + WS_KVX), 2 * DM, (long)(KVX_STRIDE / 2), 0, 1.0f, nullptr, 0};
            g8::gemm(C.lds, g, E, C.G, C.blk);
        }
        {
            g8::Desc g{(const bf16_t*)(ws + P_SK), (const bf16_t*)(ws + P_WQB), 256, DM, 256, 1, DM / 256, 2, 8, 8L * 65536, 65536, (long)DM * DM, 256};
            EpiBf16 E{(bf16_t*)(ws + WS_LW + LW_PEER), DM, (long)(LW_STRIDE / 2), 256L * DM, 1.0f, nullptr, 0};
            if (PROBE == 1) { EpiNull En; g8::gemm(C.lds, g, En, C.G, C.blk); } if (PROBE == 13) g8::gemm(C.lds, g, E, C.G, C.blk); if (GSITE < 0 || GSITE == 3) g8::gemm(C.lds, g, E, C.G, C.blk);
        }
        {
        g8::Desc g{hbuf, (const bf16_t*)(ws + WS_ABIN_T), DM, DM, DM, T / 256, AB_IN / 256, 1, 1, 0, 0, 0, 0};
        EpiRope<0> E{(bf16_t*)(ws + P_PROJ), AB_IN, pos, rtab};
        if (PROBE == 1) { EpiNull En; g8::gemm(C.lds, g, En, C.G, C.blk); } if (PROBE == 13) g8::gemm(C.lds, g, E, C.G, C.blk); if (GSITE < 0 || GSITE == 4) g8::gemm(C.lds, g, E, C.G, C.blk);
        }
    }
    SEAM(1);

    {
        constexpr int l = 0, pb = 2; (void)l;

            if (IN(pb + 3)) { if (EN_DIFF) { if (PROBE == 2) phase_diff_attn(C, P, 2); phase_diff_attn(C, P, 0); } }
            SEAM(pb + 3);
            if (IN(pb + 4)) {
                g8::Desc g{(const bf16_t*)(ws + P_GBUF), (const bf16_t*)(ws + WS_GLU_T), S5_W, S5_W, S5_W, T / 256, S5_W / 256, 1, 1, 0, 0, 0, 0};
                EpiGlu E{(const bf16_t*)(ws + P_GBUF), P.in[I_S5_BGLU], (bf16_t*)(ws + P_CONCAT)};
                if (PROBE == 1) { EpiNull En; g8::gemm(C.lds, g, En, C.G, C.blk); } if (PROBE == 13) g8::gemm(C.lds, g, E, C.G, C.blk); if (GSITE < 0 || GSITE == 5) g8::gemm(C.lds, g, E, C.G, C.blk);
            }
            SEAM(pb + 4);
            if (IN(pb + 5)) {
                g8::Desc g{(const bf16_t*)(ws + P_CONCAT), (const bf16_t*)(ws + WS_ABOUT_T), DM, DM, DM, T / 256, DM / 256, 1, 1, 0, 0, 0, 0};
                EpiResidB<true> E{P.in[I_X], xb, ssp, 0};
                if (PROBE == 1 || PROBE == 13) { EpiNull En; g8::gemm(C.lds, g, En, C.G, C.blk); } if (GSITE < 0 || GSITE == 6) g8::gemm(C.lds, g, E, C.G, C.blk);
            {
                const unsigned char* lwa = ws + WS_LW + (size_t)l * LW_STRIDE; const bf16_t* kvx = (const bf16_t*)(ws + WS_KVX + (size_t)l * KVX_STRIDE);
                {
                    g8::Desc g{kvx, (const bf16_t*)(lwa + LW_XQ), 2 * DM, DM, 512, 1, DM / 256, BATCH, 4, (long)MEM_LEN * 2 * DM, 512, 0, 512};
                    EpiBf16 E{(bf16_t*)(ws + P_WABS), DM, 1024L * DM, 256L * DM, 1.0f, nullptr, 0};
                    g8::gemm(C.lds, g, E, C.G, C.blk);
                }
                {
                    g8::Desc g{(const bf16_t*)(lwa + LW_XO), kvx + DM, DM, 2 * DM, 512, DM / 256, 1, BATCH, 4, 0, 512, (long)MEM_LEN * 2 * DM, 512};
                    EpiBf16 E{(bf16_t*)(ws + P_VW), 1024, (long)DM * 1024, 256, 1.0f, nullptr, 0};
                    g8::gemm(C.lds, g, E, C.G, C.blk);
                }
            }
            }
            SEAM(pb + 5);
    }
    {
        constexpr int l = 0, pb = 2; (void)l;
        const unsigned char* lw = ws + WS_LW + (size_t)l * LW_STRIDE;
        if (IN(pb + 7)) {
            g8::Desc g{xb, (const bf16_t*)(ws + P_WABS), DM, DM, DM, SEQ / 256, 1024 / 256, BATCH, 1, (long)SEQ * DM, 0, 1024L * DM, 0};
            EpiSoftmax256 E{(bf16_t*)(ws + P_P), 1024, (long)SEQ * 1024, 0.04419417382415922f, ssp, SEQ};
            if (PROBE == 1) { EpiNull En; g8::gemm(C.lds, g, En, C.G, C.blk); } if (PROBE == 13) g8::gemm(C.lds, g, E, C.G, C.blk); if (GSITE < 0 || GSITE == 11) g8::gemm(C.lds, g, E, C.G, C.blk);
        }
        SEAM(pb + 7);
        if (IN(pb + 10)) {
            g8::Desc g{(const bf16_t*)(ws + P_P), (const bf16_t*)(ws + P_VW), 1024, 1024, 1024, SEQ / 256, DM / 256, BATCH, 1, (long)SEQ * 1024, 0, (long)DM * 1024, 0};
            EpiResidB<false> E{nullptr, xb, ssp, SEQ};
            if (PROBE == 1 || PROBE == 13) { EpiNull En; g8::gemm(C.lds, g, En, C.G, C.blk); } if (GSITE < 0 || GSITE == 14) g8::gemm(C.lds, g, E, C.G, C.blk);
        }
        SEAM(pb + 10);
        if (IN(pb + 13)) {
            g8::Desc g{xb, (const bf16_t*)(lw + LW_PEER), DM, DM, DM, T / 256, DM / 256, 1, 1, 0, 0, 0, 0};
            EpiBf16 E{(bf16_t*)(ws + P_SC), DM, 0, 0, 1.0f, nullptr, 0};
            if (PROBE == 1) { EpiNull En; g8::gemm(C.lds, g, En, C.G, C.blk); } if (PROBE == 13) g8::gemm(C.lds, g, E, C.G, C.blk); if (GSITE < 0 || GSITE == 15) g8::gemm(C.lds, g, E, C.G, C.blk);
        }
        SEAM(pb + 13);
        if (IN(pb + 14)) { if (EN_PEER && EN_TOPK) {
            const bool conv_first = C.wave >= 4;
            if (conv_first) convert_tables(C, P, l);
            phase_peer_topk(C, P);
            if (!conv_first) convert_tables(C, P, l);
        } }
        SEAM(pb + 14);
#if PEER_SLICED
        if (IN(pb + 15)) { if (EN_PEER && EN_PU) { if (PROBE >= 7 && PROBE <= 9) { phase_peer_sliced<0, PROBE - 7>(C, P, 8 + 32 * l + 64); __syncthreads(); } phase_peer_sliced<0>(C, P, 8 + 32 * l); } }
        SEAM(pb + 15);
        if (IN(pb + 16)) { if (EN_PEER) phase_peer_combine(C, P); }
        SEAM(pb + 16);
        if (IN(pb + 17)) { if (EN_PEER && EN_PV) { if (PROBE >= 10 && PROBE <= 12) { phase_peer_sliced<1, PROBE == 10 ? 3 : PROBE - 10>(C, P, 8 + 32 * l + 80); __syncthreads(); } phase_peer_sliced<1>(C, P, 8 + 32 * l + 16); } }
        SEAM(pb + 17);
#endif
    }
    {
        constexpr int l = 1, pb = 20; (void)l;

            if (IN(pb + 1)) {
                g8::Desc g{xb, (const bf16_t*)(ws + WS_MLAIN_T), DM, DM, DM, T / 256, MLA_IN_PAD / 256, 1, 1, 0, 0, 0, 0};
                EpiBf16 E{(bf16_t*)(ws + P_MLAPROJ), MLA_IN_PAD, 0, 0, 1.0f, nullptr, 0};
                if (PROBE == 1) { EpiNull En; g8::gemm(C.lds, g, En, C.G, C.blk); } if (PROBE == 13) g8::gemm(C.lds, g, E, C.G, C.blk); if (GSITE < 0 || GSITE == 7) g8::gemm(C.lds, g, E, C.G, C.blk);
            }
            SEAM(pb + 1);
            if (IN(pb + 2)) { if (PROBE == 5) phase_mla_rows(C, P); phase_mla_rows(C, P); }
            SEAM(pb + 2);
            if (IN(pb + 3)) {
                {
                    g8::Desc g{(const bf16_t*)(ws + P_CQN), (const bf16_t*)(ws + WS_UQ_T), MLA_QR, MLA_QR, MLA_QR, T / 256, 3072 / 256, 1, 1, 0, 0, 0, 0};
                    EpiRope<1> E{(bf16_t*)(ws + P_Q), 3072, pos, rtab};
                    if (PROBE == 1) { EpiNull En; g8::gemm(C.lds, g, En, C.G, C.blk); } if (PROBE == 13) g8::gemm(C.lds, g, E, C.G, C.blk); if (GSITE < 0 || GSITE == 8) g8::gemm(C.lds, g, E, C.G, C.blk);
                }
                {
                    g8::Desc g{(const bf16_t*)(ws + P_CKVN), (const bf16_t*)(ws + WS_UKV_T), MLA_KVR, MLA_KVR, MLA_KVR, T / 256, 4096 / 256, 1, 1, 0, 0, 0, 0};
                    EpiBf16 E{(bf16_t*)(ws + P_KV), 4096, 0, 0, 1.0f, nullptr, 0};
                    if (PROBE == 1) { EpiNull En; g8::gemm(C.lds, g, En, C.G, C.blk); } if (PROBE == 13) g8::gemm(C.lds, g, E, C.G, C.blk); if (GSITE < 0 || GSITE == 9) g8::gemm(C.lds, g, E, C.G, C.blk);
                }
            }
            SEAM(pb + 3);
            if (IN(pb + 4)) { if (EN_MLA) { if (PROBE == 2) phase_mla_attn(C, P, 3); phase_mla_attn(C, P, 1); } }
            SEAM(pb + 4);
            if (IN(pb + 5)) {
                g8::Desc g{hbuf, (const bf16_t*)(ws + WS_MLAO_T), DM, DM, DM, T / 256, DM / 256, 1, 1, 0, 0, 0, 0};
                EpiResidB<false> E{nullptr, xb, ssp, 0};
                if (PROBE == 1 || PROBE == 13) { EpiNull En; g8::gemm(C.lds, g, En, C.G, C.blk); } if (GSITE < 0 || GSITE == 10) g8::gemm(C.lds, g, E, C.G, C.blk);
            {
                const unsigned char* lwa = ws + WS_LW + (size_t)l * LW_STRIDE; const bf16_t* kvx = (const bf16_t*)(ws + WS_KVX + (size_t)l * KVX_STRIDE);
                {
                    g8::Desc g{kvx, (const bf16_t*)(lwa + LW_XQ), 2 * DM, DM, 512, 1, DM / 256, BATCH, 4, (long)MEM_LEN * 2 * DM, 512, 0, 512};
                    EpiBf16 E{(bf16_t*)(ws + P_WABS), DM, 1024L * DM, 256L * DM, 1.0f, nullptr, 0};
                    g8::gemm(C.lds, g, E, C.G, C.blk);
                }
                {
                    g8::Desc g{(const bf16_t*)(lwa + LW_XO), kvx + DM, DM, 2 * DM, 512, DM / 256, 1, BATCH, 4, 0, 512, (long)MEM_LEN * 2 * DM, 512};
                    EpiBf16 E{(bf16_t*)(ws + P_VW), 1024, (long)DM * 1024, 256, 1.0f, nullptr, 0};
                    g8::gemm(C.lds, g, E, C.G, C.blk);
                }
            }
            }
            SEAM(pb + 5);
    }
    {
        constexpr int l = 1, pb = 20; (void)l;
        const unsigned char* lw = ws + WS_LW + (size_t)l * LW_STRIDE;
        if (IN(pb + 7)) {
            g8::Desc g{xb, (const bf16_t*)(ws + P_WABS), DM, DM, DM, SEQ / 256, 1024 / 256, BATCH, 1, (long)SEQ * DM, 0, 1024L * DM, 0};
            EpiSoftmax256 E{(bf16_t*)(ws + P_P), 1024, (long)SEQ * 1024, 0.04419417382415922f, ssp, SEQ};
            if (PROBE == 1) { EpiNull En; g8::gemm(C.lds, g, En, C.G, C.blk); } if (PROBE == 13) g8::gemm(C.lds, g, E, C.G, C.blk); if (GSITE < 0 || GSITE == 11) g8::gemm(C.lds, g, E, C.G, C.blk);
        }
        SEAM(pb + 7);
        if (IN(pb + 10)) {
            g8::Desc g{(const bf16_t*)(ws + P_P), (const bf16_t*)(ws + P_VW), 1024, 1024, 1024, SEQ / 256, DM / 256, BATCH, 1, (long)SEQ * 1024, 0, (long)DM * 1024, 0};
            EpiResidB<false> E{nullptr, xb, ssp, SEQ};
            if (PROBE == 1 || PROBE == 13) { EpiNull En; g8::gemm(C.lds, g, En, C.G, C.blk); } if (GSITE < 0 || GSITE == 14) g8::gemm(C.lds, g, E, C.G, C.blk);
        }
        SEAM(pb + 10);
        if (IN(pb + 13)) {
            g8::Desc g{xb, (const bf16_t*)(lw + LW_PEER), DM, DM, DM, T / 256, DM / 256, 1, 1, 0, 0, 0, 0};
            EpiBf16 E{(bf16_t*)(ws + P_SC), DM, 0, 0, 1.0f, nullptr, 0};
            if (PROBE == 1) { EpiNull En; g8::gemm(C.lds, g, En, C.G, C.blk); } if (PROBE == 13) g8::gemm(C.lds, g, E, C.G, C.blk); if (GSITE < 0 || GSITE == 15) g8::gemm(C.lds, g, E, C.G, C.blk);
        }
        SEAM(pb + 13);
        if (IN(pb + 14)) { if (EN_PEER && EN_TOPK) {
            const bool conv_first = C.wave >= 4;
            if (conv_first) convert_tables(C, P, l);
            phase_peer_topk(C, P);
            if (!conv_first) convert_tables(C, P, l);
        } }
        SEAM(pb + 14);
#if PEER_SLICED
        if (IN(pb + 15)) { if (EN_PEER && EN_PU) { if (PROBE >= 7 && PROBE <= 9) { phase_peer_sliced<0, PROBE - 7>(C, P, 8 + 32 * l + 64); __syncthreads(); } phase_peer_sliced<0>(C, P, 8 + 32 * l); } }
        SEAM(pb + 15);
        if (IN(pb + 16)) { if (EN_PEER) phase_peer_combine(C, P); }
        SEAM(pb + 16);
        if (IN(pb + 17)) { if (EN_PEER && EN_PV) { if (PROBE >= 10 && PROBE <= 12) { phase_peer_sliced<1, PROBE == 10 ? 3 : PROBE - 10>(C, P, 8 + 32 * l + 80); __syncthreads(); } phase_peer_sliced<1>(C, P, 8 + 32 * l + 16, false); } }
        SEAM(pb + 17);
#endif
    }
    if (IN(38)) rms_rows_final(C, xb, P.out, P.in[I_FINAL_NORM], T);
    if (PROBE == 14 && one) { for (int i = 0; i < 30; ++i) xcd_barrier(bar); }
    if (PROBE_T >= 0 && one) {
        xcd_barrier(bar);
        if (C.blk == 0 && C.tid == 0) stamps[seam_no + 1] = __builtin_amdgcn_s_memrealtime();
        xcd_barrier(bar);
        const unsigned long long d = __hip_atomic_load(&stamps[PROBE_T + 1], __ATOMIC_RELAXED, __HIP_MEMORY_SCOPE_AGENT) - __hip_atomic_load(&stamps[PROBE_T], __ATOMIC_RELAXED, __HIP_MEMORY_SCOPE_AGENT);
        const unsigned long long t0 = __builtin_amdgcn_s_memrealtime();
        while (__builtin_amdgcn_s_memrealtime() - t0 < 8ull * d) __builtin_amdgcn_s_sleep(8);
    }
#undef IN
#undef SEAM
}

extern "C" void kernel_launch(void* const* d_in, const int* in_sizes, int n_in, void* d_out, int out_size, void* d_ws, size_t ws_size, hipStream_t stream) {
    static int grid = 0;
    if (grid == 0) {
        if (n_in != 39 || in_sizes[0] != T * DM || out_size != T * DM || ws_size < WS_END) {
            fprintf(stderr, "kernel_launch: unexpected shapes (n_in %d in0 %d out %d ws %zu, need ws >= %zu); nothing launched\n", n_in, n_in > 0 ? in_sizes[0] : -1, out_size, ws_size, (size_t)WS_END);
            grid = -1; return; }
        int dev = 0, cus = 0;
        if (hipGetDevice(&dev) != hipSuccess || hipDeviceGetAttribute(&cus, hipDeviceAttributeMultiprocessorCount, dev) != hipSuccess) { grid = -1; return; }
        if (hipFuncSetAttribute((const void*)mk_fwd, hipFuncAttributeMaxDynamicSharedMemorySize, LDS_BYTES) != hipSuccess) { fprintf(stderr, "kernel_launch: hipFuncSetAttribute failed\n"); grid = -1; return; }
        int per_cu = 0;
        if (hipOccupancyMaxActiveBlocksPerMultiprocessor(&per_cu, (const void*)mk_fwd, NTHREADS, LDS_BYTES) != hipSuccess || per_cu < 1)
            fprintf(stderr, "kernel_launch: occupancy query reports %d blocks per CU\n", per_cu);
        (void)hipGetLastError();
        grid = cus;
    }
    if (grid < 0) return;
    (void)hipMemsetAsync((char*)d_ws + WS_CTL, 0, CTL_BYTES, stream);
    Params p{};
    for (int i = 0; i < 39; ++i) p.in[i] = (const float*)d_in[i];
    p.out = (float*)d_out; p.ws = (unsigned char*)d_ws;
#if MK_ONE_LAUNCH
    p.ph_lo = 0; p.ph_hi = N_PHASES;
    hipLaunchKernelGGL(mk_fwd, dim3(grid), dim3(NTHREADS), LDS_BYTES, stream, p);
#else
    for (int ph = 0; ph < N_PHASES; ++ph) { p.ph_lo = ph; p.ph_hi = ph + 1; hipLaunchKernelGGL(mk_fwd, dim3(grid), dim3(NTHREADS), LDS_BYTES, stream, p); }
#endif
    const hipError_t le = hipPeekAtLastError();
    if (le != hipSuccess) fprintf(stderr, "kernel_launch: launch failed: %s\n", hipGetErrorName(le));
}
```
